# Optimizing an MI355X kernel written in HIP

```python
import math
import jax, jax.numpy as jnp
from jax import lax
import numpy as np

D_MODEL = 1024
BATCH = 8
SEQ = 2048
DEPTH = 2

HEAD_DIM = 64
Q_BLOCK = 128
A_HEADS = 8
A_KV_HEADS = 2
A_WINDOW = 128
B_HEADS = 8
C_HEADS = 8
C_BLOCK = 256
C_TOPK = 3
MOBA_Q_CHUNK = 16
D_HEADS = 8
D_KV_HEADS = 2
NSA_CMP_LEN = 32
NSA_CMP_STRIDE = 16
NSA_SLC_BLOCK = 64
NSA_TOPN = 16
NSA_WINDOW = 512
NSA_Q_CHUNK = 64
FORCE_BONUS = 1000.0
N_GROUPS = 4
EXPERTS_PER_GROUP = 8
N_EXPERTS = N_GROUPS * EXPERTS_PER_GROUP
EXPERT_FF = 256
TOP_K_IN_GROUP = 2

EPS = 1e-6
NEG = -1e30
MIX_WIDTH = (A_HEADS + B_HEADS) * HEAD_DIM
EVEN_WIDTHS = (A_HEADS * HEAD_DIM, A_KV_HEADS * HEAD_DIM, A_KV_HEADS * HEAD_DIM,
               B_HEADS * HEAD_DIM, B_HEADS * HEAD_DIM, B_HEADS * HEAD_DIM)
ODD_WIDTHS = (C_HEADS * HEAD_DIM, C_HEADS * HEAD_DIM, C_HEADS * HEAD_DIM,
              D_HEADS * HEAD_DIM) + (D_KV_HEADS * HEAD_DIM,) * 6 + (D_HEADS * 3,)
EVEN_IN = sum(EVEN_WIDTHS)
ODD_IN = sum(ODD_WIDTHS)

kernel_name = 'hybrid_swa_sink_stickbreak_moba_nsa_hmoe'


def rms_norm(x, g):
    xf = x.astype(jnp.float32)
    y = xf * lax.rsqrt(jnp.mean(xf * xf, axis=-1, keepdims=True) + EPS)
    return (y * g.astype(jnp.float32)).astype(x.dtype)


def _split(x, widths):
    offs = np.cumsum([0] + list(widths))
    return [x[..., int(offs[i]):int(offs[i + 1])] for i in range(len(widths))]


def _alibi_slopes(n_heads):
    return jnp.asarray(2.0 ** (-8.0 * np.arange(1, n_heads + 1) / n_heads), dtype=jnp.float32)


def banded_attention(q, k, v, window, slopes, sink=None):
    b, s, h, d = q.shape
    hkv = k.shape[2]
    g = h // hkv
    nb = s // Q_BLOCK
    npre = window // Q_BLOCK
    pad = ((0, 0), (npre * Q_BLOCK, 0), (0, 0), (0, 0))
    kp = jnp.pad(k, pad).reshape(b, nb + npre, Q_BLOCK, hkv, d)
    vp = jnp.pad(v, pad).reshape(b, nb + npre, Q_BLOCK, hkv, d)
    kw = jnp.concatenate([kp[:, j:j + nb] for j in range(npre + 1)], axis=2)
    vw = jnp.concatenate([vp[:, j:j + nb] for j in range(npre + 1)], axis=2)
    qb = q.reshape(b, nb, Q_BLOCK, hkv, g, d)
    sc = jnp.einsum('bnqhgd,bnkhd->bnhgqk', qb, kw).astype(jnp.float32) / math.sqrt(d)
    qpos = jnp.arange(nb)[:, None] * Q_BLOCK + jnp.arange(Q_BLOCK)[None, :]
    kpos = (jnp.arange(nb)[:, None] - npre) * Q_BLOCK + jnp.arange((npre + 1) * Q_BLOCK)[None, :]
    diff = qpos[:, :, None] - kpos[:, None, :]
    mask = (diff >= 0) & (diff < window) & (kpos[:, None, :] >= 0)
    m_h = slopes.reshape(hkv, g)[:, :, None, None]
    diff_f = diff.astype(jnp.float32)[None, :, None, None]
    sc = jnp.where(mask[None, :, None, None], sc - m_h * diff_f, NEG)
    if sink is None:
        p = jax.nn.softmax(sc, axis=-1)
    else:
        sk = sink.astype(jnp.float32).reshape(hkv, g)[None, None, :, :, None, None]
        mx = jnp.maximum(sc.max(axis=-1, keepdims=True), sk)
        e = jnp.exp(sc - mx)
        p = e / (e.sum(axis=-1, keepdims=True) + jnp.exp(sk - mx))
    o = jnp.einsum('bnhgqk,bnkhd->bnqhgd', p, vw.astype(jnp.float32))
    return o.reshape(b, s, h, d).astype(q.dtype)


def stick_breaking_attention(q, k, v):
    b, s, h, d = q.shape
    nb = s // Q_BLOCK
    qb = q.reshape(b, nb, Q_BLOCK, h, d).transpose(1, 0, 2, 3, 4)
    kpos = jnp.arange(s)
    vf = v.astype(jnp.float32)

    def block(args):
        qi, i = args
        z = jnp.einsum('bqhd,bkhd->bhqk', qi, k).astype(jnp.float32) / math.sqrt(d)
        qpos = i * Q_BLOCK + jnp.arange(Q_BLOCK)
        mask = kpos[None, :] < qpos[:, None]
        log_keep = jnp.where(mask, jax.nn.log_sigmoid(-z), 0.0)
        suffix = lax.cumsum(log_keep, axis=3, reverse=True) - log_keep
        a = jnp.where(mask, jnp.exp(jax.nn.log_sigmoid(z) + suffix), 0.0)
        return jnp.einsum('bhqk,bkhd->bqhd', a, vf)

    o = lax.map(block, (qb, jnp.arange(nb)))
    return o.transpose(1, 0, 2, 3, 4).reshape(b, s, h, d).astype(q.dtype)


def moba_attention(q, k, v, slopes):
    b, s, h, d = q.shape
    nblk = -(-s // C_BLOCK)
    s_pad = nblk * C_BLOCK
    pad = ((0, 0), (0, s_pad - s), (0, 0), (0, 0))
    q, k, v = jnp.pad(q, pad), jnp.pad(k, pad), jnp.pad(v, pad)
    kb = k.reshape(b, nblk, C_BLOCK, h, d).transpose(0, 3, 1, 2, 4)
    vb = v.reshape(b, nblk, C_BLOCK, h, d).transpose(0, 3, 1, 2, 4)
    gate = jnp.einsum('bshd,bhnd->bhsn', q, kb.mean(axis=3)).astype(jnp.float32)
    own = jnp.arange(s_pad) // C_BLOCK
    past = jnp.arange(nblk)[None, :] < own[:, None]
    gate = jnp.where(past, gate, NEG)
    _, top_idx = lax.top_k(gate, min(C_TOPK, nblk))
    top_valid = top_idx < own[:, None]
    idx = jnp.concatenate([top_idx, jnp.broadcast_to(own[:, None], (b, h, s_pad, 1))], axis=-1)
    valid = jnp.concatenate([top_valid, jnp.ones((b, h, s_pad, 1), dtype=bool)], axis=-1)
    nc = s_pad // MOBA_Q_CHUNK

    def to_chunks(a):
        return jnp.moveaxis(a.reshape(b, h, nc, MOBA_Q_CHUNK, *a.shape[3:]), 2, 0)

    bi = jnp.arange(b)[:, None, None, None]
    hi = jnp.arange(h)[None, :, None, None]

    def chunk(args):
        qi, ii, vi, ci = args
        ks = kb[bi, hi, ii]
        vs = vb[bi, hi, ii]
        sc = jnp.einsum('bhqd,bhqnkd->bhqnk', qi, ks).astype(jnp.float32) / math.sqrt(d)
        qpos = ci * MOBA_Q_CHUNK + jnp.arange(MOBA_Q_CHUNK)
        kpos = ii[..., None] * C_BLOCK + jnp.arange(C_BLOCK)
        diff = (qpos[:, None, None] - kpos).astype(jnp.float32)
        mask = vi[..., None] & (diff >= 0)
        sc = jnp.where(mask, sc - slopes[:, None, None, None] * diff, NEG)
        p = jax.nn.softmax(sc.reshape(b, h, MOBA_Q_CHUNK, -1), axis=-1).reshape(sc.shape)
        return jnp.einsum('bhqnk,bhqnkd->bhqd', p, vs.astype(jnp.float32))

    o = lax.map(chunk, (to_chunks(q.transpose(0, 2, 1, 3)), to_chunks(idx), to_chunks(valid), jnp.arange(nc)))
    o = jnp.moveaxis(o, 0, 2).reshape(b, h, s_pad, d).transpose(0, 2, 1, 3)[:, :s]
    return o.astype(q.dtype)


def compress_blocks(x, pos_emb, w):
    s = x.shape[1]
    n_cmp = (s - NSA_CMP_LEN) // NSA_CMP_STRIDE + 1
    idx = np.arange(n_cmp)[:, None] * NSA_CMP_STRIDE + np.arange(NSA_CMP_LEN)[None, :]
    blocks = x[:, idx] + pos_emb[None, None, :, None, :]
    return jnp.einsum('bnlhd,lde->bnhe', blocks, w)


def nsa_attention(q, k_cmp, v_cmp, k_slc, v_slc, k_win, v_win, gates, slopes):
    b, s, h, d = q.shape
    hkv = k_slc.shape[2]
    g = h // hkv
    n_cmp = k_cmp.shape[1]
    pos = jnp.arange(s)
    m_h = slopes.reshape(hkv, g)
    qg = q.reshape(b, s, hkv, g, d)
    cmp_end = jnp.arange(n_cmp) * NSA_CMP_STRIDE + NSA_CMP_LEN - 1
    diff_c = (pos[:, None] - cmp_end[None, :]).astype(jnp.float32)
    mask_c = diff_c >= 0
    sc = jnp.einsum('bshgd,bnhd->bhgsn', qg, k_cmp).astype(jnp.float32) / math.sqrt(d)
    sc = jnp.where(mask_c, sc - m_h[:, :, None, None] * diff_c, NEG)
    e = jnp.where(mask_c, jnp.exp(sc - sc.max(axis=-1, keepdims=True)), 0.0)
    den = e.sum(axis=-1, keepdims=True)
    p_cmp = e / jnp.where(den > 0, den, 1.0)
    o_cmp = jnp.einsum('bhgsn,bnhd->bshgd', p_cmp, v_cmp.astype(jnp.float32)).reshape(b, s, h, d)
    n_slc = s // NSA_SLC_BLOCK
    cst = np.arange(n_cmp)[:, None] * NSA_CMP_STRIDE
    sst = np.arange(n_slc)[None, :] * NSA_SLC_BLOCK
    overlap = jnp.asarray(((cst < sst + NSA_SLC_BLOCK) & (cst + NSA_CMP_LEN > sst)).astype(np.float32))
    p_slc = jnp.einsum('bhgsn,nj->bhsj', p_cmp, overlap)
    cur = pos // NSA_SLC_BLOCK
    j = jnp.arange(n_slc)[None, :]
    forced = (j == 0) | (j == cur[:, None]) | (j == cur[:, None] - 1)
    score = jnp.where(j <= cur[:, None], p_slc + jnp.where(forced, FORCE_BONUS, 0.0), NEG)
    _, sel = lax.top_k(score, min(NSA_TOPN, n_slc))
    sel_valid = sel <= cur[:, None]
    ksb = k_slc.reshape(b, n_slc, NSA_SLC_BLOCK, hkv, d).transpose(0, 3, 1, 2, 4)
    vsb = v_slc.reshape(b, n_slc, NSA_SLC_BLOCK, hkv, d).transpose(0, 3, 1, 2, 4)
    nc = s // NSA_Q_CHUNK
    qc = jnp.moveaxis(qg.transpose(0, 2, 3, 1, 4).reshape(b, hkv, g, nc, NSA_Q_CHUNK, d), 3, 0)
    selc = jnp.moveaxis(sel.reshape(b, hkv, nc, NSA_Q_CHUNK, -1), 2, 0)
    valc = jnp.moveaxis(sel_valid.reshape(b, hkv, nc, NSA_Q_CHUNK, -1), 2, 0)
    bi = jnp.arange(b)[:, None, None, None]
    hi = jnp.arange(hkv)[None, :, None, None]

    def chunk(args):
        qi, si, vi, c = args
        ks = ksb[bi, hi, si]
        vs = vsb[bi, hi, si]
        scs = jnp.einsum('bhgqd,bhqnkd->bhgqnk', qi, ks).astype(jnp.float32) / math.sqrt(d)
        qpos = c * NSA_Q_CHUNK + jnp.arange(NSA_Q_CHUNK)
        kpos = si[..., None] * NSA_SLC_BLOCK + jnp.arange(NSA_SLC_BLOCK)
        diff = (qpos[:, None, None] - kpos).astype(jnp.float32)
        mask = vi[..., None] & (diff >= 0)
        scs = jnp.where(mask[:, :, None], scs - m_h[None, :, :, None, None, None] * diff[:, :, None], NEG)
        p = jax.nn.softmax(scs.reshape(b, hkv, g, NSA_Q_CHUNK, -1), axis=-1).reshape(scs.shape)
        return jnp.einsum('bhgqnk,bhqnkd->bhgqd', p, vs.astype(jnp.float32))

    o_slc = lax.map(chunk, (qc, selc, valc, jnp.arange(nc)))
    o_slc = jnp.moveaxis(o_slc, 0, 3).reshape(b, hkv, g, s, d).transpose(0, 3, 1, 2, 4).reshape(b, s, h, d)
    o_win = banded_attention(q, k_win, v_win, NSA_WINDOW, slopes).astype(jnp.float32)
    gf = gates.astype(jnp.float32)
    o = gf[..., 0:1] * o_cmp + gf[..., 1:2] * o_slc + gf[..., 2:3] * o_win
    return o.astype(q.dtype)


def even_mixer(x, norm_g, w_in, q_norm, k_norm, sink, w_out):
    b, s, _ = x.shape
    proj = rms_norm(x, norm_g) @ w_in
    qa, ka, va, qb, kb, vb = _split(proj, EVEN_WIDTHS)
    qa = rms_norm(qa.reshape(b, s, A_HEADS, HEAD_DIM), q_norm)
    ka = rms_norm(ka.reshape(b, s, A_KV_HEADS, HEAD_DIM), k_norm)
    va = va.reshape(b, s, A_KV_HEADS, HEAD_DIM)
    oa = banded_attention(qa, ka, va, A_WINDOW, _alibi_slopes(A_HEADS), sink)
    ob = stick_breaking_attention(qb.reshape(b, s, B_HEADS, HEAD_DIM),
                                  kb.reshape(b, s, B_HEADS, HEAD_DIM),
                                  vb.reshape(b, s, B_HEADS, HEAD_DIM))
    o = jnp.concatenate([oa.reshape(b, s, -1), ob.reshape(b, s, -1)], axis=-1)
    return x + o @ w_out


def odd_mixer(x, norm_g, w_in, c_q_norm, c_k_norm, d_q_norm, d_k_norm, cmp_pos, cmp_w, w_out):
    b, s, _ = x.shape
    proj = rms_norm(x, norm_g) @ w_in
    qc, kc, vc, qd, kcmp, vcmp, kslc, vslc, kwin, vwin, gd = _split(proj, ODD_WIDTHS)

    def heads(t, n):
        return t.reshape(b, s, n, HEAD_DIM)

    oc = moba_attention(rms_norm(heads(qc, C_HEADS), c_q_norm), rms_norm(heads(kc, C_HEADS), c_k_norm),
                        heads(vc, C_HEADS), _alibi_slopes(C_HEADS))
    k_cmp = rms_norm(compress_blocks(heads(kcmp, D_KV_HEADS), cmp_pos[0], cmp_w[0]), d_k_norm[0])
    v_cmp = compress_blocks(heads(vcmp, D_KV_HEADS), cmp_pos[1], cmp_w[1])
    od = nsa_attention(rms_norm(heads(qd, D_HEADS), d_q_norm), k_cmp, v_cmp,
                       rms_norm(heads(kslc, D_KV_HEADS), d_k_norm[1]), heads(vslc, D_KV_HEADS),
                       rms_norm(heads(kwin, D_KV_HEADS), d_k_norm[2]), heads(vwin, D_KV_HEADS),
                       jax.nn.sigmoid(gd.reshape(b, s, D_HEADS, 3)), _alibi_slopes(D_HEADS))
    o = jnp.concatenate([oc.reshape(b, s, -1), od.reshape(b, s, -1)], axis=-1)
    return x + o @ w_out


def hier_moe(x, norm_g, w_grp, b_grp, w_exp, b_exp, w_gate, w_up, w_down):
    shp = x.shape
    h = rms_norm(x, norm_g).reshape(-1, D_MODEL)
    t = h.shape[0]
    grp_logits = (h @ w_grp).astype(jnp.float32) + b_grp.astype(jnp.float32)
    grp_prob = jax.nn.softmax(grp_logits, axis=-1)
    g_sel = jnp.argmax(grp_logits, axis=-1)
    p_g = jnp.take_along_axis(grp_prob, g_sel[:, None], axis=1)
    exp_logits = ((h @ w_exp).astype(jnp.float32) + b_exp.astype(jnp.float32)).reshape(t, N_GROUPS, EXPERTS_PER_GROUP)
    within = jnp.take_along_axis(exp_logits, g_sel[:, None, None], axis=1)[:, 0]
    top_p, top_i = lax.top_k(jax.nn.softmax(within, axis=-1), TOP_K_IN_GROUP)
    wts = p_g * top_p / top_p.sum(axis=-1, keepdims=True)
    expert_id = g_sel[:, None] * EXPERTS_PER_GROUP + top_i
    comb = (jax.nn.one_hot(expert_id, N_EXPERTS, dtype=jnp.float32) * wts[..., None]).sum(axis=1)

    def step(acc, params):
        wg, wu, wd, c = params
        y = (jax.nn.silu(h @ wg) * (h @ wu)) @ wd
        return acc + c[:, None].astype(y.dtype) * y, None

    acc, _ = lax.scan(step, jnp.zeros_like(h), (w_gate, w_up, w_down, comb.T))
    return x + acc.reshape(shp)


def setup_inputs(seed: int = 0) -> dict:
    key = jax.random.key(seed)
    ks = iter(jax.random.split(key, 32))
    ne, no = (DEPTH + 1) // 2, DEPTH // 2

    def nrm(shape, scale):
        return scale * jax.random.normal(next(ks), shape, jnp.float32)

    def gain(shape):
        return 1.0 + nrm(shape, 0.02)

    return {
        'x': nrm((BATCH, SEQ, D_MODEL), 1.0),
        'ev_norm': gain((ne, D_MODEL)),
        'ev_w_in': nrm((ne, D_MODEL, EVEN_IN), D_MODEL ** -0.5),
        'ev_q_norm': gain((ne, HEAD_DIM)),
        'ev_k_norm': gain((ne, HEAD_DIM)),
        'ev_sink': nrm((ne, A_HEADS), 0.5),
        'ev_w_out': nrm((ne, MIX_WIDTH, D_MODEL), MIX_WIDTH ** -0.5),
        'od_norm': gain((no, D_MODEL)),
        'od_w_in': nrm((no, D_MODEL, ODD_IN), D_MODEL ** -0.5),
        'od_c_q_norm': gain((no, HEAD_DIM)),
        'od_c_k_norm': gain((no, HEAD_DIM)),
        'od_d_q_norm': gain((no, HEAD_DIM)),
        'od_d_k_norm': gain((no, 3, HEAD_DIM)),
        'od_cmp_pos': nrm((no, 2, NSA_CMP_LEN, HEAD_DIM), 0.1),
        'od_cmp_w': nrm((no, 2, NSA_CMP_LEN, HEAD_DIM, HEAD_DIM), (NSA_CMP_LEN * HEAD_DIM) ** -0.5),
        'od_w_out': nrm((no, MIX_WIDTH, D_MODEL), MIX_WIDTH ** -0.5),
        'moe_norm': gain((DEPTH, D_MODEL)),
        'moe_w_grp': nrm((DEPTH, D_MODEL, N_GROUPS), D_MODEL ** -0.5),
        'moe_b_grp': nrm((DEPTH, N_GROUPS), 0.01),
        'moe_w_exp': nrm((DEPTH, D_MODEL, N_EXPERTS), D_MODEL ** -0.5),
        'moe_b_exp': nrm((DEPTH, N_EXPERTS), 0.01),
        'moe_w_gate': nrm((DEPTH, N_EXPERTS, D_MODEL, EXPERT_FF), D_MODEL ** -0.5),
        'moe_w_up': nrm((DEPTH, N_EXPERTS, D_MODEL, EXPERT_FF), D_MODEL ** -0.5),
        'moe_w_down': nrm((DEPTH, N_EXPERTS, EXPERT_FF, D_MODEL), EXPERT_FF ** -0.5),
    }


def reference(x, ev_norm, ev_w_in, ev_q_norm, ev_k_norm, ev_sink, ev_w_out,
              od_norm, od_w_in, od_c_q_norm, od_c_k_norm, od_d_q_norm, od_d_k_norm,
              od_cmp_pos, od_cmp_w, od_w_out,
              moe_norm, moe_w_grp, moe_b_grp, moe_w_exp, moe_b_exp, moe_w_gate, moe_w_up, moe_w_down):
    for layer in range(DEPTH):
        i = layer // 2
        if layer % 2 == 0:
            x = even_mixer(x, ev_norm[i], ev_w_in[i], ev_q_norm[i], ev_k_norm[i], ev_sink[i], ev_w_out[i])
        else:
            x = odd_mixer(x, od_norm[i], od_w_in[i], od_c_q_norm[i], od_c_k_norm[i], od_d_q_norm[i],
                          od_d_k_norm[i], od_cmp_pos[i], od_cmp_w[i], od_w_out[i])
        x = hier_moe(x, moe_norm[layer], moe_w_grp[layer], moe_b_grp[layer], moe_w_exp[layer],
                     moe_b_exp[layer], moe_w_gate[layer], moe_w_up[layer], moe_w_down[layer])
    return x
```

```cpp
#ifndef CPU_EMU
#include <hip/hip_runtime.h>
#define DEV __device__ __forceinline__
#else
#include <cmath>
#include <cstring>
#include <cstdio>
#include <cstdlib>
#define DEV static inline
static inline float rsqrtf(float x) { return 1.0f / sqrtf(x); }
static inline float exp2f_(float x) { return exp2f(x); }
#endif

#ifndef NB
#define NB 8
#endif
typedef unsigned short bf16;
constexpr int S = 2048, D = 1024, T = NB * S, HD = 64;
constexpr int EVEN_IN = 2304, ODD_IN = 2840;
constexpr int NCMP = 127, NSLC = 32;
constexpr float NEG = -1e30f;
constexpr float EPS = 1e-6f;

DEV float u2f(unsigned u) { float f; __builtin_memcpy(&f, &u, 4); return f; }
DEV unsigned f2u(float f) { unsigned u; __builtin_memcpy(&u, &f, 4); return u; }
DEV float bf2f(bf16 h) { return u2f(((unsigned)h) << 16); }
DEV bf16 f2bf(float f) { unsigned u = f2u(f); u += 0x7fffu + ((u >> 16) & 1u); return (bf16)(u >> 16); }

struct Params {
    const float *x, *ev_norm, *ev_w_in, *ev_q_norm, *ev_k_norm, *ev_sink, *ev_w_out;
    const float *od_norm, *od_w_in, *od_c_q_norm, *od_c_k_norm, *od_d_q_norm, *od_d_k_norm, *od_cmp_pos, *od_cmp_w, *od_w_out;
    const float *moe_norm, *moe_w_grp, *moe_b_grp, *moe_w_exp, *moe_b_exp, *moe_w_gate, *moe_w_up, *moe_w_down;
    float* out;
    bf16* proj;
    bf16* o;
    float* rstd;
    int* eid;
    float* ew;
    float* hmid;
    float* kmean;
    bf16* kvcmp;
    float* ocmp;
    float* cml;
    float* pslc;
    unsigned* selmask;
};

DEV void load64(const bf16* p, float (&q)[64]) {
#pragma unroll
    for (int d = 0; d < 64; ++d) q[d] = bf2f(p[d]);
}
DEV float dot64(const float (&q)[64], const bf16* k) {
    float s = 0.f;
#pragma unroll
    for (int d = 0; d < 64; ++d) s += q[d] * bf2f(k[d]);
    return s;
}
DEV float dot64f(const float (&q)[64], const float* k) {
    float s = 0.f;
#pragma unroll
    for (int d = 0; d < 64; ++d) s += q[d] * k[d];
    return s;
}
DEV void os_update(float sc, const bf16* v, float& m, float& l, float (&o)[64]) {
    if (sc > m) {
        float f = expf(m - sc);
        l *= f;
#pragma unroll
        for (int d = 0; d < 64; ++d) o[d] *= f;
        m = sc;
    }
    float p = expf(sc - m);
    l += p;
#pragma unroll
    for (int d = 0; d < 64; ++d) o[d] += p * bf2f(v[d]);
}
DEV float slope_of(int hh) { return exp2f(-(float)(hh + 1)); }

DEV void ph_rstd(const float* src, float* rstd, int gtid, int gsz) {
    for (int t = gtid; t < T; t += gsz) {
        const float* r = src + (size_t)t * D;
        float s = 0.f;
        for (int i = 0; i < D; ++i) s += r[i] * r[i];
        rstd[t] = rsqrtf(s * (1.0f / D) + EPS);
    }
}

DEV void ph_gemm_in(const float* src, const float* rstd, const float* g, const float* W, int N, bf16* proj, int gtid, int gsz) {
    const long total = (long)T * N;
    for (long i = gtid; i < total; i += gsz) {
        const int t = (int)(i / N), n = (int)(i % N);
        const float* a = src + (size_t)t * D;
        float acc = 0.f;
        for (int k = 0; k < D; ++k) acc += a[k] * g[k] * W[(size_t)k * N + n];
        proj[(size_t)t * ODD_IN + n] = f2bf(acc * rstd[t]);
    }
}

DEV void headnorm_inplace(bf16* p, const float* g) {
    float v[64];
    load64(p, v);
    float s = 0.f;
#pragma unroll
    for (int d = 0; d < 64; ++d) s += v[d] * v[d];
    const float r = rsqrtf(s * (1.0f / 64) + EPS);
#pragma unroll
    for (int d = 0; d < 64; ++d) p[d] = f2bf(v[d] * r * g[d]);
}

DEV void ph_headnorm0(const Params& P, int gtid, int gsz) {
    const long total = (long)T * 10;
    for (long i = gtid; i < total; i += gsz) {
        const int t = (int)(i / 10), h = (int)(i % 10);
        bf16* row = P.proj + (size_t)t * ODD_IN;
        if (h < 8) headnorm_inplace(row + h * 64, P.ev_q_norm);
        else headnorm_inplace(row + 512 + (h - 8) * 64, P.ev_k_norm);
    }
}

DEV void ph_headnorm1(const Params& P, int gtid, int gsz) {
    const long total = (long)T * 28;
    for (long i = gtid; i < total; i += gsz) {
        const int t = (int)(i / 28), h = (int)(i % 28);
        bf16* row = P.proj + (size_t)t * ODD_IN;
        if (h < 8) headnorm_inplace(row + h * 64, P.od_c_q_norm);
        else if (h < 16) headnorm_inplace(row + 512 + (h - 8) * 64, P.od_c_k_norm);
        else if (h < 24) headnorm_inplace(row + 1536 + (h - 16) * 64, P.od_d_q_norm);
        else if (h < 26) headnorm_inplace(row + 2304 + (h - 24) * 64, P.od_d_k_norm + 64);
        else headnorm_inplace(row + 2560 + (h - 26) * 64, P.od_d_k_norm + 128);
    }
}

DEV void ph_attn0(const Params& P, int gtid, int gsz) {
    const long total = (long)T * 16;
    for (long i = gtid; i < total; i += gsz) {
        const int hh = (int)(i / T), t = (int)(i % T);
        const int b = t / S, s = t % S;
        const bf16* base = P.proj + (size_t)b * S * ODD_IN;
        float q[64], o[64];
#pragma unroll
        for (int d = 0; d < 64; ++d) o[d] = 0.f;
        if (hh < 8) {
            const int kvh = hh >> 2;
            load64(base + (size_t)s * ODD_IN + hh * 64, q);
            const float sl = slope_of(hh);
            float m = NEG, l = 0.f;
            const int s0 = s - 127 < 0 ? 0 : s - 127;
            for (int sp = s0; sp <= s; ++sp) {
                const bf16* kr = base + (size_t)sp * ODD_IN + 512 + kvh * 64;
                const float sc = dot64(q, kr) * 0.125f - sl * (float)(s - sp);
                os_update(sc, kr + 128, m, l, o);
            }
            const float sk = P.ev_sink[hh];
            const float mx = m > sk ? m : sk;
            const float scale = expf(m - mx);
            const float den = l * scale + expf(sk - mx);
            const float f = scale / den;
            bf16* op = P.o + (size_t)t * D + hh * 64;
#pragma unroll
            for (int d = 0; d < 64; ++d) op[d] = f2bf(o[d] * f);
        } else {
            const int h = hh - 8;
            load64(base + (size_t)s * ODD_IN + 768 + h * 64, q);
            float acc = 0.f;
            for (int sp = s - 1; sp >= 0; --sp) {
                const bf16* kr = base + (size_t)sp * ODD_IN + 1280 + h * 64;
                const float z = dot64(q, kr) * 0.125f;
                const float ls = (z < 0.f ? z : 0.f) - log1pf(expf(-fabsf(z)));
                const float a = expf(ls + acc);
                const bf16* vr = kr + 512;
#pragma unroll
                for (int d = 0; d < 64; ++d) o[d] += a * bf2f(vr[d]);
                acc += ls - z;
                if (acc < -110.f) break;
            }
            bf16* op = P.o + (size_t)t * D + 512 + h * 64;
#pragma unroll
            for (int d = 0; d < 64; ++d) op[d] = f2bf(o[d]);
        }
    }
}

DEV void ph_gemm_out(const bf16* o, const float* W, const float* resid, float* out, int gtid, int gsz) {
    const long total = (long)T * D;
    for (long i = gtid; i < total; i += gsz) {
        const int t = (int)(i / D), c = (int)(i % D);
        const bf16* a = o + (size_t)t * D;
        float acc = 0.f;
        for (int k = 0; k < D; ++k) acc += bf2f(a[k]) * W[(size_t)k * D + c];
        out[i] = resid[i] + acc;
    }
}

DEV void ph_moe_route(const Params& P, int layer, int gtid, int gsz) {
    const float* g = P.moe_norm + layer * D;
    const float* wgrp = P.moe_w_grp + (size_t)layer * D * 4;
    const float* wexp = P.moe_w_exp + (size_t)layer * D * 32;
    const float* bgrp = P.moe_b_grp + layer * 4;
    const float* bexp = P.moe_b_exp + layer * 32;
    for (int t = gtid; t < T; t += gsz) {
        const float* r = P.out + (size_t)t * D;
        float ss = 0.f;
        for (int k = 0; k < D; ++k) ss += r[k] * r[k];
        const float rs = rsqrtf(ss * (1.0f / D) + EPS);
        P.rstd[t] = rs;
        float lg[4], le[32];
#pragma unroll
        for (int j = 0; j < 4; ++j) lg[j] = 0.f;
#pragma unroll
        for (int j = 0; j < 32; ++j) le[j] = 0.f;
        for (int k = 0; k < D; ++k) {
            const float h = r[k] * rs * g[k];
#pragma unroll
            for (int j = 0; j < 4; ++j) lg[j] += h * wgrp[k * 4 + j];
#pragma unroll
            for (int j = 0; j < 32; ++j) le[j] += h * wexp[k * 32 + j];
        }
#pragma unroll
        for (int j = 0; j < 4; ++j) lg[j] += bgrp[j];
#pragma unroll
        for (int j = 0; j < 32; ++j) le[j] += bexp[j];
        int gs = 0; float gm = lg[0];
#pragma unroll
        for (int j = 1; j < 4; ++j) if (lg[j] > gm) { gm = lg[j]; gs = j; }
        float gz = 0.f;
#pragma unroll
        for (int j = 0; j < 4; ++j) gz += expf(lg[j] - gm);
        const float pg = 1.0f / gz;
        float w[8];
#pragma unroll
        for (int j = 0; j < 8; ++j) w[j] = gs == 0 ? le[j] : gs == 1 ? le[8 + j] : gs == 2 ? le[16 + j] : le[24 + j];
        int i1 = 0; float m1 = w[0];
#pragma unroll
        for (int j = 1; j < 8; ++j) if (w[j] > m1) { m1 = w[j]; i1 = j; }
        int i2 = -1; float m2 = -3e38f;
#pragma unroll
        for (int j = 0; j < 8; ++j) if (j != i1 && w[j] > m2) { m2 = w[j]; i2 = j; }
        const float e2 = expf(m2 - m1);
        const float w1 = pg / (1.0f + e2), w2 = pg * e2 / (1.0f + e2);
        P.eid[t * 2 + 0] = gs * 8 + i1; P.eid[t * 2 + 1] = gs * 8 + i2;
        P.ew[t * 2 + 0] = w1; P.ew[t * 2 + 1] = w2;
    }
}

DEV void ph_moe_hidden(const Params& P, int layer, int gtid, int gsz) {
    const float* g = P.moe_norm + layer * D;
    const long total = (long)T * 512;
    for (long i = gtid; i < total; i += gsz) {
        const int t = (int)(i >> 9), slot = (int)((i >> 8) & 1), f = (int)(i & 255);
        const int e = P.eid[t * 2 + slot];
        const float* wg = P.moe_w_gate + ((size_t)(layer * 32 + e) * D) * 256 + f;
        const float* wu = P.moe_w_up + ((size_t)(layer * 32 + e) * D) * 256 + f;
        const float* r = P.out + (size_t)t * D;
        const float rs = P.rstd[t];
        float a = 0.f, u = 0.f;
        for (int k = 0; k < D; ++k) {
            const float h = r[k] * rs * g[k];
            a += h * wg[(size_t)k * 256];
            u += h * wu[(size_t)k * 256];
        }
        const float sg = a / (1.0f + expf(-a));
        P.hmid[i] = sg * u;
    }
}

DEV void ph_moe_out(const Params& P, int layer, int gtid, int gsz) {
    const long total = (long)T * D;
    for (long i = gtid; i < total; i += gsz) {
        const int t = (int)(i / D), c = (int)(i % D);
        float tot = 0.f;
        for (int slot = 0; slot < 2; ++slot) {
            const int e = P.eid[t * 2 + slot];
            const float* wd = P.moe_w_down + ((size_t)(layer * 32 + e) * 256) * D + c;
            const float* hm = P.hmid + ((size_t)t * 2 + slot) * 256;
            float acc = 0.f;
            for (int f = 0; f < 256; ++f) acc += hm[f] * wd[(size_t)f * D];
            tot += P.ew[t * 2 + slot] * acc;
        }
        P.out[i] += tot;
    }
}

DEV void ph_prep1(const Params& P, int gtid, int gsz) {
    const int n1 = NB * 8 * 8 * 64;
    for (int i = gtid; i < n1; i += gsz) {
        const int d = i & 63, n = (i >> 6) & 7, h = (i >> 9) & 7, b = i >> 12;
        const bf16* kp = P.proj + ((size_t)b * S + n * 256) * ODD_IN + 512 + h * 64 + d;
        float s = 0.f;
        for (int j = 0; j < 256; ++j) s += bf2f(kp[(size_t)j * ODD_IN]);
        P.kmean[i] = s * (1.0f / 256);
    }
    const int n2 = 2 * NB * NCMP * 2;
    for (int i = gtid; i < n2; i += gsz) {
        const int hkv = i & 1; int r = i >> 1; const int n = r % NCMP; r /= NCMP; const int b = r % NB; const int which = r / NB;
        const float* pos = P.od_cmp_pos + which * 32 * 64;
        const float* w = P.od_cmp_w + (size_t)which * 32 * 64 * 64;
        const bf16* xp = P.proj + ((size_t)b * S + n * 16) * ODD_IN + (which ? 2176 : 2048) + hkv * 64;
        float acc[64];
#pragma unroll
        for (int e = 0; e < 64; ++e) acc[e] = 0.f;
        for (int l = 0; l < 32; ++l)
            for (int d = 0; d < 64; ++d) {
                const float xv = bf2f(xp[(size_t)l * ODD_IN + d]) + pos[l * 64 + d];
                const float* wr = w + ((size_t)l * 64 + d) * 64;
#pragma unroll
                for (int e = 0; e < 64; ++e) acc[e] += xv * wr[e];
            }
        if (which == 0) {
            float ss = 0.f;
#pragma unroll
            for (int e = 0; e < 64; ++e) ss += acc[e] * acc[e];
            const float rs = rsqrtf(ss * (1.0f / 64) + EPS);
#pragma unroll
            for (int e = 0; e < 64; ++e) acc[e] *= rs * P.od_d_k_norm[e];
        }
        bf16* op = P.kvcmp + (((size_t)(which * NB + b) * NCMP + n) * 2 + hkv) * 64;
#pragma unroll
        for (int e = 0; e < 64; ++e) op[e] = f2bf(acc[e]);
    }
}

DEV int cmp_count(int s) { int c = s >= 31 ? (s - 31) / 16 + 1 : 0; return c > NCMP ? NCMP : c; }

DEV void ph_nsa_cmp(const Params& P, int gtid, int gsz) {
    const long total = (long)T * 8;
    for (long i = gtid; i < total; i += gsz) {
        const int hh = (int)(i / T), t = (int)(i % T);
        const int b = t / S, s = t % S, hkv = hh >> 2;
        float q[64], o[64];
        load64(P.proj + (size_t)t * ODD_IN + 1536 + hh * 64, q);
#pragma unroll
        for (int d = 0; d < 64; ++d) o[d] = 0.f;
        const float sl = slope_of(hh);
        float m = NEG, l = 0.f;
        const int cnt = cmp_count(s);
        const bf16* kc = P.kvcmp + (((size_t)(0 * NB + b) * NCMP) * 2 + hkv) * 64;
        const bf16* vc = P.kvcmp + (((size_t)(1 * NB + b) * NCMP) * 2 + hkv) * 64;
        for (int n = 0; n < cnt; ++n) {
            const float sc = dot64(q, kc + (size_t)n * 128) * 0.125f - sl * (float)(s - (n * 16 + 31));
            os_update(sc, vc + (size_t)n * 128, m, l, o);
        }
        const float inv = cnt > 0 ? 1.0f / l : 0.f;
        float* op = P.ocmp + ((size_t)t * 8 + hh) * 64;
#pragma unroll
        for (int d = 0; d < 64; ++d) op[d] = o[d] * inv;
        P.cml[((size_t)t * 8 + hh) * 2 + 0] = m;
        P.cml[((size_t)t * 8 + hh) * 2 + 1] = l;
    }
}

DEV void ph_nsa_select(const Params& P, int gtid, int gsz) {
    const long total = (long)T * 64;
    for (long i = gtid; i < total; i += gsz) {
        const int j = (int)(i & 31), hkv = (int)((i >> 5) & 1), t = (int)(i >> 6);
        const int b = t / S, s = t % S, cur = s >> 6;
        float score = NEG;
        if (j <= cur) {
            const int cnt = cmp_count(s);
            const bf16* kc = P.kvcmp + (((size_t)(0 * NB + b) * NCMP) * 2 + hkv) * 64;
            float p = 0.f;
            int n0 = 4 * j - 1; if (n0 < 0) n0 = 0;
            int n1 = 4 * j + 3; if (n1 > NCMP - 1) n1 = NCMP - 1;
            for (int g = 0; g < 4; ++g) {
                const int hh = hkv * 4 + g;
                float q[64];
                load64(P.proj + (size_t)t * ODD_IN + 1536 + hh * 64, q);
                const float sl = slope_of(hh);
                const float m = P.cml[((size_t)t * 8 + hh) * 2 + 0], l = P.cml[((size_t)t * 8 + hh) * 2 + 1];
                for (int n = n0; n <= n1; ++n)
                    if (n < cnt) {
                        const float sc = dot64(q, kc + (size_t)n * 128) * 0.125f - sl * (float)(s - (n * 16 + 31));
                        p += expf(sc - m) / l;
                    }
            }
            const bool forced = (j == 0) || (j == cur) || (j == cur - 1);
            score = p + (forced ? 1000.0f : 0.0f);
        }
        P.pslc[i] = score;
    }
}

DEV void ph_nsa_topk(const Params& P, int gtid, int gsz) {
    const int total = T * 2;
    for (int i = gtid; i < total; i += gsz) {
        const int t = i >> 1;
        const int s = t % S, cur = s >> 6;
        const float* sc = P.pslc + (size_t)i * 32;
        unsigned mask = 0;
        for (int j = 0; j <= cur; ++j) {
            const float sj = sc[j];
            int rank = 0;
            for (int k = 0; k < 32; ++k) { const float sk = sc[k]; rank += (sk > sj || (sk == sj && k < j)) ? 1 : 0; }
            if (rank < 16) mask |= 1u << j;
        }
        P.selmask[i] = mask;
    }
}

DEV void ph_attn1(const Params& P, int gtid, int gsz) {
    const long total = (long)T * 16;
    for (long i = gtid; i < total; i += gsz) {
        const int hh = (int)(i / T), t = (int)(i % T);
        const int b = t / S, s = t % S;
        const bf16* base = P.proj + (size_t)b * S * ODD_IN;
        float q[64], o[64];
#pragma unroll
        for (int d = 0; d < 64; ++d) o[d] = 0.f;
        if (hh < 8) {
            const int h = hh, own = s >> 8;
            load64(base + (size_t)s * ODD_IN + h * 64, q);
            const float sl = slope_of(h);
            float gt[8];
#pragma unroll
            for (int n = 0; n < 8; ++n) gt[n] = n < own ? dot64f(q, P.kmean + ((size_t)(b * 8 + h) * 8 + n) * 64) : NEG;
            unsigned sel = 0;
#pragma unroll
            for (int n = 0; n < 8; ++n) {
                int rank = 0;
#pragma unroll
                for (int k = 0; k < 8; ++k) rank += (gt[k] > gt[n] || (gt[k] == gt[n] && k < n)) ? 1 : 0;
                if (rank < 3 && n < own) sel |= 1u << n;
            }
            float m = NEG, l = 0.f;
            for (int n = 0; n < own; ++n) {
                if (!((sel >> n) & 1)) continue;
                for (int kk = 0; kk < 256; ++kk) {
                    const int kp = n * 256 + kk;
                    const bf16* kr = base + (size_t)kp * ODD_IN + 512 + h * 64;
                    const float sc = dot64(q, kr) * 0.125f - sl * (float)(s - kp);
                    os_update(sc, kr + 512, m, l, o);
                }
            }
            for (int kp = own * 256; kp <= s; ++kp) {
                const bf16* kr = base + (size_t)kp * ODD_IN + 512 + h * 64;
                const float sc = dot64(q, kr) * 0.125f - sl * (float)(s - kp);
                os_update(sc, kr + 512, m, l, o);
            }
            const float inv = 1.0f / l;
            bf16* op = P.o + (size_t)t * D + h * 64;
#pragma unroll
            for (int d = 0; d < 64; ++d) op[d] = f2bf(o[d] * inv);
        } else {
            const int h = hh - 8, hkv = h >> 2, cur = s >> 6;
            load64(base + (size_t)s * ODD_IN + 1536 + h * 64, q);
            const float sl = slope_of(h);
            const bf16* grow = base + (size_t)s * ODD_IN + 2816 + h * 3;
            const float g0 = 1.0f / (1.0f + expf(-bf2f(grow[0])));
            const float g1 = 1.0f / (1.0f + expf(-bf2f(grow[1])));
            const float g2 = 1.0f / (1.0f + expf(-bf2f(grow[2])));
            float acc[64];
            const float* oc = P.ocmp + ((size_t)t * 8 + h) * 64;
#pragma unroll
            for (int d = 0; d < 64; ++d) acc[d] = g0 * oc[d];
            const unsigned mask = P.selmask[t * 2 + hkv];
            float m = NEG, l = 0.f;
            for (int j = 0; j <= cur; ++j) {
                if (!((mask >> j) & 1)) continue;
                for (int kk = 0; kk < 64; ++kk) {
                    const int kp = j * 64 + kk;
                    if (kp > s) break;
                    const bf16* kr = base + (size_t)kp * ODD_IN + 2304 + hkv * 64;
                    const float sc = dot64(q, kr) * 0.125f - sl * (float)(s - kp);
                    os_update(sc, kr + 128, m, l, o);
                }
            }
            {
                const float f = g1 / l;
#pragma unroll
                for (int d = 0; d < 64; ++d) { acc[d] += f * o[d]; o[d] = 0.f; }
            }
            m = NEG; l = 0.f;
            const int s0 = s - 511 < 0 ? 0 : s - 511;
            for (int kp = s0; kp <= s; ++kp) {
                const bf16* kr = base + (size_t)kp * ODD_IN + 2560 + hkv * 64;
                const float sc = dot64(q, kr) * 0.125f - sl * (float)(s - kp);
                os_update(sc, kr + 128, m, l, o);
            }
            {
                const float f = g2 / l;
#pragma unroll
                for (int d = 0; d < 64; ++d) acc[d] += f * o[d];
            }
            bf16* op = P.o + (size_t)t * D + 512 + h * 64;
#pragma unroll
            for (int d = 0; d < 64; ++d) op[d] = f2bf(acc[d]);
        }
    }
}

constexpr int NPHASE = 20;
DEV void run_phase(const Params& P, int ph, int gtid, int gsz) {
    switch (ph) {
        case 0: ph_rstd(P.x, P.rstd, gtid, gsz); break;
        case 1: ph_gemm_in(P.x, P.rstd, P.ev_norm, P.ev_w_in, EVEN_IN, P.proj, gtid, gsz); break;
        case 2: ph_headnorm0(P, gtid, gsz); break;
        case 3: ph_attn0(P, gtid, gsz); break;
        case 4: ph_gemm_out(P.o, P.ev_w_out, P.x, P.out, gtid, gsz); break;
        case 5: ph_moe_route(P, 0, gtid, gsz); break;
        case 6: ph_moe_hidden(P, 0, gtid, gsz); break;
        case 7: ph_moe_out(P, 0, gtid, gsz); break;
        case 8: ph_rstd(P.out, P.rstd, gtid, gsz); break;
        case 9: ph_gemm_in(P.out, P.rstd, P.od_norm, P.od_w_in, ODD_IN, P.proj, gtid, gsz); break;
        case 10: ph_headnorm1(P, gtid, gsz); break;
        case 11: ph_prep1(P, gtid, gsz); break;
        case 12: ph_nsa_cmp(P, gtid, gsz); break;
        case 13: ph_nsa_select(P, gtid, gsz); break;
        case 14: ph_nsa_topk(P, gtid, gsz); break;
        case 15: ph_attn1(P, gtid, gsz); break;
        case 16: ph_gemm_out(P.o, P.od_w_out, P.out, P.out, gtid, gsz); break;
        case 17: ph_moe_route(P, 1, gtid, gsz); break;
        case 18: ph_moe_hidden(P, 1, gtid, gsz); break;
        case 19: ph_moe_out(P, 1, gtid, gsz); break;
    }
}

static inline size_t al256(size_t x) { return (x + 255) & ~(size_t)255; }
static void carve(Params& p, void* d_ws) {
    char* w = (char*)d_ws; size_t off = 0;
    p.proj = (bf16*)(w + off); off = al256(off + (size_t)T * ODD_IN * 2);
    p.o = (bf16*)(w + off); off = al256(off + (size_t)T * D * 2);
    p.rstd = (float*)(w + off); off = al256(off + (size_t)T * 4);
    p.eid = (int*)(w + off); off = al256(off + (size_t)T * 2 * 4);
    p.ew = (float*)(w + off); off = al256(off + (size_t)T * 2 * 4);
    p.hmid = (float*)(w + off); off = al256(off + (size_t)T * 512 * 4);
    p.kmean = (float*)(w + off); off = al256(off + (size_t)NB * 8 * 8 * 64 * 4);
    p.kvcmp = (bf16*)(w + off); off = al256(off + (size_t)2 * NB * NCMP * 2 * 64 * 2);
    p.ocmp = (float*)(w + off); off = al256(off + (size_t)T * 8 * 64 * 4);
    p.cml = (float*)(w + off); off = al256(off + (size_t)T * 8 * 2 * 4);
    p.pslc = (float*)(w + off); off = al256(off + (size_t)T * 64 * 4);
    p.selmask = (unsigned*)(w + off); off = al256(off + (size_t)T * 2 * 4);
}

#ifndef CPU_EMU
__global__ void __launch_bounds__(256) k_phase(Params P, int ph) {
    run_phase(P, ph, blockIdx.x * blockDim.x + threadIdx.x, gridDim.x * blockDim.x);
}

extern "C" void kernel_launch(void* const* d_in, const int* in_sizes, int n_in, void* d_out, int out_size, void* d_ws, size_t ws_size,
                              hipStream_t stream) {
    Params p{};
    const float** f = (const float**)&p;
    for (int i = 0; i < 24; ++i) f[i] = (const float*)d_in[i];
    p.out = (float*)d_out;
    carve(p, d_ws);
    for (int ph = 0; ph < NPHASE; ++ph) hipLaunchKernelGGL(k_phase, dim3(2048), dim3(256), 0, stream, p, ph);
}
#endif
```

```cpp
#ifndef CPU_EMU
#include <hip/hip_runtime.h>
#include <hip/hip_cooperative_groups.h>
#include <cstdio>
namespace cg = cooperative_groups;
#define DEV __device__ __forceinline__
#else
#include <cmath>
#include <cstring>
#include <cstdio>
#include <cstdlib>
#define DEV static inline
static inline float rsqrtf(float x) { return 1.0f / sqrtf(x); }
static inline float exp2f_(float x) { return exp2f(x); }
#endif

#ifndef NB
#define NB 8
#endif
typedef unsigned short bf16;
constexpr int S = 2048, D = 1024, T = NB * S, HD = 64;
constexpr int EVEN_IN = 2304, ODD_IN = 2840;
constexpr int NCMP = 127, NSLC = 32;
constexpr float NEG = -1e30f;
constexpr float EPS = 1e-6f;

DEV float u2f(unsigned u) { float f; __builtin_memcpy(&f, &u, 4); return f; }
DEV unsigned f2u(float f) { unsigned u; __builtin_memcpy(&u, &f, 4); return u; }
DEV float bf2f(bf16 h) { return u2f(((unsigned)h) << 16); }
DEV bf16 f2bf(float f) { unsigned u = f2u(f); u += 0x7fffu + ((u >> 16) & 1u); return (bf16)(u >> 16); }

struct Params {
    const float *x, *ev_norm, *ev_w_in, *ev_q_norm, *ev_k_norm, *ev_sink, *ev_w_out;
    const float *od_norm, *od_w_in, *od_c_q_norm, *od_c_k_norm, *od_d_q_norm, *od_d_k_norm, *od_cmp_pos, *od_cmp_w, *od_w_out;
    const float *moe_norm, *moe_w_grp, *moe_b_grp, *moe_w_exp, *moe_b_exp, *moe_w_gate, *moe_w_up, *moe_w_down;
    float* out;
    bf16* proj;
    bf16* o;
    float* rstd;
    int* eid;
    float* ew;
    float* hmid;
    float* kmean;
    bf16* kvcmp;
    float* ocmp;
    float* cml;
    float* pslc;
    unsigned* selmask;
};

DEV void load64(const bf16* p, float (&q)[64]) {
#pragma unroll
    for (int d = 0; d < 64; ++d) q[d] = bf2f(p[d]);
}
DEV float dot64(const float (&q)[64], const bf16* k) {
    float s = 0.f;
#pragma unroll
    for (int d = 0; d < 64; ++d) s += q[d] * bf2f(k[d]);
    return s;
}
DEV float dot64f(const float (&q)[64], const float* k) {
    float s = 0.f;
#pragma unroll
    for (int d = 0; d < 64; ++d) s += q[d] * k[d];
    return s;
}
DEV void os_update(float sc, const bf16* v, float& m, float& l, float (&o)[64]) {
    if (sc > m) {
        float f = expf(m - sc);
        l *= f;
#pragma unroll
        for (int d = 0; d < 64; ++d) o[d] *= f;
        m = sc;
    }
    float p = expf(sc - m);
    l += p;
#pragma unroll
    for (int d = 0; d < 64; ++d) o[d] += p * bf2f(v[d]);
}
DEV float slope_of(int hh) { return exp2f(-(float)(hh + 1)); }

DEV void ph_rstd(const float* src, float* rstd, int gtid, int gsz) {
    for (int t = gtid; t < T; t += gsz) {
        const float* r = src + (size_t)t * D;
        float s = 0.f;
        for (int i = 0; i < D; ++i) s += r[i] * r[i];
        rstd[t] = rsqrtf(s * (1.0f / D) + EPS);
    }
}

DEV void ph_gemm_in(const float* src, const float* rstd, const float* g, const float* W, int N, bf16* proj, int gtid, int gsz) {
    const long total = (long)T * N;
    for (long i = gtid; i < total; i += gsz) {
        const int t = (int)(i / N), n = (int)(i % N);
        const float* a = src + (size_t)t * D;
        float acc = 0.f;
        for (int k = 0; k < D; ++k) acc += a[k] * g[k] * W[(size_t)k * N + n];
        proj[(size_t)t * ODD_IN + n] = f2bf(acc * rstd[t]);
    }
}

DEV void headnorm_inplace(bf16* p, const float* g) {
    float v[64];
    load64(p, v);
    float s = 0.f;
#pragma unroll
    for (int d = 0; d < 64; ++d) s += v[d] * v[d];
    const float r = rsqrtf(s * (1.0f / 64) + EPS);
#pragma unroll
    for (int d = 0; d < 64; ++d) p[d] = f2bf(v[d] * r * g[d]);
}

DEV void ph_headnorm0(const Params& P, int gtid, int gsz) {
    const long total = (long)T * 10;
    for (long i = gtid; i < total; i += gsz) {
        const int t = (int)(i / 10), h = (int)(i % 10);
        bf16* row = P.proj + (size_t)t * ODD_IN;
        if (h < 8) headnorm_inplace(row + h * 64, P.ev_q_norm);
        else headnorm_inplace(row + 512 + (h - 8) * 64, P.ev_k_norm);
    }
}

DEV void ph_headnorm1(const Params& P, int gtid, int gsz) {
    const long total = (long)T * 28;
    for (long i = gtid; i < total; i += gsz) {
        const int t = (int)(i / 28), h = (int)(i % 28);
        bf16* row = P.proj + (size_t)t * ODD_IN;
        if (h < 8) headnorm_inplace(row + h * 64, P.od_c_q_norm);
        else if (h < 16) headnorm_inplace(row + 512 + (h - 8) * 64, P.od_c_k_norm);
        else if (h < 24) headnorm_inplace(row + 1536 + (h - 16) * 64, P.od_d_q_norm);
        else if (h < 26) headnorm_inplace(row + 2304 + (h - 24) * 64, P.od_d_k_norm + 64);
        else headnorm_inplace(row + 2560 + (h - 26) * 64, P.od_d_k_norm + 128);
    }
}

DEV void ph_attn0(const Params& P, int gtid, int gsz) {
    const long total = (long)T * 16;
    for (long i = gtid; i < total; i += gsz) {
        const int hh = (int)(i / T), t = (int)(i % T);
        const int b = t / S, s = t % S;
        const bf16* base = P.proj + (size_t)b * S * ODD_IN;
        float q[64], o[64];
#pragma unroll
        for (int d = 0; d < 64; ++d) o[d] = 0.f;
        if (hh < 8) {
            const int kvh = hh >> 2;
            load64(base + (size_t)s * ODD_IN + hh * 64, q);
            const float sl = slope_of(hh);
            float m = NEG, l = 0.f;
            const int s0 = s - 127 < 0 ? 0 : s - 127;
            for (int sp = s0; sp <= s; ++sp) {
                const bf16* kr = base + (size_t)sp * ODD_IN + 512 + kvh * 64;
                const float sc = dot64(q, kr) * 0.125f - sl * (float)(s - sp);
                os_update(sc, kr + 128, m, l, o);
            }
            const float sk = P.ev_sink[hh];
            const float mx = m > sk ? m : sk;
            const float scale = expf(m - mx);
            const float den = l * scale + expf(sk - mx);
            const float f = scale / den;
            bf16* op = P.o + (size_t)t * D + hh * 64;
#pragma unroll
            for (int d = 0; d < 64; ++d) op[d] = f2bf(o[d] * f);
        } else {
            const int h = hh - 8;
            load64(base + (size_t)s * ODD_IN + 768 + h * 64, q);
            float acc = 0.f;
            for (int sp = s - 1; sp >= 0; --sp) {
                const bf16* kr = base + (size_t)sp * ODD_IN + 1280 + h * 64;
                const float z = dot64(q, kr) * 0.125f;
                const float ls = (z < 0.f ? z : 0.f) - log1pf(expf(-fabsf(z)));
                const float a = expf(ls + acc);
                const bf16* vr = kr + 512;
#pragma unroll
                for (int d = 0; d < 64; ++d) o[d] += a * bf2f(vr[d]);
                acc += ls - z;
                if (acc < -110.f) break;
            }
            bf16* op = P.o + (size_t)t * D + 512 + h * 64;
#pragma unroll
            for (int d = 0; d < 64; ++d) op[d] = f2bf(o[d]);
        }
    }
}

DEV void ph_gemm_out(const bf16* o, const float* W, const float* resid, float* out, int gtid, int gsz) {
    const long total = (long)T * D;
    for (long i = gtid; i < total; i += gsz) {
        const int t = (int)(i / D), c = (int)(i % D);
        const bf16* a = o + (size_t)t * D;
        float acc = 0.f;
        for (int k = 0; k < D; ++k) acc += bf2f(a[k]) * W[(size_t)k * D + c];
        out[i] = resid[i] + acc;
    }
}

DEV void ph_moe_route(const Params& P, int layer, int gtid, int gsz) {
    const float* g = P.moe_norm + layer * D;
    const float* wgrp = P.moe_w_grp + (size_t)layer * D * 4;
    const float* wexp = P.moe_w_exp + (size_t)layer * D * 32;
    const float* bgrp = P.moe_b_grp + layer * 4;
    const float* bexp = P.moe_b_exp + layer * 32;
    for (int t = gtid; t < T; t += gsz) {
        const float* r = P.out + (size_t)t * D;
        float ss = 0.f;
        for (int k = 0; k < D; ++k) ss += r[k] * r[k];
        const float rs = rsqrtf(ss * (1.0f / D) + EPS);
        P.rstd[t] = rs;
        float lg[4], le[32];
#pragma unroll
        for (int j = 0; j < 4; ++j) lg[j] = 0.f;
#pragma unroll
        for (int j = 0; j < 32; ++j) le[j] = 0.f;
        for (int k = 0; k < D; ++k) {
            const float h = r[k] * rs * g[k];
#pragma unroll
            for (int j = 0; j < 4; ++j) lg[j] += h * wgrp[k * 4 + j];
#pragma unroll
            for (int j = 0; j < 32; ++j) le[j] += h * wexp[k * 32 + j];
        }
#pragma unroll
        for (int j = 0; j < 4; ++j) lg[j] += bgrp[j];
#pragma unroll
        for (int j = 0; j < 32; ++j) le[j] += bexp[j];
        int gs = 0; float gm = lg[0];
#pragma unroll
        for (int j = 1; j < 4; ++j) if (lg[j] > gm) { gm = lg[j]; gs = j; }
        float gz = 0.f;
#pragma unroll
        for (int j = 0; j < 4; ++j) gz += expf(lg[j] - gm);
        const float pg = 1.0f / gz;
        float w[8];
#pragma unroll
        for (int j = 0; j < 8; ++j) w[j] = gs == 0 ? le[j] : gs == 1 ? le[8 + j] : gs == 2 ? le[16 + j] : le[24 + j];
        int i1 = 0; float m1 = w[0];
#pragma unroll
        for (int j = 1; j < 8; ++j) if (w[j] > m1) { m1 = w[j]; i1 = j; }
        int i2 = -1; float m2 = -3e38f;
#pragma unroll
        for (int j = 0; j < 8; ++j) if (j != i1 && w[j] > m2) { m2 = w[j]; i2 = j; }
        const float e2 = expf(m2 - m1);
        const float w1 = pg / (1.0f + e2), w2 = pg * e2 / (1.0f + e2);
        P.eid[t * 2 + 0] = gs * 8 + i1; P.eid[t * 2 + 1] = gs * 8 + i2;
        P.ew[t * 2 + 0] = w1; P.ew[t * 2 + 1] = w2;
    }
}

DEV void ph_moe_hidden(const Params& P, int layer, int gtid, int gsz) {
    const float* g = P.moe_norm + layer * D;
    const long total = (long)T * 512;
    for (long i = gtid; i < total; i += gsz) {
        const int t = (int)(i >> 9), slot = (int)((i >> 8) & 1), f = (int)(i & 255);
        const int e = P.eid[t * 2 + slot];
        const float* wg = P.moe_w_gate + ((size_t)(layer * 32 + e) * D) * 256 + f;
        const float* wu = P.moe_w_up + ((size_t)(layer * 32 + e) * D) * 256 + f;
        const float* r = P.out + (size_t)t * D;
        const float rs = P.rstd[t];
        float a = 0.f, u = 0.f;
        for (int k = 0; k < D; ++k) {
            const float h = r[k] * rs * g[k];
            a += h * wg[(size_t)k * 256];
            u += h * wu[(size_t)k * 256];
        }
        const float sg = a / (1.0f + expf(-a));
        P.hmid[i] = sg * u;
    }
}

DEV void ph_moe_out(const Params& P, int layer, int gtid, int gsz) {
    const long total = (long)T * D;
    for (long i = gtid; i < total; i += gsz) {
        const int t = (int)(i / D), c = (int)(i % D);
        float tot = 0.f;
        for (int slot = 0; slot < 2; ++slot) {
            const int e = P.eid[t * 2 + slot];
            const float* wd = P.moe_w_down + ((size_t)(layer * 32 + e) * 256) * D + c;
            const float* hm = P.hmid + ((size_t)t * 2 + slot) * 256;
            float acc = 0.f;
            for (int f = 0; f < 256; ++f) acc += hm[f] * wd[(size_t)f * D];
            tot += P.ew[t * 2 + slot] * acc;
        }
        P.out[i] += tot;
    }
}

DEV void ph_prep1(const Params& P, int gtid, int gsz) {
    const int n1 = NB * 8 * 8 * 64;
    for (int i = gtid; i < n1; i += gsz) {
        const int d = i & 63, n = (i >> 6) & 7, h = (i >> 9) & 7, b = i >> 12;
        const bf16* kp = P.proj + ((size_t)b * S + n * 256) * ODD_IN + 512 + h * 64 + d;
        float s = 0.f;
        for (int j = 0; j < 256; ++j) s += bf2f(kp[(size_t)j * ODD_IN]);
        P.kmean[i] = s * (1.0f / 256);
    }
    const int n2 = 2 * NB * NCMP * 2;
    for (int i = gtid; i < n2; i += gsz) {
        const int hkv = i & 1; int r = i >> 1; const int n = r % NCMP; r /= NCMP; const int b = r % NB; const int which = r / NB;
        const float* pos = P.od_cmp_pos + which * 32 * 64;
        const float* w = P.od_cmp_w + (size_t)which * 32 * 64 * 64;
        const bf16* xp = P.proj + ((size_t)b * S + n * 16) * ODD_IN + (which ? 2176 : 2048) + hkv * 64;
        float acc[64];
#pragma unroll
        for (int e = 0; e < 64; ++e) acc[e] = 0.f;
        for (int l = 0; l < 32; ++l)
            for (int d = 0; d < 64; ++d) {
                const float xv = bf2f(xp[(size_t)l * ODD_IN + d]) + pos[l * 64 + d];
                const float* wr = w + ((size_t)l * 64 + d) * 64;
#pragma unroll
                for (int e = 0; e < 64; ++e) acc[e] += xv * wr[e];
            }
        if (which == 0) {
            float ss = 0.f;
#pragma unroll
            for (int e = 0; e < 64; ++e) ss += acc[e] * acc[e];
            const float rs = rsqrtf(ss * (1.0f / 64) + EPS);
#pragma unroll
            for (int e = 0; e < 64; ++e) acc[e] *= rs * P.od_d_k_norm[e];
        }
        bf16* op = P.kvcmp + (((size_t)(which * NB + b) * NCMP + n) * 2 + hkv) * 64;
#pragma unroll
        for (int e = 0; e < 64; ++e) op[e] = f2bf(acc[e]);
    }
}

DEV int cmp_count(int s) { int c = s >= 31 ? (s - 31) / 16 + 1 : 0; return c > NCMP ? NCMP : c; }

DEV void ph_nsa_cmp(const Params& P, int gtid, int gsz) {
    const long total = (long)T * 8;
    for (long i = gtid; i < total; i += gsz) {
        const int hh = (int)(i / T), t = (int)(i % T);
        const int b = t / S, s = t % S, hkv = hh >> 2;
        float q[64], o[64];
        load64(P.proj + (size_t)t * ODD_IN + 1536 + hh * 64, q);
#pragma unroll
        for (int d = 0; d < 64; ++d) o[d] = 0.f;
        const float sl = slope_of(hh);
        float m = NEG, l = 0.f;
        const int cnt = cmp_count(s);
        const bf16* kc = P.kvcmp + (((size_t)(0 * NB + b) * NCMP) * 2 + hkv) * 64;
        const bf16* vc = P.kvcmp + (((size_t)(1 * NB + b) * NCMP) * 2 + hkv) * 64;
        for (int n = 0; n < cnt; ++n) {
            const float sc = dot64(q, kc + (size_t)n * 128) * 0.125f - sl * (float)(s - (n * 16 + 31));
            os_update(sc, vc + (size_t)n * 128, m, l, o);
        }
        const float inv = cnt > 0 ? 1.0f / l : 0.f;
        float* op = P.ocmp + ((size_t)t * 8 + hh) * 64;
#pragma unroll
        for (int d = 0; d < 64; ++d) op[d] = o[d] * inv;
        P.cml[((size_t)t * 8 + hh) * 2 + 0] = m;
        P.cml[((size_t)t * 8 + hh) * 2 + 1] = l;
    }
}

DEV void ph_nsa_select(const Params& P, int gtid, int gsz) {
    const long total = (long)T * 64;
    for (long i = gtid; i < total; i += gsz) {
        const int j = (int)(i & 31), hkv = (int)((i >> 5) & 1), t = (int)(i >> 6);
        const int b = t / S, s = t % S, cur = s >> 6;
        float score = NEG;
        if (j <= cur) {
            const int cnt = cmp_count(s);
            const bf16* kc = P.kvcmp + (((size_t)(0 * NB + b) * NCMP) * 2 + hkv) * 64;
            float p = 0.f;
            int n0 = 4 * j - 1; if (n0 < 0) n0 = 0;
            int n1 = 4 * j + 3; if (n1 > NCMP - 1) n1 = NCMP - 1;
            for (int g = 0; g < 4; ++g) {
                const int hh = hkv * 4 + g;
                float q[64];
                load64(P.proj + (size_t)t * ODD_IN + 1536 + hh * 64, q);
                const float sl = slope_of(hh);
                const float m = P.cml[((size_t)t * 8 + hh) * 2 + 0], l = P.cml[((size_t)t * 8 + hh) * 2 + 1];
                for (int n = n0; n <= n1; ++n)
                    if (n < cnt) {
                        const float sc = dot64(q, kc + (size_t)n * 128) * 0.125f - sl * (float)(s - (n * 16 + 31));
                        p += expf(sc - m) / l;
                    }
            }
            const bool forced = (j == 0) || (j == cur) || (j == cur - 1);
            score = p + (forced ? 1000.0f : 0.0f);
        }
        P.pslc[i] = score;
    }
}

DEV void ph_nsa_topk(const Params& P, int gtid, int gsz) {
    const int total = T * 2;
    for (int i = gtid; i < total; i += gsz) {
        const int t = i >> 1;
        const int s = t % S, cur = s >> 6;
        const float* sc = P.pslc + (size_t)i * 32;
        unsigned mask = 0;
        for (int j = 0; j <= cur; ++j) {
            const float sj = sc[j];
            int rank = 0;
            for (int k = 0; k < 32; ++k) { const float sk = sc[k]; rank += (sk > sj || (sk == sj && k < j)) ? 1 : 0; }
            if (rank < 16) mask |= 1u << j;
        }
        P.selmask[i] = mask;
    }
}

DEV void ph_attn1(const Params& P, int gtid, int gsz) {
    const long total = (long)T * 16;
    for (long i = gtid; i < total; i += gsz) {
        const int hh = (int)(i / T), t = (int)(i % T);
        const int b = t / S, s = t % S;
        const bf16* base = P.proj + (size_t)b * S * ODD_IN;
        float q[64], o[64];
#pragma unroll
        for (int d = 0; d < 64; ++d) o[d] = 0.f;
        if (hh < 8) {
            const int h = hh, own = s >> 8;
            load64(base + (size_t)s * ODD_IN + h * 64, q);
            const float sl = slope_of(h);
            float gt[8];
#pragma unroll
            for (int n = 0; n < 8; ++n) gt[n] = n < own ? dot64f(q, P.kmean + ((size_t)(b * 8 + h) * 8 + n) * 64) : NEG;
            unsigned sel = 0;
#pragma unroll
            for (int n = 0; n < 8; ++n) {
                int rank = 0;
#pragma unroll
                for (int k = 0; k < 8; ++k) rank += (gt[k] > gt[n] || (gt[k] == gt[n] && k < n)) ? 1 : 0;
                if (rank < 3 && n < own) sel |= 1u << n;
            }
            float m = NEG, l = 0.f;
            for (int n = 0; n < own; ++n) {
                if (!((sel >> n) & 1)) continue;
                for (int kk = 0; kk < 256; ++kk) {
                    const int kp = n * 256 + kk;
                    const bf16* kr = base + (size_t)kp * ODD_IN + 512 + h * 64;
                    const float sc = dot64(q, kr) * 0.125f - sl * (float)(s - kp);
                    os_update(sc, kr + 512, m, l, o);
                }
            }
            for (int kp = own * 256; kp <= s; ++kp) {
                const bf16* kr = base + (size_t)kp * ODD_IN + 512 + h * 64;
                const float sc = dot64(q, kr) * 0.125f - sl * (float)(s - kp);
                os_update(sc, kr + 512, m, l, o);
            }
            const float inv = 1.0f / l;
            bf16* op = P.o + (size_t)t * D + h * 64;
#pragma unroll
            for (int d = 0; d < 64; ++d) op[d] = f2bf(o[d] * inv);
        } else {
            const int h = hh - 8, hkv = h >> 2, cur = s >> 6;
            load64(base + (size_t)s * ODD_IN + 1536 + h * 64, q);
            const float sl = slope_of(h);
            const bf16* grow = base + (size_t)s * ODD_IN + 2816 + h * 3;
            const float g0 = 1.0f / (1.0f + expf(-bf2f(grow[0])));
            const float g1 = 1.0f / (1.0f + expf(-bf2f(grow[1])));
            const float g2 = 1.0f / (1.0f + expf(-bf2f(grow[2])));
            float acc[64];
            const float* oc = P.ocmp + ((size_t)t * 8 + h) * 64;
#pragma unroll
            for (int d = 0; d < 64; ++d) acc[d] = g0 * oc[d];
            const unsigned mask = P.selmask[t * 2 + hkv];
            float m = NEG, l = 0.f;
            for (int j = 0; j <= cur; ++j) {
                if (!((mask >> j) & 1)) continue;
                for (int kk = 0; kk < 64; ++kk) {
                    const int kp = j * 64 + kk;
                    if (kp > s) break;
                    const bf16* kr = base + (size_t)kp * ODD_IN + 2304 + hkv * 64;
                    const float sc = dot64(q, kr) * 0.125f - sl * (float)(s - kp);
                    os_update(sc, kr + 128, m, l, o);
                }
            }
            {
                const float f = g1 / l;
#pragma unroll
                for (int d = 0; d < 64; ++d) { acc[d] += f * o[d]; o[d] = 0.f; }
            }
            m = NEG; l = 0.f;
            const int s0 = s - 511 < 0 ? 0 : s - 511;
            for (int kp = s0; kp <= s; ++kp) {
                const bf16* kr = base + (size_t)kp * ODD_IN + 2560 + hkv * 64;
                const float sc = dot64(q, kr) * 0.125f - sl * (float)(s - kp);
                os_update(sc, kr + 128, m, l, o);
            }
            {
                const float f = g2 / l;
#pragma unroll
                for (int d = 0; d < 64; ++d) acc[d] += f * o[d];
            }
            bf16* op = P.o + (size_t)t * D + 512 + h * 64;
#pragma unroll
            for (int d = 0; d < 64; ++d) op[d] = f2bf(acc[d]);
        }
    }
}

constexpr int NPHASE = 20;
DEV void run_phase(const Params& P, int ph, int gtid, int gsz) {
    switch (ph) {
        case 0: ph_rstd(P.x, P.rstd, gtid, gsz); break;
        case 1: ph_gemm_in(P.x, P.rstd, P.ev_norm, P.ev_w_in, EVEN_IN, P.proj, gtid, gsz); break;
        case 2: ph_headnorm0(P, gtid, gsz); break;
        case 3: ph_attn0(P, gtid, gsz); break;
        case 4: ph_gemm_out(P.o, P.ev_w_out, P.x, P.out, gtid, gsz); break;
        case 5: ph_moe_route(P, 0, gtid, gsz); break;
        case 6: ph_moe_hidden(P, 0, gtid, gsz); break;
        case 7: ph_moe_out(P, 0, gtid, gsz); break;
        case 8: ph_rstd(P.out, P.rstd, gtid, gsz); break;
        case 9: ph_gemm_in(P.out, P.rstd, P.od_norm, P.od_w_in, ODD_IN, P.proj, gtid, gsz); break;
        case 10: ph_headnorm1(P, gtid, gsz); break;
        case 11: ph_prep1(P, gtid, gsz); break;
        case 12: ph_nsa_cmp(P, gtid, gsz); break;
        case 13: ph_nsa_select(P, gtid, gsz); break;
        case 14: ph_nsa_topk(P, gtid, gsz); break;
        case 15: ph_attn1(P, gtid, gsz); break;
        case 16: ph_gemm_out(P.o, P.od_w_out, P.out, P.out, gtid, gsz); break;
        case 17: ph_moe_route(P, 1, gtid, gsz); break;
        case 18: ph_moe_hidden(P, 1, gtid, gsz); break;
        case 19: ph_moe_out(P, 1, gtid, gsz); break;
    }
}

static inline size_t al256(size_t x) { return (x + 255) & ~(size_t)255; }
static void carve(Params& p, void* d_ws) {
    char* w = (char*)d_ws; size_t off = 0;
    p.proj = (bf16*)(w + off); off = al256(off + (size_t)T * ODD_IN * 2);
    p.o = (bf16*)(w + off); off = al256(off + (size_t)T * D * 2);
    p.rstd = (float*)(w + off); off = al256(off + (size_t)T * 4);
    p.eid = (int*)(w + off); off = al256(off + (size_t)T * 2 * 4);
    p.ew = (float*)(w + off); off = al256(off + (size_t)T * 2 * 4);
    p.hmid = (float*)(w + off); off = al256(off + (size_t)T * 512 * 4);
    p.kmean = (float*)(w + off); off = al256(off + (size_t)NB * 8 * 8 * 64 * 4);
    p.kvcmp = (bf16*)(w + off); off = al256(off + (size_t)2 * NB * NCMP * 2 * 64 * 2);
    p.ocmp = (float*)(w + off); off = al256(off + (size_t)T * 8 * 64 * 4);
    p.cml = (float*)(w + off); off = al256(off + (size_t)T * 8 * 2 * 4);
    p.pslc = (float*)(w + off); off = al256(off + (size_t)T * 64 * 4);
    p.selmask = (unsigned*)(w + off); off = al256(off + (size_t)T * 2 * 4);
}

#ifndef CPU_EMU
__global__ void __launch_bounds__(256) k_mega(Params P) {
    cg::grid_group grid = cg::this_grid();
    const int gtid = blockIdx.x * blockDim.x + threadIdx.x, gsz = gridDim.x * blockDim.x;
    for (int ph = 0; ph < NPHASE; ++ph) {
        run_phase(P, ph, gtid, gsz);
        grid.sync();
    }
}

extern "C" void kernel_launch(void* const* d_in, const int* in_sizes, int n_in, void* d_out, int out_size, void* d_ws, size_t ws_size,
                              hipStream_t stream) {
    Params p{};
    const float** f = (const float**)&p;
    for (int i = 0; i < 24; ++i) f[i] = (const float*)d_in[i];
    p.out = (float*)d_out;
    carve(p, d_ws);
    static int grid_blocks = 0;
    if (!grid_blocks) {
        int dev = 0, cus = 0, per_cu = 0;
        hipGetDevice(&dev);
        hipDeviceGetAttribute(&cus, hipDeviceAttributeMultiprocessorCount, dev);
        hipOccupancyMaxActiveBlocksPerMultiprocessor(&per_cu, k_mega, 256, 0);
        if (per_cu > 2) per_cu = 2;
        grid_blocks = cus * per_cu;
    }
    void* args[] = {&p};
    hipError_t e = hipLaunchCooperativeKernel((void*)k_mega, dim3(grid_blocks), dim3(256), args, 0, stream);
    if (e != hipSuccess) fprintf(stderr, "cooperative launch failed: %s (grid %d)\n", hipGetErrorString(e), grid_blocks);
}
#endif
```

```cpp
#include <hip/hip_runtime.h>
#include <cstdio>
#include <cstdint>
#define DEV __device__ __forceinline__

#ifndef NB
#define NB 8
#endif
typedef unsigned short bf16;
constexpr int S = 2048, D = 1024, T = NB * S, HD = 64;
constexpr int EVEN_IN = 2304, ODD_IN = 2840, LDP = 3072;
constexpr int NCMP = 127, NSLC = 32;
constexpr float NEG = -1e30f;
constexpr float EPS = 1e-6f;
constexpr int RMAX = 2 * T + 32 * 256;

DEV float u2f(unsigned u) { return __builtin_bit_cast(float, u); }
DEV unsigned f2u(float f) { return __builtin_bit_cast(unsigned, f); }
DEV float bf2f(bf16 h) { return u2f(((unsigned)h) << 16); }
DEV bf16 f2bf(float f) { unsigned u = f2u(f); u += 0x7fffu + ((u >> 16) & 1u); return (bf16)(u >> 16); }

struct Params {
    const float *x, *ev_norm, *ev_w_in, *ev_q_norm, *ev_k_norm, *ev_sink, *ev_w_out;
    const float *od_norm, *od_w_in, *od_c_q_norm, *od_c_k_norm, *od_d_q_norm, *od_d_k_norm, *od_cmp_pos, *od_cmp_w, *od_w_out;
    const float *moe_norm, *moe_w_grp, *moe_b_grp, *moe_w_exp, *moe_b_exp, *moe_w_gate, *moe_w_up, *moe_w_down;
    float* out;
    unsigned* ctl;
    bf16 *win0t, *wout0t, *win1t, *wout1t, *wgut, *wdt;
    bf16* proj;
    bf16* xn;
    bf16* o;
    bf16* ha;
    bf16* hid;
    float* rstd;
    int* eid;
    float* ew;
    float* hmid;
    float* kmean;
    bf16* kvcmp;
    float* ocmp;
    float* cml;
    float* pslc;
    unsigned* selmask;
    int* rowtok;
    int* pos;
};

DEV void load64(const bf16* p, float (&q)[64]) {
#pragma unroll
    for (int d = 0; d < 64; ++d) q[d] = bf2f(p[d]);
}
DEV float dot64(const float (&q)[64], const bf16* k) {
    float s = 0.f;
#pragma unroll
    for (int d = 0; d < 64; ++d) s += q[d] * bf2f(k[d]);
    return s;
}
DEV float dot64f(const float (&q)[64], const float* k) {
    float s = 0.f;
#pragma unroll
    for (int d = 0; d < 64; ++d) s += q[d] * k[d];
    return s;
}
DEV void os_update(float sc, const bf16* v, float& m, float& l, float (&o)[64]) {
    if (sc > m) {
        float f = expf(m - sc);
        l *= f;
#pragma unroll
        for (int d = 0; d < 64; ++d) o[d] *= f;
        m = sc;
    }
    float p = expf(sc - m);
    l += p;
#pragma unroll
    for (int d = 0; d < 64; ++d) o[d] += p * bf2f(v[d]);
}
DEV float slope_of(int hh) { return exp2f(-(float)(hh + 1)); }

DEV void ph_rstd(const float* src, float* rstd, int gtid, int gsz) {
    for (int t = gtid; t < T; t += gsz) {
        const float* r = src + (size_t)t * D;
        float s = 0.f;
        for (int i = 0; i < D; ++i) s += r[i] * r[i];
        rstd[t] = rsqrtf(s * (1.0f / D) + EPS);
    }
}

DEV void ph_gemm_in(const float* src, const float* rstd, const float* g, const float* W, int N, bf16* proj, int gtid, int gsz) {
    const long total = (long)T * N;
    for (long i = gtid; i < total; i += gsz) {
        const int t = (int)(i / N), n = (int)(i % N);
        const float* a = src + (size_t)t * D;
        float acc = 0.f;
        for (int k = 0; k < D; ++k) acc += a[k] * g[k] * W[(size_t)k * N + n];
        proj[(size_t)t * LDP + n] = f2bf(acc * rstd[t]);
    }
}

DEV void headnorm_inplace(bf16* p, const float* g) {
    float v[64];
    load64(p, v);
    float s = 0.f;
#pragma unroll
    for (int d = 0; d < 64; ++d) s += v[d] * v[d];
    const float r = rsqrtf(s * (1.0f / 64) + EPS);
#pragma unroll
    for (int d = 0; d < 64; ++d) p[d] = f2bf(v[d] * r * g[d]);
}

DEV void ph_headnorm0(const Params& P, int gtid, int gsz) {
    const long total = (long)T * 10;
    for (long i = gtid; i < total; i += gsz) {
        const int t = (int)(i / 10), h = (int)(i % 10);
        bf16* row = P.proj + (size_t)t * LDP;
        if (h < 8) headnorm_inplace(row + h * 64, P.ev_q_norm);
        else headnorm_inplace(row + 512 + (h - 8) * 64, P.ev_k_norm);
    }
}

DEV void ph_headnorm1(const Params& P, int gtid, int gsz) {
    const long total = (long)T * 28;
    for (long i = gtid; i < total; i += gsz) {
        const int t = (int)(i / 28), h = (int)(i % 28);
        bf16* row = P.proj + (size_t)t * LDP;
        if (h < 8) headnorm_inplace(row + h * 64, P.od_c_q_norm);
        else if (h < 16) headnorm_inplace(row + 512 + (h - 8) * 64, P.od_c_k_norm);
        else if (h < 24) headnorm_inplace(row + 1536 + (h - 16) * 64, P.od_d_q_norm);
        else if (h < 26) headnorm_inplace(row + 2304 + (h - 24) * 64, P.od_d_k_norm + 64);
        else headnorm_inplace(row + 2560 + (h - 26) * 64, P.od_d_k_norm + 128);
    }
}

DEV void ph_attn0(const Params& P, int gtid, int gsz) {
    const long total = (long)T * 16;
    for (long i = gtid; i < total; i += gsz) {
        const int hh = (int)(i / T), t = (int)(i % T);
        const int b = t / S, s = t % S;
        const bf16* base = P.proj + (size_t)b * S * LDP;
        float q[64], o[64];
#pragma unroll
        for (int d = 0; d < 64; ++d) o[d] = 0.f;
        if (hh < 8) {
            const int kvh = hh >> 2;
            load64(base + (size_t)s * LDP + hh * 64, q);
            const float sl = slope_of(hh);
            float m = NEG, l = 0.f;
            const int s0 = s - 127 < 0 ? 0 : s - 127;
            for (int sp = s0; sp <= s; ++sp) {
                const bf16* kr = base + (size_t)sp * LDP + 512 + kvh * 64;
                const float sc = dot64(q, kr) * 0.125f - sl * (float)(s - sp);
                os_update(sc, kr + 128, m, l, o);
            }
            const float sk = P.ev_sink[hh];
            const float mx = m > sk ? m : sk;
            const float scale = expf(m - mx);
            const float den = l * scale + expf(sk - mx);
            const float f = scale / den;
            bf16* op = P.o + (size_t)t * D + hh * 64;
#pragma unroll
            for (int d = 0; d < 64; ++d) op[d] = f2bf(o[d] * f);
        } else {
            const int h = hh - 8;
            load64(base + (size_t)s * LDP + 768 + h * 64, q);
            float acc = 0.f;
            for (int sp = s - 1; sp >= 0; --sp) {
                const bf16* kr = base + (size_t)sp * LDP + 1280 + h * 64;
                const float z = dot64(q, kr) * 0.125f;
                const float ls = (z < 0.f ? z : 0.f) - log1pf(expf(-fabsf(z)));
                const float a = expf(ls + acc);
                const bf16* vr = kr + 512;
#pragma unroll
                for (int d = 0; d < 64; ++d) o[d] += a * bf2f(vr[d]);
                acc += ls - z;
                if (acc < -110.f) break;
            }
            bf16* op = P.o + (size_t)t * D + 512 + h * 64;
#pragma unroll
            for (int d = 0; d < 64; ++d) op[d] = f2bf(o[d]);
        }
    }
}

DEV void ph_gemm_out(const bf16* o, const float* W, const float* resid, float* out, int gtid, int gsz) {
    const long total = (long)T * D;
    for (long i = gtid; i < total; i += gsz) {
        const int t = (int)(i / D), c = (int)(i % D);
        const bf16* a = o + (size_t)t * D;
        float acc = 0.f;
        for (int k = 0; k < D; ++k) acc += bf2f(a[k]) * W[(size_t)k * D + c];
        out[i] = resid[i] + acc;
    }
}

DEV void ph_moe_route(const Params& P, int layer, int gtid, int gsz) {
    const float* g = P.moe_norm + layer * D;
    const float* wgrp = P.moe_w_grp + (size_t)layer * D * 4;
    const float* wexp = P.moe_w_exp + (size_t)layer * D * 32;
    const float* bgrp = P.moe_b_grp + layer * 4;
    const float* bexp = P.moe_b_exp + layer * 32;
    for (int t = gtid; t < T; t += gsz) {
        const float* r = P.out + (size_t)t * D;
        float ss = 0.f;
        for (int k = 0; k < D; ++k) ss += r[k] * r[k];
        const float rs = rsqrtf(ss * (1.0f / D) + EPS);
        P.rstd[t] = rs;
        float lg[4], le[32];
#pragma unroll
        for (int j = 0; j < 4; ++j) lg[j] = 0.f;
#pragma unroll
        for (int j = 0; j < 32; ++j) le[j] = 0.f;
        for (int k = 0; k < D; ++k) {
            const float h = r[k] * rs * g[k];
#pragma unroll
            for (int j = 0; j < 4; ++j) lg[j] += h * wgrp[k * 4 + j];
#pragma unroll
            for (int j = 0; j < 32; ++j) le[j] += h * wexp[k * 32 + j];
        }
#pragma unroll
        for (int j = 0; j < 4; ++j) lg[j] += bgrp[j];
#pragma unroll
        for (int j = 0; j < 32; ++j) le[j] += bexp[j];
        int gs = 0; float gm = lg[0];
#pragma unroll
        for (int j = 1; j < 4; ++j) if (lg[j] > gm) { gm = lg[j]; gs = j; }
        float gz = 0.f;
#pragma unroll
        for (int j = 0; j < 4; ++j) gz += expf(lg[j] - gm);
        const float pg = 1.0f / gz;
        float w[8];
#pragma unroll
        for (int j = 0; j < 8; ++j) w[j] = gs == 0 ? le[j] : gs == 1 ? le[8 + j] : gs == 2 ? le[16 + j] : le[24 + j];
        int i1 = 0; float m1 = w[0];
#pragma unroll
        for (int j = 1; j < 8; ++j) if (w[j] > m1) { m1 = w[j]; i1 = j; }
        int i2 = -1; float m2 = -3e38f;
#pragma unroll
        for (int j = 0; j < 8; ++j) if (j != i1 && w[j] > m2) { m2 = w[j]; i2 = j; }
        const float e2 = expf(m2 - m1);
        const float w1 = pg / (1.0f + e2), w2 = pg * e2 / (1.0f + e2);
        P.eid[t * 2 + 0] = gs * 8 + i1; P.eid[t * 2 + 1] = gs * 8 + i2;
        P.ew[t * 2 + 0] = w1; P.ew[t * 2 + 1] = w2;
    }
}

DEV void ph_moe_hidden(const Params& P, int layer, int gtid, int gsz) {
    const float* g = P.moe_norm + layer * D;
    const long total = (long)T * 512;
    for (long i = gtid; i < total; i += gsz) {
        const int t = (int)(i >> 9), slot = (int)((i >> 8) & 1), f = (int)(i & 255);
        const int e = P.eid[t * 2 + slot];
        const float* wg = P.moe_w_gate + ((size_t)(layer * 32 + e) * D) * 256 + f;
        const float* wu = P.moe_w_up + ((size_t)(layer * 32 + e) * D) * 256 + f;
        const float* r = P.out + (size_t)t * D;
        const float rs = P.rstd[t];
        float a = 0.f, u = 0.f;
        for (int k = 0; k < D; ++k) {
            const float h = r[k] * rs * g[k];
            a += h * wg[(size_t)k * 256];
            u += h * wu[(size_t)k * 256];
        }
        const float sg = a / (1.0f + expf(-a));
        P.hmid[i] = sg * u;
    }
}

DEV void ph_moe_out(const Params& P, int layer, int gtid, int gsz) {
    const long total = (long)T * D;
    for (long i = gtid; i < total; i += gsz) {
        const int t = (int)(i / D), c = (int)(i % D);
        float tot = 0.f;
        for (int slot = 0; slot < 2; ++slot) {
            const int e = P.eid[t * 2 + slot];
            const float* wd = P.moe_w_down + ((size_t)(layer * 32 + e) * 256) * D + c;
            const float* hm = P.hmid + ((size_t)t * 2 + slot) * 256;
            float acc = 0.f;
            for (int f = 0; f < 256; ++f) acc += hm[f] * wd[(size_t)f * D];
            tot += P.ew[t * 2 + slot] * acc;
        }
        P.out[i] += tot;
    }
}

DEV void ph_prep1(const Params& P, int gtid, int gsz) {
    const int n1 = NB * 8 * 8 * 64;
    for (int i = gtid; i < n1; i += gsz) {
        const int d = i & 63, n = (i >> 6) & 7, h = (i >> 9) & 7, b = i >> 12;
        const bf16* kp = P.proj + ((size_t)b * S + n * 256) * LDP + 512 + h * 64 + d;
        float s = 0.f;
        for (int j = 0; j < 256; ++j) s += bf2f(kp[(size_t)j * LDP]);
        P.kmean[i] = s * (1.0f / 256);
    }
    const int n2 = 2 * NB * NCMP * 2;
    for (int i = gtid; i < n2; i += gsz) {
        const int hkv = i & 1; int r = i >> 1; const int n = r % NCMP; r /= NCMP; const int b = r % NB; const int which = r / NB;
        const float* pos = P.od_cmp_pos + which * 32 * 64;
        const float* w = P.od_cmp_w + (size_t)which * 32 * 64 * 64;
        const bf16* xp = P.proj + ((size_t)b * S + n * 16) * LDP + (which ? 2176 : 2048) + hkv * 64;
        float acc[64];
#pragma unroll
        for (int e = 0; e < 64; ++e) acc[e] = 0.f;
        for (int l = 0; l < 32; ++l)
            for (int d = 0; d < 64; ++d) {
                const float xv = bf2f(xp[(size_t)l * LDP + d]) + pos[l * 64 + d];
                const float* wr = w + ((size_t)l * 64 + d) * 64;
#pragma unroll
                for (int e = 0; e < 64; ++e) acc[e] += xv * wr[e];
            }
        if (which == 0) {
            float ss = 0.f;
#pragma unroll
            for (int e = 0; e < 64; ++e) ss += acc[e] * acc[e];
            const float rs = rsqrtf(ss * (1.0f / 64) + EPS);
#pragma unroll
            for (int e = 0; e < 64; ++e) acc[e] *= rs * P.od_d_k_norm[e];
        }
        bf16* op = P.kvcmp + (((size_t)(which * NB + b) * NCMP + n) * 2 + hkv) * 64;
#pragma unroll
        for (int e = 0; e < 64; ++e) op[e] = f2bf(acc[e]);
    }
}

DEV int cmp_count(int s) { int c = s >= 31 ? (s - 31) / 16 + 1 : 0; return c > NCMP ? NCMP : c; }

DEV void ph_nsa_cmp(const Params& P, int gtid, int gsz) {
    const long total = (long)T * 8;
    for (long i = gtid; i < total; i += gsz) {
        const int hh = (int)(i / T), t = (int)(i % T);
        const int b = t / S, s = t % S, hkv = hh >> 2;
        float q[64], o[64];
        load64(P.proj + (size_t)t * LDP + 1536 + hh * 64, q);
#pragma unroll
        for (int d = 0; d < 64; ++d) o[d] = 0.f;
        const float sl = slope_of(hh);
        float m = NEG, l = 0.f;
        const int cnt = cmp_count(s);
        const bf16* kc = P.kvcmp + (((size_t)(0 * NB + b) * NCMP) * 2 + hkv) * 64;
        const bf16* vc = P.kvcmp + (((size_t)(1 * NB + b) * NCMP) * 2 + hkv) * 64;
        for (int n = 0; n < cnt; ++n) {
            const float sc = dot64(q, kc + (size_t)n * 128) * 0.125f - sl * (float)(s - (n * 16 + 31));
            os_update(sc, vc + (size_t)n * 128, m, l, o);
        }
        const float inv = cnt > 0 ? 1.0f / l : 0.f;
        float* op = P.ocmp + ((size_t)t * 8 + hh) * 64;
#pragma unroll
        for (int d = 0; d < 64; ++d) op[d] = o[d] * inv;
        P.cml[((size_t)t * 8 + hh) * 2 + 0] = m;
        P.cml[((size_t)t * 8 + hh) * 2 + 1] = l;
    }
}

DEV void ph_nsa_select(const Params& P, int gtid, int gsz) {
    const long total = (long)T * 64;
    for (long i = gtid; i < total; i += gsz) {
        const int j = (int)(i & 31), hkv = (int)((i >> 5) & 1), t = (int)(i >> 6);
        const int b = t / S, s = t % S, cur = s >> 6;
        float score = NEG;
        if (j <= cur) {
            const int cnt = cmp_count(s);
            const bf16* kc = P.kvcmp + (((size_t)(0 * NB + b) * NCMP) * 2 + hkv) * 64;
            float p = 0.f;
            int n0 = 4 * j - 1; if (n0 < 0) n0 = 0;
            int n1 = 4 * j + 3; if (n1 > NCMP - 1) n1 = NCMP - 1;
            for (int g = 0; g < 4; ++g) {
                const int hh = hkv * 4 + g;
                float q[64];
                load64(P.proj + (size_t)t * LDP + 1536 + hh * 64, q);
                const float sl = slope_of(hh);
                const float m = P.cml[((size_t)t * 8 + hh) * 2 + 0], l = P.cml[((size_t)t * 8 + hh) * 2 + 1];
                for (int n = n0; n <= n1; ++n)
                    if (n < cnt) {
                        const float sc = dot64(q, kc + (size_t)n * 128) * 0.125f - sl * (float)(s - (n * 16 + 31));
                        p += expf(sc - m) / l;
                    }
            }
            const bool forced = (j == 0) || (j == cur) || (j == cur - 1);
            score = p + (forced ? 1000.0f : 0.0f);
        }
        P.pslc[i] = score;
    }
}

DEV void ph_nsa_topk(const Params& P, int gtid, int gsz) {
    const int total = T * 2;
    for (int i = gtid; i < total; i += gsz) {
        const int t = i >> 1;
        const int s = t % S, cur = s >> 6;
        const float* sc = P.pslc + (size_t)i * 32;
        unsigned mask = 0;
        for (int j = 0; j <= cur; ++j) {
            const float sj = sc[j];
            int rank = 0;
            for (int k = 0; k < 32; ++k) { const float sk = sc[k]; rank += (sk > sj || (sk == sj && k < j)) ? 1 : 0; }
            if (rank < 16) mask |= 1u << j;
        }
        P.selmask[i] = mask;
    }
}

DEV void ph_attn1(const Params& P, int gtid, int gsz) {
    const long total = (long)T * 16;
    for (long i = gtid; i < total; i += gsz) {
        const int hh = (int)(i / T), t = (int)(i % T);
        const int b = t / S, s = t % S;
        const bf16* base = P.proj + (size_t)b * S * LDP;
        float q[64], o[64];
#pragma unroll
        for (int d = 0; d < 64; ++d) o[d] = 0.f;
        if (hh < 8) {
            const int h = hh, own = s >> 8;
            load64(base + (size_t)s * LDP + h * 64, q);
            const float sl = slope_of(h);
            float gt[8];
#pragma unroll
            for (int n = 0; n < 8; ++n) gt[n] = n < own ? dot64f(q, P.kmean + ((size_t)(b * 8 + h) * 8 + n) * 64) : NEG;
            unsigned sel = 0;
#pragma unroll
            for (int n = 0; n < 8; ++n) {
                int rank = 0;
#pragma unroll
                for (int k = 0; k < 8; ++k) rank += (gt[k] > gt[n] || (gt[k] == gt[n] && k < n)) ? 1 : 0;
                if (rank < 3 && n < own) sel |= 1u << n;
            }
            float m = NEG, l = 0.f;
            for (int n = 0; n < own; ++n) {
                if (!((sel >> n) & 1)) continue;
                for (int kk = 0; kk < 256; ++kk) {
                    const int kp = n * 256 + kk;
                    const bf16* kr = base + (size_t)kp * LDP + 512 + h * 64;
                    const float sc = dot64(q, kr) * 0.125f - sl * (float)(s - kp);
                    os_update(sc, kr + 512, m, l, o);
                }
            }
            for (int kp = own * 256; kp <= s; ++kp) {
                const bf16* kr = base + (size_t)kp * LDP + 512 + h * 64;
                const float sc = dot64(q, kr) * 0.125f - sl * (float)(s - kp);
                os_update(sc, kr + 512, m, l, o);
            }
            const float inv = 1.0f / l;
            bf16* op = P.o + (size_t)t * D + h * 64;
#pragma unroll
            for (int d = 0; d < 64; ++d) op[d] = f2bf(o[d] * inv);
        } else {
            const int h = hh - 8, hkv = h >> 2, cur = s >> 6;
            load64(base + (size_t)s * LDP + 1536 + h * 64, q);
            const float sl = slope_of(h);
            const bf16* grow = base + (size_t)s * LDP + 2816 + h * 3;
            const float g0 = 1.0f / (1.0f + expf(-bf2f(grow[0])));
            const float g1 = 1.0f / (1.0f + expf(-bf2f(grow[1])));
            const float g2 = 1.0f / (1.0f + expf(-bf2f(grow[2])));
            float acc[64];
            const float* oc = P.ocmp + ((size_t)t * 8 + h) * 64;
#pragma unroll
            for (int d = 0; d < 64; ++d) acc[d] = g0 * oc[d];
            const unsigned mask = P.selmask[t * 2 + hkv];
            float m = NEG, l = 0.f;
            for (int j = 0; j <= cur; ++j) {
                if (!((mask >> j) & 1)) continue;
                for (int kk = 0; kk < 64; ++kk) {
                    const int kp = j * 64 + kk;
                    if (kp > s) break;
                    const bf16* kr = base + (size_t)kp * LDP + 2304 + hkv * 64;
                    const float sc = dot64(q, kr) * 0.125f - sl * (float)(s - kp);
                    os_update(sc, kr + 128, m, l, o);
                }
            }
            {
                const float f = g1 / l;
#pragma unroll
                for (int d = 0; d < 64; ++d) { acc[d] += f * o[d]; o[d] = 0.f; }
            }
            m = NEG; l = 0.f;
            const int s0 = s - 511 < 0 ? 0 : s - 511;
            for (int kp = s0; kp <= s; ++kp) {
                const bf16* kr = base + (size_t)kp * LDP + 2560 + hkv * 64;
                const float sc = dot64(q, kr) * 0.125f - sl * (float)(s - kp);
                os_update(sc, kr + 128, m, l, o);
            }
            {
                const float f = g2 / l;
#pragma unroll
                for (int d = 0; d < 64; ++d) acc[d] += f * o[d];
            }
            bf16* op = P.o + (size_t)t * D + 512 + h * 64;
#pragma unroll
            for (int d = 0; d < 64; ++d) op[d] = f2bf(acc[d]);
        }
    }
}

namespace pg8 {
#define PG8_LAS __attribute__((address_space(3)))
typedef unsigned short bf16_t;
typedef short bf16x8 __attribute__((ext_vector_type(8)));
typedef float f32x4 __attribute__((ext_vector_type(4)));
typedef unsigned u32x4 __attribute__((ext_vector_type(4)));
constexpr int BM = 256, BK = 64, HALF = 128, HTB = HALF * BK * 2, STAGE_BYTES = 8 * HTB, NXCD = 8, WGM = 8;

__host__ __device__ __forceinline__ int lds_byte(int r, int c) { const int st = (r >> 4) * 2 + (c >> 5), rr = r & 15, cc = c & 31, ob = rr * 64 + cc * 2; return st * 1024 + (ob ^ (((ob >> 9) & 1) << 5)); }
__host__ __device__ __forceinline__ void stage_rc(int b, int& R, int& C) { const int st = b / 1024, sb = b % 1024, swz = sb ^ (((sb >> 9) & 1) << 5); R = (st >> 1) * 16 + swz / 64; C = (st & 1) * 32 + (swz % 64) / 2; }
__host__ __device__ __forceinline__ int perm32(int rho) { const int n = rho >> 4, i = rho & 15; return 8 * (i >> 2) + 4 * n + (i & 3); }

struct Unit { const char* A; const char* B; int pm, pn; };

struct StaticOrder {
    int nM, nN, nwg, G, c; const char* A; const char* Bt; size_t tstep;
    __device__ void init(const bf16_t* A_, const bf16_t* Bt_, int M, int N, int K, int G_, int c_) { nM = M / BM; nN = N / BM; nwg = nM * nN; G = G_; c = c_; A = (const char*)A_; Bt = (const char*)Bt_; tstep = (size_t)BM * K * 2; }
    __device__ bool next(int i, Unit& u) const {
        const long L = (long)i * G + c; if (L >= nwg) return false;
        int wgid = (int)L; { const int q = nwg / NXCD, r = nwg % NXCD, xcd = wgid % NXCD, off = wgid / NXCD; wgid = (xcd < r ? xcd * (q + 1) : r * (q + 1) + (xcd - r) * q) + off; }
        const int nig = WGM * nN, gid = wgid / nig, fm = gid * WGM, gsz = (nM - fm) < WGM ? (nM - fm) : WGM;
        u.pm = fm + ((wgid % nig) % gsz); u.pn = (wgid % nig) / gsz; u.A = A + (size_t)u.pm * tstep; u.B = Bt + (size_t)u.pn * tstep; return true;
    }
};

__device__ __forceinline__ unsigned cvt_pk_bf16(float lo, float hi) { unsigned r; asm volatile("v_cvt_pk_bf16_f32 %0, %1, %2" : "=v"(r) : "v"(lo), "v"(hi)); return r; }

struct EpiStoreBf16 {
    static constexpr bool PERM = true;
    bf16_t* O; int ldc;
    __device__ __forceinline__ void operator()(const f32x4 (&acc)[2][2][4][2], const Unit& u, int wr, int wc, int fr, int fq) const {
        const int row0 = u.pm * BM + wr * 64 + fr, col0 = u.pn * BM + wc * 32 + 8 * fq;
#pragma unroll
        for (int ai = 0; ai < 2; ++ai)
#pragma unroll
            for (int m = 0; m < 4; ++m) { bf16_t* rowp = O + (size_t)(row0 + ai * HALF + m * 16) * ldc + col0;
#pragma unroll
                for (int bj = 0; bj < 2; ++bj) { const f32x4 v0 = acc[ai][bj][m][0], v1 = acc[ai][bj][m][1];
                    u32x4 w; w.x = cvt_pk_bf16(v0[0], v0[1]); w.y = cvt_pk_bf16(v0[2], v0[3]); w.z = cvt_pk_bf16(v1[0], v1[1]); w.w = cvt_pk_bf16(v1[2], v1[3]);
                    *(u32x4*)(rowp + bj * HALF) = w; } }
    }
};
struct EpiResidF32 {
    static constexpr bool PERM = true;
    const float* R; float* O; int ldc;
    __device__ __forceinline__ void operator()(const f32x4 (&acc)[2][2][4][2], const Unit& u, int wr, int wc, int fr, int fq) const {
        const int row0 = u.pm * BM + wr * 64 + fr, col0 = u.pn * BM + wc * 32 + 8 * fq;
#pragma unroll
        for (int ai = 0; ai < 2; ++ai)
#pragma unroll
            for (int m = 0; m < 4; ++m) { const size_t ro = (size_t)(row0 + ai * HALF + m * 16) * ldc + col0;
#pragma unroll
                for (int bj = 0; bj < 2; ++bj) {
                    const f32x4 r0 = *(const f32x4*)(R + ro + bj * HALF), r1 = *(const f32x4*)(R + ro + bj * HALF + 4);
                    *(f32x4*)(O + ro + bj * HALF) = r0 + acc[ai][bj][m][0]; *(f32x4*)(O + ro + bj * HALF + 4) = r1 + acc[ai][bj][m][1]; } }
    }
};
struct EpiSiluMul {
    static constexpr bool PERM = true;
    bf16_t* H; int ldh;
    __device__ __forceinline__ void operator()(const f32x4 (&acc)[2][2][4][2], const Unit& u, int wr, int wc, int fr, int fq) const {
        const int row0 = u.pm * BM + wr * 64 + fr, col0 = u.pn * HALF + wc * 32 + 8 * fq;
#pragma unroll
        for (int ai = 0; ai < 2; ++ai)
#pragma unroll
            for (int m = 0; m < 4; ++m) { bf16_t* rowp = H + (size_t)(row0 + ai * HALF + m * 16) * ldh + col0;
                float h[8];
#pragma unroll
                for (int n = 0; n < 2; ++n)
#pragma unroll
                    for (int j = 0; j < 4; ++j) { const float g = acc[ai][0][m][n][j], up = acc[ai][1][m][n][j]; h[n * 4 + j] = g * up / (1.0f + __expf(-g)); }
                u32x4 w; w.x = cvt_pk_bf16(h[0], h[1]); w.y = cvt_pk_bf16(h[2], h[3]); w.z = cvt_pk_bf16(h[4], h[5]); w.w = cvt_pk_bf16(h[6], h[7]);
                *(u32x4*)rowp = w; }
    }
};

template <class Epi, class Sched>
__device__ __forceinline__ void gemm_phase(PG8_LAS unsigned char* lds, const int K, const Sched& S, const Epi& E) {
    const int tid = threadIdx.x, wid = __builtin_amdgcn_readfirstlane(tid >> 6), lane = tid & 63, wr = wid >> 2, wc = wid & 3, fr = lane & 15, fq = lane >> 4;
    const int nt = K / BK;
    unsigned voffA[2], voffB[2];
#pragma unroll
    for (int i = 0; i < 2; ++i) { int R, C; stage_rc(tid * 16 + i * 8192, R, C); const int Rb = Epi::PERM ? ((R & ~31) + perm32(R & 31)) : R;
        voffA[i] = (unsigned)(R * K + C) * 2u; voffB[i] = (unsigned)(Rb * K + C) * 2u; }
    const size_t kstep = (size_t)(BK * 2);
    const size_t hstep = (size_t)HALF * K * 2;
    const unsigned ldsw = (unsigned)wid * 1024u;
    const int aoff = lds_byte(wr * 64 + fr, fq * 8), boff = lds_byte(wc * 32 + fr, fq * 8);
#define PG8_SA(b, h) (((b) * 2 + (h)) * HTB)
#define PG8_SB(b, h) ((4 + (b) * 2 + (h)) * HTB)
#define PG8_STAGE(bufoff, gbase, voff) do { _Pragma("unroll") for (int _i = 0; _i < 2; ++_i) \
        __builtin_amdgcn_global_load_lds((const unsigned*)((const char*)(gbase) + (voff)[_i]), (PG8_LAS unsigned*)(lds + (bufoff) + ldsw + _i * 8192), 16, 0, 0); } while (0)
#define PG8_LDA(dst, b, h) do { _Pragma("unroll") for (int m = 0; m < 4; ++m) _Pragma("unroll") for (int k = 0; k < 2; ++k) dst[m][k] = *(const PG8_LAS bf16x8*)(lds + PG8_SA(b, h) + aoff + m * 2048 + k * 1024); } while (0)
#define PG8_LDB(dst, b, h) do { _Pragma("unroll") for (int n = 0; n < 2; ++n) _Pragma("unroll") for (int k = 0; k < 2; ++k) dst[n][k] = *(const PG8_LAS bf16x8*)(lds + PG8_SB(b, h) + boff + n * 2048 + k * 1024); } while (0)
#define PG8_MMA(ai, bj, At, Bt) do { __builtin_amdgcn_s_setprio(1); _Pragma("unroll") for (int m = 0; m < 4; ++m) _Pragma("unroll") for (int n = 0; n < 2; ++n) _Pragma("unroll") for (int k = 0; k < 2; ++k) \
        acc[ai][bj][m][n] = __builtin_amdgcn_mfma_f32_16x16x32_bf16(Bt[n][k], At[m][k], acc[ai][bj][m][n], 0, 0, 0); __builtin_amdgcn_s_setprio(0); } while (0)
#define PG8_WAIT_V(n) asm volatile("s_waitcnt vmcnt(" #n ")" ::: "memory")
#define PG8_WAIT_L(n) asm volatile("s_waitcnt lgkmcnt(" #n ")" ::: "memory")
#define PG8_BAR __builtin_amdgcn_s_barrier()
#define PG8_SCHED __builtin_amdgcn_sched_barrier(0)
    Unit cur, nxt; int ui = 0;
    if (!S.next(0, cur)) return;
    f32x4 acc[2][2][4][2];
#pragma unroll
    for (int a = 0; a < 2; ++a)
#pragma unroll
        for (int b = 0; b < 2; ++b)
#pragma unroll
            for (int m = 0; m < 4; ++m)
#pragma unroll
                for (int n = 0; n < 2; ++n) acc[a][b][m][n] = (f32x4){0.f, 0.f, 0.f, 0.f};
    bf16x8 At[4][2], B0[2][2], B1[2][2];
    const char* cA = cur.A; const char* cB = cur.B;
    PG8_STAGE(PG8_SB(0, 0), cB, voffB); PG8_STAGE(PG8_SB(0, 1), cB + hstep, voffB); PG8_STAGE(PG8_SA(0, 0), cA, voffA); PG8_STAGE(PG8_SA(0, 1), cA + hstep, voffA);
    if (wr == 1) PG8_BAR;
    PG8_WAIT_V(2); PG8_BAR;
    PG8_STAGE(PG8_SB(1, 0), cB + kstep, voffB); PG8_STAGE(PG8_SA(1, 0), cA + kstep, voffA); PG8_STAGE(PG8_SB(1, 1), cB + hstep + kstep, voffB);
    PG8_WAIT_V(6); PG8_BAR;
    for (;;) {
        const bool has_next = S.next(ui + 1, nxt);
        const char* nA = has_next ? nxt.A : cA; const char* nB = has_next ? nxt.B : cB;
        for (int t = 0; t < nt; t += 2) {
            const bool last = (t == nt - 2);
            const char* a1 = cA + (size_t)(t + 1) * kstep;
            const char* a2 = last ? nA : cA + (size_t)(t + 2) * kstep; const char* b2 = last ? nB : cB + (size_t)(t + 2) * kstep;
            const char* a3 = a2 + kstep; const char* b3 = b2 + kstep;
            PG8_LDB(B0, 0, 0); PG8_LDB(B1, 0, 1); PG8_SCHED; PG8_LDA(At, 0, 0); PG8_STAGE(PG8_SA(1, 1), a1 + hstep, voffA);
            PG8_WAIT_V(8); PG8_WAIT_L(0); PG8_BAR; PG8_MMA(0, 0, At, B0); PG8_MMA(0, 1, At, B1); PG8_BAR; PG8_SCHED;
            PG8_LDA(At, 0, 1); PG8_STAGE(PG8_SB(0, 0), b2, voffB); PG8_STAGE(PG8_SB(0, 1), b2 + hstep, voffB); PG8_STAGE(PG8_SA(0, 0), a2, voffA);
            PG8_WAIT_V(8); PG8_WAIT_L(0); PG8_BAR; PG8_MMA(1, 0, At, B0); PG8_MMA(1, 1, At, B1); PG8_BAR; PG8_SCHED;
            PG8_LDB(B0, 1, 0); PG8_LDB(B1, 1, 1); PG8_SCHED; PG8_LDA(At, 1, 0); PG8_STAGE(PG8_SA(0, 1), a2 + hstep, voffA);
            PG8_WAIT_V(8); PG8_WAIT_L(0); PG8_BAR; PG8_MMA(0, 0, At, B0); PG8_MMA(0, 1, At, B1); PG8_BAR; PG8_SCHED;
            PG8_LDA(At, 1, 1); PG8_STAGE(PG8_SB(1, 0), b3, voffB); PG8_STAGE(PG8_SB(1, 1), b3 + hstep, voffB); PG8_STAGE(PG8_SA(1, 0), a3, voffA);
            PG8_WAIT_V(8); PG8_WAIT_L(0); PG8_BAR; PG8_MMA(1, 0, At, B0); PG8_MMA(1, 1, At, B1); PG8_BAR; PG8_SCHED;
        }
        if (wr == 0) PG8_BAR;
        E(acc, cur, wr, wc, fr, fq);
        if (!has_next) break;
#pragma unroll
        for (int a = 0; a < 2; ++a)
#pragma unroll
            for (int b = 0; b < 2; ++b)
#pragma unroll
                for (int m = 0; m < 4; ++m)
#pragma unroll
                    for (int n = 0; n < 2; ++n) acc[a][b][m][n] = (f32x4){0.f, 0.f, 0.f, 0.f};
        cur = nxt; cA = nA; cB = nB; ++ui;
        if (wr == 1) PG8_BAR;
    }
    PG8_WAIT_V(0);
    PG8_BAR;
#undef PG8_SA
#undef PG8_SB
#undef PG8_STAGE
#undef PG8_LDA
#undef PG8_LDB
#undef PG8_MMA
#undef PG8_WAIT_V
#undef PG8_WAIT_L
#undef PG8_BAR
#undef PG8_SCHED
}
}

#define GAS __attribute__((address_space(1)))
#define LAS __attribute__((address_space(3)))
typedef unsigned v4u __attribute__((ext_vector_type(4)));
typedef float f32x4 __attribute__((ext_vector_type(4)));
typedef short bf16x8 __attribute__((ext_vector_type(8)));
constexpr int NWAVES = 8;
constexpr int RING_BYTES = 131072, LDSCTL_OFF = RING_BYTES, MISC_OFF = LDSCTL_OFF + 320, LDS_BYTES = 147456;
constexpr size_t MiB = 1u << 20;
constexpr size_t CTL_ZERO_BYTES = 1 * MiB;
constexpr int CW_BAR = 4096;
constexpr int CW_MOE = 65536;
#define LDS_WAIT() asm volatile("s_waitcnt lgkmcnt(0)" ::: "memory")
#define VM_WAIT() asm volatile("s_waitcnt vmcnt(0)" ::: "memory")
DEV unsigned pk2(float lo, float hi) { return (unsigned)f2bf(lo) | ((unsigned)f2bf(hi) << 16); }

#define XB_TMO      128
#define XB_XCNT(j)  (256  + 64 * (j))
#define XB_XSUB(j)  (1280 + 64 * (j))
#define XB_XGEN(j)  (2304 + 64 * (j))
#define XB_TOP      3328
#define XB_TOPGEN   3392
#define XCD_BAR_WORDS 3456
#define XB_SPIN_CAP (1u << 22)
DEV unsigned xb_ld(unsigned* p)              { return __hip_atomic_load(p, __ATOMIC_RELAXED, __HIP_MEMORY_SCOPE_AGENT); }
DEV unsigned xb_add(unsigned* p, unsigned v) { return __hip_atomic_fetch_add(p, v, __ATOMIC_RELAXED, __HIP_MEMORY_SCOPE_AGENT); }
DEV unsigned xb_xcc_id() { return (unsigned)__builtin_amdgcn_s_getreg((3 << 11) | 20) & 0xFu; }
#define XB_SPIN(cond, bar) do { unsigned _sp = 0; while (cond) { __builtin_amdgcn_s_sleep(1); \
    if ((++_sp & 255u) == 0u) { if (xb_ld(&(bar)[XB_TMO])) break; if (_sp > XB_SPIN_CAP) { atomicAdd(&(bar)[XB_TMO], 1u); break; } } } } while (0)
struct XcdBarrier { unsigned* bar; unsigned x; volatile LAS unsigned* st; };
DEV XcdBarrier xcd_barrier_post(unsigned* bar, volatile LAS unsigned* st) {
    XcdBarrier b; b.bar = bar; b.x = xb_xcc_id(); b.st = st;
    if (threadIdx.x == 0) (void)xb_add(&bar[XB_XCNT(b.x)], 1u);
    return b;
}
DEV void xcd_barrier_complete(unsigned* bar, unsigned x, unsigned& nloc, unsigned& nx) {
    const unsigned G = gridDim.x * gridDim.y * gridDim.z;
    unsigned sum, cnt, mine, sp = 0u;
    for (;;) {
        sum = 0u; cnt = 0u; mine = 0u;
#pragma unroll
        for (unsigned j = 0; j < 16; ++j) { const unsigned c = xb_ld(&bar[XB_XCNT(j)]); sum += c; cnt += (c > 0u) ? 1u : 0u; mine = (j == x) ? c : mine; }
        if (sum == G) break;
        __builtin_amdgcn_s_sleep(1);
        if ((++sp & 255u) == 0u) { if (xb_ld(&bar[XB_TMO])) break; if (sp > XB_SPIN_CAP) { atomicAdd(&bar[XB_TMO], 1u); break; } }
    }
    nloc = mine > 0u ? mine : 1u; nx = cnt > 0u ? cnt : 1u;
}
DEV void xcd_barrier(const XcdBarrier& b) {
    asm volatile("s_waitcnt vmcnt(0)" ::: "memory");
    __syncthreads();
    if (threadIdx.x == 0) {
        unsigned* bar = b.bar;
        __builtin_amdgcn_s_waitcnt(0);
        unsigned nloc = b.st[0], nx = b.st[1];
        if (nloc == 0u) { xcd_barrier_complete(bar, b.x, nloc, nx); b.st[0] = nloc; b.st[1] = nx; }
        const unsigned old = xb_add(&bar[XB_XSUB(b.x)], 1u);
        const unsigned gen = old / nloc;
        if (old + 1u == (gen + 1u) * nloc) {
            __builtin_amdgcn_fence(__ATOMIC_RELEASE, "agent");
            asm volatile("s_waitcnt vmcnt(0)" ::: "memory");
            const unsigned og = xb_add(&bar[XB_TOP], 1u);
            const unsigned tg = og / nx;
            if (og + 1u == (tg + 1u) * nx) xb_add(&bar[XB_TOPGEN], 1u);
            else XB_SPIN(xb_ld(&bar[XB_TOPGEN]) == tg, bar);
            __builtin_amdgcn_fence(__ATOMIC_ACQUIRE, "agent");
            xb_add(&bar[XB_XGEN(b.x)], 1u);
            asm volatile("s_waitcnt vmcnt(0)" ::: "memory");
        } else {
            XB_SPIN(xb_ld(&bar[XB_XGEN(b.x)]) == gen, bar);
            __builtin_amdgcn_fence(__ATOMIC_ACQUIRE, "agent");
            asm volatile("s_waitcnt vmcnt(0)" ::: "memory");
        }
    }
    __syncthreads();
}

struct Frame {
    LAS unsigned char* lds;
    volatile LAS unsigned* MISC;
    int tid, lane, wave;
    int vcu, G;
};

DEV float wave_sum(float v) {
#pragma unroll
    for (int o = 1; o < 64; o <<= 1) v += __shfl_xor(v, o);
    return v;
}
DEV void transpose_item(const float* W, int K, int N, bf16* WT, int k0, int n0, int dst_row0, LAS float* scr, int lane) {
    const bool okc = (n0 + (lane & 31)) < N;
#pragma unroll 8
    for (int i = 0; i < 32; ++i) { const int kk = 2 * i + (lane >> 5); scr[kk * 33 + (lane & 31)] = okc ? W[(size_t)(k0 + kk) * N + n0 + (lane & 31)] : 0.f; }
    LDS_WAIT(); asm volatile("" ::: "memory");
    const int c = lane & 7;
#pragma unroll
    for (int j = 0; j < 4; ++j) { const int n = (lane >> 3) + 8 * j; const LAS float* s = scr + (8 * c) * 33 + n;
        v4u o; o.x = pk2(s[0 * 33], s[1 * 33]); o.y = pk2(s[2 * 33], s[3 * 33]); o.z = pk2(s[4 * 33], s[5 * 33]); o.w = pk2(s[6 * 33], s[7 * 33]);
        if (n0 + n < N) *(GAS v4u*)(WT + (size_t)(dst_row0 + n) * K + k0 + 8 * c) = o; }
    LDS_WAIT(); asm volatile("" ::: "memory");
}
DEV float rms_row_to_bf16(int lane, const float* xrow, const float* gain, bf16* orow) {
    const GAS f32x4* xr = (const GAS f32x4*)xrow + lane;
    const GAS f32x4* gr = (const GAS f32x4*)gain + lane;
    f32x4 v[4]; float s = 0.f;
#pragma unroll
    for (int j = 0; j < 4; ++j) { v[j] = xr[64 * j]; s += (v[j].x * v[j].x + v[j].y * v[j].y) + (v[j].z * v[j].z + v[j].w * v[j].w); }
    const float rstd = 1.0f / sqrtf(wave_sum(s) * (1.f / D) + EPS);
    GAS unsigned long long* o8 = (GAS unsigned long long*)orow + lane;
#pragma unroll
    for (int j = 0; j < 4; ++j) { const f32x4 g = gr[64 * j];
        o8[64 * j] = (unsigned long long)pk2(v[j].x * rstd * g.x, v[j].y * rstd * g.y) | ((unsigned long long)pk2(v[j].z * rstd * g.z, v[j].w * rstd * g.w) << 32); }
    return rstd;
}

DEV void fp_convert_weights(const Params& P, Frame& F, int which) {
    LAS float* scr = (LAS float*)(F.lds + F.wave * 16384);
    const int gw = F.vcu * NWAVES + F.wave, NGW = F.G * NWAVES;
    if (which == 0) {
        constexpr int I_IN0 = 16 * 72, I_OUT = 16 * 32, I_IN1 = 16 * 89;
        constexpr int NIT = I_IN0 + I_OUT + I_IN1 + I_OUT;
        for (int it = gw; it < NIT; it += NGW) {
            int r = it;
            if (r < I_IN0) { const int kb = r / 72, nb = r % 72; transpose_item(P.ev_w_in, D, EVEN_IN, P.win0t, 64 * kb, 32 * nb, 32 * nb, scr, F.lane); continue; } r -= I_IN0;
            if (r < I_OUT) { const int kb = r / 32, nb = r % 32; transpose_item(P.ev_w_out, D, D, P.wout0t, 64 * kb, 32 * nb, 32 * nb, scr, F.lane); continue; } r -= I_OUT;
            if (r < I_IN1) { const int kb = r / 89, nb = r % 89; transpose_item(P.od_w_in, D, ODD_IN, P.win1t, 64 * kb, 32 * nb, 32 * nb, scr, F.lane); continue; } r -= I_IN1;
            { const int kb = r / 32, nb = r % 32; transpose_item(P.od_w_out, D, D, P.wout1t, 64 * kb, 32 * nb, 32 * nb, scr, F.lane); }
        }
    } else {
        const int layer = which - 1;
        constexpr int NIT = 32 * 384;
        for (int it = gw; it < NIT; it += NGW) {
            const int e = it / 384; int r = it % 384;
            const size_t eo = (size_t)(layer * 32 + e);
            if (r < 256) { const bool up = r >= 128; r &= 127; const int kb = r / 8, nb = r % 8; const int f0 = 32 * nb;
                const float* W = (up ? P.moe_w_up : P.moe_w_gate) + eo * D * 256;
                transpose_item(W, D, 256, P.wgut + (size_t)e * 512 * D, 64 * kb, f0, (f0 >> 7) * 256 + (up ? 128 : 0) + (f0 & 127), scr, F.lane);
            } else { r -= 256; const int kb = r / 32, nb = r % 32;
                transpose_item(P.moe_w_down + eo * 256 * D, 256, D, P.wdt + (size_t)e * D * 256, 64 * kb, 32 * nb, 32 * nb, scr, F.lane); }
        }
    }
}
DEV void fp_norm_rows(Frame& F, const float* src, const float* gain, bf16* xn) {
    const int gw = F.vcu * NWAVES + F.wave, NGW = F.G * NWAVES;
    for (int m = gw; m < T; m += NGW) rms_row_to_bf16(F.lane, src + (size_t)m * D, gain, xn + (size_t)m * D);
}

constexpr int NPHASE = 20;
DEV void run_phase(const Params& P, int ph, int gtid, int gsz) {
    switch (ph) {
        case 0: ph_rstd(P.x, P.rstd, gtid, gsz); break;
        case 1: ph_gemm_in(P.x, P.rstd, P.ev_norm, P.ev_w_in, EVEN_IN, P.proj, gtid, gsz); break;
        case 2: ph_headnorm0(P, gtid, gsz); break;
        case 3: ph_attn0(P, gtid, gsz); break;
        case 4: ph_gemm_out(P.o, P.ev_w_out, P.x, P.out, gtid, gsz); break;
        case 5: ph_moe_route(P, 0, gtid, gsz); break;
        case 6: ph_moe_hidden(P, 0, gtid, gsz); break;
        case 7: ph_moe_out(P, 0, gtid, gsz); break;
        case 8: ph_rstd(P.out, P.rstd, gtid, gsz); break;
        case 9: ph_gemm_in(P.out, P.rstd, P.od_norm, P.od_w_in, ODD_IN, P.proj, gtid, gsz); break;
        case 10: ph_headnorm1(P, gtid, gsz); break;
        case 11: ph_prep1(P, gtid, gsz); break;
        case 12: ph_nsa_cmp(P, gtid, gsz); break;
        case 13: ph_nsa_select(P, gtid, gsz); break;
        case 14: ph_nsa_topk(P, gtid, gsz); break;
        case 15: ph_attn1(P, gtid, gsz); break;
        case 16: ph_gemm_out(P.o, P.od_w_out, P.out, P.out, gtid, gsz); break;
        case 17: ph_moe_route(P, 1, gtid, gsz); break;
        case 18: ph_moe_hidden(P, 1, gtid, gsz); break;
        case 19: ph_moe_out(P, 1, gtid, gsz); break;
    }
}
__global__ void __launch_bounds__(256) k_naive(Params P, int ph) {
    run_phase(P, ph, blockIdx.x * blockDim.x + threadIdx.x, gridDim.x * blockDim.x);
}

enum { FP_CONV_DENSE = 0, FP_CONV_MOE0, FP_CONV_MOE1, FP_XN0, FP_INPROJ0, FP_OUTPROJ0, FP_XN1, FP_INPROJ1, FP_OUTPROJ1, FP_COUNT };
struct FArgs { Params p; unsigned long long mask; int li, pad; };

__global__ void __launch_bounds__(NWAVES * 64, 2) k_fast(FArgs args) {
    extern __shared__ __attribute__((aligned(16))) unsigned char lds[];
    const Params& P = args.p;
    Frame F;
    F.lds = (LAS unsigned char*)lds;
    F.MISC = (volatile LAS unsigned*)(F.lds + MISC_OFF);
    F.tid = threadIdx.x; F.lane = F.tid & 63; F.wave = __builtin_amdgcn_readfirstlane(F.tid >> 6);
    F.G = gridDim.x; { const int bx = blockIdx.x; F.vcu = (F.G % 8 == 0) ? (bx % 8) * (F.G / 8) + bx / 8 : bx; }
    for (int u = F.tid; u < (LDS_BYTES - LDSCTL_OFF) / 4; u += NWAVES * 64) ((LAS unsigned*)(F.lds + LDSCTL_OFF))[u] = 0u;
    __syncthreads();
    XcdBarrier bar = xcd_barrier_post(P.ctl + CW_BAR + args.li * XCD_BAR_WORDS, F.MISC + 8);
    const unsigned long long mask = args.mask;
#define ON(k) ((mask >> (k)) & 1ull)
#define SEAM(k) do { if ((mask >> ((k) + 1)) != 0ull) xcd_barrier(bar); } while (0)
    if (ON(FP_CONV_DENSE)) { fp_convert_weights(P, F, 0); SEAM(FP_CONV_DENSE); }
    if (ON(FP_CONV_MOE0)) { fp_convert_weights(P, F, 1); SEAM(FP_CONV_MOE0); }
    if (ON(FP_CONV_MOE1)) { fp_convert_weights(P, F, 2); SEAM(FP_CONV_MOE1); }
    if (ON(FP_XN0)) { fp_norm_rows(F, P.x, P.ev_norm, P.xn); SEAM(FP_XN0); }
    if (ON(FP_INPROJ0)) { pg8::StaticOrder So; So.init(P.xn, P.win0t, T, EVEN_IN, D, F.G, (int)blockIdx.x);
        pg8::EpiStoreBf16 E{P.proj, LDP}; pg8::gemm_phase(F.lds, D, So, E); SEAM(FP_INPROJ0); }
    if (ON(FP_OUTPROJ0)) { pg8::StaticOrder So; So.init(P.o, P.wout0t, T, D, D, F.G, (int)blockIdx.x);
        pg8::EpiResidF32 E{P.x, P.out, D}; pg8::gemm_phase(F.lds, D, So, E); SEAM(FP_OUTPROJ0); }
    if (ON(FP_XN1)) { fp_norm_rows(F, P.out, P.od_norm, P.xn); SEAM(FP_XN1); }
    if (ON(FP_INPROJ1)) { pg8::StaticOrder So; So.init(P.xn, P.win1t, T, LDP, D, F.G, (int)blockIdx.x);
        pg8::EpiStoreBf16 E{P.proj, LDP}; pg8::gemm_phase(F.lds, D, So, E); SEAM(FP_INPROJ1); }
    if (ON(FP_OUTPROJ1)) { pg8::StaticOrder So; So.init(P.o, P.wout1t, T, D, D, F.G, (int)blockIdx.x);
        pg8::EpiResidF32 E{P.out, P.out, D}; pg8::gemm_phase(F.lds, D, So, E); SEAM(FP_OUTPROJ1); }
#undef ON
#undef SEAM
}

static inline size_t al256(size_t x) { return (x + 255) & ~(size_t)255; }
static size_t carve(Params& p, void* d_ws) {
    char* w = (char*)d_ws;
    p.ctl = (unsigned*)w;
    p.win0t = (bf16*)(w + 1 * MiB);
    p.wout0t = (bf16*)(w + 6 * MiB);
    p.win1t = (bf16*)(w + 8 * MiB);
    p.wout1t = (bf16*)(w + 14 * MiB);
    p.wgut = (bf16*)(w + 16 * MiB);
    p.wdt = (bf16*)(w + 48 * MiB);
    p.proj = (bf16*)(w + 64 * MiB);
    p.ha = (bf16*)(w + 64 * MiB);
    p.xn = (bf16*)(w + 160 * MiB);
    p.hmid = (float*)(w + 160 * MiB);
    p.ocmp = (float*)(w + 160 * MiB);
    p.o = (bf16*)(w + 192 * MiB);
    p.hid = (bf16*)(w + 192 * MiB);
    size_t off = 224 * MiB;
    p.rstd = (float*)(w + off); off = al256(off + (size_t)T * 4);
    p.eid = (int*)(w + off); off = al256(off + (size_t)T * 2 * 4);
    p.ew = (float*)(w + off); off = al256(off + (size_t)T * 2 * 4);
    p.kmean = (float*)(w + off); off = al256(off + (size_t)NB * 8 * 8 * 64 * 4);
    p.kvcmp = (bf16*)(w + off); off = al256(off + (size_t)2 * NB * NCMP * 2 * 64 * 2);
    p.cml = (float*)(w + off); off = al256(off + (size_t)T * 8 * 2 * 4);
    p.pslc = (float*)(w + off); off = al256(off + (size_t)T * 64 * 4);
    p.selmask = (unsigned*)(w + off); off = al256(off + (size_t)T * 2 * 4);
    p.rowtok = (int*)(w + off); off = al256(off + (size_t)RMAX * 4);
    p.pos = (int*)(w + off); off = al256(off + (size_t)T * 2 * 4);
    return off;
}

struct Step { int fast; int n; int ph[20]; };
static const Step PLAN[] = {
    {1, 3, {FP_CONV_DENSE, FP_XN0, FP_INPROJ0}},
    {0, 2, {2, 3}},
    {1, 1, {FP_OUTPROJ0}},
    {0, 3, {5, 6, 7}},
    {1, 2, {FP_XN1, FP_INPROJ1}},
    {0, 6, {10, 11, 12, 13, 14, 15}},
    {1, 1, {FP_OUTPROJ1}},
    {0, 3, {17, 18, 19}},
};

extern "C" void kernel_launch(void* const* d_in, const int* in_sizes, int n_in, void* d_out, int out_size, void* d_ws, size_t ws_size,
                              hipStream_t stream) {
    Params p{};
    const float** f = (const float**)&p;
    for (int i = 0; i < 24; ++i) f[i] = (const float*)d_in[i];
    p.out = (float*)d_out;
    const size_t need = carve(p, d_ws);
    static int grid = 0;
    if (grid == 0) {
        int dev = 0, cus = 0, per_cu = 0;
        if (hipGetDevice(&dev) != hipSuccess || hipDeviceGetAttribute(&cus, hipDeviceAttributeMultiprocessorCount, dev) != hipSuccess) { grid = -1; return; }
        if (hipFuncSetAttribute((const void*)k_fast, hipFuncAttributeMaxDynamicSharedMemorySize, LDS_BYTES) != hipSuccess) { fprintf(stderr, "hipFuncSetAttribute failed\n"); grid = -1; return; }
        if (hipOccupancyMaxActiveBlocksPerMultiprocessor(&per_cu, (const void*)k_fast, NWAVES * 64, LDS_BYTES) != hipSuccess || per_cu < 1) { fprintf(stderr, "occupancy query: %d\n", per_cu); (void)hipGetLastError(); grid = -1; return; }
        grid = cus;
        if (need > ws_size) { fprintf(stderr, "workspace too small: need %zu have %zu\n", need, ws_size); grid = -1; return; }
    }
    if (grid < 0) return;
    (void)hipMemsetAsync(d_ws, 0, CTL_ZERO_BYTES, stream);
    int li = 0;
    for (const Step& st : PLAN) {
        if (st.fast) {
            FArgs a{}; a.p = p; a.li = li++;
            for (int i = 0; i < st.n; ++i) a.mask |= 1ull << st.ph[i];
            hipLaunchKernelGGL(k_fast, dim3(grid), dim3(NWAVES * 64), LDS_BYTES, stream, a);
        } else {
            for (int i = 0; i < st.n; ++i) hipLaunchKernelGGL(k_naive, dim3(2048), dim3(256), 0, stream, p, st.ph[i]);
        }
    }
}
```

```cpp
#include <hip/hip_runtime.h>
#include <cstdio>
#include <cstdint>
#define DEV __device__ __forceinline__

#ifndef NB
#define NB 8
#endif
typedef unsigned short bf16;
constexpr int S = 2048, D = 1024, T = NB * S, HD = 64;
constexpr int EVEN_IN = 2304, ODD_IN = 2840, LDP = 3072;
constexpr int NCMP = 127, NSLC = 32;
constexpr float NEG = -1e30f;
constexpr float EPS = 1e-6f;
constexpr int RMAX = 2 * T + 32 * 256;

DEV float u2f(unsigned u) { return __builtin_bit_cast(float, u); }
DEV unsigned f2u(float f) { return __builtin_bit_cast(unsigned, f); }
DEV float bf2f(bf16 h) { return u2f(((unsigned)h) << 16); }
DEV bf16 f2bf(float f) { unsigned u = f2u(f); u += 0x7fffu + ((u >> 16) & 1u); return (bf16)(u >> 16); }

struct Params {
    const float *x, *ev_norm, *ev_w_in, *ev_q_norm, *ev_k_norm, *ev_sink, *ev_w_out;
    const float *od_norm, *od_w_in, *od_c_q_norm, *od_c_k_norm, *od_d_q_norm, *od_d_k_norm, *od_cmp_pos, *od_cmp_w, *od_w_out;
    const float *moe_norm, *moe_w_grp, *moe_b_grp, *moe_w_exp, *moe_b_exp, *moe_w_gate, *moe_w_up, *moe_w_down;
    float* out;
    unsigned* ctl;
    bf16 *win0t, *wout0t, *win1t, *wout1t, *wgut, *wdt;
    bf16* proj;
    bf16* xn;
    bf16* o;
    bf16* ha;
    bf16* hid;
    float* rstd;
    int* eid;
    float* ew;
    float* hmid;
    float* kmean;
    bf16* kvcmp;
    float* ocmp;
    float* cml;
    float* pslc;
    unsigned* selmask;
    int* rowtok;
    int* pos;
    bf16* wr;
};

DEV void load64(const bf16* p, float (&q)[64]) {
#pragma unroll
    for (int d = 0; d < 64; ++d) q[d] = bf2f(p[d]);
}
DEV float dot64(const float (&q)[64], const bf16* k) {
    float s = 0.f;
#pragma unroll
    for (int d = 0; d < 64; ++d) s += q[d] * bf2f(k[d]);
    return s;
}
DEV float dot64f(const float (&q)[64], const float* k) {
    float s = 0.f;
#pragma unroll
    for (int d = 0; d < 64; ++d) s += q[d] * k[d];
    return s;
}
DEV void os_update(float sc, const bf16* v, float& m, float& l, float (&o)[64]) {
    if (sc > m) {
        float f = expf(m - sc);
        l *= f;
#pragma unroll
        for (int d = 0; d < 64; ++d) o[d] *= f;
        m = sc;
    }
    float p = expf(sc - m);
    l += p;
#pragma unroll
    for (int d = 0; d < 64; ++d) o[d] += p * bf2f(v[d]);
}
DEV float slope_of(int hh) { return exp2f(-(float)(hh + 1)); }

DEV void ph_rstd(const float* src, float* rstd, int gtid, int gsz) {
    for (int t = gtid; t < T; t += gsz) {
        const float* r = src + (size_t)t * D;
        float s = 0.f;
        for (int i = 0; i < D; ++i) s += r[i] * r[i];
        rstd[t] = rsqrtf(s * (1.0f / D) + EPS);
    }
}

DEV void ph_gemm_in(const float* src, const float* rstd, const float* g, const float* W, int N, bf16* proj, int gtid, int gsz) {
    const long total = (long)T * N;
    for (long i = gtid; i < total; i += gsz) {
        const int t = (int)(i / N), n = (int)(i % N);
        const float* a = src + (size_t)t * D;
        float acc = 0.f;
        for (int k = 0; k < D; ++k) acc += a[k] * g[k] * W[(size_t)k * N + n];
        proj[(size_t)t * LDP + n] = f2bf(acc * rstd[t]);
    }
}

DEV void headnorm_inplace(bf16* p, const float* g) {
    float v[64];
    load64(p, v);
    float s = 0.f;
#pragma unroll
    for (int d = 0; d < 64; ++d) s += v[d] * v[d];
    const float r = rsqrtf(s * (1.0f / 64) + EPS);
#pragma unroll
    for (int d = 0; d < 64; ++d) p[d] = f2bf(v[d] * r * g[d]);
}

DEV void ph_headnorm0(const Params& P, int gtid, int gsz) {
    const long total = (long)T * 10;
    for (long i = gtid; i < total; i += gsz) {
        const int t = (int)(i / 10), h = (int)(i % 10);
        bf16* row = P.proj + (size_t)t * LDP;
        if (h < 8) headnorm_inplace(row + h * 64, P.ev_q_norm);
        else headnorm_inplace(row + 512 + (h - 8) * 64, P.ev_k_norm);
    }
}

DEV void ph_headnorm1(const Params& P, int gtid, int gsz) {
    const long total = (long)T * 28;
    for (long i = gtid; i < total; i += gsz) {
        const int t = (int)(i / 28), h = (int)(i % 28);
        bf16* row = P.proj + (size_t)t * LDP;
        if (h < 8) headnorm_inplace(row + h * 64, P.od_c_q_norm);
        else if (h < 16) headnorm_inplace(row + 512 + (h - 8) * 64, P.od_c_k_norm);
        else if (h < 24) headnorm_inplace(row + 1536 + (h - 16) * 64, P.od_d_q_norm);
        else if (h < 26) headnorm_inplace(row + 2304 + (h - 24) * 64, P.od_d_k_norm + 64);
        else headnorm_inplace(row + 2560 + (h - 26) * 64, P.od_d_k_norm + 128);
    }
}

DEV void ph_attn0(const Params& P, int gtid, int gsz) {
    const long total = (long)T * 16;
    for (long i = gtid; i < total; i += gsz) {
        const int hh = (int)(i / T), t = (int)(i % T);
        const int b = t / S, s = t % S;
        const bf16* base = P.proj + (size_t)b * S * LDP;
        float q[64], o[64];
#pragma unroll
        for (int d = 0; d < 64; ++d) o[d] = 0.f;
        if (hh < 8) {
            const int kvh = hh >> 2;
            load64(base + (size_t)s * LDP + hh * 64, q);
            const float sl = slope_of(hh);
            float m = NEG, l = 0.f;
            const int s0 = s - 127 < 0 ? 0 : s - 127;
            for (int sp = s0; sp <= s; ++sp) {
                const bf16* kr = base + (size_t)sp * LDP + 512 + kvh * 64;
                const float sc = dot64(q, kr) * 0.125f - sl * (float)(s - sp);
                os_update(sc, kr + 128, m, l, o);
            }
            const float sk = P.ev_sink[hh];
            const float mx = m > sk ? m : sk;
            const float scale = expf(m - mx);
            const float den = l * scale + expf(sk - mx);
            const float f = scale / den;
            bf16* op = P.o + (size_t)t * D + hh * 64;
#pragma unroll
            for (int d = 0; d < 64; ++d) op[d] = f2bf(o[d] * f);
        } else {
            const int h = hh - 8;
            load64(base + (size_t)s * LDP + 768 + h * 64, q);
            float acc = 0.f;
            for (int sp = s - 1; sp >= 0; --sp) {
                const bf16* kr = base + (size_t)sp * LDP + 1280 + h * 64;
                const float z = dot64(q, kr) * 0.125f;
                const float ls = (z < 0.f ? z : 0.f) - log1pf(expf(-fabsf(z)));
                const float a = expf(ls + acc);
                const bf16* vr = kr + 512;
#pragma unroll
                for (int d = 0; d < 64; ++d) o[d] += a * bf2f(vr[d]);
                acc += ls - z;
                if (acc < -110.f) break;
            }
            bf16* op = P.o + (size_t)t * D + 512 + h * 64;
#pragma unroll
            for (int d = 0; d < 64; ++d) op[d] = f2bf(o[d]);
        }
    }
}

DEV void ph_gemm_out(const bf16* o, const float* W, const float* resid, float* out, int gtid, int gsz) {
    const long total = (long)T * D;
    for (long i = gtid; i < total; i += gsz) {
        const int t = (int)(i / D), c = (int)(i % D);
        const bf16* a = o + (size_t)t * D;
        float acc = 0.f;
        for (int k = 0; k < D; ++k) acc += bf2f(a[k]) * W[(size_t)k * D + c];
        out[i] = resid[i] + acc;
    }
}

DEV void ph_moe_route(const Params& P, int layer, int gtid, int gsz) {
    const float* g = P.moe_norm + layer * D;
    const float* wgrp = P.moe_w_grp + (size_t)layer * D * 4;
    const float* wexp = P.moe_w_exp + (size_t)layer * D * 32;
    const float* bgrp = P.moe_b_grp + layer * 4;
    const float* bexp = P.moe_b_exp + layer * 32;
    for (int t = gtid; t < T; t += gsz) {
        const float* r = P.out + (size_t)t * D;
        float ss = 0.f;
        for (int k = 0; k < D; ++k) ss += r[k] * r[k];
        const float rs = rsqrtf(ss * (1.0f / D) + EPS);
        P.rstd[t] = rs;
        float lg[4], le[32];
#pragma unroll
        for (int j = 0; j < 4; ++j) lg[j] = 0.f;
#pragma unroll
        for (int j = 0; j < 32; ++j) le[j] = 0.f;
        for (int k = 0; k < D; ++k) {
            const float h = r[k] * rs * g[k];
#pragma unroll
            for (int j = 0; j < 4; ++j) lg[j] += h * wgrp[k * 4 + j];
#pragma unroll
            for (int j = 0; j < 32; ++j) le[j] += h * wexp[k * 32 + j];
        }
#pragma unroll
        for (int j = 0; j < 4; ++j) lg[j] += bgrp[j];
#pragma unroll
        for (int j = 0; j < 32; ++j) le[j] += bexp[j];
        int gs = 0; float gm = lg[0];
#pragma unroll
        for (int j = 1; j < 4; ++j) if (lg[j] > gm) { gm = lg[j]; gs = j; }
        float gz = 0.f;
#pragma unroll
        for (int j = 0; j < 4; ++j) gz += expf(lg[j] - gm);
        const float pg = 1.0f / gz;
        float w[8];
#pragma unroll
        for (int j = 0; j < 8; ++j) w[j] = gs == 0 ? le[j] : gs == 1 ? le[8 + j] : gs == 2 ? le[16 + j] : le[24 + j];
        int i1 = 0; float m1 = w[0];
#pragma unroll
        for (int j = 1; j < 8; ++j) if (w[j] > m1) { m1 = w[j]; i1 = j; }
        int i2 = -1; float m2 = -3e38f;
#pragma unroll
        for (int j = 0; j < 8; ++j) if (j != i1 && w[j] > m2) { m2 = w[j]; i2 = j; }
        const float e2 = expf(m2 - m1);
        const float w1 = pg / (1.0f + e2), w2 = pg * e2 / (1.0f + e2);
        P.eid[t * 2 + 0] = gs * 8 + i1; P.eid[t * 2 + 1] = gs * 8 + i2;
        P.ew[t * 2 + 0] = w1; P.ew[t * 2 + 1] = w2;
    }
}

DEV void ph_moe_hidden(const Params& P, int layer, int gtid, int gsz) {
    const float* g = P.moe_norm + layer * D;
    const long total = (long)T * 512;
    for (long i = gtid; i < total; i += gsz) {
        const int t = (int)(i >> 9), slot = (int)((i >> 8) & 1), f = (int)(i & 255);
        const int e = P.eid[t * 2 + slot];
        const float* wg = P.moe_w_gate + ((size_t)(layer * 32 + e) * D) * 256 + f;
        const float* wu = P.moe_w_up + ((size_t)(layer * 32 + e) * D) * 256 + f;
        const float* r = P.out + (size_t)t * D;
        const float rs = P.rstd[t];
        float a = 0.f, u = 0.f;
        for (int k = 0; k < D; ++k) {
            const float h = r[k] * rs * g[k];
            a += h * wg[(size_t)k * 256];
            u += h * wu[(size_t)k * 256];
        }
        const float sg = a / (1.0f + expf(-a));
        P.hmid[i] = sg * u;
    }
}

DEV void ph_moe_out(const Params& P, int layer, int gtid, int gsz) {
    const long total = (long)T * D;
    for (long i = gtid; i < total; i += gsz) {
        const int t = (int)(i / D), c = (int)(i % D);
        float tot = 0.f;
        for (int slot = 0; slot < 2; ++slot) {
            const int e = P.eid[t * 2 + slot];
            const float* wd = P.moe_w_down + ((size_t)(layer * 32 + e) * 256) * D + c;
            const float* hm = P.hmid + ((size_t)t * 2 + slot) * 256;
            float acc = 0.f;
            for (int f = 0; f < 256; ++f) acc += hm[f] * wd[(size_t)f * D];
            tot += P.ew[t * 2 + slot] * acc;
        }
        P.out[i] += tot;
    }
}

DEV void ph_prep1(const Params& P, int gtid, int gsz) {
    const int n1 = NB * 8 * 8 * 64;
    for (int i = gtid; i < n1; i += gsz) {
        const int d = i & 63, n = (i >> 6) & 7, h = (i >> 9) & 7, b = i >> 12;
        const bf16* kp = P.proj + ((size_t)b * S + n * 256) * LDP + 512 + h * 64 + d;
        float s = 0.f;
        for (int j = 0; j < 256; ++j) s += bf2f(kp[(size_t)j * LDP]);
        P.kmean[i] = s * (1.0f / 256);
    }
    const int n2 = 2 * NB * NCMP * 2;
    for (int i = gtid; i < n2; i += gsz) {
        const int hkv = i & 1; int r = i >> 1; const int n = r % NCMP; r /= NCMP; const int b = r % NB; const int which = r / NB;
        const float* pos = P.od_cmp_pos + which * 32 * 64;
        const float* w = P.od_cmp_w + (size_t)which * 32 * 64 * 64;
        const bf16* xp = P.proj + ((size_t)b * S + n * 16) * LDP + (which ? 2176 : 2048) + hkv * 64;
        float acc[64];
#pragma unroll
        for (int e = 0; e < 64; ++e) acc[e] = 0.f;
        for (int l = 0; l < 32; ++l)
            for (int d = 0; d < 64; ++d) {
                const float xv = bf2f(xp[(size_t)l * LDP + d]) + pos[l * 64 + d];
                const float* wr = w + ((size_t)l * 64 + d) * 64;
#pragma unroll
                for (int e = 0; e < 64; ++e) acc[e] += xv * wr[e];
            }
        if (which == 0) {
            float ss = 0.f;
#pragma unroll
            for (int e = 0; e < 64; ++e) ss += acc[e] * acc[e];
            const float rs = rsqrtf(ss * (1.0f / 64) + EPS);
#pragma unroll
            for (int e = 0; e < 64; ++e) acc[e] *= rs * P.od_d_k_norm[e];
        }
        bf16* op = P.kvcmp + (((size_t)(which * NB + b) * NCMP + n) * 2 + hkv) * 64;
#pragma unroll
        for (int e = 0; e < 64; ++e) op[e] = f2bf(acc[e]);
    }
}

DEV int cmp_count(int s) { int c = s >= 31 ? (s - 31) / 16 + 1 : 0; return c > NCMP ? NCMP : c; }

DEV void ph_nsa_cmp(const Params& P, int gtid, int gsz) {
    const long total = (long)T * 8;
    for (long i = gtid; i < total; i += gsz) {
        const int hh = (int)(i / T), t = (int)(i % T);
        const int b = t / S, s = t % S, hkv = hh >> 2;
        float q[64], o[64];
        load64(P.proj + (size_t)t * LDP + 1536 + hh * 64, q);
#pragma unroll
        for (int d = 0; d < 64; ++d) o[d] = 0.f;
        const float sl = slope_of(hh);
        float m = NEG, l = 0.f;
        const int cnt = cmp_count(s);
        const bf16* kc = P.kvcmp + (((size_t)(0 * NB + b) * NCMP) * 2 + hkv) * 64;
        const bf16* vc = P.kvcmp + (((size_t)(1 * NB + b) * NCMP) * 2 + hkv) * 64;
        for (int n = 0; n < cnt; ++n) {
            const float sc = dot64(q, kc + (size_t)n * 128) * 0.125f - sl * (float)(s - (n * 16 + 31));
            os_update(sc, vc + (size_t)n * 128, m, l, o);
        }
        const float inv = cnt > 0 ? 1.0f / l : 0.f;
        float* op = P.ocmp + ((size_t)t * 8 + hh) * 64;
#pragma unroll
        for (int d = 0; d < 64; ++d) op[d] = o[d] * inv;
        P.cml[((size_t)t * 8 + hh) * 2 + 0] = m;
        P.cml[((size_t)t * 8 + hh) * 2 + 1] = l;
    }
}

DEV void ph_nsa_select(const Params& P, int gtid, int gsz) {
    const long total = (long)T * 64;
    for (long i = gtid; i < total; i += gsz) {
        const int j = (int)(i & 31), hkv = (int)((i >> 5) & 1), t = (int)(i >> 6);
        const int b = t / S, s = t % S, cur = s >> 6;
        float score = NEG;
        if (j <= cur) {
            const int cnt = cmp_count(s);
            const bf16* kc = P.kvcmp + (((size_t)(0 * NB + b) * NCMP) * 2 + hkv) * 64;
            float p = 0.f;
            int n0 = 4 * j - 1; if (n0 < 0) n0 = 0;
            int n1 = 4 * j + 3; if (n1 > NCMP - 1) n1 = NCMP - 1;
            for (int g = 0; g < 4; ++g) {
                const int hh = hkv * 4 + g;
                float q[64];
                load64(P.proj + (size_t)t * LDP + 1536 + hh * 64, q);
                const float sl = slope_of(hh);
                const float m = P.cml[((size_t)t * 8 + hh) * 2 + 0], l = P.cml[((size_t)t * 8 + hh) * 2 + 1];
                for (int n = n0; n <= n1; ++n)
                    if (n < cnt) {
                        const float sc = dot64(q, kc + (size_t)n * 128) * 0.125f - sl * (float)(s - (n * 16 + 31));
                        p += expf(sc - m) / l;
                    }
            }
            const bool forced = (j == 0) || (j == cur) || (j == cur - 1);
            score = p + (forced ? 1000.0f : 0.0f);
        }
        P.pslc[i] = score;
    }
}

DEV void ph_nsa_topk(const Params& P, int gtid, int gsz) {
    const int total = T * 2;
    for (int i = gtid; i < total; i += gsz) {
        const int t = i >> 1;
        const int s = t % S, cur = s >> 6;
        const float* sc = P.pslc + (size_t)i * 32;
        unsigned mask = 0;
        for (int j = 0; j <= cur; ++j) {
            const float sj = sc[j];
            int rank = 0;
            for (int k = 0; k < 32; ++k) { const float sk = sc[k]; rank += (sk > sj || (sk == sj && k < j)) ? 1 : 0; }
            if (rank < 16) mask |= 1u << j;
        }
        P.selmask[i] = mask;
    }
}

DEV void ph_attn1(const Params& P, int gtid, int gsz) {
    const long total = (long)T * 16;
    for (long i = gtid; i < total; i += gsz) {
        const int hh = (int)(i / T), t = (int)(i % T);
        const int b = t / S, s = t % S;
        const bf16* base = P.proj + (size_t)b * S * LDP;
        float q[64], o[64];
#pragma unroll
        for (int d = 0; d < 64; ++d) o[d] = 0.f;
        if (hh < 8) {
            const int h = hh, own = s >> 8;
            load64(base + (size_t)s * LDP + h * 64, q);
            const float sl = slope_of(h);
            float gt[8];
#pragma unroll
            for (int n = 0; n < 8; ++n) gt[n] = n < own ? dot64f(q, P.kmean + ((size_t)(b * 8 + h) * 8 + n) * 64) : NEG;
            unsigned sel = 0;
#pragma unroll
            for (int n = 0; n < 8; ++n) {
                int rank = 0;
#pragma unroll
                for (int k = 0; k < 8; ++k) rank += (gt[k] > gt[n] || (gt[k] == gt[n] && k < n)) ? 1 : 0;
                if (rank < 3 && n < own) sel |= 1u << n;
            }
            float m = NEG, l = 0.f;
            for (int n = 0; n < own; ++n) {
                if (!((sel >> n) & 1)) continue;
                for (int kk = 0; kk < 256; ++kk) {
                    const int kp = n * 256 + kk;
                    const bf16* kr = base + (size_t)kp * LDP + 512 + h * 64;
                    const float sc = dot64(q, kr) * 0.125f - sl * (float)(s - kp);
                    os_update(sc, kr + 512, m, l, o);
                }
            }
            for (int kp = own * 256; kp <= s; ++kp) {
                const bf16* kr = base + (size_t)kp * LDP + 512 + h * 64;
                const float sc = dot64(q, kr) * 0.125f - sl * (float)(s - kp);
                os_update(sc, kr + 512, m, l, o);
            }
            const float inv = 1.0f / l;
            bf16* op = P.o + (size_t)t * D + h * 64;
#pragma unroll
            for (int d = 0; d < 64; ++d) op[d] = f2bf(o[d] * inv);
        } else {
            const int h = hh - 8, hkv = h >> 2, cur = s >> 6;
            load64(base + (size_t)s * LDP + 1536 + h * 64, q);
            const float sl = slope_of(h);
            const bf16* grow = base + (size_t)s * LDP + 2816 + h * 3;
            const float g0 = 1.0f / (1.0f + expf(-bf2f(grow[0])));
            const float g1 = 1.0f / (1.0f + expf(-bf2f(grow[1])));
            const float g2 = 1.0f / (1.0f + expf(-bf2f(grow[2])));
            float acc[64];
            const float* oc = P.ocmp + ((size_t)t * 8 + h) * 64;
#pragma unroll
            for (int d = 0; d < 64; ++d) acc[d] = g0 * oc[d];
            const unsigned mask = P.selmask[t * 2 + hkv];
            float m = NEG, l = 0.f;
            for (int j = 0; j <= cur; ++j) {
                if (!((mask >> j) & 1)) continue;
                for (int kk = 0; kk < 64; ++kk) {
                    const int kp = j * 64 + kk;
                    if (kp > s) break;
                    const bf16* kr = base + (size_t)kp * LDP + 2304 + hkv * 64;
                    const float sc = dot64(q, kr) * 0.125f - sl * (float)(s - kp);
                    os_update(sc, kr + 128, m, l, o);
                }
            }
            {
                const float f = g1 / l;
#pragma unroll
                for (int d = 0; d < 64; ++d) { acc[d] += f * o[d]; o[d] = 0.f; }
            }
            m = NEG; l = 0.f;
            const int s0 = s - 511 < 0 ? 0 : s - 511;
            for (int kp = s0; kp <= s; ++kp) {
                const bf16* kr = base + (size_t)kp * LDP + 2560 + hkv * 64;
                const float sc = dot64(q, kr) * 0.125f - sl * (float)(s - kp);
                os_update(sc, kr + 128, m, l, o);
            }
            {
                const float f = g2 / l;
#pragma unroll
                for (int d = 0; d < 64; ++d) acc[d] += f * o[d];
            }
            bf16* op = P.o + (size_t)t * D + 512 + h * 64;
#pragma unroll
            for (int d = 0; d < 64; ++d) op[d] = f2bf(acc[d]);
        }
    }
}

namespace pg8 {
#define PG8_LAS __attribute__((address_space(3)))
typedef unsigned short bf16_t;
typedef short bf16x8 __attribute__((ext_vector_type(8)));
typedef float f32x4 __attribute__((ext_vector_type(4)));
typedef unsigned u32x4 __attribute__((ext_vector_type(4)));
constexpr int BM = 256, BK = 64, HALF = 128, HTB = HALF * BK * 2, STAGE_BYTES = 8 * HTB, NXCD = 8, WGM = 8;

__host__ __device__ __forceinline__ int lds_byte(int r, int c) { const int st = (r >> 4) * 2 + (c >> 5), rr = r & 15, cc = c & 31, ob = rr * 64 + cc * 2; return st * 1024 + (ob ^ (((ob >> 9) & 1) << 5)); }
__host__ __device__ __forceinline__ void stage_rc(int b, int& R, int& C) { const int st = b / 1024, sb = b % 1024, swz = sb ^ (((sb >> 9) & 1) << 5); R = (st >> 1) * 16 + swz / 64; C = (st & 1) * 32 + (swz % 64) / 2; }
__host__ __device__ __forceinline__ int perm32(int rho) { const int n = rho >> 4, i = rho & 15; return 8 * (i >> 2) + 4 * n + (i & 3); }

struct Unit { const char* A; const char* B; int pm, pn; };

struct StaticOrder {
    int nM, nN, nwg, G, c; const char* A; const char* Bt; size_t tstep;
    __device__ void init(const bf16_t* A_, const bf16_t* Bt_, int M, int N, int K, int G_, int c_) { nM = M / BM; nN = N / BM; nwg = nM * nN; G = G_; c = c_; A = (const char*)A_; Bt = (const char*)Bt_; tstep = (size_t)BM * K * 2; }
    __device__ bool next(int i, Unit& u) const {
        const long L = (long)i * G + c; if (L >= nwg) return false;
        int wgid = (int)L; { const int q = nwg / NXCD, r = nwg % NXCD, xcd = wgid % NXCD, off = wgid / NXCD; wgid = (xcd < r ? xcd * (q + 1) : r * (q + 1) + (xcd - r) * q) + off; }
        const int nig = WGM * nN, gid = wgid / nig, fm = gid * WGM, gsz = (nM - fm) < WGM ? (nM - fm) : WGM;
        u.pm = fm + ((wgid % nig) % gsz); u.pn = (wgid % nig) / gsz; u.A = A + (size_t)u.pm * tstep; u.B = Bt + (size_t)u.pn * tstep; return true;
    }
};

__device__ __forceinline__ unsigned cvt_pk_bf16(float lo, float hi) { unsigned r; asm volatile("v_cvt_pk_bf16_f32 %0, %1, %2" : "=v"(r) : "v"(lo), "v"(hi)); return r; }

struct EpiStoreBf16 {
    static constexpr bool PERM = true;
    bf16_t* O; int ldc;
    __device__ __forceinline__ void operator()(const f32x4 (&acc)[2][2][4][2], const Unit& u, int wr, int wc, int fr, int fq) const {
        const int row0 = u.pm * BM + wr * 64 + fr, col0 = u.pn * BM + wc * 32 + 8 * fq;
#pragma unroll
        for (int ai = 0; ai < 2; ++ai)
#pragma unroll
            for (int m = 0; m < 4; ++m) { bf16_t* rowp = O + (size_t)(row0 + ai * HALF + m * 16) * ldc + col0;
#pragma unroll
                for (int bj = 0; bj < 2; ++bj) { const f32x4 v0 = acc[ai][bj][m][0], v1 = acc[ai][bj][m][1];
                    u32x4 w; w.x = cvt_pk_bf16(v0[0], v0[1]); w.y = cvt_pk_bf16(v0[2], v0[3]); w.z = cvt_pk_bf16(v1[0], v1[1]); w.w = cvt_pk_bf16(v1[2], v1[3]);
                    *(u32x4*)(rowp + bj * HALF) = w; } }
    }
};
struct EpiResidF32 {
    static constexpr bool PERM = true;
    const float* R; float* O; int ldc;
    __device__ __forceinline__ void operator()(const f32x4 (&acc)[2][2][4][2], const Unit& u, int wr, int wc, int fr, int fq) const {
        const int row0 = u.pm * BM + wr * 64 + fr, col0 = u.pn * BM + wc * 32 + 8 * fq;
#pragma unroll
        for (int ai = 0; ai < 2; ++ai)
#pragma unroll
            for (int m = 0; m < 4; ++m) { const size_t ro = (size_t)(row0 + ai * HALF + m * 16) * ldc + col0;
#pragma unroll
                for (int bj = 0; bj < 2; ++bj) {
                    const f32x4 r0 = *(const f32x4*)(R + ro + bj * HALF), r1 = *(const f32x4*)(R + ro + bj * HALF + 4);
                    *(f32x4*)(O + ro + bj * HALF) = r0 + acc[ai][bj][m][0]; *(f32x4*)(O + ro + bj * HALF + 4) = r1 + acc[ai][bj][m][1]; } }
    }
};
struct EpiSiluMul {
    static constexpr bool PERM = true;
    bf16_t* H; int ldh;
    __device__ __forceinline__ void operator()(const f32x4 (&acc)[2][2][4][2], const Unit& u, int wr, int wc, int fr, int fq) const {
        const int row0 = u.pm * BM + wr * 64 + fr, col0 = u.pn * HALF + wc * 32 + 8 * fq;
#pragma unroll
        for (int ai = 0; ai < 2; ++ai)
#pragma unroll
            for (int m = 0; m < 4; ++m) { bf16_t* rowp = H + (size_t)(row0 + ai * HALF + m * 16) * ldh + col0;
                float h[8];
#pragma unroll
                for (int n = 0; n < 2; ++n)
#pragma unroll
                    for (int j = 0; j < 4; ++j) { const float g = acc[ai][0][m][n][j], up = acc[ai][1][m][n][j]; h[n * 4 + j] = g * up / (1.0f + __expf(-g)); }
                u32x4 w; w.x = cvt_pk_bf16(h[0], h[1]); w.y = cvt_pk_bf16(h[2], h[3]); w.z = cvt_pk_bf16(h[4], h[5]); w.w = cvt_pk_bf16(h[6], h[7]);
                *(u32x4*)rowp = w; }
    }
};

template <class Epi, class Sched>
__device__ __forceinline__ void gemm_phase(PG8_LAS unsigned char* lds, const int K, const Sched& S, const Epi& E, const int tid) {
    const int wid = __builtin_amdgcn_readfirstlane(tid >> 6), lane = tid & 63, wr = wid >> 2, wc = wid & 3, fr = lane & 15, fq = lane >> 4;
    const int nt = K / BK;
    unsigned voffA[2], voffB[2];
#pragma unroll
    for (int i = 0; i < 2; ++i) { int R, C; stage_rc(tid * 16 + i * 8192, R, C); const int Rb = Epi::PERM ? ((R & ~31) + perm32(R & 31)) : R;
        voffA[i] = (unsigned)(R * K + C) * 2u; voffB[i] = (unsigned)(Rb * K + C) * 2u; }
    const size_t kstep = (size_t)(BK * 2);
    const size_t hstep = (size_t)HALF * K * 2;
    const unsigned ldsw = (unsigned)wid * 1024u;
    const int aoff = lds_byte(wr * 64 + fr, fq * 8), boff = lds_byte(wc * 32 + fr, fq * 8);
#define PG8_SA(b, h) (((b) * 2 + (h)) * HTB)
#define PG8_SB(b, h) ((4 + (b) * 2 + (h)) * HTB)
#define PG8_STAGE(bufoff, gbase, voff) do { _Pragma("unroll") for (int _i = 0; _i < 2; ++_i) \
        __builtin_amdgcn_global_load_lds((const unsigned*)((const char*)(gbase) + (voff)[_i]), (PG8_LAS unsigned*)(lds + (bufoff) + ldsw + _i * 8192), 16, 0, 0); } while (0)
#define PG8_LDA(dst, b, h) do { _Pragma("unroll") for (int m = 0; m < 4; ++m) _Pragma("unroll") for (int k = 0; k < 2; ++k) dst[m][k] = *(const PG8_LAS bf16x8*)(lds + PG8_SA(b, h) + aoff + m * 2048 + k * 1024); } while (0)
#define PG8_LDB(dst, b, h) do { _Pragma("unroll") for (int n = 0; n < 2; ++n) _Pragma("unroll") for (int k = 0; k < 2; ++k) dst[n][k] = *(const PG8_LAS bf16x8*)(lds + PG8_SB(b, h) + boff + n * 2048 + k * 1024); } while (0)
#define PG8_MMA(ai, bj, At, Bt) do { __builtin_amdgcn_s_setprio(1); _Pragma("unroll") for (int m = 0; m < 4; ++m) _Pragma("unroll") for (int n = 0; n < 2; ++n) _Pragma("unroll") for (int k = 0; k < 2; ++k) \
        acc[ai][bj][m][n] = __builtin_amdgcn_mfma_f32_16x16x32_bf16(Bt[n][k], At[m][k], acc[ai][bj][m][n], 0, 0, 0); __builtin_amdgcn_s_setprio(0); } while (0)
#define PG8_WAIT_V(n) asm volatile("s_waitcnt vmcnt(" #n ")" ::: "memory")
#define PG8_WAIT_L(n) asm volatile("s_waitcnt lgkmcnt(" #n ")" ::: "memory")
#define PG8_BAR __builtin_amdgcn_s_barrier()
#define PG8_SCHED __builtin_amdgcn_sched_barrier(0)
    Unit cur, nxt; int ui = 0;
    if (!S.next(0, cur)) return;
    f32x4 acc[2][2][4][2];
#pragma unroll
    for (int a = 0; a < 2; ++a)
#pragma unroll
        for (int b = 0; b < 2; ++b)
#pragma unroll
            for (int m = 0; m < 4; ++m)
#pragma unroll
                for (int n = 0; n < 2; ++n) acc[a][b][m][n] = (f32x4){0.f, 0.f, 0.f, 0.f};
    bf16x8 At[4][2], B0[2][2], B1[2][2];
    const char* cA = cur.A; const char* cB = cur.B;
    PG8_STAGE(PG8_SB(0, 0), cB, voffB); PG8_STAGE(PG8_SB(0, 1), cB + hstep, voffB); PG8_STAGE(PG8_SA(0, 0), cA, voffA); PG8_STAGE(PG8_SA(0, 1), cA + hstep, voffA);
    if (wr == 1) PG8_BAR;
    PG8_WAIT_V(2); PG8_BAR;
    PG8_STAGE(PG8_SB(1, 0), cB + kstep, voffB); PG8_STAGE(PG8_SA(1, 0), cA + kstep, voffA); PG8_STAGE(PG8_SB(1, 1), cB + hstep + kstep, voffB);
    PG8_WAIT_V(6); PG8_BAR;
    for (;;) {
        const bool has_next = S.next(ui + 1, nxt);
        const char* nA = has_next ? nxt.A : cA; const char* nB = has_next ? nxt.B : cB;
        for (int t = 0; t < nt; t += 2) {
            const bool last = (t == nt - 2);
            const char* a1 = cA + (size_t)(t + 1) * kstep;
            const char* a2 = last ? nA : cA + (size_t)(t + 2) * kstep; const char* b2 = last ? nB : cB + (size_t)(t + 2) * kstep;
            const char* a3 = a2 + kstep; const char* b3 = b2 + kstep;
            PG8_LDB(B0, 0, 0); PG8_LDB(B1, 0, 1); PG8_SCHED; PG8_LDA(At, 0, 0); PG8_STAGE(PG8_SA(1, 1), a1 + hstep, voffA);
            PG8_WAIT_V(8); PG8_WAIT_L(0); PG8_BAR; PG8_MMA(0, 0, At, B0); PG8_MMA(0, 1, At, B1); PG8_BAR; PG8_SCHED;
            PG8_LDA(At, 0, 1); PG8_STAGE(PG8_SB(0, 0), b2, voffB); PG8_STAGE(PG8_SB(0, 1), b2 + hstep, voffB); PG8_STAGE(PG8_SA(0, 0), a2, voffA);
            PG8_WAIT_V(8); PG8_WAIT_L(0); PG8_BAR; PG8_MMA(1, 0, At, B0); PG8_MMA(1, 1, At, B1); PG8_BAR; PG8_SCHED;
            PG8_LDB(B0, 1, 0); PG8_LDB(B1, 1, 1); PG8_SCHED; PG8_LDA(At, 1, 0); PG8_STAGE(PG8_SA(0, 1), a2 + hstep, voffA);
            PG8_WAIT_V(8); PG8_WAIT_L(0); PG8_BAR; PG8_MMA(0, 0, At, B0); PG8_MMA(0, 1, At, B1); PG8_BAR; PG8_SCHED;
            PG8_LDA(At, 1, 1); PG8_STAGE(PG8_SB(1, 0), b3, voffB); PG8_STAGE(PG8_SB(1, 1), b3 + hstep, voffB); PG8_STAGE(PG8_SA(1, 0), a3, voffA);
            PG8_WAIT_V(8); PG8_WAIT_L(0); PG8_BAR; PG8_MMA(1, 0, At, B0); PG8_MMA(1, 1, At, B1); PG8_BAR; PG8_SCHED;
        }
        if (wr == 0) PG8_BAR;
        { int fr2 = lane & 15, fq2 = lane >> 4; asm volatile("" : "+v"(fr2), "+v"(fq2)); E(acc, cur, wr, wc, fr2, fq2); }
        if (!has_next) break;
#pragma unroll
        for (int a = 0; a < 2; ++a)
#pragma unroll
            for (int b = 0; b < 2; ++b)
#pragma unroll
                for (int m = 0; m < 4; ++m)
#pragma unroll
                    for (int n = 0; n < 2; ++n) acc[a][b][m][n] = (f32x4){0.f, 0.f, 0.f, 0.f};
        cur = nxt; cA = nA; cB = nB; ++ui;
        if (wr == 1) PG8_BAR;
    }
    PG8_WAIT_V(0);
    PG8_BAR;
#undef PG8_SA
#undef PG8_SB
#undef PG8_STAGE
#undef PG8_LDA
#undef PG8_LDB
#undef PG8_MMA
#undef PG8_WAIT_V
#undef PG8_WAIT_L
#undef PG8_BAR
#undef PG8_SCHED
}
}

#define GAS __attribute__((address_space(1)))
#define LAS __attribute__((address_space(3)))
typedef unsigned v4u __attribute__((ext_vector_type(4)));
typedef float f32x4 __attribute__((ext_vector_type(4)));
typedef short bf16x8 __attribute__((ext_vector_type(8)));
constexpr int NWAVES = 8;
constexpr int RING_BYTES = 131072, LDSCTL_OFF = RING_BYTES, MISC_OFF = LDSCTL_OFF + 320, LDS_BYTES = 147456;
constexpr size_t MiB = 1u << 20;
constexpr size_t CTL_ZERO_BYTES = 1 * MiB;
constexpr int CW_BAR = 4096;
constexpr int CW_MOE = 65536;
#define LDS_WAIT() asm volatile("s_waitcnt lgkmcnt(0)" ::: "memory")
#define VM_WAIT() asm volatile("s_waitcnt vmcnt(0)" ::: "memory")
DEV unsigned pk2(float lo, float hi) { return (unsigned)f2bf(lo) | ((unsigned)f2bf(hi) << 16); }

#define XB_TMO      128
#define XB_XCNT(j)  (256  + 64 * (j))
#define XB_XSUB(j)  (1280 + 64 * (j))
#define XB_XGEN(j)  (2304 + 64 * (j))
#define XB_TOP      3328
#define XB_TOPGEN   3392
#define XCD_BAR_WORDS 3456
#define XB_SPIN_CAP (1u << 22)
DEV unsigned xb_ld(unsigned* p)              { return __hip_atomic_load(p, __ATOMIC_RELAXED, __HIP_MEMORY_SCOPE_AGENT); }
DEV unsigned xb_add(unsigned* p, unsigned v) { return __hip_atomic_fetch_add(p, v, __ATOMIC_RELAXED, __HIP_MEMORY_SCOPE_AGENT); }
DEV unsigned xb_xcc_id() { return (unsigned)__builtin_amdgcn_s_getreg((3 << 11) | 20) & 0xFu; }
#define XB_SPIN(cond, bar) do { unsigned _sp = 0; while (cond) { __builtin_amdgcn_s_sleep(1); \
    if ((++_sp & 255u) == 0u) { if (xb_ld(&(bar)[XB_TMO])) break; if (_sp > XB_SPIN_CAP) { atomicAdd(&(bar)[XB_TMO], 1u); break; } } } } while (0)
struct XcdBarrier { unsigned* bar; unsigned x; volatile LAS unsigned* st; };
DEV XcdBarrier xcd_barrier_post(unsigned* bar, volatile LAS unsigned* st) {
    XcdBarrier b; b.bar = bar; b.x = xb_xcc_id(); b.st = st;
    if (threadIdx.x == 0) (void)xb_add(&bar[XB_XCNT(b.x)], 1u);
    return b;
}
DEV void xcd_barrier_complete(unsigned* bar, unsigned x, unsigned& nloc, unsigned& nx) {
    const unsigned G = gridDim.x * gridDim.y * gridDim.z;
    unsigned sum, cnt, mine, sp = 0u;
    for (;;) {
        sum = 0u; cnt = 0u; mine = 0u;
#pragma unroll
        for (unsigned j = 0; j < 16; ++j) { const unsigned c = xb_ld(&bar[XB_XCNT(j)]); sum += c; cnt += (c > 0u) ? 1u : 0u; mine = (j == x) ? c : mine; }
        if (sum == G) break;
        __builtin_amdgcn_s_sleep(1);
        if ((++sp & 255u) == 0u) { if (xb_ld(&bar[XB_TMO])) break; if (sp > XB_SPIN_CAP) { atomicAdd(&bar[XB_TMO], 1u); break; } }
    }
    nloc = mine > 0u ? mine : 1u; nx = cnt > 0u ? cnt : 1u;
}
DEV void xcd_barrier(const XcdBarrier& b, const int tid_) {
    asm volatile("s_waitcnt vmcnt(0)" ::: "memory");
    __syncthreads();
    if (tid_ == 0) {
        unsigned* bar = b.bar;
        __builtin_amdgcn_s_waitcnt(0);
        unsigned nloc = b.st[0], nx = b.st[1];
        if (nloc == 0u) { xcd_barrier_complete(bar, b.x, nloc, nx); b.st[0] = nloc; b.st[1] = nx; }
        const unsigned old = xb_add(&bar[XB_XSUB(b.x)], 1u);
        const unsigned gen = old / nloc;
        if (old + 1u == (gen + 1u) * nloc) {
            __builtin_amdgcn_fence(__ATOMIC_RELEASE, "agent");
            asm volatile("s_waitcnt vmcnt(0)" ::: "memory");
            const unsigned og = xb_add(&bar[XB_TOP], 1u);
            const unsigned tg = og / nx;
            if (og + 1u == (tg + 1u) * nx) xb_add(&bar[XB_TOPGEN], 1u);
            else XB_SPIN(xb_ld(&bar[XB_TOPGEN]) == tg, bar);
            __builtin_amdgcn_fence(__ATOMIC_ACQUIRE, "agent");
            xb_add(&bar[XB_XGEN(b.x)], 1u);
            asm volatile("s_waitcnt vmcnt(0)" ::: "memory");
        } else {
            XB_SPIN(xb_ld(&bar[XB_XGEN(b.x)]) == gen, bar);
            __builtin_amdgcn_fence(__ATOMIC_ACQUIRE, "agent");
            asm volatile("s_waitcnt vmcnt(0)" ::: "memory");
        }
    }
    __syncthreads();
}

struct Frame {
    LAS unsigned char* lds;
    volatile LAS unsigned* MISC;
    int tid, lane, wave;
    int vcu, G;
};

DEV void refresh(Frame& F) { int l; asm volatile("v_mbcnt_lo_u32_b32 %0, -1, 0\n\tv_mbcnt_hi_u32_b32 %0, -1, %0" : "=v"(l)); F.lane = l; F.tid = F.wave * 64 + l; }
DEV float wave_sum(float v) {
#pragma unroll
    for (int o = 1; o < 64; o <<= 1) v += __shfl_xor(v, o);
    return v;
}
DEV void transpose_item(const float* W, int K, int N, bf16* WT, int k0, int n0, int dst_row0, LAS float* scr, int lane) {
    const bool okc = (n0 + (lane & 31)) < N;
#pragma unroll 8
    for (int i = 0; i < 32; ++i) { const int kk = 2 * i + (lane >> 5); scr[kk * 33 + (lane & 31)] = okc ? W[(size_t)(k0 + kk) * N + n0 + (lane & 31)] : 0.f; }
    LDS_WAIT(); asm volatile("" ::: "memory");
    const int c = lane & 7;
#pragma unroll
    for (int j = 0; j < 4; ++j) { const int n = (lane >> 3) + 8 * j; const LAS float* s = scr + (8 * c) * 33 + n;
        v4u o; o.x = pk2(s[0 * 33], s[1 * 33]); o.y = pk2(s[2 * 33], s[3 * 33]); o.z = pk2(s[4 * 33], s[5 * 33]); o.w = pk2(s[6 * 33], s[7 * 33]);
        if (n0 + n < N) *(GAS v4u*)(WT + (size_t)(dst_row0 + n) * K + k0 + 8 * c) = o; }
    LDS_WAIT(); asm volatile("" ::: "memory");
}
DEV float rms_row_to_bf16(int lane, const float* xrow, const float* gain, bf16* orow) {
    const GAS f32x4* xr = (const GAS f32x4*)xrow + lane;
    const GAS f32x4* gr = (const GAS f32x4*)gain + lane;
    f32x4 v[4]; float s = 0.f;
#pragma unroll
    for (int j = 0; j < 4; ++j) { v[j] = xr[64 * j]; s += (v[j].x * v[j].x + v[j].y * v[j].y) + (v[j].z * v[j].z + v[j].w * v[j].w); }
    const float rstd = 1.0f / sqrtf(wave_sum(s) * (1.f / D) + EPS);
    GAS unsigned long long* o8 = (GAS unsigned long long*)orow + lane;
#pragma unroll
    for (int j = 0; j < 4; ++j) { const f32x4 g = gr[64 * j];
        o8[64 * j] = (unsigned long long)pk2(v[j].x * rstd * g.x, v[j].y * rstd * g.y) | ((unsigned long long)pk2(v[j].z * rstd * g.z, v[j].w * rstd * g.w) << 32); }
    return rstd;
}

DEV void fp_convert_weights(const Params& P, Frame& F, int which) {
    LAS float* scr = (LAS float*)(F.lds + F.wave * 16384);
    const int gw = F.vcu * NWAVES + F.wave, NGW = F.G * NWAVES;
    if (which == 0) {
        constexpr int I_IN0 = 16 * 72, I_OUT = 16 * 32, I_IN1 = 16 * 89;
        constexpr int NIT = I_IN0 + I_OUT + I_IN1 + I_OUT;
        for (int it = gw; it < NIT; it += NGW) {
            int r = it;
            if (r < I_IN0) { const int kb = r / 72, nb = r % 72; transpose_item(P.ev_w_in, D, EVEN_IN, P.win0t, 64 * kb, 32 * nb, 32 * nb, scr, F.lane); continue; } r -= I_IN0;
            if (r < I_OUT) { const int kb = r / 32, nb = r % 32; transpose_item(P.ev_w_out, D, D, P.wout0t, 64 * kb, 32 * nb, 32 * nb, scr, F.lane); continue; } r -= I_OUT;
            if (r < I_IN1) { const int kb = r / 89, nb = r % 89; transpose_item(P.od_w_in, D, ODD_IN, P.win1t, 64 * kb, 32 * nb, 32 * nb, scr, F.lane); continue; } r -= I_IN1;
            { const int kb = r / 32, nb = r % 32; transpose_item(P.od_w_out, D, D, P.wout1t, 64 * kb, 32 * nb, 32 * nb, scr, F.lane); }
        }
    } else {
        const int layer = which - 1;
        constexpr int NIT = 32 * 384;
        for (int it = gw; it < NIT; it += NGW) {
            const int e = it / 384; int r = it % 384;
            const size_t eo = (size_t)(layer * 32 + e);
            if (r < 256) { const bool up = r >= 128; r &= 127; const int kb = r / 8, nb = r % 8; const int f0 = 32 * nb;
                const float* W = (up ? P.moe_w_up : P.moe_w_gate) + eo * D * 256;
                transpose_item(W, D, 256, P.wgut + (size_t)e * 512 * D, 64 * kb, f0, (f0 >> 7) * 256 + (up ? 128 : 0) + (f0 & 127), scr, F.lane);
            } else { r -= 256; const int kb = r / 32, nb = r % 32;
                transpose_item(P.moe_w_down + eo * 256 * D, 256, D, P.wdt + (size_t)e * D * 256, 64 * kb, 32 * nb, 32 * nb, scr, F.lane); }
        }
    }
}
DEV void fp_norm_rows(Frame& F, const float* src, const float* gain, bf16* xn) {
    const int gw = F.vcu * NWAVES + F.wave, NGW = F.G * NWAVES;
    for (int m = gw; m < T; m += NGW) rms_row_to_bf16(F.lane, src + (size_t)m * D, gain, xn + (size_t)m * D);
}

constexpr int TAB_OFF = MISC_OFF + 128;
constexpr int RT_PART_OFF = 0;
constexpr int RT_SS_OFF = 24576;
constexpr int RT_HIST_OFF = 25088;
typedef float f32x4v __attribute__((ext_vector_type(4)));

DEV void fp_prep_router(const Params& P, Frame& F) {
    const int gtid = F.vcu * NWAVES * 64 + F.tid, gsz = F.G * NWAVES * 64;
    for (int i = gtid; i < 2 * 48 * D; i += gsz) {
        const int k = i & (D - 1), j = (i >> 10) % 48, l = i / (48 * D);
        float w = 0.f;
        if (j < 4) w = P.moe_w_grp[((size_t)l * D + k) * 4 + j]; else if (j < 36) w = P.moe_w_exp[((size_t)l * D + k) * 32 + (j - 4)];
        w *= P.moe_norm[l * D + k];
        const bf16 hi = f2bf(w); const bf16 lo = f2bf(w - bf2f(hi));
        P.wr[((size_t)(l * 2 + 0) * 48 + j) * D + k] = hi;
        P.wr[((size_t)(l * 2 + 1) * 48 + j) * D + k] = lo;
    }
}

DEV void fp_route(const Params& P, Frame& F, int layer) {
    const int lane = F.lane, w = F.wave, rg = w & 3, kh = w >> 2;
    const bf16* wr_hi = P.wr + (size_t)(layer * 2 + 0) * 48 * D;
    const bf16* wr_lo = P.wr + (size_t)(layer * 2 + 1) * 48 * D;
    LAS float* part = (LAS float*)(F.lds + RT_PART_OFF);
    LAS float* ssp = (LAS float*)(F.lds + RT_SS_OFF);
    LAS unsigned* hist = (LAS unsigned*)(F.lds + RT_HIST_OFF);
    unsigned* cnt = P.ctl + CW_MOE + layer * 256;
    for (int tb = F.vcu; tb < T / 64; tb += F.G) {
        const int t0 = tb * 64;
        if (F.tid < 64) hist[F.tid] = 0u;
        const float* xrow = P.out + (size_t)(t0 + 16 * rg + (lane & 15)) * D + 512 * kh + 8 * (lane >> 4);
        pg8::f32x4 acc[3];
#pragma unroll
        for (int c = 0; c < 3; ++c) acc[c] = (pg8::f32x4){0.f, 0.f, 0.f, 0.f};
        float ss = 0.f;
        const size_t boff = (size_t)(lane & 15) * D + 512 * kh + 8 * (lane >> 4);
#pragma unroll 4
        for (int ks = 0; ks < 16; ++ks) {
            const f32x4v x0 = *(const f32x4v*)(xrow + 32 * ks), x1 = *(const f32x4v*)(xrow + 32 * ks + 4);
            float xv[8] = {x0.x, x0.y, x0.z, x0.w, x1.x, x1.y, x1.z, x1.w};
            bf16x8 ah, al;
#pragma unroll
            for (int j = 0; j < 8; ++j) { ss += xv[j] * xv[j]; const bf16 h = f2bf(xv[j]); ah[j] = (short)h; al[j] = (short)f2bf(xv[j] - bf2f(h)); }
#pragma unroll
            for (int c = 0; c < 3; ++c) {
                const bf16x8 bh = *(const bf16x8*)(wr_hi + boff + (size_t)16 * c * D + 32 * ks);
                const bf16x8 bl = *(const bf16x8*)(wr_lo + boff + (size_t)16 * c * D + 32 * ks);
                acc[c] = __builtin_amdgcn_mfma_f32_16x16x32_bf16(ah, bh, acc[c], 0, 0, 0);
                acc[c] = __builtin_amdgcn_mfma_f32_16x16x32_bf16(ah, bl, acc[c], 0, 0, 0);
                acc[c] = __builtin_amdgcn_mfma_f32_16x16x32_bf16(al, bh, acc[c], 0, 0, 0);
            }
        }
        ss += __shfl_xor(ss, 16); ss += __shfl_xor(ss, 32);
#pragma unroll
        for (int c = 0; c < 3; ++c)
#pragma unroll
            for (int r = 0; r < 4; ++r) part[(kh * 64 + 16 * rg + 4 * (lane >> 4) + r) * 48 + 16 * c + (lane & 15)] = acc[c][r];
        if (lane < 16) ssp[kh * 64 + 16 * rg + lane] = ss;
        __syncthreads();
        int e1 = 0, e2 = 0; float w1 = 0.f, w2 = 0.f; unsigned r1 = 0, r2 = 0;
        if (F.tid < 64) {
            const int t = t0 + F.tid;
            const float rs = 1.0f / sqrtf((ssp[F.tid] + ssp[64 + F.tid]) * (1.f / D) + EPS);
            P.rstd[t] = rs;
            float lg[4], le[32];
#pragma unroll
            for (int j = 0; j < 4; ++j) lg[j] = (part[F.tid * 48 + j] + part[(64 + F.tid) * 48 + j]) * rs + P.moe_b_grp[layer * 4 + j];
#pragma unroll
            for (int j = 0; j < 32; ++j) le[j] = (part[F.tid * 48 + 4 + j] + part[(64 + F.tid) * 48 + 4 + j]) * rs + P.moe_b_exp[layer * 32 + j];
            int gs = 0; float gm = lg[0];
#pragma unroll
            for (int j = 1; j < 4; ++j) if (lg[j] > gm) { gm = lg[j]; gs = j; }
            float gz = 0.f;
#pragma unroll
            for (int j = 0; j < 4; ++j) gz += expf(lg[j] - gm);
            const float pg = 1.0f / gz;
            float wv[8];
#pragma unroll
            for (int j = 0; j < 8; ++j) wv[j] = gs == 0 ? le[j] : gs == 1 ? le[8 + j] : gs == 2 ? le[16 + j] : le[24 + j];
            int i1 = 0; float m1 = wv[0];
#pragma unroll
            for (int j = 1; j < 8; ++j) if (wv[j] > m1) { m1 = wv[j]; i1 = j; }
            int i2 = -1; float m2 = -3e38f;
#pragma unroll
            for (int j = 0; j < 8; ++j) if (j != i1 && wv[j] > m2) { m2 = wv[j]; i2 = j; }
            const float ex2 = expf(m2 - m1);
            w1 = pg / (1.0f + ex2); w2 = pg * ex2 / (1.0f + ex2);
            e1 = gs * 8 + i1; e2 = gs * 8 + i2;
            r1 = __hip_atomic_fetch_add(&hist[e1], 1u, __ATOMIC_RELAXED, __HIP_MEMORY_SCOPE_WORKGROUP); r2 = __hip_atomic_fetch_add(&hist[e2], 1u, __ATOMIC_RELAXED, __HIP_MEMORY_SCOPE_WORKGROUP);
        }
        __syncthreads();
        if (F.tid < 32) { const unsigned h = hist[F.tid]; hist[32 + F.tid] = h ? xb_add(&cnt[F.tid], h) : 0u; }
        __syncthreads();
        if (F.tid < 64) {
            const int t = t0 + F.tid;
            P.eid[t * 2 + 0] = e1; P.eid[t * 2 + 1] = e2; P.ew[t * 2 + 0] = w1; P.ew[t * 2 + 1] = w2;
            P.pos[t * 2 + 0] = (int)(hist[32 + e1] + r1); P.pos[t * 2 + 1] = (int)(hist[32 + e2] + r2);
        }
        __syncthreads();
    }
}

DEV void moe_table(const Params& P, Frame& F, int layer) {
    volatile LAS int* tab = (volatile LAS int*)(F.lds + TAB_OFF);
    if (F.tid == 0) {
        unsigned* cnt = P.ctl + CW_MOE + layer * 256;
        int acc = 0;
        for (int e = 0; e < 32; ++e) { tab[e] = acc; acc += (int)((xb_ld(&cnt[e]) + 255u) >> 8); }
        tab[32] = acc;
    }
    __syncthreads();
}

DEV void fp_gather(const Params& P, Frame& F, int layer) {
    moe_table(P, F, layer);
    volatile LAS int* tab = (volatile LAS int*)(F.lds + TAB_OFF);
    const float* gain = P.moe_norm + layer * D;
    const int gw = F.vcu * NWAVES + F.wave, NGW = F.G * NWAVES, lane = F.lane;
    for (int t = gw; t < T; t += NGW) {
        const int e1 = P.eid[t * 2], e2 = P.eid[t * 2 + 1];
        const int p1 = tab[e1] * 256 + P.pos[t * 2], p2 = tab[e2] * 256 + P.pos[t * 2 + 1];
        const GAS f32x4* xr = (const GAS f32x4*)(P.out + (size_t)t * D) + lane;
        const GAS f32x4* gr = (const GAS f32x4*)gain + lane;
        const float rstd = P.rstd[t];
        GAS unsigned long long* o1 = (GAS unsigned long long*)(P.ha + (size_t)p1 * D) + lane;
        GAS unsigned long long* o2 = (GAS unsigned long long*)(P.ha + (size_t)p2 * D) + lane;
#pragma unroll
        for (int j = 0; j < 4; ++j) { const f32x4 v = xr[64 * j], g = gr[64 * j];
            const unsigned long long q = (unsigned long long)pk2(v.x * rstd * g.x, v.y * rstd * g.y) | ((unsigned long long)pk2(v.z * rstd * g.z, v.w * rstd * g.w) << 32);
            o1[64 * j] = q; o2[64 * j] = q; }
        if (lane == 0) { P.pos[t * 2] = p1; P.pos[t * 2 + 1] = p2; }
    }
}

struct ListOrder {
    int code[4]; int n, npn; const char* A; const char* Bt; size_t tstep;
    __device__ __forceinline__ bool next(int i, pg8::Unit& o) const {
        if (i >= n) return false;
        const int c = (i == 0) ? code[0] : (i == 1) ? code[1] : (i == 2) ? code[2] : code[3];
        const int tt = c >> 8, e = (c >> 3) & 31, pn = c & 7;
        o.pm = tt; o.pn = pn; o.A = A + (size_t)tt * tstep; o.B = Bt + (size_t)(e * npn + pn) * tstep; return true;
    }
};
DEV void moe_units(Frame& F, ListOrder& L, int npn, const bf16* A, const bf16* Bt, int K) {
    volatile LAS int* tab = (volatile LAS int*)(F.lds + TAB_OFF);
    const int ntile = tab[32], total = ntile * npn;
    L.tstep = (size_t)256 * K * 2; L.A = (const char*)A; L.Bt = (const char*)Bt; L.npn = npn;
    int n = 0;
#pragma unroll
    for (int i = 0; i < 4; ++i) {
        const int Lx = i * F.G + F.vcu;
        int code = 0;
        if (Lx < total) {
            const int tt = Lx / npn, pn = Lx % npn;
            int e = 0;
            for (int q = 1; q < 32; ++q) e += (tt >= tab[q]) ? 1 : 0;
            code = (tt << 8) | (e << 3) | pn;
            n = i + 1;
        }
        L.code[i] = __builtin_amdgcn_readfirstlane(code);
    }
    L.n = __builtin_amdgcn_readfirstlane(n);
}

DEV void fp_moe_gu(const Params& P, Frame& F, int layer) {
    moe_table(P, F, layer);
    ListOrder L; moe_units(F, L, 2, P.ha, P.wgut, D);
    pg8::EpiSiluMul E{P.hid, 256};
    pg8::gemm_phase(F.lds, D, L, E, F.tid);
}
DEV void fp_moe_dn(const Params& P, Frame& F, int layer) {
    moe_table(P, F, layer);
    ListOrder L; moe_units(F, L, 4, P.hid, P.wdt, 256);
    pg8::EpiStoreBf16 E{P.ha, D};
    pg8::gemm_phase(F.lds, 256, L, E, F.tid);
}
DEV void fp_combine(const Params& P, Frame& F, const float* gain2, bf16* xn) {
    const int gw = F.vcu * NWAVES + F.wave, NGW = F.G * NWAVES, lane = F.lane;
    for (int t = gw; t < T; t += NGW) {
        const int p1 = P.pos[t * 2], p2 = P.pos[t * 2 + 1];
        const float w1 = P.ew[t * 2], w2 = P.ew[t * 2 + 1];
        GAS f32x4* xr = (GAS f32x4*)(P.out + (size_t)t * D) + lane;
        const GAS unsigned long long* y1 = (const GAS unsigned long long*)(P.ha + (size_t)p1 * D) + lane;
        const GAS unsigned long long* y2 = (const GAS unsigned long long*)(P.ha + (size_t)p2 * D) + lane;
        f32x4 v[4]; float s = 0.f;
#pragma unroll
        for (int j = 0; j < 4; ++j) {
            v[j] = xr[64 * j];
            const unsigned long long a = y1[64 * j], b = y2[64 * j];
            v[j].x += w1 * u2f((unsigned)(a & 0xffffu) << 16) + w2 * u2f((unsigned)(b & 0xffffu) << 16);
            v[j].y += w1 * u2f((unsigned)((a >> 16) & 0xffffu) << 16) + w2 * u2f((unsigned)((b >> 16) & 0xffffu) << 16);
            v[j].z += w1 * u2f((unsigned)((a >> 32) & 0xffffu) << 16) + w2 * u2f((unsigned)((b >> 32) & 0xffffu) << 16);
            v[j].w += w1 * u2f((unsigned)((a >> 48) & 0xffffu) << 16) + w2 * u2f((unsigned)((b >> 48) & 0xffffu) << 16);
            xr[64 * j] = v[j];
            s += (v[j].x * v[j].x + v[j].y * v[j].y) + (v[j].z * v[j].z + v[j].w * v[j].w);
        }
        if (xn) {
            const float rstd = 1.0f / sqrtf(wave_sum(s) * (1.f / D) + EPS);
            const GAS f32x4* gr = (const GAS f32x4*)gain2 + lane;
            GAS unsigned long long* o8 = (GAS unsigned long long*)(xn + (size_t)t * D) + lane;
#pragma unroll
            for (int j = 0; j < 4; ++j) { const f32x4 g = gr[64 * j];
                o8[64 * j] = (unsigned long long)pk2(v[j].x * rstd * g.x, v[j].y * rstd * g.y) | ((unsigned long long)pk2(v[j].z * rstd * g.z, v[j].w * rstd * g.w) << 32); }
        }
    }
}

namespace att {
typedef float f32x16 __attribute__((ext_vector_type(16)));
typedef short s16x4 __attribute__((ext_vector_type(4)));
typedef short v4i16_t __attribute__((ext_vector_type(4)));
typedef LAS const char* lptr;
constexpr float LOG2E = 1.4426950408889634f;
constexpr int KS0 = 0, VS0 = 16384, SLOT = 8192;
constexpr float MNEG = -1e30f;

struct TileRegs { v4u k, v; };
DEV void tile_load(TileRegs& R, const bf16* Kg, const bf16* Vg, int pitch, int k0, int tid) {
    const int w = tid >> 6, lane = tid & 63;
    R.k = *(const GAS v4u*)(Kg + (size_t)(k0 + lane) * pitch + w * 8);
    R.v = *(const GAS v4u*)(Vg + (size_t)(k0 + 16 * (w & 3) + (lane >> 2)) * pitch + (w >> 2) * 32 + (lane & 3) * 8);
}
DEV void tile_store(LAS unsigned char* lds, int slot, const TileRegs& R, int tid) {
    *(LAS v4u*)(lds + KS0 + slot * SLOT + tid * 16) = R.k;
    *(LAS v4u*)(lds + VS0 + slot * SLOT + tid * 16) = R.v;
}
DEV void qk_tile(f32x16& p0, f32x16& p1, lptr Kslot, const bf16x8 (&qr)[4], int r32, int hi) {
    lptr kb = Kslot + hi * 1024 + r32 * 16;
    p0 = f32x16{}; p1 = f32x16{};
#pragma unroll
    for (int d0 = 0; d0 < 4; ++d0) {
        const bf16x8 b0 = *(const LAS bf16x8*)(kb + d0 * 2048);
        const bf16x8 b1 = *(const LAS bf16x8*)(kb + d0 * 2048 + 512);
        p0 = __builtin_amdgcn_mfma_f32_32x32x16_bf16(b0, qr[d0], p0, 0, 0, 0);
        p1 = __builtin_amdgcn_mfma_f32_32x32x16_bf16(b1, qr[d0], p1, 0, 0, 0);
    }
}
DEV s16x4 vtr(lptr p) { return __builtin_bit_cast(s16x4, __builtin_amdgcn_ds_read_tr16_b64_v4i16((LAS v4i16_t*)p)); }
DEV unsigned cvtpk(float lo, float hi) { unsigned r; asm volatile("v_cvt_pk_bf16_f32 %0, %1, %2" : "=v"(r) : "v"(lo), "v"(hi)); return r; }
DEV void pv_tile(f32x16 (&o)[2], lptr Vslot, const f32x16& p0, const f32x16& p1, int lane) {
    const int hi = lane >> 5;
    lptr vp = Vslot + ((lane >> 4) & 1) * 32 + (lane & 3) * 8 + (4 * hi + ((lane & 15) >> 2)) * 64;
    bf16x8 pf[4];
#pragma unroll
    for (int ks = 0; ks < 4; ++ks) {
        const f32x16& p = (ks < 2) ? p0 : p1; const int b = (ks & 1) * 8;
        v4u w; w.x = cvtpk(p[b + 0], p[b + 1]); w.y = cvtpk(p[b + 2], p[b + 3]); w.z = cvtpk(p[b + 4], p[b + 5]); w.w = cvtpk(p[b + 6], p[b + 7]);
        pf[ks] = __builtin_bit_cast(bf16x8, w);
    }
#pragma unroll
    for (int d0 = 0; d0 < 2; ++d0)
#pragma unroll
        for (int ks = 0; ks < 4; ++ks) {
            const s16x4 lo = vtr(vp + d0 * 4096 + ks * 1024), hh = vtr(vp + d0 * 4096 + ks * 1024 + 512);
            const bf16x8 vf = (bf16x8){lo[0], lo[1], lo[2], lo[3], hh[0], hh[1], hh[2], hh[3]};
            o[d0] = __builtin_amdgcn_mfma_f32_32x32x16_bf16(vf, pf[ks], o[d0], 0, 0, 0);
        }
}
DEV float lane_swap_max(float m) {
    auto rr = __builtin_amdgcn_permlane32_swap(__float_as_uint(m), __float_as_uint(m), false, false);
    return fmaxf(__uint_as_float(rr[0]), __uint_as_float(rr[1]));
}
DEV float lane_swap_sum(float m) {
    auto rr = __builtin_amdgcn_permlane32_swap(__float_as_uint(m), __float_as_uint(m), false, false);
    return __uint_as_float(rr[0]) + __uint_as_float(rr[1]);
}
DEV float lane_partner(float m, int hi) {
    auto rr = __builtin_amdgcn_permlane32_swap(__float_as_uint(m), __float_as_uint(m), false, false);
    return hi ? __uint_as_float(rr[0]) : __uint_as_float(rr[1]);
}

struct SoftState { float m, l; f32x16 o[2]; };
DEV void soft_reset(SoftState& s) { s.m = MNEG; s.l = 0.f; s.o[0] = f32x16{}; s.o[1] = f32x16{}; }

DEV void soft_tile(SoftState& st, f32x16& p0, f32x16& p1, float s2, float k0rel_f, int klo, int klim, bool need_mask, lptr Vslot, int lane) {
    const int hi = lane >> 5;
    const float c1 = 0.125f * LOG2E;
    const float base = s2 * (k0rel_f + (float)(4 * hi));
    float mx = MNEG;
#pragma unroll
    for (int r = 0; r < 16; ++r) {
        const int kr = (r & 3) + 8 * (r >> 2);
        float x0 = fmaf(p0[r], c1, fmaf(s2, (float)kr, base));
        float x1 = fmaf(p1[r], c1, fmaf(s2, (float)(kr + 32), base));
        if (need_mask) { x0 = (kr > klo && kr <= klim) ? x0 : MNEG; x1 = (kr + 32 > klo && kr + 32 <= klim) ? x1 : MNEG; }
        p0[r] = x0; p1[r] = x1;
        mx = fmaxf(mx, fmaxf(x0, x1));
    }
    mx = lane_swap_max(mx);
    const float mnew = fmaxf(st.m, mx);
    if (__any(mnew > st.m)) {
        const float alpha = __builtin_amdgcn_exp2f(st.m - mnew);
        st.l *= alpha;
#pragma unroll
        for (int r = 0; r < 16; ++r) { st.o[0][r] *= alpha; st.o[1][r] *= alpha; }
        st.m = mnew;
    }
    float ls = 0.f;
#pragma unroll
    for (int r = 0; r < 16; ++r) {
        p0[r] = __builtin_amdgcn_exp2f(p0[r] - st.m); p1[r] = __builtin_amdgcn_exp2f(p1[r] - st.m);
        ls += p0[r] + p1[r];
    }
    st.l += ls;
    pv_tile(st.o, Vslot, p0, p1, lane);
}

DEV void store_ot(const f32x16 (&o)[2], float f, bf16* orow, int hi) {
#pragma unroll
    for (int d0 = 0; d0 < 2; ++d0)
#pragma unroll
        for (int g = 0; g < 4; ++g) {
            const unsigned a = cvtpk(o[d0][4 * g] * f, o[d0][4 * g + 1] * f), b = cvtpk(o[d0][4 * g + 2] * f, o[d0][4 * g + 3] * f);
            *(GAS unsigned long long*)(orow + 32 * d0 + 8 * g + 4 * hi) = (unsigned long long)a | ((unsigned long long)b << 32);
        }
}
DEV void load_q(bf16x8 (&qr)[4], const bf16* qrow, int hi) {
#pragma unroll
    for (int d0 = 0; d0 < 4; ++d0) qr[d0] = *(const GAS bf16x8*)(qrow + 16 * d0 + 8 * hi);
}

template <class MaskF>
DEV void run_segment(Frame& F, SoftState& st, const bf16x8 (&qr)[4], const bf16* Kg, const bf16* Vg, int pitch, int t0, int t1, float s2, int qpos, const MaskF& mf) {
    const int tid = F.tid, lane = F.lane, r32 = lane & 31, hi = lane >> 5;
    if (t1 < t0) return;
    TileRegs R; tile_load(R, Kg, Vg, pitch, t0 * 64, tid);
    int slot = 0;
    for (int t = t0; t <= t1; ++t) {
        tile_store(F.lds, slot, R, tid);
        if (t < t1) tile_load(R, Kg, Vg, pitch, (t + 1) * 64, tid);
        __syncthreads();
        int klo, klim; mf(t, klo, klim);
        const bool any_valid = __any(klim >= 0 && klo < 60 && klim > klo);
        if (any_valid) {
            const bool need_mask = __any(klo >= 0 || klim < 60);
            f32x16 p0, p1;
            qk_tile(p0, p1, (lptr)(F.lds + KS0 + slot * SLOT), qr, r32, hi);
            soft_tile(st, p0, p1, s2, (float)(t * 64 - qpos), klo, klim, need_mask, (lptr)(F.lds + VS0 + slot * SLOT), lane);
        }
        slot ^= 1;
    }
    __syncthreads();
}
}

DEV void fp_headnorm(const Params& P, Frame& F, int layer) {
    const int gw = F.vcu * NWAVES + F.wave, NGW = F.G * NWAVES, lane = F.lane;
    for (int t = gw; t < T; t += NGW) {
        bf16* row = P.proj + (size_t)t * LDP;
        const int nh = layer == 0 ? 10 : 28;
        for (int h = 0; h < nh; ++h) {
            int off; const float* g;
            if (layer == 0) { if (h < 8) { off = h * 64; g = P.ev_q_norm; } else { off = 512 + (h - 8) * 64; g = P.ev_k_norm; } }
            else { if (h < 8) { off = h * 64; g = P.od_c_q_norm; } else if (h < 16) { off = 512 + (h - 8) * 64; g = P.od_c_k_norm; }
                   else if (h < 24) { off = 1536 + (h - 16) * 64; g = P.od_d_q_norm; } else if (h < 26) { off = 2304 + (h - 24) * 64; g = P.od_d_k_norm + 64; }
                   else { off = 2560 + (h - 26) * 64; g = P.od_d_k_norm + 128; } }
            const float v = bf2f(row[off + lane]);
            const float r = 1.0f / sqrtf(wave_sum(v * v) * (1.0f / 64) + EPS);
            row[off + lane] = f2bf(v * r * g[lane]);
        }
    }
}


DEV void sb_tile(att::f32x16& p0, att::f32x16& p1, float& carry, int lim, int hi) {
    using namespace att;
    const float c1 = 0.125f * LOG2E;
    f32x16 k0, k1;
    float cs[2][4];
#pragma unroll
    for (int hf = 0; hf < 2; ++hf)
#pragma unroll
        for (int g = 0; g < 4; ++g) {
            float s = 0.f;
#pragma unroll
            for (int i = 0; i < 4; ++i) {
                const int r = 4 * g + i, kr = i + 8 * g + 32 * hf;
                const float z2 = (hf ? p1[r] : p0[r]) * c1;
                const float e = __builtin_amdgcn_exp2f(-fabsf(z2));
                const float ls2 = fminf(z2, 0.f) - __builtin_amdgcn_logf(1.0f + e);
                const bool ok = kr < lim;
                const float lk2 = ok ? (ls2 - z2) : 0.f;
                if (hf) { p1[r] = ok ? ls2 : MNEG; k1[r] = lk2; } else { p0[r] = ok ? ls2 : MNEG; k0[r] = lk2; }
                s += lk2;
            }
            cs[hf][g] = s;
        }
    float run = carry;
#pragma unroll
    for (int hf = 1; hf >= 0; --hf)
#pragma unroll
        for (int g = 3; g >= 0; --g) {
            const float mine = cs[hf][g], other = lane_partner(mine, hi);
            float suf = hi ? run : run + other;
            run += mine + other;
#pragma unroll
            for (int i = 3; i >= 0; --i) {
                const int r = 4 * g + i;
                if (hf) { p1[r] = __builtin_amdgcn_exp2f(p1[r] + suf); suf += k1[r]; } else { p0[r] = __builtin_amdgcn_exp2f(p0[r] + suf); suf += k0[r]; }
            }
        }
    carry = run;
}

DEV void fp_attn0(const Params& P, Frame& F) {
    using namespace att;
    const int tid = F.tid, lane = F.lane, r32 = lane & 31, hi = lane >> 5, w = F.wave;
    for (int u = F.vcu; u < 1024; u += F.G) {
        if (u < 512) {
            const int b = u >> 6, h = (u >> 3) & 7, blk = u & 7;
            const bf16* base = P.proj + (size_t)b * S * LDP;
            const int q = blk * 256 + w * 32 + r32;
            bf16x8 qr[4]; load_q(qr, base + (size_t)q * LDP + 768 + h * 64, hi);
            const bf16* Kg = base + 1280 + h * 64; const bf16* Vg = base + 1792 + h * 64;
            f32x16 o[2]; o[0] = f32x16{}; o[1] = f32x16{};
            float carry = 0.f;
            const int tmax = blk * 4 + 3;
            const int tw = (blk * 256 + w * 32 + 31) >> 6;
            volatile LAS int* flag = (volatile LAS int*)(F.lds + 32768);
            if (tid < 3) flag[tid] = 0;
            TileRegs R; tile_load(R, Kg, Vg, LDP, tmax * 64, tid);
            int slot = 0; bool wave_done = false;
            for (int t = tmax; t >= 0; --t) {
                tile_store(F.lds, slot, R, tid);
                if (t > 0) tile_load(R, Kg, Vg, LDP, (t - 1) * 64, tid);
                __syncthreads();
                if (t < tmax && flag[(t + 1) % 3] == 0) break;
                if (tid == 0) flag[(t + 2) % 3] = 0;
                if (!wave_done && t <= tw) {
                    f32x16 p0, p1;
                    qk_tile(p0, p1, (lptr)(F.lds + KS0 + slot * SLOT), qr, r32, hi);
                    sb_tile(p0, p1, carry, q - t * 64 - 4 * hi, hi);
                    pv_tile(o, (lptr)(F.lds + VS0 + slot * SLOT), p0, p1, lane);
                    if (__all(carry < -150.f)) wave_done = true;
                }
                if (!wave_done && lane == 0) flag[t % 3] = 1;
                slot ^= 1;
            }
            __syncthreads();
            store_ot(o, 1.0f, P.o + (size_t)(b * S + q) * D + 512 + h * 64, hi);
        } else {
            const int v = u - 512, b = v >> 6, hkv = (v >> 5) & 1, c = v & 31;
            const bf16* base = P.proj + (size_t)b * S * LDP;
            const int hh = hkv * 4 + (w >> 1), q = c * 64 + (w & 1) * 32 + r32;
            bf16x8 qr[4]; load_q(qr, base + (size_t)q * LDP + hh * 64, hi);
            const float sl = exp2f(-(float)(hh + 1)), s2 = sl * LOG2E;
            SoftState st; soft_reset(st);
            const int t0 = c - 2 < 0 ? 0 : c - 2;
            run_segment(F, st, qr, base + 512 + hkv * 64, base + 640 + hkv * 64, LDP, t0, c, s2, q,
                        [&](int t, int& klo, int& klim) { klim = q - t * 64 - 4 * hi; klo = klim - 128; });
            const float l = lane_swap_sum(st.l);
            const float sk2 = P.ev_sink[hh] * LOG2E;
            const float mx = fmaxf(st.m, sk2);
            const float scale = __builtin_amdgcn_exp2f(st.m - mx);
            const float den = l * scale + __builtin_amdgcn_exp2f(sk2 - mx);
            store_ot(st.o, scale / den, P.o + (size_t)(b * S + q) * D + hh * 64, hi);
        }
    }
}

DEV void fp_attn1(const Params& P, Frame& F) {
    using namespace att;
    const int lane = F.lane, r32 = lane & 31, hi = lane >> 5, w = F.wave;
    for (int u = F.vcu; u < 1024; u += F.G) {
        if (u < 512) {
            const int v = u & 255, bh = v >> 2, blk = (u < 256) ? (v & 3) : 7 - (v & 3);
            const int b = bh >> 3, h = bh & 7;
            const bf16* base = P.proj + (size_t)b * S * LDP;
            const int q = blk * 256 + w * 32 + r32;
            bf16x8 qr[4]; load_q(qr, base + (size_t)q * LDP + h * 64, hi);
            const float sl = exp2f(-(float)(h + 1)), s2 = sl * LOG2E;
            float gt[8];
#pragma unroll
            for (int n = 0; n < 8; ++n) {
                float g = 0.f;
                if (n < blk) {
                    const float* km = P.kmean + ((size_t)(b * 8 + h) * 8 + n) * 64;
#pragma unroll
                    for (int d0 = 0; d0 < 4; ++d0)
#pragma unroll
                        for (int j = 0; j < 8; ++j) g += bf2f((bf16)qr[d0][j]) * km[16 * d0 + 8 * hi + j];
                }
                g = lane_swap_sum(g);
                gt[n] = n < blk ? g : NEG;
            }
            unsigned sel = 0;
#pragma unroll
            for (int n = 0; n < 8; ++n) {
                int rank = 0;
#pragma unroll
                for (int k = 0; k < 8; ++k) rank += (gt[k] > gt[n] || (gt[k] == gt[n] && k < n)) ? 1 : 0;
                if (rank < 3 && n < blk) sel |= 1u << n;
            }
            SoftState st; soft_reset(st);
            run_segment(F, st, qr, base + 512 + h * 64, base + 1024 + h * 64, LDP, 0, blk * 4 + 3, s2, q,
                        [&](int t, int& klo, int& klim) { const int n = t >> 2; klo = -1;
                            if (n < blk) klim = ((sel >> n) & 1) ? 63 : -1; else klim = q - t * 64 - 4 * hi; });
            const float l = lane_swap_sum(st.l);
            store_ot(st.o, 1.0f / l, P.o + (size_t)(b * S + q) * D + h * 64, hi);
        } else {
            const int v = u & 255, bk = v >> 4, c = (u < 768) ? (v & 15) : 31 - (v & 15);
            const int b = bk >> 1, hkv = bk & 1;
            const bf16* base = P.proj + (size_t)b * S * LDP;
            const int h = hkv * 4 + (w >> 1), q = c * 64 + (w & 1) * 32 + r32, t = b * S + q;
            bf16x8 qr[4]; load_q(qr, base + (size_t)q * LDP + 1536 + h * 64, hi);
            const float sl = exp2f(-(float)(h + 1)), s2 = sl * LOG2E;
            const bf16* grow = base + (size_t)q * LDP + 2816 + h * 3;
            const float g0 = 1.0f / (1.0f + __expf(-bf2f(grow[0]))), g1 = 1.0f / (1.0f + __expf(-bf2f(grow[1]))), g2 = 1.0f / (1.0f + __expf(-bf2f(grow[2])));
            const unsigned mask = P.selmask[t * 2 + hkv];
            f32x16 fin[2];
            {
                const float* oc = P.ocmp + ((size_t)t * 8 + h) * 64;
#pragma unroll
                for (int d0 = 0; d0 < 2; ++d0)
#pragma unroll
                    for (int g = 0; g < 4; ++g) { const f32x4 x = *(const GAS f32x4*)(oc + 32 * d0 + 8 * g + 4 * hi);
                        fin[d0][4 * g] = g0 * x.x; fin[d0][4 * g + 1] = g0 * x.y; fin[d0][4 * g + 2] = g0 * x.z; fin[d0][4 * g + 3] = g0 * x.w; }
            }
            SoftState st; soft_reset(st);
            run_segment(F, st, qr, base + 2304 + hkv * 64, base + 2432 + hkv * 64, LDP, 0, c, s2, q,
                        [&](int tt, int& klo, int& klim) { klo = -1; klim = ((mask >> tt) & 1) ? (q - tt * 64 - 4 * hi) : -1; });
            { const float f = g1 / lane_swap_sum(st.l);
#pragma unroll
              for (int r = 0; r < 16; ++r) { fin[0][r] += f * st.o[0][r]; fin[1][r] += f * st.o[1][r]; } }
            soft_reset(st);
            run_segment(F, st, qr, base + 2560 + hkv * 64, base + 2688 + hkv * 64, LDP, c - 8 < 0 ? 0 : c - 8, c, s2, q,
                        [&](int tt, int& klo, int& klim) { klim = q - tt * 64 - 4 * hi; klo = klim - 512; });
            { const float f = g2 / lane_swap_sum(st.l);
#pragma unroll
              for (int r = 0; r < 16; ++r) { fin[0][r] += f * st.o[0][r]; fin[1][r] += f * st.o[1][r]; } }
            store_ot(fin, 1.0f, P.o + (size_t)t * D + 512 + h * 64, hi);
        }
    }
}
constexpr int NPHASE = 20;
DEV void run_phase(const Params& P, int ph, int gtid, int gsz) {
    switch (ph) {
        case 0: ph_rstd(P.x, P.rstd, gtid, gsz); break;
        case 1: ph_gemm_in(P.x, P.rstd, P.ev_norm, P.ev_w_in, EVEN_IN, P.proj, gtid, gsz); break;
        case 2: ph_headnorm0(P, gtid, gsz); break;
        case 3: ph_attn0(P, gtid, gsz); break;
        case 4: ph_gemm_out(P.o, P.ev_w_out, P.x, P.out, gtid, gsz); break;
        case 5: ph_moe_route(P, 0, gtid, gsz); break;
        case 6: ph_moe_hidden(P, 0, gtid, gsz); break;
        case 7: ph_moe_out(P, 0, gtid, gsz); break;
        case 8: ph_rstd(P.out, P.rstd, gtid, gsz); break;
        case 9: ph_gemm_in(P.out, P.rstd, P.od_norm, P.od_w_in, ODD_IN, P.proj, gtid, gsz); break;
        case 10: ph_headnorm1(P, gtid, gsz); break;
        case 11: ph_prep1(P, gtid, gsz); break;
        case 12: ph_nsa_cmp(P, gtid, gsz); break;
        case 13: ph_nsa_select(P, gtid, gsz); break;
        case 14: ph_nsa_topk(P, gtid, gsz); break;
        case 15: ph_attn1(P, gtid, gsz); break;
        case 16: ph_gemm_out(P.o, P.od_w_out, P.out, P.out, gtid, gsz); break;
        case 17: ph_moe_route(P, 1, gtid, gsz); break;
        case 18: ph_moe_hidden(P, 1, gtid, gsz); break;
        case 19: ph_moe_out(P, 1, gtid, gsz); break;
    }
}
__global__ void __launch_bounds__(256) k_naive(Params P, int ph) {
    run_phase(P, ph, blockIdx.x * blockDim.x + threadIdx.x, gridDim.x * blockDim.x);
}

enum { FP_CONV_DENSE = 0, FP_CONV_MOE0, FP_XN0, FP_INPROJ0, FP_HEADNORM0, FP_ATTN0, FP_OUTPROJ0, FP_ROUTE0, FP_GATHER0, FP_GU0, FP_DN0, FP_COMBINE0, FP_CONV_MOE1, FP_XN1, FP_INPROJ1, FP_HEADNORM1, FP_PREP1, FP_NSACMP, FP_NSASEL, FP_NSATOPK, FP_ATTN1, FP_OUTPROJ1, FP_ROUTE1, FP_GATHER1, FP_GU1, FP_DN1, FP_COMBINE1, FP_COUNT };
struct FArgs { Params p; unsigned long long mask; int li, pad; };

__global__ void __launch_bounds__(NWAVES * 64, 2) k_fast(FArgs args) {
    extern __shared__ __attribute__((aligned(16))) unsigned char lds[];
    const Params& P = args.p;
    Frame F;
    F.lds = (LAS unsigned char*)lds;
    F.MISC = (volatile LAS unsigned*)(F.lds + MISC_OFF);
    F.tid = threadIdx.x; F.lane = F.tid & 63; F.wave = __builtin_amdgcn_readfirstlane(F.tid >> 6);
    F.G = gridDim.x; { const int bx = blockIdx.x; F.vcu = (F.G % 8 == 0) ? (bx % 8) * (F.G / 8) + bx / 8 : bx; }
    for (int u = F.tid; u < (LDS_BYTES - LDSCTL_OFF) / 4; u += NWAVES * 64) ((LAS unsigned*)(F.lds + LDSCTL_OFF))[u] = 0u;
    __syncthreads();
    XcdBarrier bar = xcd_barrier_post(P.ctl + CW_BAR + args.li * XCD_BAR_WORDS, F.MISC + 8);
    const unsigned long long mask = args.mask;
#define ON(k) (refresh(F), ((mask >> (k)) & 1ull))
#define SEAM(k) do { if ((mask >> ((k) + 1)) != 0ull) { refresh(F); xcd_barrier(bar, F.tid); } } while (0)
    if (ON(FP_CONV_DENSE)) { fp_convert_weights(P, F, 0); fp_prep_router(P, F); SEAM(FP_CONV_DENSE); }
    if (ON(FP_CONV_MOE0)) { fp_convert_weights(P, F, 1); SEAM(FP_CONV_MOE0); }
    if (ON(FP_XN0)) { fp_norm_rows(F, P.x, P.ev_norm, P.xn); SEAM(FP_XN0); }
    if (ON(FP_INPROJ0)) { pg8::StaticOrder So; So.init(P.xn, P.win0t, T, EVEN_IN, D, F.G, (int)blockIdx.x);
        pg8::EpiStoreBf16 E{P.proj, LDP}; pg8::gemm_phase(F.lds, D, So, E, F.tid); SEAM(FP_INPROJ0); }
    if (ON(FP_HEADNORM0)) { fp_headnorm(P, F, 0); SEAM(FP_HEADNORM0); }
    if (ON(FP_ATTN0)) { fp_attn0(P, F); SEAM(FP_ATTN0); }
    if (ON(FP_OUTPROJ0)) { pg8::StaticOrder So; So.init(P.o, P.wout0t, T, D, D, F.G, (int)blockIdx.x);
        pg8::EpiResidF32 E{P.x, P.out, D}; pg8::gemm_phase(F.lds, D, So, E, F.tid); SEAM(FP_OUTPROJ0); }
    if (ON(FP_ROUTE0)) { fp_route(P, F, 0); SEAM(FP_ROUTE0); }
    if (ON(FP_GATHER0)) { fp_gather(P, F, 0); SEAM(FP_GATHER0); }
    if (ON(FP_GU0)) { fp_moe_gu(P, F, 0); SEAM(FP_GU0); }
    if (ON(FP_DN0)) { fp_moe_dn(P, F, 0); SEAM(FP_DN0); }
    if (ON(FP_COMBINE0)) { fp_combine(P, F, P.od_norm, P.xn); SEAM(FP_COMBINE0); }
    if (ON(FP_CONV_MOE1)) { fp_convert_weights(P, F, 2); SEAM(FP_CONV_MOE1); }
    if (ON(FP_XN1)) { fp_norm_rows(F, P.out, P.od_norm, P.xn); SEAM(FP_XN1); }
    if (ON(FP_INPROJ1)) { pg8::StaticOrder So; So.init(P.xn, P.win1t, T, LDP, D, F.G, (int)blockIdx.x);
        pg8::EpiStoreBf16 E{P.proj, LDP}; pg8::gemm_phase(F.lds, D, So, E, F.tid); SEAM(FP_INPROJ1); }
    if (ON(FP_HEADNORM1)) { fp_headnorm(P, F, 1); SEAM(FP_HEADNORM1); }
    if (ON(FP_PREP1)) { ph_prep1(P, F.vcu * NWAVES * 64 + F.tid, F.G * NWAVES * 64); SEAM(FP_PREP1); }
    if (ON(FP_NSACMP)) { ph_nsa_cmp(P, F.vcu * NWAVES * 64 + F.tid, F.G * NWAVES * 64); SEAM(FP_NSACMP); }
    if (ON(FP_NSASEL)) { ph_nsa_select(P, F.vcu * NWAVES * 64 + F.tid, F.G * NWAVES * 64); SEAM(FP_NSASEL); }
    if (ON(FP_NSATOPK)) { ph_nsa_topk(P, F.vcu * NWAVES * 64 + F.tid, F.G * NWAVES * 64); SEAM(FP_NSATOPK); }
    if (ON(FP_ATTN1)) { fp_attn1(P, F); SEAM(FP_ATTN1); }
    if (ON(FP_OUTPROJ1)) { pg8::StaticOrder So; So.init(P.o, P.wout1t, T, D, D, F.G, (int)blockIdx.x);
        pg8::EpiResidF32 E{P.out, P.out, D}; pg8::gemm_phase(F.lds, D, So, E, F.tid); SEAM(FP_OUTPROJ1); }
    if (ON(FP_ROUTE1)) { fp_route(P, F, 1); SEAM(FP_ROUTE1); }
    if (ON(FP_GATHER1)) { fp_gather(P, F, 1); SEAM(FP_GATHER1); }
    if (ON(FP_GU1)) { fp_moe_gu(P, F, 1); SEAM(FP_GU1); }
    if (ON(FP_DN1)) { fp_moe_dn(P, F, 1); SEAM(FP_DN1); }
    if (ON(FP_COMBINE1)) { fp_combine(P, F, nullptr, nullptr); SEAM(FP_COMBINE1); }
#undef ON
#undef SEAM
}

static inline size_t al256(size_t x) { return (x + 255) & ~(size_t)255; }
static size_t carve(Params& p, void* d_ws) {
    char* w = (char*)d_ws;
    p.ctl = (unsigned*)w;
    p.win0t = (bf16*)(w + 1 * MiB);
    p.wout0t = (bf16*)(w + 6 * MiB);
    p.win1t = (bf16*)(w + 8 * MiB);
    p.wout1t = (bf16*)(w + 14 * MiB);
    p.wgut = (bf16*)(w + 16 * MiB);
    p.wdt = (bf16*)(w + 48 * MiB);
    p.proj = (bf16*)(w + 64 * MiB);
    p.ha = (bf16*)(w + 64 * MiB);
    p.xn = (bf16*)(w + 160 * MiB);
    p.hmid = (float*)(w + 160 * MiB);
    p.ocmp = (float*)(w + 160 * MiB);
    p.o = (bf16*)(w + 192 * MiB);
    p.hid = (bf16*)(w + 192 * MiB);
    size_t off = 224 * MiB;
    p.rstd = (float*)(w + off); off = al256(off + (size_t)T * 4);
    p.eid = (int*)(w + off); off = al256(off + (size_t)T * 2 * 4);
    p.ew = (float*)(w + off); off = al256(off + (size_t)T * 2 * 4);
    p.kmean = (float*)(w + off); off = al256(off + (size_t)NB * 8 * 8 * 64 * 4);
    p.kvcmp = (bf16*)(w + off); off = al256(off + (size_t)2 * NB * NCMP * 2 * 64 * 2);
    p.cml = (float*)(w + off); off = al256(off + (size_t)T * 8 * 2 * 4);
    p.pslc = (float*)(w + off); off = al256(off + (size_t)T * 64 * 4);
    p.selmask = (unsigned*)(w + off); off = al256(off + (size_t)T * 2 * 4);
    p.rowtok = (int*)(w + off); off = al256(off + (size_t)RMAX * 4);
    p.pos = (int*)(w + off); off = al256(off + (size_t)T * 2 * 4);
    p.wr = (bf16*)(w + off); off = al256(off + (size_t)2 * 2 * 48 * D * 2);
    return off;
}

struct Step { int fast; int n; int ph[32]; };
static const Step PLAN[] = {
    {1, 26, {FP_CONV_DENSE, FP_CONV_MOE0, FP_XN0, FP_INPROJ0, FP_HEADNORM0, FP_ATTN0, FP_OUTPROJ0, FP_ROUTE0, FP_GATHER0, FP_GU0, FP_DN0, FP_COMBINE0, FP_CONV_MOE1, FP_INPROJ1, FP_HEADNORM1,
             FP_PREP1, FP_NSACMP, FP_NSASEL, FP_NSATOPK, FP_ATTN1, FP_OUTPROJ1, FP_ROUTE1, FP_GATHER1, FP_GU1, FP_DN1, FP_COMBINE1}},
};

extern "C" void kernel_launch(void* const* d_in, const int* in_sizes, int n_in, void* d_out, int out_size, void* d_ws, size_t ws_size,
                              hipStream_t stream) {
    Params p{};
    const float** f = (const float**)&p;
    for (int i = 0; i < 24; ++i) f[i] = (const float*)d_in[i];
    p.out = (float*)d_out;
    const size_t need = carve(p, d_ws);
    static int grid = 0;
    if (grid == 0) {
        int dev = 0, cus = 0, per_cu = 0;
        if (hipGetDevice(&dev) != hipSuccess || hipDeviceGetAttribute(&cus, hipDeviceAttributeMultiprocessorCount, dev) != hipSuccess) { grid = -1; return; }
        if (hipFuncSetAttribute((const void*)k_fast, hipFuncAttributeMaxDynamicSharedMemorySize, LDS_BYTES) != hipSuccess) { fprintf(stderr, "hipFuncSetAttribute failed\n"); grid = -1; return; }
        if (hipOccupancyMaxActiveBlocksPerMultiprocessor(&per_cu, (const void*)k_fast, NWAVES * 64, LDS_BYTES) != hipSuccess || per_cu < 1) { fprintf(stderr, "occupancy query: %d\n", per_cu); (void)hipGetLastError(); grid = -1; return; }
        grid = cus;
        if (need > ws_size) { fprintf(stderr, "workspace too small: need %zu have %zu\n", need, ws_size); grid = -1; return; }
    }
    if (grid < 0) return;
    (void)hipMemsetAsync(d_ws, 0, CTL_ZERO_BYTES, stream);
    int li = 0;
    for (const Step& st : PLAN) {
        if (st.fast) {
            FArgs a{}; a.p = p; a.li = li++;
            for (int i = 0; i < st.n; ++i) a.mask |= 1ull << st.ph[i];
            hipLaunchKernelGGL(k_fast, dim3(grid), dim3(NWAVES * 64), LDS_BYTES, stream, a);
        } else {
            for (int i = 0; i < st.n; ++i) hipLaunchKernelGGL(k_naive, dim3(2048), dim3(256), 0, stream, p, st.ph[i]);
        }
    }
}
```

```cpp
#include <hip/hip_runtime.h>
#include <cstdio>
#include <cstdint>
#define DEV __device__ __forceinline__

#ifndef NB
#define NB 8
#endif
typedef unsigned short bf16;
constexpr int S = 2048, D = 1024, T = NB * S, HD = 64;
constexpr int EVEN_IN = 2304, ODD_IN = 2840, LDP = 3072;
constexpr int NCMP = 127, NSLC = 32;
constexpr float NEG = -1e30f;
constexpr float EPS = 1e-6f;
constexpr int RMAX = 2 * T + 32 * 256;

DEV float u2f(unsigned u) { return __builtin_bit_cast(float, u); }
DEV unsigned f2u(float f) { return __builtin_bit_cast(unsigned, f); }
DEV float bf2f(bf16 h) { return u2f(((unsigned)h) << 16); }
DEV bf16 f2bf(float f) { unsigned u = f2u(f); u += 0x7fffu + ((u >> 16) & 1u); return (bf16)(u >> 16); }

struct Params {
    const float *x, *ev_norm, *ev_w_in, *ev_q_norm, *ev_k_norm, *ev_sink, *ev_w_out;
    const float *od_norm, *od_w_in, *od_c_q_norm, *od_c_k_norm, *od_d_q_norm, *od_d_k_norm, *od_cmp_pos, *od_cmp_w, *od_w_out;
    const float *moe_norm, *moe_w_grp, *moe_b_grp, *moe_w_exp, *moe_b_exp, *moe_w_gate, *moe_w_up, *moe_w_down;
    float* out;
    unsigned* ctl;
    bf16 *win0t, *wout0t, *win1t, *wout1t, *wgut, *wdt;
    bf16* proj;
    bf16* xn;
    bf16* o;
    bf16* ha;
    bf16* hid;
    float* rstd;
    int* eid;
    float* ew;
    float* hmid;
    float* kmean;
    bf16* kvcmp;
    float* ocmp;
    float* cml;
    float* pslc;
    unsigned* selmask;
    int* rowtok;
    int* pos;
    bf16* wr;
};

DEV void load64(const bf16* p, float (&q)[64]) {
#pragma unroll
    for (int d = 0; d < 64; ++d) q[d] = bf2f(p[d]);
}
DEV float dot64(const float (&q)[64], const bf16* k) {
    float s = 0.f;
#pragma unroll
    for (int d = 0; d < 64; ++d) s += q[d] * bf2f(k[d]);
    return s;
}
DEV float dot64f(const float (&q)[64], const float* k) {
    float s = 0.f;
#pragma unroll
    for (int d = 0; d < 64; ++d) s += q[d] * k[d];
    return s;
}
DEV void os_update(float sc, const bf16* v, float& m, float& l, float (&o)[64]) {
    if (sc > m) {
        float f = expf(m - sc);
        l *= f;
#pragma unroll
        for (int d = 0; d < 64; ++d) o[d] *= f;
        m = sc;
    }
    float p = expf(sc - m);
    l += p;
#pragma unroll
    for (int d = 0; d < 64; ++d) o[d] += p * bf2f(v[d]);
}
DEV float slope_of(int hh) { return exp2f(-(float)(hh + 1)); }

DEV void ph_rstd(const float* src, float* rstd, int gtid, int gsz) {
    for (int t = gtid; t < T; t += gsz) {
        const float* r = src + (size_t)t * D;
        float s = 0.f;
        for (int i = 0; i < D; ++i) s += r[i] * r[i];
        rstd[t] = rsqrtf(s * (1.0f / D) + EPS);
    }
}

DEV void ph_gemm_in(const float* src, const float* rstd, const float* g, const float* W, int N, bf16* proj, int gtid, int gsz) {
    const long total = (long)T * N;
    for (long i = gtid; i < total; i += gsz) {
        const int t = (int)(i / N), n = (int)(i % N);
        const float* a = src + (size_t)t * D;
        float acc = 0.f;
        for (int k = 0; k < D; ++k) acc += a[k] * g[k] * W[(size_t)k * N + n];
        proj[(size_t)t * LDP + n] = f2bf(acc * rstd[t]);
    }
}

DEV void headnorm_inplace(bf16* p, const float* g) {
    float v[64];
    load64(p, v);
    float s = 0.f;
#pragma unroll
    for (int d = 0; d < 64; ++d) s += v[d] * v[d];
    const float r = rsqrtf(s * (1.0f / 64) + EPS);
#pragma unroll
    for (int d = 0; d < 64; ++d) p[d] = f2bf(v[d] * r * g[d]);
}

DEV void ph_headnorm0(const Params& P, int gtid, int gsz) {
    const long total = (long)T * 10;
    for (long i = gtid; i < total; i += gsz) {
        const int t = (int)(i / 10), h = (int)(i % 10);
        bf16* row = P.proj + (size_t)t * LDP;
        if (h < 8) headnorm_inplace(row + h * 64, P.ev_q_norm);
        else headnorm_inplace(row + 512 + (h - 8) * 64, P.ev_k_norm);
    }
}

DEV void ph_headnorm1(const Params& P, int gtid, int gsz) {
    const long total = (long)T * 28;
    for (long i = gtid; i < total; i += gsz) {
        const int t = (int)(i / 28), h = (int)(i % 28);
        bf16* row = P.proj + (size_t)t * LDP;
        if (h < 8) headnorm_inplace(row + h * 64, P.od_c_q_norm);
        else if (h < 16) headnorm_inplace(row + 512 + (h - 8) * 64, P.od_c_k_norm);
        else if (h < 24) headnorm_inplace(row + 1536 + (h - 16) * 64, P.od_d_q_norm);
        else if (h < 26) headnorm_inplace(row + 2304 + (h - 24) * 64, P.od_d_k_norm + 64);
        else headnorm_inplace(row + 2560 + (h - 26) * 64, P.od_d_k_norm + 128);
    }
}

DEV void ph_attn0(const Params& P, int gtid, int gsz) {
    const long total = (long)T * 16;
    for (long i = gtid; i < total; i += gsz) {
        const int hh = (int)(i / T), t = (int)(i % T);
        const int b = t / S, s = t % S;
        const bf16* base = P.proj + (size_t)b * S * LDP;
        float q[64], o[64];
#pragma unroll
        for (int d = 0; d < 64; ++d) o[d] = 0.f;
        if (hh < 8) {
            const int kvh = hh >> 2;
            load64(base + (size_t)s * LDP + hh * 64, q);
            const float sl = slope_of(hh);
            float m = NEG, l = 0.f;
            const int s0 = s - 127 < 0 ? 0 : s - 127;
            for (int sp = s0; sp <= s; ++sp) {
                const bf16* kr = base + (size_t)sp * LDP + 512 + kvh * 64;
                const float sc = dot64(q, kr) * 0.125f - sl * (float)(s - sp);
                os_update(sc, kr + 128, m, l, o);
            }
            const float sk = P.ev_sink[hh];
            const float mx = m > sk ? m : sk;
            const float scale = expf(m - mx);
            const float den = l * scale + expf(sk - mx);
            const float f = scale / den;
            bf16* op = P.o + (size_t)t * D + hh * 64;
#pragma unroll
            for (int d = 0; d < 64; ++d) op[d] = f2bf(o[d] * f);
        } else {
            const int h = hh - 8;
            load64(base + (size_t)s * LDP + 768 + h * 64, q);
            float acc = 0.f;
            for (int sp = s - 1; sp >= 0; --sp) {
                const bf16* kr = base + (size_t)sp * LDP + 1280 + h * 64;
                const float z = dot64(q, kr) * 0.125f;
                const float ls = (z < 0.f ? z : 0.f) - log1pf(expf(-fabsf(z)));
                const float a = expf(ls + acc);
                const bf16* vr = kr + 512;
#pragma unroll
                for (int d = 0; d < 64; ++d) o[d] += a * bf2f(vr[d]);
                acc += ls - z;
                if (acc < -110.f) break;
            }
            bf16* op = P.o + (size_t)t * D + 512 + h * 64;
#pragma unroll
            for (int d = 0; d < 64; ++d) op[d] = f2bf(o[d]);
        }
    }
}

DEV void ph_gemm_out(const bf16* o, const float* W, const float* resid, float* out, int gtid, int gsz) {
    const long total = (long)T * D;
    for (long i = gtid; i < total; i += gsz) {
        const int t = (int)(i / D), c = (int)(i % D);
        const bf16* a = o + (size_t)t * D;
        float acc = 0.f;
        for (int k = 0; k < D; ++k) acc += bf2f(a[k]) * W[(size_t)k * D + c];
        out[i] = resid[i] + acc;
    }
}

DEV void ph_moe_route(const Params& P, int layer, int gtid, int gsz) {
    const float* g = P.moe_norm + layer * D;
    const float* wgrp = P.moe_w_grp + (size_t)layer * D * 4;
    const float* wexp = P.moe_w_exp + (size_t)layer * D * 32;
    const float* bgrp = P.moe_b_grp + layer * 4;
    const float* bexp = P.moe_b_exp + layer * 32;
    for (int t = gtid; t < T; t += gsz) {
        const float* r = P.out + (size_t)t * D;
        float ss = 0.f;
        for (int k = 0; k < D; ++k) ss += r[k] * r[k];
        const float rs = rsqrtf(ss * (1.0f / D) + EPS);
        P.rstd[t] = rs;
        float lg[4], le[32];
#pragma unroll
        for (int j = 0; j < 4; ++j) lg[j] = 0.f;
#pragma unroll
        for (int j = 0; j < 32; ++j) le[j] = 0.f;
        for (int k = 0; k < D; ++k) {
            const float h = r[k] * rs * g[k];
#pragma unroll
            for (int j = 0; j < 4; ++j) lg[j] += h * wgrp[k * 4 + j];
#pragma unroll
            for (int j = 0; j < 32; ++j) le[j] += h * wexp[k * 32 + j];
        }
#pragma unroll
        for (int j = 0; j < 4; ++j) lg[j] += bgrp[j];
#pragma unroll
        for (int j = 0; j < 32; ++j) le[j] += bexp[j];
        int gs = 0; float gm = lg[0];
#pragma unroll
        for (int j = 1; j < 4; ++j) if (lg[j] > gm) { gm = lg[j]; gs = j; }
        float gz = 0.f;
#pragma unroll
        for (int j = 0; j < 4; ++j) gz += expf(lg[j] - gm);
        const float pg = 1.0f / gz;
        float w[8];
#pragma unroll
        for (int j = 0; j < 8; ++j) w[j] = gs == 0 ? le[j] : gs == 1 ? le[8 + j] : gs == 2 ? le[16 + j] : le[24 + j];
        int i1 = 0; float m1 = w[0];
#pragma unroll
        for (int j = 1; j < 8; ++j) if (w[j] > m1) { m1 = w[j]; i1 = j; }
        int i2 = -1; float m2 = -3e38f;
#pragma unroll
        for (int j = 0; j < 8; ++j) if (j != i1 && w[j] > m2) { m2 = w[j]; i2 = j; }
        const float e2 = expf(m2 - m1);
        const float w1 = pg / (1.0f + e2), w2 = pg * e2 / (1.0f + e2);
        P.eid[t * 2 + 0] = gs * 8 + i1; P.eid[t * 2 + 1] = gs * 8 + i2;
        P.ew[t * 2 + 0] = w1; P.ew[t * 2 + 1] = w2;
    }
}

DEV void ph_moe_hidden(const Params& P, int layer, int gtid, int gsz) {
    const float* g = P.moe_norm + layer * D;
    const long total = (long)T * 512;
    for (long i = gtid; i < total; i += gsz) {
        const int t = (int)(i >> 9), slot = (int)((i >> 8) & 1), f = (int)(i & 255);
        const int e = P.eid[t * 2 + slot];
        const float* wg = P.moe_w_gate + ((size_t)(layer * 32 + e) * D) * 256 + f;
        const float* wu = P.moe_w_up + ((size_t)(layer * 32 + e) * D) * 256 + f;
        const float* r = P.out + (size_t)t * D;
        const float rs = P.rstd[t];
        float a = 0.f, u = 0.f;
        for (int k = 0; k < D; ++k) {
            const float h = r[k] * rs * g[k];
            a += h * wg[(size_t)k * 256];
            u += h * wu[(size_t)k * 256];
        }
        const float sg = a / (1.0f + expf(-a));
        P.hmid[i] = sg * u;
    }
}

DEV void ph_moe_out(const Params& P, int layer, int gtid, int gsz) {
    const long total = (long)T * D;
    for (long i = gtid; i < total; i += gsz) {
        const int t = (int)(i / D), c = (int)(i % D);
        float tot = 0.f;
        for (int slot = 0; slot < 2; ++slot) {
            const int e = P.eid[t * 2 + slot];
            const float* wd = P.moe_w_down + ((size_t)(layer * 32 + e) * 256) * D + c;
            const float* hm = P.hmid + ((size_t)t * 2 + slot) * 256;
            float acc = 0.f;
            for (int f = 0; f < 256; ++f) acc += hm[f] * wd[(size_t)f * D];
            tot += P.ew[t * 2 + slot] * acc;
        }
        P.out[i] += tot;
    }
}

DEV void ph_prep1(const Params& P, int gtid, int gsz) {
    const int n1 = NB * 8 * 8 * 64;
    for (int i = gtid; i < n1; i += gsz) {
        const int d = i & 63, n = (i >> 6) & 7, h = (i >> 9) & 7, b = i >> 12;
        const bf16* kp = P.proj + ((size_t)b * S + n * 256) * LDP + 512 + h * 64 + d;
        float s = 0.f;
        for (int j = 0; j < 256; ++j) s += bf2f(kp[(size_t)j * LDP]);
        P.kmean[i] = s * (1.0f / 256);
    }
    const int n2 = 2 * NB * NCMP * 2;
    for (int i = gtid; i < n2; i += gsz) {
        const int hkv = i & 1; int r = i >> 1; const int n = r % NCMP; r /= NCMP; const int b = r % NB; const int which = r / NB;
        const float* pos = P.od_cmp_pos + which * 32 * 64;
        const float* w = P.od_cmp_w + (size_t)which * 32 * 64 * 64;
        const bf16* xp = P.proj + ((size_t)b * S + n * 16) * LDP + (which ? 2176 : 2048) + hkv * 64;
        float acc[64];
#pragma unroll
        for (int e = 0; e < 64; ++e) acc[e] = 0.f;
        for (int l = 0; l < 32; ++l)
            for (int d = 0; d < 64; ++d) {
                const float xv = bf2f(xp[(size_t)l * LDP + d]) + pos[l * 64 + d];
                const float* wr = w + ((size_t)l * 64 + d) * 64;
#pragma unroll
                for (int e = 0; e < 64; ++e) acc[e] += xv * wr[e];
            }
        if (which == 0) {
            float ss = 0.f;
#pragma unroll
            for (int e = 0; e < 64; ++e) ss += acc[e] * acc[e];
            const float rs = rsqrtf(ss * (1.0f / 64) + EPS);
#pragma unroll
            for (int e = 0; e < 64; ++e) acc[e] *= rs * P.od_d_k_norm[e];
        }
        bf16* op = P.kvcmp + (((size_t)(which * NB + b) * NCMP + n) * 2 + hkv) * 64;
#pragma unroll
        for (int e = 0; e < 64; ++e) op[e] = f2bf(acc[e]);
    }
}

DEV int cmp_count(int s) { int c = s >= 31 ? (s - 31) / 16 + 1 : 0; return c > NCMP ? NCMP : c; }

DEV void ph_nsa_cmp(const Params& P, int gtid, int gsz) {
    const long total = (long)T * 8;
    for (long i = gtid; i < total; i += gsz) {
        const int hh = (int)(i / T), t = (int)(i % T);
        const int b = t / S, s = t % S, hkv = hh >> 2;
        float q[64], o[64];
        load64(P.proj + (size_t)t * LDP + 1536 + hh * 64, q);
#pragma unroll
        for (int d = 0; d < 64; ++d) o[d] = 0.f;
        const float sl = slope_of(hh);
        float m = NEG, l = 0.f;
        const int cnt = cmp_count(s);
        const bf16* kc = P.kvcmp + (((size_t)(0 * NB + b) * NCMP) * 2 + hkv) * 64;
        const bf16* vc = P.kvcmp + (((size_t)(1 * NB + b) * NCMP) * 2 + hkv) * 64;
        for (int n = 0; n < cnt; ++n) {
            const float sc = dot64(q, kc + (size_t)n * 128) * 0.125f - sl * (float)(s - (n * 16 + 31));
            os_update(sc, vc + (size_t)n * 128, m, l, o);
        }
        const float inv = cnt > 0 ? 1.0f / l : 0.f;
        float* op = P.ocmp + ((size_t)t * 8 + hh) * 64;
#pragma unroll
        for (int d = 0; d < 64; ++d) op[d] = o[d] * inv;
        P.cml[((size_t)t * 8 + hh) * 2 + 0] = m;
        P.cml[((size_t)t * 8 + hh) * 2 + 1] = l;
    }
}

DEV void ph_nsa_select(const Params& P, int gtid, int gsz) {
    const long total = (long)T * 64;
    for (long i = gtid; i < total; i += gsz) {
        const int j = (int)(i & 31), hkv = (int)((i >> 5) & 1), t = (int)(i >> 6);
        const int b = t / S, s = t % S, cur = s >> 6;
        float score = NEG;
        if (j <= cur) {
            const int cnt = cmp_count(s);
            const bf16* kc = P.kvcmp + (((size_t)(0 * NB + b) * NCMP) * 2 + hkv) * 64;
            float p = 0.f;
            int n0 = 4 * j - 1; if (n0 < 0) n0 = 0;
            int n1 = 4 * j + 3; if (n1 > NCMP - 1) n1 = NCMP - 1;
            for (int g = 0; g < 4; ++g) {
                const int hh = hkv * 4 + g;
                float q[64];
                load64(P.proj + (size_t)t * LDP + 1536 + hh * 64, q);
                const float sl = slope_of(hh);
                const float m = P.cml[((size_t)t * 8 + hh) * 2 + 0], l = P.cml[((size_t)t * 8 + hh) * 2 + 1];
                for (int n = n0; n <= n1; ++n)
                    if (n < cnt) {
                        const float sc = dot64(q, kc + (size_t)n * 128) * 0.125f - sl * (float)(s - (n * 16 + 31));
                        p += expf(sc - m) / l;
                    }
            }
            const bool forced = (j == 0) || (j == cur) || (j == cur - 1);
            score = p + (forced ? 1000.0f : 0.0f);
        }
        P.pslc[i] = score;
    }
}

DEV void ph_nsa_topk(const Params& P, int gtid, int gsz) {
    const int total = T * 2;
    for (int i = gtid; i < total; i += gsz) {
        const int t = i >> 1;
        const int s = t % S, cur = s >> 6;
        const float* sc = P.pslc + (size_t)i * 32;
        unsigned mask = 0;
        for (int j = 0; j <= cur; ++j) {
            const float sj = sc[j];
            int rank = 0;
            for (int k = 0; k < 32; ++k) { const float sk = sc[k]; rank += (sk > sj || (sk == sj && k < j)) ? 1 : 0; }
            if (rank < 16) mask |= 1u << j;
        }
        P.selmask[i] = mask;
    }
}

DEV void ph_attn1(const Params& P, int gtid, int gsz) {
    const long total = (long)T * 16;
    for (long i = gtid; i < total; i += gsz) {
        const int hh = (int)(i / T), t = (int)(i % T);
        const int b = t / S, s = t % S;
        const bf16* base = P.proj + (size_t)b * S * LDP;
        float q[64], o[64];
#pragma unroll
        for (int d = 0; d < 64; ++d) o[d] = 0.f;
        if (hh < 8) {
            const int h = hh, own = s >> 8;
            load64(base + (size_t)s * LDP + h * 64, q);
            const float sl = slope_of(h);
            float gt[8];
#pragma unroll
            for (int n = 0; n < 8; ++n) gt[n] = n < own ? dot64f(q, P.kmean + ((size_t)(b * 8 + h) * 8 + n) * 64) : NEG;
            unsigned sel = 0;
#pragma unroll
            for (int n = 0; n < 8; ++n) {
                int rank = 0;
#pragma unroll
                for (int k = 0; k < 8; ++k) rank += (gt[k] > gt[n] || (gt[k] == gt[n] && k < n)) ? 1 : 0;
                if (rank < 3 && n < own) sel |= 1u << n;
            }
            float m = NEG, l = 0.f;
            for (int n = 0; n < own; ++n) {
                if (!((sel >> n) & 1)) continue;
                for (int kk = 0; kk < 256; ++kk) {
                    const int kp = n * 256 + kk;
                    const bf16* kr = base + (size_t)kp * LDP + 512 + h * 64;
                    const float sc = dot64(q, kr) * 0.125f - sl * (float)(s - kp);
                    os_update(sc, kr + 512, m, l, o);
                }
            }
            for (int kp = own * 256; kp <= s; ++kp) {
                const bf16* kr = base + (size_t)kp * LDP + 512 + h * 64;
                const float sc = dot64(q, kr) * 0.125f - sl * (float)(s - kp);
                os_update(sc, kr + 512, m, l, o);
            }
            const float inv = 1.0f / l;
            bf16* op = P.o + (size_t)t * D + h * 64;
#pragma unroll
            for (int d = 0; d < 64; ++d) op[d] = f2bf(o[d] * inv);
        } else {
            const int h = hh - 8, hkv = h >> 2, cur = s >> 6;
            load64(base + (size_t)s * LDP + 1536 + h * 64, q);
            const float sl = slope_of(h);
            const bf16* grow = base + (size_t)s * LDP + 2816 + h * 3;
            const float g0 = 1.0f / (1.0f + expf(-bf2f(grow[0])));
            const float g1 = 1.0f / (1.0f + expf(-bf2f(grow[1])));
            const float g2 = 1.0f / (1.0f + expf(-bf2f(grow[2])));
            float acc[64];
            const float* oc = P.ocmp + ((size_t)t * 8 + h) * 64;
#pragma unroll
            for (int d = 0; d < 64; ++d) acc[d] = g0 * oc[d];
            const unsigned mask = P.selmask[t * 2 + hkv];
            float m = NEG, l = 0.f;
            for (int j = 0; j <= cur; ++j) {
                if (!((mask >> j) & 1)) continue;
                for (int kk = 0; kk < 64; ++kk) {
                    const int kp = j * 64 + kk;
                    if (kp > s) break;
                    const bf16* kr = base + (size_t)kp * LDP + 2304 + hkv * 64;
                    const float sc = dot64(q, kr) * 0.125f - sl * (float)(s - kp);
                    os_update(sc, kr + 128, m, l, o);
                }
            }
            {
                const float f = g1 / l;
#pragma unroll
                for (int d = 0; d < 64; ++d) { acc[d] += f * o[d]; o[d] = 0.f; }
            }
            m = NEG; l = 0.f;
            const int s0 = s - 511 < 0 ? 0 : s - 511;
            for (int kp = s0; kp <= s; ++kp) {
                const bf16* kr = base + (size_t)kp * LDP + 2560 + hkv * 64;
                const float sc = dot64(q, kr) * 0.125f - sl * (float)(s - kp);
                os_update(sc, kr + 128, m, l, o);
            }
            {
                const float f = g2 / l;
#pragma unroll
                for (int d = 0; d < 64; ++d) acc[d] += f * o[d];
            }
            bf16* op = P.o + (size_t)t * D + 512 + h * 64;
#pragma unroll
            for (int d = 0; d < 64; ++d) op[d] = f2bf(acc[d]);
        }
    }
}

namespace pg8 {
#define PG8_LAS __attribute__((address_space(3)))
typedef unsigned short bf16_t;
typedef short bf16x8 __attribute__((ext_vector_type(8)));
typedef float f32x4 __attribute__((ext_vector_type(4)));
typedef unsigned u32x4 __attribute__((ext_vector_type(4)));
constexpr int BM = 256, BK = 64, HALF = 128, HTB = HALF * BK * 2, STAGE_BYTES = 8 * HTB, NXCD = 8, WGM = 8;

__host__ __device__ __forceinline__ int lds_byte(int r, int c) { const int st = (r >> 4) * 2 + (c >> 5), rr = r & 15, cc = c & 31, ob = rr * 64 + cc * 2; return st * 1024 + (ob ^ (((ob >> 9) & 1) << 5)); }
__host__ __device__ __forceinline__ void stage_rc(int b, int& R, int& C) { const int st = b / 1024, sb = b % 1024, swz = sb ^ (((sb >> 9) & 1) << 5); R = (st >> 1) * 16 + swz / 64; C = (st & 1) * 32 + (swz % 64) / 2; }
__host__ __device__ __forceinline__ int perm32(int rho) { const int n = rho >> 4, i = rho & 15; return 8 * (i >> 2) + 4 * n + (i & 3); }

struct Unit { const char* A; const char* B; int pm, pn; };

struct StaticOrder {
    int nM, nN, nwg, G, c; const char* A; const char* Bt; size_t tstep;
    __device__ void init(const bf16_t* A_, const bf16_t* Bt_, int M, int N, int K, int G_, int c_) { nM = M / BM; nN = N / BM; nwg = nM * nN; G = G_; c = c_; A = (const char*)A_; Bt = (const char*)Bt_; tstep = (size_t)BM * K * 2; }
    __device__ bool next(int i, Unit& u) const {
        const long L = (long)i * G + c; if (L >= nwg) return false;
        int wgid = (int)L; { const int q = nwg / NXCD, r = nwg % NXCD, xcd = wgid % NXCD, off = wgid / NXCD; wgid = (xcd < r ? xcd * (q + 1) : r * (q + 1) + (xcd - r) * q) + off; }
        const int nig = WGM * nN, gid = wgid / nig, fm = gid * WGM, gsz = (nM - fm) < WGM ? (nM - fm) : WGM;
        u.pm = fm + ((wgid % nig) % gsz); u.pn = (wgid % nig) / gsz; u.A = A + (size_t)u.pm * tstep; u.B = Bt + (size_t)u.pn * tstep; return true;
    }
};

__device__ __forceinline__ unsigned cvt_pk_bf16(float lo, float hi) { unsigned r; asm volatile("v_cvt_pk_bf16_f32 %0, %1, %2" : "=v"(r) : "v"(lo), "v"(hi)); return r; }

struct EpiStoreBf16 {
    static constexpr bool PERM = true;
    bf16_t* O; int ldc;
    __device__ __forceinline__ void operator()(const f32x4 (&acc)[2][2][4][2], const Unit& u, int wr, int wc, int fr, int fq) const {
        const int row0 = u.pm * BM + wr * 64 + fr, col0 = u.pn * BM + wc * 32 + 8 * fq;
#pragma unroll
        for (int ai = 0; ai < 2; ++ai)
#pragma unroll
            for (int m = 0; m < 4; ++m) { bf16_t* rowp = O + (size_t)(row0 + ai * HALF + m * 16) * ldc + col0;
#pragma unroll
                for (int bj = 0; bj < 2; ++bj) { const f32x4 v0 = acc[ai][bj][m][0], v1 = acc[ai][bj][m][1];
                    u32x4 w; w.x = cvt_pk_bf16(v0[0], v0[1]); w.y = cvt_pk_bf16(v0[2], v0[3]); w.z = cvt_pk_bf16(v1[0], v1[1]); w.w = cvt_pk_bf16(v1[2], v1[3]);
                    *(u32x4*)(rowp + bj * HALF) = w; } }
    }
};
struct EpiResidF32 {
    static constexpr bool PERM = true;
    const float* R; float* O; int ldc;
    __device__ __forceinline__ void operator()(const f32x4 (&acc)[2][2][4][2], const Unit& u, int wr, int wc, int fr, int fq) const {
        const int row0 = u.pm * BM + wr * 64 + fr, col0 = u.pn * BM + wc * 32 + 8 * fq;
#pragma unroll
        for (int ai = 0; ai < 2; ++ai)
#pragma unroll
            for (int m = 0; m < 4; ++m) { const size_t ro = (size_t)(row0 + ai * HALF + m * 16) * ldc + col0;
#pragma unroll
                for (int bj = 0; bj < 2; ++bj) {
                    const f32x4 r0 = *(const f32x4*)(R + ro + bj * HALF), r1 = *(const f32x4*)(R + ro + bj * HALF + 4);
                    *(f32x4*)(O + ro + bj * HALF) = r0 + acc[ai][bj][m][0]; *(f32x4*)(O + ro + bj * HALF + 4) = r1 + acc[ai][bj][m][1]; } }
    }
};
struct EpiSiluMul {
    static constexpr bool PERM = true;
    bf16_t* H; int ldh;
    __device__ __forceinline__ void operator()(const f32x4 (&acc)[2][2][4][2], const Unit& u, int wr, int wc, int fr, int fq) const {
        const int row0 = u.pm * BM + wr * 64 + fr, col0 = u.pn * HALF + wc * 32 + 8 * fq;
#pragma unroll
        for (int ai = 0; ai < 2; ++ai)
#pragma unroll
            for (int m = 0; m < 4; ++m) { bf16_t* rowp = H + (size_t)(row0 + ai * HALF + m * 16) * ldh + col0;
                float h[8];
#pragma unroll
                for (int n = 0; n < 2; ++n)
#pragma unroll
                    for (int j = 0; j < 4; ++j) { const float g = acc[ai][0][m][n][j], up = acc[ai][1][m][n][j]; h[n * 4 + j] = g * up / (1.0f + __expf(-g)); }
                u32x4 w; w.x = cvt_pk_bf16(h[0], h[1]); w.y = cvt_pk_bf16(h[2], h[3]); w.z = cvt_pk_bf16(h[4], h[5]); w.w = cvt_pk_bf16(h[6], h[7]);
                *(u32x4*)rowp = w; }
    }
};

template <class Epi, class Sched>
__device__ __forceinline__ void gemm_phase(PG8_LAS unsigned char* lds, const int K, const Sched& S, const Epi& E, const int tid) {
    const int wid = __builtin_amdgcn_readfirstlane(tid >> 6), lane = tid & 63, wr = wid >> 2, wc = wid & 3, fr = lane & 15, fq = lane >> 4;
    const int nt = K / BK;
    unsigned voffA[2], voffB[2];
#pragma unroll
    for (int i = 0; i < 2; ++i) { int R, C; stage_rc(tid * 16 + i * 8192, R, C); const int Rb = Epi::PERM ? ((R & ~31) + perm32(R & 31)) : R;
        voffA[i] = (unsigned)(R * K + C) * 2u; voffB[i] = (unsigned)(Rb * K + C) * 2u; }
    const size_t kstep = (size_t)(BK * 2);
    const size_t hstep = (size_t)HALF * K * 2;
    const unsigned ldsw = (unsigned)wid * 1024u;
    const int aoff = lds_byte(wr * 64 + fr, fq * 8), boff = lds_byte(wc * 32 + fr, fq * 8);
#define PG8_SA(b, h) (((b) * 2 + (h)) * HTB)
#define PG8_SB(b, h) ((4 + (b) * 2 + (h)) * HTB)
#define PG8_STAGE(bufoff, gbase, voff) do { _Pragma("unroll") for (int _i = 0; _i < 2; ++_i) \
        __builtin_amdgcn_global_load_lds((const unsigned*)((const char*)(gbase) + (voff)[_i]), (PG8_LAS unsigned*)(lds + (bufoff) + ldsw + _i * 8192), 16, 0, 0); } while (0)
#define PG8_LDA(dst, b, h) do { _Pragma("unroll") for (int m = 0; m < 4; ++m) _Pragma("unroll") for (int k = 0; k < 2; ++k) dst[m][k] = *(const PG8_LAS bf16x8*)(lds + PG8_SA(b, h) + aoff + m * 2048 + k * 1024); } while (0)
#define PG8_LDB(dst, b, h) do { _Pragma("unroll") for (int n = 0; n < 2; ++n) _Pragma("unroll") for (int k = 0; k < 2; ++k) dst[n][k] = *(const PG8_LAS bf16x8*)(lds + PG8_SB(b, h) + boff + n * 2048 + k * 1024); } while (0)
#define PG8_MMA(ai, bj, At, Bt) do { __builtin_amdgcn_s_setprio(1); _Pragma("unroll") for (int m = 0; m < 4; ++m) _Pragma("unroll") for (int n = 0; n < 2; ++n) _Pragma("unroll") for (int k = 0; k < 2; ++k) \
        acc[ai][bj][m][n] = __builtin_amdgcn_mfma_f32_16x16x32_bf16(Bt[n][k], At[m][k], acc[ai][bj][m][n], 0, 0, 0); __builtin_amdgcn_s_setprio(0); } while (0)
#define PG8_WAIT_V(n) asm volatile("s_waitcnt vmcnt(" #n ")" ::: "memory")
#define PG8_WAIT_L(n) asm volatile("s_waitcnt lgkmcnt(" #n ")" ::: "memory")
#define PG8_BAR __builtin_amdgcn_s_barrier()
#define PG8_SCHED __builtin_amdgcn_sched_barrier(0)
    Unit cur, nxt; int ui = 0;
    if (!S.next(0, cur)) return;
    f32x4 acc[2][2][4][2];
#pragma unroll
    for (int a = 0; a < 2; ++a)
#pragma unroll
        for (int b = 0; b < 2; ++b)
#pragma unroll
            for (int m = 0; m < 4; ++m)
#pragma unroll
                for (int n = 0; n < 2; ++n) acc[a][b][m][n] = (f32x4){0.f, 0.f, 0.f, 0.f};
    bf16x8 At[4][2], B0[2][2], B1[2][2];
    const char* cA = cur.A; const char* cB = cur.B;
    PG8_STAGE(PG8_SB(0, 0), cB, voffB); PG8_STAGE(PG8_SB(0, 1), cB + hstep, voffB); PG8_STAGE(PG8_SA(0, 0), cA, voffA); PG8_STAGE(PG8_SA(0, 1), cA + hstep, voffA);
    if (wr == 1) PG8_BAR;
    PG8_WAIT_V(2); PG8_BAR;
    PG8_STAGE(PG8_SB(1, 0), cB + kstep, voffB); PG8_STAGE(PG8_SA(1, 0), cA + kstep, voffA); PG8_STAGE(PG8_SB(1, 1), cB + hstep + kstep, voffB);
    PG8_WAIT_V(6); PG8_BAR;
    for (;;) {
        const bool has_next = S.next(ui + 1, nxt);
        const char* nA = has_next ? nxt.A : cA; const char* nB = has_next ? nxt.B : cB;
        for (int t = 0; t < nt; t += 2) {
            const bool last = (t == nt - 2);
            const char* a1 = cA + (size_t)(t + 1) * kstep;
            const char* a2 = last ? nA : cA + (size_t)(t + 2) * kstep; const char* b2 = last ? nB : cB + (size_t)(t + 2) * kstep;
            const char* a3 = a2 + kstep; const char* b3 = b2 + kstep;
            PG8_LDB(B0, 0, 0); PG8_LDB(B1, 0, 1); PG8_SCHED; PG8_LDA(At, 0, 0); PG8_STAGE(PG8_SA(1, 1), a1 + hstep, voffA);
            PG8_WAIT_V(8); PG8_WAIT_L(0); PG8_BAR; PG8_MMA(0, 0, At, B0); PG8_MMA(0, 1, At, B1); PG8_BAR; PG8_SCHED;
            PG8_LDA(At, 0, 1); PG8_STAGE(PG8_SB(0, 0), b2, voffB); PG8_STAGE(PG8_SB(0, 1), b2 + hstep, voffB); PG8_STAGE(PG8_SA(0, 0), a2, voffA);
            PG8_WAIT_V(8); PG8_WAIT_L(0); PG8_BAR; PG8_MMA(1, 0, At, B0); PG8_MMA(1, 1, At, B1); PG8_BAR; PG8_SCHED;
            PG8_LDB(B0, 1, 0); PG8_LDB(B1, 1, 1); PG8_SCHED; PG8_LDA(At, 1, 0); PG8_STAGE(PG8_SA(0, 1), a2 + hstep, voffA);
            PG8_WAIT_V(8); PG8_WAIT_L(0); PG8_BAR; PG8_MMA(0, 0, At, B0); PG8_MMA(0, 1, At, B1); PG8_BAR; PG8_SCHED;
            PG8_LDA(At, 1, 1); PG8_STAGE(PG8_SB(1, 0), b3, voffB); PG8_STAGE(PG8_SB(1, 1), b3 + hstep, voffB); PG8_STAGE(PG8_SA(1, 0), a3, voffA);
            PG8_WAIT_V(8); PG8_WAIT_L(0); PG8_BAR; PG8_MMA(1, 0, At, B0); PG8_MMA(1, 1, At, B1); PG8_BAR; PG8_SCHED;
        }
        if (wr == 0) PG8_BAR;
        { int fr2 = lane & 15, fq2 = lane >> 4; asm volatile("" : "+v"(fr2), "+v"(fq2)); E(acc, cur, wr, wc, fr2, fq2); }
        if (!has_next) break;
#pragma unroll
        for (int a = 0; a < 2; ++a)
#pragma unroll
            for (int b = 0; b < 2; ++b)
#pragma unroll
                for (int m = 0; m < 4; ++m)
#pragma unroll
                    for (int n = 0; n < 2; ++n) acc[a][b][m][n] = (f32x4){0.f, 0.f, 0.f, 0.f};
        cur = nxt; cA = nA; cB = nB; ++ui;
        if (wr == 1) PG8_BAR;
    }
    PG8_WAIT_V(0);
    PG8_BAR;
#undef PG8_SA
#undef PG8_SB
#undef PG8_STAGE
#undef PG8_LDA
#undef PG8_LDB
#undef PG8_MMA
#undef PG8_WAIT_V
#undef PG8_WAIT_L
#undef PG8_BAR
#undef PG8_SCHED
}
}

#define GAS __attribute__((address_space(1)))
#define LAS __attribute__((address_space(3)))
typedef unsigned v4u __attribute__((ext_vector_type(4)));
typedef float f32x4 __attribute__((ext_vector_type(4)));
typedef short bf16x8 __attribute__((ext_vector_type(8)));
constexpr int NWAVES = 8;
constexpr int RING_BYTES = 131072, LDSCTL_OFF = RING_BYTES, MISC_OFF = LDSCTL_OFF + 320, LDS_BYTES = 147456;
constexpr size_t MiB = 1u << 20;
constexpr size_t CTL_ZERO_BYTES = 1 * MiB;
constexpr int CW_BAR = 4096;
constexpr int CW_MOE = 65536;
#define LDS_WAIT() asm volatile("s_waitcnt lgkmcnt(0)" ::: "memory")
#define VM_WAIT() asm volatile("s_waitcnt vmcnt(0)" ::: "memory")
DEV unsigned pk2(float lo, float hi) { return (unsigned)f2bf(lo) | ((unsigned)f2bf(hi) << 16); }

#define XB_TMO      128
#define XB_XCNT(j)  (256  + 64 * (j))
#define XB_XSUB(j)  (1280 + 64 * (j))
#define XB_XGEN(j)  (2304 + 64 * (j))
#define XB_TOP      3328
#define XB_TOPGEN   3392
#define XCD_BAR_WORDS 3456
#define XB_SPIN_CAP (1u << 22)
DEV unsigned xb_ld(unsigned* p)              { return __hip_atomic_load(p, __ATOMIC_RELAXED, __HIP_MEMORY_SCOPE_AGENT); }
DEV unsigned xb_add(unsigned* p, unsigned v) { return __hip_atomic_fetch_add(p, v, __ATOMIC_RELAXED, __HIP_MEMORY_SCOPE_AGENT); }
DEV unsigned xb_xcc_id() { return (unsigned)__builtin_amdgcn_s_getreg((3 << 11) | 20) & 0xFu; }
#define XB_SPIN(cond, bar) do { unsigned _sp = 0; while (cond) { __builtin_amdgcn_s_sleep(1); \
    if ((++_sp & 255u) == 0u) { if (xb_ld(&(bar)[XB_TMO])) break; if (_sp > XB_SPIN_CAP) { atomicAdd(&(bar)[XB_TMO], 1u); break; } } } } while (0)
struct XcdBarrier { unsigned* bar; unsigned x; volatile LAS unsigned* st; };
DEV XcdBarrier xcd_barrier_post(unsigned* bar, volatile LAS unsigned* st) {
    XcdBarrier b; b.bar = bar; b.x = xb_xcc_id(); b.st = st;
    if (threadIdx.x == 0) (void)xb_add(&bar[XB_XCNT(b.x)], 1u);
    return b;
}
DEV void xcd_barrier_complete(unsigned* bar, unsigned x, unsigned& nloc, unsigned& nx) {
    const unsigned G = gridDim.x * gridDim.y * gridDim.z;
    unsigned sum, cnt, mine, sp = 0u;
    for (;;) {
        sum = 0u; cnt = 0u; mine = 0u;
#pragma unroll
        for (unsigned j = 0; j < 16; ++j) { const unsigned c = xb_ld(&bar[XB_XCNT(j)]); sum += c; cnt += (c > 0u) ? 1u : 0u; mine = (j == x) ? c : mine; }
        if (sum == G) break;
        __builtin_amdgcn_s_sleep(1);
        if ((++sp & 255u) == 0u) { if (xb_ld(&bar[XB_TMO])) break; if (sp > XB_SPIN_CAP) { atomicAdd(&bar[XB_TMO], 1u); break; } }
    }
    nloc = mine > 0u ? mine : 1u; nx = cnt > 0u ? cnt : 1u;
}
DEV void xcd_barrier(const XcdBarrier& b, const int tid_) {
    asm volatile("s_waitcnt vmcnt(0)" ::: "memory");
    __syncthreads();
    if (tid_ == 0) {
        unsigned* bar = b.bar;
        __builtin_amdgcn_s_waitcnt(0);
        unsigned nloc = b.st[0], nx = b.st[1];
        if (nloc == 0u) { xcd_barrier_complete(bar, b.x, nloc, nx); b.st[0] = nloc; b.st[1] = nx; }
        const unsigned old = xb_add(&bar[XB_XSUB(b.x)], 1u);
        const unsigned gen = old / nloc;
        if (old + 1u == (gen + 1u) * nloc) {
            __builtin_amdgcn_fence(__ATOMIC_RELEASE, "agent");
            asm volatile("s_waitcnt vmcnt(0)" ::: "memory");
            const unsigned og = xb_add(&bar[XB_TOP], 1u);
            const unsigned tg = og / nx;
            if (og + 1u == (tg + 1u) * nx) xb_add(&bar[XB_TOPGEN], 1u);
            else XB_SPIN(xb_ld(&bar[XB_TOPGEN]) == tg, bar);
            __builtin_amdgcn_fence(__ATOMIC_ACQUIRE, "agent");
            xb_add(&bar[XB_XGEN(b.x)], 1u);
            asm volatile("s_waitcnt vmcnt(0)" ::: "memory");
        } else {
            XB_SPIN(xb_ld(&bar[XB_XGEN(b.x)]) == gen, bar);
            __builtin_amdgcn_fence(__ATOMIC_ACQUIRE, "agent");
            asm volatile("s_waitcnt vmcnt(0)" ::: "memory");
        }
    }
    __syncthreads();
}

struct Frame {
    LAS unsigned char* lds;
    volatile LAS unsigned* MISC;
    int tid, lane, wave;
    int vcu, G;
};

DEV void refresh(Frame& F) { int l; asm volatile("v_mbcnt_lo_u32_b32 %0, -1, 0\n\tv_mbcnt_hi_u32_b32 %0, -1, %0" : "=v"(l)); F.lane = l; F.tid = F.wave * 64 + l; }
DEV float wave_sum(float v) {
#pragma unroll
    for (int o = 1; o < 64; o <<= 1) v += __shfl_xor(v, o);
    return v;
}
DEV void transpose_item(const float* W, int K, int N, bf16* WT, int k0, int n0, int dst_row0, LAS float* scr, int lane) {
    const bool okc = (n0 + (lane & 31)) < N;
#pragma unroll 8
    for (int i = 0; i < 32; ++i) { const int kk = 2 * i + (lane >> 5); scr[kk * 33 + (lane & 31)] = okc ? W[(size_t)(k0 + kk) * N + n0 + (lane & 31)] : 0.f; }
    LDS_WAIT(); asm volatile("" ::: "memory");
    const int c = lane & 7;
#pragma unroll
    for (int j = 0; j < 4; ++j) { const int n = (lane >> 3) + 8 * j; const LAS float* s = scr + (8 * c) * 33 + n;
        v4u o; o.x = pk2(s[0 * 33], s[1 * 33]); o.y = pk2(s[2 * 33], s[3 * 33]); o.z = pk2(s[4 * 33], s[5 * 33]); o.w = pk2(s[6 * 33], s[7 * 33]);
        if (n0 + n < N) *(GAS v4u*)(WT + (size_t)(dst_row0 + n) * K + k0 + 8 * c) = o; }
    LDS_WAIT(); asm volatile("" ::: "memory");
}
DEV float rms_row_to_bf16(int lane, const float* xrow, const float* gain, bf16* orow) {
    const GAS f32x4* xr = (const GAS f32x4*)xrow + lane;
    const GAS f32x4* gr = (const GAS f32x4*)gain + lane;
    f32x4 v[4]; float s = 0.f;
#pragma unroll
    for (int j = 0; j < 4; ++j) { v[j] = xr[64 * j]; s += (v[j].x * v[j].x + v[j].y * v[j].y) + (v[j].z * v[j].z + v[j].w * v[j].w); }
    const float rstd = 1.0f / sqrtf(wave_sum(s) * (1.f / D) + EPS);
    GAS unsigned long long* o8 = (GAS unsigned long long*)orow + lane;
#pragma unroll
    for (int j = 0; j < 4; ++j) { const f32x4 g = gr[64 * j];
        o8[64 * j] = (unsigned long long)pk2(v[j].x * rstd * g.x, v[j].y * rstd * g.y) | ((unsigned long long)pk2(v[j].z * rstd * g.z, v[j].w * rstd * g.w) << 32); }
    return rstd;
}

DEV void fp_convert_weights(const Params& P, Frame& F, int which) {
    LAS float* scr = (LAS float*)(F.lds + F.wave * 16384);
    const int gw = F.vcu * NWAVES + F.wave, NGW = F.G * NWAVES;
    if (which == 0) {
        constexpr int I_IN0 = 16 * 72, I_OUT = 16 * 32, I_IN1 = 16 * 89;
        constexpr int NIT = I_IN0 + I_OUT + I_IN1 + I_OUT;
        for (int it = gw; it < NIT; it += NGW) {
            int r = it;
            if (r < I_IN0) { const int kb = r / 72, nb = r % 72; transpose_item(P.ev_w_in, D, EVEN_IN, P.win0t, 64 * kb, 32 * nb, 32 * nb, scr, F.lane); continue; } r -= I_IN0;
            if (r < I_OUT) { const int kb = r / 32, nb = r % 32; transpose_item(P.ev_w_out, D, D, P.wout0t, 64 * kb, 32 * nb, 32 * nb, scr, F.lane); continue; } r -= I_OUT;
            if (r < I_IN1) { const int kb = r / 89, nb = r % 89; transpose_item(P.od_w_in, D, ODD_IN, P.win1t, 64 * kb, 32 * nb, 32 * nb, scr, F.lane); continue; } r -= I_IN1;
            { const int kb = r / 32, nb = r % 32; transpose_item(P.od_w_out, D, D, P.wout1t, 64 * kb, 32 * nb, 32 * nb, scr, F.lane); }
        }
    } else {
        const int layer = which - 1;
        constexpr int NIT = 32 * 384;
        for (int it = gw; it < NIT; it += NGW) {
            const int e = it / 384; int r = it % 384;
            const size_t eo = (size_t)(layer * 32 + e);
            if (r < 256) { const bool up = r >= 128; r &= 127; const int kb = r / 8, nb = r % 8; const int f0 = 32 * nb;
                const float* W = (up ? P.moe_w_up : P.moe_w_gate) + eo * D * 256;
                transpose_item(W, D, 256, P.wgut + (size_t)e * 512 * D, 64 * kb, f0, (f0 >> 7) * 256 + (up ? 128 : 0) + (f0 & 127), scr, F.lane);
            } else { r -= 256; const int kb = r / 32, nb = r % 32;
                transpose_item(P.moe_w_down + eo * 256 * D, 256, D, P.wdt + (size_t)e * D * 256, 64 * kb, 32 * nb, 32 * nb, scr, F.lane); }
        }
    }
}
DEV void fp_norm_rows(Frame& F, const float* src, const float* gain, bf16* xn) {
    const int gw = F.vcu * NWAVES + F.wave, NGW = F.G * NWAVES;
    for (int m = gw; m < T; m += NGW) rms_row_to_bf16(F.lane, src + (size_t)m * D, gain, xn + (size_t)m * D);
}

constexpr int TAB_OFF = MISC_OFF + 128;
constexpr int RT_PART_OFF = 0;
constexpr int RT_SS_OFF = 24576;
constexpr int RT_HIST_OFF = 25088;
typedef float f32x4v __attribute__((ext_vector_type(4)));

DEV void fp_prep_router(const Params& P, Frame& F) {
    const int gtid = F.vcu * NWAVES * 64 + F.tid, gsz = F.G * NWAVES * 64;
    for (int i = gtid; i < 2 * 48 * D; i += gsz) {
        const int k = i & (D - 1), j = (i >> 10) % 48, l = i / (48 * D);
        float w = 0.f;
        if (j < 4) w = P.moe_w_grp[((size_t)l * D + k) * 4 + j]; else if (j < 36) w = P.moe_w_exp[((size_t)l * D + k) * 32 + (j - 4)];
        w *= P.moe_norm[l * D + k];
        const bf16 hi = f2bf(w); const bf16 lo = f2bf(w - bf2f(hi));
        P.wr[((size_t)(l * 2 + 0) * 48 + j) * D + k] = hi;
        P.wr[((size_t)(l * 2 + 1) * 48 + j) * D + k] = lo;
    }
}

DEV void fp_route(const Params& P, Frame& F, int layer) {
    const int lane = F.lane, w = F.wave, rg = w & 3, kh = w >> 2;
    const bf16* wr_hi = P.wr + (size_t)(layer * 2 + 0) * 48 * D;
    const bf16* wr_lo = P.wr + (size_t)(layer * 2 + 1) * 48 * D;
    LAS float* part = (LAS float*)(F.lds + RT_PART_OFF);
    LAS float* ssp = (LAS float*)(F.lds + RT_SS_OFF);
    LAS unsigned* hist = (LAS unsigned*)(F.lds + RT_HIST_OFF);
    unsigned* cnt = P.ctl + CW_MOE + layer * 256;
    for (int tb = F.vcu; tb < T / 64; tb += F.G) {
        const int t0 = tb * 64;
        if (F.tid < 64) hist[F.tid] = 0u;
        const float* xrow = P.out + (size_t)(t0 + 16 * rg + (lane & 15)) * D + 512 * kh + 8 * (lane >> 4);
        pg8::f32x4 acc[3];
#pragma unroll
        for (int c = 0; c < 3; ++c) acc[c] = (pg8::f32x4){0.f, 0.f, 0.f, 0.f};
        float ss = 0.f;
        const size_t boff = (size_t)(lane & 15) * D + 512 * kh + 8 * (lane >> 4);
#pragma unroll 4
        for (int ks = 0; ks < 16; ++ks) {
            const f32x4v x0 = *(const f32x4v*)(xrow + 32 * ks), x1 = *(const f32x4v*)(xrow + 32 * ks + 4);
            float xv[8] = {x0.x, x0.y, x0.z, x0.w, x1.x, x1.y, x1.z, x1.w};
            bf16x8 ah, al;
#pragma unroll
            for (int j = 0; j < 8; ++j) { ss += xv[j] * xv[j]; const bf16 h = f2bf(xv[j]); ah[j] = (short)h; al[j] = (short)f2bf(xv[j] - bf2f(h)); }
#pragma unroll
            for (int c = 0; c < 3; ++c) {
                const bf16x8 bh = *(const bf16x8*)(wr_hi + boff + (size_t)16 * c * D + 32 * ks);
                const bf16x8 bl = *(const bf16x8*)(wr_lo + boff + (size_t)16 * c * D + 32 * ks);
                acc[c] = __builtin_amdgcn_mfma_f32_16x16x32_bf16(ah, bh, acc[c], 0, 0, 0);
                acc[c] = __builtin_amdgcn_mfma_f32_16x16x32_bf16(ah, bl, acc[c], 0, 0, 0);
                acc[c] = __builtin_amdgcn_mfma_f32_16x16x32_bf16(al, bh, acc[c], 0, 0, 0);
            }
        }
        ss += __shfl_xor(ss, 16); ss += __shfl_xor(ss, 32);
#pragma unroll
        for (int c = 0; c < 3; ++c)
#pragma unroll
            for (int r = 0; r < 4; ++r) part[(kh * 64 + 16 * rg + 4 * (lane >> 4) + r) * 48 + 16 * c + (lane & 15)] = acc[c][r];
        if (lane < 16) ssp[kh * 64 + 16 * rg + lane] = ss;
        __syncthreads();
        int e1 = 0, e2 = 0; float w1 = 0.f, w2 = 0.f; unsigned r1 = 0, r2 = 0;
        if (F.tid < 64) {
            const int t = t0 + F.tid;
            const float rs = 1.0f / sqrtf((ssp[F.tid] + ssp[64 + F.tid]) * (1.f / D) + EPS);
            P.rstd[t] = rs;
            float lg[4], le[32];
#pragma unroll
            for (int j = 0; j < 4; ++j) lg[j] = (part[F.tid * 48 + j] + part[(64 + F.tid) * 48 + j]) * rs + P.moe_b_grp[layer * 4 + j];
#pragma unroll
            for (int j = 0; j < 32; ++j) le[j] = (part[F.tid * 48 + 4 + j] + part[(64 + F.tid) * 48 + 4 + j]) * rs + P.moe_b_exp[layer * 32 + j];
            int gs = 0; float gm = lg[0];
#pragma unroll
            for (int j = 1; j < 4; ++j) if (lg[j] > gm) { gm = lg[j]; gs = j; }
            float gz = 0.f;
#pragma unroll
            for (int j = 0; j < 4; ++j) gz += expf(lg[j] - gm);
            const float pg = 1.0f / gz;
            float wv[8];
#pragma unroll
            for (int j = 0; j < 8; ++j) wv[j] = gs == 0 ? le[j] : gs == 1 ? le[8 + j] : gs == 2 ? le[16 + j] : le[24 + j];
            int i1 = 0; float m1 = wv[0];
#pragma unroll
            for (int j = 1; j < 8; ++j) if (wv[j] > m1) { m1 = wv[j]; i1 = j; }
            int i2 = -1; float m2 = -3e38f;
#pragma unroll
            for (int j = 0; j < 8; ++j) if (j != i1 && wv[j] > m2) { m2 = wv[j]; i2 = j; }
            const float ex2 = expf(m2 - m1);
            w1 = pg / (1.0f + ex2); w2 = pg * ex2 / (1.0f + ex2);
            e1 = gs * 8 + i1; e2 = gs * 8 + i2;
            r1 = __hip_atomic_fetch_add(&hist[e1], 1u, __ATOMIC_RELAXED, __HIP_MEMORY_SCOPE_WORKGROUP); r2 = __hip_atomic_fetch_add(&hist[e2], 1u, __ATOMIC_RELAXED, __HIP_MEMORY_SCOPE_WORKGROUP);
        }
        __syncthreads();
        if (F.tid < 32) { const unsigned h = hist[F.tid]; hist[32 + F.tid] = h ? xb_add(&cnt[F.tid], h) : 0u; }
        __syncthreads();
        if (F.tid < 64) {
            const int t = t0 + F.tid;
            P.eid[t * 2 + 0] = e1; P.eid[t * 2 + 1] = e2; P.ew[t * 2 + 0] = w1; P.ew[t * 2 + 1] = w2;
            P.pos[t * 2 + 0] = (int)(hist[32 + e1] + r1); P.pos[t * 2 + 1] = (int)(hist[32 + e2] + r2);
        }
        __syncthreads();
    }
}

DEV void moe_table(const Params& P, Frame& F, int layer) {
    volatile LAS int* tab = (volatile LAS int*)(F.lds + TAB_OFF);
    if (F.tid == 0) {
        unsigned* cnt = P.ctl + CW_MOE + layer * 256;
        int acc = 0;
        for (int e = 0; e < 32; ++e) { tab[e] = acc; acc += (int)((xb_ld(&cnt[e]) + 255u) >> 8); }
        tab[32] = acc;
    }
    __syncthreads();
}

DEV void fp_gather(const Params& P, Frame& F, int layer) {
    moe_table(P, F, layer);
    volatile LAS int* tab = (volatile LAS int*)(F.lds + TAB_OFF);
    const float* gain = P.moe_norm + layer * D;
    const int gw = F.vcu * NWAVES + F.wave, NGW = F.G * NWAVES, lane = F.lane;
    for (int t = gw; t < T; t += NGW) {
        const int e1 = P.eid[t * 2], e2 = P.eid[t * 2 + 1];
        const int p1 = tab[e1] * 256 + P.pos[t * 2], p2 = tab[e2] * 256 + P.pos[t * 2 + 1];
        const GAS f32x4* xr = (const GAS f32x4*)(P.out + (size_t)t * D) + lane;
        const GAS f32x4* gr = (const GAS f32x4*)gain + lane;
        const float rstd = P.rstd[t];
        GAS unsigned long long* o1 = (GAS unsigned long long*)(P.ha + (size_t)p1 * D) + lane;
        GAS unsigned long long* o2 = (GAS unsigned long long*)(P.ha + (size_t)p2 * D) + lane;
#pragma unroll
        for (int j = 0; j < 4; ++j) { const f32x4 v = xr[64 * j], g = gr[64 * j];
            const unsigned long long q = (unsigned long long)pk2(v.x * rstd * g.x, v.y * rstd * g.y) | ((unsigned long long)pk2(v.z * rstd * g.z, v.w * rstd * g.w) << 32);
            o1[64 * j] = q; o2[64 * j] = q; }
        if (lane == 0) { P.pos[t * 2] = p1; P.pos[t * 2 + 1] = p2; }
    }
}

struct ListOrder {
    int code[4]; int n, npn; const char* A; const char* Bt; size_t tstep;
    __device__ __forceinline__ bool next(int i, pg8::Unit& o) const {
        if (i >= n) return false;
        const int c = (i == 0) ? code[0] : (i == 1) ? code[1] : (i == 2) ? code[2] : code[3];
        const int tt = c >> 8, e = (c >> 3) & 31, pn = c & 7;
        o.pm = tt; o.pn = pn; o.A = A + (size_t)tt * tstep; o.B = Bt + (size_t)(e * npn + pn) * tstep; return true;
    }
};
DEV void moe_units(Frame& F, ListOrder& L, int npn, const bf16* A, const bf16* Bt, int K) {
    volatile LAS int* tab = (volatile LAS int*)(F.lds + TAB_OFF);
    const int ntile = tab[32], total = ntile * npn;
    L.tstep = (size_t)256 * K * 2; L.A = (const char*)A; L.Bt = (const char*)Bt; L.npn = npn;
    int n = 0;
#pragma unroll
    for (int i = 0; i < 4; ++i) {
        const int Lx = i * F.G + F.vcu;
        int code = 0;
        if (Lx < total) {
            const int tt = Lx / npn, pn = Lx % npn;
            int e = 0;
            for (int q = 1; q < 32; ++q) e += (tt >= tab[q]) ? 1 : 0;
            code = (tt << 8) | (e << 3) | pn;
            n = i + 1;
        }
        L.code[i] = __builtin_amdgcn_readfirstlane(code);
    }
    L.n = __builtin_amdgcn_readfirstlane(n);
}

DEV void fp_moe_gu(const Params& P, Frame& F, int layer) {
    moe_table(P, F, layer);
    ListOrder L; moe_units(F, L, 2, P.ha, P.wgut, D);
    pg8::EpiSiluMul E{P.hid, 256};
    pg8::gemm_phase(F.lds, D, L, E, F.tid);
}
DEV void fp_moe_dn(const Params& P, Frame& F, int layer) {
    moe_table(P, F, layer);
    ListOrder L; moe_units(F, L, 4, P.hid, P.wdt, 256);
    pg8::EpiStoreBf16 E{P.ha, D};
    pg8::gemm_phase(F.lds, 256, L, E, F.tid);
}
DEV void fp_combine(const Params& P, Frame& F, const float* gain2, bf16* xn) {
    const int gw = F.vcu * NWAVES + F.wave, NGW = F.G * NWAVES, lane = F.lane;
    for (int t = gw; t < T; t += NGW) {
        const int p1 = P.pos[t * 2], p2 = P.pos[t * 2 + 1];
        const float w1 = P.ew[t * 2], w2 = P.ew[t * 2 + 1];
        GAS f32x4* xr = (GAS f32x4*)(P.out + (size_t)t * D) + lane;
        const GAS unsigned long long* y1 = (const GAS unsigned long long*)(P.ha + (size_t)p1 * D) + lane;
        const GAS unsigned long long* y2 = (const GAS unsigned long long*)(P.ha + (size_t)p2 * D) + lane;
        f32x4 v[4]; float s = 0.f;
#pragma unroll
        for (int j = 0; j < 4; ++j) {
            v[j] = xr[64 * j];
            const unsigned long long a = y1[64 * j], b = y2[64 * j];
            v[j].x += w1 * u2f((unsigned)(a & 0xffffu) << 16) + w2 * u2f((unsigned)(b & 0xffffu) << 16);
            v[j].y += w1 * u2f((unsigned)((a >> 16) & 0xffffu) << 16) + w2 * u2f((unsigned)((b >> 16) & 0xffffu) << 16);
            v[j].z += w1 * u2f((unsigned)((a >> 32) & 0xffffu) << 16) + w2 * u2f((unsigned)((b >> 32) & 0xffffu) << 16);
            v[j].w += w1 * u2f((unsigned)((a >> 48) & 0xffffu) << 16) + w2 * u2f((unsigned)((b >> 48) & 0xffffu) << 16);
            xr[64 * j] = v[j];
            s += (v[j].x * v[j].x + v[j].y * v[j].y) + (v[j].z * v[j].z + v[j].w * v[j].w);
        }
        if (xn) {
            const float rstd = 1.0f / sqrtf(wave_sum(s) * (1.f / D) + EPS);
            const GAS f32x4* gr = (const GAS f32x4*)gain2 + lane;
            GAS unsigned long long* o8 = (GAS unsigned long long*)(xn + (size_t)t * D) + lane;
#pragma unroll
            for (int j = 0; j < 4; ++j) { const f32x4 g = gr[64 * j];
                o8[64 * j] = (unsigned long long)pk2(v[j].x * rstd * g.x, v[j].y * rstd * g.y) | ((unsigned long long)pk2(v[j].z * rstd * g.z, v[j].w * rstd * g.w) << 32); }
        }
    }
}

namespace att {
typedef float f32x16 __attribute__((ext_vector_type(16)));
typedef short s16x4 __attribute__((ext_vector_type(4)));
typedef short v4i16_t __attribute__((ext_vector_type(4)));
typedef LAS const char* lptr;
constexpr float LOG2E = 1.4426950408889634f;
constexpr int KS0 = 0, VS0 = 16384, SLOT = 8192;
constexpr float MNEG = -1e30f;

struct TileRegs { v4u k, v; };
DEV void tile_load(TileRegs& R, const bf16* Kg, const bf16* Vg, int pitch, int k0, int tid) {
    const int w = tid >> 6, lane = tid & 63;
    R.k = *(const GAS v4u*)(Kg + (size_t)(k0 + lane) * pitch + w * 8);
    R.v = *(const GAS v4u*)(Vg + (size_t)(k0 + 16 * (w & 3) + (lane >> 2)) * pitch + (w >> 2) * 32 + (lane & 3) * 8);
}
DEV void tile_store(LAS unsigned char* lds, int slot, const TileRegs& R, int tid) {
    *(LAS v4u*)(lds + KS0 + slot * SLOT + tid * 16) = R.k;
    *(LAS v4u*)(lds + VS0 + slot * SLOT + tid * 16) = R.v;
}
DEV void qk_tile(f32x16& p0, f32x16& p1, lptr Kslot, const bf16x8 (&qr)[4], int r32, int hi) {
    lptr kb = Kslot + hi * 1024 + r32 * 16;
    p0 = f32x16{}; p1 = f32x16{};
#pragma unroll
    for (int d0 = 0; d0 < 4; ++d0) {
        const bf16x8 b0 = *(const LAS bf16x8*)(kb + d0 * 2048);
        const bf16x8 b1 = *(const LAS bf16x8*)(kb + d0 * 2048 + 512);
        p0 = __builtin_amdgcn_mfma_f32_32x32x16_bf16(b0, qr[d0], p0, 0, 0, 0);
        p1 = __builtin_amdgcn_mfma_f32_32x32x16_bf16(b1, qr[d0], p1, 0, 0, 0);
    }
}
DEV s16x4 vtr(lptr p) { return __builtin_bit_cast(s16x4, __builtin_amdgcn_ds_read_tr16_b64_v4i16((LAS v4i16_t*)p)); }
DEV unsigned cvtpk(float lo, float hi) { unsigned r; asm volatile("v_cvt_pk_bf16_f32 %0, %1, %2" : "=v"(r) : "v"(lo), "v"(hi)); return r; }
DEV void pv_tile(f32x16 (&o)[2], lptr Vslot, const f32x16& p0, const f32x16& p1, int lane) {
    const int hi = lane >> 5;
    lptr vp = Vslot + ((lane >> 4) & 1) * 32 + (lane & 3) * 8 + (4 * hi + ((lane & 15) >> 2)) * 64;
    bf16x8 pf[4];
#pragma unroll
    for (int ks = 0; ks < 4; ++ks) {
        const f32x16& p = (ks < 2) ? p0 : p1; const int b = (ks & 1) * 8;
        v4u w; w.x = cvtpk(p[b + 0], p[b + 1]); w.y = cvtpk(p[b + 2], p[b + 3]); w.z = cvtpk(p[b + 4], p[b + 5]); w.w = cvtpk(p[b + 6], p[b + 7]);
        pf[ks] = __builtin_bit_cast(bf16x8, w);
    }
#pragma unroll
    for (int d0 = 0; d0 < 2; ++d0)
#pragma unroll
        for (int ks = 0; ks < 4; ++ks) {
            const s16x4 lo = vtr(vp + d0 * 4096 + ks * 1024), hh = vtr(vp + d0 * 4096 + ks * 1024 + 512);
            const bf16x8 vf = (bf16x8){lo[0], lo[1], lo[2], lo[3], hh[0], hh[1], hh[2], hh[3]};
            o[d0] = __builtin_amdgcn_mfma_f32_32x32x16_bf16(vf, pf[ks], o[d0], 0, 0, 0);
        }
}
DEV float lane_swap_max(float m) {
    auto rr = __builtin_amdgcn_permlane32_swap(__float_as_uint(m), __float_as_uint(m), false, false);
    return fmaxf(__uint_as_float(rr[0]), __uint_as_float(rr[1]));
}
DEV float lane_swap_sum(float m) {
    auto rr = __builtin_amdgcn_permlane32_swap(__float_as_uint(m), __float_as_uint(m), false, false);
    return __uint_as_float(rr[0]) + __uint_as_float(rr[1]);
}
DEV float lane_partner(float m, int hi) {
    auto rr = __builtin_amdgcn_permlane32_swap(__float_as_uint(m), __float_as_uint(m), false, false);
    return hi ? __uint_as_float(rr[0]) : __uint_as_float(rr[1]);
}

struct SoftState { float m, l; f32x16 o[2]; };
DEV void soft_reset(SoftState& s) { s.m = MNEG; s.l = 0.f; s.o[0] = f32x16{}; s.o[1] = f32x16{}; }

DEV void soft_tile(SoftState& st, f32x16& p0, f32x16& p1, float s2, float k0rel_f, int klo, int klim, bool need_mask, lptr Vslot, int lane) {
    const int hi = lane >> 5;
    const float c1 = 0.125f * LOG2E;
    const float base = s2 * (k0rel_f + (float)(4 * hi));
    float mx = MNEG;
#pragma unroll
    for (int r = 0; r < 16; ++r) {
        const int kr = (r & 3) + 8 * (r >> 2);
        float x0 = fmaf(p0[r], c1, fmaf(s2, (float)kr, base));
        float x1 = fmaf(p1[r], c1, fmaf(s2, (float)(kr + 32), base));
        if (need_mask) { x0 = (kr > klo && kr <= klim) ? x0 : MNEG; x1 = (kr + 32 > klo && kr + 32 <= klim) ? x1 : MNEG; }
        p0[r] = x0; p1[r] = x1;
        mx = fmaxf(mx, fmaxf(x0, x1));
    }
    mx = lane_swap_max(mx);
    const float mnew = fmaxf(st.m, mx);
    if (__any(mnew > st.m)) {
        const float alpha = __builtin_amdgcn_exp2f(st.m - mnew);
        st.l *= alpha;
#pragma unroll
        for (int r = 0; r < 16; ++r) { st.o[0][r] *= alpha; st.o[1][r] *= alpha; }
        st.m = mnew;
    }
    float ls = 0.f;
#pragma unroll
    for (int r = 0; r < 16; ++r) {
        p0[r] = __builtin_amdgcn_exp2f(p0[r] - st.m); p1[r] = __builtin_amdgcn_exp2f(p1[r] - st.m);
        ls += p0[r] + p1[r];
    }
    st.l += ls;
    pv_tile(st.o, Vslot, p0, p1, lane);
}

DEV void store_ot(const f32x16 (&o)[2], float f, bf16* orow, int hi) {
#pragma unroll
    for (int d0 = 0; d0 < 2; ++d0)
#pragma unroll
        for (int g = 0; g < 4; ++g) {
            const unsigned a = cvtpk(o[d0][4 * g] * f, o[d0][4 * g + 1] * f), b = cvtpk(o[d0][4 * g + 2] * f, o[d0][4 * g + 3] * f);
            *(GAS unsigned long long*)(orow + 32 * d0 + 8 * g + 4 * hi) = (unsigned long long)a | ((unsigned long long)b << 32);
        }
}
DEV void load_q(bf16x8 (&qr)[4], const bf16* qrow, int hi) {
#pragma unroll
    for (int d0 = 0; d0 < 4; ++d0) qr[d0] = *(const GAS bf16x8*)(qrow + 16 * d0 + 8 * hi);
}

template <class MaskF>
DEV void run_segment(Frame& F, SoftState& st, const bf16x8 (&qr)[4], const bf16* Kg, const bf16* Vg, int pitch, int t0, int t1, float s2, int qpos, const MaskF& mf) {
    const int tid = F.tid, lane = F.lane, r32 = lane & 31, hi = lane >> 5;
    if (t1 < t0) return;
    TileRegs R; tile_load(R, Kg, Vg, pitch, t0 * 64, tid);
    int slot = 0;
    for (int t = t0; t <= t1; ++t) {
        tile_store(F.lds, slot, R, tid);
        if (t < t1) tile_load(R, Kg, Vg, pitch, (t + 1) * 64, tid);
        __syncthreads();
        int klo, klim; mf(t, klo, klim);
        const bool any_valid = __any(klim >= 0 && klo < 60 && klim > klo);
        if (any_valid) {
            const bool need_mask = __any(klo >= 0 || klim < 60);
            f32x16 p0, p1;
            qk_tile(p0, p1, (lptr)(F.lds + KS0 + slot * SLOT), qr, r32, hi);
            soft_tile(st, p0, p1, s2, (float)(t * 64 - qpos), klo, klim, need_mask, (lptr)(F.lds + VS0 + slot * SLOT), lane);
        }
        slot ^= 1;
    }
    __syncthreads();
}
}

DEV void headnorm_group(bf16* row, int off, int nheads, const float* g, int lane) {
    const int hg = lane >> 3, ch = lane & 7;
    if (hg < nheads) {
        GAS v4u* p = (GAS v4u*)(row + off + hg * 64 + ch * 8);
        const v4u x = *p;
        float v[8] = {u2f(x.x << 16), u2f(x.x & 0xffff0000u), u2f(x.y << 16), u2f(x.y & 0xffff0000u), u2f(x.z << 16), u2f(x.z & 0xffff0000u), u2f(x.w << 16), u2f(x.w & 0xffff0000u)};
        float ss = 0.f;
#pragma unroll
        for (int j = 0; j < 8; ++j) ss += v[j] * v[j];
        ss += __shfl_xor(ss, 1); ss += __shfl_xor(ss, 2); ss += __shfl_xor(ss, 4);
        const float r = 1.0f / sqrtf(ss * (1.0f / 64) + EPS);
        const f32x4 g0 = *(const GAS f32x4*)(g + ch * 8), g1 = *(const GAS f32x4*)(g + ch * 8 + 4);
        v4u o; o.x = pk2(v[0] * r * g0.x, v[1] * r * g0.y); o.y = pk2(v[2] * r * g0.z, v[3] * r * g0.w); o.z = pk2(v[4] * r * g1.x, v[5] * r * g1.y); o.w = pk2(v[6] * r * g1.z, v[7] * r * g1.w);
        *p = o;
    }
}
DEV void fp_headnorm(const Params& P, Frame& F, int layer) {
    const int gw = F.vcu * NWAVES + F.wave, NGW = F.G * NWAVES, lane = F.lane;
    for (int t = gw; t < T; t += NGW) {
        bf16* row = P.proj + (size_t)t * LDP;
        if (layer == 0) {
            headnorm_group(row, 0, 8, P.ev_q_norm, lane);
            headnorm_group(row, 512, 2, P.ev_k_norm, lane);
        } else {
            headnorm_group(row, 0, 8, P.od_c_q_norm, lane);
            headnorm_group(row, 512, 8, P.od_c_k_norm, lane);
            headnorm_group(row, 1536, 8, P.od_d_q_norm, lane);
            headnorm_group(row, 2304, 2, P.od_d_k_norm + 64, lane);
            headnorm_group(row, 2560, 2, P.od_d_k_norm + 128, lane);
        }
    }
}

DEV void fp_prep1(const Params& P, Frame& F) {
    const int gw = F.vcu * NWAVES + F.wave, NGW = F.G * NWAVES, lane = F.lane;
    for (int i = gw; i < NB * 64; i += NGW) {
        const int n = i & 7, h = (i >> 3) & 7, b = i >> 6;
        const bf16* kp = P.proj + ((size_t)b * S + n * 256) * LDP + 512 + h * 64 + lane;
        float s0 = 0.f, s1 = 0.f, s2 = 0.f, s3 = 0.f;
#pragma unroll 4
        for (int j = 0; j < 256; j += 4) { s0 += bf2f(kp[(size_t)j * LDP]); s1 += bf2f(kp[(size_t)(j + 1) * LDP]); s2 += bf2f(kp[(size_t)(j + 2) * LDP]); s3 += bf2f(kp[(size_t)(j + 3) * LDP]); }
        P.kmean[(size_t)i * 64 + lane] = ((s0 + s1) + (s2 + s3)) * (1.0f / 256);
    }
    const int n2 = 2 * NB * NCMP * 2;
    for (int i = gw; i < n2; i += NGW) {
        const int hkv = i & 1; int r = i >> 1; const int n = r % NCMP; r /= NCMP; const int b = r % NB; const int which = r / NB;
        const float* pos = P.od_cmp_pos + which * 32 * 64;
        const float* wq = P.od_cmp_w + (size_t)which * 32 * 64 * 64 + lane;
        const bf16* xp = P.proj + ((size_t)b * S + n * 16) * LDP + (which ? 2176 : 2048) + hkv * 64 + lane;
        float a0 = 0.f, a1 = 0.f, a2 = 0.f, a3 = 0.f;
        for (int l = 0; l < 32; ++l) {
            const unsigned xv = f2u(bf2f(xp[(size_t)l * LDP]) + pos[l * 64 + lane]);
            const float* wl = wq + (size_t)l * 64 * 64;
#pragma unroll
            for (int d = 0; d < 64; d += 4) {
                a0 += u2f((unsigned)__builtin_amdgcn_readlane((int)xv, d)) * wl[(d + 0) * 64];
                a1 += u2f((unsigned)__builtin_amdgcn_readlane((int)xv, d + 1)) * wl[(d + 1) * 64];
                a2 += u2f((unsigned)__builtin_amdgcn_readlane((int)xv, d + 2)) * wl[(d + 2) * 64];
                a3 += u2f((unsigned)__builtin_amdgcn_readlane((int)xv, d + 3)) * wl[(d + 3) * 64];
            }
        }
        float acc = (a0 + a1) + (a2 + a3);
        if (which == 0) {
            const float rs = 1.0f / sqrtf(wave_sum(acc * acc) * (1.0f / 64) + EPS);
            acc *= rs * P.od_d_k_norm[lane];
        }
        P.kvcmp[(((size_t)(which * NB + b) * NCMP + n) * 2 + hkv) * 64 + lane] = f2bf(acc);
    }
}

DEV void sb_tile(att::f32x16& p0, att::f32x16& p1, float& carry, int lim, int hi) {
    using namespace att;
    const float c1 = 0.125f * LOG2E;
    f32x16 k0, k1;
    float cs[2][4];
#pragma unroll
    for (int hf = 0; hf < 2; ++hf)
#pragma unroll
        for (int g = 0; g < 4; ++g) {
            float s = 0.f;
#pragma unroll
            for (int i = 0; i < 4; ++i) {
                const int r = 4 * g + i, kr = i + 8 * g + 32 * hf;
                const float z2 = (hf ? p1[r] : p0[r]) * c1;
                const float e = __builtin_amdgcn_exp2f(-fabsf(z2));
                const float ls2 = fminf(z2, 0.f) - __builtin_amdgcn_logf(1.0f + e);
                const bool ok = kr < lim;
                const float lk2 = ok ? (ls2 - z2) : 0.f;
                if (hf) { p1[r] = ok ? ls2 : MNEG; k1[r] = lk2; } else { p0[r] = ok ? ls2 : MNEG; k0[r] = lk2; }
                s += lk2;
            }
            cs[hf][g] = s;
        }
    float run = carry;
#pragma unroll
    for (int hf = 1; hf >= 0; --hf)
#pragma unroll
        for (int g = 3; g >= 0; --g) {
            const float mine = cs[hf][g], other = lane_partner(mine, hi);
            float suf = hi ? run : run + other;
            run += mine + other;
#pragma unroll
            for (int i = 3; i >= 0; --i) {
                const int r = 4 * g + i;
                if (hf) { p1[r] = __builtin_amdgcn_exp2f(p1[r] + suf); suf += k1[r]; } else { p0[r] = __builtin_amdgcn_exp2f(p0[r] + suf); suf += k0[r]; }
            }
        }
    carry = run;
}

DEV void fp_attn0(const Params& P, Frame& F) {
    using namespace att;
    const int tid = F.tid, lane = F.lane, r32 = lane & 31, hi = lane >> 5, w = F.wave;
    for (int u = F.vcu; u < 1024; u += F.G) {
        if (u < 512) {
            const int b = u >> 6, h = (u >> 3) & 7, blk = u & 7;
            const bf16* base = P.proj + (size_t)b * S * LDP;
            const int q = blk * 256 + w * 32 + r32;
            bf16x8 qr[4]; load_q(qr, base + (size_t)q * LDP + 768 + h * 64, hi);
            const bf16* Kg = base + 1280 + h * 64; const bf16* Vg = base + 1792 + h * 64;
            f32x16 o[2]; o[0] = f32x16{}; o[1] = f32x16{};
            float carry = 0.f;
            const int tmax = blk * 4 + 3;
            const int tw = (blk * 256 + w * 32 + 31) >> 6;
            volatile LAS int* flag = (volatile LAS int*)(F.lds + 32768);
            if (tid < 3) flag[tid] = 0;
            TileRegs R; tile_load(R, Kg, Vg, LDP, tmax * 64, tid);
            int slot = 0; bool wave_done = false;
            for (int t = tmax; t >= 0; --t) {
                tile_store(F.lds, slot, R, tid);
                if (t > 0) tile_load(R, Kg, Vg, LDP, (t - 1) * 64, tid);
                __syncthreads();
                if (t < tmax && flag[(t + 1) % 3] == 0) break;
                if (tid == 0) flag[(t + 2) % 3] = 0;
                if (!wave_done && t <= tw) {
                    f32x16 p0, p1;
                    qk_tile(p0, p1, (lptr)(F.lds + KS0 + slot * SLOT), qr, r32, hi);
                    sb_tile(p0, p1, carry, q - t * 64 - 4 * hi, hi);
                    pv_tile(o, (lptr)(F.lds + VS0 + slot * SLOT), p0, p1, lane);
                    if (__all(carry < -150.f)) wave_done = true;
                }
                if (!wave_done && lane == 0) flag[t % 3] = 1;
                slot ^= 1;
            }
            __syncthreads();
            store_ot(o, 1.0f, P.o + (size_t)(b * S + q) * D + 512 + h * 64, hi);
        } else {
            const int v = u - 512, b = v >> 6, hkv = (v >> 5) & 1, c = v & 31;
            const bf16* base = P.proj + (size_t)b * S * LDP;
            const int hh = hkv * 4 + (w >> 1), q = c * 64 + (w & 1) * 32 + r32;
            bf16x8 qr[4]; load_q(qr, base + (size_t)q * LDP + hh * 64, hi);
            const float sl = exp2f(-(float)(hh + 1)), s2 = sl * LOG2E;
            SoftState st; soft_reset(st);
            const int t0 = c - 2 < 0 ? 0 : c - 2;
            run_segment(F, st, qr, base + 512 + hkv * 64, base + 640 + hkv * 64, LDP, t0, c, s2, q,
                        [&](int t, int& klo, int& klim) { klim = q - t * 64 - 4 * hi; klo = klim - 128; });
            const float l = lane_swap_sum(st.l);
            const float sk2 = P.ev_sink[hh] * LOG2E;
            const float mx = fmaxf(st.m, sk2);
            const float scale = __builtin_amdgcn_exp2f(st.m - mx);
            const float den = l * scale + __builtin_amdgcn_exp2f(sk2 - mx);
            store_ot(st.o, scale / den, P.o + (size_t)(b * S + q) * D + hh * 64, hi);
        }
    }
}

DEV void fp_attn1(const Params& P, Frame& F) {
    using namespace att;
    const int lane = F.lane, r32 = lane & 31, hi = lane >> 5, w = F.wave;
    for (int u = F.vcu; u < 1024; u += F.G) {
        if (u < 512) {
            const int v = u & 255, bh = v >> 2, blk = (u < 256) ? (v & 3) : 7 - (v & 3);
            const int b = bh >> 3, h = bh & 7;
            const bf16* base = P.proj + (size_t)b * S * LDP;
            const int q = blk * 256 + w * 32 + r32;
            bf16x8 qr[4]; load_q(qr, base + (size_t)q * LDP + h * 64, hi);
            const float sl = exp2f(-(float)(h + 1)), s2 = sl * LOG2E;
            float gt[8];
#pragma unroll
            for (int n = 0; n < 8; ++n) {
                float g = 0.f;
                if (n < blk) {
                    const float* km = P.kmean + ((size_t)(b * 8 + h) * 8 + n) * 64;
#pragma unroll
                    for (int d0 = 0; d0 < 4; ++d0)
#pragma unroll
                        for (int j = 0; j < 8; ++j) g += bf2f((bf16)qr[d0][j]) * km[16 * d0 + 8 * hi + j];
                }
                g = lane_swap_sum(g);
                gt[n] = n < blk ? g : NEG;
            }
            unsigned sel = 0;
#pragma unroll
            for (int n = 0; n < 8; ++n) {
                int rank = 0;
#pragma unroll
                for (int k = 0; k < 8; ++k) rank += (gt[k] > gt[n] || (gt[k] == gt[n] && k < n)) ? 1 : 0;
                if (rank < 3 && n < blk) sel |= 1u << n;
            }
            SoftState st; soft_reset(st);
            run_segment(F, st, qr, base + 512 + h * 64, base + 1024 + h * 64, LDP, 0, blk * 4 + 3, s2, q,
                        [&](int t, int& klo, int& klim) { const int n = t >> 2; klo = -1;
                            if (n < blk) klim = ((sel >> n) & 1) ? 63 : -1; else klim = q - t * 64 - 4 * hi; });
            const float l = lane_swap_sum(st.l);
            store_ot(st.o, 1.0f / l, P.o + (size_t)(b * S + q) * D + h * 64, hi);
        } else {
            const int v = u & 255, bk = v >> 4, c = (u < 768) ? (v & 15) : 31 - (v & 15);
            const int b = bk >> 1, hkv = bk & 1;
            const bf16* base = P.proj + (size_t)b * S * LDP;
            const int h = hkv * 4 + (w >> 1), q = c * 64 + (w & 1) * 32 + r32, t = b * S + q;
            bf16x8 qr[4]; load_q(qr, base + (size_t)q * LDP + 1536 + h * 64, hi);
            const float sl = exp2f(-(float)(h + 1)), s2 = sl * LOG2E;
            const bf16* grow = base + (size_t)q * LDP + 2816 + h * 3;
            const float g0 = 1.0f / (1.0f + __expf(-bf2f(grow[0]))), g1 = 1.0f / (1.0f + __expf(-bf2f(grow[1]))), g2 = 1.0f / (1.0f + __expf(-bf2f(grow[2])));
            const unsigned mask = P.selmask[t * 2 + hkv];
            f32x16 fin[2];
            {
                const float* oc = P.ocmp + ((size_t)t * 8 + h) * 64;
#pragma unroll
                for (int d0 = 0; d0 < 2; ++d0)
#pragma unroll
                    for (int g = 0; g < 4; ++g) { const f32x4 x = *(const GAS f32x4*)(oc + 32 * d0 + 8 * g + 4 * hi);
                        fin[d0][4 * g] = g0 * x.x; fin[d0][4 * g + 1] = g0 * x.y; fin[d0][4 * g + 2] = g0 * x.z; fin[d0][4 * g + 3] = g0 * x.w; }
            }
            SoftState st; soft_reset(st);
            run_segment(F, st, qr, base + 2304 + hkv * 64, base + 2432 + hkv * 64, LDP, 0, c, s2, q,
                        [&](int tt, int& klo, int& klim) { klo = -1; klim = ((mask >> tt) & 1) ? (q - tt * 64 - 4 * hi) : -1; });
            { const float f = g1 / lane_swap_sum(st.l);
#pragma unroll
              for (int r = 0; r < 16; ++r) { fin[0][r] += f * st.o[0][r]; fin[1][r] += f * st.o[1][r]; } }
            soft_reset(st);
            run_segment(F, st, qr, base + 2560 + hkv * 64, base + 2688 + hkv * 64, LDP, c - 8 < 0 ? 0 : c - 8, c, s2, q,
                        [&](int tt, int& klo, int& klim) { klim = q - tt * 64 - 4 * hi; klo = klim - 512; });
            { const float f = g2 / lane_swap_sum(st.l);
#pragma unroll
              for (int r = 0; r < 16; ++r) { fin[0][r] += f * st.o[0][r]; fin[1][r] += f * st.o[1][r]; } }
            store_ot(fin, 1.0f, P.o + (size_t)t * D + 512 + h * 64, hi);
        }
    }
}
constexpr int NPHASE = 20;
DEV void run_phase(const Params& P, int ph, int gtid, int gsz) {
    switch (ph) {
        case 0: ph_rstd(P.x, P.rstd, gtid, gsz); break;
        case 1: ph_gemm_in(P.x, P.rstd, P.ev_norm, P.ev_w_in, EVEN_IN, P.proj, gtid, gsz); break;
        case 2: ph_headnorm0(P, gtid, gsz); break;
        case 3: ph_attn0(P, gtid, gsz); break;
        case 4: ph_gemm_out(P.o, P.ev_w_out, P.x, P.out, gtid, gsz); break;
        case 5: ph_moe_route(P, 0, gtid, gsz); break;
        case 6: ph_moe_hidden(P, 0, gtid, gsz); break;
        case 7: ph_moe_out(P, 0, gtid, gsz); break;
        case 8: ph_rstd(P.out, P.rstd, gtid, gsz); break;
        case 9: ph_gemm_in(P.out, P.rstd, P.od_norm, P.od_w_in, ODD_IN, P.proj, gtid, gsz); break;
        case 10: ph_headnorm1(P, gtid, gsz); break;
        case 11: ph_prep1(P, gtid, gsz); break;
        case 12: ph_nsa_cmp(P, gtid, gsz); break;
        case 13: ph_nsa_select(P, gtid, gsz); break;
        case 14: ph_nsa_topk(P, gtid, gsz); break;
        case 15: ph_attn1(P, gtid, gsz); break;
        case 16: ph_gemm_out(P.o, P.od_w_out, P.out, P.out, gtid, gsz); break;
        case 17: ph_moe_route(P, 1, gtid, gsz); break;
        case 18: ph_moe_hidden(P, 1, gtid, gsz); break;
        case 19: ph_moe_out(P, 1, gtid, gsz); break;
    }
}
__global__ void __launch_bounds__(256) k_naive(Params P, int ph) {
    run_phase(P, ph, blockIdx.x * blockDim.x + threadIdx.x, gridDim.x * blockDim.x);
}

enum { FP_CONV_DENSE = 0, FP_CONV_MOE0, FP_XN0, FP_INPROJ0, FP_HEADNORM0, FP_ATTN0, FP_OUTPROJ0, FP_ROUTE0, FP_GATHER0, FP_GU0, FP_DN0, FP_COMBINE0, FP_CONV_MOE1, FP_XN1, FP_INPROJ1, FP_HEADNORM1, FP_PREP1, FP_NSACMP, FP_NSASEL, FP_NSATOPK, FP_ATTN1, FP_OUTPROJ1, FP_ROUTE1, FP_GATHER1, FP_GU1, FP_DN1, FP_COMBINE1, FP_COUNT };
struct FArgs { Params p; unsigned long long mask; int li, pad; };

__global__ void __launch_bounds__(NWAVES * 64, 2) k_fast(FArgs args) {
    extern __shared__ __attribute__((aligned(16))) unsigned char lds[];
    const Params& P = args.p;
    Frame F;
    F.lds = (LAS unsigned char*)lds;
    F.MISC = (volatile LAS unsigned*)(F.lds + MISC_OFF);
    F.tid = threadIdx.x; F.lane = F.tid & 63; F.wave = __builtin_amdgcn_readfirstlane(F.tid >> 6);
    F.G = gridDim.x; { const int bx = blockIdx.x; F.vcu = (F.G % 8 == 0) ? (bx % 8) * (F.G / 8) + bx / 8 : bx; }
    for (int u = F.tid; u < (LDS_BYTES - LDSCTL_OFF) / 4; u += NWAVES * 64) ((LAS unsigned*)(F.lds + LDSCTL_OFF))[u] = 0u;
    __syncthreads();
    XcdBarrier bar = xcd_barrier_post(P.ctl + CW_BAR + args.li * XCD_BAR_WORDS, F.MISC + 8);
    const unsigned long long mask = args.mask;
#define ON(k) (refresh(F), ((mask >> (k)) & 1ull))
#define SEAM(k) do { if ((mask >> ((k) + 1)) != 0ull) { refresh(F); xcd_barrier(bar, F.tid); } } while (0)
    if (ON(FP_CONV_DENSE)) { fp_convert_weights(P, F, 0); fp_prep_router(P, F); SEAM(FP_CONV_DENSE); }
    if (ON(FP_CONV_MOE0)) { fp_convert_weights(P, F, 1); SEAM(FP_CONV_MOE0); }
    if (ON(FP_XN0)) { fp_norm_rows(F, P.x, P.ev_norm, P.xn); SEAM(FP_XN0); }
    if (ON(FP_INPROJ0)) { pg8::StaticOrder So; So.init(P.xn, P.win0t, T, EVEN_IN, D, F.G, (int)blockIdx.x);
        pg8::EpiStoreBf16 E{P.proj, LDP}; pg8::gemm_phase(F.lds, D, So, E, F.tid); SEAM(FP_INPROJ0); }
    if (ON(FP_HEADNORM0)) { fp_headnorm(P, F, 0); SEAM(FP_HEADNORM0); }
    if (ON(FP_ATTN0)) { fp_attn0(P, F); SEAM(FP_ATTN0); }
    if (ON(FP_OUTPROJ0)) { pg8::StaticOrder So; So.init(P.o, P.wout0t, T, D, D, F.G, (int)blockIdx.x);
        pg8::EpiResidF32 E{P.x, P.out, D}; pg8::gemm_phase(F.lds, D, So, E, F.tid); SEAM(FP_OUTPROJ0); }
    if (ON(FP_ROUTE0)) { fp_route(P, F, 0); SEAM(FP_ROUTE0); }
    if (ON(FP_GATHER0)) { fp_gather(P, F, 0); SEAM(FP_GATHER0); }
    if (ON(FP_GU0)) { fp_moe_gu(P, F, 0); SEAM(FP_GU0); }
    if (ON(FP_DN0)) { fp_moe_dn(P, F, 0); SEAM(FP_DN0); }
    if (ON(FP_COMBINE0)) { fp_combine(P, F, P.od_norm, P.xn); SEAM(FP_COMBINE0); }
    if (ON(FP_CONV_MOE1)) { fp_convert_weights(P, F, 2); SEAM(FP_CONV_MOE1); }
    if (ON(FP_XN1)) { fp_norm_rows(F, P.out, P.od_norm, P.xn); SEAM(FP_XN1); }
    if (ON(FP_INPROJ1)) { pg8::StaticOrder So; So.init(P.xn, P.win1t, T, LDP, D, F.G, (int)blockIdx.x);
        pg8::EpiStoreBf16 E{P.proj, LDP}; pg8::gemm_phase(F.lds, D, So, E, F.tid); SEAM(FP_INPROJ1); }
    if (ON(FP_HEADNORM1)) { fp_headnorm(P, F, 1); SEAM(FP_HEADNORM1); }
    if (ON(FP_PREP1)) { fp_prep1(P, F); SEAM(FP_PREP1); }
    if (ON(FP_NSACMP)) { ph_nsa_cmp(P, F.vcu * NWAVES * 64 + F.tid, F.G * NWAVES * 64); SEAM(FP_NSACMP); }
    if (ON(FP_NSASEL)) { ph_nsa_select(P, F.vcu * NWAVES * 64 + F.tid, F.G * NWAVES * 64); SEAM(FP_NSASEL); }
    if (ON(FP_NSATOPK)) { ph_nsa_topk(P, F.vcu * NWAVES * 64 + F.tid, F.G * NWAVES * 64); SEAM(FP_NSATOPK); }
    if (ON(FP_ATTN1)) { fp_attn1(P, F); SEAM(FP_ATTN1); }
    if (ON(FP_OUTPROJ1)) { pg8::StaticOrder So; So.init(P.o, P.wout1t, T, D, D, F.G, (int)blockIdx.x);
        pg8::EpiResidF32 E{P.out, P.out, D}; pg8::gemm_phase(F.lds, D, So, E, F.tid); SEAM(FP_OUTPROJ1); }
    if (ON(FP_ROUTE1)) { fp_route(P, F, 1); SEAM(FP_ROUTE1); }
    if (ON(FP_GATHER1)) { fp_gather(P, F, 1); SEAM(FP_GATHER1); }
    if (ON(FP_GU1)) { fp_moe_gu(P, F, 1); SEAM(FP_GU1); }
    if (ON(FP_DN1)) { fp_moe_dn(P, F, 1); SEAM(FP_DN1); }
    if (ON(FP_COMBINE1)) { fp_combine(P, F, nullptr, nullptr); SEAM(FP_COMBINE1); }
#undef ON
#undef SEAM
}

static inline size_t al256(size_t x) { return (x + 255) & ~(size_t)255; }
static size_t carve(Params& p, void* d_ws) {
    char* w = (char*)d_ws;
    p.ctl = (unsigned*)w;
    p.win0t = (bf16*)(w + 1 * MiB);
    p.wout0t = (bf16*)(w + 6 * MiB);
    p.win1t = (bf16*)(w + 8 * MiB);
    p.wout1t = (bf16*)(w + 14 * MiB);
    p.wgut = (bf16*)(w + 16 * MiB);
    p.wdt = (bf16*)(w + 48 * MiB);
    p.proj = (bf16*)(w + 64 * MiB);
    p.ha = (bf16*)(w + 64 * MiB);
    p.xn = (bf16*)(w + 160 * MiB);
    p.hmid = (float*)(w + 160 * MiB);
    p.ocmp = (float*)(w + 160 * MiB);
    p.o = (bf16*)(w + 192 * MiB);
    p.hid = (bf16*)(w + 192 * MiB);
    size_t off = 224 * MiB;
    p.rstd = (float*)(w + off); off = al256(off + (size_t)T * 4);
    p.eid = (int*)(w + off); off = al256(off + (size_t)T * 2 * 4);
    p.ew = (float*)(w + off); off = al256(off + (size_t)T * 2 * 4);
    p.kmean = (float*)(w + off); off = al256(off + (size_t)NB * 8 * 8 * 64 * 4);
    p.kvcmp = (bf16*)(w + off); off = al256(off + (size_t)2 * NB * NCMP * 2 * 64 * 2);
    p.cml = (float*)(w + off); off = al256(off + (size_t)T * 8 * 2 * 4);
    p.pslc = (float*)(w + off); off = al256(off + (size_t)T * 64 * 4);
    p.selmask = (unsigned*)(w + off); off = al256(off + (size_t)T * 2 * 4);
    p.rowtok = (int*)(w + off); off = al256(off + (size_t)RMAX * 4);
    p.pos = (int*)(w + off); off = al256(off + (size_t)T * 2 * 4);
    p.wr = (bf16*)(w + off); off = al256(off + (size_t)2 * 2 * 48 * D * 2);
    return off;
}

struct Step { int fast; int n; int ph[32]; };
static const Step PLAN[] = {
    {1, 26, {FP_CONV_DENSE, FP_CONV_MOE0, FP_XN0, FP_INPROJ0, FP_HEADNORM0, FP_ATTN0, FP_OUTPROJ0, FP_ROUTE0, FP_GATHER0, FP_GU0, FP_DN0, FP_COMBINE0, FP_CONV_MOE1, FP_INPROJ1, FP_HEADNORM1,
             FP_PREP1, FP_NSACMP, FP_NSASEL, FP_NSATOPK, FP_ATTN1, FP_OUTPROJ1, FP_ROUTE1, FP_GATHER1, FP_GU1, FP_DN1, FP_COMBINE1}},
};

extern "C" void kernel_launch(void* const* d_in, const int* in_sizes, int n_in, void* d_out, int out_size, void* d_ws, size_t ws_size,
                              hipStream_t stream) {
    Params p{};
    const float** f = (const float**)&p;
    for (int i = 0; i < 24; ++i) f[i] = (const float*)d_in[i];
    p.out = (float*)d_out;
    const size_t need = carve(p, d_ws);
    static int grid = 0;
    if (grid == 0) {
        int dev = 0, cus = 0, per_cu = 0;
        if (hipGetDevice(&dev) != hipSuccess || hipDeviceGetAttribute(&cus, hipDeviceAttributeMultiprocessorCount, dev) != hipSuccess) { grid = -1; return; }
        if (hipFuncSetAttribute((const void*)k_fast, hipFuncAttributeMaxDynamicSharedMemorySize, LDS_BYTES) != hipSuccess) { fprintf(stderr, "hipFuncSetAttribute failed\n"); grid = -1; return; }
        if (hipOccupancyMaxActiveBlocksPerMultiprocessor(&per_cu, (const void*)k_fast, NWAVES * 64, LDS_BYTES) != hipSuccess || per_cu < 1) { fprintf(stderr, "occupancy query: %d\n", per_cu); (void)hipGetLastError(); grid = -1; return; }
        grid = cus;
        if (need > ws_size) { fprintf(stderr, "workspace too small: need %zu have %zu\n", need, ws_size); grid = -1; return; }
    }
    if (grid < 0) return;
    (void)hipMemsetAsync(d_ws, 0, CTL_ZERO_BYTES, stream);
    int li = 0;
    for (const Step& st : PLAN) {
        if (st.fast) {
            FArgs a{}; a.p = p; a.li = li++;
            for (int i = 0; i < st.n; ++i) a.mask |= 1ull << st.ph[i];
            hipLaunchKernelGGL(k_fast, dim3(grid), dim3(NWAVES * 64), LDS_BYTES, stream, a);
        } else {
            for (int i = 0; i < st.n; ++i) hipLaunchKernelGGL(k_naive, dim3(2048), dim3(256), 0, stream, p, st.ph[i]);
        }
    }
}
```

```cpp
#include <hip/hip_runtime.h>
#include <cstdio>
#include <cstdint>
#define DEV __device__ __forceinline__

#ifndef NB
#define NB 8
#endif
typedef unsigned short bf16;
constexpr int S = 2048, D = 1024, T = NB * S, HD = 64;
constexpr int EVEN_IN = 2304, ODD_IN = 2840, LDP = 3072;
constexpr int NCMP = 127, NSLC = 32;
constexpr float NEG = -1e30f;
constexpr float EPS = 1e-6f;
constexpr int RMAX = 2 * T + 32 * 256;

DEV float u2f(unsigned u) { return __builtin_bit_cast(float, u); }
DEV unsigned f2u(float f) { return __builtin_bit_cast(unsigned, f); }
DEV float bf2f(bf16 h) { return u2f(((unsigned)h) << 16); }
DEV bf16 f2bf(float f) { unsigned u = f2u(f); u += 0x7fffu + ((u >> 16) & 1u); return (bf16)(u >> 16); }

struct Params {
    const float *x, *ev_norm, *ev_w_in, *ev_q_norm, *ev_k_norm, *ev_sink, *ev_w_out;
    const float *od_norm, *od_w_in, *od_c_q_norm, *od_c_k_norm, *od_d_q_norm, *od_d_k_norm, *od_cmp_pos, *od_cmp_w, *od_w_out;
    const float *moe_norm, *moe_w_grp, *moe_b_grp, *moe_w_exp, *moe_b_exp, *moe_w_gate, *moe_w_up, *moe_w_down;
    float* out;
    unsigned* ctl;
    bf16 *win0t, *wout0t, *win1t, *wout1t, *wgut, *wdt;
    bf16* proj;
    bf16* xn;
    bf16* o;
    bf16* ha;
    bf16* hid;
    float* rstd;
    int* eid;
    float* ew;
    float* hmid;
    float* kmean;
    bf16* kvcmp;
    float* ocmp;
    float* cml;
    float* pslc;
    unsigned* selmask;
    int* rowtok;
    int* pos;
    bf16* wr;
};

DEV void load64(const bf16* p, float (&q)[64]) {
#pragma unroll
    for (int d = 0; d < 64; ++d) q[d] = bf2f(p[d]);
}
DEV float dot64(const float (&q)[64], const bf16* k) {
    float s = 0.f;
#pragma unroll
    for (int d = 0; d < 64; ++d) s += q[d] * bf2f(k[d]);
    return s;
}
DEV float dot64f(const float (&q)[64], const float* k) {
    float s = 0.f;
#pragma unroll
    for (int d = 0; d < 64; ++d) s += q[d] * k[d];
    return s;
}
DEV void os_update(float sc, const bf16* v, float& m, float& l, float (&o)[64]) {
    if (sc > m) {
        float f = expf(m - sc);
        l *= f;
#pragma unroll
        for (int d = 0; d < 64; ++d) o[d] *= f;
        m = sc;
    }
    float p = expf(sc - m);
    l += p;
#pragma unroll
    for (int d = 0; d < 64; ++d) o[d] += p * bf2f(v[d]);
}
DEV float slope_of(int hh) { return exp2f(-(float)(hh + 1)); }

DEV void ph_rstd(const float* src, float* rstd, int gtid, int gsz) {
    for (int t = gtid; t < T; t += gsz) {
        const float* r = src + (size_t)t * D;
        float s = 0.f;
        for (int i = 0; i < D; ++i) s += r[i] * r[i];
        rstd[t] = rsqrtf(s * (1.0f / D) + EPS);
    }
}

DEV void ph_gemm_in(const float* src, const float* rstd, const float* g, const float* W, int N, bf16* proj, int gtid, int gsz) {
    const long total = (long)T * N;
    for (long i = gtid; i < total; i += gsz) {
        const int t = (int)(i / N), n = (int)(i % N);
        const float* a = src + (size_t)t * D;
        float acc = 0.f;
        for (int k = 0; k < D; ++k) acc += a[k] * g[k] * W[(size_t)k * N + n];
        proj[(size_t)t * LDP + n] = f2bf(acc * rstd[t]);
    }
}

DEV void headnorm_inplace(bf16* p, const float* g) {
    float v[64];
    load64(p, v);
    float s = 0.f;
#pragma unroll
    for (int d = 0; d < 64; ++d) s += v[d] * v[d];
    const float r = rsqrtf(s * (1.0f / 64) + EPS);
#pragma unroll
    for (int d = 0; d < 64; ++d) p[d] = f2bf(v[d] * r * g[d]);
}

DEV void ph_headnorm0(const Params& P, int gtid, int gsz) {
    const long total = (long)T * 10;
    for (long i = gtid; i < total; i += gsz) {
        const int t = (int)(i / 10), h = (int)(i % 10);
        bf16* row = P.proj + (size_t)t * LDP;
        if (h < 8) headnorm_inplace(row + h * 64, P.ev_q_norm);
        else headnorm_inplace(row + 512 + (h - 8) * 64, P.ev_k_norm);
    }
}

DEV void ph_headnorm1(const Params& P, int gtid, int gsz) {
    const long total = (long)T * 28;
    for (long i = gtid; i < total; i += gsz) {
        const int t = (int)(i / 28), h = (int)(i % 28);
        bf16* row = P.proj + (size_t)t * LDP;
        if (h < 8) headnorm_inplace(row + h * 64, P.od_c_q_norm);
        else if (h < 16) headnorm_inplace(row + 512 + (h - 8) * 64, P.od_c_k_norm);
        else if (h < 24) headnorm_inplace(row + 1536 + (h - 16) * 64, P.od_d_q_norm);
        else if (h < 26) headnorm_inplace(row + 2304 + (h - 24) * 64, P.od_d_k_norm + 64);
        else headnorm_inplace(row + 2560 + (h - 26) * 64, P.od_d_k_norm + 128);
    }
}

DEV void ph_attn0(const Params& P, int gtid, int gsz) {
    const long total = (long)T * 16;
    for (long i = gtid; i < total; i += gsz) {
        const int hh = (int)(i / T), t = (int)(i % T);
        const int b = t / S, s = t % S;
        const bf16* base = P.proj + (size_t)b * S * LDP;
        float q[64], o[64];
#pragma unroll
        for (int d = 0; d < 64; ++d) o[d] = 0.f;
        if (hh < 8) {
            const int kvh = hh >> 2;
            load64(base + (size_t)s * LDP + hh * 64, q);
            const float sl = slope_of(hh);
            float m = NEG, l = 0.f;
            const int s0 = s - 127 < 0 ? 0 : s - 127;
            for (int sp = s0; sp <= s; ++sp) {
                const bf16* kr = base + (size_t)sp * LDP + 512 + kvh * 64;
                const float sc = dot64(q, kr) * 0.125f - sl * (float)(s - sp);
                os_update(sc, kr + 128, m, l, o);
            }
            const float sk = P.ev_sink[hh];
            const float mx = m > sk ? m : sk;
            const float scale = expf(m - mx);
            const float den = l * scale + expf(sk - mx);
            const float f = scale / den;
            bf16* op = P.o + (size_t)t * D + hh * 64;
#pragma unroll
            for (int d = 0; d < 64; ++d) op[d] = f2bf(o[d] * f);
        } else {
            const int h = hh - 8;
            load64(base + (size_t)s * LDP + 768 + h * 64, q);
            float acc = 0.f;
            for (int sp = s - 1; sp >= 0; --sp) {
                const bf16* kr = base + (size_t)sp * LDP + 1280 + h * 64;
                const float z = dot64(q, kr) * 0.125f;
                const float ls = (z < 0.f ? z : 0.f) - log1pf(expf(-fabsf(z)));
                const float a = expf(ls + acc);
                const bf16* vr = kr + 512;
#pragma unroll
                for (int d = 0; d < 64; ++d) o[d] += a * bf2f(vr[d]);
                acc += ls - z;
                if (acc < -110.f) break;
            }
            bf16* op = P.o + (size_t)t * D + 512 + h * 64;
#pragma unroll
            for (int d = 0; d < 64; ++d) op[d] = f2bf(o[d]);
        }
    }
}

DEV void ph_gemm_out(const bf16* o, const float* W, const float* resid, float* out, int gtid, int gsz) {
    const long total = (long)T * D;
    for (long i = gtid; i < total; i += gsz) {
        const int t = (int)(i / D), c = (int)(i % D);
        const bf16* a = o + (size_t)t * D;
        float acc = 0.f;
        for (int k = 0; k < D; ++k) acc += bf2f(a[k]) * W[(size_t)k * D + c];
        out[i] = resid[i] + acc;
    }
}

DEV void ph_moe_route(const Params& P, int layer, int gtid, int gsz) {
    const float* g = P.moe_norm + layer * D;
    const float* wgrp = P.moe_w_grp + (size_t)layer * D * 4;
    const float* wexp = P.moe_w_exp + (size_t)layer * D * 32;
    const float* bgrp = P.moe_b_grp + layer * 4;
    const float* bexp = P.moe_b_exp + layer * 32;
    for (int t = gtid; t < T; t += gsz) {
        const float* r = P.out + (size_t)t * D;
        float ss = 0.f;
        for (int k = 0; k < D; ++k) ss += r[k] * r[k];
        const float rs = rsqrtf(ss * (1.0f / D) + EPS);
        P.rstd[t] = rs;
        float lg[4], le[32];
#pragma unroll
        for (int j = 0; j < 4; ++j) lg[j] = 0.f;
#pragma unroll
        for (int j = 0; j < 32; ++j) le[j] = 0.f;
        for (int k = 0; k < D; ++k) {
            const float h = r[k] * rs * g[k];
#pragma unroll
            for (int j = 0; j < 4; ++j) lg[j] += h * wgrp[k * 4 + j];
#pragma unroll
            for (int j = 0; j < 32; ++j) le[j] += h * wexp[k * 32 + j];
        }
#pragma unroll
        for (int j = 0; j < 4; ++j) lg[j] += bgrp[j];
#pragma unroll
        for (int j = 0; j < 32; ++j) le[j] += bexp[j];
        int gs = 0; float gm = lg[0];
#pragma unroll
        for (int j = 1; j < 4; ++j) if (lg[j] > gm) { gm = lg[j]; gs = j; }
        float gz = 0.f;
#pragma unroll
        for (int j = 0; j < 4; ++j) gz += expf(lg[j] - gm);
        const float pg = 1.0f / gz;
        float w[8];
#pragma unroll
        for (int j = 0; j < 8; ++j) w[j] = gs == 0 ? le[j] : gs == 1 ? le[8 + j] : gs == 2 ? le[16 + j] : le[24 + j];
        int i1 = 0; float m1 = w[0];
#pragma unroll
        for (int j = 1; j < 8; ++j) if (w[j] > m1) { m1 = w[j]; i1 = j; }
        int i2 = -1; float m2 = -3e38f;
#pragma unroll
        for (int j = 0; j < 8; ++j) if (j != i1 && w[j] > m2) { m2 = w[j]; i2 = j; }
        const float e2 = expf(m2 - m1);
        const float w1 = pg / (1.0f + e2), w2 = pg * e2 / (1.0f + e2);
        P.eid[t * 2 + 0] = gs * 8 + i1; P.eid[t * 2 + 1] = gs * 8 + i2;
        P.ew[t * 2 + 0] = w1; P.ew[t * 2 + 1] = w2;
    }
}

DEV void ph_moe_hidden(const Params& P, int layer, int gtid, int gsz) {
    const float* g = P.moe_norm + layer * D;
    const long total = (long)T * 512;
    for (long i = gtid; i < total; i += gsz) {
        const int t = (int)(i >> 9), slot = (int)((i >> 8) & 1), f = (int)(i & 255);
        const int e = P.eid[t * 2 + slot];
        const float* wg = P.moe_w_gate + ((size_t)(layer * 32 + e) * D) * 256 + f;
        const float* wu = P.moe_w_up + ((size_t)(layer * 32 + e) * D) * 256 + f;
        const float* r = P.out + (size_t)t * D;
        const float rs = P.rstd[t];
        float a = 0.f, u = 0.f;
        for (int k = 0; k < D; ++k) {
            const float h = r[k] * rs * g[k];
            a += h * wg[(size_t)k * 256];
            u += h * wu[(size_t)k * 256];
        }
        const float sg = a / (1.0f + expf(-a));
        P.hmid[i] = sg * u;
    }
}

DEV void ph_moe_out(const Params& P, int layer, int gtid, int gsz) {
    const long total = (long)T * D;
    for (long i = gtid; i < total; i += gsz) {
        const int t = (int)(i / D), c = (int)(i % D);
        float tot = 0.f;
        for (int slot = 0; slot < 2; ++slot) {
            const int e = P.eid[t * 2 + slot];
            const float* wd = P.moe_w_down + ((size_t)(layer * 32 + e) * 256) * D + c;
            const float* hm = P.hmid + ((size_t)t * 2 + slot) * 256;
            float acc = 0.f;
            for (int f = 0; f < 256; ++f) acc += hm[f] * wd[(size_t)f * D];
            tot += P.ew[t * 2 + slot] * acc;
        }
        P.out[i] += tot;
    }
}

DEV void ph_prep1(const Params& P, int gtid, int gsz) {
    const int n1 = NB * 8 * 8 * 64;
    for (int i = gtid; i < n1; i += gsz) {
        const int d = i & 63, n = (i >> 6) & 7, h = (i >> 9) & 7, b = i >> 12;
        const bf16* kp = P.proj + ((size_t)b * S + n * 256) * LDP + 512 + h * 64 + d;
        float s = 0.f;
        for (int j = 0; j < 256; ++j) s += bf2f(kp[(size_t)j * LDP]);
        P.kmean[i] = s * (1.0f / 256);
    }
    const int n2 = 2 * NB * NCMP * 2;
    for (int i = gtid; i < n2; i += gsz) {
        const int hkv = i & 1; int r = i >> 1; const int n = r % NCMP; r /= NCMP; const int b = r % NB; const int which = r / NB;
        const float* pos = P.od_cmp_pos + which * 32 * 64;
        const float* w = P.od_cmp_w + (size_t)which * 32 * 64 * 64;
        const bf16* xp = P.proj + ((size_t)b * S + n * 16) * LDP + (which ? 2176 : 2048) + hkv * 64;
        float acc[64];
#pragma unroll
        for (int e = 0; e < 64; ++e) acc[e] = 0.f;
        for (int l = 0; l < 32; ++l)
            for (int d = 0; d < 64; ++d) {
                const float xv = bf2f(xp[(size_t)l * LDP + d]) + pos[l * 64 + d];
                const float* wr = w + ((size_t)l * 64 + d) * 64;
#pragma unroll
                for (int e = 0; e < 64; ++e) acc[e] += xv * wr[e];
            }
        if (which == 0) {
            float ss = 0.f;
#pragma unroll
            for (int e = 0; e < 64; ++e) ss += acc[e] * acc[e];
            const float rs = rsqrtf(ss * (1.0f / 64) + EPS);
#pragma unroll
            for (int e = 0; e < 64; ++e) acc[e] *= rs * P.od_d_k_norm[e];
        }
        bf16* op = P.kvcmp + (((size_t)(which * NB + b) * NCMP + n) * 2 + hkv) * 64;
#pragma unroll
        for (int e = 0; e < 64; ++e) op[e] = f2bf(acc[e]);
    }
}

DEV int cmp_count(int s) { int c = s >= 31 ? (s - 31) / 16 + 1 : 0; return c > NCMP ? NCMP : c; }

DEV void ph_nsa_cmp(const Params& P, int gtid, int gsz) {
    const long total = (long)T * 8;
    for (long i = gtid; i < total; i += gsz) {
        const int hh = (int)(i / T), t = (int)(i % T);
        const int b = t / S, s = t % S, hkv = hh >> 2;
        float q[64], o[64];
        load64(P.proj + (size_t)t * LDP + 1536 + hh * 64, q);
#pragma unroll
        for (int d = 0; d < 64; ++d) o[d] = 0.f;
        const float sl = slope_of(hh);
        float m = NEG, l = 0.f;
        const int cnt = cmp_count(s);
        const bf16* kc = P.kvcmp + (((size_t)(0 * NB + b) * NCMP) * 2 + hkv) * 64;
        const bf16* vc = P.kvcmp + (((size_t)(1 * NB + b) * NCMP) * 2 + hkv) * 64;
        for (int n = 0; n < cnt; ++n) {
            const float sc = dot64(q, kc + (size_t)n * 128) * 0.125f - sl * (float)(s - (n * 16 + 31));
            os_update(sc, vc + (size_t)n * 128, m, l, o);
        }
        const float inv = cnt > 0 ? 1.0f / l : 0.f;
        float* op = P.ocmp + ((size_t)t * 8 + hh) * 64;
#pragma unroll
        for (int d = 0; d < 64; ++d) op[d] = o[d] * inv;
        P.cml[((size_t)t * 8 + hh) * 2 + 0] = m;
        P.cml[((size_t)t * 8 + hh) * 2 + 1] = l;
    }
}

DEV void ph_nsa_select(const Params& P, int gtid, int gsz) {
    const long total = (long)T * 64;
    for (long i = gtid; i < total; i += gsz) {
        const int j = (int)(i & 31), hkv = (int)((i >> 5) & 1), t = (int)(i >> 6);
        const int b = t / S, s = t % S, cur = s >> 6;
        float score = NEG;
        if (j <= cur) {
            const int cnt = cmp_count(s);
            const bf16* kc = P.kvcmp + (((size_t)(0 * NB + b) * NCMP) * 2 + hkv) * 64;
            float p = 0.f;
            int n0 = 4 * j - 1; if (n0 < 0) n0 = 0;
            int n1 = 4 * j + 3; if (n1 > NCMP - 1) n1 = NCMP - 1;
            for (int g = 0; g < 4; ++g) {
                const int hh = hkv * 4 + g;
                float q[64];
                load64(P.proj + (size_t)t * LDP + 1536 + hh * 64, q);
                const float sl = slope_of(hh);
                const float m = P.cml[((size_t)t * 8 + hh) * 2 + 0], l = P.cml[((size_t)t * 8 + hh) * 2 + 1];
                for (int n = n0; n <= n1; ++n)
                    if (n < cnt) {
                        const float sc = dot64(q, kc + (size_t)n * 128) * 0.125f - sl * (float)(s - (n * 16 + 31));
                        p += expf(sc - m) / l;
                    }
            }
            const bool forced = (j == 0) || (j == cur) || (j == cur - 1);
            score = p + (forced ? 1000.0f : 0.0f);
        }
        P.pslc[i] = score;
    }
}

DEV void ph_nsa_topk(const Params& P, int gtid, int gsz) {
    const int total = T * 2;
    for (int i = gtid; i < total; i += gsz) {
        const int t = i >> 1;
        const int s = t % S, cur = s >> 6;
        const float* sc = P.pslc + (size_t)i * 32;
        unsigned mask = 0;
        for (int j = 0; j <= cur; ++j) {
            const float sj = sc[j];
            int rank = 0;
            for (int k = 0; k < 32; ++k) { const float sk = sc[k]; rank += (sk > sj || (sk == sj && k < j)) ? 1 : 0; }
            if (rank < 16) mask |= 1u << j;
        }
        P.selmask[i] = mask;
    }
}

DEV void ph_attn1(const Params& P, int gtid, int gsz) {
    const long total = (long)T * 16;
    for (long i = gtid; i < total; i += gsz) {
        const int hh = (int)(i / T), t = (int)(i % T);
        const int b = t / S, s = t % S;
        const bf16* base = P.proj + (size_t)b * S * LDP;
        float q[64], o[64];
#pragma unroll
        for (int d = 0; d < 64; ++d) o[d] = 0.f;
        if (hh < 8) {
            const int h = hh, own = s >> 8;
            load64(base + (size_t)s * LDP + h * 64, q);
            const float sl = slope_of(h);
            float gt[8];
#pragma unroll
            for (int n = 0; n < 8; ++n) gt[n] = n < own ? dot64f(q, P.kmean + ((size_t)(b * 8 + h) * 8 + n) * 64) : NEG;
            unsigned sel = 0;
#pragma unroll
            for (int n = 0; n < 8; ++n) {
                int rank = 0;
#pragma unroll
                for (int k = 0; k < 8; ++k) rank += (gt[k] > gt[n] || (gt[k] == gt[n] && k < n)) ? 1 : 0;
                if (rank < 3 && n < own) sel |= 1u << n;
            }
            float m = NEG, l = 0.f;
            for (int n = 0; n < own; ++n) {
                if (!((sel >> n) & 1)) continue;
                for (int kk = 0; kk < 256; ++kk) {
                    const int kp = n * 256 + kk;
                    const bf16* kr = base + (size_t)kp * LDP + 512 + h * 64;
                    const float sc = dot64(q, kr) * 0.125f - sl * (float)(s - kp);
                    os_update(sc, kr + 512, m, l, o);
                }
            }
            for (int kp = own * 256; kp <= s; ++kp) {
                const bf16* kr = base + (size_t)kp * LDP + 512 + h * 64;
                const float sc = dot64(q, kr) * 0.125f - sl * (float)(s - kp);
                os_update(sc, kr + 512, m, l, o);
            }
            const float inv = 1.0f / l;
            bf16* op = P.o + (size_t)t * D + h * 64;
#pragma unroll
            for (int d = 0; d < 64; ++d) op[d] = f2bf(o[d] * inv);
        } else {
            const int h = hh - 8, hkv = h >> 2, cur = s >> 6;
            load64(base + (size_t)s * LDP + 1536 + h * 64, q);
            const float sl = slope_of(h);
            const bf16* grow = base + (size_t)s * LDP + 2816 + h * 3;
            const float g0 = 1.0f / (1.0f + expf(-bf2f(grow[0])));
            const float g1 = 1.0f / (1.0f + expf(-bf2f(grow[1])));
            const float g2 = 1.0f / (1.0f + expf(-bf2f(grow[2])));
            float acc[64];
            const float* oc = P.ocmp + ((size_t)t * 8 + h) * 64;
#pragma unroll
            for (int d = 0; d < 64; ++d) acc[d] = g0 * oc[d];
            const unsigned mask = P.selmask[t * 2 + hkv];
            float m = NEG, l = 0.f;
            for (int j = 0; j <= cur; ++j) {
                if (!((mask >> j) & 1)) continue;
                for (int kk = 0; kk < 64; ++kk) {
                    const int kp = j * 64 + kk;
                    if (kp > s) break;
                    const bf16* kr = base + (size_t)kp * LDP + 2304 + hkv * 64;
                    const float sc = dot64(q, kr) * 0.125f - sl * (float)(s - kp);
                    os_update(sc, kr + 128, m, l, o);
                }
            }
            {
                const float f = g1 / l;
#pragma unroll
                for (int d = 0; d < 64; ++d) { acc[d] += f * o[d]; o[d] = 0.f; }
            }
            m = NEG; l = 0.f;
            const int s0 = s - 511 < 0 ? 0 : s - 511;
            for (int kp = s0; kp <= s; ++kp) {
                const bf16* kr = base + (size_t)kp * LDP + 2560 + hkv * 64;
                const float sc = dot64(q, kr) * 0.125f - sl * (float)(s - kp);
                os_update(sc, kr + 128, m, l, o);
            }
            {
                const float f = g2 / l;
#pragma unroll
                for (int d = 0; d < 64; ++d) acc[d] += f * o[d];
            }
            bf16* op = P.o + (size_t)t * D + 512 + h * 64;
#pragma unroll
            for (int d = 0; d < 64; ++d) op[d] = f2bf(acc[d]);
        }
    }
}

namespace pg8 {
#define PG8_LAS __attribute__((address_space(3)))
typedef unsigned short bf16_t;
typedef short bf16x8 __attribute__((ext_vector_type(8)));
typedef float f32x4 __attribute__((ext_vector_type(4)));
typedef unsigned u32x4 __attribute__((ext_vector_type(4)));
constexpr int BM = 256, BK = 64, HALF = 128, HTB = HALF * BK * 2, STAGE_BYTES = 8 * HTB, NXCD = 8, WGM = 8;

__host__ __device__ __forceinline__ int lds_byte(int r, int c) { const int st = (r >> 4) * 2 + (c >> 5), rr = r & 15, cc = c & 31, ob = rr * 64 + cc * 2; return st * 1024 + (ob ^ (((ob >> 9) & 1) << 5)); }
__host__ __device__ __forceinline__ void stage_rc(int b, int& R, int& C) { const int st = b / 1024, sb = b % 1024, swz = sb ^ (((sb >> 9) & 1) << 5); R = (st >> 1) * 16 + swz / 64; C = (st & 1) * 32 + (swz % 64) / 2; }
__host__ __device__ __forceinline__ int perm32(int rho) { const int n = rho >> 4, i = rho & 15; return 8 * (i >> 2) + 4 * n + (i & 3); }

struct Unit { const char* A; const char* B; int pm, pn; };

struct StaticOrder {
    int nM, nN, nwg, G, c; const char* A; const char* Bt; size_t tstep;
    __device__ void init(const bf16_t* A_, const bf16_t* Bt_, int M, int N, int K, int G_, int c_) { nM = M / BM; nN = N / BM; nwg = nM * nN; G = G_; c = c_; A = (const char*)A_; Bt = (const char*)Bt_; tstep = (size_t)BM * K * 2; }
    __device__ bool next(int i, Unit& u) const {
        const long L = (long)i * G + c; if (L >= nwg) return false;
        int wgid = (int)L; { const int q = nwg / NXCD, r = nwg % NXCD, xcd = wgid % NXCD, off = wgid / NXCD; wgid = (xcd < r ? xcd * (q + 1) : r * (q + 1) + (xcd - r) * q) + off; }
        const int nig = WGM * nN, gid = wgid / nig, fm = gid * WGM, gsz = (nM - fm) < WGM ? (nM - fm) : WGM;
        u.pm = fm + ((wgid % nig) % gsz); u.pn = (wgid % nig) / gsz; u.A = A + (size_t)u.pm * tstep; u.B = Bt + (size_t)u.pn * tstep; return true;
    }
};

__device__ __forceinline__ unsigned cvt_pk_bf16(float lo, float hi) { unsigned r; asm volatile("v_cvt_pk_bf16_f32 %0, %1, %2" : "=v"(r) : "v"(lo), "v"(hi)); return r; }

struct EpiStoreBf16 {
    static constexpr bool PERM = true;
    bf16_t* O; int ldc;
    __device__ __forceinline__ void operator()(const f32x4 (&acc)[2][2][4][2], const Unit& u, int wr, int wc, int fr, int fq) const {
        const int row0 = u.pm * BM + wr * 64 + fr, col0 = u.pn * BM + wc * 32 + 8 * fq;
#pragma unroll
        for (int ai = 0; ai < 2; ++ai)
#pragma unroll
            for (int m = 0; m < 4; ++m) { bf16_t* rowp = O + (size_t)(row0 + ai * HALF + m * 16) * ldc + col0;
#pragma unroll
                for (int bj = 0; bj < 2; ++bj) { const f32x4 v0 = acc[ai][bj][m][0], v1 = acc[ai][bj][m][1];
                    u32x4 w; w.x = cvt_pk_bf16(v0[0], v0[1]); w.y = cvt_pk_bf16(v0[2], v0[3]); w.z = cvt_pk_bf16(v1[0], v1[1]); w.w = cvt_pk_bf16(v1[2], v1[3]);
                    *(u32x4*)(rowp + bj * HALF) = w; } }
    }
};
struct EpiResidF32 {
    static constexpr bool PERM = true;
    const float* R; float* O; int ldc;
    __device__ __forceinline__ void operator()(const f32x4 (&acc)[2][2][4][2], const Unit& u, int wr, int wc, int fr, int fq) const {
        const int row0 = u.pm * BM + wr * 64 + fr, col0 = u.pn * BM + wc * 32 + 8 * fq;
#pragma unroll
        for (int ai = 0; ai < 2; ++ai)
#pragma unroll
            for (int m = 0; m < 4; ++m) { const size_t ro = (size_t)(row0 + ai * HALF + m * 16) * ldc + col0;
#pragma unroll
                for (int bj = 0; bj < 2; ++bj) {
                    const f32x4 r0 = *(const f32x4*)(R + ro + bj * HALF), r1 = *(const f32x4*)(R + ro + bj * HALF + 4);
                    *(f32x4*)(O + ro + bj * HALF) = r0 + acc[ai][bj][m][0]; *(f32x4*)(O + ro + bj * HALF + 4) = r1 + acc[ai][bj][m][1]; } }
    }
};
struct EpiSiluMul {
    static constexpr bool PERM = true;
    bf16_t* H; int ldh;
    __device__ __forceinline__ void operator()(const f32x4 (&acc)[2][2][4][2], const Unit& u, int wr, int wc, int fr, int fq) const {
        const int row0 = u.pm * BM + wr * 64 + fr, col0 = u.pn * HALF + wc * 32 + 8 * fq;
#pragma unroll
        for (int ai = 0; ai < 2; ++ai)
#pragma unroll
            for (int m = 0; m < 4; ++m) { bf16_t* rowp = H + (size_t)(row0 + ai * HALF + m * 16) * ldh + col0;
                float h[8];
#pragma unroll
                for (int n = 0; n < 2; ++n)
#pragma unroll
                    for (int j = 0; j < 4; ++j) { const float g = acc[ai][0][m][n][j], up = acc[ai][1][m][n][j]; h[n * 4 + j] = g * up / (1.0f + __expf(-g)); }
                u32x4 w; w.x = cvt_pk_bf16(h[0], h[1]); w.y = cvt_pk_bf16(h[2], h[3]); w.z = cvt_pk_bf16(h[4], h[5]); w.w = cvt_pk_bf16(h[6], h[7]);
                *(u32x4*)rowp = w; }
    }
};

template <class Epi, class Sched>
__device__ __forceinline__ void gemm_phase(PG8_LAS unsigned char* lds, const int K, const Sched& S, const Epi& E, const int tid) {
    const int wid = __builtin_amdgcn_readfirstlane(tid >> 6), lane = tid & 63, wr = wid >> 2, wc = wid & 3, fr = lane & 15, fq = lane >> 4;
    const int nt = K / BK;
    unsigned voffA[2], voffB[2];
#pragma unroll
    for (int i = 0; i < 2; ++i) { int R, C; stage_rc(tid * 16 + i * 8192, R, C); const int Rb = Epi::PERM ? ((R & ~31) + perm32(R & 31)) : R;
        voffA[i] = (unsigned)(R * K + C) * 2u; voffB[i] = (unsigned)(Rb * K + C) * 2u; }
    const size_t kstep = (size_t)(BK * 2);
    const size_t hstep = (size_t)HALF * K * 2;
    const unsigned ldsw = (unsigned)wid * 1024u;
    const int aoff = lds_byte(wr * 64 + fr, fq * 8), boff = lds_byte(wc * 32 + fr, fq * 8);
#define PG8_SA(b, h) (((b) * 2 + (h)) * HTB)
#define PG8_SB(b, h) ((4 + (b) * 2 + (h)) * HTB)
#define PG8_STAGE(bufoff, gbase, voff) do { _Pragma("unroll") for (int _i = 0; _i < 2; ++_i) \
        __builtin_amdgcn_global_load_lds((const unsigned*)((const char*)(gbase) + (voff)[_i]), (PG8_LAS unsigned*)(lds + (bufoff) + ldsw + _i * 8192), 16, 0, 0); } while (0)
#define PG8_LDA(dst, b, h) do { _Pragma("unroll") for (int m = 0; m < 4; ++m) _Pragma("unroll") for (int k = 0; k < 2; ++k) dst[m][k] = *(const PG8_LAS bf16x8*)(lds + PG8_SA(b, h) + aoff + m * 2048 + k * 1024); } while (0)
#define PG8_LDB(dst, b, h) do { _Pragma("unroll") for (int n = 0; n < 2; ++n) _Pragma("unroll") for (int k = 0; k < 2; ++k) dst[n][k] = *(const PG8_LAS bf16x8*)(lds + PG8_SB(b, h) + boff + n * 2048 + k * 1024); } while (0)
#define PG8_MMA(ai, bj, At, Bt) do { __builtin_amdgcn_s_setprio(1); _Pragma("unroll") for (int m = 0; m < 4; ++m) _Pragma("unroll") for (int n = 0; n < 2; ++n) _Pragma("unroll") for (int k = 0; k < 2; ++k) \
        acc[ai][bj][m][n] = __builtin_amdgcn_mfma_f32_16x16x32_bf16(Bt[n][k], At[m][k], acc[ai][bj][m][n], 0, 0, 0); __builtin_amdgcn_s_setprio(0); } while (0)
#define PG8_WAIT_V(n) asm volatile("s_waitcnt vmcnt(" #n ")" ::: "memory")
#define PG8_WAIT_L(n) asm volatile("s_waitcnt lgkmcnt(" #n ")" ::: "memory")
#define PG8_BAR __builtin_amdgcn_s_barrier()
#define PG8_SCHED __builtin_amdgcn_sched_barrier(0)
    Unit cur, nxt; int ui = 0;
    if (!S.next(0, cur)) return;
    f32x4 acc[2][2][4][2];
#pragma unroll
    for (int a = 0; a < 2; ++a)
#pragma unroll
        for (int b = 0; b < 2; ++b)
#pragma unroll
            for (int m = 0; m < 4; ++m)
#pragma unroll
                for (int n = 0; n < 2; ++n) acc[a][b][m][n] = (f32x4){0.f, 0.f, 0.f, 0.f};
    bf16x8 At[4][2], B0[2][2], B1[2][2];
    const char* cA = cur.A; const char* cB = cur.B;
    PG8_STAGE(PG8_SB(0, 0), cB, voffB); PG8_STAGE(PG8_SB(0, 1), cB + hstep, voffB); PG8_STAGE(PG8_SA(0, 0), cA, voffA); PG8_STAGE(PG8_SA(0, 1), cA + hstep, voffA);
    if (wr == 1) PG8_BAR;
    PG8_WAIT_V(2); PG8_BAR;
    PG8_STAGE(PG8_SB(1, 0), cB + kstep, voffB); PG8_STAGE(PG8_SA(1, 0), cA + kstep, voffA); PG8_STAGE(PG8_SB(1, 1), cB + hstep + kstep, voffB);
    PG8_WAIT_V(6); PG8_BAR;
    for (;;) {
        const bool has_next = S.next(ui + 1, nxt);
        const char* nA = has_next ? nxt.A : cA; const char* nB = has_next ? nxt.B : cB;
        for (int t = 0; t < nt; t += 2) {
            const bool last = (t == nt - 2);
            const char* a1 = cA + (size_t)(t + 1) * kstep;
            const char* a2 = last ? nA : cA + (size_t)(t + 2) * kstep; const char* b2 = last ? nB : cB + (size_t)(t + 2) * kstep;
            const char* a3 = a2 + kstep; const char* b3 = b2 + kstep;
            PG8_LDB(B0, 0, 0); PG8_LDB(B1, 0, 1); PG8_SCHED; PG8_LDA(At, 0, 0); PG8_STAGE(PG8_SA(1, 1), a1 + hstep, voffA);
            PG8_WAIT_V(8); PG8_WAIT_L(0); PG8_BAR; PG8_MMA(0, 0, At, B0); PG8_MMA(0, 1, At, B1); PG8_BAR; PG8_SCHED;
            PG8_LDA(At, 0, 1); PG8_STAGE(PG8_SB(0, 0), b2, voffB); PG8_STAGE(PG8_SB(0, 1), b2 + hstep, voffB); PG8_STAGE(PG8_SA(0, 0), a2, voffA);
            PG8_WAIT_V(8); PG8_WAIT_L(0); PG8_BAR; PG8_MMA(1, 0, At, B0); PG8_MMA(1, 1, At, B1); PG8_BAR; PG8_SCHED;
            PG8_LDB(B0, 1, 0); PG8_LDB(B1, 1, 1); PG8_SCHED; PG8_LDA(At, 1, 0); PG8_STAGE(PG8_SA(0, 1), a2 + hstep, voffA);
            PG8_WAIT_V(8); PG8_WAIT_L(0); PG8_BAR; PG8_MMA(0, 0, At, B0); PG8_MMA(0, 1, At, B1); PG8_BAR; PG8_SCHED;
            PG8_LDA(At, 1, 1); PG8_STAGE(PG8_SB(1, 0), b3, voffB); PG8_STAGE(PG8_SB(1, 1), b3 + hstep, voffB); PG8_STAGE(PG8_SA(1, 0), a3, voffA);
            PG8_WAIT_V(8); PG8_WAIT_L(0); PG8_BAR; PG8_MMA(1, 0, At, B0); PG8_MMA(1, 1, At, B1); PG8_BAR; PG8_SCHED;
        }
        if (wr == 0) PG8_BAR;
        { int fr2 = lane & 15, fq2 = lane >> 4; asm volatile("" : "+v"(fr2), "+v"(fq2)); E(acc, cur, wr, wc, fr2, fq2); }
        if (!has_next) break;
#pragma unroll
        for (int a = 0; a < 2; ++a)
#pragma unroll
            for (int b = 0; b < 2; ++b)
#pragma unroll
                for (int m = 0; m < 4; ++m)
#pragma unroll
                    for (int n = 0; n < 2; ++n) acc[a][b][m][n] = (f32x4){0.f, 0.f, 0.f, 0.f};
        cur = nxt; cA = nA; cB = nB; ++ui;
        if (wr == 1) PG8_BAR;
    }
    PG8_WAIT_V(0);
    PG8_BAR;
#undef PG8_SA
#undef PG8_SB
#undef PG8_STAGE
#undef PG8_LDA
#undef PG8_LDB
#undef PG8_MMA
#undef PG8_WAIT_V
#undef PG8_WAIT_L
#undef PG8_BAR
#undef PG8_SCHED
}
}

#define GAS __attribute__((address_space(1)))
#define LAS __attribute__((address_space(3)))
typedef unsigned v4u __attribute__((ext_vector_type(4)));
typedef float f32x4 __attribute__((ext_vector_type(4)));
typedef short bf16x8 __attribute__((ext_vector_type(8)));
constexpr int NWAVES = 8;
constexpr int RING_BYTES = 131072, LDSCTL_OFF = RING_BYTES, MISC_OFF = LDSCTL_OFF + 320, LDS_BYTES = 147456;
constexpr size_t MiB = 1u << 20;
constexpr size_t CTL_ZERO_BYTES = 1 * MiB;
constexpr int CW_BAR = 4096;
constexpr int CW_MOE = 65536;
#define LDS_WAIT() asm volatile("s_waitcnt lgkmcnt(0)" ::: "memory")
#define VM_WAIT() asm volatile("s_waitcnt vmcnt(0)" ::: "memory")
DEV unsigned pk2(float lo, float hi) { return (unsigned)f2bf(lo) | ((unsigned)f2bf(hi) << 16); }

#define XB_TMO      128
#define XB_XCNT(j)  (256  + 64 * (j))
#define XB_XSUB(j)  (1280 + 64 * (j))
#define XB_XGEN(j)  (2304 + 64 * (j))
#define XB_TOP      3328
#define XB_TOPGEN   3392
#define XCD_BAR_WORDS 3456
#define XB_SPIN_CAP (1u << 22)
DEV unsigned xb_ld(unsigned* p)              { return __hip_atomic_load(p, __ATOMIC_RELAXED, __HIP_MEMORY_SCOPE_AGENT); }
DEV unsigned xb_add(unsigned* p, unsigned v) { return __hip_atomic_fetch_add(p, v, __ATOMIC_RELAXED, __HIP_MEMORY_SCOPE_AGENT); }
DEV unsigned xb_xcc_id() { return (unsigned)__builtin_amdgcn_s_getreg((3 << 11) | 20) & 0xFu; }
#define XB_SPIN(cond, bar) do { unsigned _sp = 0; while (cond) { __builtin_amdgcn_s_sleep(1); \
    if ((++_sp & 255u) == 0u) { if (xb_ld(&(bar)[XB_TMO])) break; if (_sp > XB_SPIN_CAP) { atomicAdd(&(bar)[XB_TMO], 1u); break; } } } } while (0)
struct XcdBarrier { unsigned* bar; unsigned x; volatile LAS unsigned* st; };
DEV XcdBarrier xcd_barrier_post(unsigned* bar, volatile LAS unsigned* st) {
    XcdBarrier b; b.bar = bar; b.x = xb_xcc_id(); b.st = st;
    if (threadIdx.x == 0) (void)xb_add(&bar[XB_XCNT(b.x)], 1u);
    return b;
}
DEV void xcd_barrier_complete(unsigned* bar, unsigned x, unsigned& nloc, unsigned& nx) {
    const unsigned G = gridDim.x * gridDim.y * gridDim.z;
    unsigned sum, cnt, mine, sp = 0u;
    for (;;) {
        sum = 0u; cnt = 0u; mine = 0u;
#pragma unroll
        for (unsigned j = 0; j < 16; ++j) { const unsigned c = xb_ld(&bar[XB_XCNT(j)]); sum += c; cnt += (c > 0u) ? 1u : 0u; mine = (j == x) ? c : mine; }
        if (sum == G) break;
        __builtin_amdgcn_s_sleep(1);
        if ((++sp & 255u) == 0u) { if (xb_ld(&bar[XB_TMO])) break; if (sp > XB_SPIN_CAP) { atomicAdd(&bar[XB_TMO], 1u); break; } }
    }
    nloc = mine > 0u ? mine : 1u; nx = cnt > 0u ? cnt : 1u;
}
DEV void xcd_barrier(const XcdBarrier& b, const int tid_) {
    asm volatile("s_waitcnt vmcnt(0)" ::: "memory");
    __syncthreads();
    if (tid_ == 0) {
        unsigned* bar = b.bar;
        __builtin_amdgcn_s_waitcnt(0);
        unsigned nloc = b.st[0], nx = b.st[1];
        if (nloc == 0u) { xcd_barrier_complete(bar, b.x, nloc, nx); b.st[0] = nloc; b.st[1] = nx; }
        const unsigned old = xb_add(&bar[XB_XSUB(b.x)], 1u);
        const unsigned gen = old / nloc;
        if (old + 1u == (gen + 1u) * nloc) {
            __builtin_amdgcn_fence(__ATOMIC_RELEASE, "agent");
            asm volatile("s_waitcnt vmcnt(0)" ::: "memory");
            const unsigned og = xb_add(&bar[XB_TOP], 1u);
            const unsigned tg = og / nx;
            if (og + 1u == (tg + 1u) * nx) xb_add(&bar[XB_TOPGEN], 1u);
            else XB_SPIN(xb_ld(&bar[XB_TOPGEN]) == tg, bar);
            __builtin_amdgcn_fence(__ATOMIC_ACQUIRE, "agent");
            xb_add(&bar[XB_XGEN(b.x)], 1u);
            asm volatile("s_waitcnt vmcnt(0)" ::: "memory");
        } else {
            XB_SPIN(xb_ld(&bar[XB_XGEN(b.x)]) == gen, bar);
            __builtin_amdgcn_fence(__ATOMIC_ACQUIRE, "agent");
            asm volatile("s_waitcnt vmcnt(0)" ::: "memory");
        }
    }
    __syncthreads();
}

struct Frame {
    LAS unsigned char* lds;
    volatile LAS unsigned* MISC;
    int tid, lane, wave;
    int vcu, G;
};

DEV void refresh(Frame& F) { int l; asm volatile("v_mbcnt_lo_u32_b32 %0, -1, 0\n\tv_mbcnt_hi_u32_b32 %0, -1, %0" : "=v"(l)); F.lane = l; F.tid = F.wave * 64 + l; }
DEV float wave_sum(float v) {
#pragma unroll
    for (int o = 1; o < 64; o <<= 1) v += __shfl_xor(v, o);
    return v;
}
DEV void transpose_item(const float* W, int K, int N, bf16* WT, int k0, int n0, int dst_row0, LAS float* scr, int lane) {
    const bool okc = (n0 + (lane & 31)) < N;
#pragma unroll 8
    for (int i = 0; i < 32; ++i) { const int kk = 2 * i + (lane >> 5); scr[kk * 33 + (lane & 31)] = okc ? W[(size_t)(k0 + kk) * N + n0 + (lane & 31)] : 0.f; }
    LDS_WAIT(); asm volatile("" ::: "memory");
    const int c = lane & 7;
#pragma unroll
    for (int j = 0; j < 4; ++j) { const int n = (lane >> 3) + 8 * j; const LAS float* s = scr + (8 * c) * 33 + n;
        v4u o; o.x = pk2(s[0 * 33], s[1 * 33]); o.y = pk2(s[2 * 33], s[3 * 33]); o.z = pk2(s[4 * 33], s[5 * 33]); o.w = pk2(s[6 * 33], s[7 * 33]);
        if (n0 + n < N) *(GAS v4u*)(WT + (size_t)(dst_row0 + n) * K + k0 + 8 * c) = o; }
    LDS_WAIT(); asm volatile("" ::: "memory");
}
DEV float rms_row_to_bf16(int lane, const float* xrow, const float* gain, bf16* orow) {
    const GAS f32x4* xr = (const GAS f32x4*)xrow + lane;
    const GAS f32x4* gr = (const GAS f32x4*)gain + lane;
    f32x4 v[4]; float s = 0.f;
#pragma unroll
    for (int j = 0; j < 4; ++j) { v[j] = xr[64 * j]; s += (v[j].x * v[j].x + v[j].y * v[j].y) + (v[j].z * v[j].z + v[j].w * v[j].w); }
    const float rstd = 1.0f / sqrtf(wave_sum(s) * (1.f / D) + EPS);
    GAS unsigned long long* o8 = (GAS unsigned long long*)orow + lane;
#pragma unroll
    for (int j = 0; j < 4; ++j) { const f32x4 g = gr[64 * j];
        o8[64 * j] = (unsigned long long)pk2(v[j].x * rstd * g.x, v[j].y * rstd * g.y) | ((unsigned long long)pk2(v[j].z * rstd * g.z, v[j].w * rstd * g.w) << 32); }
    return rstd;
}

DEV void fp_convert_weights(const Params& P, Frame& F, int which) {
    LAS float* scr = (LAS float*)(F.lds + F.wave * 16384);
    const int gw = F.vcu * NWAVES + F.wave, NGW = F.G * NWAVES;
    if (which == 0) {
        constexpr int I_IN0 = 16 * 72, I_OUT = 16 * 32, I_IN1 = 16 * 89;
        constexpr int NIT = I_IN0 + I_OUT + I_IN1 + I_OUT;
        for (int it = gw; it < NIT; it += NGW) {
            int r = it;
            if (r < I_IN0) { const int kb = r / 72, nb = r % 72; transpose_item(P.ev_w_in, D, EVEN_IN, P.win0t, 64 * kb, 32 * nb, 32 * nb, scr, F.lane); continue; } r -= I_IN0;
            if (r < I_OUT) { const int kb = r / 32, nb = r % 32; transpose_item(P.ev_w_out, D, D, P.wout0t, 64 * kb, 32 * nb, 32 * nb, scr, F.lane); continue; } r -= I_OUT;
            if (r < I_IN1) { const int kb = r / 89, nb = r % 89; transpose_item(P.od_w_in, D, ODD_IN, P.win1t, 64 * kb, 32 * nb, 32 * nb, scr, F.lane); continue; } r -= I_IN1;
            { const int kb = r / 32, nb = r % 32; transpose_item(P.od_w_out, D, D, P.wout1t, 64 * kb, 32 * nb, 32 * nb, scr, F.lane); }
        }
    } else {
        const int layer = which - 1;
        constexpr int NIT = 32 * 384;
        for (int it = gw; it < NIT; it += NGW) {
            const int e = it / 384; int r = it % 384;
            const size_t eo = (size_t)(layer * 32 + e);
            if (r < 256) { const bool up = r >= 128; r &= 127; const int kb = r / 8, nb = r % 8; const int f0 = 32 * nb;
                const float* W = (up ? P.moe_w_up : P.moe_w_gate) + eo * D * 256;
                transpose_item(W, D, 256, P.wgut + (size_t)e * 512 * D, 64 * kb, f0, (f0 >> 7) * 256 + (up ? 128 : 0) + (f0 & 127), scr, F.lane);
            } else { r -= 256; const int kb = r / 32, nb = r % 32;
                transpose_item(P.moe_w_down + eo * 256 * D, 256, D, P.wdt + (size_t)e * D * 256, 64 * kb, 32 * nb, 32 * nb, scr, F.lane); }
        }
    }
}
DEV void fp_norm_rows(Frame& F, const float* src, const float* gain, bf16* xn) {
    const int gw = F.vcu * NWAVES + F.wave, NGW = F.G * NWAVES;
    for (int m = gw; m < T; m += NGW) rms_row_to_bf16(F.lane, src + (size_t)m * D, gain, xn + (size_t)m * D);
}

constexpr int TAB_OFF = MISC_OFF + 128;
constexpr int RT_PART_OFF = 0;
constexpr int RT_SS_OFF = 24576;
constexpr int RT_HIST_OFF = 25088;
typedef float f32x4v __attribute__((ext_vector_type(4)));

DEV void fp_prep_router(const Params& P, Frame& F) {
    const int gtid = F.vcu * NWAVES * 64 + F.tid, gsz = F.G * NWAVES * 64;
    for (int i = gtid; i < 2 * 48 * D; i += gsz) {
        const int k = i & (D - 1), j = (i >> 10) % 48, l = i / (48 * D);
        float w = 0.f;
        if (j < 4) w = P.moe_w_grp[((size_t)l * D + k) * 4 + j]; else if (j < 36) w = P.moe_w_exp[((size_t)l * D + k) * 32 + (j - 4)];
        w *= P.moe_norm[l * D + k];
        const bf16 hi = f2bf(w); const bf16 lo = f2bf(w - bf2f(hi));
        P.wr[((size_t)(l * 2 + 0) * 48 + j) * D + k] = hi;
        P.wr[((size_t)(l * 2 + 1) * 48 + j) * D + k] = lo;
    }
}

DEV void fp_route(const Params& P, Frame& F, int layer) {
    const int lane = F.lane, w = F.wave, rg = w & 3, kh = w >> 2;
    const bf16* wr_hi = P.wr + (size_t)(layer * 2 + 0) * 48 * D;
    const bf16* wr_lo = P.wr + (size_t)(layer * 2 + 1) * 48 * D;
    LAS float* part = (LAS float*)(F.lds + RT_PART_OFF);
    LAS float* ssp = (LAS float*)(F.lds + RT_SS_OFF);
    LAS unsigned* hist = (LAS unsigned*)(F.lds + RT_HIST_OFF);
    unsigned* cnt = P.ctl + CW_MOE + layer * 256;
    for (int tb = F.vcu; tb < T / 64; tb += F.G) {
        const int t0 = tb * 64;
        if (F.tid < 64) hist[F.tid] = 0u;
        const float* xrow = P.out + (size_t)(t0 + 16 * rg + (lane & 15)) * D + 512 * kh + 8 * (lane >> 4);
        pg8::f32x4 acc[3];
#pragma unroll
        for (int c = 0; c < 3; ++c) acc[c] = (pg8::f32x4){0.f, 0.f, 0.f, 0.f};
        float ss = 0.f;
        const size_t boff = (size_t)(lane & 15) * D + 512 * kh + 8 * (lane >> 4);
#pragma unroll 4
        for (int ks = 0; ks < 16; ++ks) {
            const f32x4v x0 = *(const f32x4v*)(xrow + 32 * ks), x1 = *(const f32x4v*)(xrow + 32 * ks + 4);
            float xv[8] = {x0.x, x0.y, x0.z, x0.w, x1.x, x1.y, x1.z, x1.w};
            bf16x8 ah, al;
#pragma unroll
            for (int j = 0; j < 8; ++j) { ss += xv[j] * xv[j]; const bf16 h = f2bf(xv[j]); ah[j] = (short)h; al[j] = (short)f2bf(xv[j] - bf2f(h)); }
#pragma unroll
            for (int c = 0; c < 3; ++c) {
                const bf16x8 bh = *(const bf16x8*)(wr_hi + boff + (size_t)16 * c * D + 32 * ks);
                const bf16x8 bl = *(const bf16x8*)(wr_lo + boff + (size_t)16 * c * D + 32 * ks);
                acc[c] = __builtin_amdgcn_mfma_f32_16x16x32_bf16(ah, bh, acc[c], 0, 0, 0);
                acc[c] = __builtin_amdgcn_mfma_f32_16x16x32_bf16(ah, bl, acc[c], 0, 0, 0);
                acc[c] = __builtin_amdgcn_mfma_f32_16x16x32_bf16(al, bh, acc[c], 0, 0, 0);
            }
        }
        ss += __shfl_xor(ss, 16); ss += __shfl_xor(ss, 32);
#pragma unroll
        for (int c = 0; c < 3; ++c)
#pragma unroll
            for (int r = 0; r < 4; ++r) part[(kh * 64 + 16 * rg + 4 * (lane >> 4) + r) * 48 + 16 * c + (lane & 15)] = acc[c][r];
        if (lane < 16) ssp[kh * 64 + 16 * rg + lane] = ss;
        __syncthreads();
        int e1 = 0, e2 = 0; float w1 = 0.f, w2 = 0.f; unsigned r1 = 0, r2 = 0;
        if (F.tid < 64) {
            const int t = t0 + F.tid;
            const float rs = 1.0f / sqrtf((ssp[F.tid] + ssp[64 + F.tid]) * (1.f / D) + EPS);
            P.rstd[t] = rs;
            float lg[4], le[32];
#pragma unroll
            for (int j = 0; j < 4; ++j) lg[j] = (part[F.tid * 48 + j] + part[(64 + F.tid) * 48 + j]) * rs + P.moe_b_grp[layer * 4 + j];
#pragma unroll
            for (int j = 0; j < 32; ++j) le[j] = (part[F.tid * 48 + 4 + j] + part[(64 + F.tid) * 48 + 4 + j]) * rs + P.moe_b_exp[layer * 32 + j];
            int gs = 0; float gm = lg[0];
#pragma unroll
            for (int j = 1; j < 4; ++j) if (lg[j] > gm) { gm = lg[j]; gs = j; }
            float gz = 0.f;
#pragma unroll
            for (int j = 0; j < 4; ++j) gz += expf(lg[j] - gm);
            const float pg = 1.0f / gz;
            float wv[8];
#pragma unroll
            for (int j = 0; j < 8; ++j) wv[j] = gs == 0 ? le[j] : gs == 1 ? le[8 + j] : gs == 2 ? le[16 + j] : le[24 + j];
            int i1 = 0; float m1 = wv[0];
#pragma unroll
            for (int j = 1; j < 8; ++j) if (wv[j] > m1) { m1 = wv[j]; i1 = j; }
            int i2 = -1; float m2 = -3e38f;
#pragma unroll
            for (int j = 0; j < 8; ++j) if (j != i1 && wv[j] > m2) { m2 = wv[j]; i2 = j; }
            const float ex2 = expf(m2 - m1);
            w1 = pg / (1.0f + ex2); w2 = pg * ex2 / (1.0f + ex2);
            e1 = gs * 8 + i1; e2 = gs * 8 + i2;
            r1 = __hip_atomic_fetch_add(&hist[e1], 1u, __ATOMIC_RELAXED, __HIP_MEMORY_SCOPE_WORKGROUP); r2 = __hip_atomic_fetch_add(&hist[e2], 1u, __ATOMIC_RELAXED, __HIP_MEMORY_SCOPE_WORKGROUP);
        }
        __syncthreads();
        if (F.tid < 32) { const unsigned h = hist[F.tid]; hist[32 + F.tid] = h ? xb_add(&cnt[F.tid], h) : 0u; }
        __syncthreads();
        if (F.tid < 64) {
            const int t = t0 + F.tid;
            P.eid[t * 2 + 0] = e1; P.eid[t * 2 + 1] = e2; P.ew[t * 2 + 0] = w1; P.ew[t * 2 + 1] = w2;
            P.pos[t * 2 + 0] = (int)(hist[32 + e1] + r1); P.pos[t * 2 + 1] = (int)(hist[32 + e2] + r2);
        }
        __syncthreads();
    }
}

DEV void moe_table(const Params& P, Frame& F, int layer) {
    volatile LAS int* tab = (volatile LAS int*)(F.lds + TAB_OFF);
    if (F.tid == 0) {
        unsigned* cnt = P.ctl + CW_MOE + layer * 256;
        int acc = 0;
        for (int e = 0; e < 32; ++e) { tab[e] = acc; acc += (int)((xb_ld(&cnt[e]) + 255u) >> 8); }
        tab[32] = acc;
    }
    __syncthreads();
}

DEV void fp_gather(const Params& P, Frame& F, int layer) {
    moe_table(P, F, layer);
    volatile LAS int* tab = (volatile LAS int*)(F.lds + TAB_OFF);
    const float* gain = P.moe_norm + layer * D;
    const int gw = F.vcu * NWAVES + F.wave, NGW = F.G * NWAVES, lane = F.lane;
    for (int t = gw; t < T; t += NGW) {
        const int e1 = P.eid[t * 2], e2 = P.eid[t * 2 + 1];
        const int p1 = tab[e1] * 256 + P.pos[t * 2], p2 = tab[e2] * 256 + P.pos[t * 2 + 1];
        const GAS f32x4* xr = (const GAS f32x4*)(P.out + (size_t)t * D) + lane;
        const GAS f32x4* gr = (const GAS f32x4*)gain + lane;
        const float rstd = P.rstd[t];
        GAS unsigned long long* o1 = (GAS unsigned long long*)(P.ha + (size_t)p1 * D) + lane;
        GAS unsigned long long* o2 = (GAS unsigned long long*)(P.ha + (size_t)p2 * D) + lane;
#pragma unroll
        for (int j = 0; j < 4; ++j) { const f32x4 v = xr[64 * j], g = gr[64 * j];
            const unsigned long long q = (unsigned long long)pk2(v.x * rstd * g.x, v.y * rstd * g.y) | ((unsigned long long)pk2(v.z * rstd * g.z, v.w * rstd * g.w) << 32);
            o1[64 * j] = q; o2[64 * j] = q; }
        if (lane == 0) { P.pos[t * 2] = p1; P.pos[t * 2 + 1] = p2; }
    }
}

struct ListOrder {
    int code[4]; int n, npn; const char* A; const char* Bt; size_t tstep;
    __device__ __forceinline__ bool next(int i, pg8::Unit& o) const {
        if (i >= n) return false;
        const int c = (i == 0) ? code[0] : (i == 1) ? code[1] : (i == 2) ? code[2] : code[3];
        const int tt = c >> 8, e = (c >> 3) & 31, pn = c & 7;
        o.pm = tt; o.pn = pn; o.A = A + (size_t)tt * tstep; o.B = Bt + (size_t)(e * npn + pn) * tstep; return true;
    }
};
DEV void moe_units(Frame& F, ListOrder& L, int npn, const bf16* A, const bf16* Bt, int K) {
    volatile LAS int* tab = (volatile LAS int*)(F.lds + TAB_OFF);
    const int ntile = tab[32], total = ntile * npn;
    L.tstep = (size_t)256 * K * 2; L.A = (const char*)A; L.Bt = (const char*)Bt; L.npn = npn;
    int n = 0;
#pragma unroll
    for (int i = 0; i < 4; ++i) {
        const int Lx = i * F.G + F.vcu;
        int code = 0;
        if (Lx < total) {
            const int tt = Lx / npn, pn = Lx % npn;
            int e = 0;
            for (int q = 1; q < 32; ++q) e += (tt >= tab[q]) ? 1 : 0;
            code = (tt << 8) | (e << 3) | pn;
            n = i + 1;
        }
        L.code[i] = __builtin_amdgcn_readfirstlane(code);
    }
    L.n = __builtin_amdgcn_readfirstlane(n);
}

DEV void fp_moe_gu(const Params& P, Frame& F, int layer) {
    moe_table(P, F, layer);
    ListOrder L; moe_units(F, L, 2, P.ha, P.wgut, D);
    pg8::EpiSiluMul E{P.hid, 256};
    pg8::gemm_phase(F.lds, D, L, E, F.tid);
}
DEV void fp_moe_dn(const Params& P, Frame& F, int layer) {
    moe_table(P, F, layer);
    ListOrder L; moe_units(F, L, 4, P.hid, P.wdt, 256);
    pg8::EpiStoreBf16 E{P.ha, D};
    pg8::gemm_phase(F.lds, 256, L, E, F.tid);
}
DEV void fp_combine(const Params& P, Frame& F, const float* gain2, bf16* xn) {
    const int gw = F.vcu * NWAVES + F.wave, NGW = F.G * NWAVES, lane = F.lane;
    for (int t = gw; t < T; t += NGW) {
        const int p1 = P.pos[t * 2], p2 = P.pos[t * 2 + 1];
        const float w1 = P.ew[t * 2], w2 = P.ew[t * 2 + 1];
        GAS f32x4* xr = (GAS f32x4*)(P.out + (size_t)t * D) + lane;
        const GAS unsigned long long* y1 = (const GAS unsigned long long*)(P.ha + (size_t)p1 * D) + lane;
        const GAS unsigned long long* y2 = (const GAS unsigned long long*)(P.ha + (size_t)p2 * D) + lane;
        f32x4 v[4]; float s = 0.f;
#pragma unroll
        for (int j = 0; j < 4; ++j) {
            v[j] = xr[64 * j];
            const unsigned long long a = y1[64 * j], b = y2[64 * j];
            v[j].x += w1 * u2f((unsigned)(a & 0xffffu) << 16) + w2 * u2f((unsigned)(b & 0xffffu) << 16);
            v[j].y += w1 * u2f((unsigned)((a >> 16) & 0xffffu) << 16) + w2 * u2f((unsigned)((b >> 16) & 0xffffu) << 16);
            v[j].z += w1 * u2f((unsigned)((a >> 32) & 0xffffu) << 16) + w2 * u2f((unsigned)((b >> 32) & 0xffffu) << 16);
            v[j].w += w1 * u2f((unsigned)((a >> 48) & 0xffffu) << 16) + w2 * u2f((unsigned)((b >> 48) & 0xffffu) << 16);
            xr[64 * j] = v[j];
            s += (v[j].x * v[j].x + v[j].y * v[j].y) + (v[j].z * v[j].z + v[j].w * v[j].w);
        }
        if (xn) {
            const float rstd = 1.0f / sqrtf(wave_sum(s) * (1.f / D) + EPS);
            const GAS f32x4* gr = (const GAS f32x4*)gain2 + lane;
            GAS unsigned long long* o8 = (GAS unsigned long long*)(xn + (size_t)t * D) + lane;
#pragma unroll
            for (int j = 0; j < 4; ++j) { const f32x4 g = gr[64 * j];
                o8[64 * j] = (unsigned long long)pk2(v[j].x * rstd * g.x, v[j].y * rstd * g.y) | ((unsigned long long)pk2(v[j].z * rstd * g.z, v[j].w * rstd * g.w) << 32); }
        }
    }
}

namespace att {
typedef float f32x16 __attribute__((ext_vector_type(16)));
typedef short s16x4 __attribute__((ext_vector_type(4)));
typedef short v4i16_t __attribute__((ext_vector_type(4)));
typedef LAS const char* lptr;
constexpr float LOG2E = 1.4426950408889634f;
constexpr int KS0 = 0, VS0 = 16384, SLOT = 8192;
constexpr float MNEG = -1e30f;

struct TileRegs { v4u k, v; };
DEV void tile_load(TileRegs& R, const bf16* Kg, const bf16* Vg, int pitch, int k0, int tid) {
    const int w = tid >> 6, lane = tid & 63;
    R.k = *(const GAS v4u*)(Kg + (size_t)(k0 + lane) * pitch + w * 8);
    R.v = *(const GAS v4u*)(Vg + (size_t)(k0 + 16 * (w & 3) + (lane >> 2)) * pitch + (w >> 2) * 32 + (lane & 3) * 8);
}
DEV void tile_store(LAS unsigned char* lds, int slot, const TileRegs& R, int tid) {
    *(LAS v4u*)(lds + KS0 + slot * SLOT + tid * 16) = R.k;
    *(LAS v4u*)(lds + VS0 + slot * SLOT + tid * 16) = R.v;
}
DEV void qk_tile(f32x16& p0, f32x16& p1, lptr Kslot, const bf16x8 (&qr)[4], int r32, int hi) {
    lptr kb = Kslot + hi * 1024 + r32 * 16;
    p0 = f32x16{}; p1 = f32x16{};
#pragma unroll
    for (int d0 = 0; d0 < 4; ++d0) {
        const bf16x8 b0 = *(const LAS bf16x8*)(kb + d0 * 2048);
        const bf16x8 b1 = *(const LAS bf16x8*)(kb + d0 * 2048 + 512);
        p0 = __builtin_amdgcn_mfma_f32_32x32x16_bf16(b0, qr[d0], p0, 0, 0, 0);
        p1 = __builtin_amdgcn_mfma_f32_32x32x16_bf16(b1, qr[d0], p1, 0, 0, 0);
    }
}
DEV s16x4 vtr(lptr p) { return __builtin_bit_cast(s16x4, __builtin_amdgcn_ds_read_tr16_b64_v4i16((LAS v4i16_t*)p)); }
DEV unsigned cvtpk(float lo, float hi) { unsigned r; asm volatile("v_cvt_pk_bf16_f32 %0, %1, %2" : "=v"(r) : "v"(lo), "v"(hi)); return r; }
DEV void pv_tile(f32x16 (&o)[2], lptr Vslot, const f32x16& p0, const f32x16& p1, int lane) {
    const int hi = lane >> 5;
    lptr vp = Vslot + ((lane >> 4) & 1) * 32 + (lane & 3) * 8 + (4 * hi + ((lane & 15) >> 2)) * 64;
    bf16x8 pf[4];
#pragma unroll
    for (int ks = 0; ks < 4; ++ks) {
        const f32x16& p = (ks < 2) ? p0 : p1; const int b = (ks & 1) * 8;
        v4u w; w.x = cvtpk(p[b + 0], p[b + 1]); w.y = cvtpk(p[b + 2], p[b + 3]); w.z = cvtpk(p[b + 4], p[b + 5]); w.w = cvtpk(p[b + 6], p[b + 7]);
        pf[ks] = __builtin_bit_cast(bf16x8, w);
    }
#pragma unroll
    for (int d0 = 0; d0 < 2; ++d0)
#pragma unroll
        for (int ks = 0; ks < 4; ++ks) {
            const s16x4 lo = vtr(vp + d0 * 4096 + ks * 1024), hh = vtr(vp + d0 * 4096 + ks * 1024 + 512);
            const bf16x8 vf = (bf16x8){lo[0], lo[1], lo[2], lo[3], hh[0], hh[1], hh[2], hh[3]};
            o[d0] = __builtin_amdgcn_mfma_f32_32x32x16_bf16(vf, pf[ks], o[d0], 0, 0, 0);
        }
}
DEV float lane_swap_max(float m) {
    auto rr = __builtin_amdgcn_permlane32_swap(__float_as_uint(m), __float_as_uint(m), false, false);
    return fmaxf(__uint_as_float(rr[0]), __uint_as_float(rr[1]));
}
DEV float lane_swap_sum(float m) {
    auto rr = __builtin_amdgcn_permlane32_swap(__float_as_uint(m), __float_as_uint(m), false, false);
    return __uint_as_float(rr[0]) + __uint_as_float(rr[1]);
}
DEV float lane_partner(float m, int hi) {
    auto rr = __builtin_amdgcn_permlane32_swap(__float_as_uint(m), __float_as_uint(m), false, false);
    return hi ? __uint_as_float(rr[0]) : __uint_as_float(rr[1]);
}

struct SoftState { float m, l; f32x16 o[2]; };
DEV void soft_reset(SoftState& s) { s.m = MNEG; s.l = 0.f; s.o[0] = f32x16{}; s.o[1] = f32x16{}; }

DEV void soft_tile(SoftState& st, f32x16& p0, f32x16& p1, float s2, float k0rel_f, int klo, int klim, bool need_mask, lptr Vslot, int lane) {
    const int hi = lane >> 5;
    const float c1 = 0.125f * LOG2E;
    const float base = s2 * (k0rel_f + (float)(4 * hi));
    float mx = MNEG;
#pragma unroll
    for (int r = 0; r < 16; ++r) {
        const int kr = (r & 3) + 8 * (r >> 2);
        float x0 = fmaf(p0[r], c1, fmaf(s2, (float)kr, base));
        float x1 = fmaf(p1[r], c1, fmaf(s2, (float)(kr + 32), base));
        if (need_mask) { x0 = (kr > klo && kr <= klim) ? x0 : MNEG; x1 = (kr + 32 > klo && kr + 32 <= klim) ? x1 : MNEG; }
        p0[r] = x0; p1[r] = x1;
        mx = fmaxf(mx, fmaxf(x0, x1));
    }
    mx = lane_swap_max(mx);
    const float mnew = fmaxf(st.m, mx);
    if (__any(mnew > st.m)) {
        const float alpha = __builtin_amdgcn_exp2f(st.m - mnew);
        st.l *= alpha;
#pragma unroll
        for (int r = 0; r < 16; ++r) { st.o[0][r] *= alpha; st.o[1][r] *= alpha; }
        st.m = mnew;
    }
    float ls = 0.f;
#pragma unroll
    for (int r = 0; r < 16; ++r) {
        p0[r] = __builtin_amdgcn_exp2f(p0[r] - st.m); p1[r] = __builtin_amdgcn_exp2f(p1[r] - st.m);
        ls += p0[r] + p1[r];
    }
    st.l += ls;
    pv_tile(st.o, Vslot, p0, p1, lane);
}

DEV void store_ot(const f32x16 (&o)[2], float f, bf16* orow, int hi) {
#pragma unroll
    for (int d0 = 0; d0 < 2; ++d0)
#pragma unroll
        for (int g = 0; g < 4; ++g) {
            const unsigned a = cvtpk(o[d0][4 * g] * f, o[d0][4 * g + 1] * f), b = cvtpk(o[d0][4 * g + 2] * f, o[d0][4 * g + 3] * f);
            *(GAS unsigned long long*)(orow + 32 * d0 + 8 * g + 4 * hi) = (unsigned long long)a | ((unsigned long long)b << 32);
        }
}
DEV void load_q(bf16x8 (&qr)[4], const bf16* qrow, int hi) {
#pragma unroll
    for (int d0 = 0; d0 < 4; ++d0) qr[d0] = *(const GAS bf16x8*)(qrow + 16 * d0 + 8 * hi);
}

template <class MaskF>
DEV void run_segment(Frame& F, SoftState& st, const bf16x8 (&qr)[4], const bf16* Kg, const bf16* Vg, int pitch, int t0, int t1, float s2, int qpos, const MaskF& mf) {
    const int tid = F.tid, lane = F.lane, r32 = lane & 31, hi = lane >> 5;
    if (t1 < t0) return;
    TileRegs R; tile_load(R, Kg, Vg, pitch, t0 * 64, tid);
    int slot = 0;
    for (int t = t0; t <= t1; ++t) {
        tile_store(F.lds, slot, R, tid);
        if (t < t1) tile_load(R, Kg, Vg, pitch, (t + 1) * 64, tid);
        __syncthreads();
        int klo, klim; mf(t, klo, klim);
        const bool any_valid = __any(klim >= 0 && klo < 60 && klim > klo);
        if (any_valid) {
            const bool need_mask = __any(klo >= 0 || klim < 60);
            f32x16 p0, p1;
            qk_tile(p0, p1, (lptr)(F.lds + KS0 + slot * SLOT), qr, r32, hi);
            soft_tile(st, p0, p1, s2, (float)(t * 64 - qpos), klo, klim, need_mask, (lptr)(F.lds + VS0 + slot * SLOT), lane);
        }
        slot ^= 1;
    }
    __syncthreads();
}
}

DEV void headnorm_group(bf16* row, int off, int nheads, const float* g, int lane) {
    const int hg = lane >> 3, ch = lane & 7;
    if (hg < nheads) {
        GAS v4u* p = (GAS v4u*)(row + off + hg * 64 + ch * 8);
        const v4u x = *p;
        float v[8] = {u2f(x.x << 16), u2f(x.x & 0xffff0000u), u2f(x.y << 16), u2f(x.y & 0xffff0000u), u2f(x.z << 16), u2f(x.z & 0xffff0000u), u2f(x.w << 16), u2f(x.w & 0xffff0000u)};
        float ss = 0.f;
#pragma unroll
        for (int j = 0; j < 8; ++j) ss += v[j] * v[j];
        ss += __shfl_xor(ss, 1); ss += __shfl_xor(ss, 2); ss += __shfl_xor(ss, 4);
        const float r = 1.0f / sqrtf(ss * (1.0f / 64) + EPS);
        const f32x4 g0 = *(const GAS f32x4*)(g + ch * 8), g1 = *(const GAS f32x4*)(g + ch * 8 + 4);
        v4u o; o.x = pk2(v[0] * r * g0.x, v[1] * r * g0.y); o.y = pk2(v[2] * r * g0.z, v[3] * r * g0.w); o.z = pk2(v[4] * r * g1.x, v[5] * r * g1.y); o.w = pk2(v[6] * r * g1.z, v[7] * r * g1.w);
        *p = o;
    }
}
DEV void fp_headnorm(const Params& P, Frame& F, int layer) {
    const int gw = F.vcu * NWAVES + F.wave, NGW = F.G * NWAVES, lane = F.lane;
    for (int t = gw; t < T; t += NGW) {
        bf16* row = P.proj + (size_t)t * LDP;
        if (layer == 0) {
            headnorm_group(row, 0, 8, P.ev_q_norm, lane);
            headnorm_group(row, 512, 2, P.ev_k_norm, lane);
        } else {
            headnorm_group(row, 0, 8, P.od_c_q_norm, lane);
            headnorm_group(row, 512, 8, P.od_c_k_norm, lane);
            headnorm_group(row, 1536, 8, P.od_d_q_norm, lane);
            headnorm_group(row, 2304, 2, P.od_d_k_norm + 64, lane);
            headnorm_group(row, 2560, 2, P.od_d_k_norm + 128, lane);
        }
    }
}

DEV void fp_prep1(const Params& P, Frame& F) {
    const int gw = F.vcu * NWAVES + F.wave, NGW = F.G * NWAVES, lane = F.lane;
    for (int i = gw; i < NB * 64; i += NGW) {
        const int n = i & 7, h = (i >> 3) & 7, b = i >> 6;
        const bf16* kp = P.proj + ((size_t)b * S + n * 256) * LDP + 512 + h * 64 + lane;
        float s0 = 0.f, s1 = 0.f, s2 = 0.f, s3 = 0.f;
#pragma unroll 4
        for (int j = 0; j < 256; j += 4) { s0 += bf2f(kp[(size_t)j * LDP]); s1 += bf2f(kp[(size_t)(j + 1) * LDP]); s2 += bf2f(kp[(size_t)(j + 2) * LDP]); s3 += bf2f(kp[(size_t)(j + 3) * LDP]); }
        P.kmean[(size_t)i * 64 + lane] = ((s0 + s1) + (s2 + s3)) * (1.0f / 256);
    }
    const int n2 = 2 * NB * NCMP * 2;
    for (int i = gw; i < n2; i += NGW) {
        const int hkv = i & 1; int r = i >> 1; const int n = r % NCMP; r /= NCMP; const int b = r % NB; const int which = r / NB;
        const float* pos = P.od_cmp_pos + which * 32 * 64;
        const float* wq = P.od_cmp_w + (size_t)which * 32 * 64 * 64 + lane;
        const bf16* xp = P.proj + ((size_t)b * S + n * 16) * LDP + (which ? 2176 : 2048) + hkv * 64 + lane;
        float a0 = 0.f, a1 = 0.f, a2 = 0.f, a3 = 0.f;
        for (int l = 0; l < 32; ++l) {
            const unsigned xv = f2u(bf2f(xp[(size_t)l * LDP]) + pos[l * 64 + lane]);
            const float* wl = wq + (size_t)l * 64 * 64;
#pragma unroll
            for (int d = 0; d < 64; d += 4) {
                a0 += u2f((unsigned)__builtin_amdgcn_readlane((int)xv, d)) * wl[(d + 0) * 64];
                a1 += u2f((unsigned)__builtin_amdgcn_readlane((int)xv, d + 1)) * wl[(d + 1) * 64];
                a2 += u2f((unsigned)__builtin_amdgcn_readlane((int)xv, d + 2)) * wl[(d + 2) * 64];
                a3 += u2f((unsigned)__builtin_amdgcn_readlane((int)xv, d + 3)) * wl[(d + 3) * 64];
            }
        }
        float acc = (a0 + a1) + (a2 + a3);
        if (which == 0) {
            const float rs = 1.0f / sqrtf(wave_sum(acc * acc) * (1.0f / 64) + EPS);
            acc *= rs * P.od_d_k_norm[lane];
        }
        P.kvcmp[(((size_t)(which * NB + b) * NCMP + n) * 2 + hkv) * 64 + lane] = f2bf(acc);
    }
}

DEV void sb_tile(att::f32x16& p0, att::f32x16& p1, float& carry, int lim, int hi) {
    using namespace att;
    const float c1 = 0.125f * LOG2E;
    f32x16 k0, k1;
    float cs[2][4];
#pragma unroll
    for (int hf = 0; hf < 2; ++hf)
#pragma unroll
        for (int g = 0; g < 4; ++g) {
            float s = 0.f;
#pragma unroll
            for (int i = 0; i < 4; ++i) {
                const int r = 4 * g + i, kr = i + 8 * g + 32 * hf;
                const float z2 = (hf ? p1[r] : p0[r]) * c1;
                const float e = __builtin_amdgcn_exp2f(-fabsf(z2));
                const float ls2 = fminf(z2, 0.f) - __builtin_amdgcn_logf(1.0f + e);
                const bool ok = kr < lim;
                const float lk2 = ok ? (ls2 - z2) : 0.f;
                if (hf) { p1[r] = ok ? ls2 : MNEG; k1[r] = lk2; } else { p0[r] = ok ? ls2 : MNEG; k0[r] = lk2; }
                s += lk2;
            }
            cs[hf][g] = s;
        }
    float run = carry;
#pragma unroll
    for (int hf = 1; hf >= 0; --hf)
#pragma unroll
        for (int g = 3; g >= 0; --g) {
            const float mine = cs[hf][g], other = lane_partner(mine, hi);
            float suf = hi ? run : run + other;
            run += mine + other;
#pragma unroll
            for (int i = 3; i >= 0; --i) {
                const int r = 4 * g + i;
                if (hf) { p1[r] = __builtin_amdgcn_exp2f(p1[r] + suf); suf += k1[r]; } else { p0[r] = __builtin_amdgcn_exp2f(p0[r] + suf); suf += k0[r]; }
            }
        }
    carry = run;
}

DEV void fp_attn0(const Params& P, Frame& F) {
    using namespace att;
    const int tid = F.tid, lane = F.lane, r32 = lane & 31, hi = lane >> 5, w = F.wave;
    for (int u = F.vcu; u < 512; u += F.G) {
        {
            const int b = u >> 6, h = (u >> 3) & 7, blk = u & 7;
            const bf16* base = P.proj + (size_t)b * S * LDP;
            const int q = blk * 256 + w * 32 + r32;
            bf16x8 qr[4]; load_q(qr, base + (size_t)q * LDP + 768 + h * 64, hi);
            const bf16* Kg = base + 1280 + h * 64; const bf16* Vg = base + 1792 + h * 64;
            f32x16 o[2]; o[0] = f32x16{}; o[1] = f32x16{};
            float carry = 0.f;
            const int tmax = blk * 4 + 3;
            const int tw = (blk * 256 + w * 32 + 31) >> 6;
            volatile LAS int* flag = (volatile LAS int*)(F.lds + 32768);
            if (tid < 3) flag[tid] = 0;
            TileRegs R; tile_load(R, Kg, Vg, LDP, tmax * 64, tid);
            int slot = 0; bool wave_done = false;
            for (int t = tmax; t >= 0; --t) {
                tile_store(F.lds, slot, R, tid);
                if (t > 0) tile_load(R, Kg, Vg, LDP, (t - 1) * 64, tid);
                __syncthreads();
                if (t < tmax && flag[(t + 1) % 3] == 0) break;
                if (tid == 0) flag[(t + 2) % 3] = 0;
                if (!wave_done && t <= tw) {
                    f32x16 p0, p1;
                    qk_tile(p0, p1, (lptr)(F.lds + KS0 + slot * SLOT), qr, r32, hi);
                    sb_tile(p0, p1, carry, q - t * 64 - 4 * hi, hi);
                    pv_tile(o, (lptr)(F.lds + VS0 + slot * SLOT), p0, p1, lane);
                    if (__all(carry < -150.f)) wave_done = true;
                }
                if (!wave_done && lane == 0) flag[t % 3] = 1;
                slot ^= 1;
            }
            __syncthreads();
            store_ot(o, 1.0f, P.o + (size_t)(b * S + q) * D + 512 + h * 64, hi);
        }
    }
    asm volatile("" ::: "memory");
    for (int u = 512 + F.vcu; u < 1024; u += F.G) {
        {
            const int v = u - 512, b = v >> 6, hkv = (v >> 5) & 1, c = v & 31;
            const bf16* base = P.proj + (size_t)b * S * LDP;
            const int hh = hkv * 4 + (w >> 1), q = c * 64 + (w & 1) * 32 + r32;
            bf16x8 qr[4]; load_q(qr, base + (size_t)q * LDP + hh * 64, hi);
            const float sl = exp2f(-(float)(hh + 1)), s2 = sl * LOG2E;
            SoftState st; soft_reset(st);
            const int t0 = c - 2 < 0 ? 0 : c - 2;
            run_segment(F, st, qr, base + 512 + hkv * 64, base + 640 + hkv * 64, LDP, t0, c, s2, q,
                        [&](int t, int& klo, int& klim) { klim = q - t * 64 - 4 * hi; klo = klim - 128; });
            const float l = lane_swap_sum(st.l);
            const float sk2 = P.ev_sink[hh] * LOG2E;
            const float mx = fmaxf(st.m, sk2);
            const float scale = __builtin_amdgcn_exp2f(st.m - mx);
            const float den = l * scale + __builtin_amdgcn_exp2f(sk2 - mx);
            store_ot(st.o, scale / den, P.o + (size_t)(b * S + q) * D + hh * 64, hi);
        }
    }
}

DEV void fp_attn1(const Params& P, Frame& F) {
    using namespace att;
    const int lane = F.lane, r32 = lane & 31, hi = lane >> 5, w = F.wave;
    for (int u = F.vcu; u < 512; u += F.G) {
        {
            const int v = u & 255, bh = v >> 2, blk = (u < 256) ? (v & 3) : 7 - (v & 3);
            const int b = bh >> 3, h = bh & 7;
            const bf16* base = P.proj + (size_t)b * S * LDP;
            const int q = blk * 256 + w * 32 + r32;
            bf16x8 qr[4]; load_q(qr, base + (size_t)q * LDP + h * 64, hi);
            const float sl = exp2f(-(float)(h + 1)), s2 = sl * LOG2E;
            float gt[8];
#pragma unroll
            for (int n = 0; n < 8; ++n) {
                float g = 0.f;
                if (n < blk) {
                    const float* km = P.kmean + ((size_t)(b * 8 + h) * 8 + n) * 64;
#pragma unroll
                    for (int d0 = 0; d0 < 4; ++d0)
#pragma unroll
                        for (int j = 0; j < 8; ++j) g += bf2f((bf16)qr[d0][j]) * km[16 * d0 + 8 * hi + j];
                }
                g = lane_swap_sum(g);
                gt[n] = n < blk ? g : NEG;
            }
            unsigned sel = 0;
#pragma unroll
            for (int n = 0; n < 8; ++n) {
                int rank = 0;
#pragma unroll
                for (int k = 0; k < 8; ++k) rank += (gt[k] > gt[n] || (gt[k] == gt[n] && k < n)) ? 1 : 0;
                if (rank < 3 && n < blk) sel |= 1u << n;
            }
            SoftState st; soft_reset(st);
            run_segment(F, st, qr, base + 512 + h * 64, base + 1024 + h * 64, LDP, 0, blk * 4 + 3, s2, q,
                        [&](int t, int& klo, int& klim) { const int n = t >> 2; klo = -1;
                            if (n < blk) klim = ((sel >> n) & 1) ? 63 : -1; else klim = q - t * 64 - 4 * hi; });
            const float l = lane_swap_sum(st.l);
            store_ot(st.o, 1.0f / l, P.o + (size_t)(b * S + q) * D + h * 64, hi);
        }
    }
    asm volatile("" ::: "memory");
    for (int u = 512 + F.vcu; u < 1024; u += F.G) {
        {
            const int v = u & 255, bk = v >> 4, c = (u < 768) ? (v & 15) : 31 - (v & 15);
            const int b = bk >> 1, hkv = bk & 1;
            const bf16* base = P.proj + (size_t)b * S * LDP;
            const int h = hkv * 4 + (w >> 1), q = c * 64 + (w & 1) * 32 + r32, t = b * S + q;
            bf16x8 qr[4]; load_q(qr, base + (size_t)q * LDP + 1536 + h * 64, hi);
            const float sl = exp2f(-(float)(h + 1)), s2 = sl * LOG2E;
            const bf16* grow = base + (size_t)q * LDP + 2816 + h * 3;
            const float g0 = 1.0f / (1.0f + __expf(-bf2f(grow[0]))), g1 = 1.0f / (1.0f + __expf(-bf2f(grow[1]))), g2 = 1.0f / (1.0f + __expf(-bf2f(grow[2])));
            LAS float* part = (LAS float*)(F.lds + 36864);
            volatile LAS unsigned long long* tot = (volatile LAS unsigned long long*)(F.lds + 36864 + 33792);
            volatile LAS unsigned* selm = (volatile LAS unsigned*)(F.lds + 36864 + 33792 + 16896);
            f32x16 fin[2];
            {
                const int ntile = c >= 16 ? 2 : 1;
                const bf16* Kc = P.kvcmp + ((size_t)(0 * NB + b) * NCMP) * 128 + hkv * 64;
                const bf16* Vc = P.kvcmp + ((size_t)(1 * NB + b) * NCMP) * 128 + hkv * 64;
                TileRegs R0, R1; tile_load(R0, Kc, Vc, 128, 0, F.tid); if (ntile == 2) tile_load(R1, Kc, Vc, 128, 64, F.tid);
                tile_store(F.lds, 0, R0, F.tid); if (ntile == 2) tile_store(F.lds, 1, R1, F.tid);
                __syncthreads();
                const int nlim = (q - 31) >> 4;
                const float c1 = 0.125f * LOG2E, s16 = 16.0f * s2;
                const float basec = s2 * (float)(31 - q) + s16 * (float)(4 * hi);
                float mx = MNEG, lsum = 0.f;
                for (int tl = 0; tl < ntile; ++tl) {
                    f32x16 x0, x1; qk_tile(x0, x1, (lptr)(F.lds + KS0 + tl * SLOT), qr, r32, hi);
                    const int klim = nlim - 64 * tl - 4 * hi; const float bt = basec + s16 * (float)(64 * tl);
                    float tm = MNEG;
#pragma unroll
                    for (int r = 0; r < 16; ++r) {
                        const int kr = (r & 3) + 8 * (r >> 2);
                        x0[r] = kr <= klim ? fmaf(x0[r], c1, fmaf(s16, (float)kr, bt)) : MNEG;
                        x1[r] = kr + 32 <= klim ? fmaf(x1[r], c1, fmaf(s16, (float)(kr + 32), bt)) : MNEG;
                        tm = fmaxf(tm, fmaxf(x0[r], x1[r]));
                    }
                    tm = fmaxf(mx, lane_swap_max(tm));
                    lsum *= __builtin_amdgcn_exp2f(mx - tm); mx = tm;
#pragma unroll
                    for (int r = 0; r < 16; ++r) lsum += __builtin_amdgcn_exp2f(x0[r] - mx) + __builtin_amdgcn_exp2f(x1[r] - mx);
                }
                lsum = lane_swap_sum(lsum);
                const float inv = nlim >= 0 ? 1.0f / lsum : 0.f;
                fin[0] = f32x16{}; fin[1] = f32x16{};
                LAS float* prow = part + ((w >> 1) * 64 + (w & 1) * 32 + r32) * 33;
                float peprev = 0.f;
                for (int tl = 0; tl < ntile; ++tl) {
                    f32x16 x0, x1; qk_tile(x0, x1, (lptr)(F.lds + KS0 + tl * SLOT), qr, r32, hi);
                    const int klim = nlim - 64 * tl - 4 * hi; const float bt = basec + s16 * (float)(64 * tl);
#pragma unroll
                    for (int r = 0; r < 16; ++r) {
                        const int kr = (r & 3) + 8 * (r >> 2);
                        x0[r] = kr <= klim ? __builtin_amdgcn_exp2f(fmaf(x0[r], c1, fmaf(s16, (float)kr, bt)) - mx) * inv : 0.f;
                        x1[r] = kr + 32 <= klim ? __builtin_amdgcn_exp2f(fmaf(x1[r], c1, fmaf(s16, (float)(kr + 32), bt)) - mx) * inv : 0.f;
                    }
#pragma unroll
                    for (int ix = 0; ix < 8; ++ix) {
                        const int g = ix & 3;
                        const float C = (ix < 4) ? (x0[4 * g] + x0[4 * g + 1]) + (x0[4 * g + 2] + x0[4 * g + 3]) : (x1[4 * g] + x1[4 * g + 1]) + (x1[4 * g + 2] + x1[4 * g + 3]);
                        const float pe = lane_partner((ix < 4) ? x0[4 * g + 3] : x1[4 * g + 3], hi);
                        prow[2 * (8 * tl + ix) + hi] = C + (hi ? pe : peprev);
                        peprev = pe;
                    }
                    pv_tile(fin, (lptr)(F.lds + VS0 + tl * SLOT), x0, x1, lane);
                }
#pragma unroll
                for (int r = 0; r < 16; ++r) { fin[0][r] *= g0; fin[1][r] *= g0; }
            }
            __syncthreads();
            {
                const int ql = F.tid >> 3, jg = F.tid & 7;
#pragma unroll
                for (int jj = 0; jj < 4; ++jj) {
                    const int j = 4 * jg + jj;
                    float sc = ((part[(0 * 64 + ql) * 33 + j] + part[(1 * 64 + ql) * 33 + j]) + part[(2 * 64 + ql) * 33 + j]) + part[(3 * 64 + ql) * 33 + j];
                    const bool forced = (j == 0) || (j == c) || (j == c - 1);
                    sc = (j <= c) ? sc + (forced ? 1000.0f : 0.0f) : NEG;
                    const unsigned ub = f2u(sc), ord = ub ^ ((ub >> 31) ? 0xffffffffu : 0x80000000u);
                    tot[ql * 33 + j] = ((unsigned long long)ord << 32) | (unsigned)(31 - j);
                }
                __syncthreads();
                unsigned long long mine[4];
#pragma unroll
                for (int jj = 0; jj < 4; ++jj) mine[jj] = tot[ql * 33 + 4 * jg + jj];
                int rank[4] = {0, 0, 0, 0};
                for (int k = 0; k < 32; ++k) {
                    const unsigned long long sk = tot[ql * 33 + k];
#pragma unroll
                    for (int jj = 0; jj < 4; ++jj) rank[jj] += (sk > mine[jj]) ? 1 : 0;
                }
                unsigned bits = 0;
#pragma unroll
                for (int jj = 0; jj < 4; ++jj) if (rank[jj] < 16 && 4 * jg + jj <= c) bits |= 1u << (4 * jg + jj);
                bits |= __shfl_xor(bits, 1); bits |= __shfl_xor(bits, 2); bits |= __shfl_xor(bits, 4);
                if (jg == 0) selm[ql] = bits;
            }
            __syncthreads();
            const unsigned mask = selm[(w & 1) * 32 + r32];
            __syncthreads();
            LAS float* stg = (LAS float*)(F.lds + 36864) + w * 2048 + lane;
#pragma unroll
            for (int r = 0; r < 16; ++r) { stg[r * 64] = fin[0][r]; stg[(16 + r) * 64] = fin[1][r]; }
            SoftState st; soft_reset(st);
            run_segment(F, st, qr, base + 2304 + hkv * 64, base + 2432 + hkv * 64, LDP, 0, c, s2, q,
                        [&](int tt, int& klo, int& klim) { klo = -1; klim = ((mask >> tt) & 1) ? (q - tt * 64 - 4 * hi) : -1; });
            { const float f = g1 / lane_swap_sum(st.l);
#pragma unroll
              for (int r = 0; r < 16; ++r) { stg[r * 64] += f * st.o[0][r]; stg[(16 + r) * 64] += f * st.o[1][r]; } }
            soft_reset(st);
            run_segment(F, st, qr, base + 2560 + hkv * 64, base + 2688 + hkv * 64, LDP, c - 8 < 0 ? 0 : c - 8, c, s2, q,
                        [&](int tt, int& klo, int& klim) { klim = q - tt * 64 - 4 * hi; klo = klim - 512; });
            { const float f = g2 / lane_swap_sum(st.l);
#pragma unroll
              for (int r = 0; r < 16; ++r) { st.o[0][r] = stg[r * 64] + f * st.o[0][r]; st.o[1][r] = stg[(16 + r) * 64] + f * st.o[1][r]; } }
            store_ot(st.o, 1.0f, P.o + (size_t)t * D + 512 + h * 64, hi);
            __syncthreads();
        }
    }
}
constexpr int NPHASE = 20;
DEV void run_phase(const Params& P, int ph, int gtid, int gsz) {
    switch (ph) {
        case 0: ph_rstd(P.x, P.rstd, gtid, gsz); break;
        case 1: ph_gemm_in(P.x, P.rstd, P.ev_norm, P.ev_w_in, EVEN_IN, P.proj, gtid, gsz); break;
        case 2: ph_headnorm0(P, gtid, gsz); break;
        case 3: ph_attn0(P, gtid, gsz); break;
        case 4: ph_gemm_out(P.o, P.ev_w_out, P.x, P.out, gtid, gsz); break;
        case 5: ph_moe_route(P, 0, gtid, gsz); break;
        case 6: ph_moe_hidden(P, 0, gtid, gsz); break;
        case 7: ph_moe_out(P, 0, gtid, gsz); break;
        case 8: ph_rstd(P.out, P.rstd, gtid, gsz); break;
        case 9: ph_gemm_in(P.out, P.rstd, P.od_norm, P.od_w_in, ODD_IN, P.proj, gtid, gsz); break;
        case 10: ph_headnorm1(P, gtid, gsz); break;
        case 11: ph_prep1(P, gtid, gsz); break;
        case 12: ph_nsa_cmp(P, gtid, gsz); break;
        case 13: ph_nsa_select(P, gtid, gsz); break;
        case 14: ph_nsa_topk(P, gtid, gsz); break;
        case 15: ph_attn1(P, gtid, gsz); break;
        case 16: ph_gemm_out(P.o, P.od_w_out, P.out, P.out, gtid, gsz); break;
        case 17: ph_moe_route(P, 1, gtid, gsz); break;
        case 18: ph_moe_hidden(P, 1, gtid, gsz); break;
        case 19: ph_moe_out(P, 1, gtid, gsz); break;
    }
}
__global__ void __launch_bounds__(256) k_naive(Params P, int ph) {
    run_phase(P, ph, blockIdx.x * blockDim.x + threadIdx.x, gridDim.x * blockDim.x);
}

enum { FP_CONV_DENSE = 0, FP_CONV_MOE0, FP_XN0, FP_INPROJ0, FP_HEADNORM0, FP_ATTN0, FP_OUTPROJ0, FP_ROUTE0, FP_GATHER0, FP_GU0, FP_DN0, FP_COMBINE0, FP_CONV_MOE1, FP_XN1, FP_INPROJ1, FP_HEADNORM1, FP_PREP1, FP_NSACMP, FP_NSASEL, FP_NSATOPK, FP_ATTN1, FP_OUTPROJ1, FP_ROUTE1, FP_GATHER1, FP_GU1, FP_DN1, FP_COMBINE1, FP_COUNT };
struct FArgs { Params p; unsigned long long mask; int li, pad; };

__global__ void __launch_bounds__(NWAVES * 64, 2) k_fast(FArgs args) {
    extern __shared__ __attribute__((aligned(16))) unsigned char lds[];
    const Params& P = args.p;
    Frame F;
    F.lds = (LAS unsigned char*)lds;
    F.MISC = (volatile LAS unsigned*)(F.lds + MISC_OFF);
    F.tid = threadIdx.x; F.lane = F.tid & 63; F.wave = __builtin_amdgcn_readfirstlane(F.tid >> 6);
    F.G = gridDim.x; { const int bx = blockIdx.x; F.vcu = (F.G % 8 == 0) ? (bx % 8) * (F.G / 8) + bx / 8 : bx; }
    for (int u = F.tid; u < (LDS_BYTES - LDSCTL_OFF) / 4; u += NWAVES * 64) ((LAS unsigned*)(F.lds + LDSCTL_OFF))[u] = 0u;
    __syncthreads();
    XcdBarrier bar = xcd_barrier_post(P.ctl + CW_BAR + args.li * XCD_BAR_WORDS, F.MISC + 8);
    const unsigned long long mask = args.mask;
#ifndef DUPMASK
#define DUPMASK 0ull
#endif
#define ON(k) (refresh(F), ((mask >> (k)) & 1ull))
#define DUP(k) (((DUPMASK) >> (k)) & 1ull)
#define SEAM(k) do { if ((mask >> ((k) + 1)) != 0ull) { refresh(F); xcd_barrier(bar, F.tid); } } while (0)
    if (ON(FP_CONV_DENSE)) { fp_convert_weights(P, F, 0); fp_prep_router(P, F); if (DUP(FP_CONV_DENSE)) { refresh(F); xcd_barrier(bar, F.tid); refresh(F); fp_convert_weights(P, F, 0); fp_prep_router(P, F); } SEAM(FP_CONV_DENSE); }
    if (ON(FP_CONV_MOE0)) { fp_convert_weights(P, F, 1); if (DUP(FP_CONV_MOE0)) { refresh(F); xcd_barrier(bar, F.tid); refresh(F); fp_convert_weights(P, F, 1); } SEAM(FP_CONV_MOE0); }
    if (ON(FP_XN0)) { fp_norm_rows(F, P.x, P.ev_norm, P.xn); if (DUP(FP_XN0)) { refresh(F); xcd_barrier(bar, F.tid); refresh(F); fp_norm_rows(F, P.x, P.ev_norm, P.xn); } SEAM(FP_XN0); }
    if (ON(FP_INPROJ0)) { pg8::StaticOrder So; So.init(P.xn, P.win0t, T, EVEN_IN, D, F.G, (int)blockIdx.x);
        pg8::EpiStoreBf16 E{P.proj, LDP}; pg8::gemm_phase(F.lds, D, So, E, F.tid); if (DUP(FP_INPROJ0)) { refresh(F); xcd_barrier(bar, F.tid); refresh(F); pg8::StaticOrder So; So.init(P.xn, P.win0t, T, EVEN_IN, D, F.G, (int)blockIdx.x);
        pg8::EpiStoreBf16 E{P.proj, LDP}; pg8::gemm_phase(F.lds, D, So, E, F.tid); } SEAM(FP_INPROJ0); }
    if (ON(FP_HEADNORM0)) { fp_headnorm(P, F, 0); if (DUP(FP_HEADNORM0)) { refresh(F); xcd_barrier(bar, F.tid); refresh(F); fp_headnorm(P, F, 0); } SEAM(FP_HEADNORM0); }
    if (ON(FP_ATTN0)) { fp_attn0(P, F); if (DUP(FP_ATTN0)) { refresh(F); xcd_barrier(bar, F.tid); refresh(F); fp_attn0(P, F); } SEAM(FP_ATTN0); }
    if (ON(FP_OUTPROJ0)) { pg8::StaticOrder So; So.init(P.o, P.wout0t, T, D, D, F.G, (int)blockIdx.x);
        pg8::EpiResidF32 E{P.x, P.out, D}; pg8::gemm_phase(F.lds, D, So, E, F.tid); if (DUP(FP_OUTPROJ0)) { refresh(F); xcd_barrier(bar, F.tid); refresh(F); pg8::StaticOrder So; So.init(P.o, P.wout0t, T, D, D, F.G, (int)blockIdx.x);
        pg8::EpiResidF32 E{P.x, P.out, D}; pg8::gemm_phase(F.lds, D, So, E, F.tid); } SEAM(FP_OUTPROJ0); }
    if (ON(FP_ROUTE0)) { fp_route(P, F, 0); if (DUP(FP_ROUTE0)) { refresh(F); xcd_barrier(bar, F.tid); refresh(F); fp_route(P, F, 0); } SEAM(FP_ROUTE0); }
    if (ON(FP_GATHER0)) { fp_gather(P, F, 0); if (DUP(FP_GATHER0)) { refresh(F); xcd_barrier(bar, F.tid); refresh(F); fp_gather(P, F, 0); } SEAM(FP_GATHER0); }
    if (ON(FP_GU0)) { fp_moe_gu(P, F, 0); if (DUP(FP_GU0)) { refresh(F); xcd_barrier(bar, F.tid); refresh(F); fp_moe_gu(P, F, 0); } SEAM(FP_GU0); }
    if (ON(FP_DN0)) { fp_moe_dn(P, F, 0); if (DUP(FP_DN0)) { refresh(F); xcd_barrier(bar, F.tid); refresh(F); fp_moe_dn(P, F, 0); } SEAM(FP_DN0); }
    if (ON(FP_COMBINE0)) { fp_combine(P, F, P.od_norm, P.xn); if (DUP(FP_COMBINE0)) { refresh(F); xcd_barrier(bar, F.tid); refresh(F); fp_combine(P, F, P.od_norm, P.xn); } SEAM(FP_COMBINE0); }
    if (ON(FP_CONV_MOE1)) { fp_convert_weights(P, F, 2); if (DUP(FP_CONV_MOE1)) { refresh(F); xcd_barrier(bar, F.tid); refresh(F); fp_convert_weights(P, F, 2); } SEAM(FP_CONV_MOE1); }
    if (ON(FP_XN1)) { fp_norm_rows(F, P.out, P.od_norm, P.xn); if (DUP(FP_XN1)) { refresh(F); xcd_barrier(bar, F.tid); refresh(F); fp_norm_rows(F, P.out, P.od_norm, P.xn); } SEAM(FP_XN1); }
    if (ON(FP_INPROJ1)) { pg8::StaticOrder So; So.init(P.xn, P.win1t, T, LDP, D, F.G, (int)blockIdx.x);
        pg8::EpiStoreBf16 E{P.proj, LDP}; pg8::gemm_phase(F.lds, D, So, E, F.tid); if (DUP(FP_INPROJ1)) { refresh(F); xcd_barrier(bar, F.tid); refresh(F); pg8::StaticOrder So; So.init(P.xn, P.win1t, T, LDP, D, F.G, (int)blockIdx.x);
        pg8::EpiStoreBf16 E{P.proj, LDP}; pg8::gemm_phase(F.lds, D, So, E, F.tid); } SEAM(FP_INPROJ1); }
    if (ON(FP_HEADNORM1)) { fp_headnorm(P, F, 1); if (DUP(FP_HEADNORM1)) { refresh(F); xcd_barrier(bar, F.tid); refresh(F); fp_headnorm(P, F, 1); } SEAM(FP_HEADNORM1); }
    if (ON(FP_PREP1)) { fp_prep1(P, F); if (DUP(FP_PREP1)) { refresh(F); xcd_barrier(bar, F.tid); refresh(F); fp_prep1(P, F); } SEAM(FP_PREP1); }
    if (ON(FP_NSACMP)) { ph_nsa_cmp(P, F.vcu * NWAVES * 64 + F.tid, F.G * NWAVES * 64); if (DUP(FP_NSACMP)) { refresh(F); xcd_barrier(bar, F.tid); refresh(F); ph_nsa_cmp(P, F.vcu * NWAVES * 64 + F.tid, F.G * NWAVES * 64); } SEAM(FP_NSACMP); }
    if (ON(FP_NSASEL)) { ph_nsa_select(P, F.vcu * NWAVES * 64 + F.tid, F.G * NWAVES * 64); if (DUP(FP_NSASEL)) { refresh(F); xcd_barrier(bar, F.tid); refresh(F); ph_nsa_select(P, F.vcu * NWAVES * 64 + F.tid, F.G * NWAVES * 64); } SEAM(FP_NSASEL); }
    if (ON(FP_NSATOPK)) { ph_nsa_topk(P, F.vcu * NWAVES * 64 + F.tid, F.G * NWAVES * 64); if (DUP(FP_NSATOPK)) { refresh(F); xcd_barrier(bar, F.tid); refresh(F); ph_nsa_topk(P, F.vcu * NWAVES * 64 + F.tid, F.G * NWAVES * 64); } SEAM(FP_NSATOPK); }
    if (ON(FP_ATTN1)) { fp_attn1(P, F); if (DUP(FP_ATTN1)) { refresh(F); xcd_barrier(bar, F.tid); refresh(F); fp_attn1(P, F); } SEAM(FP_ATTN1); }
    if (ON(FP_OUTPROJ1)) { pg8::StaticOrder So; So.init(P.o, P.wout1t, T, D, D, F.G, (int)blockIdx.x);
        pg8::EpiResidF32 E{P.out, P.out, D}; pg8::gemm_phase(F.lds, D, So, E, F.tid); if (DUP(FP_OUTPROJ1)) { refresh(F); xcd_barrier(bar, F.tid); refresh(F); pg8::StaticOrder So; So.init(P.o, P.wout1t, T, D, D, F.G, (int)blockIdx.x);
        pg8::EpiResidF32 E{P.out, P.out, D}; pg8::gemm_phase(F.lds, D, So, E, F.tid); } SEAM(FP_OUTPROJ1); }
    if (ON(FP_ROUTE1)) { fp_route(P, F, 1); if (DUP(FP_ROUTE1)) { refresh(F); xcd_barrier(bar, F.tid); refresh(F); fp_route(P, F, 1); } SEAM(FP_ROUTE1); }
    if (ON(FP_GATHER1)) { fp_gather(P, F, 1); if (DUP(FP_GATHER1)) { refresh(F); xcd_barrier(bar, F.tid); refresh(F); fp_gather(P, F, 1); } SEAM(FP_GATHER1); }
    if (ON(FP_GU1)) { fp_moe_gu(P, F, 1); if (DUP(FP_GU1)) { refresh(F); xcd_barrier(bar, F.tid); refresh(F); fp_moe_gu(P, F, 1); } SEAM(FP_GU1); }
    if (ON(FP_DN1)) { fp_moe_dn(P, F, 1); if (DUP(FP_DN1)) { refresh(F); xcd_barrier(bar, F.tid); refresh(F); fp_moe_dn(P, F, 1); } SEAM(FP_DN1); }
    if (ON(FP_COMBINE1)) { fp_combine(P, F, nullptr, nullptr); if (DUP(FP_COMBINE1)) { refresh(F); xcd_barrier(bar, F.tid); refresh(F); fp_combine(P, F, nullptr, nullptr); } SEAM(FP_COMBINE1); }
#undef ON
#undef SEAM
}

static inline size_t al256(size_t x) { return (x + 255) & ~(size_t)255; }
static size_t carve(Params& p, void* d_ws) {
    char* w = (char*)d_ws;
    p.ctl = (unsigned*)w;
    p.win0t = (bf16*)(w + 1 * MiB);
    p.wout0t = (bf16*)(w + 6 * MiB);
    p.win1t = (bf16*)(w + 8 * MiB);
    p.wout1t = (bf16*)(w + 14 * MiB);
    p.wgut = (bf16*)(w + 16 * MiB);
    p.wdt = (bf16*)(w + 48 * MiB);
    p.proj = (bf16*)(w + 64 * MiB);
    p.ha = (bf16*)(w + 64 * MiB);
    p.xn = (bf16*)(w + 160 * MiB);
    p.hmid = (float*)(w + 160 * MiB);
    p.ocmp = (float*)(w + 160 * MiB);
    p.o = (bf16*)(w + 192 * MiB);
    p.hid = (bf16*)(w + 192 * MiB);
    size_t off = 224 * MiB;
    p.rstd = (float*)(w + off); off = al256(off + (size_t)T * 4);
    p.eid = (int*)(w + off); off = al256(off + (size_t)T * 2 * 4);
    p.ew = (float*)(w + off); off = al256(off + (size_t)T * 2 * 4);
    p.kmean = (float*)(w + off); off = al256(off + (size_t)NB * 8 * 8 * 64 * 4);
    p.kvcmp = (bf16*)(w + off); off = al256(off + (size_t)2 * NB * NCMP * 2 * 64 * 2);
    p.cml = (float*)(w + off); off = al256(off + (size_t)T * 8 * 2 * 4);
    p.pslc = (float*)(w + off); off = al256(off + (size_t)T * 64 * 4);
    p.selmask = (unsigned*)(w + off); off = al256(off + (size_t)T * 2 * 4);
    p.rowtok = (int*)(w + off); off = al256(off + (size_t)RMAX * 4);
    p.pos = (int*)(w + off); off = al256(off + (size_t)T * 2 * 4);
    p.wr = (bf16*)(w + off); off = al256(off + (size_t)2 * 2 * 48 * D * 2);
    return off;
}

struct Step { int fast; int n; int ph[32]; };
static const Step PLAN[] = {
    {1, 23, {FP_CONV_DENSE, FP_CONV_MOE0, FP_XN0, FP_INPROJ0, FP_HEADNORM0, FP_ATTN0, FP_OUTPROJ0, FP_ROUTE0, FP_GATHER0, FP_GU0, FP_DN0, FP_COMBINE0, FP_CONV_MOE1, FP_INPROJ1, FP_HEADNORM1,
             FP_PREP1, FP_ATTN1, FP_OUTPROJ1, FP_ROUTE1, FP_GATHER1, FP_GU1, FP_DN1, FP_COMBINE1}},
};

extern "C" void kernel_launch(void* const* d_in, const int* in_sizes, int n_in, void* d_out, int out_size, void* d_ws, size_t ws_size,
                              hipStream_t stream) {
    Params p{};
    const float** f = (const float**)&p;
    for (int i = 0; i < 24; ++i) f[i] = (const float*)d_in[i];
    p.out = (float*)d_out;
    const size_t need = carve(p, d_ws);
    static int grid = 0;
    if (grid == 0) {
        int dev = 0, cus = 0, per_cu = 0;
        if (hipGetDevice(&dev) != hipSuccess || hipDeviceGetAttribute(&cus, hipDeviceAttributeMultiprocessorCount, dev) != hipSuccess) { grid = -1; return; }
        if (hipFuncSetAttribute((const void*)k_fast, hipFuncAttributeMaxDynamicSharedMemorySize, LDS_BYTES) != hipSuccess) { fprintf(stderr, "hipFuncSetAttribute failed\n"); grid = -1; return; }
        if (hipOccupancyMaxActiveBlocksPerMultiprocessor(&per_cu, (const void*)k_fast, NWAVES * 64, LDS_BYTES) != hipSuccess || per_cu < 1) { fprintf(stderr, "occupancy query: %d\n", per_cu); (void)hipGetLastError(); grid = -1; return; }
        grid = cus;
        if (need > ws_size) { fprintf(stderr, "workspace too small: need %zu have %zu\n", need, ws_size); grid = -1; return; }
    }
    if (grid < 0) return;
    (void)hipMemsetAsync(d_ws, 0, CTL_ZERO_BYTES, stream);
    int li = 0;
    for (const Step& st : PLAN) {
        if (st.fast) {
            FArgs a{}; a.p = p; a.li = li++;
            for (int i = 0; i < st.n; ++i) a.mask |= 1ull << st.ph[i];
            hipLaunchKernelGGL(k_fast, dim3(grid), dim3(NWAVES * 64), LDS_BYTES, stream, a);
        } else {
            for (int i = 0; i < st.n; ++i) hipLaunchKernelGGL(k_naive, dim3(2048), dim3(256), 0, stream, p, st.ph[i]);
        }
    }
}
```

```cpp
#include <hip/hip_runtime.h>
#include <cstdio>
#include <cstdint>
#define DEV __device__ __forceinline__

#ifndef NB
#define NB 8
#endif
typedef unsigned short bf16;
constexpr int S = 2048, D = 1024, T = NB * S, HD = 64;
constexpr int EVEN_IN = 2304, ODD_IN = 2840, LDP = 3072;
constexpr int NCMP = 127, NSLC = 32;
constexpr float NEG = -1e30f;
constexpr float EPS = 1e-6f;
constexpr int RMAX = 2 * T + 32 * 256;

DEV float u2f(unsigned u) { return __builtin_bit_cast(float, u); }
DEV unsigned f2u(float f) { return __builtin_bit_cast(unsigned, f); }
DEV float bf2f(bf16 h) { return u2f(((unsigned)h) << 16); }
DEV bf16 f2bf(float f) { unsigned u = f2u(f); u += 0x7fffu + ((u >> 16) & 1u); return (bf16)(u >> 16); }

struct Params {
    const float *x, *ev_norm, *ev_w_in, *ev_q_norm, *ev_k_norm, *ev_sink, *ev_w_out;
    const float *od_norm, *od_w_in, *od_c_q_norm, *od_c_k_norm, *od_d_q_norm, *od_d_k_norm, *od_cmp_pos, *od_cmp_w, *od_w_out;
    const float *moe_norm, *moe_w_grp, *moe_b_grp, *moe_w_exp, *moe_b_exp, *moe_w_gate, *moe_w_up, *moe_w_down;
    float* out;
    unsigned* ctl;
    bf16 *win0t, *wout0t, *win1t, *wout1t, *wgut, *wdt;
    bf16* proj;
    bf16* xn;
    bf16* o;
    bf16* ha;
    bf16* hid;
    float* rstd;
    int* eid;
    float* ew;
    float* hmid;
    float* kmean;
    bf16* kvcmp;
    float* ocmp;
    float* cml;
    float* pslc;
    unsigned* selmask;
    int* rowtok;
    int* pos;
    bf16* wr;
};

DEV void load64(const bf16* p, float (&q)[64]) {
#pragma unroll
    for (int d = 0; d < 64; ++d) q[d] = bf2f(p[d]);
}
DEV float dot64(const float (&q)[64], const bf16* k) {
    float s = 0.f;
#pragma unroll
    for (int d = 0; d < 64; ++d) s += q[d] * bf2f(k[d]);
    return s;
}
DEV float dot64f(const float (&q)[64], const float* k) {
    float s = 0.f;
#pragma unroll
    for (int d = 0; d < 64; ++d) s += q[d] * k[d];
    return s;
}
DEV void os_update(float sc, const bf16* v, float& m, float& l, float (&o)[64]) {
    if (sc > m) {
        float f = expf(m - sc);
        l *= f;
#pragma unroll
        for (int d = 0; d < 64; ++d) o[d] *= f;
        m = sc;
    }
    float p = expf(sc - m);
    l += p;
#pragma unroll
    for (int d = 0; d < 64; ++d) o[d] += p * bf2f(v[d]);
}
DEV float slope_of(int hh) { return exp2f(-(float)(hh + 1)); }

DEV void ph_rstd(const float* src, float* rstd, int gtid, int gsz) {
    for (int t = gtid; t < T; t += gsz) {
        const float* r = src + (size_t)t * D;
        float s = 0.f;
        for (int i = 0; i < D; ++i) s += r[i] * r[i];
        rstd[t] = rsqrtf(s * (1.0f / D) + EPS);
    }
}

DEV void ph_gemm_in(const float* src, const float* rstd, const float* g, const float* W, int N, bf16* proj, int gtid, int gsz) {
    const long total = (long)T * N;
    for (long i = gtid; i < total; i += gsz) {
        const int t = (int)(i / N), n = (int)(i % N);
        const float* a = src + (size_t)t * D;
        float acc = 0.f;
        for (int k = 0; k < D; ++k) acc += a[k] * g[k] * W[(size_t)k * N + n];
        proj[(size_t)t * LDP + n] = f2bf(acc * rstd[t]);
    }
}

DEV void headnorm_inplace(bf16* p, const float* g) {
    float v[64];
    load64(p, v);
    float s = 0.f;
#pragma unroll
    for (int d = 0; d < 64; ++d) s += v[d] * v[d];
    const float r = rsqrtf(s * (1.0f / 64) + EPS);
#pragma unroll
    for (int d = 0; d < 64; ++d) p[d] = f2bf(v[d] * r * g[d]);
}

DEV void ph_headnorm0(const Params& P, int gtid, int gsz) {
    const long total = (long)T * 10;
    for (long i = gtid; i < total; i += gsz) {
        const int t = (int)(i / 10), h = (int)(i % 10);
        bf16* row = P.proj + (size_t)t * LDP;
        if (h < 8) headnorm_inplace(row + h * 64, P.ev_q_norm);
        else headnorm_inplace(row + 512 + (h - 8) * 64, P.ev_k_norm);
    }
}

DEV void ph_headnorm1(const Params& P, int gtid, int gsz) {
    const long total = (long)T * 28;
    for (long i = gtid; i < total; i += gsz) {
        const int t = (int)(i / 28), h = (int)(i % 28);
        bf16* row = P.proj + (size_t)t * LDP;
        if (h < 8) headnorm_inplace(row + h * 64, P.od_c_q_norm);
        else if (h < 16) headnorm_inplace(row + 512 + (h - 8) * 64, P.od_c_k_norm);
        else if (h < 24) headnorm_inplace(row + 1536 + (h - 16) * 64, P.od_d_q_norm);
        else if (h < 26) headnorm_inplace(row + 2304 + (h - 24) * 64, P.od_d_k_norm + 64);
        else headnorm_inplace(row + 2560 + (h - 26) * 64, P.od_d_k_norm + 128);
    }
}

DEV void ph_attn0(const Params& P, int gtid, int gsz) {
    const long total = (long)T * 16;
    for (long i = gtid; i < total; i += gsz) {
        const int hh = (int)(i / T), t = (int)(i % T);
        const int b = t / S, s = t % S;
        const bf16* base = P.proj + (size_t)b * S * LDP;
        float q[64], o[64];
#pragma unroll
        for (int d = 0; d < 64; ++d) o[d] = 0.f;
        if (hh < 8) {
            const int kvh = hh >> 2;
            load64(base + (size_t)s * LDP + hh * 64, q);
            const float sl = slope_of(hh);
            float m = NEG, l = 0.f;
            const int s0 = s - 127 < 0 ? 0 : s - 127;
            for (int sp = s0; sp <= s; ++sp) {
                const bf16* kr = base + (size_t)sp * LDP + 512 + kvh * 64;
                const float sc = dot64(q, kr) * 0.125f - sl * (float)(s - sp);
                os_update(sc, kr + 128, m, l, o);
            }
            const float sk = P.ev_sink[hh];
            const float mx = m > sk ? m : sk;
            const float scale = expf(m - mx);
            const float den = l * scale + expf(sk - mx);
            const float f = scale / den;
            bf16* op = P.o + (size_t)t * D + hh * 64;
#pragma unroll
            for (int d = 0; d < 64; ++d) op[d] = f2bf(o[d] * f);
        } else {
            const int h = hh - 8;
            load64(base + (size_t)s * LDP + 768 + h * 64, q);
            float acc = 0.f;
            for (int sp = s - 1; sp >= 0; --sp) {
                const bf16* kr = base + (size_t)sp * LDP + 1280 + h * 64;
                const float z = dot64(q, kr) * 0.125f;
                const float ls = (z < 0.f ? z : 0.f) - log1pf(expf(-fabsf(z)));
                const float a = expf(ls + acc);
                const bf16* vr = kr + 512;
#pragma unroll
                for (int d = 0; d < 64; ++d) o[d] += a * bf2f(vr[d]);
                acc += ls - z;
                if (acc < -110.f) break;
            }
            bf16* op = P.o + (size_t)t * D + 512 + h * 64;
#pragma unroll
            for (int d = 0; d < 64; ++d) op[d] = f2bf(o[d]);
        }
    }
}

DEV void ph_gemm_out(const bf16* o, const float* W, const float* resid, float* out, int gtid, int gsz) {
    const long total = (long)T * D;
    for (long i = gtid; i < total; i += gsz) {
        const int t = (int)(i / D), c = (int)(i % D);
        const bf16* a = o + (size_t)t * D;
        float acc = 0.f;
        for (int k = 0; k < D; ++k) acc += bf2f(a[k]) * W[(size_t)k * D + c];
        out[i] = resid[i] + acc;
    }
}

DEV void ph_moe_route(const Params& P, int layer, int gtid, int gsz) {
    const float* g = P.moe_norm + layer * D;
    const float* wgrp = P.moe_w_grp + (size_t)layer * D * 4;
    const float* wexp = P.moe_w_exp + (size_t)layer * D * 32;
    const float* bgrp = P.moe_b_grp + layer * 4;
    const float* bexp = P.moe_b_exp + layer * 32;
    for (int t = gtid; t < T; t += gsz) {
        const float* r = P.out + (size_t)t * D;
        float ss = 0.f;
        for (int k = 0; k < D; ++k) ss += r[k] * r[k];
        const float rs = rsqrtf(ss * (1.0f / D) + EPS);
        P.rstd[t] = rs;
        float lg[4], le[32];
#pragma unroll
        for (int j = 0; j < 4; ++j) lg[j] = 0.f;
#pragma unroll
        for (int j = 0; j < 32; ++j) le[j] = 0.f;
        for (int k = 0; k < D; ++k) {
            const float h = r[k] * rs * g[k];
#pragma unroll
            for (int j = 0; j < 4; ++j) lg[j] += h * wgrp[k * 4 + j];
#pragma unroll
            for (int j = 0; j < 32; ++j) le[j] += h * wexp[k * 32 + j];
        }
#pragma unroll
        for (int j = 0; j < 4; ++j) lg[j] += bgrp[j];
#pragma unroll
        for (int j = 0; j < 32; ++j) le[j] += bexp[j];
        int gs = 0; float gm = lg[0];
#pragma unroll
        for (int j = 1; j < 4; ++j) if (lg[j] > gm) { gm = lg[j]; gs = j; }
        float gz = 0.f;
#pragma unroll
        for (int j = 0; j < 4; ++j) gz += expf(lg[j] - gm);
        const float pg = 1.0f / gz;
        float w[8];
#pragma unroll
        for (int j = 0; j < 8; ++j) w[j] = gs == 0 ? le[j] : gs == 1 ? le[8 + j] : gs == 2 ? le[16 + j] : le[24 + j];
        int i1 = 0; float m1 = w[0];
#pragma unroll
        for (int j = 1; j < 8; ++j) if (w[j] > m1) { m1 = w[j]; i1 = j; }
        int i2 = -1; float m2 = -3e38f;
#pragma unroll
        for (int j = 0; j < 8; ++j) if (j != i1 && w[j] > m2) { m2 = w[j]; i2 = j; }
        const float e2 = expf(m2 - m1);
        const float w1 = pg / (1.0f + e2), w2 = pg * e2 / (1.0f + e2);
        P.eid[t * 2 + 0] = gs * 8 + i1; P.eid[t * 2 + 1] = gs * 8 + i2;
        P.ew[t * 2 + 0] = w1; P.ew[t * 2 + 1] = w2;
    }
}

DEV void ph_moe_hidden(const Params& P, int layer, int gtid, int gsz) {
    const float* g = P.moe_norm + layer * D;
    const long total = (long)T * 512;
    for (long i = gtid; i < total; i += gsz) {
        const int t = (int)(i >> 9), slot = (int)((i >> 8) & 1), f = (int)(i & 255);
        const int e = P.eid[t * 2 + slot];
        const float* wg = P.moe_w_gate + ((size_t)(layer * 32 + e) * D) * 256 + f;
        const float* wu = P.moe_w_up + ((size_t)(layer * 32 + e) * D) * 256 + f;
        const float* r = P.out + (size_t)t * D;
        const float rs = P.rstd[t];
        float a = 0.f, u = 0.f;
        for (int k = 0; k < D; ++k) {
            const float h = r[k] * rs * g[k];
            a += h * wg[(size_t)k * 256];
            u += h * wu[(size_t)k * 256];
        }
        const float sg = a / (1.0f + expf(-a));
        P.hmid[i] = sg * u;
    }
}

DEV void ph_moe_out(const Params& P, int layer, int gtid, int gsz) {
    const long total = (long)T * D;
    for (long i = gtid; i < total; i += gsz) {
        const int t = (int)(i / D), c = (int)(i % D);
        float tot = 0.f;
        for (int slot = 0; slot < 2; ++slot) {
            const int e = P.eid[t * 2 + slot];
            const float* wd = P.moe_w_down + ((size_t)(layer * 32 + e) * 256) * D + c;
            const float* hm = P.hmid + ((size_t)t * 2 + slot) * 256;
            float acc = 0.f;
            for (int f = 0; f < 256; ++f) acc += hm[f] * wd[(size_t)f * D];
            tot += P.ew[t * 2 + slot] * acc;
        }
        P.out[i] += tot;
    }
}

DEV void ph_prep1(const Params& P, int gtid, int gsz) {
    const int n1 = NB * 8 * 8 * 64;
    for (int i = gtid; i < n1; i += gsz) {
        const int d = i & 63, n = (i >> 6) & 7, h = (i >> 9) & 7, b = i >> 12;
        const bf16* kp = P.proj + ((size_t)b * S + n * 256) * LDP + 512 + h * 64 + d;
        float s = 0.f;
        for (int j = 0; j < 256; ++j) s += bf2f(kp[(size_t)j * LDP]);
        P.kmean[i] = s * (1.0f / 256);
    }
    const int n2 = 2 * NB * NCMP * 2;
    for (int i = gtid; i < n2; i += gsz) {
        const int hkv = i & 1; int r = i >> 1; const int n = r % NCMP; r /= NCMP; const int b = r % NB; const int which = r / NB;
        const float* pos = P.od_cmp_pos + which * 32 * 64;
        const float* w = P.od_cmp_w + (size_t)which * 32 * 64 * 64;
        const bf16* xp = P.proj + ((size_t)b * S + n * 16) * LDP + (which ? 2176 : 2048) + hkv * 64;
        float acc[64];
#pragma unroll
        for (int e = 0; e < 64; ++e) acc[e] = 0.f;
        for (int l = 0; l < 32; ++l)
            for (int d = 0; d < 64; ++d) {
                const float xv = bf2f(xp[(size_t)l * LDP + d]) + pos[l * 64 + d];
                const float* wr = w + ((size_t)l * 64 + d) * 64;
#pragma unroll
                for (int e = 0; e < 64; ++e) acc[e] += xv * wr[e];
            }
        if (which == 0) {
            float ss = 0.f;
#pragma unroll
            for (int e = 0; e < 64; ++e) ss += acc[e] * acc[e];
            const float rs = rsqrtf(ss * (1.0f / 64) + EPS);
#pragma unroll
            for (int e = 0; e < 64; ++e) acc[e] *= rs * P.od_d_k_norm[e];
        }
        bf16* op = P.kvcmp + (((size_t)(which * NB + b) * NCMP + n) * 2 + hkv) * 64;
#pragma unroll
        for (int e = 0; e < 64; ++e) op[e] = f2bf(acc[e]);
    }
}

DEV int cmp_count(int s) { int c = s >= 31 ? (s - 31) / 16 + 1 : 0; return c > NCMP ? NCMP : c; }

DEV void ph_nsa_cmp(const Params& P, int gtid, int gsz) {
    const long total = (long)T * 8;
    for (long i = gtid; i < total; i += gsz) {
        const int hh = (int)(i / T), t = (int)(i % T);
        const int b = t / S, s = t % S, hkv = hh >> 2;
        float q[64], o[64];
        load64(P.proj + (size_t)t * LDP + 1536 + hh * 64, q);
#pragma unroll
        for (int d = 0; d < 64; ++d) o[d] = 0.f;
        const float sl = slope_of(hh);
        float m = NEG, l = 0.f;
        const int cnt = cmp_count(s);
        const bf16* kc = P.kvcmp + (((size_t)(0 * NB + b) * NCMP) * 2 + hkv) * 64;
        const bf16* vc = P.kvcmp + (((size_t)(1 * NB + b) * NCMP) * 2 + hkv) * 64;
        for (int n = 0; n < cnt; ++n) {
            const float sc = dot64(q, kc + (size_t)n * 128) * 0.125f - sl * (float)(s - (n * 16 + 31));
            os_update(sc, vc + (size_t)n * 128, m, l, o);
        }
        const float inv = cnt > 0 ? 1.0f / l : 0.f;
        float* op = P.ocmp + ((size_t)t * 8 + hh) * 64;
#pragma unroll
        for (int d = 0; d < 64; ++d) op[d] = o[d] * inv;
        P.cml[((size_t)t * 8 + hh) * 2 + 0] = m;
        P.cml[((size_t)t * 8 + hh) * 2 + 1] = l;
    }
}

DEV void ph_nsa_select(const Params& P, int gtid, int gsz) {
    const long total = (long)T * 64;
    for (long i = gtid; i < total; i += gsz) {
        const int j = (int)(i & 31), hkv = (int)((i >> 5) & 1), t = (int)(i >> 6);
        const int b = t / S, s = t % S, cur = s >> 6;
        float score = NEG;
        if (j <= cur) {
            const int cnt = cmp_count(s);
            const bf16* kc = P.kvcmp + (((size_t)(0 * NB + b) * NCMP) * 2 + hkv) * 64;
            float p = 0.f;
            int n0 = 4 * j - 1; if (n0 < 0) n0 = 0;
            int n1 = 4 * j + 3; if (n1 > NCMP - 1) n1 = NCMP - 1;
            for (int g = 0; g < 4; ++g) {
                const int hh = hkv * 4 + g;
                float q[64];
                load64(P.proj + (size_t)t * LDP + 1536 + hh * 64, q);
                const float sl = slope_of(hh);
                const float m = P.cml[((size_t)t * 8 + hh) * 2 + 0], l = P.cml[((size_t)t * 8 + hh) * 2 + 1];
                for (int n = n0; n <= n1; ++n)
                    if (n < cnt) {
                        const float sc = dot64(q, kc + (size_t)n * 128) * 0.125f - sl * (float)(s - (n * 16 + 31));
                        p += expf(sc - m) / l;
                    }
            }
            const bool forced = (j == 0) || (j == cur) || (j == cur - 1);
            score = p + (forced ? 1000.0f : 0.0f);
        }
        P.pslc[i] = score;
    }
}

DEV void ph_nsa_topk(const Params& P, int gtid, int gsz) {
    const int total = T * 2;
    for (int i = gtid; i < total; i += gsz) {
        const int t = i >> 1;
        const int s = t % S, cur = s >> 6;
        const float* sc = P.pslc + (size_t)i * 32;
        unsigned mask = 0;
        for (int j = 0; j <= cur; ++j) {
            const float sj = sc[j];
            int rank = 0;
            for (int k = 0; k < 32; ++k) { const float sk = sc[k]; rank += (sk > sj || (sk == sj && k < j)) ? 1 : 0; }
            if (rank < 16) mask |= 1u << j;
        }
        P.selmask[i] = mask;
    }
}

DEV void ph_attn1(const Params& P, int gtid, int gsz) {
    const long total = (long)T * 16;
    for (long i = gtid; i < total; i += gsz) {
        const int hh = (int)(i / T), t = (int)(i % T);
        const int b = t / S, s = t % S;
        const bf16* base = P.proj + (size_t)b * S * LDP;
        float q[64], o[64];
#pragma unroll
        for (int d = 0; d < 64; ++d) o[d] = 0.f;
        if (hh < 8) {
            const int h = hh, own = s >> 8;
            load64(base + (size_t)s * LDP + h * 64, q);
            const float sl = slope_of(h);
            float gt[8];
#pragma unroll
            for (int n = 0; n < 8; ++n) gt[n] = n < own ? dot64f(q, P.kmean + ((size_t)(b * 8 + h) * 8 + n) * 64) : NEG;
            unsigned sel = 0;
#pragma unroll
            for (int n = 0; n < 8; ++n) {
                int rank = 0;
#pragma unroll
                for (int k = 0; k < 8; ++k) rank += (gt[k] > gt[n] || (gt[k] == gt[n] && k < n)) ? 1 : 0;
                if (rank < 3 && n < own) sel |= 1u << n;
            }
            float m = NEG, l = 0.f;
            for (int n = 0; n < own; ++n) {
                if (!((sel >> n) & 1)) continue;
                for (int kk = 0; kk < 256; ++kk) {
                    const int kp = n * 256 + kk;
                    const bf16* kr = base + (size_t)kp * LDP + 512 + h * 64;
                    const float sc = dot64(q, kr) * 0.125f - sl * (float)(s - kp);
                    os_update(sc, kr + 512, m, l, o);
                }
            }
            for (int kp = own * 256; kp <= s; ++kp) {
                const bf16* kr = base + (size_t)kp * LDP + 512 + h * 64;
                const float sc = dot64(q, kr) * 0.125f - sl * (float)(s - kp);
                os_update(sc, kr + 512, m, l, o);
            }
            const float inv = 1.0f / l;
            bf16* op = P.o + (size_t)t * D + h * 64;
#pragma unroll
            for (int d = 0; d < 64; ++d) op[d] = f2bf(o[d] * inv);
        } else {
            const int h = hh - 8, hkv = h >> 2, cur = s >> 6;
            load64(base + (size_t)s * LDP + 1536 + h * 64, q);
            const float sl = slope_of(h);
            const bf16* grow = base + (size_t)s * LDP + 2816 + h * 3;
            const float g0 = 1.0f / (1.0f + expf(-bf2f(grow[0])));
            const float g1 = 1.0f / (1.0f + expf(-bf2f(grow[1])));
            const float g2 = 1.0f / (1.0f + expf(-bf2f(grow[2])));
            float acc[64];
            const float* oc = P.ocmp + ((size_t)t * 8 + h) * 64;
#pragma unroll
            for (int d = 0; d < 64; ++d) acc[d] = g0 * oc[d];
            const unsigned mask = P.selmask[t * 2 + hkv];
            float m = NEG, l = 0.f;
            for (int j = 0; j <= cur; ++j) {
                if (!((mask >> j) & 1)) continue;
                for (int kk = 0; kk < 64; ++kk) {
                    const int kp = j * 64 + kk;
                    if (kp > s) break;
                    const bf16* kr = base + (size_t)kp * LDP + 2304 + hkv * 64;
                    const float sc = dot64(q, kr) * 0.125f - sl * (float)(s - kp);
                    os_update(sc, kr + 128, m, l, o);
                }
            }
            {
                const float f = g1 / l;
#pragma unroll
                for (int d = 0; d < 64; ++d) { acc[d] += f * o[d]; o[d] = 0.f; }
            }
            m = NEG; l = 0.f;
            const int s0 = s - 511 < 0 ? 0 : s - 511;
            for (int kp = s0; kp <= s; ++kp) {
                const bf16* kr = base + (size_t)kp * LDP + 2560 + hkv * 64;
                const float sc = dot64(q, kr) * 0.125f - sl * (float)(s - kp);
                os_update(sc, kr + 128, m, l, o);
            }
            {
                const float f = g2 / l;
#pragma unroll
                for (int d = 0; d < 64; ++d) acc[d] += f * o[d];
            }
            bf16* op = P.o + (size_t)t * D + 512 + h * 64;
#pragma unroll
            for (int d = 0; d < 64; ++d) op[d] = f2bf(acc[d]);
        }
    }
}

namespace pg8 {
#define PG8_LAS __attribute__((address_space(3)))
typedef unsigned short bf16_t;
typedef short bf16x8 __attribute__((ext_vector_type(8)));
typedef float f32x4 __attribute__((ext_vector_type(4)));
typedef unsigned u32x4 __attribute__((ext_vector_type(4)));
constexpr int BM = 256, BK = 64, HALF = 128, HTB = HALF * BK * 2, STAGE_BYTES = 8 * HTB, NXCD = 8, WGM = 8;

__host__ __device__ __forceinline__ int lds_byte(int r, int c) { const int st = (r >> 4) * 2 + (c >> 5), rr = r & 15, cc = c & 31, ob = rr * 64 + cc * 2; return st * 1024 + (ob ^ (((ob >> 9) & 1) << 5)); }
__host__ __device__ __forceinline__ void stage_rc(int b, int& R, int& C) { const int st = b / 1024, sb = b % 1024, swz = sb ^ (((sb >> 9) & 1) << 5); R = (st >> 1) * 16 + swz / 64; C = (st & 1) * 32 + (swz % 64) / 2; }
__host__ __device__ __forceinline__ int perm32(int rho) { const int n = rho >> 4, i = rho & 15; return 8 * (i >> 2) + 4 * n + (i & 3); }

struct Unit { const char* A; const char* B; int pm, pn; };

struct StaticOrder {
    int nM, nN, nwg, G, c; const char* A; const char* Bt; size_t tstep;
    __device__ void init(const bf16_t* A_, const bf16_t* Bt_, int M, int N, int K, int G_, int c_) { nM = M / BM; nN = N / BM; nwg = nM * nN; G = G_; c = c_; A = (const char*)A_; Bt = (const char*)Bt_; tstep = (size_t)BM * K * 2; }
    __device__ bool next(int i, Unit& u) const {
        const long L = (long)i * G + c; if (L >= nwg) return false;
        int wgid = (int)L; { const int q = nwg / NXCD, r = nwg % NXCD, xcd = wgid % NXCD, off = wgid / NXCD; wgid = (xcd < r ? xcd * (q + 1) : r * (q + 1) + (xcd - r) * q) + off; }
        const int nig = WGM * nN, gid = wgid / nig, fm = gid * WGM, gsz = (nM - fm) < WGM ? (nM - fm) : WGM;
        u.pm = fm + ((wgid % nig) % gsz); u.pn = (wgid % nig) / gsz; u.A = A + (size_t)u.pm * tstep; u.B = Bt + (size_t)u.pn * tstep; return true;
    }
};

__device__ __forceinline__ unsigned cvt_pk_bf16(float lo, float hi) { unsigned r; asm volatile("v_cvt_pk_bf16_f32 %0, %1, %2" : "=v"(r) : "v"(lo), "v"(hi)); return r; }

struct EpiStoreBf16 {
    static constexpr bool PERM = true;
    bf16_t* O; int ldc;
    __device__ __forceinline__ void operator()(const f32x4 (&acc)[2][2][4][2], const Unit& u, int wr, int wc, int fr, int fq) const {
        const int row0 = u.pm * BM + wr * 64 + fr, col0 = u.pn * BM + wc * 32 + 8 * fq;
#pragma unroll
        for (int ai = 0; ai < 2; ++ai)
#pragma unroll
            for (int m = 0; m < 4; ++m) { bf16_t* rowp = O + (size_t)(row0 + ai * HALF + m * 16) * ldc + col0;
#pragma unroll
                for (int bj = 0; bj < 2; ++bj) { const f32x4 v0 = acc[ai][bj][m][0], v1 = acc[ai][bj][m][1];
                    u32x4 w; w.x = cvt_pk_bf16(v0[0], v0[1]); w.y = cvt_pk_bf16(v0[2], v0[3]); w.z = cvt_pk_bf16(v1[0], v1[1]); w.w = cvt_pk_bf16(v1[2], v1[3]);
                    *(u32x4*)(rowp + bj * HALF) = w; } }
    }
};
struct EpiResidF32 {
    static constexpr bool PERM = true;
    const float* R; float* O; int ldc;
    __device__ __forceinline__ void operator()(const f32x4 (&acc)[2][2][4][2], const Unit& u, int wr, int wc, int fr, int fq) const {
        const int row0 = u.pm * BM + wr * 64 + fr, col0 = u.pn * BM + wc * 32 + 8 * fq;
#pragma unroll
        for (int ai = 0; ai < 2; ++ai)
#pragma unroll
            for (int m = 0; m < 4; ++m) { const size_t ro = (size_t)(row0 + ai * HALF + m * 16) * ldc + col0;
#pragma unroll
                for (int bj = 0; bj < 2; ++bj) {
                    const f32x4 r0 = *(const f32x4*)(R + ro + bj * HALF), r1 = *(const f32x4*)(R + ro + bj * HALF + 4);
                    *(f32x4*)(O + ro + bj * HALF) = r0 + acc[ai][bj][m][0]; *(f32x4*)(O + ro + bj * HALF + 4) = r1 + acc[ai][bj][m][1]; } }
    }
};
struct EpiSiluMul {
    static constexpr bool PERM = true;
    bf16_t* H; int ldh;
    __device__ __forceinline__ void operator()(const f32x4 (&acc)[2][2][4][2], const Unit& u, int wr, int wc, int fr, int fq) const {
        const int row0 = u.pm * BM + wr * 64 + fr, col0 = u.pn * HALF + wc * 32 + 8 * fq;
#pragma unroll
        for (int ai = 0; ai < 2; ++ai)
#pragma unroll
            for (int m = 0; m < 4; ++m) { bf16_t* rowp = H + (size_t)(row0 + ai * HALF + m * 16) * ldh + col0;
                float h[8];
#pragma unroll
                for (int n = 0; n < 2; ++n)
#pragma unroll
                    for (int j = 0; j < 4; ++j) { const float g = acc[ai][0][m][n][j], up = acc[ai][1][m][n][j]; h[n * 4 + j] = g * up / (1.0f + __expf(-g)); }
                u32x4 w; w.x = cvt_pk_bf16(h[0], h[1]); w.y = cvt_pk_bf16(h[2], h[3]); w.z = cvt_pk_bf16(h[4], h[5]); w.w = cvt_pk_bf16(h[6], h[7]);
                *(u32x4*)rowp = w; }
    }
};

template <class Epi, class Sched>
__device__ __forceinline__ void gemm_phase(PG8_LAS unsigned char* lds, const int K, const Sched& S, const Epi& E, const int tid) {
    const int wid = __builtin_amdgcn_readfirstlane(tid >> 6), lane = tid & 63, wr = wid >> 2, wc = wid & 3, fr = lane & 15, fq = lane >> 4;
    const int nt = K / BK;
    unsigned voffA[2], voffB[2];
#pragma unroll
    for (int i = 0; i < 2; ++i) { int R, C; stage_rc(tid * 16 + i * 8192, R, C); const int Rb = Epi::PERM ? ((R & ~31) + perm32(R & 31)) : R;
        voffA[i] = (unsigned)(R * K + C) * 2u; voffB[i] = (unsigned)(Rb * K + C) * 2u; }
    const size_t kstep = (size_t)(BK * 2);
    const size_t hstep = (size_t)HALF * K * 2;
    const unsigned ldsw = (unsigned)wid * 1024u;
    const int aoff = lds_byte(wr * 64 + fr, fq * 8), boff = lds_byte(wc * 32 + fr, fq * 8);
#define PG8_SA(b, h) (((b) * 2 + (h)) * HTB)
#define PG8_SB(b, h) ((4 + (b) * 2 + (h)) * HTB)
#define PG8_STAGE(bufoff, gbase, voff) do { _Pragma("unroll") for (int _i = 0; _i < 2; ++_i) \
        __builtin_amdgcn_global_load_lds((const unsigned*)((const char*)(gbase) + (voff)[_i]), (PG8_LAS unsigned*)(lds + (bufoff) + ldsw + _i * 8192), 16, 0, 0); } while (0)
#define PG8_LDA(dst, b, h) do { _Pragma("unroll") for (int m = 0; m < 4; ++m) _Pragma("unroll") for (int k = 0; k < 2; ++k) dst[m][k] = *(const PG8_LAS bf16x8*)(lds + PG8_SA(b, h) + aoff + m * 2048 + k * 1024); } while (0)
#define PG8_LDB(dst, b, h) do { _Pragma("unroll") for (int n = 0; n < 2; ++n) _Pragma("unroll") for (int k = 0; k < 2; ++k) dst[n][k] = *(const PG8_LAS bf16x8*)(lds + PG8_SB(b, h) + boff + n * 2048 + k * 1024); } while (0)
#define PG8_MMA(ai, bj, At, Bt) do { __builtin_amdgcn_s_setprio(1); _Pragma("unroll") for (int m = 0; m < 4; ++m) _Pragma("unroll") for (int n = 0; n < 2; ++n) _Pragma("unroll") for (int k = 0; k < 2; ++k) \
        acc[ai][bj][m][n] = __builtin_amdgcn_mfma_f32_16x16x32_bf16(Bt[n][k], At[m][k], acc[ai][bj][m][n], 0, 0, 0); __builtin_amdgcn_s_setprio(0); } while (0)
#define PG8_WAIT_V(n) asm volatile("s_waitcnt vmcnt(" #n ")" ::: "memory")
#define PG8_WAIT_L(n) asm volatile("s_waitcnt lgkmcnt(" #n ")" ::: "memory")
#define PG8_BAR __builtin_amdgcn_s_barrier()
#define PG8_SCHED __builtin_amdgcn_sched_barrier(0)
    Unit cur, nxt; int ui = 0;
    if (!S.next(0, cur)) return;
    f32x4 acc[2][2][4][2];
#pragma unroll
    for (int a = 0; a < 2; ++a)
#pragma unroll
        for (int b = 0; b < 2; ++b)
#pragma unroll
            for (int m = 0; m < 4; ++m)
#pragma unroll
                for (int n = 0; n < 2; ++n) acc[a][b][m][n] = (f32x4){0.f, 0.f, 0.f, 0.f};
    bf16x8 At[4][2], B0[2][2], B1[2][2];
    const char* cA = cur.A; const char* cB = cur.B;
    PG8_STAGE(PG8_SB(0, 0), cB, voffB); PG8_STAGE(PG8_SB(0, 1), cB + hstep, voffB); PG8_STAGE(PG8_SA(0, 0), cA, voffA); PG8_STAGE(PG8_SA(0, 1), cA + hstep, voffA);
    if (wr == 1) PG8_BAR;
    PG8_WAIT_V(2); PG8_BAR;
    PG8_STAGE(PG8_SB(1, 0), cB + kstep, voffB); PG8_STAGE(PG8_SA(1, 0), cA + kstep, voffA); PG8_STAGE(PG8_SB(1, 1), cB + hstep + kstep, voffB);
    PG8_WAIT_V(6); PG8_BAR;
    for (;;) {
        const bool has_next = S.next(ui + 1, nxt);
        const char* nA = has_next ? nxt.A : cA; const char* nB = has_next ? nxt.B : cB;
        for (int t = 0; t < nt; t += 2) {
            const bool last = (t == nt - 2);
            const char* a1 = cA + (size_t)(t + 1) * kstep;
            const char* a2 = last ? nA : cA + (size_t)(t + 2) * kstep; const char* b2 = last ? nB : cB + (size_t)(t + 2) * kstep;
            const char* a3 = a2 + kstep; const char* b3 = b2 + kstep;
            PG8_LDB(B0, 0, 0); PG8_LDB(B1, 0, 1); PG8_SCHED; PG8_LDA(At, 0, 0); PG8_STAGE(PG8_SA(1, 1), a1 + hstep, voffA);
            PG8_WAIT_V(8); PG8_WAIT_L(0); PG8_BAR; PG8_MMA(0, 0, At, B0); PG8_MMA(0, 1, At, B1); PG8_BAR; PG8_SCHED;
            PG8_LDA(At, 0, 1); PG8_STAGE(PG8_SB(0, 0), b2, voffB); PG8_STAGE(PG8_SB(0, 1), b2 + hstep, voffB); PG8_STAGE(PG8_SA(0, 0), a2, voffA);
            PG8_WAIT_V(8); PG8_WAIT_L(0); PG8_BAR; PG8_MMA(1, 0, At, B0); PG8_MMA(1, 1, At, B1); PG8_BAR; PG8_SCHED;
            PG8_LDB(B0, 1, 0); PG8_LDB(B1, 1, 1); PG8_SCHED; PG8_LDA(At, 1, 0); PG8_STAGE(PG8_SA(0, 1), a2 + hstep, voffA);
            PG8_WAIT_V(8); PG8_WAIT_L(0); PG8_BAR; PG8_MMA(0, 0, At, B0); PG8_MMA(0, 1, At, B1); PG8_BAR; PG8_SCHED;
            PG8_LDA(At, 1, 1); PG8_STAGE(PG8_SB(1, 0), b3, voffB); PG8_STAGE(PG8_SB(1, 1), b3 + hstep, voffB); PG8_STAGE(PG8_SA(1, 0), a3, voffA);
            PG8_WAIT_V(8); PG8_WAIT_L(0); PG8_BAR; PG8_MMA(1, 0, At, B0); PG8_MMA(1, 1, At, B1); PG8_BAR; PG8_SCHED;
        }
        if (wr == 0) PG8_BAR;
        { int fr2 = lane & 15, fq2 = lane >> 4; asm volatile("" : "+v"(fr2), "+v"(fq2)); E(acc, cur, wr, wc, fr2, fq2); }
        if (!has_next) break;
#pragma unroll
        for (int a = 0; a < 2; ++a)
#pragma unroll
            for (int b = 0; b < 2; ++b)
#pragma unroll
                for (int m = 0; m < 4; ++m)
#pragma unroll
                    for (int n = 0; n < 2; ++n) acc[a][b][m][n] = (f32x4){0.f, 0.f, 0.f, 0.f};
        cur = nxt; cA = nA; cB = nB; ++ui;
        if (wr == 1) PG8_BAR;
    }
    PG8_WAIT_V(0);
    PG8_BAR;
#undef PG8_SA
#undef PG8_SB
#undef PG8_STAGE
#undef PG8_LDA
#undef PG8_LDB
#undef PG8_MMA
#undef PG8_WAIT_V
#undef PG8_WAIT_L
#undef PG8_BAR
#undef PG8_SCHED
}
}

#define GAS __attribute__((address_space(1)))
#define LAS __attribute__((address_space(3)))
typedef unsigned v4u __attribute__((ext_vector_type(4)));
typedef float f32x4 __attribute__((ext_vector_type(4)));
typedef short bf16x8 __attribute__((ext_vector_type(8)));
constexpr int NWAVES = 8;
constexpr int RING_BYTES = 131072, LDSCTL_OFF = RING_BYTES, MISC_OFF = LDSCTL_OFF + 320, LDS_BYTES = 147456;
constexpr size_t MiB = 1u << 20;
constexpr size_t CTL_ZERO_BYTES = 1 * MiB;
constexpr int CW_BAR = 4096;
constexpr int CW_MOE = 65536;
#define LDS_WAIT() asm volatile("s_waitcnt lgkmcnt(0)" ::: "memory")
#define VM_WAIT() asm volatile("s_waitcnt vmcnt(0)" ::: "memory")
DEV unsigned pk2(float lo, float hi) { return (unsigned)f2bf(lo) | ((unsigned)f2bf(hi) << 16); }

#define XB_TMO      128
#define XB_XCNT(j)  (256  + 64 * (j))
#define XB_XSUB(j)  (1280 + 64 * (j))
#define XB_XGEN(j)  (2304 + 64 * (j))
#define XB_TOP      3328
#define XB_TOPGEN   3392
#define XCD_BAR_WORDS 3456
#define XB_SPIN_CAP (1u << 22)
DEV unsigned xb_ld(unsigned* p)              { return __hip_atomic_load(p, __ATOMIC_RELAXED, __HIP_MEMORY_SCOPE_AGENT); }
DEV unsigned xb_add(unsigned* p, unsigned v) { return __hip_atomic_fetch_add(p, v, __ATOMIC_RELAXED, __HIP_MEMORY_SCOPE_AGENT); }
DEV unsigned xb_xcc_id() { return (unsigned)__builtin_amdgcn_s_getreg((3 << 11) | 20) & 0xFu; }
#define XB_SPIN(cond, bar) do { unsigned _sp = 0; while (cond) { __builtin_amdgcn_s_sleep(1); \
    if ((++_sp & 255u) == 0u) { if (xb_ld(&(bar)[XB_TMO])) break; if (_sp > XB_SPIN_CAP) { atomicAdd(&(bar)[XB_TMO], 1u); break; } } } } while (0)
struct XcdBarrier { unsigned* bar; unsigned x; volatile LAS unsigned* st; };
DEV XcdBarrier xcd_barrier_post(unsigned* bar, volatile LAS unsigned* st) {
    XcdBarrier b; b.bar = bar; b.x = xb_xcc_id(); b.st = st;
    if (threadIdx.x == 0) (void)xb_add(&bar[XB_XCNT(b.x)], 1u);
    return b;
}
DEV void xcd_barrier_complete(unsigned* bar, unsigned x, unsigned& nloc, unsigned& nx) {
    const unsigned G = gridDim.x * gridDim.y * gridDim.z;
    unsigned sum, cnt, mine, sp = 0u;
    for (;;) {
        sum = 0u; cnt = 0u; mine = 0u;
#pragma unroll
        for (unsigned j = 0; j < 16; ++j) { const unsigned c = xb_ld(&bar[XB_XCNT(j)]); sum += c; cnt += (c > 0u) ? 1u : 0u; mine = (j == x) ? c : mine; }
        if (sum == G) break;
        __builtin_amdgcn_s_sleep(1);
        if ((++sp & 255u) == 0u) { if (xb_ld(&bar[XB_TMO])) break; if (sp > XB_SPIN_CAP) { atomicAdd(&bar[XB_TMO], 1u); break; } }
    }
    nloc = mine > 0u ? mine : 1u; nx = cnt > 0u ? cnt : 1u;
}
DEV void xcd_barrier(const XcdBarrier& b, const int tid_) {
    asm volatile("s_waitcnt vmcnt(0)" ::: "memory");
    __syncthreads();
    if (tid_ == 0) {
        unsigned* bar = b.bar;
        __builtin_amdgcn_s_waitcnt(0);
        unsigned nloc = b.st[0], nx = b.st[1];
        if (nloc == 0u) { xcd_barrier_complete(bar, b.x, nloc, nx); b.st[0] = nloc; b.st[1] = nx; }
        const unsigned old = xb_add(&bar[XB_XSUB(b.x)], 1u);
        const unsigned gen = old / nloc;
        if (old + 1u == (gen + 1u) * nloc) {
            __builtin_amdgcn_fence(__ATOMIC_RELEASE, "agent");
            asm volatile("s_waitcnt vmcnt(0)" ::: "memory");
            const unsigned og = xb_add(&bar[XB_TOP], 1u);
            const unsigned tg = og / nx;
            if (og + 1u == (tg + 1u) * nx) xb_add(&bar[XB_TOPGEN], 1u);
            else XB_SPIN(xb_ld(&bar[XB_TOPGEN]) == tg, bar);
            __builtin_amdgcn_fence(__ATOMIC_ACQUIRE, "agent");
            xb_add(&bar[XB_XGEN(b.x)], 1u);
            asm volatile("s_waitcnt vmcnt(0)" ::: "memory");
        } else {
            XB_SPIN(xb_ld(&bar[XB_XGEN(b.x)]) == gen, bar);
            __builtin_amdgcn_fence(__ATOMIC_ACQUIRE, "agent");
            asm volatile("s_waitcnt vmcnt(0)" ::: "memory");
        }
    }
    __syncthreads();
}

struct Frame {
    LAS unsigned char* lds;
    volatile LAS unsigned* MISC;
    int tid, lane, wave;
    int vcu, G;
};

DEV void refresh(Frame& F) { int l; asm volatile("v_mbcnt_lo_u32_b32 %0, -1, 0\n\tv_mbcnt_hi_u32_b32 %0, -1, %0" : "=v"(l)); F.lane = l; F.tid = F.wave * 64 + l; }
DEV float wave_sum(float v) {
#pragma unroll
    for (int o = 1; o < 64; o <<= 1) v += __shfl_xor(v, o);
    return v;
}
DEV void transpose_item(const float* W, int K, int N, bf16* WT, int k0, int n0, int dst_row0, LAS float* scr, int lane) {
    const bool okc = (n0 + (lane & 31)) < N;
#pragma unroll 8
    for (int i = 0; i < 32; ++i) { const int kk = 2 * i + (lane >> 5); scr[kk * 33 + (lane & 31)] = okc ? W[(size_t)(k0 + kk) * N + n0 + (lane & 31)] : 0.f; }
    LDS_WAIT(); asm volatile("" ::: "memory");
    const int c = lane & 7;
#pragma unroll
    for (int j = 0; j < 4; ++j) { const int n = (lane >> 3) + 8 * j; const LAS float* s = scr + (8 * c) * 33 + n;
        v4u o; o.x = pk2(s[0 * 33], s[1 * 33]); o.y = pk2(s[2 * 33], s[3 * 33]); o.z = pk2(s[4 * 33], s[5 * 33]); o.w = pk2(s[6 * 33], s[7 * 33]);
        if (n0 + n < N) *(GAS v4u*)(WT + (size_t)(dst_row0 + n) * K + k0 + 8 * c) = o; }
    LDS_WAIT(); asm volatile("" ::: "memory");
}
DEV float rms_row_to_bf16(int lane, const float* xrow, const float* gain, bf16* orow) {
    const GAS f32x4* xr = (const GAS f32x4*)xrow + lane;
    const GAS f32x4* gr = (const GAS f32x4*)gain + lane;
    f32x4 v[4]; float s = 0.f;
#pragma unroll
    for (int j = 0; j < 4; ++j) { v[j] = xr[64 * j]; s += (v[j].x * v[j].x + v[j].y * v[j].y) + (v[j].z * v[j].z + v[j].w * v[j].w); }
    const float rstd = 1.0f / sqrtf(wave_sum(s) * (1.f / D) + EPS);
    GAS unsigned long long* o8 = (GAS unsigned long long*)orow + lane;
#pragma unroll
    for (int j = 0; j < 4; ++j) { const f32x4 g = gr[64 * j];
        o8[64 * j] = (unsigned long long)pk2(v[j].x * rstd * g.x, v[j].y * rstd * g.y) | ((unsigned long long)pk2(v[j].z * rstd * g.z, v[j].w * rstd * g.w) << 32); }
    return rstd;
}

DEV void fp_convert_weights(const Params& P, Frame& F, int which) {
    LAS float* scr = (LAS float*)(F.lds + F.wave * 16384);
    const int gw = F.vcu * NWAVES + F.wave, NGW = F.G * NWAVES;
    if (which == 0) {
        constexpr int I_IN0 = 16 * 72, I_OUT = 16 * 32, I_IN1 = 16 * 89;
        constexpr int NIT = I_IN0 + I_OUT + I_IN1 + I_OUT;
        for (int it = gw; it < NIT; it += NGW) {
            int r = it;
            if (r < I_IN0) { const int kb = r / 72, nb = r % 72; transpose_item(P.ev_w_in, D, EVEN_IN, P.win0t, 64 * kb, 32 * nb, 32 * nb, scr, F.lane); continue; } r -= I_IN0;
            if (r < I_OUT) { const int kb = r / 32, nb = r % 32; transpose_item(P.ev_w_out, D, D, P.wout0t, 64 * kb, 32 * nb, 32 * nb, scr, F.lane); continue; } r -= I_OUT;
            if (r < I_IN1) { const int kb = r / 89, nb = r % 89; transpose_item(P.od_w_in, D, ODD_IN, P.win1t, 64 * kb, 32 * nb, 32 * nb, scr, F.lane); continue; } r -= I_IN1;
            { const int kb = r / 32, nb = r % 32; transpose_item(P.od_w_out, D, D, P.wout1t, 64 * kb, 32 * nb, 32 * nb, scr, F.lane); }
        }
    } else {
        const int layer = which - 1;
        constexpr int NIT = 32 * 384;
        for (int it = gw; it < NIT; it += NGW) {
            const int e = it / 384; int r = it % 384;
            const size_t eo = (size_t)(layer * 32 + e);
            if (r < 256) { const bool up = r >= 128; r &= 127; const int kb = r / 8, nb = r % 8; const int f0 = 32 * nb;
                const float* W = (up ? P.moe_w_up : P.moe_w_gate) + eo * D * 256;
                transpose_item(W, D, 256, P.wgut + (size_t)e * 512 * D, 64 * kb, f0, (f0 >> 7) * 256 + (up ? 128 : 0) + (f0 & 127), scr, F.lane);
            } else { r -= 256; const int kb = r / 32, nb = r % 32;
                transpose_item(P.moe_w_down + eo * 256 * D, 256, D, P.wdt + (size_t)e * D * 256, 64 * kb, 32 * nb, 32 * nb, scr, F.lane); }
        }
    }
}
DEV void fp_norm_rows(Frame& F, const float* src, const float* gain, bf16* xn) {
    const int gw = F.vcu * NWAVES + F.wave, NGW = F.G * NWAVES;
    for (int m = gw; m < T; m += NGW) rms_row_to_bf16(F.lane, src + (size_t)m * D, gain, xn + (size_t)m * D);
}

constexpr int TAB_OFF = MISC_OFF + 128;
constexpr int RT_PART_OFF = 0;
constexpr int RT_SS_OFF = 24576;
constexpr int RT_HIST_OFF = 25088;
typedef float f32x4v __attribute__((ext_vector_type(4)));

DEV void fp_prep_router(const Params& P, Frame& F) {
    const int gtid = F.vcu * NWAVES * 64 + F.tid, gsz = F.G * NWAVES * 64;
    for (int i = gtid; i < 2 * 48 * D; i += gsz) {
        const int k = i & (D - 1), j = (i >> 10) % 48, l = i / (48 * D);
        float w = 0.f;
        if (j < 4) w = P.moe_w_grp[((size_t)l * D + k) * 4 + j]; else if (j < 36) w = P.moe_w_exp[((size_t)l * D + k) * 32 + (j - 4)];
        w *= P.moe_norm[l * D + k];
        const bf16 hi = f2bf(w); const bf16 lo = f2bf(w - bf2f(hi));
        P.wr[((size_t)(l * 2 + 0) * 48 + j) * D + k] = hi;
        P.wr[((size_t)(l * 2 + 1) * 48 + j) * D + k] = lo;
    }
}

DEV void fp_route(const Params& P, Frame& F, int layer) {
    const int lane = F.lane, w = F.wave, rg = w & 3, kh = w >> 2;
    const bf16* wr_hi = P.wr + (size_t)(layer * 2 + 0) * 48 * D;
    const bf16* wr_lo = P.wr + (size_t)(layer * 2 + 1) * 48 * D;
    LAS float* part = (LAS float*)(F.lds + RT_PART_OFF);
    LAS float* ssp = (LAS float*)(F.lds + RT_SS_OFF);
    LAS unsigned* hist = (LAS unsigned*)(F.lds + RT_HIST_OFF);
    unsigned* cnt = P.ctl + CW_MOE + layer * 256;
    for (int tb = F.vcu; tb < T / 64; tb += F.G) {
        const int t0 = tb * 64;
        if (F.tid < 64) hist[F.tid] = 0u;
        const float* xrow = P.out + (size_t)(t0 + 16 * rg + (lane & 15)) * D + 512 * kh + 8 * (lane >> 4);
        pg8::f32x4 acc[3];
#pragma unroll
        for (int c = 0; c < 3; ++c) acc[c] = (pg8::f32x4){0.f, 0.f, 0.f, 0.f};
        float ss = 0.f;
        const size_t boff = (size_t)(lane & 15) * D + 512 * kh + 8 * (lane >> 4);
#pragma unroll 4
        for (int ks = 0; ks < 16; ++ks) {
            const f32x4v x0 = *(const f32x4v*)(xrow + 32 * ks), x1 = *(const f32x4v*)(xrow + 32 * ks + 4);
            float xv[8] = {x0.x, x0.y, x0.z, x0.w, x1.x, x1.y, x1.z, x1.w};
            bf16x8 ah, al;
#pragma unroll
            for (int j = 0; j < 8; ++j) { ss += xv[j] * xv[j]; const bf16 h = f2bf(xv[j]); ah[j] = (short)h; al[j] = (short)f2bf(xv[j] - bf2f(h)); }
#pragma unroll
            for (int c = 0; c < 3; ++c) {
                const bf16x8 bh = *(const bf16x8*)(wr_hi + boff + (size_t)16 * c * D + 32 * ks);
                const bf16x8 bl = *(const bf16x8*)(wr_lo + boff + (size_t)16 * c * D + 32 * ks);
                acc[c] = __builtin_amdgcn_mfma_f32_16x16x32_bf16(ah, bh, acc[c], 0, 0, 0);
                acc[c] = __builtin_amdgcn_mfma_f32_16x16x32_bf16(ah, bl, acc[c], 0, 0, 0);
                acc[c] = __builtin_amdgcn_mfma_f32_16x16x32_bf16(al, bh, acc[c], 0, 0, 0);
            }
        }
        ss += __shfl_xor(ss, 16); ss += __shfl_xor(ss, 32);
#pragma unroll
        for (int c = 0; c < 3; ++c)
#pragma unroll
            for (int r = 0; r < 4; ++r) part[(kh * 64 + 16 * rg + 4 * (lane >> 4) + r) * 48 + 16 * c + (lane & 15)] = acc[c][r];
        if (lane < 16) ssp[kh * 64 + 16 * rg + lane] = ss;
        __syncthreads();
        int e1 = 0, e2 = 0; float w1 = 0.f, w2 = 0.f; unsigned r1 = 0, r2 = 0;
        if (F.tid < 64) {
            const int t = t0 + F.tid;
            const float rs = 1.0f / sqrtf((ssp[F.tid] + ssp[64 + F.tid]) * (1.f / D) + EPS);
            P.rstd[t] = rs;
            float lg[4], le[32];
#pragma unroll
            for (int j = 0; j < 4; ++j) lg[j] = (part[F.tid * 48 + j] + part[(64 + F.tid) * 48 + j]) * rs + P.moe_b_grp[layer * 4 + j];
#pragma unroll
            for (int j = 0; j < 32; ++j) le[j] = (part[F.tid * 48 + 4 + j] + part[(64 + F.tid) * 48 + 4 + j]) * rs + P.moe_b_exp[layer * 32 + j];
            int gs = 0; float gm = lg[0];
#pragma unroll
            for (int j = 1; j < 4; ++j) if (lg[j] > gm) { gm = lg[j]; gs = j; }
            float gz = 0.f;
#pragma unroll
            for (int j = 0; j < 4; ++j) gz += expf(lg[j] - gm);
            const float pg = 1.0f / gz;
            float wv[8];
#pragma unroll
            for (int j = 0; j < 8; ++j) wv[j] = gs == 0 ? le[j] : gs == 1 ? le[8 + j] : gs == 2 ? le[16 + j] : le[24 + j];
            int i1 = 0; float m1 = wv[0];
#pragma unroll
            for (int j = 1; j < 8; ++j) if (wv[j] > m1) { m1 = wv[j]; i1 = j; }
            int i2 = -1; float m2 = -3e38f;
#pragma unroll
            for (int j = 0; j < 8; ++j) if (j != i1 && wv[j] > m2) { m2 = wv[j]; i2 = j; }
            const float ex2 = expf(m2 - m1);
            w1 = pg / (1.0f + ex2); w2 = pg * ex2 / (1.0f + ex2);
            e1 = gs * 8 + i1; e2 = gs * 8 + i2;
            r1 = __hip_atomic_fetch_add(&hist[e1], 1u, __ATOMIC_RELAXED, __HIP_MEMORY_SCOPE_WORKGROUP); r2 = __hip_atomic_fetch_add(&hist[e2], 1u, __ATOMIC_RELAXED, __HIP_MEMORY_SCOPE_WORKGROUP);
        }
        __syncthreads();
        if (F.tid < 32) { const unsigned h = hist[F.tid]; hist[32 + F.tid] = h ? xb_add(&cnt[F.tid], h) : 0u; }
        __syncthreads();
        if (F.tid < 64) {
            const int t = t0 + F.tid;
            P.eid[t * 2 + 0] = e1; P.eid[t * 2 + 1] = e2; P.ew[t * 2 + 0] = w1; P.ew[t * 2 + 1] = w2;
            P.pos[t * 2 + 0] = (int)(hist[32 + e1] + r1); P.pos[t * 2 + 1] = (int)(hist[32 + e2] + r2);
        }
        __syncthreads();
    }
}

DEV void moe_table(const Params& P, Frame& F, int layer) {
    volatile LAS int* tab = (volatile LAS int*)(F.lds + TAB_OFF);
    if (F.tid == 0) {
        unsigned* cnt = P.ctl + CW_MOE + layer * 256;
        int acc = 0;
        for (int e = 0; e < 32; ++e) { tab[e] = acc; acc += (int)((xb_ld(&cnt[e]) + 255u) >> 8); }
        tab[32] = acc;
    }
    __syncthreads();
}

DEV void fp_gather(const Params& P, Frame& F, int layer) {
    moe_table(P, F, layer);
    volatile LAS int* tab = (volatile LAS int*)(F.lds + TAB_OFF);
    const float* gain = P.moe_norm + layer * D;
    const int gw = F.vcu * NWAVES + F.wave, NGW = F.G * NWAVES, lane = F.lane;
    for (int t = gw; t < T; t += NGW) {
        const int e1 = P.eid[t * 2], e2 = P.eid[t * 2 + 1];
        const int p1 = tab[e1] * 256 + P.pos[t * 2], p2 = tab[e2] * 256 + P.pos[t * 2 + 1];
        const GAS f32x4* xr = (const GAS f32x4*)(P.out + (size_t)t * D) + lane;
        const GAS f32x4* gr = (const GAS f32x4*)gain + lane;
        const float rstd = P.rstd[t];
        GAS unsigned long long* o1 = (GAS unsigned long long*)(P.ha + (size_t)p1 * D) + lane;
        GAS unsigned long long* o2 = (GAS unsigned long long*)(P.ha + (size_t)p2 * D) + lane;
#pragma unroll
        for (int j = 0; j < 4; ++j) { const f32x4 v = xr[64 * j], g = gr[64 * j];
            const unsigned long long q = (unsigned long long)pk2(v.x * rstd * g.x, v.y * rstd * g.y) | ((unsigned long long)pk2(v.z * rstd * g.z, v.w * rstd * g.w) << 32);
            o1[64 * j] = q; o2[64 * j] = q; }
        if (lane == 0) { P.pos[t * 2] = p1; P.pos[t * 2 + 1] = p2; }
    }
}

struct ListOrder {
    int code[4]; int n, npn; const char* A; const char* Bt; size_t tstep;
    __device__ __forceinline__ bool next(int i, pg8::Unit& o) const {
        if (i >= n) return false;
        const int c = (i == 0) ? code[0] : (i == 1) ? code[1] : (i == 2) ? code[2] : code[3];
        const int tt = c >> 8, e = (c >> 3) & 31, pn = c & 7;
        o.pm = tt; o.pn = pn; o.A = A + (size_t)tt * tstep; o.B = Bt + (size_t)(e * npn + pn) * tstep; return true;
    }
};
DEV void moe_units(Frame& F, ListOrder& L, int npn, const bf16* A, const bf16* Bt, int K) {
    volatile LAS int* tab = (volatile LAS int*)(F.lds + TAB_OFF);
    const int ntile = tab[32], total = ntile * npn;
    L.tstep = (size_t)256 * K * 2; L.A = (const char*)A; L.Bt = (const char*)Bt; L.npn = npn;
    int n = 0;
#pragma unroll
    for (int i = 0; i < 4; ++i) {
        const int Lx = i * F.G + F.vcu;
        int code = 0;
        if (Lx < total) {
            const int tt = Lx / npn, pn = Lx % npn;
            int e = 0;
            for (int q = 1; q < 32; ++q) e += (tt >= tab[q]) ? 1 : 0;
            code = (tt << 8) | (e << 3) | pn;
            n = i + 1;
        }
        L.code[i] = __builtin_amdgcn_readfirstlane(code);
    }
    L.n = __builtin_amdgcn_readfirstlane(n);
}

DEV void fp_moe_gu(const Params& P, Frame& F, int layer) {
    moe_table(P, F, layer);
    ListOrder L; moe_units(F, L, 2, P.ha, P.wgut, D);
    pg8::EpiSiluMul E{P.hid, 256};
    pg8::gemm_phase(F.lds, D, L, E, F.tid);
}
DEV void fp_moe_dn(const Params& P, Frame& F, int layer) {
    moe_table(P, F, layer);
    ListOrder L; moe_units(F, L, 4, P.hid, P.wdt, 256);
    pg8::EpiStoreBf16 E{P.ha, D};
    pg8::gemm_phase(F.lds, 256, L, E, F.tid);
}
DEV void fp_combine(const Params& P, Frame& F, const float* gain2, bf16* xn) {
    const int gw = F.vcu * NWAVES + F.wave, NGW = F.G * NWAVES, lane = F.lane;
    for (int t = gw; t < T; t += NGW) {
        const int p1 = P.pos[t * 2], p2 = P.pos[t * 2 + 1];
        const float w1 = P.ew[t * 2], w2 = P.ew[t * 2 + 1];
        GAS f32x4* xr = (GAS f32x4*)(P.out + (size_t)t * D) + lane;
        const GAS unsigned long long* y1 = (const GAS unsigned long long*)(P.ha + (size_t)p1 * D) + lane;
        const GAS unsigned long long* y2 = (const GAS unsigned long long*)(P.ha + (size_t)p2 * D) + lane;
        f32x4 v[4]; float s = 0.f;
#pragma unroll
        for (int j = 0; j < 4; ++j) {
            v[j] = xr[64 * j];
            const unsigned long long a = y1[64 * j], b = y2[64 * j];
            v[j].x += w1 * u2f((unsigned)(a & 0xffffu) << 16) + w2 * u2f((unsigned)(b & 0xffffu) << 16);
            v[j].y += w1 * u2f((unsigned)((a >> 16) & 0xffffu) << 16) + w2 * u2f((unsigned)((b >> 16) & 0xffffu) << 16);
            v[j].z += w1 * u2f((unsigned)((a >> 32) & 0xffffu) << 16) + w2 * u2f((unsigned)((b >> 32) & 0xffffu) << 16);
            v[j].w += w1 * u2f((unsigned)((a >> 48) & 0xffffu) << 16) + w2 * u2f((unsigned)((b >> 48) & 0xffffu) << 16);
            xr[64 * j] = v[j];
            s += (v[j].x * v[j].x + v[j].y * v[j].y) + (v[j].z * v[j].z + v[j].w * v[j].w);
        }
        if (xn) {
            const float rstd = 1.0f / sqrtf(wave_sum(s) * (1.f / D) + EPS);
            const GAS f32x4* gr = (const GAS f32x4*)gain2 + lane;
            GAS unsigned long long* o8 = (GAS unsigned long long*)(xn + (size_t)t * D) + lane;
#pragma unroll
            for (int j = 0; j < 4; ++j) { const f32x4 g = gr[64 * j];
                o8[64 * j] = (unsigned long long)pk2(v[j].x * rstd * g.x, v[j].y * rstd * g.y) | ((unsigned long long)pk2(v[j].z * rstd * g.z, v[j].w * rstd * g.w) << 32); }
        }
    }
}

namespace att {
typedef float f32x16 __attribute__((ext_vector_type(16)));
typedef short s16x4 __attribute__((ext_vector_type(4)));
typedef short v4i16_t __attribute__((ext_vector_type(4)));
typedef LAS const char* lptr;
constexpr float LOG2E = 1.4426950408889634f;
constexpr int KS0 = 0, VS0 = 16384, SLOT = 8192;
constexpr float MNEG = -1e30f;

struct TileRegs { v4u k, v; };
DEV void tile_load(TileRegs& R, const bf16* Kg, const bf16* Vg, int pitch, int k0, int tid) {
    const int w = tid >> 6, lane = tid & 63;
    R.k = *(const GAS v4u*)(Kg + (size_t)(k0 + lane) * pitch + w * 8);
    R.v = *(const GAS v4u*)(Vg + (size_t)(k0 + 16 * (w & 3) + (lane >> 2)) * pitch + (w >> 2) * 32 + (lane & 3) * 8);
}
DEV void tile_store(LAS unsigned char* lds, int slot, const TileRegs& R, int tid) {
    *(LAS v4u*)(lds + KS0 + slot * SLOT + tid * 16) = R.k;
    *(LAS v4u*)(lds + VS0 + slot * SLOT + tid * 16) = R.v;
}
DEV void qk_tile(f32x16& p0, f32x16& p1, lptr Kslot, const bf16x8 (&qr)[4], int r32, int hi) {
    lptr kb = Kslot + hi * 1024 + r32 * 16;
    p0 = f32x16{}; p1 = f32x16{};
#pragma unroll
    for (int d0 = 0; d0 < 4; ++d0) {
        const bf16x8 b0 = *(const LAS bf16x8*)(kb + d0 * 2048);
        const bf16x8 b1 = *(const LAS bf16x8*)(kb + d0 * 2048 + 512);
        p0 = __builtin_amdgcn_mfma_f32_32x32x16_bf16(b0, qr[d0], p0, 0, 0, 0);
        p1 = __builtin_amdgcn_mfma_f32_32x32x16_bf16(b1, qr[d0], p1, 0, 0, 0);
    }
}
DEV s16x4 vtr(lptr p) { return __builtin_bit_cast(s16x4, __builtin_amdgcn_ds_read_tr16_b64_v4i16((LAS v4i16_t*)p)); }
DEV unsigned cvtpk(float lo, float hi) { unsigned r; asm volatile("v_cvt_pk_bf16_f32 %0, %1, %2" : "=v"(r) : "v"(lo), "v"(hi)); return r; }
DEV void pv_tile(f32x16 (&o)[2], lptr Vslot, const f32x16& p0, const f32x16& p1, int lane) {
    const int hi = lane >> 5;
    lptr vp = Vslot + ((lane >> 4) & 1) * 32 + (lane & 3) * 8 + (4 * hi + ((lane & 15) >> 2)) * 64;
    bf16x8 pf[4];
#pragma unroll
    for (int ks = 0; ks < 4; ++ks) {
        const f32x16& p = (ks < 2) ? p0 : p1; const int b = (ks & 1) * 8;
        v4u w; w.x = cvtpk(p[b + 0], p[b + 1]); w.y = cvtpk(p[b + 2], p[b + 3]); w.z = cvtpk(p[b + 4], p[b + 5]); w.w = cvtpk(p[b + 6], p[b + 7]);
        pf[ks] = __builtin_bit_cast(bf16x8, w);
    }
#pragma unroll
    for (int d0 = 0; d0 < 2; ++d0)
#pragma unroll
        for (int ks = 0; ks < 4; ++ks) {
            const s16x4 lo = vtr(vp + d0 * 4096 + ks * 1024), hh = vtr(vp + d0 * 4096 + ks * 1024 + 512);
            const bf16x8 vf = (bf16x8){lo[0], lo[1], lo[2], lo[3], hh[0], hh[1], hh[2], hh[3]};
            o[d0] = __builtin_amdgcn_mfma_f32_32x32x16_bf16(vf, pf[ks], o[d0], 0, 0, 0);
        }
}
DEV float lane_swap_max(float m) {
    auto rr = __builtin_amdgcn_permlane32_swap(__float_as_uint(m), __float_as_uint(m), false, false);
    return fmaxf(__uint_as_float(rr[0]), __uint_as_float(rr[1]));
}
DEV float lane_swap_sum(float m) {
    auto rr = __builtin_amdgcn_permlane32_swap(__float_as_uint(m), __float_as_uint(m), false, false);
    return __uint_as_float(rr[0]) + __uint_as_float(rr[1]);
}
DEV float lane_partner(float m, int hi) {
    auto rr = __builtin_amdgcn_permlane32_swap(__float_as_uint(m), __float_as_uint(m), false, false);
    return hi ? __uint_as_float(rr[0]) : __uint_as_float(rr[1]);
}

constexpr float M0 = 16.0f;
struct SoftState { float l; f32x16 o[2]; };
DEV void soft_reset(SoftState& s) { s.l = 0.f; s.o[0] = f32x16{}; s.o[1] = f32x16{}; }

DEV void soft_tile(SoftState& st, f32x16& p0, f32x16& p1, float s2, float k0rel_f, int klo, int klim, bool need_mask, lptr Vslot, int lane) {
    const int hi = lane >> 5;
    const float c1 = 0.125f * LOG2E;
    const float base = s2 * (k0rel_f + (float)(4 * hi)) - M0;
    float ls0 = 0.f, ls1 = 0.f;
    if (need_mask) {
#pragma unroll
        for (int r = 0; r < 16; ++r) {
            const int kr = (r & 3) + 8 * (r >> 2);
            const float x0 = __builtin_amdgcn_exp2f(fmaf(p0[r], c1, fmaf(s2, (float)kr, base)));
            const float x1 = __builtin_amdgcn_exp2f(fmaf(p1[r], c1, fmaf(s2, (float)(kr + 32), base)));
            p0[r] = (kr > klo && kr <= klim) ? x0 : 0.f; p1[r] = (kr + 32 > klo && kr + 32 <= klim) ? x1 : 0.f;
            ls0 += p0[r]; ls1 += p1[r];
        }
    } else {
#pragma unroll
        for (int r = 0; r < 16; ++r) {
            const int kr = (r & 3) + 8 * (r >> 2);
            p0[r] = __builtin_amdgcn_exp2f(fmaf(p0[r], c1, fmaf(s2, (float)kr, base)));
            p1[r] = __builtin_amdgcn_exp2f(fmaf(p1[r], c1, fmaf(s2, (float)(kr + 32), base)));
            ls0 += p0[r]; ls1 += p1[r];
        }
    }
    st.l += ls0 + ls1;
    pv_tile(st.o, Vslot, p0, p1, lane);
}

DEV void store_ot(const f32x16 (&o)[2], float f, bf16* orow, int hi) {
#pragma unroll
    for (int d0 = 0; d0 < 2; ++d0)
#pragma unroll
        for (int g = 0; g < 4; ++g) {
            const unsigned a = cvtpk(o[d0][4 * g] * f, o[d0][4 * g + 1] * f), b = cvtpk(o[d0][4 * g + 2] * f, o[d0][4 * g + 3] * f);
            *(GAS unsigned long long*)(orow + 32 * d0 + 8 * g + 4 * hi) = (unsigned long long)a | ((unsigned long long)b << 32);
        }
}
DEV void load_q(bf16x8 (&qr)[4], const bf16* qrow, int hi) {
#pragma unroll
    for (int d0 = 0; d0 < 4; ++d0) qr[d0] = *(const GAS bf16x8*)(qrow + 16 * d0 + 8 * hi);
}

template <class MaskF>
DEV void run_segment(Frame& F, SoftState& st, const bf16x8 (&qr)[4], const bf16* Kg, const bf16* Vg, int pitch, unsigned long long tmask, float s2, int qpos, const MaskF& mf) {
    const int tid = F.tid, lane = F.lane, r32 = lane & 31, hi = lane >> 5;
    if (tmask == 0ull) return;
#define NEXT_TILE(var) do { if (tmask) { var = __builtin_ctzll(tmask); tmask &= tmask - 1ull; } else var = -1; } while (0)
#define SEG_COMPUTE(t, slot) do { int klo, klim; mf((t), klo, klim); \
        if (__any(klim >= 0 && klo < 60 && klim > klo)) { const bool need_mask = __any(klo >= 0 || klim < 60); f32x16 p0, p1; \
            qk_tile(p0, p1, (lptr)(F.lds + KS0 + (slot) * SLOT), qr, r32, hi); \
            soft_tile(st, p0, p1, s2, (float)((t) * 64 - qpos), klo, klim, need_mask, (lptr)(F.lds + VS0 + (slot) * SLOT), lane); } } while (0)
    int ta, tb, tc, td;
    NEXT_TILE(ta); NEXT_TILE(tb);
    TileRegs RA, RB; tile_load(RA, Kg, Vg, pitch, ta * 64, tid); if (tb >= 0) tile_load(RB, Kg, Vg, pitch, tb * 64, tid);
    for (;;) {
        tile_store(F.lds, 0, RA, tid);
        NEXT_TILE(tc); if (tc >= 0) tile_load(RA, Kg, Vg, pitch, tc * 64, tid);
        __syncthreads();
        SEG_COMPUTE(ta, 0);
        if (tb < 0) break;
        tile_store(F.lds, 1, RB, tid);
        NEXT_TILE(td); if (td >= 0) tile_load(RB, Kg, Vg, pitch, td * 64, tid);
        __syncthreads();
        SEG_COMPUTE(tb, 1);
        if (tc < 0) break;
        ta = tc; tb = td;
    }
    __syncthreads();
#undef NEXT_TILE
#undef SEG_COMPUTE
}
DEV unsigned long long tile_range(int t0, int t1) { return (t1 < t0) ? 0ull : ((~0ull >> (63 - (t1 - t0))) << t0); }
}

DEV void headnorm_group(bf16* row, int off, int nheads, const float* g, int lane) {
    const int hg = lane >> 3, ch = lane & 7;
    if (hg < nheads) {
        GAS v4u* p = (GAS v4u*)(row + off + hg * 64 + ch * 8);
        const v4u x = *p;
        float v[8] = {u2f(x.x << 16), u2f(x.x & 0xffff0000u), u2f(x.y << 16), u2f(x.y & 0xffff0000u), u2f(x.z << 16), u2f(x.z & 0xffff0000u), u2f(x.w << 16), u2f(x.w & 0xffff0000u)};
        float ss = 0.f;
#pragma unroll
        for (int j = 0; j < 8; ++j) ss += v[j] * v[j];
        ss += __shfl_xor(ss, 1); ss += __shfl_xor(ss, 2); ss += __shfl_xor(ss, 4);
        const float r = 1.0f / sqrtf(ss * (1.0f / 64) + EPS);
        const f32x4 g0 = *(const GAS f32x4*)(g + ch * 8), g1 = *(const GAS f32x4*)(g + ch * 8 + 4);
        v4u o; o.x = pk2(v[0] * r * g0.x, v[1] * r * g0.y); o.y = pk2(v[2] * r * g0.z, v[3] * r * g0.w); o.z = pk2(v[4] * r * g1.x, v[5] * r * g1.y); o.w = pk2(v[6] * r * g1.z, v[7] * r * g1.w);
        *p = o;
    }
}
DEV void fp_headnorm(const Params& P, Frame& F, int layer) {
    const int gw = F.vcu * NWAVES + F.wave, NGW = F.G * NWAVES, lane = F.lane;
    for (int t = gw; t < T; t += NGW) {
        bf16* row = P.proj + (size_t)t * LDP;
        if (layer == 0) {
            headnorm_group(row, 0, 8, P.ev_q_norm, lane);
            headnorm_group(row, 512, 2, P.ev_k_norm, lane);
        } else {
            headnorm_group(row, 0, 8, P.od_c_q_norm, lane);
            headnorm_group(row, 512, 8, P.od_c_k_norm, lane);
            headnorm_group(row, 1536, 8, P.od_d_q_norm, lane);
            headnorm_group(row, 2304, 2, P.od_d_k_norm + 64, lane);
            headnorm_group(row, 2560, 2, P.od_d_k_norm + 128, lane);
        }
    }
}

DEV void fp_prep1(const Params& P, Frame& F) {
    const int gw = F.vcu * NWAVES + F.wave, NGW = F.G * NWAVES, lane = F.lane;
    for (int i = gw; i < NB * 64; i += NGW) {
        const int n = i & 7, h = (i >> 3) & 7, b = i >> 6;
        const bf16* kp = P.proj + ((size_t)b * S + n * 256) * LDP + 512 + h * 64 + lane;
        float s0 = 0.f, s1 = 0.f, s2 = 0.f, s3 = 0.f;
#pragma unroll 4
        for (int j = 0; j < 256; j += 4) { s0 += bf2f(kp[(size_t)j * LDP]); s1 += bf2f(kp[(size_t)(j + 1) * LDP]); s2 += bf2f(kp[(size_t)(j + 2) * LDP]); s3 += bf2f(kp[(size_t)(j + 3) * LDP]); }
        P.kmean[(size_t)i * 64 + lane] = ((s0 + s1) + (s2 + s3)) * (1.0f / 256);
    }
    const int n2 = 2 * NB * 2 * 32;
    for (int i = gw; i < n2; i += NGW) {
        const int ng = i & 31, hkv = (i >> 5) & 1, b = (i >> 6) % NB, which = i / (64 * NB);
        const int n0 = ng * 4;
        const float* pos = P.od_cmp_pos + which * 32 * 64;
        const float* wq = P.od_cmp_w + (size_t)which * 32 * 64 * 64 + lane;
        const bf16* xp = P.proj + ((size_t)b * S + n0 * 16) * LDP + (which ? 2176 : 2048) + hkv * 64 + lane;
        float a[4] = {0.f, 0.f, 0.f, 0.f};
        for (int l = 0; l < 32; ++l) {
            const float pl = pos[l * 64 + lane];
            unsigned xv[4];
#pragma unroll
            for (int j = 0; j < 4; ++j) { const int tok = n0 * 16 + j * 16 + l; xv[j] = f2u((tok < S ? bf2f(xp[(size_t)(j * 16 + l) * LDP]) : 0.f) + pl); }
            const float* wl = wq + (size_t)l * 64 * 64;
#pragma unroll
            for (int d0 = 0; d0 < 64; d0 += 16) {
                float wv[16];
#pragma unroll
                for (int dd = 0; dd < 16; ++dd) wv[dd] = wl[(d0 + dd) * 64];
#pragma unroll
                for (int dd = 0; dd < 16; ++dd)
#pragma unroll
                    for (int j = 0; j < 4; ++j) a[j] += u2f((unsigned)__builtin_amdgcn_readlane((int)xv[j], d0 + dd)) * wv[dd];
            }
        }
#pragma unroll
        for (int j = 0; j < 4; ++j) {
            const int n = n0 + j;
            float acc = a[j];
            if (which == 0) { const float rs = 1.0f / sqrtf(wave_sum(acc * acc) * (1.0f / 64) + EPS); acc *= rs * P.od_d_k_norm[lane]; }
            if (n < NCMP) P.kvcmp[(((size_t)(which * NB + b) * NCMP + n) * 2 + hkv) * 64 + lane] = f2bf(acc);
        }
    }
}

DEV void sb_tile(att::f32x16& p0, att::f32x16& p1, float& carry, int lim, int hi) {
    using namespace att;
    const float c1 = 0.125f * LOG2E;
    f32x16 k0, k1;
    float cs[2][4];
#pragma unroll
    for (int hf = 0; hf < 2; ++hf)
#pragma unroll
        for (int g = 0; g < 4; ++g) {
            float s = 0.f;
#pragma unroll
            for (int i = 0; i < 4; ++i) {
                const int r = 4 * g + i, kr = i + 8 * g + 32 * hf;
                const float z2 = (hf ? p1[r] : p0[r]) * c1;
                const float e = __builtin_amdgcn_exp2f(-fabsf(z2));
                const float ls2 = fminf(z2, 0.f) - __builtin_amdgcn_logf(1.0f + e);
                const bool ok = kr < lim;
                const float lk2 = ok ? (ls2 - z2) : 0.f;
                if (hf) { p1[r] = ok ? ls2 : MNEG; k1[r] = lk2; } else { p0[r] = ok ? ls2 : MNEG; k0[r] = lk2; }
                s += lk2;
            }
            cs[hf][g] = s;
        }
    float run = carry;
#pragma unroll
    for (int hf = 1; hf >= 0; --hf)
#pragma unroll
        for (int g = 3; g >= 0; --g) {
            const float mine = cs[hf][g], other = lane_partner(mine, hi);
            float suf = hi ? run : run + other;
            run += mine + other;
#pragma unroll
            for (int i = 3; i >= 0; --i) {
                const int r = 4 * g + i;
                if (hf) { p1[r] = __builtin_amdgcn_exp2f(p1[r] + suf); suf += k1[r]; } else { p0[r] = __builtin_amdgcn_exp2f(p0[r] + suf); suf += k0[r]; }
            }
        }
    carry = run;
}

DEV void fp_attn0(const Params& P, Frame& F) {
    using namespace att;
    const int tid = F.tid, lane = F.lane, r32 = lane & 31, hi = lane >> 5, w = F.wave;
    for (int u = F.vcu; u < 512; u += F.G) {
        {
            const int b = u >> 6, h = (u >> 3) & 7, blk = u & 7;
            const bf16* base = P.proj + (size_t)b * S * LDP;
            const int q = blk * 256 + w * 32 + r32;
            bf16x8 qr[4]; load_q(qr, base + (size_t)q * LDP + 768 + h * 64, hi);
            const bf16* Kg = base + 1280 + h * 64; const bf16* Vg = base + 1792 + h * 64;
            f32x16 o[2]; o[0] = f32x16{}; o[1] = f32x16{};
            float carry = 0.f;
            const int tmax = blk * 4 + 3;
            const int tw = (blk * 256 + w * 32 + 31) >> 6;
            volatile LAS int* flag = (volatile LAS int*)(F.lds + 32768);
            if (tid < 3) flag[tid] = 0;
            TileRegs R; tile_load(R, Kg, Vg, LDP, tmax * 64, tid);
            int slot = 0; bool wave_done = false;
            for (int t = tmax; t >= 0; --t) {
                tile_store(F.lds, slot, R, tid);
                if (t > 0) tile_load(R, Kg, Vg, LDP, (t - 1) * 64, tid);
                __syncthreads();
                if (t < tmax && flag[(t + 1) % 3] == 0) break;
                if (tid == 0) flag[(t + 2) % 3] = 0;
                if (!wave_done && t <= tw) {
                    f32x16 p0, p1;
                    qk_tile(p0, p1, (lptr)(F.lds + KS0 + slot * SLOT), qr, r32, hi);
                    sb_tile(p0, p1, carry, q - t * 64 - 4 * hi, hi);
                    pv_tile(o, (lptr)(F.lds + VS0 + slot * SLOT), p0, p1, lane);
                    if (__all(carry < -150.f)) wave_done = true;
                }
                if (!wave_done && lane == 0) flag[t % 3] = 1;
                slot ^= 1;
            }
            __syncthreads();
            store_ot(o, 1.0f, P.o + (size_t)(b * S + q) * D + 512 + h * 64, hi);
        }
    }
    asm volatile("" ::: "memory");
    for (int u = 512 + F.vcu; u < 1024; u += F.G) {
        {
            const int v = u - 512, b = v >> 6, hkv = (v >> 5) & 1, c = v & 31;
            const bf16* base = P.proj + (size_t)b * S * LDP;
            const int hh = hkv * 4 + (w >> 1), q = c * 64 + (w & 1) * 32 + r32;
            bf16x8 qr[4]; load_q(qr, base + (size_t)q * LDP + hh * 64, hi);
            const float sl = exp2f(-(float)(hh + 1)), s2 = sl * LOG2E;
            SoftState st; soft_reset(st);
            const int t0 = c - 2 < 0 ? 0 : c - 2;
            run_segment(F, st, qr, base + 512 + hkv * 64, base + 640 + hkv * 64, LDP, tile_range(t0, c), s2, q,
                        [&](int t, int& klo, int& klim) { klim = q - t * 64 - 4 * hi; klo = klim - 128; });
            const float den = lane_swap_sum(st.l) + __builtin_amdgcn_exp2f(P.ev_sink[hh] * LOG2E - M0);
            store_ot(st.o, 1.0f / den, P.o + (size_t)(b * S + q) * D + hh * 64, hi);
        }
    }
}

DEV void fp_attn1(const Params& P, Frame& F) {
    using namespace att;
    const int lane = F.lane, r32 = lane & 31, hi = lane >> 5, w = F.wave;
    for (int u = F.vcu; u < 512; u += F.G) {
        {
            const int v = u & 255, bh = v >> 2, blk = (u < 256) ? (v & 3) : 7 - (v & 3);
            const int b = bh >> 3, h = bh & 7;
            const bf16* base = P.proj + (size_t)b * S * LDP;
            const int q = blk * 256 + w * 32 + r32;
            bf16x8 qr[4]; load_q(qr, base + (size_t)q * LDP + h * 64, hi);
            const float sl = exp2f(-(float)(h + 1)), s2 = sl * LOG2E;
            float gt[8];
#pragma unroll
            for (int n = 0; n < 8; ++n) {
                float g = 0.f;
                if (n < blk) {
                    const float* km = P.kmean + ((size_t)(b * 8 + h) * 8 + n) * 64;
#pragma unroll
                    for (int d0 = 0; d0 < 4; ++d0)
#pragma unroll
                        for (int j = 0; j < 8; ++j) g += bf2f((bf16)qr[d0][j]) * km[16 * d0 + 8 * hi + j];
                }
                g = lane_swap_sum(g);
                gt[n] = n < blk ? g : NEG;
            }
            unsigned sel = 0;
#pragma unroll
            for (int n = 0; n < 8; ++n) {
                int rank = 0;
#pragma unroll
                for (int k = 0; k < 8; ++k) rank += (gt[k] > gt[n] || (gt[k] == gt[n] && k < n)) ? 1 : 0;
                if (rank < 3 && n < blk) sel |= 1u << n;
            }
            SoftState st; soft_reset(st);
            run_segment(F, st, qr, base + 512 + h * 64, base + 1024 + h * 64, LDP, tile_range(0, blk * 4 + 3), s2, q,
                        [&](int t, int& klo, int& klim) { const int n = t >> 2; klo = -1;
                            if (n < blk) klim = ((sel >> n) & 1) ? 63 : -1; else klim = q - t * 64 - 4 * hi; });
            const float l = lane_swap_sum(st.l);
            store_ot(st.o, 1.0f / l, P.o + (size_t)(b * S + q) * D + h * 64, hi);
        }
    }
    asm volatile("" ::: "memory");
    for (int u = 512 + F.vcu; u < 1024; u += F.G) {
        {
            const int v = u & 255, bk = v >> 4, c = (u < 768) ? (v & 15) : 31 - (v & 15);
            const int b = bk >> 1, hkv = bk & 1;
            const bf16* base = P.proj + (size_t)b * S * LDP;
            const int h = hkv * 4 + (w >> 1), q = c * 64 + (w & 1) * 32 + r32, t = b * S + q;
            bf16x8 qr[4]; load_q(qr, base + (size_t)q * LDP + 1536 + h * 64, hi);
            const float sl = exp2f(-(float)(h + 1)), s2 = sl * LOG2E;
            const bf16* grow = base + (size_t)q * LDP + 2816 + h * 3;
            const float g0 = 1.0f / (1.0f + __expf(-bf2f(grow[0]))), g1 = 1.0f / (1.0f + __expf(-bf2f(grow[1]))), g2 = 1.0f / (1.0f + __expf(-bf2f(grow[2])));
            LAS float* part = (LAS float*)(F.lds + 36864);
            volatile LAS unsigned long long* tot = (volatile LAS unsigned long long*)(F.lds + 36864 + 33792);
            volatile LAS unsigned* selm = (volatile LAS unsigned*)(F.lds + 36864 + 33792 + 16896);
            f32x16 fin[2];
            {
                const int ntile = c >= 16 ? 2 : 1;
                const bf16* Kc = P.kvcmp + ((size_t)(0 * NB + b) * NCMP) * 128 + hkv * 64;
                const bf16* Vc = P.kvcmp + ((size_t)(1 * NB + b) * NCMP) * 128 + hkv * 64;
                TileRegs R0, R1; tile_load(R0, Kc, Vc, 128, 0, F.tid); if (ntile == 2) tile_load(R1, Kc, Vc, 128, 64, F.tid);
                tile_store(F.lds, 0, R0, F.tid); if (ntile == 2) tile_store(F.lds, 1, R1, F.tid);
                __syncthreads();
                const int nlim = (q - 31) >> 4;
                const float c1 = 0.125f * LOG2E, s16 = 16.0f * s2;
                const float basec = s2 * (float)(31 - q) + s16 * (float)(4 * hi);
                float lsum = 0.f;
                for (int tl = 0; tl < ntile; ++tl) {
                    f32x16 x0, x1; qk_tile(x0, x1, (lptr)(F.lds + KS0 + tl * SLOT), qr, r32, hi);
                    const int klim = nlim - 64 * tl - 4 * hi; const float bt = basec + s16 * (float)(64 * tl) - M0;
#pragma unroll
                    for (int r = 0; r < 16; ++r) {
                        const int kr = (r & 3) + 8 * (r >> 2);
                        lsum += kr <= klim ? __builtin_amdgcn_exp2f(fmaf(x0[r], c1, fmaf(s16, (float)kr, bt))) : 0.f;
                        lsum += kr + 32 <= klim ? __builtin_amdgcn_exp2f(fmaf(x1[r], c1, fmaf(s16, (float)(kr + 32), bt))) : 0.f;
                    }
                }
                lsum = lane_swap_sum(lsum);
                const float inv = nlim >= 0 ? 1.0f / lsum : 0.f;
                fin[0] = f32x16{}; fin[1] = f32x16{};
                LAS float* prow = part + ((w >> 1) * 64 + (w & 1) * 32 + r32) * 33;
                float peprev = 0.f;
                for (int tl = 0; tl < ntile; ++tl) {
                    f32x16 x0, x1; qk_tile(x0, x1, (lptr)(F.lds + KS0 + tl * SLOT), qr, r32, hi);
                    const int klim = nlim - 64 * tl - 4 * hi; const float bt = basec + s16 * (float)(64 * tl) - M0;
#pragma unroll
                    for (int r = 0; r < 16; ++r) {
                        const int kr = (r & 3) + 8 * (r >> 2);
                        x0[r] = kr <= klim ? __builtin_amdgcn_exp2f(fmaf(x0[r], c1, fmaf(s16, (float)kr, bt))) * inv : 0.f;
                        x1[r] = kr + 32 <= klim ? __builtin_amdgcn_exp2f(fmaf(x1[r], c1, fmaf(s16, (float)(kr + 32), bt))) * inv : 0.f;
                    }
#pragma unroll
                    for (int ix = 0; ix < 8; ++ix) {
                        const int g = ix & 3;
                        const float C = (ix < 4) ? (x0[4 * g] + x0[4 * g + 1]) + (x0[4 * g + 2] + x0[4 * g + 3]) : (x1[4 * g] + x1[4 * g + 1]) + (x1[4 * g + 2] + x1[4 * g + 3]);
                        const float pe = lane_partner((ix < 4) ? x0[4 * g + 3] : x1[4 * g + 3], hi);
                        prow[2 * (8 * tl + ix) + hi] = C + (hi ? pe : peprev);
                        peprev = pe;
                    }
                    pv_tile(fin, (lptr)(F.lds + VS0 + tl * SLOT), x0, x1, lane);
                }
#pragma unroll
                for (int r = 0; r < 16; ++r) { fin[0][r] *= g0; fin[1][r] *= g0; }
            }
            __syncthreads();
            {
                const int ql = F.tid >> 3, jg = F.tid & 7;
#pragma unroll
                for (int jj = 0; jj < 4; ++jj) {
                    const int j = 4 * jg + jj;
                    float sc = ((part[(0 * 64 + ql) * 33 + j] + part[(1 * 64 + ql) * 33 + j]) + part[(2 * 64 + ql) * 33 + j]) + part[(3 * 64 + ql) * 33 + j];
                    const bool forced = (j == 0) || (j == c) || (j == c - 1);
                    sc = (j <= c) ? sc + (forced ? 1000.0f : 0.0f) : NEG;
                    const unsigned ub = f2u(sc), ord = ub ^ ((ub >> 31) ? 0xffffffffu : 0x80000000u);
                    tot[ql * 33 + j] = ((unsigned long long)ord << 32) | (unsigned)(31 - j);
                }
                __syncthreads();
                unsigned long long mine[4];
#pragma unroll
                for (int jj = 0; jj < 4; ++jj) mine[jj] = tot[ql * 33 + 4 * jg + jj];
                int rank[4] = {0, 0, 0, 0};
                for (int k = 0; k < 32; ++k) {
                    const unsigned long long sk = tot[ql * 33 + k];
#pragma unroll
                    for (int jj = 0; jj < 4; ++jj) rank[jj] += (sk > mine[jj]) ? 1 : 0;
                }
                unsigned bits = 0;
#pragma unroll
                for (int jj = 0; jj < 4; ++jj) if (rank[jj] < 16 && 4 * jg + jj <= c) bits |= 1u << (4 * jg + jj);
                bits |= __shfl_xor(bits, 1); bits |= __shfl_xor(bits, 2); bits |= __shfl_xor(bits, 4);
                if (jg == 0) selm[ql] = bits;
                unsigned ub = bits; ub |= __shfl_xor(ub, 8); ub |= __shfl_xor(ub, 16); ub |= __shfl_xor(ub, 32);
                if (lane == 0) selm[64 + w] = ub;
            }
            __syncthreads();
            const unsigned mask = selm[(w & 1) * 32 + r32];
            const unsigned umask = ((selm[64] | selm[65]) | (selm[66] | selm[67])) | ((selm[68] | selm[69]) | (selm[70] | selm[71]));
            __syncthreads();
            LAS float* stg = (LAS float*)(F.lds + 36864) + w * 2048 + lane;
#pragma unroll
            for (int r = 0; r < 16; ++r) { stg[r * 64] = fin[0][r]; stg[(16 + r) * 64] = fin[1][r]; }
            SoftState st; soft_reset(st);
            run_segment(F, st, qr, base + 2304 + hkv * 64, base + 2432 + hkv * 64, LDP, (unsigned long long)umask, s2, q,
                        [&](int tt, int& klo, int& klim) { klo = -1; klim = ((mask >> tt) & 1) ? (q - tt * 64 - 4 * hi) : -1; });
            { const float f = g1 / lane_swap_sum(st.l);
#pragma unroll
              for (int r = 0; r < 16; ++r) { stg[r * 64] += f * st.o[0][r]; stg[(16 + r) * 64] += f * st.o[1][r]; } }
            soft_reset(st);
            run_segment(F, st, qr, base + 2560 + hkv * 64, base + 2688 + hkv * 64, LDP, tile_range(c - 8 < 0 ? 0 : c - 8, c), s2, q,
                        [&](int tt, int& klo, int& klim) { klim = q - tt * 64 - 4 * hi; klo = klim - 512; });
            { const float f = g2 / lane_swap_sum(st.l);
#pragma unroll
              for (int r = 0; r < 16; ++r) { st.o[0][r] = stg[r * 64] + f * st.o[0][r]; st.o[1][r] = stg[(16 + r) * 64] + f * st.o[1][r]; } }
            store_ot(st.o, 1.0f, P.o + (size_t)t * D + 512 + h * 64, hi);
            __syncthreads();
        }
    }
}
constexpr int NPHASE = 20;
DEV void run_phase(const Params& P, int ph, int gtid, int gsz) {
    switch (ph) {
        case 0: ph_rstd(P.x, P.rstd, gtid, gsz); break;
        case 1: ph_gemm_in(P.x, P.rstd, P.ev_norm, P.ev_w_in, EVEN_IN, P.proj, gtid, gsz); break;
        case 2: ph_headnorm0(P, gtid, gsz); break;
        case 3: ph_attn0(P, gtid, gsz); break;
        case 4: ph_gemm_out(P.o, P.ev_w_out, P.x, P.out, gtid, gsz); break;
        case 5: ph_moe_route(P, 0, gtid, gsz); break;
        case 6: ph_moe_hidden(P, 0, gtid, gsz); break;
        case 7: ph_moe_out(P, 0, gtid, gsz); break;
        case 8: ph_rstd(P.out, P.rstd, gtid, gsz); break;
        case 9: ph_gemm_in(P.out, P.rstd, P.od_norm, P.od_w_in, ODD_IN, P.proj, gtid, gsz); break;
        case 10: ph_headnorm1(P, gtid, gsz); break;
        case 11: ph_prep1(P, gtid, gsz); break;
        case 12: ph_nsa_cmp(P, gtid, gsz); break;
        case 13: ph_nsa_select(P, gtid, gsz); break;
        case 14: ph_nsa_topk(P, gtid, gsz); break;
        case 15: ph_attn1(P, gtid, gsz); break;
        case 16: ph_gemm_out(P.o, P.od_w_out, P.out, P.out, gtid, gsz); break;
        case 17: ph_moe_route(P, 1, gtid, gsz); break;
        case 18: ph_moe_hidden(P, 1, gtid, gsz); break;
        case 19: ph_moe_out(P, 1, gtid, gsz); break;
    }
}
__global__ void __launch_bounds__(256) k_naive(Params P, int ph) {
    run_phase(P, ph, blockIdx.x * blockDim.x + threadIdx.x, gridDim.x * blockDim.x);
}

enum { FP_CONV_DENSE = 0, FP_CONV_MOE0, FP_XN0, FP_INPROJ0, FP_HEADNORM0, FP_ATTN0, FP_OUTPROJ0, FP_ROUTE0, FP_GATHER0, FP_GU0, FP_DN0, FP_COMBINE0, FP_CONV_MOE1, FP_XN1, FP_INPROJ1, FP_HEADNORM1, FP_PREP1, FP_NSACMP, FP_NSASEL, FP_NSATOPK, FP_ATTN1, FP_OUTPROJ1, FP_ROUTE1, FP_GATHER1, FP_GU1, FP_DN1, FP_COMBINE1, FP_COUNT };
struct FArgs { Params p; unsigned long long mask; int li, pad; };

#ifndef PROBE_PHASE
#define PROBE_PHASE -1
#endif
constexpr int STAMP_OFF = LDSCTL_OFF + 1024;
DEV void stampk(Frame& F, int k, unsigned long long mask) {
    if (PROBE_PHASE >= 0 && F.tid == 0 && ((mask >> k) & 1ull)) ((volatile LAS unsigned*)(F.lds + STAMP_OFF))[k] = (unsigned)__builtin_amdgcn_s_memrealtime() | 1u;
}
__global__ void __launch_bounds__(NWAVES * 64, 2) k_fast(FArgs args) {
    extern __shared__ __attribute__((aligned(16))) unsigned char lds[];
    const Params& P = args.p;
    Frame F;
    F.lds = (LAS unsigned char*)lds;
    F.MISC = (volatile LAS unsigned*)(F.lds + MISC_OFF);
    F.tid = threadIdx.x; F.lane = F.tid & 63; F.wave = __builtin_amdgcn_readfirstlane(F.tid >> 6);
    F.G = gridDim.x; { const int bx = blockIdx.x; F.vcu = (F.G % 8 == 0) ? (bx % 8) * (F.G / 8) + bx / 8 : bx; }
    for (int u = F.tid; u < (LDS_BYTES - LDSCTL_OFF) / 4; u += NWAVES * 64) ((LAS unsigned*)(F.lds + LDSCTL_OFF))[u] = 0u;
    __syncthreads();
    XcdBarrier bar = xcd_barrier_post(P.ctl + CW_BAR + args.li * XCD_BAR_WORDS, F.MISC + 8);
    const unsigned long long mask = args.mask;
#ifndef DUPMASK
#define DUPMASK 0ull
#endif
#define ON(k) (refresh(F), stampk(F, (k), mask), ((mask >> (k)) & 1ull))
#define DUP(k) (((DUPMASK) >> (k)) & 1ull)
#define SEAM(k) do { if ((mask >> ((k) + 1)) != 0ull) { refresh(F); xcd_barrier(bar, F.tid); } } while (0)
    if (ON(FP_CONV_DENSE)) { fp_convert_weights(P, F, 0); fp_prep_router(P, F); fp_convert_weights(P, F, 1); fp_norm_rows(F, P.x, P.ev_norm, P.xn); if (DUP(FP_CONV_DENSE)) { refresh(F); xcd_barrier(bar, F.tid); refresh(F); fp_convert_weights(P, F, 0); fp_prep_router(P, F); fp_convert_weights(P, F, 1); fp_norm_rows(F, P.x, P.ev_norm, P.xn); } SEAM(FP_CONV_DENSE); }
    if (ON(FP_CONV_MOE0)) { fp_convert_weights(P, F, 1); if (DUP(FP_CONV_MOE0)) { refresh(F); xcd_barrier(bar, F.tid); refresh(F); fp_convert_weights(P, F, 1); } SEAM(FP_CONV_MOE0); }
    if (ON(FP_XN0)) { fp_norm_rows(F, P.x, P.ev_norm, P.xn); if (DUP(FP_XN0)) { refresh(F); xcd_barrier(bar, F.tid); refresh(F); fp_norm_rows(F, P.x, P.ev_norm, P.xn); } SEAM(FP_XN0); }
    if (ON(FP_INPROJ0)) { pg8::StaticOrder So; So.init(P.xn, P.win0t, T, EVEN_IN, D, F.G, (int)blockIdx.x);
        pg8::EpiStoreBf16 E{P.proj, LDP}; pg8::gemm_phase(F.lds, D, So, E, F.tid); if (DUP(FP_INPROJ0)) { refresh(F); xcd_barrier(bar, F.tid); refresh(F); pg8::StaticOrder So; So.init(P.xn, P.win0t, T, EVEN_IN, D, F.G, (int)blockIdx.x);
        pg8::EpiStoreBf16 E{P.proj, LDP}; pg8::gemm_phase(F.lds, D, So, E, F.tid); } SEAM(FP_INPROJ0); }
    if (ON(FP_HEADNORM0)) { fp_headnorm(P, F, 0); if (DUP(FP_HEADNORM0)) { refresh(F); xcd_barrier(bar, F.tid); refresh(F); fp_headnorm(P, F, 0); } SEAM(FP_HEADNORM0); }
    if (ON(FP_ATTN0)) { fp_attn0(P, F); if (DUP(FP_ATTN0)) { refresh(F); xcd_barrier(bar, F.tid); refresh(F); fp_attn0(P, F); } SEAM(FP_ATTN0); }
    if (ON(FP_OUTPROJ0)) { pg8::StaticOrder So; So.init(P.o, P.wout0t, T, D, D, F.G, (int)blockIdx.x);
        pg8::EpiResidF32 E{P.x, P.out, D}; pg8::gemm_phase(F.lds, D, So, E, F.tid); if (DUP(FP_OUTPROJ0)) { refresh(F); xcd_barrier(bar, F.tid); refresh(F); pg8::StaticOrder So; So.init(P.o, P.wout0t, T, D, D, F.G, (int)blockIdx.x);
        pg8::EpiResidF32 E{P.x, P.out, D}; pg8::gemm_phase(F.lds, D, So, E, F.tid); } SEAM(FP_OUTPROJ0); }
    if (ON(FP_ROUTE0)) { fp_route(P, F, 0); if (DUP(FP_ROUTE0)) { refresh(F); xcd_barrier(bar, F.tid); refresh(F); fp_route(P, F, 0); } SEAM(FP_ROUTE0); }
    if (ON(FP_GATHER0)) { fp_gather(P, F, 0); if (DUP(FP_GATHER0)) { refresh(F); xcd_barrier(bar, F.tid); refresh(F); fp_gather(P, F, 0); } SEAM(FP_GATHER0); }
    if (ON(FP_GU0)) { fp_moe_gu(P, F, 0); if (DUP(FP_GU0)) { refresh(F); xcd_barrier(bar, F.tid); refresh(F); fp_moe_gu(P, F, 0); } SEAM(FP_GU0); }
    if (ON(FP_DN0)) { fp_moe_dn(P, F, 0); if (DUP(FP_DN0)) { refresh(F); xcd_barrier(bar, F.tid); refresh(F); fp_moe_dn(P, F, 0); } SEAM(FP_DN0); }
    if (ON(FP_COMBINE0)) { fp_combine(P, F, P.od_norm, P.xn); if (DUP(FP_COMBINE0)) { refresh(F); xcd_barrier(bar, F.tid); refresh(F); fp_combine(P, F, P.od_norm, P.xn); } SEAM(FP_COMBINE0); }
    if (ON(FP_CONV_MOE1)) { fp_convert_weights(P, F, 2); if (DUP(FP_CONV_MOE1)) { refresh(F); xcd_barrier(bar, F.tid); refresh(F); fp_convert_weights(P, F, 2); } SEAM(FP_CONV_MOE1); }
    if (ON(FP_XN1)) { fp_norm_rows(F, P.out, P.od_norm, P.xn); if (DUP(FP_XN1)) { refresh(F); xcd_barrier(bar, F.tid); refresh(F); fp_norm_rows(F, P.out, P.od_norm, P.xn); } SEAM(FP_XN1); }
    if (ON(FP_INPROJ1)) { pg8::StaticOrder So; So.init(P.xn, P.win1t, T, LDP, D, F.G, (int)blockIdx.x);
        pg8::EpiStoreBf16 E{P.proj, LDP}; pg8::gemm_phase(F.lds, D, So, E, F.tid); if (DUP(FP_INPROJ1)) { refresh(F); xcd_barrier(bar, F.tid); refresh(F); pg8::StaticOrder So; So.init(P.xn, P.win1t, T, LDP, D, F.G, (int)blockIdx.x);
        pg8::EpiStoreBf16 E{P.proj, LDP}; pg8::gemm_phase(F.lds, D, So, E, F.tid); } SEAM(FP_INPROJ1); }
    if (ON(FP_HEADNORM1)) { fp_headnorm(P, F, 1); if (DUP(FP_HEADNORM1)) { refresh(F); xcd_barrier(bar, F.tid); refresh(F); fp_headnorm(P, F, 1); } SEAM(FP_HEADNORM1); }
    if (ON(FP_PREP1)) { fp_prep1(P, F); fp_convert_weights(P, F, 2); if (DUP(FP_PREP1)) { refresh(F); xcd_barrier(bar, F.tid); refresh(F); fp_prep1(P, F); fp_convert_weights(P, F, 2); } SEAM(FP_PREP1); }
    if (ON(FP_NSACMP)) { ph_nsa_cmp(P, F.vcu * NWAVES * 64 + F.tid, F.G * NWAVES * 64); if (DUP(FP_NSACMP)) { refresh(F); xcd_barrier(bar, F.tid); refresh(F); ph_nsa_cmp(P, F.vcu * NWAVES * 64 + F.tid, F.G * NWAVES * 64); } SEAM(FP_NSACMP); }
    if (ON(FP_NSASEL)) { ph_nsa_select(P, F.vcu * NWAVES * 64 + F.tid, F.G * NWAVES * 64); if (DUP(FP_NSASEL)) { refresh(F); xcd_barrier(bar, F.tid); refresh(F); ph_nsa_select(P, F.vcu * NWAVES * 64 + F.tid, F.G * NWAVES * 64); } SEAM(FP_NSASEL); }
    if (ON(FP_NSATOPK)) { ph_nsa_topk(P, F.vcu * NWAVES * 64 + F.tid, F.G * NWAVES * 64); if (DUP(FP_NSATOPK)) { refresh(F); xcd_barrier(bar, F.tid); refresh(F); ph_nsa_topk(P, F.vcu * NWAVES * 64 + F.tid, F.G * NWAVES * 64); } SEAM(FP_NSATOPK); }
    if (ON(FP_ATTN1)) { fp_attn1(P, F); if (DUP(FP_ATTN1)) { refresh(F); xcd_barrier(bar, F.tid); refresh(F); fp_attn1(P, F); } SEAM(FP_ATTN1); }
    if (ON(FP_OUTPROJ1)) { pg8::StaticOrder So; So.init(P.o, P.wout1t, T, D, D, F.G, (int)blockIdx.x);
        pg8::EpiResidF32 E{P.out, P.out, D}; pg8::gemm_phase(F.lds, D, So, E, F.tid); if (DUP(FP_OUTPROJ1)) { refresh(F); xcd_barrier(bar, F.tid); refresh(F); pg8::StaticOrder So; So.init(P.o, P.wout1t, T, D, D, F.G, (int)blockIdx.x);
        pg8::EpiResidF32 E{P.out, P.out, D}; pg8::gemm_phase(F.lds, D, So, E, F.tid); } SEAM(FP_OUTPROJ1); }
    if (ON(FP_ROUTE1)) { fp_route(P, F, 1); if (DUP(FP_ROUTE1)) { refresh(F); xcd_barrier(bar, F.tid); refresh(F); fp_route(P, F, 1); } SEAM(FP_ROUTE1); }
    if (ON(FP_GATHER1)) { fp_gather(P, F, 1); if (DUP(FP_GATHER1)) { refresh(F); xcd_barrier(bar, F.tid); refresh(F); fp_gather(P, F, 1); } SEAM(FP_GATHER1); }
    if (ON(FP_GU1)) { fp_moe_gu(P, F, 1); if (DUP(FP_GU1)) { refresh(F); xcd_barrier(bar, F.tid); refresh(F); fp_moe_gu(P, F, 1); } SEAM(FP_GU1); }
    if (ON(FP_DN1)) { fp_moe_dn(P, F, 1); if (DUP(FP_DN1)) { refresh(F); xcd_barrier(bar, F.tid); refresh(F); fp_moe_dn(P, F, 1); } SEAM(FP_DN1); }
    if (ON(FP_COMBINE1)) { fp_combine(P, F, nullptr, nullptr); if (DUP(FP_COMBINE1)) { refresh(F); xcd_barrier(bar, F.tid); refresh(F); fp_combine(P, F, nullptr, nullptr); } SEAM(FP_COMBINE1); }
    if (PROBE_PHASE >= 0) {
        refresh(F);
        if (F.vcu == 0 && F.tid == 0) {
            volatile LAS unsigned* st = (volatile LAS unsigned*)(F.lds + STAMP_OFF);
            unsigned t1 = (unsigned)__builtin_amdgcn_s_memrealtime();
            for (int q = FP_COUNT - 1; q > PROBE_PHASE; --q) if (st[q]) t1 = st[q];
            const unsigned t0 = st[PROBE_PHASE];
            asm volatile("s_waitcnt vmcnt(0)" ::: "memory");
            P.out[0] += (float)(t1 - t0) * 0.01f;
        }
    }
#undef ON
#undef SEAM
}

static inline size_t al256(size_t x) { return (x + 255) & ~(size_t)255; }
static size_t carve(Params& p, void* d_ws) {
    char* w = (char*)d_ws;
    p.ctl = (unsigned*)w;
    p.win0t = (bf16*)(w + 1 * MiB);
    p.wout0t = (bf16*)(w + 6 * MiB);
    p.win1t = (bf16*)(w + 8 * MiB);
    p.wout1t = (bf16*)(w + 14 * MiB);
    p.wgut = (bf16*)(w + 16 * MiB);
    p.wdt = (bf16*)(w + 48 * MiB);
    p.proj = (bf16*)(w + 64 * MiB);
    p.ha = (bf16*)(w + 64 * MiB);
    p.xn = (bf16*)(w + 160 * MiB);
    p.hmid = (float*)(w + 160 * MiB);
    p.ocmp = (float*)(w + 160 * MiB);
    p.o = (bf16*)(w + 192 * MiB);
    p.hid = (bf16*)(w + 192 * MiB);
    size_t off = 224 * MiB;
    p.rstd = (float*)(w + off); off = al256(off + (size_t)T * 4);
    p.eid = (int*)(w + off); off = al256(off + (size_t)T * 2 * 4);
    p.ew = (float*)(w + off); off = al256(off + (size_t)T * 2 * 4);
    p.kmean = (float*)(w + off); off = al256(off + (size_t)NB * 8 * 8 * 64 * 4);
    p.kvcmp = (bf16*)(w + off); off = al256(off + (size_t)2 * NB * NCMP * 2 * 64 * 2);
    p.cml = (float*)(w + off); off = al256(off + (size_t)T * 8 * 2 * 4);
    p.pslc = (float*)(w + off); off = al256(off + (size_t)T * 64 * 4);
    p.selmask = (unsigned*)(w + off); off = al256(off + (size_t)T * 2 * 4);
    p.rowtok = (int*)(w + off); off = al256(off + (size_t)RMAX * 4);
    p.pos = (int*)(w + off); off = al256(off + (size_t)T * 2 * 4);
    p.wr = (bf16*)(w + off); off = al256(off + (size_t)2 * 2 * 48 * D * 2);
    return off;
}

struct Step { int fast; int n; int ph[32]; };
static const Step PLAN[] = {
    {1, 20, {FP_CONV_DENSE, FP_INPROJ0, FP_HEADNORM0, FP_ATTN0, FP_OUTPROJ0, FP_ROUTE0, FP_GATHER0, FP_GU0, FP_DN0, FP_COMBINE0, FP_INPROJ1, FP_HEADNORM1,
             FP_PREP1, FP_ATTN1, FP_OUTPROJ1, FP_ROUTE1, FP_GATHER1, FP_GU1, FP_DN1, FP_COMBINE1}},
};

extern "C" void kernel_launch(void* const* d_in, const int* in_sizes, int n_in, void* d_out, int out_size, void* d_ws, size_t ws_size,
                              hipStream_t stream) {
    Params p{};
    const float** f = (const float**)&p;
    for (int i = 0; i < 24; ++i) f[i] = (const float*)d_in[i];
    p.out = (float*)d_out;
    const size_t need = carve(p, d_ws);
    static int grid = 0;
    if (grid == 0) {
        int dev = 0, cus = 0, per_cu = 0;
        if (hipGetDevice(&dev) != hipSuccess || hipDeviceGetAttribute(&cus, hipDeviceAttributeMultiprocessorCount, dev) != hipSuccess) { grid = -1; return; }
        if (hipFuncSetAttribute((const void*)k_fast, hipFuncAttributeMaxDynamicSharedMemorySize, LDS_BYTES) != hipSuccess) { fprintf(stderr, "hipFuncSetAttribute failed\n"); grid = -1; return; }
        if (hipOccupancyMaxActiveBlocksPerMultiprocessor(&per_cu, (const void*)k_fast, NWAVES * 64, LDS_BYTES) != hipSuccess || per_cu < 1) { fprintf(stderr, "occupancy query: %d\n", per_cu); (void)hipGetLastError(); grid = -1; return; }
        grid = cus;
        if (need > ws_size) { fprintf(stderr, "workspace too small: need %zu have %zu\n", need, ws_size); grid = -1; return; }
    }
    if (grid < 0) return;
    (void)hipMemsetAsync(d_ws, 0, CTL_ZERO_BYTES, stream);
    int li = 0;
    for (const Step& st : PLAN) {
        if (st.fast) {
            FArgs a{}; a.p = p; a.li = li++;
            for (int i = 0; i < st.n; ++i) a.mask |= 1ull << st.ph[i];
            hipLaunchKernelGGL(k_fast, dim3(grid), dim3(NWAVES * 64), LDS_BYTES, stream, a);
        } else {
            for (int i = 0; i < st.n; ++i) hipLaunchKernelGGL(k_naive, dim3(2048), dim3(256), 0, stream, p, st.ph[i]);
        }
    }
}
```

```cpp
#include <hip/hip_runtime.h>
#include <cstdio>
#include <cstdint>
#define DEV __device__ __forceinline__

#ifndef NB
#define NB 8
#endif
typedef unsigned short bf16;
constexpr int S = 2048, D = 1024, T = NB * S, HD = 64;
constexpr int EVEN_IN = 2304, ODD_IN = 2840, LDP = 3072;
constexpr int NCMP = 127, NSLC = 32;
constexpr float NEG = -1e30f;
constexpr float EPS = 1e-6f;
constexpr int RMAX = 2 * T + 32 * 256;

DEV float u2f(unsigned u) { return __builtin_bit_cast(float, u); }
DEV unsigned f2u(float f) { return __builtin_bit_cast(unsigned, f); }
DEV float bf2f(bf16 h) { return u2f(((unsigned)h) << 16); }
DEV bf16 f2bf(float f) { unsigned u = f2u(f); u += 0x7fffu + ((u >> 16) & 1u); return (bf16)(u >> 16); }

struct Params {
    const float *x, *ev_norm, *ev_w_in, *ev_q_norm, *ev_k_norm, *ev_sink, *ev_w_out;
    const float *od_norm, *od_w_in, *od_c_q_norm, *od_c_k_norm, *od_d_q_norm, *od_d_k_norm, *od_cmp_pos, *od_cmp_w, *od_w_out;
    const float *moe_norm, *moe_w_grp, *moe_b_grp, *moe_w_exp, *moe_b_exp, *moe_w_gate, *moe_w_up, *moe_w_down;
    float* out;
    unsigned* ctl;
    bf16 *win0t, *wout0t, *win1t, *wout1t;
    bf16 *wgut[2], *wdt[2];
    bf16* proj;
    bf16* xn;
    bf16* o;
    bf16* ha;
    bf16* hid;
    float* rstd;
    int* eid;
    float* ew;
    float* kmean;
    bf16* kvcmp;
    int* pos;
    bf16* wr;
    bf16* wcmpt;
    float* cbias;
};


namespace pg8 {
#define PG8_LAS __attribute__((address_space(3)))
typedef unsigned short bf16_t;
typedef short bf16x8 __attribute__((ext_vector_type(8)));
typedef float f32x4 __attribute__((ext_vector_type(4)));
typedef unsigned u32x4 __attribute__((ext_vector_type(4)));
constexpr int BM = 256, BK = 64, HALF = 128, HTB = HALF * BK * 2, STAGE_BYTES = 8 * HTB, NXCD = 8, WGM = 8;

__host__ __device__ __forceinline__ int lds_byte(int r, int c) { const int st = (r >> 4) * 2 + (c >> 5), rr = r & 15, cc = c & 31, ob = rr * 64 + cc * 2; return st * 1024 + (ob ^ (((ob >> 9) & 1) << 5)); }
__host__ __device__ __forceinline__ void stage_rc(int b, int& R, int& C) { const int st = b / 1024, sb = b % 1024, swz = sb ^ (((sb >> 9) & 1) << 5); R = (st >> 1) * 16 + swz / 64; C = (st & 1) * 32 + (swz % 64) / 2; }
__host__ __device__ __forceinline__ int perm32(int rho) { const int n = rho >> 4, i = rho & 15; return 8 * (i >> 2) + 4 * n + (i & 3); }

struct Unit { const char* A; const char* B; int pm, pn; };

struct StaticOrder {
    int nM, nN, nwg, G, c; const char* A; const char* Bt; size_t tstep;
    __device__ void init(const bf16_t* A_, const bf16_t* Bt_, int M, int N, int K, int G_, int c_) { nM = M / BM; nN = N / BM; nwg = nM * nN; G = G_; c = c_; A = (const char*)A_; Bt = (const char*)Bt_; tstep = (size_t)BM * K * 2; }
    __device__ bool next(int i, Unit& u) const {
        const long L = (long)i * G + c; if (L >= nwg) return false;
        int wgid = (int)L; { const int q = nwg / NXCD, r = nwg % NXCD, xcd = wgid % NXCD, off = wgid / NXCD; wgid = (xcd < r ? xcd * (q + 1) : r * (q + 1) + (xcd - r) * q) + off; }
        const int nig = WGM * nN, gid = wgid / nig, fm = gid * WGM, gsz = (nM - fm) < WGM ? (nM - fm) : WGM;
        u.pm = fm + ((wgid % nig) % gsz); u.pn = (wgid % nig) / gsz; u.A = A + (size_t)u.pm * tstep; u.B = Bt + (size_t)u.pn * tstep; return true;
    }
};

__device__ __forceinline__ unsigned cvt_pk_bf16(float lo, float hi) { unsigned r; asm volatile("v_cvt_pk_bf16_f32 %0, %1, %2" : "=v"(r) : "v"(lo), "v"(hi)); return r; }

struct EpiStoreBf16 {
    static constexpr bool PERM = true;
    bf16_t* O; int ldc;
    __device__ __forceinline__ void operator()(const f32x4 (&acc)[2][2][4][2], const Unit& u, int wr, int wc, int fr, int fq) const {
        const int row0 = u.pm * BM + wr * 64 + fr, col0 = u.pn * BM + wc * 32 + 8 * fq;
#pragma unroll
        for (int ai = 0; ai < 2; ++ai)
#pragma unroll
            for (int m = 0; m < 4; ++m) { bf16_t* rowp = O + (size_t)(row0 + ai * HALF + m * 16) * ldc + col0;
#pragma unroll
                for (int bj = 0; bj < 2; ++bj) { const f32x4 v0 = acc[ai][bj][m][0], v1 = acc[ai][bj][m][1];
                    u32x4 w; w.x = cvt_pk_bf16(v0[0], v0[1]); w.y = cvt_pk_bf16(v0[2], v0[3]); w.z = cvt_pk_bf16(v1[0], v1[1]); w.w = cvt_pk_bf16(v1[2], v1[3]);
                    *(u32x4*)(rowp + bj * HALF) = w; } }
    }
};

template <int LAYER> struct EpiProjNorm {
    static constexpr bool PERM = true;
    bf16_t* O; int ldc; const float *g0, *g1, *g2, *g3, *g4; PG8_LAS float* hn;
    __device__ __forceinline__ const float* gain_of(int H) const {
        if (LAYER == 0) return H < 8 ? g0 : (H < 10 ? g1 : nullptr);
        return H < 8 ? g0 : H < 16 ? g1 : (H >= 24 && H < 32) ? g2 : (H == 36 || H == 37) ? g3 : (H == 40 || H == 41) ? g4 : nullptr;
    }
    __device__ __forceinline__ void operator()(f32x4 (&acc)[2][2][4][2], const Unit& u, int wr, int wc, int fr, int fq) const {
        const bool any = (LAYER == 0) ? (u.pn < 3) : (u.pn < 4 || u.pn == 6 || u.pn == 7 || u.pn == 9 || u.pn == 10);
        if (any) {
#pragma unroll
            for (int ai = 0; ai < 2; ++ai)
#pragma unroll
                for (int m = 0; m < 4; ++m)
#pragma unroll
                    for (int bj = 0; bj < 2; ++bj) {
                        const f32x4 a = acc[ai][bj][m][0], b = acc[ai][bj][m][1];
                        float ss = (a[0] * a[0] + a[1] * a[1]) + (a[2] * a[2] + a[3] * a[3]) + (b[0] * b[0] + b[1] * b[1]) + (b[2] * b[2] + b[3] * b[3]);
                        ss += __shfl_xor(ss, 16); ss += __shfl_xor(ss, 32);
                        if (fq == 0) hn[(ai * HALF + wr * 64 + m * 16 + fr) * 8 + bj * 4 + wc] = ss;
                    }
        }
        asm volatile("s_waitcnt lgkmcnt(0)" ::: "memory"); __builtin_amdgcn_s_barrier(); asm volatile("" ::: "memory");
        const int row0 = u.pm * BM + wr * 64 + fr, col0 = u.pn * BM + wc * 32 + 8 * fq;
#pragma unroll
        for (int bj = 0; bj < 2; ++bj) {
            const float* g = gain_of(4 * u.pn + 2 * bj + (wc >> 1));
            f32x4 ga = (f32x4){1.f, 1.f, 1.f, 1.f}, gb = ga;
            if (g) { ga = *(const f32x4*)(g + (wc & 1) * 32 + 8 * fq); gb = *(const f32x4*)(g + (wc & 1) * 32 + 8 * fq + 4); }
#pragma unroll
            for (int ai = 0; ai < 2; ++ai)
#pragma unroll
                for (int m = 0; m < 4; ++m) {
                    f32x4 v0 = acc[ai][bj][m][0], v1 = acc[ai][bj][m][1];
                    if (g) { const int rl = (ai * HALF + wr * 64 + m * 16 + fr) * 8 + bj * 4;
                        const float r = 1.0f / sqrtf((hn[rl + wc] + hn[rl + (wc ^ 1)]) * (1.0f / 64) + 1e-6f);
                        v0 = v0 * ga * r; v1 = v1 * gb * r; }
                    u32x4 w; w.x = cvt_pk_bf16(v0[0], v0[1]); w.y = cvt_pk_bf16(v0[2], v0[3]); w.z = cvt_pk_bf16(v1[0], v1[1]); w.w = cvt_pk_bf16(v1[2], v1[3]);
                    *(u32x4*)(O + (size_t)(row0 + ai * HALF + m * 16) * ldc + col0 + bj * HALF) = w;
                }
        }
    }
};
struct EpiResidF32 {
    static constexpr bool PERM = true;
    const float* R; float* O; int ldc;
    __device__ __forceinline__ void operator()(const f32x4 (&acc)[2][2][4][2], const Unit& u, int wr, int wc, int fr, int fq) const {
        const int row0 = u.pm * BM + wr * 64 + fr, col0 = u.pn * BM + wc * 32 + 8 * fq;
#pragma unroll
        for (int ai = 0; ai < 2; ++ai)
#pragma unroll
            for (int m = 0; m < 4; ++m) { const size_t ro = (size_t)(row0 + ai * HALF + m * 16) * ldc + col0;
#pragma unroll
                for (int bj = 0; bj < 2; ++bj) {
                    const f32x4 r0 = *(const f32x4*)(R + ro + bj * HALF), r1 = *(const f32x4*)(R + ro + bj * HALF + 4);
                    *(f32x4*)(O + ro + bj * HALF) = r0 + acc[ai][bj][m][0]; *(f32x4*)(O + ro + bj * HALF + 4) = r1 + acc[ai][bj][m][1]; } }
    }
};
struct EpiSiluMul {
    static constexpr bool PERM = true;
    bf16_t* H; int ldh;
    __device__ __forceinline__ void operator()(const f32x4 (&acc)[2][2][4][2], const Unit& u, int wr, int wc, int fr, int fq) const {
        const int row0 = u.pm * BM + wr * 64 + fr, col0 = u.pn * HALF + wc * 32 + 8 * fq;
#pragma unroll
        for (int ai = 0; ai < 2; ++ai)
#pragma unroll
            for (int m = 0; m < 4; ++m) { bf16_t* rowp = H + (size_t)(row0 + ai * HALF + m * 16) * ldh + col0;
                float h[8];
#pragma unroll
                for (int n = 0; n < 2; ++n)
#pragma unroll
                    for (int j = 0; j < 4; ++j) { const float g = acc[ai][0][m][n][j], up = acc[ai][1][m][n][j]; h[n * 4 + j] = g * up / (1.0f + __expf(-g)); }
                u32x4 w; w.x = cvt_pk_bf16(h[0], h[1]); w.y = cvt_pk_bf16(h[2], h[3]); w.z = cvt_pk_bf16(h[4], h[5]); w.w = cvt_pk_bf16(h[6], h[7]);
                *(u32x4*)rowp = w; }
    }
};

template <class Epi, class Sched>
__device__ __forceinline__ void gemm_phase(PG8_LAS unsigned char* lds, const int K, const Sched& S, const Epi& E, const int tid) {
    const int wid = __builtin_amdgcn_readfirstlane(tid >> 6), lane = tid & 63, wr = wid >> 2, wc = wid & 3, fr = lane & 15, fq = lane >> 4;
    const int nt = K / BK;
    unsigned voffA[2], voffB[2];
#pragma unroll
    for (int i = 0; i < 2; ++i) { int R, C; stage_rc(tid * 16 + i * 8192, R, C); const int Rb = Epi::PERM ? ((R & ~31) + perm32(R & 31)) : R;
        voffA[i] = (unsigned)(R * K + C) * 2u; voffB[i] = (unsigned)(Rb * K + C) * 2u; }
    const size_t kstep = (size_t)(BK * 2);
    const size_t hstep = (size_t)HALF * K * 2;
    const unsigned ldsw = (unsigned)wid * 1024u;
    const int aoff = lds_byte(wr * 64 + fr, fq * 8), boff = lds_byte(wc * 32 + fr, fq * 8);
#define PG8_SA(b, h) (((b) * 2 + (h)) * HTB)
#define PG8_SB(b, h) ((4 + (b) * 2 + (h)) * HTB)
#define PG8_STAGE(bufoff, gbase, voff) do { _Pragma("unroll") for (int _i = 0; _i < 2; ++_i) \
        __builtin_amdgcn_global_load_lds((const unsigned*)((const char*)(gbase) + (voff)[_i]), (PG8_LAS unsigned*)(lds + (bufoff) + ldsw + _i * 8192), 16, 0, 0); } while (0)
#define PG8_LDA(dst, b, h) do { _Pragma("unroll") for (int m = 0; m < 4; ++m) _Pragma("unroll") for (int k = 0; k < 2; ++k) dst[m][k] = *(const PG8_LAS bf16x8*)(lds + PG8_SA(b, h) + aoff + m * 2048 + k * 1024); } while (0)
#define PG8_LDB(dst, b, h) do { _Pragma("unroll") for (int n = 0; n < 2; ++n) _Pragma("unroll") for (int k = 0; k < 2; ++k) dst[n][k] = *(const PG8_LAS bf16x8*)(lds + PG8_SB(b, h) + boff + n * 2048 + k * 1024); } while (0)
#define PG8_MMA(ai, bj, At, Bt) do { __builtin_amdgcn_s_setprio(1); _Pragma("unroll") for (int m = 0; m < 4; ++m) _Pragma("unroll") for (int n = 0; n < 2; ++n) _Pragma("unroll") for (int k = 0; k < 2; ++k) \
        acc[ai][bj][m][n] = __builtin_amdgcn_mfma_f32_16x16x32_bf16(Bt[n][k], At[m][k], acc[ai][bj][m][n], 0, 0, 0); __builtin_amdgcn_s_setprio(0); } while (0)
#define PG8_WAIT_V(n) asm volatile("s_waitcnt vmcnt(" #n ")" ::: "memory")
#define PG8_WAIT_L(n) asm volatile("s_waitcnt lgkmcnt(" #n ")" ::: "memory")
#define PG8_BAR __builtin_amdgcn_s_barrier()
#define PG8_SCHED __builtin_amdgcn_sched_barrier(0)
    Unit cur, nxt; int ui = 0;
    if (!S.next(0, cur)) return;
    f32x4 acc[2][2][4][2];
#pragma unroll
    for (int a = 0; a < 2; ++a)
#pragma unroll
        for (int b = 0; b < 2; ++b)
#pragma unroll
            for (int m = 0; m < 4; ++m)
#pragma unroll
                for (int n = 0; n < 2; ++n) acc[a][b][m][n] = (f32x4){0.f, 0.f, 0.f, 0.f};
    bf16x8 At[4][2], B0[2][2], B1[2][2];
    const char* cA = cur.A; const char* cB = cur.B;
    PG8_STAGE(PG8_SB(0, 0), cB, voffB); PG8_STAGE(PG8_SB(0, 1), cB + hstep, voffB); PG8_STAGE(PG8_SA(0, 0), cA, voffA); PG8_STAGE(PG8_SA(0, 1), cA + hstep, voffA);
    if (wr == 1) PG8_BAR;
    PG8_WAIT_V(2); PG8_BAR;
    PG8_STAGE(PG8_SB(1, 0), cB + kstep, voffB); PG8_STAGE(PG8_SA(1, 0), cA + kstep, voffA); PG8_STAGE(PG8_SB(1, 1), cB + hstep + kstep, voffB);
    PG8_WAIT_V(6); PG8_BAR;
    for (;;) {
        const bool has_next = S.next(ui + 1, nxt);
        const char* nA = has_next ? nxt.A : cA; const char* nB = has_next ? nxt.B : cB;
        for (int t = 0; t < nt; t += 2) {
            const bool last = (t == nt - 2);
            const char* a1 = cA + (size_t)(t + 1) * kstep;
            const char* a2 = last ? nA : cA + (size_t)(t + 2) * kstep; const char* b2 = last ? nB : cB + (size_t)(t + 2) * kstep;
            const char* a3 = a2 + kstep; const char* b3 = b2 + kstep;
            PG8_LDB(B0, 0, 0); PG8_LDB(B1, 0, 1); PG8_SCHED; PG8_LDA(At, 0, 0); PG8_STAGE(PG8_SA(1, 1), a1 + hstep, voffA);
            PG8_WAIT_V(8); PG8_WAIT_L(0); PG8_BAR; PG8_MMA(0, 0, At, B0); PG8_MMA(0, 1, At, B1); PG8_BAR; PG8_SCHED;
            PG8_LDA(At, 0, 1); PG8_STAGE(PG8_SB(0, 0), b2, voffB); PG8_STAGE(PG8_SB(0, 1), b2 + hstep, voffB); PG8_STAGE(PG8_SA(0, 0), a2, voffA);
            PG8_WAIT_V(8); PG8_WAIT_L(0); PG8_BAR; PG8_MMA(1, 0, At, B0); PG8_MMA(1, 1, At, B1); PG8_BAR; PG8_SCHED;
            PG8_LDB(B0, 1, 0); PG8_LDB(B1, 1, 1); PG8_SCHED; PG8_LDA(At, 1, 0); PG8_STAGE(PG8_SA(0, 1), a2 + hstep, voffA);
            PG8_WAIT_V(8); PG8_WAIT_L(0); PG8_BAR; PG8_MMA(0, 0, At, B0); PG8_MMA(0, 1, At, B1); PG8_BAR; PG8_SCHED;
            PG8_LDA(At, 1, 1); PG8_STAGE(PG8_SB(1, 0), b3, voffB); PG8_STAGE(PG8_SB(1, 1), b3 + hstep, voffB); PG8_STAGE(PG8_SA(1, 0), a3, voffA);
            PG8_WAIT_V(8); PG8_WAIT_L(0); PG8_BAR; PG8_MMA(1, 0, At, B0); PG8_MMA(1, 1, At, B1); PG8_BAR; PG8_SCHED;
        }
        if (wr == 0) PG8_BAR;
        { int l2; asm volatile("v_mbcnt_lo_u32_b32 %0, -1, 0\n\tv_mbcnt_hi_u32_b32 %0, -1, %0" : "=v"(l2)); E(acc, cur, wr, wc, l2 & 15, l2 >> 4); }
        if (!has_next) break;
#pragma unroll
        for (int a = 0; a < 2; ++a)
#pragma unroll
            for (int b = 0; b < 2; ++b)
#pragma unroll
                for (int m = 0; m < 4; ++m)
#pragma unroll
                    for (int n = 0; n < 2; ++n) acc[a][b][m][n] = (f32x4){0.f, 0.f, 0.f, 0.f};
        cur = nxt; cA = nA; cB = nB; ++ui;
        if (wr == 1) PG8_BAR;
    }
    PG8_WAIT_V(0);
    PG8_BAR;
#undef PG8_SA
#undef PG8_SB
#undef PG8_STAGE
#undef PG8_LDA
#undef PG8_LDB
#undef PG8_MMA
#undef PG8_WAIT_V
#undef PG8_WAIT_L
#undef PG8_BAR
#undef PG8_SCHED
}
}

#define GAS __attribute__((address_space(1)))
#define LAS __attribute__((address_space(3)))
typedef unsigned v4u __attribute__((ext_vector_type(4)));
typedef float f32x4 __attribute__((ext_vector_type(4)));
typedef short bf16x8 __attribute__((ext_vector_type(8)));
constexpr int NWAVES = 8;
constexpr int RING_BYTES = 131072, LDSCTL_OFF = RING_BYTES, MISC_OFF = LDSCTL_OFF + 320, LDS_BYTES = 147456;
constexpr size_t MiB = 1u << 20;
constexpr size_t CTL_ZERO_BYTES = 1 * MiB;
constexpr int CW_BAR = 4096;
constexpr int CW_MOE = 65536;
#define LDS_WAIT() asm volatile("s_waitcnt lgkmcnt(0)" ::: "memory")
#define VM_WAIT() asm volatile("s_waitcnt vmcnt(0)" ::: "memory")
DEV unsigned pk2(float lo, float hi) { return (unsigned)f2bf(lo) | ((unsigned)f2bf(hi) << 16); }

#define XB_TMO      128
#define XB_XCNT(j)  (256  + 64 * (j))
#define XB_XSUB(j)  (1280 + 64 * (j))
#define XB_XGEN(j)  (2304 + 64 * (j))
#define XB_TOP      3328
#define XB_TOPGEN   3392
#define XCD_BAR_WORDS 3456
#define XB_SPIN_CAP (1u << 22)
DEV unsigned xb_ld(unsigned* p)              { return __hip_atomic_load(p, __ATOMIC_RELAXED, __HIP_MEMORY_SCOPE_AGENT); }
DEV unsigned xb_add(unsigned* p, unsigned v) { return __hip_atomic_fetch_add(p, v, __ATOMIC_RELAXED, __HIP_MEMORY_SCOPE_AGENT); }
DEV unsigned xb_xcc_id() { return (unsigned)__builtin_amdgcn_s_getreg((3 << 11) | 20) & 0xFu; }
#define XB_SPIN(cond, bar) do { unsigned _sp = 0; while (cond) { __builtin_amdgcn_s_sleep(1); \
    if ((++_sp & 255u) == 0u) { if (xb_ld(&(bar)[XB_TMO])) break; if (_sp > XB_SPIN_CAP) { atomicAdd(&(bar)[XB_TMO], 1u); break; } } } } while (0)
struct XcdBarrier { unsigned* bar; unsigned x; volatile LAS unsigned* st; };
DEV XcdBarrier xcd_barrier_post(unsigned* bar, volatile LAS unsigned* st) {
    XcdBarrier b; b.bar = bar; b.x = xb_xcc_id(); b.st = st;
    if (threadIdx.x == 0) (void)xb_add(&bar[XB_XCNT(b.x)], 1u);
    return b;
}
DEV void xcd_barrier_complete(unsigned* bar, unsigned x, unsigned& nloc, unsigned& nx) {
    const unsigned G = gridDim.x * gridDim.y * gridDim.z;
    unsigned sum, cnt, mine, sp = 0u;
    for (;;) {
        sum = 0u; cnt = 0u; mine = 0u;
#pragma unroll
        for (unsigned j = 0; j < 16; ++j) { const unsigned c = xb_ld(&bar[XB_XCNT(j)]); sum += c; cnt += (c > 0u) ? 1u : 0u; mine = (j == x) ? c : mine; }
        if (sum == G) break;
        __builtin_amdgcn_s_sleep(1);
        if ((++sp & 255u) == 0u) { if (xb_ld(&bar[XB_TMO])) break; if (sp > XB_SPIN_CAP) { atomicAdd(&bar[XB_TMO], 1u); break; } }
    }
    nloc = mine > 0u ? mine : 1u; nx = cnt > 0u ? cnt : 1u;
}
DEV void xcd_barrier(const XcdBarrier& b, const int tid_) {
    asm volatile("s_waitcnt vmcnt(0)" ::: "memory");
    __syncthreads();
    if (tid_ == 0) {
        unsigned* bar = b.bar;
        __builtin_amdgcn_s_waitcnt(0);
        unsigned nloc = b.st[0], nx = b.st[1];
        if (nloc == 0u) { xcd_barrier_complete(bar, b.x, nloc, nx); b.st[0] = nloc; b.st[1] = nx; }
        const unsigned old = xb_add(&bar[XB_XSUB(b.x)], 1u);
        const unsigned gen = old / nloc;
        if (old + 1u == (gen + 1u) * nloc) {
            __builtin_amdgcn_fence(__ATOMIC_RELEASE, "agent");
            asm volatile("s_waitcnt vmcnt(0)" ::: "memory");
            const unsigned og = xb_add(&bar[XB_TOP], 1u);
            const unsigned tg = og / nx;
            if (og + 1u == (tg + 1u) * nx) xb_add(&bar[XB_TOPGEN], 1u);
            else XB_SPIN(xb_ld(&bar[XB_TOPGEN]) == tg, bar);
            __builtin_amdgcn_fence(__ATOMIC_ACQUIRE, "agent");
            xb_add(&bar[XB_XGEN(b.x)], 1u);
            asm volatile("s_waitcnt vmcnt(0)" ::: "memory");
        } else {
            XB_SPIN(xb_ld(&bar[XB_XGEN(b.x)]) == gen, bar);
            __builtin_amdgcn_fence(__ATOMIC_ACQUIRE, "agent");
            asm volatile("s_waitcnt vmcnt(0)" ::: "memory");
        }
    }
    __syncthreads();
}

struct Frame {
    LAS unsigned char* lds;
    volatile LAS unsigned* MISC;
    int tid, lane, wave;
    int vcu, G;
};

DEV void refresh(Frame& F) { int l; asm volatile("v_mbcnt_lo_u32_b32 %0, -1, 0\n\tv_mbcnt_hi_u32_b32 %0, -1, %0" : "=v"(l)); F.lane = l; F.tid = F.wave * 64 + l; }
DEV float wave_sum(float v) {
#pragma unroll
    for (int o = 1; o < 64; o <<= 1) v += __shfl_xor(v, o);
    return v;
}
DEV void transpose_item(const float* W, int K, int N, bf16* WT, int k0, int n0, int dst_row0, LAS float* scr, int lane) {
    const int c4 = lane & 7, r0 = lane >> 3;
    const bool okc = (n0 + 4 * c4) < N;
    f32x4 v[8];
#pragma unroll
    for (int i = 0; i < 8; ++i) v[i] = okc ? *(const GAS f32x4*)(W + (size_t)(k0 + r0 + 8 * i) * N + n0 + 4 * c4) : (f32x4){0.f, 0.f, 0.f, 0.f};
#pragma unroll
    for (int i = 0; i < 8; ++i) { LAS float* d = scr + (r0 + 8 * i) * 33 + 4 * c4; d[0] = v[i].x; d[1] = v[i].y; d[2] = v[i].z; d[3] = v[i].w; }
    LDS_WAIT(); asm volatile("" ::: "memory");
    const int c = lane & 7;
#pragma unroll
    for (int j = 0; j < 4; ++j) { const int n = (lane >> 3) + 8 * j; const LAS float* s = scr + (8 * c) * 33 + n;
        v4u o; o.x = pk2(s[0 * 33], s[1 * 33]); o.y = pk2(s[2 * 33], s[3 * 33]); o.z = pk2(s[4 * 33], s[5 * 33]); o.w = pk2(s[6 * 33], s[7 * 33]);
        if (n0 + n < N) *(GAS v4u*)(WT + (size_t)(dst_row0 + n) * K + k0 + 8 * c) = o; }
    LDS_WAIT(); asm volatile("" ::: "memory");
}
DEV float rms_row_to_bf16(int lane, const float* xrow, const float* gain, bf16* orow) {
    const GAS f32x4* xr = (const GAS f32x4*)xrow + lane;
    const GAS f32x4* gr = (const GAS f32x4*)gain + lane;
    f32x4 v[4]; float s = 0.f;
#pragma unroll
    for (int j = 0; j < 4; ++j) { v[j] = xr[64 * j]; s += (v[j].x * v[j].x + v[j].y * v[j].y) + (v[j].z * v[j].z + v[j].w * v[j].w); }
    const float rstd = 1.0f / sqrtf(wave_sum(s) * (1.f / D) + EPS);
    GAS unsigned long long* o8 = (GAS unsigned long long*)orow + lane;
#pragma unroll
    for (int j = 0; j < 4; ++j) { const f32x4 g = gr[64 * j];
        o8[64 * j] = (unsigned long long)pk2(v[j].x * rstd * g.x, v[j].y * rstd * g.y) | ((unsigned long long)pk2(v[j].z * rstd * g.z, v[j].w * rstd * g.w) << 32); }
    return rstd;
}

DEV void fp_convert_weights(const Params& P, Frame& F, int which) {
    LAS float* scr = (LAS float*)(F.lds + F.wave * 16384);
    const int gw = F.vcu * NWAVES + F.wave, NGW = F.G * NWAVES;
    if (which == 0) {
        constexpr int I_IN0 = 16 * 72, I_OUT = 16 * 32, I_IN1 = 16 * 89;
        constexpr int NIT = I_IN0 + I_OUT + I_IN1 + I_OUT;
        for (int it = gw; it < NIT; it += NGW) {
            int r = it;
            if (r < I_IN0) { const int kb = r / 72, nb = r % 72; transpose_item(P.ev_w_in, D, EVEN_IN, P.win0t, 64 * kb, 32 * nb, 32 * nb, scr, F.lane); continue; } r -= I_IN0;
            if (r < I_OUT) { const int kb = r / 32, nb = r % 32; transpose_item(P.ev_w_out, D, D, P.wout0t, 64 * kb, 32 * nb, 32 * nb, scr, F.lane); continue; } r -= I_OUT;
            if (r < I_IN1) { const int kb = r / 89, nb = r % 89; transpose_item(P.od_w_in, D, ODD_IN, P.win1t, 64 * kb, 32 * nb, 32 * nb, scr, F.lane); continue; } r -= I_IN1;
            { const int kb = r / 32, nb = r % 32; transpose_item(P.od_w_out, D, D, P.wout1t, 64 * kb, 32 * nb, 32 * nb, scr, F.lane); }
        }
    }
}
DEV void fp_norm_rows(Frame& F, const float* src, const float* gain, bf16* xn) {
    const int gw = F.vcu * NWAVES + F.wave, NGW = F.G * NWAVES;
    for (int m = gw; m < T; m += NGW) rms_row_to_bf16(F.lane, src + (size_t)m * D, gain, xn + (size_t)m * D);
}

constexpr int TAB_OFF = MISC_OFF + 128;
constexpr int RT_PART_OFF = 0;
constexpr int RT_SS_OFF = 24576;
constexpr int RT_HIST_OFF = 25088;
typedef float f32x4v __attribute__((ext_vector_type(4)));

DEV void fp_prep_router(const Params& P, Frame& F) {
    const int gtid = F.vcu * NWAVES * 64 + F.tid, gsz = F.G * NWAVES * 64;
    for (int i = gtid; i < 2 * 48 * D; i += gsz) {
        const int k = i & (D - 1), j = (i >> 10) % 48, l = i / (48 * D);
        float w = 0.f;
        if (j < 4) w = P.moe_w_grp[((size_t)l * D + k) * 4 + j]; else if (j < 36) w = P.moe_w_exp[((size_t)l * D + k) * 32 + (j - 4)];
        w *= P.moe_norm[l * D + k];
        const bf16 hi = f2bf(w); const bf16 lo = f2bf(w - bf2f(hi));
        P.wr[((size_t)(l * 2 + 0) * 48 + j) * D + k] = hi;
        P.wr[((size_t)(l * 2 + 1) * 48 + j) * D + k] = lo;
    }
}

DEV void fp_route(const Params& P, Frame& F, int layer) {
    const int lane = F.lane, w = F.wave, rg = w & 3, kh = w >> 2;
    const bf16* wr_hi = P.wr + (size_t)(layer * 2 + 0) * 48 * D;
    const bf16* wr_lo = P.wr + (size_t)(layer * 2 + 1) * 48 * D;
    LAS float* part = (LAS float*)(F.lds + RT_PART_OFF);
    LAS float* ssp = (LAS float*)(F.lds + RT_SS_OFF);
    LAS unsigned* hist = (LAS unsigned*)(F.lds + RT_HIST_OFF);
    unsigned* cnt = P.ctl + CW_MOE + layer * 256;
    for (int tb = F.vcu; tb < T / 64; tb += F.G) {
        const int t0 = tb * 64;
        if (F.tid < 64) hist[F.tid] = 0u;
        const float* xrow = P.out + (size_t)(t0 + 16 * rg + (lane & 15)) * D + 512 * kh + 8 * (lane >> 4);
        pg8::f32x4 acc[3];
#pragma unroll
        for (int c = 0; c < 3; ++c) acc[c] = (pg8::f32x4){0.f, 0.f, 0.f, 0.f};
        float ss = 0.f;
        const size_t boff = (size_t)(lane & 15) * D + 512 * kh + 8 * (lane >> 4);
#pragma unroll 4
        for (int ks = 0; ks < 16; ++ks) {
            const f32x4v x0 = *(const f32x4v*)(xrow + 32 * ks), x1 = *(const f32x4v*)(xrow + 32 * ks + 4);
            float xv[8] = {x0.x, x0.y, x0.z, x0.w, x1.x, x1.y, x1.z, x1.w};
            bf16x8 ah, al;
#pragma unroll
            for (int j = 0; j < 8; ++j) { ss += xv[j] * xv[j]; const bf16 h = f2bf(xv[j]); ah[j] = (short)h; al[j] = (short)f2bf(xv[j] - bf2f(h)); }
#pragma unroll
            for (int c = 0; c < 3; ++c) {
                const bf16x8 bh = *(const bf16x8*)(wr_hi + boff + (size_t)16 * c * D + 32 * ks);
                const bf16x8 bl = *(const bf16x8*)(wr_lo + boff + (size_t)16 * c * D + 32 * ks);
                acc[c] = __builtin_amdgcn_mfma_f32_16x16x32_bf16(ah, bh, acc[c], 0, 0, 0);
                acc[c] = __builtin_amdgcn_mfma_f32_16x16x32_bf16(ah, bl, acc[c], 0, 0, 0);
                acc[c] = __builtin_amdgcn_mfma_f32_16x16x32_bf16(al, bh, acc[c], 0, 0, 0);
            }
        }
        ss += __shfl_xor(ss, 16); ss += __shfl_xor(ss, 32);
#pragma unroll
        for (int c = 0; c < 3; ++c)
#pragma unroll
            for (int r = 0; r < 4; ++r) part[(kh * 64 + 16 * rg + 4 * (lane >> 4) + r) * 48 + 16 * c + (lane & 15)] = acc[c][r];
        if (lane < 16) ssp[kh * 64 + 16 * rg + lane] = ss;
        __syncthreads();
        int e1 = 0, e2 = 0; float w1 = 0.f, w2 = 0.f; unsigned r1 = 0, r2 = 0;
        if (F.tid < 64) {
            const int t = t0 + F.tid;
            const float rs = 1.0f / sqrtf((ssp[F.tid] + ssp[64 + F.tid]) * (1.f / D) + EPS);
            P.rstd[t] = rs;
            float lg[4], le[32];
#pragma unroll
            for (int j = 0; j < 4; ++j) lg[j] = (part[F.tid * 48 + j] + part[(64 + F.tid) * 48 + j]) * rs + P.moe_b_grp[layer * 4 + j];
#pragma unroll
            for (int j = 0; j < 32; ++j) le[j] = (part[F.tid * 48 + 4 + j] + part[(64 + F.tid) * 48 + 4 + j]) * rs + P.moe_b_exp[layer * 32 + j];
            int gs = 0; float gm = lg[0];
#pragma unroll
            for (int j = 1; j < 4; ++j) if (lg[j] > gm) { gm = lg[j]; gs = j; }
            float gz = 0.f;
#pragma unroll
            for (int j = 0; j < 4; ++j) gz += expf(lg[j] - gm);
            const float pg = 1.0f / gz;
            float wv[8];
#pragma unroll
            for (int j = 0; j < 8; ++j) wv[j] = gs == 0 ? le[j] : gs == 1 ? le[8 + j] : gs == 2 ? le[16 + j] : le[24 + j];
            int i1 = 0; float m1 = wv[0];
#pragma unroll
            for (int j = 1; j < 8; ++j) if (wv[j] > m1) { m1 = wv[j]; i1 = j; }
            int i2 = -1; float m2 = -3e38f;
#pragma unroll
            for (int j = 0; j < 8; ++j) if (j != i1 && wv[j] > m2) { m2 = wv[j]; i2 = j; }
            const float ex2 = expf(m2 - m1);
            w1 = pg / (1.0f + ex2); w2 = pg * ex2 / (1.0f + ex2);
            e1 = gs * 8 + i1; e2 = gs * 8 + i2;
            r1 = __hip_atomic_fetch_add(&hist[e1], 1u, __ATOMIC_RELAXED, __HIP_MEMORY_SCOPE_WORKGROUP); r2 = __hip_atomic_fetch_add(&hist[e2], 1u, __ATOMIC_RELAXED, __HIP_MEMORY_SCOPE_WORKGROUP);
        }
        __syncthreads();
        if (F.tid < 32) { const unsigned h = hist[F.tid]; hist[32 + F.tid] = h ? xb_add(&cnt[F.tid], h) : 0u; }
        __syncthreads();
        if (F.tid < 64) {
            const int t = t0 + F.tid;
            P.eid[t * 2 + 0] = e1; P.eid[t * 2 + 1] = e2; P.ew[t * 2 + 0] = w1; P.ew[t * 2 + 1] = w2;
            P.pos[t * 2 + 0] = (int)(hist[32 + e1] + r1); P.pos[t * 2 + 1] = (int)(hist[32 + e2] + r2);
        }
        __syncthreads();
    }
}

DEV void moe_table(const Params& P, Frame& F, int layer) {
    volatile LAS int* tab = (volatile LAS int*)(F.lds + TAB_OFF);
    if (F.tid == 0) {
        unsigned* cnt = P.ctl + CW_MOE + layer * 256;
        int acc = 0;
        for (int e = 0; e < 32; ++e) { tab[e] = acc; acc += (int)((xb_ld(&cnt[e]) + 255u) >> 8); }
        tab[32] = acc;
    }
    __syncthreads();
}

DEV void fp_gather(const Params& P, Frame& F, int layer) {
    moe_table(P, F, layer);
    volatile LAS int* tab = (volatile LAS int*)(F.lds + TAB_OFF);
    const float* gain = P.moe_norm + layer * D;
    const int gw = F.vcu * NWAVES + F.wave, NGW = F.G * NWAVES, lane = F.lane;
    for (int t = gw; t < T; t += NGW) {
        const int e1 = P.eid[t * 2], e2 = P.eid[t * 2 + 1];
        const int p1 = tab[e1] * 256 + P.pos[t * 2], p2 = tab[e2] * 256 + P.pos[t * 2 + 1];
        const GAS f32x4* xr = (const GAS f32x4*)(P.out + (size_t)t * D) + lane;
        const GAS f32x4* gr = (const GAS f32x4*)gain + lane;
        const float rstd = P.rstd[t];
        GAS unsigned long long* o1 = (GAS unsigned long long*)(P.ha + (size_t)p1 * D) + lane;
        GAS unsigned long long* o2 = (GAS unsigned long long*)(P.ha + (size_t)p2 * D) + lane;
#pragma unroll
        for (int j = 0; j < 4; ++j) { const f32x4 v = xr[64 * j], g = gr[64 * j];
            const unsigned long long q = (unsigned long long)pk2(v.x * rstd * g.x, v.y * rstd * g.y) | ((unsigned long long)pk2(v.z * rstd * g.z, v.w * rstd * g.w) << 32);
            o1[64 * j] = q; o2[64 * j] = q; }
        if (lane == 0) { P.pos[t * 2] = p1; P.pos[t * 2 + 1] = p2; }
    }
}

struct ListOrder {
    int code[4]; int n, npn; const char* A; const char* Bt; size_t tstep;
    __device__ __forceinline__ bool next(int i, pg8::Unit& o) const {
        if (i >= n) return false;
        const int c = (i == 0) ? code[0] : (i == 1) ? code[1] : (i == 2) ? code[2] : code[3];
        const int tt = c >> 8, e = (c >> 3) & 31, pn = c & 7;
        o.pm = tt; o.pn = pn; o.A = A + (size_t)tt * tstep; o.B = Bt + (size_t)(e * npn + pn) * tstep; return true;
    }
};
DEV void moe_units(Frame& F, ListOrder& L, int npn, const bf16* A, const bf16* Bt, int K, int ci, int ncu) {
    volatile LAS int* tab = (volatile LAS int*)(F.lds + TAB_OFF);
    const int ntile = tab[32], total = ntile * npn;
    L.tstep = (size_t)256 * K * 2; L.A = (const char*)A; L.Bt = (const char*)Bt; L.npn = npn;
    int n = 0;
#pragma unroll
    for (int i = 0; i < 4; ++i) {
        const int Lx = i * ncu + ci;
        int code = 0;
        if (Lx < total) {
            const int tt = Lx / npn, pn = Lx % npn;
            int e = 0;
            for (int q = 1; q < 32; ++q) e += (tt >= tab[q]) ? 1 : 0;
            code = (tt << 8) | (e << 3) | pn;
            n = i + 1;
        }
        L.code[i] = __builtin_amdgcn_readfirstlane(code);
    }
    L.n = __builtin_amdgcn_readfirstlane(n);
}

DEV void fp_moe_gu(const Params& P, Frame& F, int layer, int ci, int ncu) {
    moe_table(P, F, layer);
    ListOrder L; moe_units(F, L, 2, P.ha, P.wgut[layer], D, ci, ncu);
    pg8::EpiSiluMul E{P.hid, 256};
    pg8::gemm_phase(F.lds, D, L, E, F.tid);
}
DEV void fp_moe_dn(const Params& P, Frame& F, int layer) {
    moe_table(P, F, layer);
    ListOrder L; moe_units(F, L, 4, P.hid, P.wdt[layer], 256, F.vcu, F.G);
    pg8::EpiStoreBf16 E{P.ha, D};
    pg8::gemm_phase(F.lds, 256, L, E, F.tid);
}
DEV void fp_combine(const Params& P, Frame& F, const float* gain2, bf16* xn) {
    const int gw = F.vcu * NWAVES + F.wave, NGW = F.G * NWAVES, lane = F.lane;
    for (int t = gw; t < T; t += NGW) {
        const int p1 = P.pos[t * 2], p2 = P.pos[t * 2 + 1];
        const float w1 = P.ew[t * 2], w2 = P.ew[t * 2 + 1];
        GAS f32x4* xr = (GAS f32x4*)(P.out + (size_t)t * D) + lane;
        const GAS unsigned long long* y1 = (const GAS unsigned long long*)(P.ha + (size_t)p1 * D) + lane;
        const GAS unsigned long long* y2 = (const GAS unsigned long long*)(P.ha + (size_t)p2 * D) + lane;
        f32x4 v[4]; float s = 0.f;
#pragma unroll
        for (int j = 0; j < 4; ++j) {
            v[j] = xr[64 * j];
            const unsigned long long a = y1[64 * j], b = y2[64 * j];
            v[j].x += w1 * u2f((unsigned)(a & 0xffffu) << 16) + w2 * u2f((unsigned)(b & 0xffffu) << 16);
            v[j].y += w1 * u2f((unsigned)((a >> 16) & 0xffffu) << 16) + w2 * u2f((unsigned)((b >> 16) & 0xffffu) << 16);
            v[j].z += w1 * u2f((unsigned)((a >> 32) & 0xffffu) << 16) + w2 * u2f((unsigned)((b >> 32) & 0xffffu) << 16);
            v[j].w += w1 * u2f((unsigned)((a >> 48) & 0xffffu) << 16) + w2 * u2f((unsigned)((b >> 48) & 0xffffu) << 16);
            xr[64 * j] = v[j];
            s += (v[j].x * v[j].x + v[j].y * v[j].y) + (v[j].z * v[j].z + v[j].w * v[j].w);
        }
        if (xn) {
            const float rstd = 1.0f / sqrtf(wave_sum(s) * (1.f / D) + EPS);
            const GAS f32x4* gr = (const GAS f32x4*)gain2 + lane;
            GAS unsigned long long* o8 = (GAS unsigned long long*)(xn + (size_t)t * D) + lane;
#pragma unroll
            for (int j = 0; j < 4; ++j) { const f32x4 g = gr[64 * j];
                o8[64 * j] = (unsigned long long)pk2(v[j].x * rstd * g.x, v[j].y * rstd * g.y) | ((unsigned long long)pk2(v[j].z * rstd * g.z, v[j].w * rstd * g.w) << 32); }
        }
    }
}


DEV void fp_convert_moe_part(const Params& P, Frame& F, int layer, int ci, int nconv) {
    LAS float* scr = (LAS float*)(F.lds + F.wave * 16384);
    constexpr int NIT = 32 * 384;
    for (int it = ci * NWAVES + F.wave; it < NIT; it += nconv * NWAVES) {
        const int e = it / 384; int r = it % 384;
        const size_t eo = (size_t)(layer * 32 + e);
        if (r < 256) { const bool up = r >= 128; r &= 127; const int kb = r / 8, nb = r % 8; const int f0 = 32 * nb;
            const float* W = (up ? P.moe_w_up : P.moe_w_gate) + eo * D * 256;
            transpose_item(W, D, 256, P.wgut[layer] + (size_t)e * 512 * D, 64 * kb, f0, (f0 >> 7) * 256 + (up ? 128 : 0) + (f0 & 127), scr, F.lane);
        } else { r -= 256; const int kb = r / 32, nb = r % 32;
            transpose_item(P.moe_w_down + eo * 256 * D, 256, D, P.wdt[layer] + (size_t)e * D * 256, 64 * kb, 32 * nb, 32 * nb, scr, F.lane); }
    }
}
namespace att {
typedef float f32x16 __attribute__((ext_vector_type(16)));
typedef short s16x4 __attribute__((ext_vector_type(4)));
typedef short v4i16_t __attribute__((ext_vector_type(4)));
typedef LAS const char* lptr;
constexpr float LOG2E = 1.4426950408889634f;
constexpr int KS0 = 0, VS0 = 16384, SLOT = 8192;
constexpr float MNEG = -1e30f;

struct TileRegs { v4u k, v; };
DEV void tile_load(TileRegs& R, const bf16* Kg, const bf16* Vg, int pitch, int k0, int tid) {
    const int w = tid >> 6, lane = tid & 63;
    R.k = *(const GAS v4u*)(Kg + (size_t)(k0 + lane) * pitch + w * 8);
    R.v = *(const GAS v4u*)(Vg + (size_t)(k0 + 16 * (w & 3) + (lane >> 2)) * pitch + (w >> 2) * 32 + (lane & 3) * 8);
}
DEV void tile_store(LAS unsigned char* lds, int slot, const TileRegs& R, int tid) {
    *(LAS v4u*)(lds + KS0 + slot * SLOT + tid * 16) = R.k;
    *(LAS v4u*)(lds + VS0 + slot * SLOT + tid * 16) = R.v;
}
DEV void qk_tile(f32x16& p0, f32x16& p1, lptr Kslot, const bf16x8 (&qr)[4], int r32, int hi) {
    lptr kb = Kslot + hi * 1024 + r32 * 16;
    p0 = f32x16{}; p1 = f32x16{};
#pragma unroll
    for (int d0 = 0; d0 < 4; ++d0) {
        const bf16x8 b0 = *(const LAS bf16x8*)(kb + d0 * 2048);
        const bf16x8 b1 = *(const LAS bf16x8*)(kb + d0 * 2048 + 512);
        p0 = __builtin_amdgcn_mfma_f32_32x32x16_bf16(b0, qr[d0], p0, 0, 0, 0);
        p1 = __builtin_amdgcn_mfma_f32_32x32x16_bf16(b1, qr[d0], p1, 0, 0, 0);
    }
}
DEV s16x4 vtr(lptr p) { return __builtin_bit_cast(s16x4, __builtin_amdgcn_ds_read_tr16_b64_v4i16((LAS v4i16_t*)p)); }
DEV unsigned cvtpk(float lo, float hi) { unsigned r; asm volatile("v_cvt_pk_bf16_f32 %0, %1, %2" : "=v"(r) : "v"(lo), "v"(hi)); return r; }
DEV void pv_tile(f32x16 (&o)[2], lptr Vslot, const f32x16& p0, const f32x16& p1, int lane) {
    const int hi = lane >> 5;
    lptr vp = Vslot + ((lane >> 4) & 1) * 32 + (lane & 3) * 8 + (4 * hi + ((lane & 15) >> 2)) * 64;
    bf16x8 pf[4];
#pragma unroll
    for (int ks = 0; ks < 4; ++ks) {
        const f32x16& p = (ks < 2) ? p0 : p1; const int b = (ks & 1) * 8;
        v4u w; w.x = cvtpk(p[b + 0], p[b + 1]); w.y = cvtpk(p[b + 2], p[b + 3]); w.z = cvtpk(p[b + 4], p[b + 5]); w.w = cvtpk(p[b + 6], p[b + 7]);
        pf[ks] = __builtin_bit_cast(bf16x8, w);
    }
#pragma unroll
    for (int d0 = 0; d0 < 2; ++d0)
#pragma unroll
        for (int ks = 0; ks < 4; ++ks) {
            const s16x4 lo = vtr(vp + d0 * 4096 + ks * 1024), hh = vtr(vp + d0 * 4096 + ks * 1024 + 512);
            const bf16x8 vf = (bf16x8){lo[0], lo[1], lo[2], lo[3], hh[0], hh[1], hh[2], hh[3]};
            o[d0] = __builtin_amdgcn_mfma_f32_32x32x16_bf16(vf, pf[ks], o[d0], 0, 0, 0);
        }
}
DEV float lane_swap_max(float m) {
    auto rr = __builtin_amdgcn_permlane32_swap(__float_as_uint(m), __float_as_uint(m), false, false);
    return fmaxf(__uint_as_float(rr[0]), __uint_as_float(rr[1]));
}
DEV float lane_swap_sum(float m) {
    auto rr = __builtin_amdgcn_permlane32_swap(__float_as_uint(m), __float_as_uint(m), false, false);
    return __uint_as_float(rr[0]) + __uint_as_float(rr[1]);
}
DEV float lane_partner(float m, int hi) {
    auto rr = __builtin_amdgcn_permlane32_swap(__float_as_uint(m), __float_as_uint(m), false, false);
    return hi ? __uint_as_float(rr[0]) : __uint_as_float(rr[1]);
}

constexpr float M0 = 16.0f;
struct SoftState { float l; f32x16 o[2]; };
DEV void soft_reset(SoftState& s) { s.l = 0.f; s.o[0] = f32x16{}; s.o[1] = f32x16{}; }

DEV void soft_tile(SoftState& st, f32x16& p0, f32x16& p1, float s2, float k0rel_f, int klo, int klim, bool need_mask, lptr Vslot, int lane) {
    const int hi = lane >> 5;
    const float c1 = 0.125f * LOG2E;
    const float base = s2 * (k0rel_f + (float)(4 * hi)) - M0;
    float ls0 = 0.f, ls1 = 0.f;
    if (need_mask) {
#pragma unroll
        for (int r = 0; r < 16; ++r) {
            const int kr = (r & 3) + 8 * (r >> 2);
            const float x0 = __builtin_amdgcn_exp2f(fmaf(p0[r], c1, fmaf(s2, (float)kr, base)));
            const float x1 = __builtin_amdgcn_exp2f(fmaf(p1[r], c1, fmaf(s2, (float)(kr + 32), base)));
            p0[r] = (kr > klo && kr <= klim) ? x0 : 0.f; p1[r] = (kr + 32 > klo && kr + 32 <= klim) ? x1 : 0.f;
            ls0 += p0[r]; ls1 += p1[r];
        }
    } else {
#pragma unroll
        for (int r = 0; r < 16; ++r) {
            const int kr = (r & 3) + 8 * (r >> 2);
            p0[r] = __builtin_amdgcn_exp2f(fmaf(p0[r], c1, fmaf(s2, (float)kr, base)));
            p1[r] = __builtin_amdgcn_exp2f(fmaf(p1[r], c1, fmaf(s2, (float)(kr + 32), base)));
            ls0 += p0[r]; ls1 += p1[r];
        }
    }
    st.l += ls0 + ls1;
    pv_tile(st.o, Vslot, p0, p1, lane);
}

DEV void store_ot(const f32x16 (&o)[2], float f, bf16* orow, int hi) {
#pragma unroll
    for (int d0 = 0; d0 < 2; ++d0)
#pragma unroll
        for (int g = 0; g < 4; ++g) {
            const unsigned a = cvtpk(o[d0][4 * g] * f, o[d0][4 * g + 1] * f), b = cvtpk(o[d0][4 * g + 2] * f, o[d0][4 * g + 3] * f);
            *(GAS unsigned long long*)(orow + 32 * d0 + 8 * g + 4 * hi) = (unsigned long long)a | ((unsigned long long)b << 32);
        }
}
DEV void load_q(bf16x8 (&qr)[4], const bf16* qrow, int hi) {
#pragma unroll
    for (int d0 = 0; d0 < 4; ++d0) qr[d0] = *(const GAS bf16x8*)(qrow + 16 * d0 + 8 * hi);
}

template <class MaskF>
DEV void run_segment(Frame& F, SoftState& st, const bf16x8 (&qr)[4], const bf16* Kg, const bf16* Vg, int pitch, unsigned long long tmask, float s2, int qpos, const MaskF& mf) {
    const int tid = F.tid, lane = F.lane, r32 = lane & 31, hi = lane >> 5;
    if (tmask == 0ull) return;
#define NEXT_TILE(var) do { if (tmask) { var = __builtin_ctzll(tmask); tmask &= tmask - 1ull; } else var = -1; } while (0)
#define SEG_COMPUTE(t, slot) do { int klo, klim; mf((t), klo, klim); \
        if (__any(klim >= 0 && klo < 60 && klim > klo)) { const bool need_mask = __any(klo >= 0 || klim < 60); f32x16 p0, p1; \
            qk_tile(p0, p1, (lptr)(F.lds + KS0 + (slot) * SLOT), qr, r32, hi); \
            soft_tile(st, p0, p1, s2, (float)((t) * 64 - qpos), klo, klim, need_mask, (lptr)(F.lds + VS0 + (slot) * SLOT), lane); } } while (0)
    int ta, tb, tc, td;
    NEXT_TILE(ta); NEXT_TILE(tb);
    TileRegs RA, RB; tile_load(RA, Kg, Vg, pitch, ta * 64, tid); if (tb >= 0) tile_load(RB, Kg, Vg, pitch, tb * 64, tid);
    for (;;) {
        tile_store(F.lds, 0, RA, tid);
        NEXT_TILE(tc); if (tc >= 0) tile_load(RA, Kg, Vg, pitch, tc * 64, tid);
        __syncthreads();
        SEG_COMPUTE(ta, 0);
        if (tb < 0) break;
        tile_store(F.lds, 1, RB, tid);
        NEXT_TILE(td); if (td >= 0) tile_load(RB, Kg, Vg, pitch, td * 64, tid);
        __syncthreads();
        SEG_COMPUTE(tb, 1);
        if (tc < 0) break;
        ta = tc; tb = td;
    }
    __syncthreads();
#undef NEXT_TILE
#undef SEG_COMPUTE
}
DEV unsigned long long tile_range(int t0, int t1) { return (t1 < t0) ? 0ull : ((~0ull >> (63 - (t1 - t0))) << t0); }
}

DEV void headnorm_group(bf16* row, int off, int nheads, const float* g, int lane) {
    const int hg = lane >> 3, ch = lane & 7;
    if (hg < nheads) {
        GAS v4u* p = (GAS v4u*)(row + off + hg * 64 + ch * 8);
        const v4u x = *p;
        float v[8] = {u2f(x.x << 16), u2f(x.x & 0xffff0000u), u2f(x.y << 16), u2f(x.y & 0xffff0000u), u2f(x.z << 16), u2f(x.z & 0xffff0000u), u2f(x.w << 16), u2f(x.w & 0xffff0000u)};
        float ss = 0.f;
#pragma unroll
        for (int j = 0; j < 8; ++j) ss += v[j] * v[j];
        ss += __shfl_xor(ss, 1); ss += __shfl_xor(ss, 2); ss += __shfl_xor(ss, 4);
        const float r = 1.0f / sqrtf(ss * (1.0f / 64) + EPS);
        const f32x4 g0 = *(const GAS f32x4*)(g + ch * 8), g1 = *(const GAS f32x4*)(g + ch * 8 + 4);
        v4u o; o.x = pk2(v[0] * r * g0.x, v[1] * r * g0.y); o.y = pk2(v[2] * r * g0.z, v[3] * r * g0.w); o.z = pk2(v[4] * r * g1.x, v[5] * r * g1.y); o.w = pk2(v[6] * r * g1.z, v[7] * r * g1.w);
        *p = o;
    }
}
DEV void fp_headnorm(const Params& P, Frame& F, int layer) {
    const int gw = F.vcu * NWAVES + F.wave, NGW = F.G * NWAVES, lane = F.lane;
    for (int t = gw; t < T; t += NGW) {
        bf16* row = P.proj + (size_t)t * LDP;
        if (layer == 0) {
            headnorm_group(row, 0, 8, P.ev_q_norm, lane);
            headnorm_group(row, 512, 2, P.ev_k_norm, lane);
        } else {
            headnorm_group(row, 0, 8, P.od_c_q_norm, lane);
            headnorm_group(row, 512, 8, P.od_c_k_norm, lane);
            headnorm_group(row, 1536, 8, P.od_d_q_norm, lane);
            headnorm_group(row, 2304, 2, P.od_d_k_norm + 64, lane);
            headnorm_group(row, 2560, 2, P.od_d_k_norm + 128, lane);
        }
    }
}

DEV void fp_prep_compress(const Params& P, Frame& F) {
    const int gw = F.vcu * NWAVES + F.wave, NGW = F.G * NWAVES, lane = F.lane;
    for (int i = gw; i < 128; i += NGW) {
        const int which = i >> 6, e = i & 63;
        const float* pos = P.od_cmp_pos + which * 2048; const float* w = P.od_cmp_w + (size_t)which * 2048 * 64 + e;
        float s = 0.f;
        for (int k = lane; k < 2048; k += 64) s += pos[k] * w[(size_t)k * 64];
        s = wave_sum(s);
        if (lane == 0) P.cbias[i] = s;
    }
    LAS float* scr = (LAS float*)(F.lds + F.wave * 16384);
    for (int i = gw; i < 128; i += NGW) {
        const int which = i >> 6, r = i & 63, kb = r >> 1, nb = r & 1;
        transpose_item(P.od_cmp_w + (size_t)which * 2048 * 64, 2048, 64, P.wcmpt + (size_t)which * 64 * 2048, 64 * kb, 32 * nb, 32 * nb, scr, lane);
    }
}

DEV void fp_prep1(const Params& P, Frame& F) {
    const int gw = F.vcu * NWAVES + F.wave, NGW = F.G * NWAVES, lane = F.lane, w = F.wave;
    for (int i = gw; i < NB * 64; i += NGW) {
        const int n = i & 7, h = (i >> 3) & 7, b = i >> 6;
        const bf16* kp = P.proj + ((size_t)b * S + n * 256) * LDP + 512 + h * 64 + lane;
        float s0 = 0.f, s1 = 0.f, s2 = 0.f, s3 = 0.f;
#pragma unroll 4
        for (int j = 0; j < 256; j += 4) { s0 += bf2f(kp[(size_t)j * LDP]); s1 += bf2f(kp[(size_t)(j + 1) * LDP]); s2 += bf2f(kp[(size_t)(j + 2) * LDP]); s3 += bf2f(kp[(size_t)(j + 3) * LDP]); }
        P.kmean[(size_t)i * 64 + lane] = ((s0 + s1) + (s2 + s3)) * (1.0f / 256);
    }
    LAS float* part = (LAS float*)F.lds;
    for (int it = F.vcu; it < 2 * NB * 2 * 8; it += F.G) {
        const int ng = it & 7, hkv = (it >> 3) & 1, b = (it >> 4) % NB, which = it / (16 * NB);
        const int n = 16 * ng + (lane & 15);
        const int ncl = n > 126 ? 126 : n;
        const bf16* arow = P.proj + ((size_t)b * S + ncl * 16) * LDP + (which ? 2176 : 2048) + hkv * 64 + 8 * (lane >> 4);
        const bf16* brow = P.wcmpt + (size_t)which * 64 * 2048 + (size_t)(lane & 15) * 2048 + 8 * (lane >> 4);
        pg8::f32x4 acc[4];
#pragma unroll
        for (int c = 0; c < 4; ++c) acc[c] = (pg8::f32x4){0.f, 0.f, 0.f, 0.f};
#pragma unroll
        for (int kk = 0; kk < 8; ++kk) {
            const int ks = 8 * w + kk, li = ks >> 1, dh = (ks & 1) * 32;
            const bf16x8 a = *(const GAS bf16x8*)(arow + (size_t)li * LDP + dh);
#pragma unroll
            for (int c = 0; c < 4; ++c) {
                const bf16x8 bb = *(const GAS bf16x8*)(brow + (size_t)(16 * c) * 2048 + 32 * ks);
                acc[c] = __builtin_amdgcn_mfma_f32_16x16x32_bf16(a, bb, acc[c], 0, 0, 0);
            }
        }
#pragma unroll
        for (int c = 0; c < 4; ++c)
#pragma unroll
            for (int r = 0; r < 4; ++r) part[(w * 16 + 4 * (lane >> 4) + r) * 64 + 16 * c + (lane & 15)] = acc[c][r];
        __syncthreads();
        {
            const int row = F.tid >> 5, c0 = 2 * (F.tid & 31);
            float v0 = P.cbias[which * 64 + c0], v1 = P.cbias[which * 64 + c0 + 1];
#pragma unroll
            for (int ww = 0; ww < 8; ++ww) { v0 += part[(ww * 16 + row) * 64 + c0]; v1 += part[(ww * 16 + row) * 64 + c0 + 1]; }
            if (which == 0) {
                float ss = v0 * v0 + v1 * v1;
                ss += __shfl_xor(ss, 1); ss += __shfl_xor(ss, 2); ss += __shfl_xor(ss, 4); ss += __shfl_xor(ss, 8); ss += __shfl_xor(ss, 16);
                const float rs = 1.0f / sqrtf(ss * (1.0f / 64) + EPS);
                v0 *= rs * P.od_d_k_norm[c0]; v1 *= rs * P.od_d_k_norm[c0 + 1];
            }
            const int nn = 16 * ng + row;
            if (nn < NCMP) *(GAS unsigned*)(P.kvcmp + (((size_t)(which * NB + b) * NCMP + nn) * 2 + hkv) * 64 + c0) = pk2(v0, v1);
        }
        __syncthreads();
    }
}

DEV void sb_tile(att::f32x16& p0, att::f32x16& p1, float& carry, int lim, int hi) {
    using namespace att;
    const float c1 = 0.125f * LOG2E;
    f32x16 k0, k1;
    float cs[2][4];
#pragma unroll
    for (int hf = 0; hf < 2; ++hf)
#pragma unroll
        for (int g = 0; g < 4; ++g) {
            float s = 0.f;
#pragma unroll
            for (int i = 0; i < 4; ++i) {
                const int r = 4 * g + i, kr = i + 8 * g + 32 * hf;
                const float z2 = (hf ? p1[r] : p0[r]) * c1;
                const float e = __builtin_amdgcn_exp2f(-fabsf(z2));
                const float ls2 = fminf(z2, 0.f) - __builtin_amdgcn_logf(1.0f + e);
                const bool ok = kr < lim;
                const float lk2 = ok ? (ls2 - z2) : 0.f;
                if (hf) { p1[r] = ok ? ls2 : MNEG; k1[r] = lk2; } else { p0[r] = ok ? ls2 : MNEG; k0[r] = lk2; }
                s += lk2;
            }
            cs[hf][g] = s;
        }
    float run = carry;
#pragma unroll
    for (int hf = 1; hf >= 0; --hf)
#pragma unroll
        for (int g = 3; g >= 0; --g) {
            const float mine = cs[hf][g], other = lane_partner(mine, hi);
            float suf = hi ? run : run + other;
            run += mine + other;
#pragma unroll
            for (int i = 3; i >= 0; --i) {
                const int r = 4 * g + i;
                if (hf) { p1[r] = __builtin_amdgcn_exp2f(p1[r] + suf); suf += k1[r]; } else { p0[r] = __builtin_amdgcn_exp2f(p0[r] + suf); suf += k0[r]; }
            }
        }
    carry = run;
}

DEV void fp_attn0(const Params& P, Frame& F) {
    using namespace att;
    const int tid = F.tid, lane = F.lane, r32 = lane & 31, hi = lane >> 5, w = F.wave;
    for (int u = F.vcu; u < 512; u += F.G) {
        {
            const int b = u >> 6, h = (u >> 3) & 7, blk = u & 7;
            const bf16* base = P.proj + (size_t)b * S * LDP;
            const int q = blk * 256 + w * 32 + r32;
            bf16x8 qr[4]; load_q(qr, base + (size_t)q * LDP + 768 + h * 64, hi);
            const bf16* Kg = base + 1280 + h * 64; const bf16* Vg = base + 1792 + h * 64;
            f32x16 o[2]; o[0] = f32x16{}; o[1] = f32x16{};
            float carry = 0.f;
            const int tmax = blk * 4 + 3;
            const int tw = (blk * 256 + w * 32 + 31) >> 6;
            volatile LAS int* flag = (volatile LAS int*)(F.lds + 32768);
            if (tid < 3) flag[tid] = 0;
            TileRegs R; tile_load(R, Kg, Vg, LDP, tmax * 64, tid);
            int slot = 0; bool wave_done = false;
            for (int t = tmax; t >= 0; --t) {
                tile_store(F.lds, slot, R, tid);
                if (t > 0) tile_load(R, Kg, Vg, LDP, (t - 1) * 64, tid);
                __syncthreads();
                if (t < tmax && flag[(t + 1) % 3] == 0) break;
                if (tid == 0) flag[(t + 2) % 3] = 0;
                if (!wave_done && t <= tw) {
                    f32x16 p0, p1;
                    qk_tile(p0, p1, (lptr)(F.lds + KS0 + slot * SLOT), qr, r32, hi);
                    sb_tile(p0, p1, carry, q - t * 64 - 4 * hi, hi);
                    pv_tile(o, (lptr)(F.lds + VS0 + slot * SLOT), p0, p1, lane);
                    if (__all(carry < -150.f)) wave_done = true;
                }
                if (!wave_done && lane == 0) flag[t % 3] = 1;
                slot ^= 1;
            }
            __syncthreads();
            store_ot(o, 1.0f, P.o + (size_t)(b * S + q) * D + 512 + h * 64, hi);
        }
    }
    asm volatile("" ::: "memory");
    for (int u = 512 + F.vcu; u < 1024; u += F.G) {
        {
            const int v = u - 512, b = v >> 6, hkv = (v >> 5) & 1, c = v & 31;
            const bf16* base = P.proj + (size_t)b * S * LDP;
            const int hh = hkv * 4 + (w >> 1), q = c * 64 + (w & 1) * 32 + r32;
            bf16x8 qr[4]; load_q(qr, base + (size_t)q * LDP + hh * 64, hi);
            const float sl = exp2f(-(float)(hh + 1)), s2 = sl * LOG2E;
            SoftState st; soft_reset(st);
            const int t0 = c - 2 < 0 ? 0 : c - 2;
            run_segment(F, st, qr, base + 512 + hkv * 64, base + 640 + hkv * 64, LDP, tile_range(t0, c), s2, q,
                        [&](int t, int& klo, int& klim) { klim = q - t * 64 - 4 * hi; klo = klim - 128; });
            const float den = lane_swap_sum(st.l) + __builtin_amdgcn_exp2f(P.ev_sink[hh] * LOG2E - M0);
            store_ot(st.o, 1.0f / den, P.o + (size_t)(b * S + q) * D + hh * 64, hi);
        }
    }
}

DEV void fp_attn1(const Params& P, Frame& F) {
    using namespace att;
    const int lane = F.lane, r32 = lane & 31, hi = lane >> 5, w = F.wave;
    for (int u = F.vcu; u < 512; u += F.G) {
        {
            const int v = u & 255, bh = v >> 2, blk = (u < 256) ? (v & 3) : 7 - (v & 3);
            const int b = bh >> 3, h = bh & 7;
            const bf16* base = P.proj + (size_t)b * S * LDP;
            const int q = blk * 256 + w * 32 + r32;
            bf16x8 qr[4]; load_q(qr, base + (size_t)q * LDP + h * 64, hi);
            const float sl = exp2f(-(float)(h + 1)), s2 = sl * LOG2E;
            float gt[8];
#pragma unroll
            for (int n = 0; n < 8; ++n) {
                float g = 0.f;
                if (n < blk) {
                    const float* km = P.kmean + ((size_t)(b * 8 + h) * 8 + n) * 64;
#pragma unroll
                    for (int d0 = 0; d0 < 4; ++d0)
#pragma unroll
                        for (int j = 0; j < 8; ++j) g += bf2f((bf16)qr[d0][j]) * km[16 * d0 + 8 * hi + j];
                }
                g = lane_swap_sum(g);
                gt[n] = n < blk ? g : NEG;
            }
            unsigned sel = 0;
#pragma unroll
            for (int n = 0; n < 8; ++n) {
                int rank = 0;
#pragma unroll
                for (int k = 0; k < 8; ++k) rank += (gt[k] > gt[n] || (gt[k] == gt[n] && k < n)) ? 1 : 0;
                if (rank < 3 && n < blk) sel |= 1u << n;
            }
            SoftState st; soft_reset(st);
            run_segment(F, st, qr, base + 512 + h * 64, base + 1024 + h * 64, LDP, tile_range(0, blk * 4 + 3), s2, q,
                        [&](int t, int& klo, int& klim) { const int n = t >> 2; klo = -1;
                            if (n < blk) klim = ((sel >> n) & 1) ? 63 : -1; else klim = q - t * 64 - 4 * hi; });
            const float l = lane_swap_sum(st.l);
            store_ot(st.o, 1.0f / l, P.o + (size_t)(b * S + q) * D + h * 64, hi);
        }
    }
    asm volatile("" ::: "memory");
    for (int u = 512 + F.vcu; u < 1024; u += F.G) {
        {
            const int v = u & 255, bk = v >> 4, c = (u < 768) ? (v & 15) : 31 - (v & 15);
            const int b = bk >> 1, hkv = bk & 1;
            const bf16* base = P.proj + (size_t)b * S * LDP;
            const int h = hkv * 4 + (w >> 1), q = c * 64 + (w & 1) * 32 + r32, t = b * S + q;
            bf16x8 qr[4]; load_q(qr, base + (size_t)q * LDP + 1536 + h * 64, hi);
            const float sl = exp2f(-(float)(h + 1)), s2 = sl * LOG2E;
            const bf16* grow = base + (size_t)q * LDP + 2816 + h * 3;
            const float g0 = 1.0f / (1.0f + __expf(-bf2f(grow[0]))), g1 = 1.0f / (1.0f + __expf(-bf2f(grow[1]))), g2 = 1.0f / (1.0f + __expf(-bf2f(grow[2])));
            LAS float* part = (LAS float*)(F.lds + 36864);
            volatile LAS unsigned long long* tot = (volatile LAS unsigned long long*)(F.lds + 36864 + 33792);
            volatile LAS unsigned* selm = (volatile LAS unsigned*)(F.lds + 36864 + 33792 + 16896);
            f32x16 fin[2];
            {
                const int ntile = c >= 16 ? 2 : 1;
                const bf16* Kc = P.kvcmp + ((size_t)(0 * NB + b) * NCMP) * 128 + hkv * 64;
                const bf16* Vc = P.kvcmp + ((size_t)(1 * NB + b) * NCMP) * 128 + hkv * 64;
                TileRegs R0, R1; tile_load(R0, Kc, Vc, 128, 0, F.tid); if (ntile == 2) tile_load(R1, Kc, Vc, 128, 64, F.tid);
                tile_store(F.lds, 0, R0, F.tid); if (ntile == 2) tile_store(F.lds, 1, R1, F.tid);
                __syncthreads();
                const int nlim = (q - 31) >> 4;
                const float c1 = 0.125f * LOG2E, s16 = 16.0f * s2;
                const float basec = s2 * (float)(31 - q) + s16 * (float)(4 * hi);
                float lsum = 0.f;
                for (int tl = 0; tl < ntile; ++tl) {
                    f32x16 x0, x1; qk_tile(x0, x1, (lptr)(F.lds + KS0 + tl * SLOT), qr, r32, hi);
                    const int klim = nlim - 64 * tl - 4 * hi; const float bt = basec + s16 * (float)(64 * tl) - M0;
#pragma unroll
                    for (int r = 0; r < 16; ++r) {
                        const int kr = (r & 3) + 8 * (r >> 2);
                        lsum += kr <= klim ? __builtin_amdgcn_exp2f(fmaf(x0[r], c1, fmaf(s16, (float)kr, bt))) : 0.f;
                        lsum += kr + 32 <= klim ? __builtin_amdgcn_exp2f(fmaf(x1[r], c1, fmaf(s16, (float)(kr + 32), bt))) : 0.f;
                    }
                }
                lsum = lane_swap_sum(lsum);
                const float inv = nlim >= 0 ? 1.0f / lsum : 0.f;
                fin[0] = f32x16{}; fin[1] = f32x16{};
                LAS float* prow = part + ((w >> 1) * 64 + (w & 1) * 32 + r32) * 33;
                float peprev = 0.f;
                for (int tl = 0; tl < ntile; ++tl) {
                    f32x16 x0, x1; qk_tile(x0, x1, (lptr)(F.lds + KS0 + tl * SLOT), qr, r32, hi);
                    const int klim = nlim - 64 * tl - 4 * hi; const float bt = basec + s16 * (float)(64 * tl) - M0;
#pragma unroll
                    for (int r = 0; r < 16; ++r) {
                        const int kr = (r & 3) + 8 * (r >> 2);
                        x0[r] = kr <= klim ? __builtin_amdgcn_exp2f(fmaf(x0[r], c1, fmaf(s16, (float)kr, bt))) * inv : 0.f;
                        x1[r] = kr + 32 <= klim ? __builtin_amdgcn_exp2f(fmaf(x1[r], c1, fmaf(s16, (float)(kr + 32), bt))) * inv : 0.f;
                    }
#pragma unroll
                    for (int ix = 0; ix < 8; ++ix) {
                        const int g = ix & 3;
                        const float C = (ix < 4) ? (x0[4 * g] + x0[4 * g + 1]) + (x0[4 * g + 2] + x0[4 * g + 3]) : (x1[4 * g] + x1[4 * g + 1]) + (x1[4 * g + 2] + x1[4 * g + 3]);
                        const float pe = lane_partner((ix < 4) ? x0[4 * g + 3] : x1[4 * g + 3], hi);
                        prow[2 * (8 * tl + ix) + hi] = C + (hi ? pe : peprev);
                        peprev = pe;
                    }
                    pv_tile(fin, (lptr)(F.lds + VS0 + tl * SLOT), x0, x1, lane);
                }
#pragma unroll
                for (int r = 0; r < 16; ++r) { fin[0][r] *= g0; fin[1][r] *= g0; }
            }
            __syncthreads();
            {
                const int ql = F.tid >> 3, jg = F.tid & 7;
#pragma unroll
                for (int jj = 0; jj < 4; ++jj) {
                    const int j = 4 * jg + jj;
                    float sc = ((part[(0 * 64 + ql) * 33 + j] + part[(1 * 64 + ql) * 33 + j]) + part[(2 * 64 + ql) * 33 + j]) + part[(3 * 64 + ql) * 33 + j];
                    const bool forced = (j == 0) || (j == c) || (j == c - 1);
                    sc = (j <= c) ? sc + (forced ? 1000.0f : 0.0f) : NEG;
                    const unsigned ub = f2u(sc), ord = ub ^ ((ub >> 31) ? 0xffffffffu : 0x80000000u);
                    tot[ql * 33 + j] = ((unsigned long long)ord << 32) | (unsigned)(31 - j);
                }
                __syncthreads();
                unsigned long long mine[4];
#pragma unroll
                for (int jj = 0; jj < 4; ++jj) mine[jj] = tot[ql * 33 + 4 * jg + jj];
                int rank[4] = {0, 0, 0, 0};
                for (int k = 0; k < 32; ++k) {
                    const unsigned long long sk = tot[ql * 33 + k];
#pragma unroll
                    for (int jj = 0; jj < 4; ++jj) rank[jj] += (sk > mine[jj]) ? 1 : 0;
                }
                unsigned bits = 0;
#pragma unroll
                for (int jj = 0; jj < 4; ++jj) if (rank[jj] < 16 && 4 * jg + jj <= c) bits |= 1u << (4 * jg + jj);
                bits |= __shfl_xor(bits, 1); bits |= __shfl_xor(bits, 2); bits |= __shfl_xor(bits, 4);
                if (jg == 0) selm[ql] = bits;
                unsigned ub = bits; ub |= __shfl_xor(ub, 8); ub |= __shfl_xor(ub, 16); ub |= __shfl_xor(ub, 32);
                if (lane == 0) selm[64 + w] = ub;
            }
            __syncthreads();
            const unsigned mask = selm[(w & 1) * 32 + r32];
            const unsigned umask = ((selm[64] | selm[65]) | (selm[66] | selm[67])) | ((selm[68] | selm[69]) | (selm[70] | selm[71]));
            __syncthreads();
            LAS float* stg = (LAS float*)(F.lds + 36864) + w * 2048 + lane;
#pragma unroll
            for (int r = 0; r < 16; ++r) { stg[r * 64] = fin[0][r]; stg[(16 + r) * 64] = fin[1][r]; }
            SoftState st; soft_reset(st);
            run_segment(F, st, qr, base + 2304 + hkv * 64, base + 2432 + hkv * 64, LDP, (unsigned long long)umask, s2, q,
                        [&](int tt, int& klo, int& klim) { klo = -1; klim = ((mask >> tt) & 1) ? (q - tt * 64 - 4 * hi) : -1; });
            { const float f = g1 / lane_swap_sum(st.l);
#pragma unroll
              for (int r = 0; r < 16; ++r) { stg[r * 64] += f * st.o[0][r]; stg[(16 + r) * 64] += f * st.o[1][r]; } }
            soft_reset(st);
            run_segment(F, st, qr, base + 2560 + hkv * 64, base + 2688 + hkv * 64, LDP, tile_range(c - 8 < 0 ? 0 : c - 8, c), s2, q,
                        [&](int tt, int& klo, int& klim) { klim = q - tt * 64 - 4 * hi; klo = klim - 512; });
            { const float f = g2 / lane_swap_sum(st.l);
#pragma unroll
              for (int r = 0; r < 16; ++r) { st.o[0][r] = stg[r * 64] + f * st.o[0][r]; st.o[1][r] = stg[(16 + r) * 64] + f * st.o[1][r]; } }
            store_ot(st.o, 1.0f, P.o + (size_t)t * D + 512 + h * 64, hi);
            __syncthreads();
        }
    }
}
enum { PH_PRE = 0, PH_INPROJ0, PH_ATTN0, PH_OUTPROJ0, PH_ROUTE0, PH_GATHER0, PH_GU0, PH_DN0, PH_COMBINE0, PH_INPROJ1, PH_PREP1, PH_ATTN1, PH_OUTPROJ1, PH_ROUTE1, PH_GATHER1, PH_GU1, PH_DN1, PH_COMBINE1, PH_COUNT };
struct FArgs { Params p; };

#ifndef PROBE_PHASE
#define PROBE_PHASE -1
#endif
constexpr int STAMP_OFF = LDSCTL_OFF + 1024;
constexpr int HN_OFF = LDSCTL_OFF + 2048;
DEV void stampk(Frame& F, int k) {
    if (PROBE_PHASE >= 0 && F.tid == 0) ((volatile LAS unsigned*)(F.lds + STAMP_OFF))[k] = (unsigned)__builtin_amdgcn_s_memrealtime() | 1u;
}
__global__ void __launch_bounds__(NWAVES * 64, 2) k_fast(FArgs args) {
    extern __shared__ __attribute__((aligned(16))) unsigned char lds[];
    const Params& P = args.p;
    Frame F;
    F.lds = (LAS unsigned char*)lds;
    F.MISC = (volatile LAS unsigned*)(F.lds + MISC_OFF);
    F.tid = threadIdx.x; F.lane = F.tid & 63; F.wave = __builtin_amdgcn_readfirstlane(F.tid >> 6);
    F.G = gridDim.x; { const int bx = blockIdx.x; F.vcu = (F.G % 8 == 0) ? (bx % 8) * (F.G / 8) + bx / 8 : bx; }
    for (int u = F.tid; u < (LDS_BYTES - LDSCTL_OFF) / 4; u += NWAVES * 64) ((LAS unsigned*)(F.lds + LDSCTL_OFF))[u] = 0u;
    __syncthreads();
    XcdBarrier bar = xcd_barrier_post(P.ctl + CW_BAR, F.MISC + 8);
#define BEGIN(k) refresh(F); stampk(F, (k));
#define SEAM() do { refresh(F); xcd_barrier(bar, F.tid); } while (0)
    { BEGIN(PH_PRE) fp_convert_weights(P, F, 0); fp_prep_router(P, F); fp_prep_compress(P, F); fp_norm_rows(F, P.x, P.ev_norm, P.xn); SEAM(); }
    { BEGIN(PH_INPROJ0) const int cq = F.vcu >> 2, cr = F.vcu & 3, gi = 3 * cq + cr;
      if (F.G == 256 && cr == 3) fp_convert_moe_part(P, F, 0, cq, 64);
      else { pg8::StaticOrder So; So.init(P.xn, P.win0t, T, EVEN_IN, D, F.G == 256 ? 192 : F.G, F.G == 256 ? gi : F.vcu);
        pg8::EpiProjNorm<0> E{P.proj, LDP, P.ev_q_norm, P.ev_k_norm, nullptr, nullptr, nullptr, (PG8_LAS float*)(F.lds + HN_OFF)};
        pg8::gemm_phase(F.lds, D, So, E, F.tid); if (F.G != 256) { refresh(F); fp_convert_moe_part(P, F, 0, F.vcu, F.G); } }
      SEAM(); }
    { BEGIN(PH_ATTN0) fp_attn0(P, F); SEAM(); }
    { BEGIN(PH_OUTPROJ0) pg8::StaticOrder So; So.init(P.o, P.wout0t, T, D, D, F.G, (int)blockIdx.x);
      pg8::EpiResidF32 E{P.x, P.out, D}; pg8::gemm_phase(F.lds, D, So, E, F.tid); SEAM(); }
    { BEGIN(PH_ROUTE0) fp_route(P, F, 0); SEAM(); }
    { BEGIN(PH_GATHER0) fp_gather(P, F, 0); SEAM(); }
    { BEGIN(PH_GU0) const int cq = F.vcu >> 2, cr = F.vcu & 3, gi = 3 * cq + cr;
      if (F.G == 256 && cr == 3) fp_convert_moe_part(P, F, 1, cq, 64);
      else if (F.G == 256) fp_moe_gu(P, F, 0, gi, 192);
      else { fp_moe_gu(P, F, 0, F.vcu, F.G); refresh(F); fp_convert_moe_part(P, F, 1, F.vcu, F.G); }
      SEAM(); }
    { BEGIN(PH_DN0) fp_moe_dn(P, F, 0); SEAM(); }
    { BEGIN(PH_COMBINE0) fp_combine(P, F, P.od_norm, P.xn); SEAM(); }
    { BEGIN(PH_INPROJ1) pg8::StaticOrder So; So.init(P.xn, P.win1t, T, LDP, D, F.G, (int)blockIdx.x);
      pg8::EpiProjNorm<1> E{P.proj, LDP, P.od_c_q_norm, P.od_c_k_norm, P.od_d_q_norm, P.od_d_k_norm + 64, P.od_d_k_norm + 128, (PG8_LAS float*)(F.lds + HN_OFF)};
      pg8::gemm_phase(F.lds, D, So, E, F.tid); SEAM(); }
    { BEGIN(PH_PREP1) fp_prep1(P, F); SEAM(); }
    { BEGIN(PH_ATTN1) fp_attn1(P, F); SEAM(); }
    { BEGIN(PH_OUTPROJ1) pg8::StaticOrder So; So.init(P.o, P.wout1t, T, D, D, F.G, (int)blockIdx.x);
      pg8::EpiResidF32 E{P.out, P.out, D}; pg8::gemm_phase(F.lds, D, So, E, F.tid); SEAM(); }
    { BEGIN(PH_ROUTE1) fp_route(P, F, 1); SEAM(); }
    { BEGIN(PH_GATHER1) fp_gather(P, F, 1); SEAM(); }
    { BEGIN(PH_GU1) fp_moe_gu(P, F, 1, F.vcu, F.G); SEAM(); }
    { BEGIN(PH_DN1) fp_moe_dn(P, F, 1); SEAM(); }
    { BEGIN(PH_COMBINE1) fp_combine(P, F, nullptr, nullptr); }
    if (PROBE_PHASE >= 0) {
        refresh(F);
        if (F.vcu == 0 && F.tid == 0) {
            volatile LAS unsigned* st = (volatile LAS unsigned*)(F.lds + STAMP_OFF);
            const unsigned t1 = (PROBE_PHASE + 1 < PH_COUNT) ? st[(PROBE_PHASE + 1 < PH_COUNT) ? PROBE_PHASE + 1 : 0] : ((unsigned)__builtin_amdgcn_s_memrealtime() | 1u);
            const unsigned t0 = st[PROBE_PHASE < 0 ? 0 : PROBE_PHASE];
            asm volatile("s_waitcnt vmcnt(0)" ::: "memory");
#ifndef PROBE_SCALE
#define PROBE_SCALE 0.01f
#endif
            P.out[0] += (float)(t1 - t0) * PROBE_SCALE;
        }
    }
#undef BEGIN
#undef SEAM
}

static size_t carve(Params& p, void* d_ws) {
    char* w = (char*)d_ws;
    p.ctl = (unsigned*)w;
    p.win0t = (bf16*)(w + 1 * MiB);
    p.wout0t = (bf16*)(w + 6 * MiB);
    p.win1t = (bf16*)(w + 8 * MiB);
    p.wout1t = (bf16*)(w + 14 * MiB);
    p.wgut[0] = (bf16*)(w + 16 * MiB);
    p.wdt[0] = (bf16*)(w + 48 * MiB);
    p.proj = (bf16*)(w + 64 * MiB);
    p.ha = (bf16*)(w + 64 * MiB);
    p.xn = (bf16*)(w + 160 * MiB);
    p.o = (bf16*)(w + 192 * MiB);
    p.hid = (bf16*)(w + 192 * MiB);
    size_t off = 224 * MiB;
    auto take = [&](size_t bytes) { char* r = w + off; off = (off + bytes + 255) & ~(size_t)255; return r; };
    p.rstd = (float*)take((size_t)T * 4);
    p.eid = (int*)take((size_t)T * 2 * 4);
    p.ew = (float*)take((size_t)T * 2 * 4);
    p.kmean = (float*)take((size_t)NB * 8 * 8 * 64 * 4);
    p.kvcmp = (bf16*)take((size_t)2 * NB * 128 * 2 * 64 * 2);
    p.pos = (int*)take((size_t)T * 2 * 4);
    p.wr = (bf16*)take((size_t)2 * 2 * 48 * D * 2);
    p.wcmpt = (bf16*)take((size_t)2 * 64 * 2048 * 2);
    p.cbias = (float*)take((size_t)128 * 4);
    p.wgut[1] = (bf16*)(w + 228 * MiB);
    p.wdt[1] = (bf16*)(w + 260 * MiB);
    return off > 228 * MiB ? (size_t)1 << 40 : 276 * MiB;
}

extern "C" void kernel_launch(void* const* d_in, const int* in_sizes, int n_in, void* d_out, int out_size, void* d_ws, size_t ws_size,
                              hipStream_t stream) {
    Params p{};
    const float** f = (const float**)&p;
    for (int i = 0; i < 24; ++i) f[i] = (const float*)d_in[i];
    p.out = (float*)d_out;
    const size_t need = carve(p, d_ws);
    static int grid = 0;
    if (grid == 0) {
        int dev = 0, cus = 0, per_cu = 0;
        if (hipGetDevice(&dev) != hipSuccess || hipDeviceGetAttribute(&cus, hipDeviceAttributeMultiprocessorCount, dev) != hipSuccess) { grid = -1; return; }
        if (hipFuncSetAttribute((const void*)k_fast, hipFuncAttributeMaxDynamicSharedMemorySize, LDS_BYTES) != hipSuccess) { fprintf(stderr, "hipFuncSetAttribute failed\n"); grid = -1; return; }
        if (hipOccupancyMaxActiveBlocksPerMultiprocessor(&per_cu, (const void*)k_fast, NWAVES * 64, LDS_BYTES) != hipSuccess || per_cu < 1) { fprintf(stderr, "occupancy query: %d\n", per_cu); (void)hipGetLastError(); grid = -1; return; }
        grid = cus;
        if (need > ws_size) { fprintf(stderr, "workspace too small: need %zu have %zu\n", need, ws_size); grid = -1; return; }
    }
    if (grid < 0) return;
    (void)hipMemsetAsync(d_ws, 0, CTL_ZERO_BYTES, stream);
    FArgs a{}; a.p = p;
    hipLaunchKernelGGL(k_fast, dim3(grid), dim3(NWAVES * 64), LDS_BYTES, stream, a);
}
```

```cpp
#include <hip/hip_runtime.h>
#include <cstdio>
#include <cstdint>
#define DEV __device__ __forceinline__

#ifndef NB
#define NB 8
#endif
typedef unsigned short bf16;
constexpr int S = 2048, D = 1024, T = NB * S, HD = 64;
constexpr int EVEN_IN = 2304, ODD_IN = 2840, LDP = 3072;
constexpr int NCMP = 127, NSLC = 32;
constexpr float NEG = -1e30f;
constexpr float EPS = 1e-6f;
constexpr int RMAX = 2 * T + 32 * 256;

DEV float u2f(unsigned u) { return __builtin_bit_cast(float, u); }
DEV unsigned f2u(float f) { return __builtin_bit_cast(unsigned, f); }
DEV float bf2f(bf16 h) { return u2f(((unsigned)h) << 16); }
DEV bf16 f2bf(float f) { unsigned u = f2u(f); u += 0x7fffu + ((u >> 16) & 1u); return (bf16)(u >> 16); }

struct Params {
    const float *x, *ev_norm, *ev_w_in, *ev_q_norm, *ev_k_norm, *ev_sink, *ev_w_out;
    const float *od_norm, *od_w_in, *od_c_q_norm, *od_c_k_norm, *od_d_q_norm, *od_d_k_norm, *od_cmp_pos, *od_cmp_w, *od_w_out;
    const float *moe_norm, *moe_w_grp, *moe_b_grp, *moe_w_exp, *moe_b_exp, *moe_w_gate, *moe_w_up, *moe_w_down;
    float* out;
    unsigned* ctl;
    bf16 *win0t, *wout0t, *win1t, *wout1t;
    bf16 *wgut[2], *wdt[2];
    bf16* proj;
    bf16* xn;
    bf16* o;
    bf16* ha;
    bf16* hid;
    float* rstd;
    int* eid;
    float* ew;
    float* kmean;
    bf16* kvcmp;
    int* pos;
    bf16* wr;
    bf16* wcmpt;
    float* cbias;
};


namespace pg8 {
#define PG8_LAS __attribute__((address_space(3)))
typedef unsigned short bf16_t;
typedef short bf16x8 __attribute__((ext_vector_type(8)));
typedef float f32x4 __attribute__((ext_vector_type(4)));
typedef unsigned u32x4 __attribute__((ext_vector_type(4)));
constexpr int BM = 256, BK = 64, HALF = 128, HTB = HALF * BK * 2, STAGE_BYTES = 8 * HTB, NXCD = 8, WGM = 8;

__host__ __device__ __forceinline__ int lds_byte(int r, int c) { const int st = (r >> 4) * 2 + (c >> 5), rr = r & 15, cc = c & 31, ob = rr * 64 + cc * 2; return st * 1024 + (ob ^ (((ob >> 9) & 1) << 5)); }
__host__ __device__ __forceinline__ void stage_rc(int b, int& R, int& C) { const int st = b / 1024, sb = b % 1024, swz = sb ^ (((sb >> 9) & 1) << 5); R = (st >> 1) * 16 + swz / 64; C = (st & 1) * 32 + (swz % 64) / 2; }
__host__ __device__ __forceinline__ int perm32(int rho) { const int n = rho >> 4, i = rho & 15; return 8 * (i >> 2) + 4 * n + (i & 3); }

struct Unit { const char* A; const char* B; int pm, pn; };

struct StaticOrder {
    int nM, nN, nwg, G, c; const char* A; const char* Bt; size_t tstep;
    __device__ void init(const bf16_t* A_, const bf16_t* Bt_, int M, int N, int K, int G_, int c_) { nM = M / BM; nN = N / BM; nwg = nM * nN; G = G_; c = c_; A = (const char*)A_; Bt = (const char*)Bt_; tstep = (size_t)BM * K * 2; }
    __device__ bool next(int i, Unit& u) const {
        const long L = (long)i * G + c; if (L >= nwg) return false;
        int wgid = (int)L; { const int q = nwg / NXCD, r = nwg % NXCD, xcd = wgid % NXCD, off = wgid / NXCD; wgid = (xcd < r ? xcd * (q + 1) : r * (q + 1) + (xcd - r) * q) + off; }
        const int nig = WGM * nN, gid = wgid / nig, fm = gid * WGM, gsz = (nM - fm) < WGM ? (nM - fm) : WGM;
        u.pm = fm + ((wgid % nig) % gsz); u.pn = (wgid % nig) / gsz; u.A = A + (size_t)u.pm * tstep; u.B = Bt + (size_t)u.pn * tstep; return true;
    }
};

__device__ __forceinline__ unsigned cvt_pk_bf16(float lo, float hi) { unsigned r; asm volatile("v_cvt_pk_bf16_f32 %0, %1, %2" : "=v"(r) : "v"(lo), "v"(hi)); return r; }

struct EpiStoreBf16 {
    static constexpr bool PERM = true;
    bf16_t* O; int ldc;
    __device__ __forceinline__ void operator()(const f32x4 (&acc)[2][2][4][2], const Unit& u, int wr, int wc, int fr, int fq) const {
        const int row0 = u.pm * BM + wr * 64 + fr, col0 = u.pn * BM + wc * 32 + 8 * fq;
#pragma unroll
        for (int ai = 0; ai < 2; ++ai)
#pragma unroll
            for (int m = 0; m < 4; ++m) { bf16_t* rowp = O + (size_t)(row0 + ai * HALF + m * 16) * ldc + col0;
#pragma unroll
                for (int bj = 0; bj < 2; ++bj) { const f32x4 v0 = acc[ai][bj][m][0], v1 = acc[ai][bj][m][1];
                    u32x4 w; w.x = cvt_pk_bf16(v0[0], v0[1]); w.y = cvt_pk_bf16(v0[2], v0[3]); w.z = cvt_pk_bf16(v1[0], v1[1]); w.w = cvt_pk_bf16(v1[2], v1[3]);
                    *(u32x4*)(rowp + bj * HALF) = w; } }
    }
};

template <int LAYER> struct EpiProjNorm {
    static constexpr bool PERM = true;
    bf16_t* O; int ldc; const float *g0, *g1, *g2, *g3, *g4; PG8_LAS float* hn;
    __device__ __forceinline__ const float* gain_of(int H) const {
        if (LAYER == 0) return H < 8 ? g0 : (H < 10 ? g1 : nullptr);
        return H < 8 ? g0 : H < 16 ? g1 : (H >= 24 && H < 32) ? g2 : (H == 36 || H == 37) ? g3 : (H == 40 || H == 41) ? g4 : nullptr;
    }
    __device__ __forceinline__ void operator()(f32x4 (&acc)[2][2][4][2], const Unit& u, int wr, int wc, int fr, int fq) const {
        const bool any = (LAYER == 0) ? (u.pn < 3) : (u.pn < 4 || u.pn == 6 || u.pn == 7 || u.pn == 9 || u.pn == 10);
        if (any) {
#pragma unroll
            for (int ai = 0; ai < 2; ++ai)
#pragma unroll
                for (int m = 0; m < 4; ++m)
#pragma unroll
                    for (int bj = 0; bj < 2; ++bj) {
                        const f32x4 a = acc[ai][bj][m][0], b = acc[ai][bj][m][1];
                        float ss = (a[0] * a[0] + a[1] * a[1]) + (a[2] * a[2] + a[3] * a[3]) + (b[0] * b[0] + b[1] * b[1]) + (b[2] * b[2] + b[3] * b[3]);
                        ss += __shfl_xor(ss, 16); ss += __shfl_xor(ss, 32);
                        if (fq == 0) hn[(ai * HALF + wr * 64 + m * 16 + fr) * 8 + bj * 4 + wc] = ss;
                    }
        }
        asm volatile("s_waitcnt lgkmcnt(0)" ::: "memory"); __builtin_amdgcn_s_barrier(); asm volatile("" ::: "memory");
        const int row0 = u.pm * BM + wr * 64 + fr, col0 = u.pn * BM + wc * 32 + 8 * fq;
#pragma unroll
        for (int bj = 0; bj < 2; ++bj) {
            const float* g = gain_of(4 * u.pn + 2 * bj + (wc >> 1));
            f32x4 ga = (f32x4){1.f, 1.f, 1.f, 1.f}, gb = ga;
            if (g) { ga = *(const f32x4*)(g + (wc & 1) * 32 + 8 * fq); gb = *(const f32x4*)(g + (wc & 1) * 32 + 8 * fq + 4); }
#pragma unroll
            for (int ai = 0; ai < 2; ++ai)
#pragma unroll
                for (int m = 0; m < 4; ++m) {
                    f32x4 v0 = acc[ai][bj][m][0], v1 = acc[ai][bj][m][1];
                    if (g) { const int rl = (ai * HALF + wr * 64 + m * 16 + fr) * 8 + bj * 4;
                        const float r = 1.0f / sqrtf((hn[rl + wc] + hn[rl + (wc ^ 1)]) * (1.0f / 64) + 1e-6f);
                        v0 = v0 * ga * r; v1 = v1 * gb * r; }
                    u32x4 w; w.x = cvt_pk_bf16(v0[0], v0[1]); w.y = cvt_pk_bf16(v0[2], v0[3]); w.z = cvt_pk_bf16(v1[0], v1[1]); w.w = cvt_pk_bf16(v1[2], v1[3]);
                    *(u32x4*)(O + (size_t)(row0 + ai * HALF + m * 16) * ldc + col0 + bj * HALF) = w;
                }
        }
    }
};
struct EpiResidF32 {
    static constexpr bool PERM = true;
    const float* R; float* O; int ldc;
    __device__ __forceinline__ void operator()(const f32x4 (&acc)[2][2][4][2], const Unit& u, int wr, int wc, int fr, int fq) const {
        const int row0 = u.pm * BM + wr * 64 + fr, col0 = u.pn * BM + wc * 32 + 8 * fq;
#pragma unroll
        for (int ai = 0; ai < 2; ++ai)
#pragma unroll
            for (int m = 0; m < 4; ++m) { const size_t ro = (size_t)(row0 + ai * HALF + m * 16) * ldc + col0;
#pragma unroll
                for (int bj = 0; bj < 2; ++bj) {
                    const f32x4 r0 = *(const f32x4*)(R + ro + bj * HALF), r1 = *(const f32x4*)(R + ro + bj * HALF + 4);
                    *(f32x4*)(O + ro + bj * HALF) = r0 + acc[ai][bj][m][0]; *(f32x4*)(O + ro + bj * HALF + 4) = r1 + acc[ai][bj][m][1]; } }
    }
};
struct EpiSiluMul {
    static constexpr bool PERM = true;
    bf16_t* H; int ldh;
    __device__ __forceinline__ void operator()(const f32x4 (&acc)[2][2][4][2], const Unit& u, int wr, int wc, int fr, int fq) const {
        const int row0 = u.pm * BM + wr * 64 + fr, col0 = u.pn * HALF + wc * 32 + 8 * fq;
#pragma unroll
        for (int ai = 0; ai < 2; ++ai)
#pragma unroll
            for (int m = 0; m < 4; ++m) { bf16_t* rowp = H + (size_t)(row0 + ai * HALF + m * 16) * ldh + col0;
                float h[8];
#pragma unroll
                for (int n = 0; n < 2; ++n)
#pragma unroll
                    for (int j = 0; j < 4; ++j) { const float g = acc[ai][0][m][n][j], up = acc[ai][1][m][n][j]; h[n * 4 + j] = g * up / (1.0f + __expf(-g)); }
                u32x4 w; w.x = cvt_pk_bf16(h[0], h[1]); w.y = cvt_pk_bf16(h[2], h[3]); w.z = cvt_pk_bf16(h[4], h[5]); w.w = cvt_pk_bf16(h[6], h[7]);
                *(u32x4*)rowp = w; }
    }
};

template <class Epi, class Sched>
__device__ __forceinline__ void gemm_phase(PG8_LAS unsigned char* lds, const int K, const Sched& S, const Epi& E, const int tid) {
    const int wid = __builtin_amdgcn_readfirstlane(tid >> 6), lane = tid & 63, wr = wid >> 2, wc = wid & 3, fr = lane & 15, fq = lane >> 4;
    const int nt = K / BK;
    unsigned voffA[2], voffB[2];
#pragma unroll
    for (int i = 0; i < 2; ++i) { int R, C; stage_rc(tid * 16 + i * 8192, R, C); const int Rb = Epi::PERM ? ((R & ~31) + perm32(R & 31)) : R;
        voffA[i] = (unsigned)(R * K + C) * 2u; voffB[i] = (unsigned)(Rb * K + C) * 2u; }
    const size_t kstep = (size_t)(BK * 2);
    const size_t hstep = (size_t)HALF * K * 2;
    const unsigned ldsw = (unsigned)wid * 1024u;
    const int aoff = lds_byte(wr * 64 + fr, fq * 8), boff = lds_byte(wc * 32 + fr, fq * 8);
#define PG8_SA(b, h) (((b) * 2 + (h)) * HTB)
#define PG8_SB(b, h) ((4 + (b) * 2 + (h)) * HTB)
#define PG8_STAGE(bufoff, gbase, voff) do { _Pragma("unroll") for (int _i = 0; _i < 2; ++_i) \
        __builtin_amdgcn_global_load_lds((const unsigned*)((const char*)(gbase) + (voff)[_i]), (PG8_LAS unsigned*)(lds + (bufoff) + ldsw + _i * 8192), 16, 0, 0); } while (0)
#define PG8_LDA(dst, b, h) do { _Pragma("unroll") for (int m = 0; m < 4; ++m) _Pragma("unroll") for (int k = 0; k < 2; ++k) dst[m][k] = *(const PG8_LAS bf16x8*)(lds + PG8_SA(b, h) + aoff + m * 2048 + k * 1024); } while (0)
#define PG8_LDB(dst, b, h) do { _Pragma("unroll") for (int n = 0; n < 2; ++n) _Pragma("unroll") for (int k = 0; k < 2; ++k) dst[n][k] = *(const PG8_LAS bf16x8*)(lds + PG8_SB(b, h) + boff + n * 2048 + k * 1024); } while (0)
#define PG8_MMA(ai, bj, At, Bt) do { __builtin_amdgcn_s_setprio(1); _Pragma("unroll") for (int m = 0; m < 4; ++m) _Pragma("unroll") for (int n = 0; n < 2; ++n) _Pragma("unroll") for (int k = 0; k < 2; ++k) \
        acc[ai][bj][m][n] = __builtin_amdgcn_mfma_f32_16x16x32_bf16(Bt[n][k], At[m][k], acc[ai][bj][m][n], 0, 0, 0); __builtin_amdgcn_s_setprio(0); } while (0)
#define PG8_WAIT_V(n) asm volatile("s_waitcnt vmcnt(" #n ")" ::: "memory")
#define PG8_WAIT_L(n) asm volatile("s_waitcnt lgkmcnt(" #n ")" ::: "memory")
#define PG8_BAR __builtin_amdgcn_s_barrier()
#define PG8_SCHED __builtin_amdgcn_sched_barrier(0)
    Unit cur, nxt; int ui = 0;
    if (!S.next(0, cur)) return;
    f32x4 acc[2][2][4][2];
#pragma unroll
    for (int a = 0; a < 2; ++a)
#pragma unroll
        for (int b = 0; b < 2; ++b)
#pragma unroll
            for (int m = 0; m < 4; ++m)
#pragma unroll
                for (int n = 0; n < 2; ++n) acc[a][b][m][n] = (f32x4){0.f, 0.f, 0.f, 0.f};
    bf16x8 At[4][2], B0[2][2], B1[2][2];
    const char* cA = cur.A; const char* cB = cur.B;
    PG8_STAGE(PG8_SB(0, 0), cB, voffB); PG8_STAGE(PG8_SB(0, 1), cB + hstep, voffB); PG8_STAGE(PG8_SA(0, 0), cA, voffA); PG8_STAGE(PG8_SA(0, 1), cA + hstep, voffA);
    if (wr == 1) PG8_BAR;
    PG8_WAIT_V(2); PG8_BAR;
    PG8_STAGE(PG8_SB(1, 0), cB + kstep, voffB); PG8_STAGE(PG8_SA(1, 0), cA + kstep, voffA); PG8_STAGE(PG8_SB(1, 1), cB + hstep + kstep, voffB);
    PG8_WAIT_V(6); PG8_BAR;
    for (;;) {
        const bool has_next = S.next(ui + 1, nxt);
        const char* nA = has_next ? nxt.A : cA; const char* nB = has_next ? nxt.B : cB;
        for (int t = 0; t < nt; t += 2) {
            const bool last = (t == nt - 2);
            const char* a1 = cA + (size_t)(t + 1) * kstep;
            const char* a2 = last ? nA : cA + (size_t)(t + 2) * kstep; const char* b2 = last ? nB : cB + (size_t)(t + 2) * kstep;
            const char* a3 = a2 + kstep; const char* b3 = b2 + kstep;
            PG8_LDB(B0, 0, 0); PG8_LDB(B1, 0, 1); PG8_SCHED; PG8_LDA(At, 0, 0); PG8_STAGE(PG8_SA(1, 1), a1 + hstep, voffA);
            PG8_WAIT_V(8); PG8_WAIT_L(0); PG8_BAR; PG8_MMA(0, 0, At, B0); PG8_MMA(0, 1, At, B1); PG8_BAR; PG8_SCHED;
            PG8_LDA(At, 0, 1); PG8_STAGE(PG8_SB(0, 0), b2, voffB); PG8_STAGE(PG8_SB(0, 1), b2 + hstep, voffB); PG8_STAGE(PG8_SA(0, 0), a2, voffA);
            PG8_WAIT_V(8); PG8_WAIT_L(0); PG8_BAR; PG8_MMA(1, 0, At, B0); PG8_MMA(1, 1, At, B1); PG8_BAR; PG8_SCHED;
            PG8_LDB(B0, 1, 0); PG8_LDB(B1, 1, 1); PG8_SCHED; PG8_LDA(At, 1, 0); PG8_STAGE(PG8_SA(0, 1), a2 + hstep, voffA);
            PG8_WAIT_V(8); PG8_WAIT_L(0); PG8_BAR; PG8_MMA(0, 0, At, B0); PG8_MMA(0, 1, At, B1); PG8_BAR; PG8_SCHED;
            PG8_LDA(At, 1, 1); PG8_STAGE(PG8_SB(1, 0), b3, voffB); PG8_STAGE(PG8_SB(1, 1), b3 + hstep, voffB); PG8_STAGE(PG8_SA(1, 0), a3, voffA);
            PG8_WAIT_V(8); PG8_WAIT_L(0); PG8_BAR; PG8_MMA(1, 0, At, B0); PG8_MMA(1, 1, At, B1); PG8_BAR; PG8_SCHED;
        }
        if (wr == 0) PG8_BAR;
        { int l2; asm volatile("v_mbcnt_lo_u32_b32 %0, -1, 0\n\tv_mbcnt_hi_u32_b32 %0, -1, %0" : "=v"(l2)); E(acc, cur, wr, wc, l2 & 15, l2 >> 4); }
        if (!has_next) break;
#pragma unroll
        for (int a = 0; a < 2; ++a)
#pragma unroll
            for (int b = 0; b < 2; ++b)
#pragma unroll
                for (int m = 0; m < 4; ++m)
#pragma unroll
                    for (int n = 0; n < 2; ++n) acc[a][b][m][n] = (f32x4){0.f, 0.f, 0.f, 0.f};
        cur = nxt; cA = nA; cB = nB; ++ui;
        if (wr == 1) PG8_BAR;
    }
    PG8_WAIT_V(0);
    PG8_BAR;
#undef PG8_SA
#undef PG8_SB
#undef PG8_STAGE
#undef PG8_LDA
#undef PG8_LDB
#undef PG8_MMA
#undef PG8_WAIT_V
#undef PG8_WAIT_L
#undef PG8_BAR
#undef PG8_SCHED
}
}

#define GAS __attribute__((address_space(1)))
#define LAS __attribute__((address_space(3)))
typedef unsigned v4u __attribute__((ext_vector_type(4)));
typedef float f32x4 __attribute__((ext_vector_type(4)));
typedef short bf16x8 __attribute__((ext_vector_type(8)));
constexpr int NWAVES = 8;
constexpr int RING_BYTES = 131072, LDSCTL_OFF = RING_BYTES, MISC_OFF = LDSCTL_OFF + 320, LDS_BYTES = 147456;
constexpr size_t MiB = 1u << 20;
constexpr size_t CTL_ZERO_BYTES = 1 * MiB;
constexpr int CW_BAR = 4096;
constexpr int CW_MOE = 65536;
#define LDS_WAIT() asm volatile("s_waitcnt lgkmcnt(0)" ::: "memory")
#define VM_WAIT() asm volatile("s_waitcnt vmcnt(0)" ::: "memory")
DEV unsigned pk2(float lo, float hi) { return (unsigned)f2bf(lo) | ((unsigned)f2bf(hi) << 16); }

#define XB_TMO      128
#define XB_XCNT(j)  (256  + 64 * (j))
#define XB_XSUB(j)  (1280 + 64 * (j))
#define XB_XGEN(j)  (2304 + 64 * (j))
#define XB_TOP      3328
#define XB_TOPGEN   3392
#define XCD_BAR_WORDS 3456
#define XB_SPIN_CAP (1u << 22)
DEV unsigned xb_ld(unsigned* p)              { return __hip_atomic_load(p, __ATOMIC_RELAXED, __HIP_MEMORY_SCOPE_AGENT); }
DEV unsigned xb_add(unsigned* p, unsigned v) { return __hip_atomic_fetch_add(p, v, __ATOMIC_RELAXED, __HIP_MEMORY_SCOPE_AGENT); }
DEV unsigned xb_xcc_id() { return (unsigned)__builtin_amdgcn_s_getreg((3 << 11) | 20) & 0xFu; }
#define XB_SPIN(cond, bar) do { unsigned _sp = 0; while (cond) { __builtin_amdgcn_s_sleep(1); \
    if ((++_sp & 255u) == 0u) { if (xb_ld(&(bar)[XB_TMO])) break; if (_sp > XB_SPIN_CAP) { atomicAdd(&(bar)[XB_TMO], 1u); break; } } } } while (0)
struct XcdBarrier { unsigned* bar; unsigned x; volatile LAS unsigned* st; };
DEV XcdBarrier xcd_barrier_post(unsigned* bar, volatile LAS unsigned* st) {
    XcdBarrier b; b.bar = bar; b.x = xb_xcc_id(); b.st = st;
    if (threadIdx.x == 0) (void)xb_add(&bar[XB_XCNT(b.x)], 1u);
    return b;
}
DEV void xcd_barrier_complete(unsigned* bar, unsigned x, unsigned& nloc, unsigned& nx) {
    const unsigned G = gridDim.x * gridDim.y * gridDim.z;
    unsigned sum, cnt, mine, sp = 0u;
    for (;;) {
        sum = 0u; cnt = 0u; mine = 0u;
#pragma unroll
        for (unsigned j = 0; j < 16; ++j) { const unsigned c = xb_ld(&bar[XB_XCNT(j)]); sum += c; cnt += (c > 0u) ? 1u : 0u; mine = (j == x) ? c : mine; }
        if (sum == G) break;
        __builtin_amdgcn_s_sleep(1);
        if ((++sp & 255u) == 0u) { if (xb_ld(&bar[XB_TMO])) break; if (sp > XB_SPIN_CAP) { atomicAdd(&bar[XB_TMO], 1u); break; } }
    }
    nloc = mine > 0u ? mine : 1u; nx = cnt > 0u ? cnt : 1u;
}
DEV void xcd_barrier(const XcdBarrier& b, const int tid_) {
    asm volatile("s_waitcnt vmcnt(0)" ::: "memory");
    __syncthreads();
    if (tid_ == 0) {
        unsigned* bar = b.bar;
        __builtin_amdgcn_s_waitcnt(0);
        unsigned nloc = b.st[0], nx = b.st[1];
        if (nloc == 0u) { xcd_barrier_complete(bar, b.x, nloc, nx); b.st[0] = nloc; b.st[1] = nx; }
        const unsigned old = xb_add(&bar[XB_XSUB(b.x)], 1u);
        const unsigned gen = old / nloc;
        if (old + 1u == (gen + 1u) * nloc) {
            __builtin_amdgcn_fence(__ATOMIC_RELEASE, "agent");
            asm volatile("s_waitcnt vmcnt(0)" ::: "memory");
            const unsigned og = xb_add(&bar[XB_TOP], 1u);
            const unsigned tg = og / nx;
            if (og + 1u == (tg + 1u) * nx) xb_add(&bar[XB_TOPGEN], 1u);
            else XB_SPIN(xb_ld(&bar[XB_TOPGEN]) == tg, bar);
            __builtin_amdgcn_fence(__ATOMIC_ACQUIRE, "agent");
            xb_add(&bar[XB_XGEN(b.x)], 1u);
            asm volatile("s_waitcnt vmcnt(0)" ::: "memory");
        } else {
            XB_SPIN(xb_ld(&bar[XB_XGEN(b.x)]) == gen, bar);
            __builtin_amdgcn_fence(__ATOMIC_ACQUIRE, "agent");
            asm volatile("s_waitcnt vmcnt(0)" ::: "memory");
        }
    }
    __syncthreads();
}

struct Frame {
    LAS unsigned char* lds;
    volatile LAS unsigned* MISC;
    int tid, lane, wave;
    int vcu, G;
};

DEV void refresh(Frame& F) { int l; asm volatile("v_mbcnt_lo_u32_b32 %0, -1, 0\n\tv_mbcnt_hi_u32_b32 %0, -1, %0" : "=v"(l)); F.lane = l; F.tid = F.wave * 64 + l; }
DEV float wave_sum(float v) {
#pragma unroll
    for (int o = 1; o < 64; o <<= 1) v += __shfl_xor(v, o);
    return v;
}
DEV void transpose_item(const float* W, int K, int N, bf16* WT, int k0, int n0, int dst_row0, LAS float* scr, int lane) {
    const int c4 = lane & 7, r0 = lane >> 3;
    const bool okc = (n0 + 4 * c4) < N;
    f32x4 v[8];
#pragma unroll
    for (int i = 0; i < 8; ++i) v[i] = okc ? *(const GAS f32x4*)(W + (size_t)(k0 + r0 + 8 * i) * N + n0 + 4 * c4) : (f32x4){0.f, 0.f, 0.f, 0.f};
#pragma unroll
    for (int i = 0; i < 8; ++i) { LAS float* d = scr + (r0 + 8 * i) * 33 + 4 * c4; d[0] = v[i].x; d[1] = v[i].y; d[2] = v[i].z; d[3] = v[i].w; }
    LDS_WAIT(); asm volatile("" ::: "memory");
    const int c = lane & 7;
#pragma unroll
    for (int j = 0; j < 4; ++j) { const int n = (lane >> 3) + 8 * j; const LAS float* s = scr + (8 * c) * 33 + n;
        v4u o; o.x = pk2(s[0 * 33], s[1 * 33]); o.y = pk2(s[2 * 33], s[3 * 33]); o.z = pk2(s[4 * 33], s[5 * 33]); o.w = pk2(s[6 * 33], s[7 * 33]);
        if (n0 + n < N) *(GAS v4u*)(WT + (size_t)(dst_row0 + n) * K + k0 + 8 * c) = o; }
    LDS_WAIT(); asm volatile("" ::: "memory");
}
DEV float rms_row_to_bf16(int lane, const float* xrow, const float* gain, bf16* orow) {
    const GAS f32x4* xr = (const GAS f32x4*)xrow + lane;
    const GAS f32x4* gr = (const GAS f32x4*)gain + lane;
    f32x4 v[4]; float s = 0.f;
#pragma unroll
    for (int j = 0; j < 4; ++j) { v[j] = xr[64 * j]; s += (v[j].x * v[j].x + v[j].y * v[j].y) + (v[j].z * v[j].z + v[j].w * v[j].w); }
    const float rstd = 1.0f / sqrtf(wave_sum(s) * (1.f / D) + EPS);
    GAS unsigned long long* o8 = (GAS unsigned long long*)orow + lane;
#pragma unroll
    for (int j = 0; j < 4; ++j) { const f32x4 g = gr[64 * j];
        o8[64 * j] = (unsigned long long)pk2(v[j].x * rstd * g.x, v[j].y * rstd * g.y) | ((unsigned long long)pk2(v[j].z * rstd * g.z, v[j].w * rstd * g.w) << 32); }
    return rstd;
}

DEV void fp_convert_weights(const Params& P, Frame& F, int which, int ci, int n) {
    LAS float* scr = (LAS float*)(F.lds + F.wave * 16384);
    const int gw = ci * NWAVES + F.wave, NGW = n * NWAVES;
    constexpr int I_IN0 = 16 * 72, I_OUT = 16 * 32, I_IN1 = 16 * 89;
    if (which == 0) {
        for (int it = gw; it < I_IN0 + I_OUT; it += NGW) {
            int r = it;
            if (r < I_IN0) { const int kb = r / 72, nb = r % 72; transpose_item(P.ev_w_in, D, EVEN_IN, P.win0t, 64 * kb, 32 * nb, 32 * nb, scr, F.lane); continue; } r -= I_IN0;
            { const int kb = r / 32, nb = r % 32; transpose_item(P.ev_w_out, D, D, P.wout0t, 64 * kb, 32 * nb, 32 * nb, scr, F.lane); }
        }
    } else {
        for (int it = gw; it < I_IN1 + I_OUT; it += NGW) {
            int r = it;
            if (r < I_IN1) { const int kb = r / 89, nb = r % 89; transpose_item(P.od_w_in, D, ODD_IN, P.win1t, 64 * kb, 32 * nb, 32 * nb, scr, F.lane); continue; } r -= I_IN1;
            { const int kb = r / 32, nb = r % 32; transpose_item(P.od_w_out, D, D, P.wout1t, 64 * kb, 32 * nb, 32 * nb, scr, F.lane); }
        }
    }
}
DEV void fp_norm_rows(Frame& F, const float* src, const float* gain, bf16* xn) {
    const int gw = F.vcu * NWAVES + F.wave, NGW = F.G * NWAVES;
    for (int m = gw; m < T; m += NGW) rms_row_to_bf16(F.lane, src + (size_t)m * D, gain, xn + (size_t)m * D);
}

constexpr int TAB_OFF = MISC_OFF + 128;
constexpr int RT_PART_OFF = 0;
constexpr int RT_SS_OFF = 98304;
constexpr int RT_HIST_OFF = 100352;
typedef float f32x4v __attribute__((ext_vector_type(4)));

DEV void fp_prep_router(const Params& P, Frame& F) {
    const int gtid = F.vcu * NWAVES * 64 + F.tid, gsz = F.G * NWAVES * 64;
    for (int i = gtid; i < 2 * 48 * D; i += gsz) {
        const int k = i & (D - 1), j = (i >> 10) % 48, l = i / (48 * D);
        float w = 0.f;
        if (j < 4) w = P.moe_w_grp[((size_t)l * D + k) * 4 + j]; else if (j < 36) w = P.moe_w_exp[((size_t)l * D + k) * 32 + (j - 4)];
        w *= P.moe_norm[l * D + k];
        const bf16 hi = f2bf(w); const bf16 lo = f2bf(w - bf2f(hi));
        P.wr[((size_t)(l * 2 + 0) * 48 + j) * D + k] = hi;
        P.wr[((size_t)(l * 2 + 1) * 48 + j) * D + k] = lo;
    }
}

DEV void fp_route(const Params& P, Frame& F, int layer) {
    const int lane = F.lane, w = F.wave;
    const bf16* wr_hi = P.wr + (size_t)(layer * 2 + 0) * 48 * D;
    const bf16* wr_lo = P.wr + (size_t)(layer * 2 + 1) * 48 * D;
    LAS float* part = (LAS float*)(F.lds + RT_PART_OFF);
    LAS float* ssp = (LAS float*)(F.lds + RT_SS_OFF);
    LAS unsigned* hist = (LAS unsigned*)(F.lds + RT_HIST_OFF);
    unsigned* cnt = P.ctl + CW_MOE + layer * 256;
    for (int tb = F.vcu; tb < T / 64; tb += F.G) {
        const int t0 = tb * 64;
        if (F.tid < 64) hist[F.tid] = 0u;
        const float* xrow = P.out + (size_t)(t0 + (lane & 15)) * D + 128 * w + 8 * (lane >> 4);
        const size_t boff = (size_t)(lane & 15) * D + 128 * w + 8 * (lane >> 4);
        pg8::f32x4 acc[4][3];
        float ss[4] = {0.f, 0.f, 0.f, 0.f};
#pragma unroll
        for (int g = 0; g < 4; ++g)
#pragma unroll
            for (int c = 0; c < 3; ++c) acc[g][c] = (pg8::f32x4){0.f, 0.f, 0.f, 0.f};
#pragma unroll 1
        for (int ks = 0; ks < 4; ++ks) {
            bf16x8 bh[3], bl[3];
#pragma unroll
            for (int c = 0; c < 3; ++c) { bh[c] = *(const bf16x8*)(wr_hi + boff + (size_t)16 * c * D + 32 * ks); bl[c] = *(const bf16x8*)(wr_lo + boff + (size_t)16 * c * D + 32 * ks); }
            f32x4v xa[4], xb[4];
#pragma unroll
            for (int g = 0; g < 4; ++g) { xa[g] = *(const f32x4v*)(xrow + (size_t)16 * g * D + 32 * ks); xb[g] = *(const f32x4v*)(xrow + (size_t)16 * g * D + 32 * ks + 4); }
#pragma unroll
            for (int g = 0; g < 4; ++g) {
                float xv[8] = {xa[g].x, xa[g].y, xa[g].z, xa[g].w, xb[g].x, xb[g].y, xb[g].z, xb[g].w};
                bf16x8 ah, al;
#pragma unroll
                for (int j = 0; j < 8; ++j) { ss[g] += xv[j] * xv[j]; const bf16 h = f2bf(xv[j]); ah[j] = (short)h; al[j] = (short)f2bf(xv[j] - bf2f(h)); }
#pragma unroll
                for (int c = 0; c < 3; ++c) {
                    acc[g][c] = __builtin_amdgcn_mfma_f32_16x16x32_bf16(ah, bh[c], acc[g][c], 0, 0, 0);
                    acc[g][c] = __builtin_amdgcn_mfma_f32_16x16x32_bf16(ah, bl[c], acc[g][c], 0, 0, 0);
                    acc[g][c] = __builtin_amdgcn_mfma_f32_16x16x32_bf16(al, bh[c], acc[g][c], 0, 0, 0);
                }
            }
        }
#pragma unroll
        for (int g = 0; g < 4; ++g) {
            float s = ss[g]; s += __shfl_xor(s, 16); s += __shfl_xor(s, 32);
            if (lane < 16) ssp[w * 64 + 16 * g + lane] = s;
#pragma unroll
            for (int c = 0; c < 3; ++c)
#pragma unroll
                for (int r = 0; r < 4; ++r) part[(w * 64 + 16 * g + 4 * (lane >> 4) + r) * 48 + 16 * c + (lane & 15)] = acc[g][c][r];
        }
        __syncthreads();
        for (int i = F.tid; i < 64 * 48; i += NWAVES * 64) { float a = part[i];
#pragma unroll
            for (int ww = 1; ww < 8; ++ww) a += part[ww * 64 * 48 + i];
            part[i] = a; }
        if (F.tid < 64) { float a = ssp[F.tid];
#pragma unroll
            for (int ww = 1; ww < 8; ++ww) a += ssp[ww * 64 + F.tid];
            ssp[F.tid] = a; }
        __syncthreads();
        int e1 = 0, e2 = 0; float w1 = 0.f, w2 = 0.f; unsigned r1 = 0, r2 = 0;
        if (F.tid < 64) {
            const int t = t0 + F.tid;
            const float rs = 1.0f / sqrtf(ssp[F.tid] * (1.f / D) + EPS);
            P.rstd[t] = rs;
            float lg[4], le[32];
#pragma unroll
            for (int j = 0; j < 4; ++j) lg[j] = part[F.tid * 48 + j] * rs + P.moe_b_grp[layer * 4 + j];
#pragma unroll
            for (int j = 0; j < 32; ++j) le[j] = part[F.tid * 48 + 4 + j] * rs + P.moe_b_exp[layer * 32 + j];
            int gs = 0; float gm = lg[0];
#pragma unroll
            for (int j = 1; j < 4; ++j) if (lg[j] > gm) { gm = lg[j]; gs = j; }
            float gz = 0.f;
#pragma unroll
            for (int j = 0; j < 4; ++j) gz += expf(lg[j] - gm);
            const float pg = 1.0f / gz;
            float wv[8];
#pragma unroll
            for (int j = 0; j < 8; ++j) wv[j] = gs == 0 ? le[j] : gs == 1 ? le[8 + j] : gs == 2 ? le[16 + j] : le[24 + j];
            int i1 = 0; float m1 = wv[0];
#pragma unroll
            for (int j = 1; j < 8; ++j) if (wv[j] > m1) { m1 = wv[j]; i1 = j; }
            int i2 = -1; float m2 = -3e38f;
#pragma unroll
            for (int j = 0; j < 8; ++j) if (j != i1 && wv[j] > m2) { m2 = wv[j]; i2 = j; }
            const float ex2 = expf(m2 - m1);
            w1 = pg / (1.0f + ex2); w2 = pg * ex2 / (1.0f + ex2);
            e1 = gs * 8 + i1; e2 = gs * 8 + i2;
            r1 = __hip_atomic_fetch_add(&hist[e1], 1u, __ATOMIC_RELAXED, __HIP_MEMORY_SCOPE_WORKGROUP); r2 = __hip_atomic_fetch_add(&hist[e2], 1u, __ATOMIC_RELAXED, __HIP_MEMORY_SCOPE_WORKGROUP);
        }
        __syncthreads();
        if (F.tid < 32) { const unsigned h = hist[F.tid]; hist[32 + F.tid] = h ? xb_add(&cnt[F.tid], h) : 0u; }
        __syncthreads();
        if (F.tid < 64) {
            const int t = t0 + F.tid;
            P.eid[t * 2 + 0] = e1; P.eid[t * 2 + 1] = e2; P.ew[t * 2 + 0] = w1; P.ew[t * 2 + 1] = w2;
            P.pos[t * 2 + 0] = (int)(hist[32 + e1] + r1); P.pos[t * 2 + 1] = (int)(hist[32 + e2] + r2);
        }
        __syncthreads();
    }
}

DEV void moe_table(const Params& P, Frame& F, int layer) {
    volatile LAS int* tab = (volatile LAS int*)(F.lds + TAB_OFF);
    if (F.tid == 0) {
        unsigned* cnt = P.ctl + CW_MOE + layer * 256;
        int acc = 0;
        for (int e = 0; e < 32; ++e) { tab[e] = acc; acc += (int)((xb_ld(&cnt[e]) + 255u) >> 8); }
        tab[32] = acc;
    }
    __syncthreads();
}

DEV void fp_gather(const Params& P, Frame& F, int layer) {
    moe_table(P, F, layer);
    volatile LAS int* tab = (volatile LAS int*)(F.lds + TAB_OFF);
    const float* gain = P.moe_norm + layer * D;
    const int gw = F.vcu * NWAVES + F.wave, NGW = F.G * NWAVES, lane = F.lane;
    for (int t = gw; t < T; t += NGW) {
        const int e1 = P.eid[t * 2], e2 = P.eid[t * 2 + 1];
        const int p1 = tab[e1] * 256 + P.pos[t * 2], p2 = tab[e2] * 256 + P.pos[t * 2 + 1];
        const GAS f32x4* xr = (const GAS f32x4*)(P.out + (size_t)t * D) + lane;
        const GAS f32x4* gr = (const GAS f32x4*)gain + lane;
        const float rstd = P.rstd[t];
        GAS unsigned long long* o1 = (GAS unsigned long long*)(P.ha + (size_t)p1 * D) + lane;
        GAS unsigned long long* o2 = (GAS unsigned long long*)(P.ha + (size_t)p2 * D) + lane;
#pragma unroll
        for (int j = 0; j < 4; ++j) { const f32x4 v = xr[64 * j], g = gr[64 * j];
            const unsigned long long q = (unsigned long long)pk2(v.x * rstd * g.x, v.y * rstd * g.y) | ((unsigned long long)pk2(v.z * rstd * g.z, v.w * rstd * g.w) << 32);
            o1[64 * j] = q; o2[64 * j] = q; }
        if (lane == 0) { P.pos[t * 2] = p1; P.pos[t * 2 + 1] = p2; }
    }
}

struct ListOrder {
    int code[4]; int n, npn; const char* A; const char* Bt; size_t tstep;
    __device__ __forceinline__ bool next(int i, pg8::Unit& o) const {
        if (i >= n) return false;
        const int c = (i == 0) ? code[0] : (i == 1) ? code[1] : (i == 2) ? code[2] : code[3];
        const int tt = c >> 8, e = (c >> 3) & 31, pn = c & 7;
        o.pm = tt; o.pn = pn; o.A = A + (size_t)tt * tstep; o.B = Bt + (size_t)(e * npn + pn) * tstep; return true;
    }
};
DEV void fp_moe_fused(const Params& P, Frame& F, int layer, int ci, int ncu) {
    moe_table(P, F, layer);
    volatile LAS int* tab = (volatile LAS int*)(F.lds + TAB_OFF);
    const int ntile = __builtin_amdgcn_readfirstlane(tab[32]);
#pragma unroll
    for (int rep = 0; rep < 2; ++rep) { const int tt = ci + rep * ncu; if (tt >= ntile) break;
        int e = 0;
        for (int q = 1; q < 32; ++q) e += (tt >= tab[q]) ? 1 : 0;
        e = __builtin_amdgcn_readfirstlane(e);
        const int cb = (tt << 8) | (e << 3);
        { ListOrder L; L.tstep = (size_t)256 * D * 2; L.A = (const char*)P.ha; L.Bt = (const char*)P.wgut[layer]; L.npn = 2; L.n = 2;
          L.code[0] = cb; L.code[1] = cb | 1; L.code[2] = 0; L.code[3] = 0;
          pg8::EpiSiluMul E{P.hid, 256}; pg8::gemm_phase(F.lds, D, L, E, F.tid); }
        refresh(F);
        if (F.tid == 0) { __builtin_amdgcn_fence(__ATOMIC_ACQUIRE, "agent"); asm volatile("s_waitcnt vmcnt(0)" ::: "memory"); }
        __syncthreads();
        { ListOrder L; L.tstep = (size_t)256 * 256 * 2; L.A = (const char*)P.hid; L.Bt = (const char*)P.wdt[layer]; L.npn = 4; L.n = 4;
          L.code[0] = cb; L.code[1] = cb | 1; L.code[2] = cb | 2; L.code[3] = cb | 3;
          pg8::EpiStoreBf16 E{P.ha, D}; pg8::gemm_phase(F.lds, 256, L, E, F.tid); }
        refresh(F);
    }
}
DEV void fp_combine(const Params& P, Frame& F, const float* gain2, bf16* xn) {
    const int gw = F.vcu * NWAVES + F.wave, NGW = F.G * NWAVES, lane = F.lane;
    for (int t = gw; t < T; t += NGW) {
        const int p1 = P.pos[t * 2], p2 = P.pos[t * 2 + 1];
        const float w1 = P.ew[t * 2], w2 = P.ew[t * 2 + 1];
        GAS f32x4* xr = (GAS f32x4*)(P.out + (size_t)t * D) + lane;
        const GAS unsigned long long* y1 = (const GAS unsigned long long*)(P.ha + (size_t)p1 * D) + lane;
        const GAS unsigned long long* y2 = (const GAS unsigned long long*)(P.ha + (size_t)p2 * D) + lane;
        f32x4 v[4]; float s = 0.f;
#pragma unroll
        for (int j = 0; j < 4; ++j) {
            v[j] = xr[64 * j];
            const unsigned long long a = y1[64 * j], b = y2[64 * j];
            v[j].x += w1 * u2f((unsigned)(a & 0xffffu) << 16) + w2 * u2f((unsigned)(b & 0xffffu) << 16);
            v[j].y += w1 * u2f((unsigned)((a >> 16) & 0xffffu) << 16) + w2 * u2f((unsigned)((b >> 16) & 0xffffu) << 16);
            v[j].z += w1 * u2f((unsigned)((a >> 32) & 0xffffu) << 16) + w2 * u2f((unsigned)((b >> 32) & 0xffffu) << 16);
            v[j].w += w1 * u2f((unsigned)((a >> 48) & 0xffffu) << 16) + w2 * u2f((unsigned)((b >> 48) & 0xffffu) << 16);
            xr[64 * j] = v[j];
            s += (v[j].x * v[j].x + v[j].y * v[j].y) + (v[j].z * v[j].z + v[j].w * v[j].w);
        }
        if (xn) {
            const float rstd = 1.0f / sqrtf(wave_sum(s) * (1.f / D) + EPS);
            const GAS f32x4* gr = (const GAS f32x4*)gain2 + lane;
            GAS unsigned long long* o8 = (GAS unsigned long long*)(xn + (size_t)t * D) + lane;
#pragma unroll
            for (int j = 0; j < 4; ++j) { const f32x4 g = gr[64 * j];
                o8[64 * j] = (unsigned long long)pk2(v[j].x * rstd * g.x, v[j].y * rstd * g.y) | ((unsigned long long)pk2(v[j].z * rstd * g.z, v[j].w * rstd * g.w) << 32); }
        }
    }
}


DEV void fp_convert_moe_part(const Params& P, Frame& F, int layer, int ci, int nconv) {
    LAS float* scr = (LAS float*)(F.lds + F.wave * 16384);
    constexpr int NIT = 32 * 384;
    for (int it = ci * NWAVES + F.wave; it < NIT; it += nconv * NWAVES) {
        const int e = it / 384; int r = it % 384;
        const size_t eo = (size_t)(layer * 32 + e);
        if (r < 256) { const bool up = r >= 128; r &= 127; const int kb = r / 8, nb = r % 8; const int f0 = 32 * nb;
            const float* W = (up ? P.moe_w_up : P.moe_w_gate) + eo * D * 256;
            transpose_item(W, D, 256, P.wgut[layer] + (size_t)e * 512 * D, 64 * kb, f0, (f0 >> 7) * 256 + (up ? 128 : 0) + (f0 & 127), scr, F.lane);
        } else { r -= 256; const int kb = r / 32, nb = r % 32;
            transpose_item(P.moe_w_down + eo * 256 * D, 256, D, P.wdt[layer] + (size_t)e * D * 256, 64 * kb, 32 * nb, 32 * nb, scr, F.lane); }
    }
}
namespace att {
typedef float f32x16 __attribute__((ext_vector_type(16)));
typedef short s16x4 __attribute__((ext_vector_type(4)));
typedef short v4i16_t __attribute__((ext_vector_type(4)));
typedef LAS const char* lptr;
constexpr float LOG2E = 1.4426950408889634f;
constexpr int KS0 = 0, VS0 = 32768, SLOT = 8192;
constexpr int SCR0 = 65536;
constexpr float MNEG = -1e30f;

struct TileRegs { v4u k, v; };
DEV void tile_load(TileRegs& R, const bf16* Kg, const bf16* Vg, int pitch, int k0, int tid) {
    const int w = tid >> 6, lane = tid & 63;
    R.k = *(const GAS v4u*)(Kg + (size_t)(k0 + lane) * pitch + w * 8);
    R.v = *(const GAS v4u*)(Vg + (size_t)(k0 + 16 * (w & 3) + (lane >> 2)) * pitch + (w >> 2) * 32 + (lane & 3) * 8);
}
DEV void tile_store(LAS unsigned char* lds, int slot, const TileRegs& R, int tid) {
    *(LAS v4u*)(lds + KS0 + slot * SLOT + tid * 16) = R.k;
    *(LAS v4u*)(lds + VS0 + slot * SLOT + tid * 16) = R.v;
}
DEV void qk_tile(f32x16& p0, f32x16& p1, lptr Kslot, const bf16x8 (&qr)[4], int r32, int hi) {
    lptr kb = Kslot + hi * 1024 + r32 * 16;
    p0 = f32x16{}; p1 = f32x16{};
#pragma unroll
    for (int dh = 0; dh < 2; ++dh) {
        bf16x8 kf[4];
#pragma unroll
        for (int d1 = 0; d1 < 2; ++d1) { kf[2 * d1] = *(const LAS bf16x8*)(kb + (2 * dh + d1) * 2048); kf[2 * d1 + 1] = *(const LAS bf16x8*)(kb + (2 * dh + d1) * 2048 + 512); }
#pragma unroll
        for (int d1 = 0; d1 < 2; ++d1) {
            p0 = __builtin_amdgcn_mfma_f32_32x32x16_bf16(kf[2 * d1], qr[2 * dh + d1], p0, 0, 0, 0);
            p1 = __builtin_amdgcn_mfma_f32_32x32x16_bf16(kf[2 * d1 + 1], qr[2 * dh + d1], p1, 0, 0, 0);
        }
    }
}
DEV s16x4 vtr(lptr p) { return __builtin_bit_cast(s16x4, __builtin_amdgcn_ds_read_tr16_b64_v4i16((LAS v4i16_t*)p)); }
DEV unsigned cvtpk(float lo, float hi) { unsigned r; asm volatile("v_cvt_pk_bf16_f32 %0, %1, %2" : "=v"(r) : "v"(lo), "v"(hi)); return r; }
DEV void pv_tile(f32x16 (&o)[2], lptr Vslot, const f32x16& p0, const f32x16& p1, int lane) {
    const int hi = lane >> 5;
    lptr vp = Vslot + ((lane >> 4) & 1) * 32 + (lane & 3) * 8 + (4 * hi + ((lane & 15) >> 2)) * 64;
    bf16x8 pf[4];
#pragma unroll
    for (int ks = 0; ks < 4; ++ks) {
        const f32x16& p = (ks < 2) ? p0 : p1; const int b = (ks & 1) * 8;
        v4u w; w.x = cvtpk(p[b + 0], p[b + 1]); w.y = cvtpk(p[b + 2], p[b + 3]); w.z = cvtpk(p[b + 4], p[b + 5]); w.w = cvtpk(p[b + 6], p[b + 7]);
        pf[ks] = __builtin_bit_cast(bf16x8, w);
    }
#pragma unroll
    for (int d0 = 0; d0 < 2; ++d0)
#pragma unroll
        for (int ks = 0; ks < 4; ++ks) {
            const s16x4 lo = vtr(vp + d0 * 4096 + ks * 1024), hh = vtr(vp + d0 * 4096 + ks * 1024 + 512);
            const bf16x8 vf = (bf16x8){lo[0], lo[1], lo[2], lo[3], hh[0], hh[1], hh[2], hh[3]};
            o[d0] = __builtin_amdgcn_mfma_f32_32x32x16_bf16(vf, pf[ks], o[d0], 0, 0, 0);
        }
}
DEV float lane_swap_max(float m) {
    auto rr = __builtin_amdgcn_permlane32_swap(__float_as_uint(m), __float_as_uint(m), false, false);
    return fmaxf(__uint_as_float(rr[0]), __uint_as_float(rr[1]));
}
DEV float lane_swap_sum(float m) {
    auto rr = __builtin_amdgcn_permlane32_swap(__float_as_uint(m), __float_as_uint(m), false, false);
    return __uint_as_float(rr[0]) + __uint_as_float(rr[1]);
}
DEV float lane_partner(float m, int hi) {
    auto rr = __builtin_amdgcn_permlane32_swap(__float_as_uint(m), __float_as_uint(m), false, false);
    return hi ? __uint_as_float(rr[0]) : __uint_as_float(rr[1]);
}

constexpr float M0 = 16.0f;
struct SoftState { float l; f32x16 o[2]; };
DEV void soft_reset(SoftState& s) { s.l = 0.f; s.o[0] = f32x16{}; s.o[1] = f32x16{}; }

DEV void soft_tile(SoftState& st, f32x16& p0, f32x16& p1, float s2, float k0rel_f, int klo, int klim, bool need_mask, lptr Vslot, int lane) {
    const int hi = lane >> 5;
    const float c1 = 0.125f * LOG2E;
    const float base = s2 * (k0rel_f + (float)(4 * hi)) - M0;
    float ls0 = 0.f, ls1 = 0.f;
    if (need_mask) {
#pragma unroll
        for (int r = 0; r < 16; ++r) {
            const int kr = (r & 3) + 8 * (r >> 2);
            const float x0 = __builtin_amdgcn_exp2f(fmaf(p0[r], c1, fmaf(s2, (float)kr, base)));
            const float x1 = __builtin_amdgcn_exp2f(fmaf(p1[r], c1, fmaf(s2, (float)(kr + 32), base)));
            p0[r] = (kr > klo && kr <= klim) ? x0 : 0.f; p1[r] = (kr + 32 > klo && kr + 32 <= klim) ? x1 : 0.f;
            ls0 += p0[r]; ls1 += p1[r];
        }
    } else {
#pragma unroll
        for (int r = 0; r < 16; ++r) {
            const int kr = (r & 3) + 8 * (r >> 2);
            p0[r] = __builtin_amdgcn_exp2f(fmaf(p0[r], c1, fmaf(s2, (float)kr, base)));
            p1[r] = __builtin_amdgcn_exp2f(fmaf(p1[r], c1, fmaf(s2, (float)(kr + 32), base)));
            ls0 += p0[r]; ls1 += p1[r];
        }
    }
    st.l += ls0 + ls1;
    pv_tile(st.o, Vslot, p0, p1, lane);
}

DEV void store_ot(const f32x16 (&o)[2], float f, bf16* orow, int hi) {
#pragma unroll
    for (int d0 = 0; d0 < 2; ++d0)
#pragma unroll
        for (int g = 0; g < 4; ++g) {
            const unsigned a = cvtpk(o[d0][4 * g] * f, o[d0][4 * g + 1] * f), b = cvtpk(o[d0][4 * g + 2] * f, o[d0][4 * g + 3] * f);
            *(GAS unsigned long long*)(orow + 32 * d0 + 8 * g + 4 * hi) = (unsigned long long)a | ((unsigned long long)b << 32);
        }
}
DEV void load_q(bf16x8 (&qr)[4], const bf16* qrow, int hi) {
#pragma unroll
    for (int d0 = 0; d0 < 4; ++d0) qr[d0] = *(const GAS bf16x8*)(qrow + 16 * d0 + 8 * hi);
}

template <class MaskF>
DEV void run_segment(Frame& F, SoftState& st, const bf16x8 (&qr)[4], const bf16* Kg, const bf16* Vg, int pitch, unsigned long long tmask, float s2, int qpos, const MaskF& mf) {
    const int tid = F.tid, lane = F.lane, r32 = lane & 31, hi = lane >> 5;
    if (tmask == 0ull) return;
#define NEXT_TILE(var) do { if (tmask) { var = __builtin_ctzll(tmask); tmask &= tmask - 1ull; } else var = -1; } while (0)
#define SEG_COMPUTE(t, slot) do { int klo, klim; mf((t), klo, klim); \
        if (__any(klim >= 0 && klo < 60 && klim > klo)) { const bool need_mask = __any(klo >= 0 || klim < 60); f32x16 p0, p1; \
            qk_tile(p0, p1, (lptr)(F.lds + KS0 + (slot) * SLOT), qr, r32, hi); \
            soft_tile(st, p0, p1, s2, (float)((t) * 64 - qpos), klo, klim, need_mask, (lptr)(F.lds + VS0 + (slot) * SLOT), lane); } } while (0)
    int ta, tb, tc, td, set = 0;
    NEXT_TILE(ta); NEXT_TILE(tb);
    TileRegs RA, RB; tile_load(RA, Kg, Vg, pitch, ta * 64, tid); if (tb >= 0) tile_load(RB, Kg, Vg, pitch, tb * 64, tid);
    for (;;) {
        tile_store(F.lds, 2 * set, RA, tid); if (tb >= 0) tile_store(F.lds, 2 * set + 1, RB, tid);
        NEXT_TILE(tc); NEXT_TILE(td);
        if (tc >= 0) tile_load(RA, Kg, Vg, pitch, tc * 64, tid);
        if (td >= 0) tile_load(RB, Kg, Vg, pitch, td * 64, tid);
        __syncthreads();
        SEG_COMPUTE(ta, 2 * set);
        if (tb >= 0) SEG_COMPUTE(tb, 2 * set + 1);
        if (tc < 0) break;
        ta = tc; tb = td; set ^= 1;
    }
    __syncthreads();
#undef NEXT_TILE
#undef SEG_COMPUTE
}
DEV unsigned long long tile_range(int t0, int t1) { return (t1 < t0) ? 0ull : ((~0ull >> (63 - (t1 - t0))) << t0); }
}

DEV void headnorm_group(bf16* row, int off, int nheads, const float* g, int lane) {
    const int hg = lane >> 3, ch = lane & 7;
    if (hg < nheads) {
        GAS v4u* p = (GAS v4u*)(row + off + hg * 64 + ch * 8);
        const v4u x = *p;
        float v[8] = {u2f(x.x << 16), u2f(x.x & 0xffff0000u), u2f(x.y << 16), u2f(x.y & 0xffff0000u), u2f(x.z << 16), u2f(x.z & 0xffff0000u), u2f(x.w << 16), u2f(x.w & 0xffff0000u)};
        float ss = 0.f;
#pragma unroll
        for (int j = 0; j < 8; ++j) ss += v[j] * v[j];
        ss += __shfl_xor(ss, 1); ss += __shfl_xor(ss, 2); ss += __shfl_xor(ss, 4);
        const float r = 1.0f / sqrtf(ss * (1.0f / 64) + EPS);
        const f32x4 g0 = *(const GAS f32x4*)(g + ch * 8), g1 = *(const GAS f32x4*)(g + ch * 8 + 4);
        v4u o; o.x = pk2(v[0] * r * g0.x, v[1] * r * g0.y); o.y = pk2(v[2] * r * g0.z, v[3] * r * g0.w); o.z = pk2(v[4] * r * g1.x, v[5] * r * g1.y); o.w = pk2(v[6] * r * g1.z, v[7] * r * g1.w);
        *p = o;
    }
}
DEV void fp_headnorm(const Params& P, Frame& F, int layer) {
    const int gw = F.vcu * NWAVES + F.wave, NGW = F.G * NWAVES, lane = F.lane;
    for (int t = gw; t < T; t += NGW) {
        bf16* row = P.proj + (size_t)t * LDP;
        if (layer == 0) {
            headnorm_group(row, 0, 8, P.ev_q_norm, lane);
            headnorm_group(row, 512, 2, P.ev_k_norm, lane);
        } else {
            headnorm_group(row, 0, 8, P.od_c_q_norm, lane);
            headnorm_group(row, 512, 8, P.od_c_k_norm, lane);
            headnorm_group(row, 1536, 8, P.od_d_q_norm, lane);
            headnorm_group(row, 2304, 2, P.od_d_k_norm + 64, lane);
            headnorm_group(row, 2560, 2, P.od_d_k_norm + 128, lane);
        }
    }
}

DEV void fp_prep_compress(const Params& P, Frame& F, int ci, int n) {
    const int gw = ci * NWAVES + F.wave, NGW = n * NWAVES, lane = F.lane;
    for (int i = gw; i < 128; i += NGW) {
        const int which = i >> 6, e = i & 63;
        const float* pos = P.od_cmp_pos + which * 2048; const float* w = P.od_cmp_w + (size_t)which * 2048 * 64 + e;
        float s = 0.f;
        for (int k = lane; k < 2048; k += 64) s += pos[k] * w[(size_t)k * 64];
        s = wave_sum(s);
        if (lane == 0) P.cbias[i] = s;
    }
    LAS float* scr = (LAS float*)(F.lds + F.wave * 16384);
    for (int i = gw; i < 128; i += NGW) {
        const int which = i >> 6, r = i & 63, kb = r >> 1, nb = r & 1;
        transpose_item(P.od_cmp_w + (size_t)which * 2048 * 64, 2048, 64, P.wcmpt + (size_t)which * 64 * 2048, 64 * kb, 32 * nb, 32 * nb, scr, lane);
    }
}

DEV void fp_prep1(const Params& P, Frame& F) {
    const int gw = F.vcu * NWAVES + F.wave, NGW = F.G * NWAVES, lane = F.lane, w = F.wave;
    for (int i = gw; i < NB * 64; i += NGW) {
        const int n = i & 7, h = (i >> 3) & 7, b = i >> 6;
        const bf16* kp = P.proj + ((size_t)b * S + n * 256) * LDP + 512 + h * 64 + lane;
        float s0 = 0.f, s1 = 0.f, s2 = 0.f, s3 = 0.f;
#pragma unroll 4
        for (int j = 0; j < 256; j += 4) { s0 += bf2f(kp[(size_t)j * LDP]); s1 += bf2f(kp[(size_t)(j + 1) * LDP]); s2 += bf2f(kp[(size_t)(j + 2) * LDP]); s3 += bf2f(kp[(size_t)(j + 3) * LDP]); }
        P.kmean[(size_t)i * 64 + lane] = ((s0 + s1) + (s2 + s3)) * (1.0f / 256);
    }
    LAS float* part = (LAS float*)F.lds;
    for (int it = F.vcu; it < 2 * NB * 2 * 8; it += F.G) {
        const int ng = it & 7, hkv = (it >> 3) & 1, b = (it >> 4) % NB, which = it / (16 * NB);
        const int n = 16 * ng + (lane & 15);
        const int ncl = n > 126 ? 126 : n;
        const bf16* arow = P.proj + ((size_t)b * S + ncl * 16) * LDP + (which ? 2176 : 2048) + hkv * 64 + 8 * (lane >> 4);
        const bf16* brow = P.wcmpt + (size_t)which * 64 * 2048 + (size_t)(lane & 15) * 2048 + 8 * (lane >> 4);
        pg8::f32x4 acc[4];
#pragma unroll
        for (int c = 0; c < 4; ++c) acc[c] = (pg8::f32x4){0.f, 0.f, 0.f, 0.f};
#pragma unroll
        for (int kk = 0; kk < 8; ++kk) {
            const int ks = 8 * w + kk, li = ks >> 1, dh = (ks & 1) * 32;
            const bf16x8 a = *(const GAS bf16x8*)(arow + (size_t)li * LDP + dh);
#pragma unroll
            for (int c = 0; c < 4; ++c) {
                const bf16x8 bb = *(const GAS bf16x8*)(brow + (size_t)(16 * c) * 2048 + 32 * ks);
                acc[c] = __builtin_amdgcn_mfma_f32_16x16x32_bf16(a, bb, acc[c], 0, 0, 0);
            }
        }
#pragma unroll
        for (int c = 0; c < 4; ++c)
#pragma unroll
            for (int r = 0; r < 4; ++r) part[(w * 16 + 4 * (lane >> 4) + r) * 64 + 16 * c + (lane & 15)] = acc[c][r];
        __syncthreads();
        {
            const int row = F.tid >> 5, c0 = 2 * (F.tid & 31);
            float v0 = P.cbias[which * 64 + c0], v1 = P.cbias[which * 64 + c0 + 1];
#pragma unroll
            for (int ww = 0; ww < 8; ++ww) { v0 += part[(ww * 16 + row) * 64 + c0]; v1 += part[(ww * 16 + row) * 64 + c0 + 1]; }
            if (which == 0) {
                float ss = v0 * v0 + v1 * v1;
                ss += __shfl_xor(ss, 1); ss += __shfl_xor(ss, 2); ss += __shfl_xor(ss, 4); ss += __shfl_xor(ss, 8); ss += __shfl_xor(ss, 16);
                const float rs = 1.0f / sqrtf(ss * (1.0f / 64) + EPS);
                v0 *= rs * P.od_d_k_norm[c0]; v1 *= rs * P.od_d_k_norm[c0 + 1];
            }
            const int nn = 16 * ng + row;
            if (nn < NCMP) *(GAS unsigned*)(P.kvcmp + (((size_t)(which * NB + b) * NCMP + nn) * 2 + hkv) * 64 + c0) = pk2(v0, v1);
        }
        __syncthreads();
    }
}

DEV void sb_tile(att::f32x16& p0, att::f32x16& p1, float& carry, int lim, int hi) {
    using namespace att;
    const float c1 = 0.125f * LOG2E;
    f32x16 k0, k1;
    float cs[2][4];
#pragma unroll
    for (int hf = 0; hf < 2; ++hf)
#pragma unroll
        for (int g = 0; g < 4; ++g) {
            float s = 0.f;
#pragma unroll
            for (int i = 0; i < 4; ++i) {
                const int r = 4 * g + i, kr = i + 8 * g + 32 * hf;
                const float z2 = (hf ? p1[r] : p0[r]) * c1;
                const float e = __builtin_amdgcn_exp2f(-fabsf(z2));
                const float ls2 = fminf(z2, 0.f) - __builtin_amdgcn_logf(1.0f + e);
                const bool ok = kr < lim;
                const float lk2 = ok ? (ls2 - z2) : 0.f;
                if (hf) { p1[r] = ok ? ls2 : MNEG; k1[r] = lk2; } else { p0[r] = ok ? ls2 : MNEG; k0[r] = lk2; }
                s += lk2;
            }
            cs[hf][g] = s;
        }
    float run = carry;
#pragma unroll
    for (int hf = 1; hf >= 0; --hf)
#pragma unroll
        for (int g = 3; g >= 0; --g) {
            const float mine = cs[hf][g], other = lane_partner(mine, hi);
            float suf = hi ? run : run + other;
            run += mine + other;
#pragma unroll
            for (int i = 3; i >= 0; --i) {
                const int r = 4 * g + i;
                if (hf) { p1[r] = __builtin_amdgcn_exp2f(p1[r] + suf); suf += k1[r]; } else { p0[r] = __builtin_amdgcn_exp2f(p0[r] + suf); suf += k0[r]; }
            }
        }
    carry = run;
}

DEV void fp_attn0(const Params& P, Frame& F) {
    using namespace att;
    const int tid = F.tid, lane = F.lane, r32 = lane & 31, hi = lane >> 5, w = F.wave;
    for (int u = F.vcu; u < 512; u += F.G) {
        {
            const int b = u >> 6, h = (u >> 3) & 7, blk = u & 7;
            const bf16* base = P.proj + (size_t)b * S * LDP;
            const int q = blk * 256 + w * 32 + r32;
            bf16x8 qr[4]; load_q(qr, base + (size_t)q * LDP + 768 + h * 64, hi);
            const bf16* Kg = base + 1280 + h * 64; const bf16* Vg = base + 1792 + h * 64;
            f32x16 o[2]; o[0] = f32x16{}; o[1] = f32x16{};
            float carry = 0.f;
            const int tmax = blk * 4 + 3;
            const int tw = (blk * 256 + w * 32 + 31) >> 6;
            volatile LAS int* flag = (volatile LAS int*)(F.lds + LDSCTL_OFF + 12288);
            if (tid < 3) flag[tid] = 0;
            TileRegs R; tile_load(R, Kg, Vg, LDP, tmax * 64, tid);
            int slot = 0; bool wave_done = false;
            for (int t = tmax; t >= 0; --t) {
                tile_store(F.lds, slot, R, tid);
                if (t > 0) tile_load(R, Kg, Vg, LDP, (t - 1) * 64, tid);
                __syncthreads();
                if (t < tmax && flag[(t + 1) % 3] == 0) break;
                if (tid == 0) flag[(t + 2) % 3] = 0;
                if (!wave_done && t <= tw) {
                    f32x16 p0, p1;
                    qk_tile(p0, p1, (lptr)(F.lds + KS0 + slot * SLOT), qr, r32, hi);
                    sb_tile(p0, p1, carry, q - t * 64 - 4 * hi, hi);
                    pv_tile(o, (lptr)(F.lds + VS0 + slot * SLOT), p0, p1, lane);
                    if (__all(carry < -150.f)) wave_done = true;
                }
                if (!wave_done && lane == 0) flag[t % 3] = 1;
                slot ^= 1;
            }
            __syncthreads();
            store_ot(o, 1.0f, P.o + (size_t)(b * S + q) * D + 512 + h * 64, hi);
        }
    }
    asm volatile("" ::: "memory");
    for (int u = 512 + F.vcu; u < 1024; u += F.G) {
        {
            const int v = u - 512, b = v >> 6, hkv = (v >> 5) & 1, c = v & 31;
            const bf16* base = P.proj + (size_t)b * S * LDP;
            const int hh = hkv * 4 + (w >> 1), q = c * 64 + (w & 1) * 32 + r32;
            bf16x8 qr[4]; load_q(qr, base + (size_t)q * LDP + hh * 64, hi);
            const float sl = exp2f(-(float)(hh + 1)), s2 = sl * LOG2E;
            SoftState st; soft_reset(st);
            const int t0 = c - 2 < 0 ? 0 : c - 2;
            run_segment(F, st, qr, base + 512 + hkv * 64, base + 640 + hkv * 64, LDP, tile_range(t0, c), s2, q,
                        [&](int t, int& klo, int& klim) { klim = q - t * 64 - 4 * hi; klo = klim - 128; });
            const float den = lane_swap_sum(st.l) + __builtin_amdgcn_exp2f(P.ev_sink[hh] * LOG2E - M0);
            store_ot(st.o, 1.0f / den, P.o + (size_t)(b * S + q) * D + hh * 64, hi);
        }
    }
}

DEV void fp_attn1(const Params& P, Frame& F) {
    using namespace att;
    const int lane = F.lane, r32 = lane & 31, hi = lane >> 5, w = F.wave;
    for (int u = F.vcu; u < 512; u += F.G) {
        {
            const int v = u & 255, bh = v >> 2, blk = (u < 256) ? (v & 3) : 7 - (v & 3);
            const int b = bh >> 3, h = bh & 7;
            const bf16* base = P.proj + (size_t)b * S * LDP;
            const int q = blk * 256 + w * 32 + r32;
            bf16x8 qr[4]; load_q(qr, base + (size_t)q * LDP + h * 64, hi);
            const float sl = exp2f(-(float)(h + 1)), s2 = sl * LOG2E;
            float gt[8];
#pragma unroll
            for (int n = 0; n < 8; ++n) {
                float g = 0.f;
                if (n < blk) {
                    const float* km = P.kmean + ((size_t)(b * 8 + h) * 8 + n) * 64;
#pragma unroll
                    for (int d0 = 0; d0 < 4; ++d0)
#pragma unroll
                        for (int j = 0; j < 8; ++j) g += bf2f((bf16)qr[d0][j]) * km[16 * d0 + 8 * hi + j];
                }
                g = lane_swap_sum(g);
                gt[n] = n < blk ? g : NEG;
            }
            unsigned sel = 0;
#pragma unroll
            for (int n = 0; n < 8; ++n) {
                int rank = 0;
#pragma unroll
                for (int k = 0; k < 8; ++k) rank += (gt[k] > gt[n] || (gt[k] == gt[n] && k < n)) ? 1 : 0;
                if (rank < 3 && n < blk) sel |= 1u << n;
            }
            SoftState st; soft_reset(st);
            run_segment(F, st, qr, base + 512 + h * 64, base + 1024 + h * 64, LDP, tile_range(0, blk * 4 + 3), s2, q,
                        [&](int t, int& klo, int& klim) { const int n = t >> 2; klo = -1;
                            if (n < blk) klim = ((sel >> n) & 1) ? 63 : -1; else klim = q - t * 64 - 4 * hi; });
            const float l = lane_swap_sum(st.l);
            store_ot(st.o, 1.0f / l, P.o + (size_t)(b * S + q) * D + h * 64, hi);
        }
    }
    asm volatile("" ::: "memory");
    for (int u = 512 + F.vcu; u < 1024; u += F.G) {
        {
            const int v = u & 255, bk = v >> 4, c = (u < 768) ? (v & 15) : 31 - (v & 15);
            const int b = bk >> 1, hkv = bk & 1;
            const bf16* base = P.proj + (size_t)b * S * LDP;
            const int h = hkv * 4 + (w >> 1), q = c * 64 + (w & 1) * 32 + r32, t = b * S + q;
            bf16x8 qr[4]; load_q(qr, base + (size_t)q * LDP + 1536 + h * 64, hi);
            const float sl = exp2f(-(float)(h + 1)), s2 = sl * LOG2E;
            const bf16* grow = base + (size_t)q * LDP + 2816 + h * 3;
            LAS float* part = (LAS float*)(F.lds + SCR0);
            volatile LAS unsigned long long* tot = (volatile LAS unsigned long long*)(F.lds + SCR0 + 33792);
            volatile LAS unsigned* selm = (volatile LAS unsigned*)(F.lds + SCR0 + 33792 + 16896);
            f32x16 fin[2];
            {
                const int ntile = c >= 16 ? 2 : 1;
                const bf16* Kc = P.kvcmp + ((size_t)(0 * NB + b) * NCMP) * 128 + hkv * 64;
                const bf16* Vc = P.kvcmp + ((size_t)(1 * NB + b) * NCMP) * 128 + hkv * 64;
                TileRegs R0, R1; tile_load(R0, Kc, Vc, 128, 0, F.tid); if (ntile == 2) tile_load(R1, Kc, Vc, 128, 64, F.tid);
                tile_store(F.lds, 0, R0, F.tid); if (ntile == 2) tile_store(F.lds, 1, R1, F.tid);
                __syncthreads();
                const int nlim = (q - 31) >> 4;
                const float c1 = 0.125f * LOG2E, s16 = 16.0f * s2;
                const float basec = s2 * (float)(31 - q) + s16 * (float)(4 * hi);
                float lsum = 0.f;
                for (int tl = 0; tl < ntile; ++tl) {
                    f32x16 x0, x1; qk_tile(x0, x1, (lptr)(F.lds + KS0 + tl * SLOT), qr, r32, hi);
                    const int klim = nlim - 64 * tl - 4 * hi; const float bt = basec + s16 * (float)(64 * tl) - M0;
#pragma unroll
                    for (int r = 0; r < 16; ++r) {
                        const int kr = (r & 3) + 8 * (r >> 2);
                        lsum += kr <= klim ? __builtin_amdgcn_exp2f(fmaf(x0[r], c1, fmaf(s16, (float)kr, bt))) : 0.f;
                        lsum += kr + 32 <= klim ? __builtin_amdgcn_exp2f(fmaf(x1[r], c1, fmaf(s16, (float)(kr + 32), bt))) : 0.f;
                    }
                }
                lsum = lane_swap_sum(lsum);
                const float inv = nlim >= 0 ? 1.0f / lsum : 0.f;
                fin[0] = f32x16{}; fin[1] = f32x16{};
                LAS float* prow = part + ((w >> 1) * 64 + (w & 1) * 32 + r32) * 33;
                float peprev = 0.f;
                for (int tl = 0; tl < ntile; ++tl) {
                    f32x16 x0, x1; qk_tile(x0, x1, (lptr)(F.lds + KS0 + tl * SLOT), qr, r32, hi);
                    const int klim = nlim - 64 * tl - 4 * hi; const float bt = basec + s16 * (float)(64 * tl) - M0;
#pragma unroll
                    for (int r = 0; r < 16; ++r) {
                        const int kr = (r & 3) + 8 * (r >> 2);
                        x0[r] = kr <= klim ? __builtin_amdgcn_exp2f(fmaf(x0[r], c1, fmaf(s16, (float)kr, bt))) * inv : 0.f;
                        x1[r] = kr + 32 <= klim ? __builtin_amdgcn_exp2f(fmaf(x1[r], c1, fmaf(s16, (float)(kr + 32), bt))) * inv : 0.f;
                    }
#pragma unroll
                    for (int ix = 0; ix < 8; ++ix) {
                        const int g = ix & 3;
                        const float C = (ix < 4) ? (x0[4 * g] + x0[4 * g + 1]) + (x0[4 * g + 2] + x0[4 * g + 3]) : (x1[4 * g] + x1[4 * g + 1]) + (x1[4 * g + 2] + x1[4 * g + 3]);
                        const float pe = lane_partner((ix < 4) ? x0[4 * g + 3] : x1[4 * g + 3], hi);
                        prow[2 * (8 * tl + ix) + hi] = C + (hi ? pe : peprev);
                        peprev = pe;
                    }
                    pv_tile(fin, (lptr)(F.lds + VS0 + tl * SLOT), x0, x1, lane);
                }
                { const float g0 = 1.0f / (1.0f + __expf(-bf2f(grow[0])));
#pragma unroll
                for (int r = 0; r < 16; ++r) { fin[0][r] *= g0; fin[1][r] *= g0; } }
            }
            __syncthreads();
            {
                const int ql = F.tid >> 3, jg = F.tid & 7;
#pragma unroll
                for (int jj = 0; jj < 4; ++jj) {
                    const int j = 4 * jg + jj;
                    float sc = ((part[(0 * 64 + ql) * 33 + j] + part[(1 * 64 + ql) * 33 + j]) + part[(2 * 64 + ql) * 33 + j]) + part[(3 * 64 + ql) * 33 + j];
                    const bool forced = (j == 0) || (j == c) || (j == c - 1);
                    sc = (j <= c) ? sc + (forced ? 1000.0f : 0.0f) : NEG;
                    const unsigned ub = f2u(sc), ord = ub ^ ((ub >> 31) ? 0xffffffffu : 0x80000000u);
                    tot[ql * 33 + j] = ((unsigned long long)ord << 32) | (unsigned)(31 - j);
                }
                __syncthreads();
                unsigned long long mine[4];
#pragma unroll
                for (int jj = 0; jj < 4; ++jj) mine[jj] = tot[ql * 33 + 4 * jg + jj];
                int rank[4] = {0, 0, 0, 0};
                for (int k = 0; k < 32; ++k) {
                    const unsigned long long sk = tot[ql * 33 + k];
#pragma unroll
                    for (int jj = 0; jj < 4; ++jj) rank[jj] += (sk > mine[jj]) ? 1 : 0;
                }
                unsigned bits = 0;
#pragma unroll
                for (int jj = 0; jj < 4; ++jj) if (rank[jj] < 16 && 4 * jg + jj <= c) bits |= 1u << (4 * jg + jj);
                bits |= __shfl_xor(bits, 1); bits |= __shfl_xor(bits, 2); bits |= __shfl_xor(bits, 4);
                if (jg == 0) selm[ql] = bits;
                unsigned ub = bits; ub |= __shfl_xor(ub, 8); ub |= __shfl_xor(ub, 16); ub |= __shfl_xor(ub, 32);
                if (lane == 0) selm[64 + w] = ub;
            }
            __syncthreads();
            const unsigned mask = selm[(w & 1) * 32 + r32];
            const unsigned umask = ((selm[64] | selm[65]) | (selm[66] | selm[67])) | ((selm[68] | selm[69]) | (selm[70] | selm[71]));
            __syncthreads();
            LAS float* stg = (LAS float*)(F.lds + SCR0) + w * 2048 + lane;
#pragma unroll
            for (int r = 0; r < 16; ++r) { stg[r * 64] = fin[0][r]; stg[(16 + r) * 64] = fin[1][r]; }
            SoftState st; soft_reset(st);
            run_segment(F, st, qr, base + 2304 + hkv * 64, base + 2432 + hkv * 64, LDP, (unsigned long long)umask, s2, q,
                        [&](int tt, int& klo, int& klim) { klo = -1; klim = ((mask >> tt) & 1) ? (q - tt * 64 - 4 * hi) : -1; });
            { const float g1 = 1.0f / (1.0f + __expf(-bf2f(grow[1]))); const float f = g1 / lane_swap_sum(st.l);
#pragma unroll
              for (int r = 0; r < 16; ++r) { stg[r * 64] += f * st.o[0][r]; stg[(16 + r) * 64] += f * st.o[1][r]; } }
            soft_reset(st);
            run_segment(F, st, qr, base + 2560 + hkv * 64, base + 2688 + hkv * 64, LDP, tile_range(c - 8 < 0 ? 0 : c - 8, c), s2, q,
                        [&](int tt, int& klo, int& klim) { klim = q - tt * 64 - 4 * hi; klo = klim - 512; });
            { const float g2 = 1.0f / (1.0f + __expf(-bf2f(grow[2]))); const float f = g2 / lane_swap_sum(st.l);
#pragma unroll
              for (int r = 0; r < 16; ++r) { st.o[0][r] = stg[r * 64] + f * st.o[0][r]; st.o[1][r] = stg[(16 + r) * 64] + f * st.o[1][r]; } }
            store_ot(st.o, 1.0f, P.o + (size_t)t * D + 512 + h * 64, hi);
            __syncthreads();
        }
    }
}
enum { PH_PRE = 0, PH_INPROJ0, PH_ATTN0, PH_OUTPROJ0, PH_ROUTE0, PH_GATHER0, PH_FFN0, PH_COMBINE0, PH_INPROJ1, PH_PREP1, PH_ATTN1, PH_OUTPROJ1, PH_ROUTE1, PH_GATHER1, PH_FFN1, PH_COMBINE1, PH_COUNT };
struct FArgs { Params p; };

#ifndef PROBE_PHASE
#define PROBE_PHASE -1
#endif
constexpr int STAMP_OFF = LDSCTL_OFF + 1024;
constexpr int HN_OFF = LDSCTL_OFF + 2048;
DEV void stampk(Frame& F, int k) {
    if (PROBE_PHASE >= 0 && F.tid == 0) ((volatile LAS unsigned*)(F.lds + STAMP_OFF))[k] = (unsigned)__builtin_amdgcn_s_memrealtime() | 1u;
}
__global__ void __launch_bounds__(NWAVES * 64, 2) k_fast(FArgs args) {
    extern __shared__ __attribute__((aligned(16))) unsigned char lds[];
    const Params& P = args.p;
    Frame F;
    F.lds = (LAS unsigned char*)lds;
    F.MISC = (volatile LAS unsigned*)(F.lds + MISC_OFF);
    F.tid = threadIdx.x; F.lane = F.tid & 63; F.wave = __builtin_amdgcn_readfirstlane(F.tid >> 6);
    F.G = gridDim.x; { const int bx = blockIdx.x; F.vcu = (F.G % 8 == 0) ? (bx % 8) * (F.G / 8) + bx / 8 : bx; }
    for (int u = F.tid; u < (LDS_BYTES - LDSCTL_OFF) / 4; u += NWAVES * 64) ((LAS unsigned*)(F.lds + LDSCTL_OFF))[u] = 0u;
    __syncthreads();
    XcdBarrier bar = xcd_barrier_post(P.ctl + CW_BAR, F.MISC + 8);
#define BEGIN(k) refresh(F); stampk(F, (k));
#define SEAM() do { refresh(F); xcd_barrier(bar, F.tid); } while (0)
    { BEGIN(PH_PRE) fp_convert_weights(P, F, 0, F.vcu, F.G); fp_prep_router(P, F); fp_norm_rows(F, P.x, P.ev_norm, P.xn); if (F.G != 256) { fp_convert_weights(P, F, 1, F.vcu, F.G); fp_prep_compress(P, F, F.vcu, F.G); } SEAM(); }
    { BEGIN(PH_INPROJ0) const int cq = F.vcu >> 2, cr = F.vcu & 3, gi = 3 * cq + cr;
      if (F.G == 256 && cr == 3) fp_convert_moe_part(P, F, 0, cq, 64);
      else { pg8::StaticOrder So; So.init(P.xn, P.win0t, T, EVEN_IN, D, F.G == 256 ? 192 : F.G, F.G == 256 ? gi : F.vcu);
        pg8::EpiProjNorm<0> E{P.proj, LDP, P.ev_q_norm, P.ev_k_norm, nullptr, nullptr, nullptr, (PG8_LAS float*)(F.lds + HN_OFF)};
        pg8::gemm_phase(F.lds, D, So, E, F.tid); if (F.G != 256) { refresh(F); fp_convert_moe_part(P, F, 0, F.vcu, F.G); } }
      SEAM(); }
    { BEGIN(PH_ATTN0) fp_attn0(P, F); SEAM(); }
    { BEGIN(PH_OUTPROJ0) pg8::StaticOrder So; So.init(P.o, P.wout0t, T, D, D, F.G, (int)blockIdx.x);
      pg8::EpiResidF32 E{P.x, P.out, D}; pg8::gemm_phase(F.lds, D, So, E, F.tid); SEAM(); }
    { BEGIN(PH_ROUTE0) fp_route(P, F, 0); SEAM(); }
    { BEGIN(PH_GATHER0) fp_gather(P, F, 0); SEAM(); }
    { BEGIN(PH_FFN0) const int cq = F.vcu >> 2, cr = F.vcu & 3, gi = 3 * cq + cr;
      if (F.G == 256 && cr == 3) { fp_convert_weights(P, F, 1, cq, 64); fp_prep_compress(P, F, cq, 64); fp_convert_moe_part(P, F, 1, cq, 64); }
      else if (F.G == 256) fp_moe_fused(P, F, 0, gi, 192);
      else { fp_moe_fused(P, F, 0, F.vcu, F.G); refresh(F); fp_convert_moe_part(P, F, 1, F.vcu, F.G); }
      SEAM(); }
    { BEGIN(PH_COMBINE0) fp_combine(P, F, P.od_norm, P.xn); SEAM(); }
    { BEGIN(PH_INPROJ1) pg8::StaticOrder So; So.init(P.xn, P.win1t, T, LDP, D, F.G, (int)blockIdx.x);
      pg8::EpiProjNorm<1> E{P.proj, LDP, P.od_c_q_norm, P.od_c_k_norm, P.od_d_q_norm, P.od_d_k_norm + 64, P.od_d_k_norm + 128, (PG8_LAS float*)(F.lds + HN_OFF)};
      pg8::gemm_phase(F.lds, D, So, E, F.tid); SEAM(); }
    { BEGIN(PH_PREP1) fp_prep1(P, F); SEAM(); }
    { BEGIN(PH_ATTN1) fp_attn1(P, F); SEAM(); }
    { BEGIN(PH_OUTPROJ1) pg8::StaticOrder So; So.init(P.o, P.wout1t, T, D, D, F.G, (int)blockIdx.x);
      pg8::EpiResidF32 E{P.out, P.out, D}; pg8::gemm_phase(F.lds, D, So, E, F.tid); SEAM(); }
    { BEGIN(PH_ROUTE1) fp_route(P, F, 1); SEAM(); }
    { BEGIN(PH_GATHER1) fp_gather(P, F, 1); SEAM(); }
    { BEGIN(PH_FFN1) fp_moe_fused(P, F, 1, F.vcu, F.G); SEAM(); }
    { BEGIN(PH_COMBINE1) fp_combine(P, F, nullptr, nullptr); }
    if (PROBE_PHASE >= 0) {
        refresh(F);
        if (F.vcu == 0 && F.tid == 0) {
            volatile LAS unsigned* st = (volatile LAS unsigned*)(F.lds + STAMP_OFF);
            const unsigned t1 = (PROBE_PHASE + 1 < PH_COUNT) ? st[(PROBE_PHASE + 1 < PH_COUNT) ? PROBE_PHASE + 1 : 0] : ((unsigned)__builtin_amdgcn_s_memrealtime() | 1u);
            const unsigned t0 = st[PROBE_PHASE < 0 ? 0 : PROBE_PHASE];
            asm volatile("s_waitcnt vmcnt(0)" ::: "memory");
#ifndef PROBE_SCALE
#define PROBE_SCALE 0.01f
#endif
            P.out[0] += (float)(t1 - t0) * PROBE_SCALE;
        }
    }
#undef BEGIN
#undef SEAM
}

static size_t carve(Params& p, void* d_ws) {
    char* w = (char*)d_ws;
    p.ctl = (unsigned*)w;
    p.win0t = (bf16*)(w + 1 * MiB);
    p.wout0t = (bf16*)(w + 6 * MiB);
    p.win1t = (bf16*)(w + 8 * MiB);
    p.wout1t = (bf16*)(w + 14 * MiB);
    p.wgut[0] = (bf16*)(w + 16 * MiB);
    p.wdt[0] = (bf16*)(w + 48 * MiB);
    p.proj = (bf16*)(w + 64 * MiB);
    p.ha = (bf16*)(w + 64 * MiB);
    p.xn = (bf16*)(w + 160 * MiB);
    p.o = (bf16*)(w + 192 * MiB);
    p.hid = (bf16*)(w + 192 * MiB);
    size_t off = 224 * MiB;
    auto take = [&](size_t bytes) { char* r = w + off; off = (off + bytes + 255) & ~(size_t)255; return r; };
    p.rstd = (float*)take((size_t)T * 4);
    p.eid = (int*)take((size_t)T * 2 * 4);
    p.ew = (float*)take((size_t)T * 2 * 4);
    p.kmean = (float*)take((size_t)NB * 8 * 8 * 64 * 4);
    p.kvcmp = (bf16*)take((size_t)2 * NB * 128 * 2 * 64 * 2);
    p.pos = (int*)take((size_t)T * 2 * 4);
    p.wr = (bf16*)take((size_t)2 * 2 * 48 * D * 2);
    p.wcmpt = (bf16*)take((size_t)2 * 64 * 2048 * 2);
    p.cbias = (float*)take((size_t)128 * 4);
    p.wgut[1] = (bf16*)(w + 228 * MiB);
    p.wdt[1] = (bf16*)(w + 260 * MiB);
    return off > 228 * MiB ? (size_t)1 << 40 : 276 * MiB;
}

extern "C" void kernel_launch(void* const* d_in, const int* in_sizes, int n_in, void* d_out, int out_size, void* d_ws, size_t ws_size,
                              hipStream_t stream) {
    Params p{};
    const float** f = (const float**)&p;
    for (int i = 0; i < 24; ++i) f[i] = (const float*)d_in[i];
    p.out = (float*)d_out;
    const size_t need = carve(p, d_ws);
    static int grid = 0;
    if (grid == 0) {
        int dev = 0, cus = 0, per_cu = 0;
        if (hipGetDevice(&dev) != hipSuccess || hipDeviceGetAttribute(&cus, hipDeviceAttributeMultiprocessorCount, dev) != hipSuccess) { grid = -1; return; }
        if (hipFuncSetAttribute((const void*)k_fast, hipFuncAttributeMaxDynamicSharedMemorySize, LDS_BYTES) != hipSuccess) { fprintf(stderr, "hipFuncSetAttribute failed\n"); grid = -1; return; }
        if (hipOccupancyMaxActiveBlocksPerMultiprocessor(&per_cu, (const void*)k_fast, NWAVES * 64, LDS_BYTES) != hipSuccess || per_cu < 1) { fprintf(stderr, "occupancy query: %d\n", per_cu); (void)hipGetLastError(); grid = -1; return; }
        grid = cus;
        if (need > ws_size) { fprintf(stderr, "workspace too small: need %zu have %zu\n", need, ws_size); grid = -1; return; }
    }
    if (grid < 0) return;
    (void)hipMemsetAsync(d_ws, 0, CTL_ZERO_BYTES, stream);
    FArgs a{}; a.p = p;
    hipLaunchKernelGGL(k_fast, dim3(grid), dim3(NWAVES * 64), LDS_BYTES, stream, a);
}
```

```cpp
#include <hip/hip_runtime.h>
#include <cstdio>
#include <cstdint>
#define DEV __device__ __forceinline__

#ifndef NB
#define NB 8
#endif
typedef unsigned short bf16;
constexpr int S = 2048, D = 1024, T = NB * S, HD = 64;
constexpr int EVEN_IN = 2304, ODD_IN = 2840, LDP = 3072;
constexpr int NCMP = 127, NSLC = 32;
constexpr float NEG = -1e30f;
constexpr float EPS = 1e-6f;
constexpr int RMAX = 2 * T + 32 * 256;

DEV float u2f(unsigned u) { return __builtin_bit_cast(float, u); }
DEV unsigned f2u(float f) { return __builtin_bit_cast(unsigned, f); }
DEV float bf2f(bf16 h) { return u2f(((unsigned)h) << 16); }
DEV bf16 f2bf(float f) { unsigned u = f2u(f); u += 0x7fffu + ((u >> 16) & 1u); return (bf16)(u >> 16); }

struct Params {
    const float *x, *ev_norm, *ev_w_in, *ev_q_norm, *ev_k_norm, *ev_sink, *ev_w_out;
    const float *od_norm, *od_w_in, *od_c_q_norm, *od_c_k_norm, *od_d_q_norm, *od_d_k_norm, *od_cmp_pos, *od_cmp_w, *od_w_out;
    const float *moe_norm, *moe_w_grp, *moe_b_grp, *moe_w_exp, *moe_b_exp, *moe_w_gate, *moe_w_up, *moe_w_down;
    float* out;
    unsigned* ctl;
    bf16 *win0t, *wout0t, *win1t, *wout1t;
    bf16 *wgut[2], *wdt[2];
    bf16* proj;
    bf16* xn;
    bf16* o;
    bf16* ha;
    bf16* hid;
    float* rstd;
    int* eid;
    float* ew;
    float* kmean;
    bf16* kvcmp;
    int* pos;
    int* rowtok;
    bf16* wr;
    bf16* wcmpt;
    float* cbias;
};


namespace pg8 {
#define PG8_LAS __attribute__((address_space(3)))
typedef unsigned short bf16_t;
typedef short bf16x8 __attribute__((ext_vector_type(8)));
typedef float f32x4 __attribute__((ext_vector_type(4)));
typedef unsigned u32x4 __attribute__((ext_vector_type(4)));
constexpr int BM = 256, BK = 64, HALF = 128, HTB = HALF * BK * 2, STAGE_BYTES = 8 * HTB, NXCD = 8, WGM = 8;

__host__ __device__ __forceinline__ int lds_byte(int r, int c) { const int st = (r >> 4) * 2 + (c >> 5), rr = r & 15, cc = c & 31, ob = rr * 64 + cc * 2; return st * 1024 + (ob ^ (((ob >> 9) & 1) << 5)); }
__host__ __device__ __forceinline__ void stage_rc(int b, int& R, int& C) { const int st = b / 1024, sb = b % 1024, swz = sb ^ (((sb >> 9) & 1) << 5); R = (st >> 1) * 16 + swz / 64; C = (st & 1) * 32 + (swz % 64) / 2; }
__host__ __device__ __forceinline__ int perm32(int rho) { const int n = rho >> 4, i = rho & 15; return 8 * (i >> 2) + 4 * n + (i & 3); }

struct Unit { const char* A; const char* B; int pm, pn; };

struct StaticOrder {
    int nM, nN, nwg, G, c; const char* A; const char* Bt; size_t tstep;
    __device__ void init(const bf16_t* A_, const bf16_t* Bt_, int M, int N, int K, int G_, int c_) { nM = M / BM; nN = N / BM; nwg = nM * nN; G = G_; c = c_; A = (const char*)A_; Bt = (const char*)Bt_; tstep = (size_t)BM * K * 2; }
    __device__ bool next(int i, Unit& u) const {
        const long L = (long)i * G + c; if (L >= nwg) return false;
        int wgid = (int)L; { const int q = nwg / NXCD, r = nwg % NXCD, xcd = wgid % NXCD, off = wgid / NXCD; wgid = (xcd < r ? xcd * (q + 1) : r * (q + 1) + (xcd - r) * q) + off; }
        const int nig = WGM * nN, gid = wgid / nig, fm = gid * WGM, gsz = (nM - fm) < WGM ? (nM - fm) : WGM;
        u.pm = fm + ((wgid % nig) % gsz); u.pn = (wgid % nig) / gsz; u.A = A + (size_t)u.pm * tstep; u.B = Bt + (size_t)u.pn * tstep; return true;
    }
};

__device__ __forceinline__ unsigned cvt_pk_bf16(float lo, float hi) { unsigned r; asm volatile("v_cvt_pk_bf16_f32 %0, %1, %2" : "=v"(r) : "v"(lo), "v"(hi)); return r; }

struct EpiStoreBf16 {
    static constexpr bool PERM = true;
    bf16_t* O; int ldc;
    __device__ __forceinline__ void operator()(const f32x4 (&acc)[2][2][4][2], const Unit& u, int wr, int wc, int fr, int fq) const {
        const int row0 = u.pm * BM + wr * 64 + fr, col0 = u.pn * BM + wc * 32 + 8 * fq;
#pragma unroll
        for (int ai = 0; ai < 2; ++ai)
#pragma unroll
            for (int m = 0; m < 4; ++m) { bf16_t* rowp = O + (size_t)(row0 + ai * HALF + m * 16) * ldc + col0;
#pragma unroll
                for (int bj = 0; bj < 2; ++bj) { const f32x4 v0 = acc[ai][bj][m][0], v1 = acc[ai][bj][m][1];
                    u32x4 w; w.x = cvt_pk_bf16(v0[0], v0[1]); w.y = cvt_pk_bf16(v0[2], v0[3]); w.z = cvt_pk_bf16(v1[0], v1[1]); w.w = cvt_pk_bf16(v1[2], v1[3]);
                    *(u32x4*)(rowp + bj * HALF) = w; } }
    }
};

template <int LAYER> struct EpiProjNorm {
    static constexpr bool PERM = true;
    bf16_t* O; int ldc; const float *g0, *g1, *g2, *g3, *g4; PG8_LAS float* hn;
    __device__ __forceinline__ const float* gain_of(int H) const {
        if (LAYER == 0) return H < 8 ? g0 : (H < 10 ? g1 : nullptr);
        return H < 8 ? g0 : H < 16 ? g1 : (H >= 24 && H < 32) ? g2 : (H == 36 || H == 37) ? g3 : (H == 40 || H == 41) ? g4 : nullptr;
    }
    __device__ __forceinline__ void operator()(f32x4 (&acc)[2][2][4][2], const Unit& u, int wr, int wc, int fr, int fq) const {
        const bool any = (LAYER == 0) ? (u.pn < 3) : (u.pn < 4 || u.pn == 6 || u.pn == 7 || u.pn == 9 || u.pn == 10);
        if (any) {
#pragma unroll
            for (int ai = 0; ai < 2; ++ai)
#pragma unroll
                for (int m = 0; m < 4; ++m)
#pragma unroll
                    for (int bj = 0; bj < 2; ++bj) {
                        const f32x4 a = acc[ai][bj][m][0], b = acc[ai][bj][m][1];
                        float ss = (a[0] * a[0] + a[1] * a[1]) + (a[2] * a[2] + a[3] * a[3]) + (b[0] * b[0] + b[1] * b[1]) + (b[2] * b[2] + b[3] * b[3]);
                        ss += __shfl_xor(ss, 16); ss += __shfl_xor(ss, 32);
                        if (fq == 0) hn[(ai * HALF + wr * 64 + m * 16 + fr) * 8 + bj * 4 + wc] = ss;
                    }
        }
        asm volatile("s_waitcnt lgkmcnt(0)" ::: "memory"); __builtin_amdgcn_s_barrier(); asm volatile("" ::: "memory");
        const int row0 = u.pm * BM + wr * 64 + fr, col0 = u.pn * BM + wc * 32 + 8 * fq;
#pragma unroll
        for (int bj = 0; bj < 2; ++bj) {
            const float* g = gain_of(4 * u.pn + 2 * bj + (wc >> 1));
            f32x4 ga = (f32x4){1.f, 1.f, 1.f, 1.f}, gb = ga;
            if (g) { ga = *(const f32x4*)(g + (wc & 1) * 32 + 8 * fq); gb = *(const f32x4*)(g + (wc & 1) * 32 + 8 * fq + 4); }
#pragma unroll
            for (int ai = 0; ai < 2; ++ai)
#pragma unroll
                for (int m = 0; m < 4; ++m) {
                    f32x4 v0 = acc[ai][bj][m][0], v1 = acc[ai][bj][m][1];
                    if (g) { const int rl = (ai * HALF + wr * 64 + m * 16 + fr) * 8 + bj * 4;
                        const float r = 1.0f / sqrtf((hn[rl + wc] + hn[rl + (wc ^ 1)]) * (1.0f / 64) + 1e-6f);
                        v0 = v0 * ga * r; v1 = v1 * gb * r; }
                    u32x4 w; w.x = cvt_pk_bf16(v0[0], v0[1]); w.y = cvt_pk_bf16(v0[2], v0[3]); w.z = cvt_pk_bf16(v1[0], v1[1]); w.w = cvt_pk_bf16(v1[2], v1[3]);
                    *(u32x4*)(O + (size_t)(row0 + ai * HALF + m * 16) * ldc + col0 + bj * HALF) = w;
                }
        }
    }
};
struct EpiResidF32 {
    static constexpr bool PERM = true;
    const float* R; float* O; int ldc;
    __device__ __forceinline__ void operator()(const f32x4 (&acc)[2][2][4][2], const Unit& u, int wr, int wc, int fr, int fq) const {
        const int row0 = u.pm * BM + wr * 64 + fr, col0 = u.pn * BM + wc * 32 + 8 * fq;
#pragma unroll
        for (int ai = 0; ai < 2; ++ai)
#pragma unroll
            for (int m = 0; m < 4; ++m) { const size_t ro = (size_t)(row0 + ai * HALF + m * 16) * ldc + col0;
#pragma unroll
                for (int bj = 0; bj < 2; ++bj) {
                    const f32x4 r0 = *(const f32x4*)(R + ro + bj * HALF), r1 = *(const f32x4*)(R + ro + bj * HALF + 4);
                    *(f32x4*)(O + ro + bj * HALF) = r0 + acc[ai][bj][m][0]; *(f32x4*)(O + ro + bj * HALF + 4) = r1 + acc[ai][bj][m][1]; } }
    }
};
struct EpiSiluMul {
    static constexpr bool PERM = true;
    bf16_t* H; int ldh;
    __device__ __forceinline__ void operator()(const f32x4 (&acc)[2][2][4][2], const Unit& u, int wr, int wc, int fr, int fq) const {
        const int row0 = u.pm * BM + wr * 64 + fr, col0 = u.pn * HALF + wc * 32 + 8 * fq;
#pragma unroll
        for (int ai = 0; ai < 2; ++ai)
#pragma unroll
            for (int m = 0; m < 4; ++m) { bf16_t* rowp = H + (size_t)(row0 + ai * HALF + m * 16) * ldh + col0;
                float h[8];
#pragma unroll
                for (int n = 0; n < 2; ++n)
#pragma unroll
                    for (int j = 0; j < 4; ++j) { const float g = acc[ai][0][m][n][j], up = acc[ai][1][m][n][j]; h[n * 4 + j] = g * up / (1.0f + __expf(-g)); }
                u32x4 w; w.x = cvt_pk_bf16(h[0], h[1]); w.y = cvt_pk_bf16(h[2], h[3]); w.z = cvt_pk_bf16(h[4], h[5]); w.w = cvt_pk_bf16(h[6], h[7]);
                *(u32x4*)rowp = w; }
    }
};

template <class Epi, class Sched, bool GATHER = false>
__device__ __forceinline__ void gemm_phase(PG8_LAS unsigned char* lds, const int K, const Sched& S, const Epi& E, const int tid, unsigned g00 = 0, unsigned g01 = 0, unsigned g10 = 0, unsigned g11 = 0) {
    const int wid = __builtin_amdgcn_readfirstlane(tid >> 6), lane = tid & 63, wr = wid >> 2, wc = wid & 3, fr = lane & 15, fq = lane >> 4;
    const int nt = K / BK;
    unsigned voffA[2], voffB[2], voffA1[2];
#pragma unroll
    for (int i = 0; i < 2; ++i) { int R, C; stage_rc(tid * 16 + i * 8192, R, C); const int Rb = Epi::PERM ? ((R & ~31) + perm32(R & 31)) : R;
        voffA[i] = (unsigned)(R * K + C) * 2u; voffB[i] = (unsigned)(Rb * K + C) * 2u; voffA1[i] = voffA[i];
        if (GATHER) { voffA[i] = (i ? g01 : g00) + (unsigned)C * 2u; voffA1[i] = (i ? g11 : g10) + (unsigned)C * 2u; } }
    const size_t kstep = (size_t)(BK * 2);
    const size_t hstep = (size_t)HALF * K * 2;
    const size_t hstepA = GATHER ? (size_t)0 : hstep;
    const unsigned ldsw = (unsigned)wid * 1024u;
    const int aoff = lds_byte(wr * 64 + fr, fq * 8), boff = lds_byte(wc * 32 + fr, fq * 8);
#define PG8_SA(b, h) (((b) * 2 + (h)) * HTB)
#define PG8_SB(b, h) ((4 + (b) * 2 + (h)) * HTB)
#define PG8_STAGE(bufoff, gbase, voff) do { _Pragma("unroll") for (int _i = 0; _i < 2; ++_i) \
        __builtin_amdgcn_global_load_lds((const unsigned*)((const char*)(gbase) + (voff)[_i]), (PG8_LAS unsigned*)(lds + (bufoff) + ldsw + _i * 8192), 16, 0, 0); } while (0)
#define PG8_LDA(dst, b, h) do { _Pragma("unroll") for (int m = 0; m < 4; ++m) _Pragma("unroll") for (int k = 0; k < 2; ++k) dst[m][k] = *(const PG8_LAS bf16x8*)(lds + PG8_SA(b, h) + aoff + m * 2048 + k * 1024); } while (0)
#define PG8_LDB(dst, b, h) do { _Pragma("unroll") for (int n = 0; n < 2; ++n) _Pragma("unroll") for (int k = 0; k < 2; ++k) dst[n][k] = *(const PG8_LAS bf16x8*)(lds + PG8_SB(b, h) + boff + n * 2048 + k * 1024); } while (0)
#define PG8_MMA(ai, bj, At, Bt) do { __builtin_amdgcn_s_setprio(1); _Pragma("unroll") for (int m = 0; m < 4; ++m) _Pragma("unroll") for (int n = 0; n < 2; ++n) _Pragma("unroll") for (int k = 0; k < 2; ++k) \
        acc[ai][bj][m][n] = __builtin_amdgcn_mfma_f32_16x16x32_bf16(Bt[n][k], At[m][k], acc[ai][bj][m][n], 0, 0, 0); __builtin_amdgcn_s_setprio(0); } while (0)
#define PG8_WAIT_V(n) asm volatile("s_waitcnt vmcnt(" #n ")" ::: "memory")
#define PG8_WAIT_L(n) asm volatile("s_waitcnt lgkmcnt(" #n ")" ::: "memory")
#define PG8_BAR __builtin_amdgcn_s_barrier()
#define PG8_SCHED __builtin_amdgcn_sched_barrier(0)
    Unit cur, nxt; int ui = 0;
    if (!S.next(0, cur)) return;
    f32x4 acc[2][2][4][2];
#pragma unroll
    for (int a = 0; a < 2; ++a)
#pragma unroll
        for (int b = 0; b < 2; ++b)
#pragma unroll
            for (int m = 0; m < 4; ++m)
#pragma unroll
                for (int n = 0; n < 2; ++n) acc[a][b][m][n] = (f32x4){0.f, 0.f, 0.f, 0.f};
    bf16x8 At[4][2], B0[2][2], B1[2][2];
    const char* cA = cur.A; const char* cB = cur.B;
    PG8_STAGE(PG8_SB(0, 0), cB, voffB); PG8_STAGE(PG8_SB(0, 1), cB + hstep, voffB); PG8_STAGE(PG8_SA(0, 0), cA, voffA); PG8_STAGE(PG8_SA(0, 1), cA + hstepA, voffA1);
    if (wr == 1) PG8_BAR;
    PG8_WAIT_V(2); PG8_BAR;
    PG8_STAGE(PG8_SB(1, 0), cB + kstep, voffB); PG8_STAGE(PG8_SA(1, 0), cA + kstep, voffA); PG8_STAGE(PG8_SB(1, 1), cB + hstep + kstep, voffB);
    PG8_WAIT_V(6); PG8_BAR;
    for (;;) {
        const bool has_next = S.next(ui + 1, nxt);
        const char* nA = has_next ? nxt.A : cA; const char* nB = has_next ? nxt.B : cB;
        for (int t = 0; t < nt; t += 2) {
            const bool last = (t == nt - 2);
            const char* a1 = cA + (size_t)(t + 1) * kstep;
            const char* a2 = last ? nA : cA + (size_t)(t + 2) * kstep; const char* b2 = last ? nB : cB + (size_t)(t + 2) * kstep;
            const char* a3 = a2 + kstep; const char* b3 = b2 + kstep;
            PG8_LDB(B0, 0, 0); PG8_LDB(B1, 0, 1); PG8_SCHED; PG8_LDA(At, 0, 0); PG8_STAGE(PG8_SA(1, 1), a1 + hstepA, voffA1);
            PG8_WAIT_V(8); PG8_WAIT_L(0); PG8_BAR; PG8_MMA(0, 0, At, B0); PG8_MMA(0, 1, At, B1); PG8_BAR; PG8_SCHED;
            PG8_LDA(At, 0, 1); PG8_STAGE(PG8_SB(0, 0), b2, voffB); PG8_STAGE(PG8_SB(0, 1), b2 + hstep, voffB); PG8_STAGE(PG8_SA(0, 0), a2, voffA);
            PG8_WAIT_V(8); PG8_WAIT_L(0); PG8_BAR; PG8_MMA(1, 0, At, B0); PG8_MMA(1, 1, At, B1); PG8_BAR; PG8_SCHED;
            PG8_LDB(B0, 1, 0); PG8_LDB(B1, 1, 1); PG8_SCHED; PG8_LDA(At, 1, 0); PG8_STAGE(PG8_SA(0, 1), a2 + hstepA, voffA1);
            PG8_WAIT_V(8); PG8_WAIT_L(0); PG8_BAR; PG8_MMA(0, 0, At, B0); PG8_MMA(0, 1, At, B1); PG8_BAR; PG8_SCHED;
            PG8_LDA(At, 1, 1); PG8_STAGE(PG8_SB(1, 0), b3, voffB); PG8_STAGE(PG8_SB(1, 1), b3 + hstep, voffB); PG8_STAGE(PG8_SA(1, 0), a3, voffA);
            PG8_WAIT_V(8); PG8_WAIT_L(0); PG8_BAR; PG8_MMA(1, 0, At, B0); PG8_MMA(1, 1, At, B1); PG8_BAR; PG8_SCHED;
        }
        if (wr == 0) PG8_BAR;
        { int l2; asm volatile("v_mbcnt_lo_u32_b32 %0, -1, 0\n\tv_mbcnt_hi_u32_b32 %0, -1, %0" : "=v"(l2)); E(acc, cur, wr, wc, l2 & 15, l2 >> 4); }
        if (!has_next) break;
#pragma unroll
        for (int a = 0; a < 2; ++a)
#pragma unroll
            for (int b = 0; b < 2; ++b)
#pragma unroll
                for (int m = 0; m < 4; ++m)
#pragma unroll
                    for (int n = 0; n < 2; ++n) acc[a][b][m][n] = (f32x4){0.f, 0.f, 0.f, 0.f};
        cur = nxt; cA = nA; cB = nB; ++ui;
        if (wr == 1) PG8_BAR;
    }
    PG8_WAIT_V(0);
    PG8_BAR;
#undef PG8_SA
#undef PG8_SB
#undef PG8_STAGE
#undef PG8_LDA
#undef PG8_LDB
#undef PG8_MMA
#undef PG8_WAIT_V
#undef PG8_WAIT_L
#undef PG8_BAR
#undef PG8_SCHED
}
}

#define GAS __attribute__((address_space(1)))
#define LAS __attribute__((address_space(3)))
typedef unsigned v4u __attribute__((ext_vector_type(4)));
typedef float f32x4 __attribute__((ext_vector_type(4)));
typedef short bf16x8 __attribute__((ext_vector_type(8)));
constexpr int NWAVES = 8;
constexpr int RING_BYTES = 131072, LDSCTL_OFF = RING_BYTES, MISC_OFF = LDSCTL_OFF + 320, LDS_BYTES = 147456;
constexpr size_t MiB = 1u << 20;
constexpr size_t CTL_ZERO_BYTES = 1 * MiB;
constexpr int CW_BAR = 4096;
constexpr int CW_MOE = 65536;
#define LDS_WAIT() asm volatile("s_waitcnt lgkmcnt(0)" ::: "memory")
#define VM_WAIT() asm volatile("s_waitcnt vmcnt(0)" ::: "memory")
DEV unsigned pk2(float lo, float hi) { return (unsigned)f2bf(lo) | ((unsigned)f2bf(hi) << 16); }

#define XB_TMO      128
#define XB_XCNT(j)  (256  + 64 * (j))
#define XB_XSUB(j)  (1280 + 64 * (j))
#define XB_XGEN(j)  (2304 + 64 * (j))
#define XB_TOP      3328
#define XB_TOPGEN   3392
#define XCD_BAR_WORDS 3456
#define XB_SPIN_CAP (1u << 22)
DEV unsigned xb_ld(unsigned* p)              { return __hip_atomic_load(p, __ATOMIC_RELAXED, __HIP_MEMORY_SCOPE_AGENT); }
DEV unsigned xb_add(unsigned* p, unsigned v) { return __hip_atomic_fetch_add(p, v, __ATOMIC_RELAXED, __HIP_MEMORY_SCOPE_AGENT); }
DEV unsigned xb_xcc_id() { return (unsigned)__builtin_amdgcn_s_getreg((3 << 11) | 20) & 0xFu; }
#define XB_SPIN(cond, bar) do { unsigned _sp = 0; while (cond) { __builtin_amdgcn_s_sleep(1); \
    if ((++_sp & 255u) == 0u) { if (xb_ld(&(bar)[XB_TMO])) break; if (_sp > XB_SPIN_CAP) { atomicAdd(&(bar)[XB_TMO], 1u); break; } } } } while (0)
struct XcdBarrier { unsigned* bar; unsigned x; volatile LAS unsigned* st; };
DEV XcdBarrier xcd_barrier_post(unsigned* bar, volatile LAS unsigned* st) {
    XcdBarrier b; b.bar = bar; b.x = xb_xcc_id(); b.st = st;
    if (threadIdx.x == 0) (void)xb_add(&bar[XB_XCNT(b.x)], 1u);
    return b;
}
DEV void xcd_barrier_complete(unsigned* bar, unsigned x, unsigned& nloc, unsigned& nx) {
    const unsigned G = gridDim.x * gridDim.y * gridDim.z;
    unsigned sum, cnt, mine, sp = 0u;
    for (;;) {
        sum = 0u; cnt = 0u; mine = 0u;
#pragma unroll
        for (unsigned j = 0; j < 16; ++j) { const unsigned c = xb_ld(&bar[XB_XCNT(j)]); sum += c; cnt += (c > 0u) ? 1u : 0u; mine = (j == x) ? c : mine; }
        if (sum == G) break;
        __builtin_amdgcn_s_sleep(1);
        if ((++sp & 255u) == 0u) { if (xb_ld(&bar[XB_TMO])) break; if (sp > XB_SPIN_CAP) { atomicAdd(&bar[XB_TMO], 1u); break; } }
    }
    nloc = mine > 0u ? mine : 1u; nx = cnt > 0u ? cnt : 1u;
}
DEV void xcd_barrier(const XcdBarrier& b, const int tid_) {
    asm volatile("s_waitcnt vmcnt(0)" ::: "memory");
    __syncthreads();
    if (tid_ == 0) {
        unsigned* bar = b.bar;
        __builtin_amdgcn_s_waitcnt(0);
        unsigned nloc = b.st[0], nx = b.st[1];
        if (nloc == 0u) { xcd_barrier_complete(bar, b.x, nloc, nx); b.st[0] = nloc; b.st[1] = nx; }
        const unsigned old = xb_add(&bar[XB_XSUB(b.x)], 1u);
        const unsigned gen = old / nloc;
        if (old + 1u == (gen + 1u) * nloc) {
            __builtin_amdgcn_fence(__ATOMIC_RELEASE, "agent");
            asm volatile("s_waitcnt vmcnt(0)" ::: "memory");
            const unsigned og = xb_add(&bar[XB_TOP], 1u);
            const unsigned tg = og / nx;
            if (og + 1u == (tg + 1u) * nx) xb_add(&bar[XB_TOPGEN], 1u);
            else XB_SPIN(xb_ld(&bar[XB_TOPGEN]) == tg, bar);
            __builtin_amdgcn_fence(__ATOMIC_ACQUIRE, "agent");
            xb_add(&bar[XB_XGEN(b.x)], 1u);
            asm volatile("s_waitcnt vmcnt(0)" ::: "memory");
        } else {
            XB_SPIN(xb_ld(&bar[XB_XGEN(b.x)]) == gen, bar);
            __builtin_amdgcn_fence(__ATOMIC_ACQUIRE, "agent");
            asm volatile("s_waitcnt vmcnt(0)" ::: "memory");
        }
    }
    __syncthreads();
}

struct Frame {
    LAS unsigned char* lds;
    volatile LAS unsigned* MISC;
    int tid, lane, wave;
    int vcu, G;
};

DEV void refresh(Frame& F) { int l; asm volatile("v_mbcnt_lo_u32_b32 %0, -1, 0\n\tv_mbcnt_hi_u32_b32 %0, -1, %0" : "=v"(l)); F.lane = l; F.tid = F.wave * 64 + l; }
DEV float wave_sum(float v) {
#pragma unroll
    for (int o = 1; o < 64; o <<= 1) v += __shfl_xor(v, o);
    return v;
}
DEV void transpose_item(const float* W, int K, int N, bf16* WT, int k0, int n0, int dst_row0, LAS float* scr, int lane) {
    const int c4 = lane & 7, r0 = lane >> 3;
    const bool okc = (n0 + 4 * c4) < N;
    f32x4 v[8];
#pragma unroll
    for (int i = 0; i < 8; ++i) v[i] = okc ? *(const GAS f32x4*)(W + (size_t)(k0 + r0 + 8 * i) * N + n0 + 4 * c4) : (f32x4){0.f, 0.f, 0.f, 0.f};
#pragma unroll
    for (int i = 0; i < 8; ++i) { LAS float* d = scr + (r0 + 8 * i) * 33 + 4 * c4; d[0] = v[i].x; d[1] = v[i].y; d[2] = v[i].z; d[3] = v[i].w; }
    LDS_WAIT(); asm volatile("" ::: "memory");
    const int c = lane & 7;
#pragma unroll
    for (int j = 0; j < 4; ++j) { const int n = (lane >> 3) + 8 * j; const LAS float* s = scr + (8 * c) * 33 + n;
        v4u o; o.x = pk2(s[0 * 33], s[1 * 33]); o.y = pk2(s[2 * 33], s[3 * 33]); o.z = pk2(s[4 * 33], s[5 * 33]); o.w = pk2(s[6 * 33], s[7 * 33]);
        if (n0 + n < N) *(GAS v4u*)(WT + (size_t)(dst_row0 + n) * K + k0 + 8 * c) = o; }
    LDS_WAIT(); asm volatile("" ::: "memory");
}
DEV float rms_row_to_bf16(int lane, const float* xrow, const float* gain, bf16* orow) {
    const GAS f32x4* xr = (const GAS f32x4*)xrow + lane;
    const GAS f32x4* gr = (const GAS f32x4*)gain + lane;
    f32x4 v[4]; float s = 0.f;
#pragma unroll
    for (int j = 0; j < 4; ++j) { v[j] = xr[64 * j]; s += (v[j].x * v[j].x + v[j].y * v[j].y) + (v[j].z * v[j].z + v[j].w * v[j].w); }
    const float rstd = 1.0f / sqrtf(wave_sum(s) * (1.f / D) + EPS);
    GAS unsigned long long* o8 = (GAS unsigned long long*)orow + lane;
#pragma unroll
    for (int j = 0; j < 4; ++j) { const f32x4 g = gr[64 * j];
        o8[64 * j] = (unsigned long long)pk2(v[j].x * rstd * g.x, v[j].y * rstd * g.y) | ((unsigned long long)pk2(v[j].z * rstd * g.z, v[j].w * rstd * g.w) << 32); }
    return rstd;
}

DEV void fp_convert_weights(const Params& P, Frame& F, int which, int ci, int n) {
    LAS float* scr = (LAS float*)(F.lds + F.wave * 16384);
    const int gw = ci * NWAVES + F.wave, NGW = n * NWAVES;
    constexpr int I_IN0 = 16 * 72, I_OUT = 16 * 32, I_IN1 = 16 * 89;
    if (which == 0) {
        for (int it = gw; it < I_IN0 + I_OUT; it += NGW) {
            int r = it;
            if (r < I_IN0) { const int kb = r / 72, nb = r % 72; transpose_item(P.ev_w_in, D, EVEN_IN, P.win0t, 64 * kb, 32 * nb, 32 * nb, scr, F.lane); continue; } r -= I_IN0;
            { const int kb = r / 32, nb = r % 32; transpose_item(P.ev_w_out, D, D, P.wout0t, 64 * kb, 32 * nb, 32 * nb, scr, F.lane); }
        }
    } else {
        for (int it = gw; it < I_IN1 + I_OUT; it += NGW) {
            int r = it;
            if (r < I_IN1) { const int kb = r / 89, nb = r % 89; transpose_item(P.od_w_in, D, ODD_IN, P.win1t, 64 * kb, 32 * nb, 32 * nb, scr, F.lane); continue; } r -= I_IN1;
            { const int kb = r / 32, nb = r % 32; transpose_item(P.od_w_out, D, D, P.wout1t, 64 * kb, 32 * nb, 32 * nb, scr, F.lane); }
        }
    }
}
DEV void fp_norm_rows(Frame& F, const float* src, const float* gain, bf16* xn) {
    const int gw = F.vcu * NWAVES + F.wave, NGW = F.G * NWAVES;
    for (int m = gw; m < T; m += NGW) rms_row_to_bf16(F.lane, src + (size_t)m * D, gain, xn + (size_t)m * D);
}

constexpr int TAB_OFF = MISC_OFF + 128;
constexpr int RT_PART_OFF = 0;
constexpr int RT_SS_OFF = 98304;
constexpr int RT_HIST_OFF = 100352;
typedef float f32x4v __attribute__((ext_vector_type(4)));

DEV void fp_prep_router(const Params& P, Frame& F) {
    const int gtid = F.vcu * NWAVES * 64 + F.tid, gsz = F.G * NWAVES * 64;
    for (int i = gtid; i < 2 * 48 * D; i += gsz) {
        const int k = i & (D - 1), j = (i >> 10) % 48, l = i / (48 * D);
        float w = 0.f;
        if (j < 4) w = P.moe_w_grp[((size_t)l * D + k) * 4 + j]; else if (j < 36) w = P.moe_w_exp[((size_t)l * D + k) * 32 + (j - 4)];
        w *= P.moe_norm[l * D + k];
        const bf16 hi = f2bf(w); const bf16 lo = f2bf(w - bf2f(hi));
        P.wr[((size_t)(l * 2 + 0) * 48 + j) * D + k] = hi;
        P.wr[((size_t)(l * 2 + 1) * 48 + j) * D + k] = lo;
    }
}

DEV void fp_route(const Params& P, Frame& F, int layer) {
    const int lane = F.lane, w = F.wave;
    const bf16* wr_hi = P.wr + (size_t)(layer * 2 + 0) * 48 * D;
    const bf16* wr_lo = P.wr + (size_t)(layer * 2 + 1) * 48 * D;
    LAS float* part = (LAS float*)(F.lds + RT_PART_OFF);
    LAS float* ssp = (LAS float*)(F.lds + RT_SS_OFF);
    LAS unsigned* hist = (LAS unsigned*)(F.lds + RT_HIST_OFF);
    unsigned* cnt = P.ctl + CW_MOE + layer * 256;
    for (int tb = F.vcu; tb < T / 64; tb += F.G) {
        const int t0 = tb * 64;
        if (F.tid < 64) hist[F.tid] = 0u;
        const float* xrow = P.out + (size_t)(t0 + (lane & 15)) * D + 128 * w + 8 * (lane >> 4);
        const size_t boff = (size_t)(lane & 15) * D + 128 * w + 8 * (lane >> 4);
        pg8::f32x4 acc[4][3];
        float ss[4] = {0.f, 0.f, 0.f, 0.f};
#pragma unroll
        for (int g = 0; g < 4; ++g)
#pragma unroll
            for (int c = 0; c < 3; ++c) acc[g][c] = (pg8::f32x4){0.f, 0.f, 0.f, 0.f};
#pragma unroll 1
        for (int ks = 0; ks < 4; ++ks) {
            bf16x8 bh[3], bl[3];
#pragma unroll
            for (int c = 0; c < 3; ++c) { bh[c] = *(const bf16x8*)(wr_hi + boff + (size_t)16 * c * D + 32 * ks); bl[c] = *(const bf16x8*)(wr_lo + boff + (size_t)16 * c * D + 32 * ks); }
            f32x4v xa[4], xb[4];
#pragma unroll
            for (int g = 0; g < 4; ++g) { xa[g] = *(const f32x4v*)(xrow + (size_t)16 * g * D + 32 * ks); xb[g] = *(const f32x4v*)(xrow + (size_t)16 * g * D + 32 * ks + 4); }
#pragma unroll
            for (int g = 0; g < 4; ++g) {
                float xv[8] = {xa[g].x, xa[g].y, xa[g].z, xa[g].w, xb[g].x, xb[g].y, xb[g].z, xb[g].w};
                bf16x8 ah, al;
#pragma unroll
                for (int j = 0; j < 8; ++j) { ss[g] += xv[j] * xv[j]; const bf16 h = f2bf(xv[j]); ah[j] = (short)h; al[j] = (short)f2bf(xv[j] - bf2f(h)); }
#pragma unroll
                for (int c = 0; c < 3; ++c) {
                    acc[g][c] = __builtin_amdgcn_mfma_f32_16x16x32_bf16(ah, bh[c], acc[g][c], 0, 0, 0);
                    acc[g][c] = __builtin_amdgcn_mfma_f32_16x16x32_bf16(ah, bl[c], acc[g][c], 0, 0, 0);
                    acc[g][c] = __builtin_amdgcn_mfma_f32_16x16x32_bf16(al, bh[c], acc[g][c], 0, 0, 0);
                }
            }
        }
#pragma unroll
        for (int g = 0; g < 4; ++g) {
            float s = ss[g]; s += __shfl_xor(s, 16); s += __shfl_xor(s, 32);
            if (lane < 16) ssp[w * 64 + 16 * g + lane] = s;
#pragma unroll
            for (int c = 0; c < 3; ++c)
#pragma unroll
                for (int r = 0; r < 4; ++r) part[(w * 64 + 16 * g + 4 * (lane >> 4) + r) * 48 + 16 * c + (lane & 15)] = acc[g][c][r];
        }
        __syncthreads();
        for (int i = F.tid; i < 64 * 48; i += NWAVES * 64) { float a = part[i];
#pragma unroll
            for (int ww = 1; ww < 8; ++ww) a += part[ww * 64 * 48 + i];
            part[i] = a; }
        if (F.tid < 64) { float a = ssp[F.tid];
#pragma unroll
            for (int ww = 1; ww < 8; ++ww) a += ssp[ww * 64 + F.tid];
            ssp[F.tid] = a; }
        __syncthreads();
        int e1 = 0, e2 = 0; float w1 = 0.f, w2 = 0.f; unsigned r1 = 0, r2 = 0;
        if (F.tid < 64) {
            const int t = t0 + F.tid;
            const float rs = 1.0f / sqrtf(ssp[F.tid] * (1.f / D) + EPS);
            P.rstd[t] = rs;
            float lg[4], le[32];
#pragma unroll
            for (int j = 0; j < 4; ++j) lg[j] = part[F.tid * 48 + j] * rs + P.moe_b_grp[layer * 4 + j];
#pragma unroll
            for (int j = 0; j < 32; ++j) le[j] = part[F.tid * 48 + 4 + j] * rs + P.moe_b_exp[layer * 32 + j];
            int gs = 0; float gm = lg[0];
#pragma unroll
            for (int j = 1; j < 4; ++j) if (lg[j] > gm) { gm = lg[j]; gs = j; }
            float gz = 0.f;
#pragma unroll
            for (int j = 0; j < 4; ++j) gz += expf(lg[j] - gm);
            const float pg = 1.0f / gz;
            float wv[8];
#pragma unroll
            for (int j = 0; j < 8; ++j) wv[j] = gs == 0 ? le[j] : gs == 1 ? le[8 + j] : gs == 2 ? le[16 + j] : le[24 + j];
            int i1 = 0; float m1 = wv[0];
#pragma unroll
            for (int j = 1; j < 8; ++j) if (wv[j] > m1) { m1 = wv[j]; i1 = j; }
            int i2 = -1; float m2 = -3e38f;
#pragma unroll
            for (int j = 0; j < 8; ++j) if (j != i1 && wv[j] > m2) { m2 = wv[j]; i2 = j; }
            const float ex2 = expf(m2 - m1);
            w1 = pg / (1.0f + ex2); w2 = pg * ex2 / (1.0f + ex2);
            e1 = gs * 8 + i1; e2 = gs * 8 + i2;
            r1 = __hip_atomic_fetch_add(&hist[e1], 1u, __ATOMIC_RELAXED, __HIP_MEMORY_SCOPE_WORKGROUP); r2 = __hip_atomic_fetch_add(&hist[e2], 1u, __ATOMIC_RELAXED, __HIP_MEMORY_SCOPE_WORKGROUP);
        }
        __syncthreads();
        if (F.tid < 32) { const unsigned h = hist[F.tid]; hist[32 + F.tid] = h ? xb_add(&cnt[F.tid], h) : 0u; }
        __syncthreads();
        if (F.tid < 64) {
            const int t = t0 + F.tid;
            P.eid[t * 2 + 0] = e1; P.eid[t * 2 + 1] = e2; P.ew[t * 2 + 0] = w1; P.ew[t * 2 + 1] = w2;
            const int i1x = (int)(hist[32 + e1] + r1), i2x = (int)(hist[32 + e2] + r2);
            P.pos[t * 2 + 0] = i1x; P.pos[t * 2 + 1] = i2x;
            P.rowtok[e1 * T + i1x] = t; P.rowtok[e2 * T + i2x] = t;
        }
        for (int r = w; r < 64; r += NWAVES) rms_row_to_bf16(lane, P.out + (size_t)(t0 + r) * D, P.moe_norm + layer * D, P.xn + (size_t)(t0 + r) * D);
        __syncthreads();
    }
}

DEV void moe_table(const Params& P, Frame& F, int layer) {
    volatile LAS int* tab = (volatile LAS int*)(F.lds + TAB_OFF);
    if (F.tid == 0) {
        unsigned* cnt = P.ctl + CW_MOE + layer * 256;
        int acc = 0;
        for (int e = 0; e < 32; ++e) { tab[e] = acc; acc += (int)((xb_ld(&cnt[e]) + 255u) >> 8); }
        tab[32] = acc;
    }
    __syncthreads();
}

struct ListOrder {
    int code[4]; int n, npn; const char* A; const char* Bt; size_t tstep, bstep;
    __device__ __forceinline__ bool next(int i, pg8::Unit& o) const {
        if (i >= n) return false;
        const int c = (i == 0) ? code[0] : (i == 1) ? code[1] : (i == 2) ? code[2] : code[3];
        const int tt = c >> 8, e = (c >> 3) & 31, pn = c & 7;
        o.pm = tt; o.pn = pn; o.A = A + (size_t)tt * tstep; o.B = Bt + (size_t)(e * npn + pn) * bstep; return true;
    }
};
DEV void fp_moe_fused(const Params& P, Frame& F, int layer, int ci, int ncu) {
    moe_table(P, F, layer);
    volatile LAS int* tab = (volatile LAS int*)(F.lds + TAB_OFF);
    const int ntile = __builtin_amdgcn_readfirstlane(tab[32]);
#pragma unroll
    for (int rep = 0; rep < 2; ++rep) { const int tt = ci + rep * ncu; if (tt >= ntile) break;
        int e = 0;
        for (int q = 1; q < 32; ++q) e += (tt >= tab[q]) ? 1 : 0;
        e = __builtin_amdgcn_readfirstlane(e);
        const int cb = (tt << 8) | (e << 3);
        {
          const int rbase = e * T + (tt - tab[e]) * 256;
          unsigned g[2][2];
#pragma unroll
          for (int hh = 0; hh < 2; ++hh)
#pragma unroll
              for (int i = 0; i < 2; ++i) { int R, C; pg8::stage_rc(F.tid * 16 + i * 8192, R, C); int tk = P.rowtok[rbase + hh * 128 + R]; tk = ((unsigned)tk < (unsigned)T) ? tk : 0; g[hh][i] = (unsigned)tk * (unsigned)(D * 2); }
          ListOrder L; L.tstep = 0; L.A = (const char*)P.xn; L.Bt = (const char*)P.wgut[layer]; L.npn = 2; L.n = 2; L.bstep = (size_t)256 * D * 2;
          L.code[0] = cb; L.code[1] = cb | 1; L.code[2] = 0; L.code[3] = 0;
          pg8::EpiSiluMul E{P.hid, 256}; pg8::gemm_phase<pg8::EpiSiluMul, ListOrder, true>(F.lds, D, L, E, F.tid, g[0][0], g[0][1], g[1][0], g[1][1]); }
        refresh(F);
        if (F.tid == 0) { __builtin_amdgcn_fence(__ATOMIC_ACQUIRE, "agent"); asm volatile("s_waitcnt vmcnt(0)" ::: "memory"); }
        __syncthreads();
        { ListOrder L; L.tstep = (size_t)256 * 256 * 2; L.bstep = L.tstep; L.A = (const char*)P.hid; L.Bt = (const char*)P.wdt[layer]; L.npn = 4; L.n = 4;
          L.code[0] = cb; L.code[1] = cb | 1; L.code[2] = cb | 2; L.code[3] = cb | 3;
          pg8::EpiStoreBf16 E{P.ha, D}; pg8::gemm_phase(F.lds, 256, L, E, F.tid); }
        refresh(F);
    }
}
DEV void fp_combine(const Params& P, Frame& F, int layer, const float* gain2, bf16* xn) {
    moe_table(P, F, layer);
    volatile LAS int* tab = (volatile LAS int*)(F.lds + TAB_OFF);
    const int gw = F.vcu * NWAVES + F.wave, NGW = F.G * NWAVES, lane = F.lane;
    for (int t = gw; t < T; t += NGW) {
        const int p1 = tab[P.eid[t * 2]] * 256 + P.pos[t * 2], p2 = tab[P.eid[t * 2 + 1]] * 256 + P.pos[t * 2 + 1];
        const float w1 = P.ew[t * 2], w2 = P.ew[t * 2 + 1];
        GAS f32x4* xr = (GAS f32x4*)(P.out + (size_t)t * D) + lane;
        const GAS unsigned long long* y1 = (const GAS unsigned long long*)(P.ha + (size_t)p1 * D) + lane;
        const GAS unsigned long long* y2 = (const GAS unsigned long long*)(P.ha + (size_t)p2 * D) + lane;
        f32x4 v[4]; float s = 0.f;
#pragma unroll
        for (int j = 0; j < 4; ++j) {
            v[j] = xr[64 * j];
            const unsigned long long a = y1[64 * j], b = y2[64 * j];
            v[j].x += w1 * u2f((unsigned)(a & 0xffffu) << 16) + w2 * u2f((unsigned)(b & 0xffffu) << 16);
            v[j].y += w1 * u2f((unsigned)((a >> 16) & 0xffffu) << 16) + w2 * u2f((unsigned)((b >> 16) & 0xffffu) << 16);
            v[j].z += w1 * u2f((unsigned)((a >> 32) & 0xffffu) << 16) + w2 * u2f((unsigned)((b >> 32) & 0xffffu) << 16);
            v[j].w += w1 * u2f((unsigned)((a >> 48) & 0xffffu) << 16) + w2 * u2f((unsigned)((b >> 48) & 0xffffu) << 16);
            xr[64 * j] = v[j];
            s += (v[j].x * v[j].x + v[j].y * v[j].y) + (v[j].z * v[j].z + v[j].w * v[j].w);
        }
        if (xn) {
            const float rstd = 1.0f / sqrtf(wave_sum(s) * (1.f / D) + EPS);
            const GAS f32x4* gr = (const GAS f32x4*)gain2 + lane;
            GAS unsigned long long* o8 = (GAS unsigned long long*)(xn + (size_t)t * D) + lane;
#pragma unroll
            for (int j = 0; j < 4; ++j) { const f32x4 g = gr[64 * j];
                o8[64 * j] = (unsigned long long)pk2(v[j].x * rstd * g.x, v[j].y * rstd * g.y) | ((unsigned long long)pk2(v[j].z * rstd * g.z, v[j].w * rstd * g.w) << 32); }
        }
    }
}


DEV void fp_convert_moe_part(const Params& P, Frame& F, int layer, int ci, int nconv) {
    LAS float* scr = (LAS float*)(F.lds + F.wave * 16384);
    constexpr int NIT = 32 * 384;
    for (int it = ci * NWAVES + F.wave; it < NIT; it += nconv * NWAVES) {
        const int e = it / 384; int r = it % 384;
        const size_t eo = (size_t)(layer * 32 + e);
        if (r < 256) { const bool up = r >= 128; r &= 127; const int kb = r / 8, nb = r % 8; const int f0 = 32 * nb;
            const float* W = (up ? P.moe_w_up : P.moe_w_gate) + eo * D * 256;
            transpose_item(W, D, 256, P.wgut[layer] + (size_t)e * 512 * D, 64 * kb, f0, (f0 >> 7) * 256 + (up ? 128 : 0) + (f0 & 127), scr, F.lane);
        } else { r -= 256; const int kb = r / 32, nb = r % 32;
            transpose_item(P.moe_w_down + eo * 256 * D, 256, D, P.wdt[layer] + (size_t)e * D * 256, 64 * kb, 32 * nb, 32 * nb, scr, F.lane); }
    }
}
namespace att {
typedef float f32x16 __attribute__((ext_vector_type(16)));
typedef short s16x4 __attribute__((ext_vector_type(4)));
typedef short v4i16_t __attribute__((ext_vector_type(4)));
typedef LAS const char* lptr;
constexpr float LOG2E = 1.4426950408889634f;
constexpr int KS0 = 0, VS0 = 32768, SLOT = 8192;
constexpr int SCR0 = 65536;
constexpr float MNEG = -1e30f;

struct TileRegs { v4u k, v; };
DEV void tile_load(TileRegs& R, const bf16* Kg, const bf16* Vg, int pitch, int k0, int tid) {
    const int w = tid >> 6, lane = tid & 63;
    R.k = *(const GAS v4u*)(Kg + (size_t)(k0 + lane) * pitch + w * 8);
    R.v = *(const GAS v4u*)(Vg + (size_t)(k0 + 16 * (w & 3) + (lane >> 2)) * pitch + (w >> 2) * 32 + (lane & 3) * 8);
}
DEV void tile_store(LAS unsigned char* lds, int slot, const TileRegs& R, int tid) {
    *(LAS v4u*)(lds + KS0 + slot * SLOT + tid * 16) = R.k;
    *(LAS v4u*)(lds + VS0 + slot * SLOT + tid * 16) = R.v;
}
DEV void qk_tile(f32x16& p0, f32x16& p1, lptr Kslot, const bf16x8 (&qr)[4], int r32, int hi) {
    lptr kb = Kslot + hi * 1024 + r32 * 16;
    p0 = f32x16{}; p1 = f32x16{};
#pragma unroll
    for (int dh = 0; dh < 2; ++dh) {
        bf16x8 kf[4];
#pragma unroll
        for (int d1 = 0; d1 < 2; ++d1) { kf[2 * d1] = *(const LAS bf16x8*)(kb + (2 * dh + d1) * 2048); kf[2 * d1 + 1] = *(const LAS bf16x8*)(kb + (2 * dh + d1) * 2048 + 512); }
#pragma unroll
        for (int d1 = 0; d1 < 2; ++d1) {
            p0 = __builtin_amdgcn_mfma_f32_32x32x16_bf16(kf[2 * d1], qr[2 * dh + d1], p0, 0, 0, 0);
            p1 = __builtin_amdgcn_mfma_f32_32x32x16_bf16(kf[2 * d1 + 1], qr[2 * dh + d1], p1, 0, 0, 0);
        }
    }
}
DEV s16x4 vtr(lptr p) { return __builtin_bit_cast(s16x4, __builtin_amdgcn_ds_read_tr16_b64_v4i16((LAS v4i16_t*)p)); }
DEV unsigned cvtpk(float lo, float hi) { unsigned r; asm volatile("v_cvt_pk_bf16_f32 %0, %1, %2" : "=v"(r) : "v"(lo), "v"(hi)); return r; }
DEV void pv_tile(f32x16 (&o)[2], lptr Vslot, const f32x16& p0, const f32x16& p1, int lane) {
    const int hi = lane >> 5;
    lptr vp = Vslot + ((lane >> 4) & 1) * 32 + (lane & 3) * 8 + (4 * hi + ((lane & 15) >> 2)) * 64;
    bf16x8 pf[4];
#pragma unroll
    for (int ks = 0; ks < 4; ++ks) {
        const f32x16& p = (ks < 2) ? p0 : p1; const int b = (ks & 1) * 8;
        v4u w; w.x = cvtpk(p[b + 0], p[b + 1]); w.y = cvtpk(p[b + 2], p[b + 3]); w.z = cvtpk(p[b + 4], p[b + 5]); w.w = cvtpk(p[b + 6], p[b + 7]);
        pf[ks] = __builtin_bit_cast(bf16x8, w);
    }
#pragma unroll
    for (int d0 = 0; d0 < 2; ++d0)
#pragma unroll
        for (int ks = 0; ks < 4; ++ks) {
            const s16x4 lo = vtr(vp + d0 * 4096 + ks * 1024), hh = vtr(vp + d0 * 4096 + ks * 1024 + 512);
            const bf16x8 vf = (bf16x8){lo[0], lo[1], lo[2], lo[3], hh[0], hh[1], hh[2], hh[3]};
            o[d0] = __builtin_amdgcn_mfma_f32_32x32x16_bf16(vf, pf[ks], o[d0], 0, 0, 0);
        }
}
DEV float lane_swap_max(float m) {
    auto rr = __builtin_amdgcn_permlane32_swap(__float_as_uint(m), __float_as_uint(m), false, false);
    return fmaxf(__uint_as_float(rr[0]), __uint_as_float(rr[1]));
}
DEV float lane_swap_sum(float m) {
    auto rr = __builtin_amdgcn_permlane32_swap(__float_as_uint(m), __float_as_uint(m), false, false);
    return __uint_as_float(rr[0]) + __uint_as_float(rr[1]);
}
DEV float lane_partner(float m, int hi) {
    auto rr = __builtin_amdgcn_permlane32_swap(__float_as_uint(m), __float_as_uint(m), false, false);
    return hi ? __uint_as_float(rr[0]) : __uint_as_float(rr[1]);
}

constexpr float M0 = 16.0f;
struct SoftState { float l; f32x16 o[2]; };
DEV void soft_reset(SoftState& s) { s.l = 0.f; s.o[0] = f32x16{}; s.o[1] = f32x16{}; }

DEV void soft_tile(SoftState& st, f32x16& p0, f32x16& p1, float s2, float k0rel_f, int klo, int klim, bool need_mask, lptr Vslot, int lane) {
    const int hi = lane >> 5;
    const float c1 = 0.125f * LOG2E;
    const float base = s2 * (k0rel_f + (float)(4 * hi)) - M0;
    float ls0 = 0.f, ls1 = 0.f;
    if (need_mask) {
#pragma unroll
        for (int r = 0; r < 16; ++r) {
            const int kr = (r & 3) + 8 * (r >> 2);
            const float x0 = __builtin_amdgcn_exp2f(fmaf(p0[r], c1, fmaf(s2, (float)kr, base)));
            const float x1 = __builtin_amdgcn_exp2f(fmaf(p1[r], c1, fmaf(s2, (float)(kr + 32), base)));
            p0[r] = (kr > klo && kr <= klim) ? x0 : 0.f; p1[r] = (kr + 32 > klo && kr + 32 <= klim) ? x1 : 0.f;
            ls0 += p0[r]; ls1 += p1[r];
        }
    } else {
#pragma unroll
        for (int r = 0; r < 16; ++r) {
            const int kr = (r & 3) + 8 * (r >> 2);
            p0[r] = __builtin_amdgcn_exp2f(fmaf(p0[r], c1, fmaf(s2, (float)kr, base)));
            p1[r] = __builtin_amdgcn_exp2f(fmaf(p1[r], c1, fmaf(s2, (float)(kr + 32), base)));
            ls0 += p0[r]; ls1 += p1[r];
        }
    }
    st.l += ls0 + ls1;
    pv_tile(st.o, Vslot, p0, p1, lane);
}

DEV void soft_pair_fast(SoftState& st, const bf16x8 (&qr)[4], lptr Ka, lptr Va, lptr Kb, lptr Vb, float s2, float baseA, float baseB, int lane) {
    const int r32 = lane & 31, hi = lane >> 5;
    const float c1 = 0.125f * LOG2E;
    f32x16 a0, a1, b0, b1;
    qk_tile(a0, a1, Ka, qr, r32, hi);
    qk_tile(b0, b1, Kb, qr, r32, hi);
    float ls0 = 0.f, ls1 = 0.f;
#pragma unroll
    for (int r = 0; r < 16; ++r) {
        const int kr = (r & 3) + 8 * (r >> 2);
        a0[r] = __builtin_amdgcn_exp2f(fmaf(a0[r], c1, fmaf(s2, (float)kr, baseA)));
        a1[r] = __builtin_amdgcn_exp2f(fmaf(a1[r], c1, fmaf(s2, (float)(kr + 32), baseA)));
        ls0 += a0[r]; ls1 += a1[r];
    }
    pv_tile(st.o, Va, a0, a1, lane);
#pragma unroll
    for (int r = 0; r < 16; ++r) {
        const int kr = (r & 3) + 8 * (r >> 2);
        b0[r] = __builtin_amdgcn_exp2f(fmaf(b0[r], c1, fmaf(s2, (float)kr, baseB)));
        b1[r] = __builtin_amdgcn_exp2f(fmaf(b1[r], c1, fmaf(s2, (float)(kr + 32), baseB)));
        ls0 += b0[r]; ls1 += b1[r];
    }
    st.l += ls0 + ls1;
    pv_tile(st.o, Vb, b0, b1, lane);
}

DEV void store_ot(const f32x16 (&o)[2], float f, bf16* orow, int hi) {
#pragma unroll
    for (int d0 = 0; d0 < 2; ++d0)
#pragma unroll
        for (int g = 0; g < 4; ++g) {
            const unsigned a = cvtpk(o[d0][4 * g] * f, o[d0][4 * g + 1] * f), b = cvtpk(o[d0][4 * g + 2] * f, o[d0][4 * g + 3] * f);
            *(GAS unsigned long long*)(orow + 32 * d0 + 8 * g + 4 * hi) = (unsigned long long)a | ((unsigned long long)b << 32);
        }
}
DEV void load_q(bf16x8 (&qr)[4], const bf16* qrow, int hi) {
#pragma unroll
    for (int d0 = 0; d0 < 4; ++d0) qr[d0] = *(const GAS bf16x8*)(qrow + 16 * d0 + 8 * hi);
}

template <bool FAST, class MaskF>
DEV void run_segment(Frame& F, SoftState& st, const bf16x8 (&qr)[4], const bf16* Kg, const bf16* Vg, int pitch, unsigned long long tmask, float s2, int qpos, const MaskF& mf) {
    const int tid = F.tid, lane = F.lane, r32 = lane & 31, hi = lane >> 5;
    if (tmask == 0ull) return;
#define NEXT_TILE(var) do { if (tmask) { var = __builtin_ctzll(tmask); tmask &= tmask - 1ull; } else var = -1; } while (0)
#define SEG_COMPUTE(t, slot) do { int klo, klim; mf((t), klo, klim); \
        if (__any(klim >= 0 && klo < 60 && klim > klo)) { const bool need_mask = __any(klo >= 0 || klim < 60); f32x16 p0, p1; \
            qk_tile(p0, p1, (lptr)(F.lds + KS0 + (slot) * SLOT), qr, r32, hi); \
            soft_tile(st, p0, p1, s2, (float)((t) * 64 - qpos), klo, klim, need_mask, (lptr)(F.lds + VS0 + (slot) * SLOT), lane); } } while (0)
    int ta, tb, tc, td, set = 0;
    NEXT_TILE(ta); NEXT_TILE(tb);
    TileRegs RA, RB; tile_load(RA, Kg, Vg, pitch, ta * 64, tid); if (tb >= 0) tile_load(RB, Kg, Vg, pitch, tb * 64, tid);
    for (;;) {
        tile_store(F.lds, 2 * set, RA, tid); if (tb >= 0) tile_store(F.lds, 2 * set + 1, RB, tid);
        NEXT_TILE(tc); NEXT_TILE(td);
        if (tc >= 0) tile_load(RA, Kg, Vg, pitch, tc * 64, tid);
        if (td >= 0) tile_load(RB, Kg, Vg, pitch, td * 64, tid);
        __syncthreads();
        bool fast = false;
        if (FAST && tb >= 0) {
            int kloA, klimA, kloB, klimB; mf(ta, kloA, klimA); mf(tb, kloB, klimB);
            const bool fullA = klimA >= 59 && kloA < 0, noneA = klimA < 0 || kloA >= 59 || klimA <= kloA;
            const bool fullB = klimB >= 59 && kloB < 0, noneB = klimB < 0 || kloB >= 59 || klimB <= kloB;
            fast = __all((fullA || noneA) && (fullB || noneB)) && __any(fullA) && __any(fullB);
            if (fast) {
                const float hb = (float)(4 * hi - qpos);
                const float baseA = fullA ? s2 * ((float)(ta * 64) + hb) - M0 : MNEG, baseB = fullB ? s2 * ((float)(tb * 64) + hb) - M0 : MNEG;
                soft_pair_fast(st, qr, (lptr)(F.lds + KS0 + (2 * set) * SLOT), (lptr)(F.lds + VS0 + (2 * set) * SLOT), (lptr)(F.lds + KS0 + (2 * set + 1) * SLOT), (lptr)(F.lds + VS0 + (2 * set + 1) * SLOT), s2, baseA, baseB, lane);
            }
        }
        if (!fast) {
            SEG_COMPUTE(ta, 2 * set);
            if (tb >= 0) SEG_COMPUTE(tb, 2 * set + 1);
        }
        if (tc < 0) break;
        ta = tc; tb = td; set ^= 1;
    }
    __syncthreads();
#undef NEXT_TILE
#undef SEG_COMPUTE
}
DEV unsigned long long tile_range(int t0, int t1) { return (t1 < t0) ? 0ull : ((~0ull >> (63 - (t1 - t0))) << t0); }
}

DEV void headnorm_group(bf16* row, int off, int nheads, const float* g, int lane) {
    const int hg = lane >> 3, ch = lane & 7;
    if (hg < nheads) {
        GAS v4u* p = (GAS v4u*)(row + off + hg * 64 + ch * 8);
        const v4u x = *p;
        float v[8] = {u2f(x.x << 16), u2f(x.x & 0xffff0000u), u2f(x.y << 16), u2f(x.y & 0xffff0000u), u2f(x.z << 16), u2f(x.z & 0xffff0000u), u2f(x.w << 16), u2f(x.w & 0xffff0000u)};
        float ss = 0.f;
#pragma unroll
        for (int j = 0; j < 8; ++j) ss += v[j] * v[j];
        ss += __shfl_xor(ss, 1); ss += __shfl_xor(ss, 2); ss += __shfl_xor(ss, 4);
        const float r = 1.0f / sqrtf(ss * (1.0f / 64) + EPS);
        const f32x4 g0 = *(const GAS f32x4*)(g + ch * 8), g1 = *(const GAS f32x4*)(g + ch * 8 + 4);
        v4u o; o.x = pk2(v[0] * r * g0.x, v[1] * r * g0.y); o.y = pk2(v[2] * r * g0.z, v[3] * r * g0.w); o.z = pk2(v[4] * r * g1.x, v[5] * r * g1.y); o.w = pk2(v[6] * r * g1.z, v[7] * r * g1.w);
        *p = o;
    }
}
DEV void fp_headnorm(const Params& P, Frame& F, int layer) {
    const int gw = F.vcu * NWAVES + F.wave, NGW = F.G * NWAVES, lane = F.lane;
    for (int t = gw; t < T; t += NGW) {
        bf16* row = P.proj + (size_t)t * LDP;
        if (layer == 0) {
            headnorm_group(row, 0, 8, P.ev_q_norm, lane);
            headnorm_group(row, 512, 2, P.ev_k_norm, lane);
        } else {
            headnorm_group(row, 0, 8, P.od_c_q_norm, lane);
            headnorm_group(row, 512, 8, P.od_c_k_norm, lane);
            headnorm_group(row, 1536, 8, P.od_d_q_norm, lane);
            headnorm_group(row, 2304, 2, P.od_d_k_norm + 64, lane);
            headnorm_group(row, 2560, 2, P.od_d_k_norm + 128, lane);
        }
    }
}

DEV void fp_prep_compress(const Params& P, Frame& F, int ci, int n) {
    const int gw = ci * NWAVES + F.wave, NGW = n * NWAVES, lane = F.lane;
    for (int i = gw; i < 128; i += NGW) {
        const int which = i >> 6, e = i & 63;
        const float* pos = P.od_cmp_pos + which * 2048; const float* w = P.od_cmp_w + (size_t)which * 2048 * 64 + e;
        float s = 0.f;
        for (int k = lane; k < 2048; k += 64) s += pos[k] * w[(size_t)k * 64];
        s = wave_sum(s);
        if (lane == 0) P.cbias[i] = s;
    }
    LAS float* scr = (LAS float*)(F.lds + F.wave * 16384);
    for (int i = gw; i < 128; i += NGW) {
        const int which = i >> 6, r = i & 63, kb = r >> 1, nb = r & 1;
        transpose_item(P.od_cmp_w + (size_t)which * 2048 * 64, 2048, 64, P.wcmpt + (size_t)which * 64 * 2048, 64 * kb, 32 * nb, 32 * nb, scr, lane);
    }
}

DEV void fp_prep1(const Params& P, Frame& F) {
    const int gw = F.vcu * NWAVES + F.wave, NGW = F.G * NWAVES, lane = F.lane, w = F.wave;
    for (int i = gw; i < NB * 64; i += NGW) {
        const int n = i & 7, h = (i >> 3) & 7, b = i >> 6;
        const bf16* kp = P.proj + ((size_t)b * S + n * 256) * LDP + 512 + h * 64 + lane;
        float s0 = 0.f, s1 = 0.f, s2 = 0.f, s3 = 0.f;
#pragma unroll 4
        for (int j = 0; j < 256; j += 4) { s0 += bf2f(kp[(size_t)j * LDP]); s1 += bf2f(kp[(size_t)(j + 1) * LDP]); s2 += bf2f(kp[(size_t)(j + 2) * LDP]); s3 += bf2f(kp[(size_t)(j + 3) * LDP]); }
        P.kmean[(size_t)i * 64 + lane] = ((s0 + s1) + (s2 + s3)) * (1.0f / 256);
    }
    LAS float* part = (LAS float*)F.lds;
    for (int it = F.vcu; it < 2 * NB * 2 * 8; it += F.G) {
        const int ng = it & 7, hkv = (it >> 3) & 1, b = (it >> 4) % NB, which = it / (16 * NB);
        const int n = 16 * ng + (lane & 15);
        const int ncl = n > 126 ? 126 : n;
        const bf16* arow = P.proj + ((size_t)b * S + ncl * 16) * LDP + (which ? 2176 : 2048) + hkv * 64 + 8 * (lane >> 4);
        const bf16* brow = P.wcmpt + (size_t)which * 64 * 2048 + (size_t)(lane & 15) * 2048 + 8 * (lane >> 4);
        pg8::f32x4 acc[4];
#pragma unroll
        for (int c = 0; c < 4; ++c) acc[c] = (pg8::f32x4){0.f, 0.f, 0.f, 0.f};
#pragma unroll
        for (int kk = 0; kk < 8; ++kk) {
            const int ks = 8 * w + kk, li = ks >> 1, dh = (ks & 1) * 32;
            const bf16x8 a = *(const GAS bf16x8*)(arow + (size_t)li * LDP + dh);
#pragma unroll
            for (int c = 0; c < 4; ++c) {
                const bf16x8 bb = *(const GAS bf16x8*)(brow + (size_t)(16 * c) * 2048 + 32 * ks);
                acc[c] = __builtin_amdgcn_mfma_f32_16x16x32_bf16(a, bb, acc[c], 0, 0, 0);
            }
        }
#pragma unroll
        for (int c = 0; c < 4; ++c)
#pragma unroll
            for (int r = 0; r < 4; ++r) part[(w * 16 + 4 * (lane >> 4) + r) * 64 + 16 * c + (lane & 15)] = acc[c][r];
        __syncthreads();
        {
            const int row = F.tid >> 5, c0 = 2 * (F.tid & 31);
            float v0 = P.cbias[which * 64 + c0], v1 = P.cbias[which * 64 + c0 + 1];
#pragma unroll
            for (int ww = 0; ww < 8; ++ww) { v0 += part[(ww * 16 + row) * 64 + c0]; v1 += part[(ww * 16 + row) * 64 + c0 + 1]; }
            if (which == 0) {
                float ss = v0 * v0 + v1 * v1;
                ss += __shfl_xor(ss, 1); ss += __shfl_xor(ss, 2); ss += __shfl_xor(ss, 4); ss += __shfl_xor(ss, 8); ss += __shfl_xor(ss, 16);
                const float rs = 1.0f / sqrtf(ss * (1.0f / 64) + EPS);
                v0 *= rs * P.od_d_k_norm[c0]; v1 *= rs * P.od_d_k_norm[c0 + 1];
            }
            const int nn = 16 * ng + row;
            if (nn < NCMP) *(GAS unsigned*)(P.kvcmp + (((size_t)(which * NB + b) * NCMP + nn) * 2 + hkv) * 64 + c0) = pk2(v0, v1);
        }
        __syncthreads();
    }
}

DEV void sb_tile(att::f32x16& p0, att::f32x16& p1, float& carry, int lim, int hi) {
    using namespace att;
    const float c1 = 0.125f * LOG2E;
    f32x16 k0, k1;
    float cs[2][4];
#pragma unroll
    for (int hf = 0; hf < 2; ++hf)
#pragma unroll
        for (int g = 0; g < 4; ++g) {
            float s = 0.f;
#pragma unroll
            for (int i = 0; i < 4; ++i) {
                const int r = 4 * g + i, kr = i + 8 * g + 32 * hf;
                const float z2 = (hf ? p1[r] : p0[r]) * c1;
                const float e = __builtin_amdgcn_exp2f(-fabsf(z2));
                const float ls2 = fminf(z2, 0.f) - __builtin_amdgcn_logf(1.0f + e);
                const bool ok = kr < lim;
                const float lk2 = ok ? (ls2 - z2) : 0.f;
                if (hf) { p1[r] = ok ? ls2 : MNEG; k1[r] = lk2; } else { p0[r] = ok ? ls2 : MNEG; k0[r] = lk2; }
                s += lk2;
            }
            cs[hf][g] = s;
        }
    float run = carry;
#pragma unroll
    for (int hf = 1; hf >= 0; --hf)
#pragma unroll
        for (int g = 3; g >= 0; --g) {
            const float mine = cs[hf][g], other = lane_partner(mine, hi);
            float suf = hi ? run : run + other;
            run += mine + other;
#pragma unroll
            for (int i = 3; i >= 0; --i) {
                const int r = 4 * g + i;
                if (hf) { p1[r] = __builtin_amdgcn_exp2f(p1[r] + suf); suf += k1[r]; } else { p0[r] = __builtin_amdgcn_exp2f(p0[r] + suf); suf += k0[r]; }
            }
        }
    carry = run;
}

DEV void fp_attn0(const Params& P, Frame& F) {
    using namespace att;
    const int tid = F.tid, lane = F.lane, r32 = lane & 31, hi = lane >> 5, w = F.wave;
    for (int u = F.vcu; u < 512; u += F.G) {
        {
            const int b = u >> 6, h = (u >> 3) & 7, blk = u & 7;
            const bf16* base = P.proj + (size_t)b * S * LDP;
            const int q = blk * 256 + w * 32 + r32;
            bf16x8 qr[4]; load_q(qr, base + (size_t)q * LDP + 768 + h * 64, hi);
            const bf16* Kg = base + 1280 + h * 64; const bf16* Vg = base + 1792 + h * 64;
            f32x16 o[2]; o[0] = f32x16{}; o[1] = f32x16{};
            float carry = 0.f;
            const int tmax = blk * 4 + 3;
            const int tw = (blk * 256 + w * 32 + 31) >> 6;
            volatile LAS int* flag = (volatile LAS int*)(F.lds + LDSCTL_OFF + 12288);
            if (tid < 3) flag[tid] = 0;
            TileRegs R; tile_load(R, Kg, Vg, LDP, tmax * 64, tid);
            int slot = 0; bool wave_done = false;
            for (int t = tmax; t >= 0; --t) {
                tile_store(F.lds, slot, R, tid);
                if (t > 0) tile_load(R, Kg, Vg, LDP, (t - 1) * 64, tid);
                __syncthreads();
                if (t < tmax && flag[(t + 1) % 3] == 0) break;
                if (tid == 0) flag[(t + 2) % 3] = 0;
                if (!wave_done && t <= tw) {
                    f32x16 p0, p1;
                    qk_tile(p0, p1, (lptr)(F.lds + KS0 + slot * SLOT), qr, r32, hi);
                    sb_tile(p0, p1, carry, q - t * 64 - 4 * hi, hi);
                    pv_tile(o, (lptr)(F.lds + VS0 + slot * SLOT), p0, p1, lane);
                    if (__all(carry < -150.f)) wave_done = true;
                }
                if (!wave_done && lane == 0) flag[t % 3] = 1;
                slot ^= 1;
            }
            __syncthreads();
            store_ot(o, 1.0f, P.o + (size_t)(b * S + q) * D + 512 + h * 64, hi);
        }
    }
    asm volatile("" ::: "memory");
    for (int u = 512 + F.vcu; u < 1024; u += F.G) {
        {
            const int v = u - 512, b = v >> 6, hkv = (v >> 5) & 1, c = v & 31;
            const bf16* base = P.proj + (size_t)b * S * LDP;
            const int hh = hkv * 4 + (w >> 1), q = c * 64 + (w & 1) * 32 + r32;
            bf16x8 qr[4]; load_q(qr, base + (size_t)q * LDP + hh * 64, hi);
            const float sl = exp2f(-(float)(hh + 1)), s2 = sl * LOG2E;
            SoftState st; soft_reset(st);
            const int t0 = c - 2 < 0 ? 0 : c - 2;
            run_segment<true>(F, st, qr, base + 512 + hkv * 64, base + 640 + hkv * 64, LDP, tile_range(t0, c), s2, q,
                        [&](int t, int& klo, int& klim) { klim = q - t * 64 - 4 * hi; klo = klim - 128; });
            const float den = lane_swap_sum(st.l) + __builtin_amdgcn_exp2f(P.ev_sink[hh] * LOG2E - M0);
            store_ot(st.o, 1.0f / den, P.o + (size_t)(b * S + q) * D + hh * 64, hi);
        }
    }
}

DEV void fp_attn1(const Params& P, Frame& F) {
    using namespace att;
    const int lane = F.lane, r32 = lane & 31, hi = lane >> 5, w = F.wave;
    for (int u = F.vcu; u < 512; u += F.G) {
        {
            const int v = u & 255, bh = v >> 2, blk = (u < 256) ? (v & 3) : 7 - (v & 3);
            const int b = bh >> 3, h = bh & 7;
            const bf16* base = P.proj + (size_t)b * S * LDP;
            const int q = blk * 256 + w * 32 + r32;
            bf16x8 qr[4]; load_q(qr, base + (size_t)q * LDP + h * 64, hi);
            const float sl = exp2f(-(float)(h + 1)), s2 = sl * LOG2E;
            float gt[8];
#pragma unroll
            for (int n = 0; n < 8; ++n) {
                float g = 0.f;
                if (n < blk) {
                    const float* km = P.kmean + ((size_t)(b * 8 + h) * 8 + n) * 64;
#pragma unroll
                    for (int d0 = 0; d0 < 4; ++d0)
#pragma unroll
                        for (int j = 0; j < 8; ++j) g += bf2f((bf16)qr[d0][j]) * km[16 * d0 + 8 * hi + j];
                }
                g = lane_swap_sum(g);
                gt[n] = n < blk ? g : NEG;
            }
            unsigned sel = 0;
#pragma unroll
            for (int n = 0; n < 8; ++n) {
                int rank = 0;
#pragma unroll
                for (int k = 0; k < 8; ++k) rank += (gt[k] > gt[n] || (gt[k] == gt[n] && k < n)) ? 1 : 0;
                if (rank < 3 && n < blk) sel |= 1u << n;
            }
            SoftState st; soft_reset(st);
            run_segment<true>(F, st, qr, base + 512 + h * 64, base + 1024 + h * 64, LDP, tile_range(0, blk * 4 + 3), s2, q,
                        [&](int t, int& klo, int& klim) { const int n = t >> 2; klo = -1;
                            if (n < blk) klim = ((sel >> n) & 1) ? 63 : -1; else klim = q - t * 64 - 4 * hi; });
            const float l = lane_swap_sum(st.l);
            store_ot(st.o, 1.0f / l, P.o + (size_t)(b * S + q) * D + h * 64, hi);
        }
    }
    asm volatile("" ::: "memory");
    for (int u = 512 + F.vcu; u < 1024; u += F.G) {
        {
            const int v = u & 255, bk = v >> 4, c = (u < 768) ? (v & 15) : 31 - (v & 15);
            const int b = bk >> 1, hkv = bk & 1;
            const bf16* base = P.proj + (size_t)b * S * LDP;
            const int h = hkv * 4 + (w >> 1), q = c * 64 + (w & 1) * 32 + r32, t = b * S + q;
            bf16x8 qr[4]; load_q(qr, base + (size_t)q * LDP + 1536 + h * 64, hi);
            const float sl = exp2f(-(float)(h + 1)), s2 = sl * LOG2E;
            const bf16* grow = base + (size_t)q * LDP + 2816 + h * 3;
            LAS float* part = (LAS float*)(F.lds + SCR0);
            volatile LAS unsigned long long* tot = (volatile LAS unsigned long long*)(F.lds + SCR0 + 33792);
            volatile LAS unsigned* selm = (volatile LAS unsigned*)(F.lds + SCR0 + 33792 + 16896);
            f32x16 fin[2];
            {
                const int ntile = c >= 16 ? 2 : 1;
                const bf16* Kc = P.kvcmp + ((size_t)(0 * NB + b) * NCMP) * 128 + hkv * 64;
                const bf16* Vc = P.kvcmp + ((size_t)(1 * NB + b) * NCMP) * 128 + hkv * 64;
                { TileRegs R0; tile_load(R0, Kc, Vc, 128, 0, F.tid); tile_store(F.lds, 0, R0, F.tid); }
                if (ntile == 2) { TileRegs R1; tile_load(R1, Kc, Vc, 128, 64, F.tid); tile_store(F.lds, 1, R1, F.tid); }
                __syncthreads();
                const int nlim = (q - 31) >> 4;
                const float c1 = 0.125f * LOG2E, s16 = 16.0f * s2;
                const float basec = s2 * (float)(31 - q) + s16 * (float)(4 * hi);
                float lsum = 0.f;
                for (int tl = 0; tl < ntile; ++tl) {
                    f32x16 x0, x1; qk_tile(x0, x1, (lptr)(F.lds + KS0 + tl * SLOT), qr, r32, hi);
                    const int klim = nlim - 64 * tl - 4 * hi; const float bt = basec + s16 * (float)(64 * tl) - M0;
#pragma unroll
                    for (int r = 0; r < 16; ++r) {
                        const int kr = (r & 3) + 8 * (r >> 2);
                        lsum += kr <= klim ? __builtin_amdgcn_exp2f(fmaf(x0[r], c1, fmaf(s16, (float)kr, bt))) : 0.f;
                        lsum += kr + 32 <= klim ? __builtin_amdgcn_exp2f(fmaf(x1[r], c1, fmaf(s16, (float)(kr + 32), bt))) : 0.f;
                    }
                }
                lsum = lane_swap_sum(lsum);
                const float inv = nlim >= 0 ? 1.0f / lsum : 0.f;
                fin[0] = f32x16{}; fin[1] = f32x16{};
                LAS float* prow = part + ((w >> 1) * 64 + (w & 1) * 32 + r32) * 33;
                float peprev = 0.f;
                for (int tl = 0; tl < ntile; ++tl) {
                    f32x16 x0, x1; qk_tile(x0, x1, (lptr)(F.lds + KS0 + tl * SLOT), qr, r32, hi);
                    const int klim = nlim - 64 * tl - 4 * hi; const float bt = basec + s16 * (float)(64 * tl) - M0;
#pragma unroll
                    for (int r = 0; r < 16; ++r) {
                        const int kr = (r & 3) + 8 * (r >> 2);
                        x0[r] = kr <= klim ? __builtin_amdgcn_exp2f(fmaf(x0[r], c1, fmaf(s16, (float)kr, bt))) * inv : 0.f;
                        x1[r] = kr + 32 <= klim ? __builtin_amdgcn_exp2f(fmaf(x1[r], c1, fmaf(s16, (float)(kr + 32), bt))) * inv : 0.f;
                    }
#pragma unroll
                    for (int ix = 0; ix < 8; ++ix) {
                        const int g = ix & 3;
                        const float C = (ix < 4) ? (x0[4 * g] + x0[4 * g + 1]) + (x0[4 * g + 2] + x0[4 * g + 3]) : (x1[4 * g] + x1[4 * g + 1]) + (x1[4 * g + 2] + x1[4 * g + 3]);
                        const float pe = lane_partner((ix < 4) ? x0[4 * g + 3] : x1[4 * g + 3], hi);
                        prow[2 * (8 * tl + ix) + hi] = C + (hi ? pe : peprev);
                        peprev = pe;
                    }
                    pv_tile(fin, (lptr)(F.lds + VS0 + tl * SLOT), x0, x1, lane);
                }
                { const float g0 = 1.0f / (1.0f + __expf(-bf2f(grow[0])));
#pragma unroll
                for (int r = 0; r < 16; ++r) { fin[0][r] *= g0; fin[1][r] *= g0; } }
            }
            __syncthreads();
            {
                const int ql = F.tid >> 3, jg = F.tid & 7;
#pragma unroll
                for (int jj = 0; jj < 4; ++jj) {
                    const int j = 4 * jg + jj;
                    float sc = ((part[(0 * 64 + ql) * 33 + j] + part[(1 * 64 + ql) * 33 + j]) + part[(2 * 64 + ql) * 33 + j]) + part[(3 * 64 + ql) * 33 + j];
                    const bool forced = (j == 0) || (j == c) || (j == c - 1);
                    sc = (j <= c) ? sc + (forced ? 1000.0f : 0.0f) : NEG;
                    const unsigned ub = f2u(sc), ord = ub ^ ((ub >> 31) ? 0xffffffffu : 0x80000000u);
                    tot[ql * 33 + j] = ((unsigned long long)ord << 32) | (unsigned)(31 - j);
                }
                __syncthreads();
                unsigned long long mine[4];
#pragma unroll
                for (int jj = 0; jj < 4; ++jj) mine[jj] = tot[ql * 33 + 4 * jg + jj];
                int rank[4] = {0, 0, 0, 0};
                for (int k = 0; k < 32; ++k) {
                    const unsigned long long sk = tot[ql * 33 + k];
#pragma unroll
                    for (int jj = 0; jj < 4; ++jj) rank[jj] += (sk > mine[jj]) ? 1 : 0;
                }
                unsigned bits = 0;
#pragma unroll
                for (int jj = 0; jj < 4; ++jj) if (rank[jj] < 16 && 4 * jg + jj <= c) bits |= 1u << (4 * jg + jj);
                bits |= __shfl_xor(bits, 1); bits |= __shfl_xor(bits, 2); bits |= __shfl_xor(bits, 4);
                if (jg == 0) selm[ql] = bits;
                unsigned ub = bits; ub |= __shfl_xor(ub, 8); ub |= __shfl_xor(ub, 16); ub |= __shfl_xor(ub, 32);
                if (lane == 0) selm[64 + w] = ub;
            }
            __syncthreads();
            const unsigned mask = selm[(w & 1) * 32 + r32];
            const unsigned umask = ((selm[64] | selm[65]) | (selm[66] | selm[67])) | ((selm[68] | selm[69]) | (selm[70] | selm[71]));
            __syncthreads();
            LAS float* stg = (LAS float*)(F.lds + SCR0) + w * 2048 + lane;
#pragma unroll
            for (int r = 0; r < 16; ++r) { stg[r * 64] = fin[0][r]; stg[(16 + r) * 64] = fin[1][r]; }
            SoftState st; soft_reset(st);
            run_segment<false>(F, st, qr, base + 2304 + hkv * 64, base + 2432 + hkv * 64, LDP, (unsigned long long)umask, s2, q,
                        [&](int tt, int& klo, int& klim) { klo = -1; klim = ((mask >> tt) & 1) ? (q - tt * 64 - 4 * hi) : -1; });
            { const float g1 = 1.0f / (1.0f + __expf(-bf2f(grow[1]))); const float f = g1 / lane_swap_sum(st.l);
#pragma unroll
              for (int r = 0; r < 16; ++r) { stg[r * 64] += f * st.o[0][r]; stg[(16 + r) * 64] += f * st.o[1][r]; } }
            soft_reset(st);
            run_segment<true>(F, st, qr, base + 2560 + hkv * 64, base + 2688 + hkv * 64, LDP, tile_range(c - 8 < 0 ? 0 : c - 8, c), s2, q,
                        [&](int tt, int& klo, int& klim) { klim = q - tt * 64 - 4 * hi; klo = klim - 512; });
            { const float g2 = 1.0f / (1.0f + __expf(-bf2f(grow[2]))); const float f = g2 / lane_swap_sum(st.l);
#pragma unroll
              for (int r = 0; r < 16; ++r) { st.o[0][r] = stg[r * 64] + f * st.o[0][r]; st.o[1][r] = stg[(16 + r) * 64] + f * st.o[1][r]; } }
            store_ot(st.o, 1.0f, P.o + (size_t)t * D + 512 + h * 64, hi);
            __syncthreads();
        }
    }
}
enum { PH_PRE = 0, PH_INPROJ0, PH_ATTN0, PH_OUTPROJ0, PH_ROUTE0, PH_FFN0, PH_COMBINE0, PH_INPROJ1, PH_PREP1, PH_ATTN1, PH_OUTPROJ1, PH_ROUTE1, PH_FFN1, PH_COMBINE1, PH_COUNT };
struct FArgs { Params p; };

#ifndef PROBE_PHASE
#define PROBE_PHASE -1
#endif
constexpr int STAMP_OFF = LDSCTL_OFF + 1024;
constexpr int HN_OFF = LDSCTL_OFF + 2048;
DEV void stampk(Frame& F, int k) {
    if (PROBE_PHASE >= 0 && F.tid == 0) ((volatile LAS unsigned*)(F.lds + STAMP_OFF))[k] = (unsigned)__builtin_amdgcn_s_memrealtime() | 1u;
}
__global__ void __launch_bounds__(NWAVES * 64, 2) k_fast(FArgs args) {
    extern __shared__ __attribute__((aligned(16))) unsigned char lds[];
    const Params& P = args.p;
    Frame F;
    F.lds = (LAS unsigned char*)lds;
    F.MISC = (volatile LAS unsigned*)(F.lds + MISC_OFF);
    F.tid = threadIdx.x; F.lane = F.tid & 63; F.wave = __builtin_amdgcn_readfirstlane(F.tid >> 6);
    F.G = gridDim.x; { const int bx = blockIdx.x; F.vcu = (F.G % 8 == 0) ? (bx % 8) * (F.G / 8) + bx / 8 : bx; }
    for (int u = F.tid; u < (LDS_BYTES - LDSCTL_OFF) / 4; u += NWAVES * 64) ((LAS unsigned*)(F.lds + LDSCTL_OFF))[u] = 0u;
    __syncthreads();
    XcdBarrier bar = xcd_barrier_post(P.ctl + CW_BAR, F.MISC + 8);
#define BEGIN(k) refresh(F); stampk(F, (k));
#define SEAM() do { refresh(F); xcd_barrier(bar, F.tid); } while (0)
    { BEGIN(PH_PRE) fp_convert_weights(P, F, 0, F.vcu, F.G); fp_prep_router(P, F); fp_norm_rows(F, P.x, P.ev_norm, P.xn); if (F.G != 256) { fp_convert_weights(P, F, 1, F.vcu, F.G); fp_prep_compress(P, F, F.vcu, F.G); } SEAM(); }
    { BEGIN(PH_INPROJ0) const int cq = F.vcu >> 2, cr = F.vcu & 3, gi = 3 * cq + cr;
      if (F.G == 256 && cr == 3) fp_convert_moe_part(P, F, 0, cq, 64);
      else { pg8::StaticOrder So; So.init(P.xn, P.win0t, T, EVEN_IN, D, F.G == 256 ? 192 : F.G, F.G == 256 ? gi : F.vcu);
        pg8::EpiProjNorm<0> E{P.proj, LDP, P.ev_q_norm, P.ev_k_norm, nullptr, nullptr, nullptr, (PG8_LAS float*)(F.lds + HN_OFF)};
        pg8::gemm_phase(F.lds, D, So, E, F.tid); if (F.G != 256) { refresh(F); fp_convert_moe_part(P, F, 0, F.vcu, F.G); } }
      SEAM(); }
    { BEGIN(PH_ATTN0) fp_attn0(P, F); SEAM(); }
    { BEGIN(PH_OUTPROJ0) pg8::StaticOrder So; So.init(P.o, P.wout0t, T, D, D, F.G, (int)blockIdx.x);
      pg8::EpiResidF32 E{P.x, P.out, D}; pg8::gemm_phase(F.lds, D, So, E, F.tid); SEAM(); }
    { BEGIN(PH_ROUTE0) fp_route(P, F, 0); SEAM(); }
    { BEGIN(PH_FFN0) const int cq = F.vcu >> 2, cr = F.vcu & 3, gi = 3 * cq + cr;
      if (F.G == 256 && cr == 3) { fp_convert_weights(P, F, 1, cq, 64); fp_prep_compress(P, F, cq, 64); fp_convert_moe_part(P, F, 1, cq, 64); }
      else if (F.G == 256) fp_moe_fused(P, F, 0, gi, 192);
      else { fp_moe_fused(P, F, 0, F.vcu, F.G); refresh(F); fp_convert_moe_part(P, F, 1, F.vcu, F.G); }
      SEAM(); }
    { BEGIN(PH_COMBINE0) fp_combine(P, F, 0, P.od_norm, P.xn); SEAM(); }
    { BEGIN(PH_INPROJ1) pg8::StaticOrder So; So.init(P.xn, P.win1t, T, LDP, D, F.G, (int)blockIdx.x);
      pg8::EpiProjNorm<1> E{P.proj, LDP, P.od_c_q_norm, P.od_c_k_norm, P.od_d_q_norm, P.od_d_k_norm + 64, P.od_d_k_norm + 128, (PG8_LAS float*)(F.lds + HN_OFF)};
      pg8::gemm_phase(F.lds, D, So, E, F.tid); SEAM(); }
    { BEGIN(PH_PREP1) fp_prep1(P, F); SEAM(); }
    { BEGIN(PH_ATTN1) fp_attn1(P, F); SEAM(); }
    { BEGIN(PH_OUTPROJ1) pg8::StaticOrder So; So.init(P.o, P.wout1t, T, D, D, F.G, (int)blockIdx.x);
      pg8::EpiResidF32 E{P.out, P.out, D}; pg8::gemm_phase(F.lds, D, So, E, F.tid); SEAM(); }
    { BEGIN(PH_ROUTE1) fp_route(P, F, 1); SEAM(); }
    { BEGIN(PH_FFN1) fp_moe_fused(P, F, 1, F.vcu, F.G); SEAM(); }
    { BEGIN(PH_COMBINE1) fp_combine(P, F, 1, nullptr, nullptr); }
    if (PROBE_PHASE >= 0) {
        refresh(F);
        if (F.vcu == 0 && F.tid == 0) {
            volatile LAS unsigned* st = (volatile LAS unsigned*)(F.lds + STAMP_OFF);
            const unsigned t1 = (PROBE_PHASE + 1 < PH_COUNT) ? st[(PROBE_PHASE + 1 < PH_COUNT) ? PROBE_PHASE + 1 : 0] : ((unsigned)__builtin_amdgcn_s_memrealtime() | 1u);
            const unsigned t0 = st[PROBE_PHASE < 0 ? 0 : PROBE_PHASE];
            asm volatile("s_waitcnt vmcnt(0)" ::: "memory");
#ifndef PROBE_SCALE
#define PROBE_SCALE 0.01f
#endif
            P.out[0] += (float)(t1 - t0) * PROBE_SCALE;
        }
    }
#undef BEGIN
#undef SEAM
}

static size_t carve(Params& p, void* d_ws) {
    char* w = (char*)d_ws;
    p.ctl = (unsigned*)w;
    p.win0t = (bf16*)(w + 1 * MiB);
    p.wout0t = (bf16*)(w + 6 * MiB);
    p.win1t = (bf16*)(w + 8 * MiB);
    p.wout1t = (bf16*)(w + 14 * MiB);
    p.wgut[0] = (bf16*)(w + 16 * MiB);
    p.wdt[0] = (bf16*)(w + 48 * MiB);
    p.proj = (bf16*)(w + 64 * MiB);
    p.ha = (bf16*)(w + 64 * MiB);
    p.xn = (bf16*)(w + 160 * MiB);
    p.o = (bf16*)(w + 192 * MiB);
    p.hid = (bf16*)(w + 192 * MiB);
    size_t off = 224 * MiB;
    auto take = [&](size_t bytes) { char* r = w + off; off = (off + bytes + 255) & ~(size_t)255; return r; };
    p.rstd = (float*)take((size_t)T * 4);
    p.eid = (int*)take((size_t)T * 2 * 4);
    p.ew = (float*)take((size_t)T * 2 * 4);
    p.kmean = (float*)take((size_t)NB * 8 * 8 * 64 * 4);
    p.kvcmp = (bf16*)take((size_t)2 * NB * 128 * 2 * 64 * 2);
    p.pos = (int*)take((size_t)T * 2 * 4);
    p.wr = (bf16*)take((size_t)2 * 2 * 48 * D * 2);
    p.wcmpt = (bf16*)take((size_t)2 * 64 * 2048 * 2);
    p.cbias = (float*)take((size_t)128 * 4);
    p.wgut[1] = (bf16*)(w + 228 * MiB);
    p.wdt[1] = (bf16*)(w + 260 * MiB);
    p.rowtok = (int*)(w + 276 * MiB);
    return off > 228 * MiB ? (size_t)1 << 40 : 278 * MiB;
}

extern "C" void kernel_launch(void* const* d_in, const int* in_sizes, int n_in, void* d_out, int out_size, void* d_ws, size_t ws_size,
                              hipStream_t stream) {
    Params p{};
    const float** f = (const float**)&p;
    for (int i = 0; i < 24; ++i) f[i] = (const float*)d_in[i];
    p.out = (float*)d_out;
    const size_t need = carve(p, d_ws);
    static int grid = 0;
    if (grid == 0) {
        int dev = 0, cus = 0, per_cu = 0;
        if (hipGetDevice(&dev) != hipSuccess || hipDeviceGetAttribute(&cus, hipDeviceAttributeMultiprocessorCount, dev) != hipSuccess) { grid = -1; return; }
        if (hipFuncSetAttribute((const void*)k_fast, hipFuncAttributeMaxDynamicSharedMemorySize, LDS_BYTES) != hipSuccess) { fprintf(stderr, "hipFuncSetAttribute failed\n"); grid = -1; return; }
        if (hipOccupancyMaxActiveBlocksPerMultiprocessor(&per_cu, (const void*)k_fast, NWAVES * 64, LDS_BYTES) != hipSuccess || per_cu < 1) { fprintf(stderr, "occupancy query: %d\n", per_cu); (void)hipGetLastError(); grid = -1; return; }
        grid = cus;
        if (need > ws_size) { fprintf(stderr, "workspace too small: need %zu have %zu\n", need, ws_size); grid = -1; return; }
    }
    if (grid < 0) return;
    (void)hipMemsetAsync(d_ws, 0, CTL_ZERO_BYTES, stream);
    FArgs a{}; a.p = p;
    hipLaunchKernelGGL(k_fast, dim3(grid), dim3(NWAVES * 64), LDS_BYTES, stream, a);
}
```

```cpp
#include <hip/hip_runtime.h>
#include <cstdio>
#include <cstdint>
#define DEV __device__ __forceinline__

#ifndef NB
#define NB 8
#endif
typedef unsigned short bf16;
constexpr int S = 2048, D = 1024, T = NB * S, HD = 64;
constexpr int EVEN_IN = 2304, ODD_IN = 2840, LDP = 3072;
constexpr int NCMP = 127, NSLC = 32;
constexpr float NEG = -1e30f;
constexpr float EPS = 1e-6f;
constexpr int RMAX = 2 * T + 32 * 256;

DEV float u2f(unsigned u) { return __builtin_bit_cast(float, u); }
DEV unsigned f2u(float f) { return __builtin_bit_cast(unsigned, f); }
DEV float bf2f(bf16 h) { return u2f(((unsigned)h) << 16); }
DEV bf16 f2bf(float f) { unsigned u = f2u(f); u += 0x7fffu + ((u >> 16) & 1u); return (bf16)(u >> 16); }

struct Params {
    const float *x, *ev_norm, *ev_w_in, *ev_q_norm, *ev_k_norm, *ev_sink, *ev_w_out;
    const float *od_norm, *od_w_in, *od_c_q_norm, *od_c_k_norm, *od_d_q_norm, *od_d_k_norm, *od_cmp_pos, *od_cmp_w, *od_w_out;
    const float *moe_norm, *moe_w_grp, *moe_b_grp, *moe_w_exp, *moe_b_exp, *moe_w_gate, *moe_w_up, *moe_w_down;
    float* out;
    unsigned* ctl;
    bf16 *win0t, *wout0t, *win1t, *wout1t;
    bf16 *wgut[2], *wdt[2];
    bf16* proj;
    bf16* xn;
    bf16* o;
    bf16* ha;
    bf16* hid;
    float* rstd;
    int* eid;
    float* ew;
    float* kmean;
    bf16* kvcmp;
    int* pos;
    int* rowtok;
    bf16* wr;
    bf16* wcmpt;
    float* cbias;
};


namespace pg8 {
#define PG8_LAS __attribute__((address_space(3)))
typedef unsigned short bf16_t;
typedef short bf16x8 __attribute__((ext_vector_type(8)));
typedef float f32x4 __attribute__((ext_vector_type(4)));
typedef unsigned u32x4 __attribute__((ext_vector_type(4)));
constexpr int BM = 256, BK = 64, HALF = 128, HTB = HALF * BK * 2, STAGE_BYTES = 8 * HTB, NXCD = 8, WGM = 8;

__host__ __device__ __forceinline__ int lds_byte(int r, int c) { const int st = (r >> 4) * 2 + (c >> 5), rr = r & 15, cc = c & 31, ob = rr * 64 + cc * 2; return st * 1024 + (ob ^ (((ob >> 9) & 1) << 5)); }
__host__ __device__ __forceinline__ void stage_rc(int b, int& R, int& C) { const int st = b / 1024, sb = b % 1024, swz = sb ^ (((sb >> 9) & 1) << 5); R = (st >> 1) * 16 + swz / 64; C = (st & 1) * 32 + (swz % 64) / 2; }
__host__ __device__ __forceinline__ int perm32(int rho) { const int n = rho >> 4, i = rho & 15; return 8 * (i >> 2) + 4 * n + (i & 3); }

struct Unit { const char* A; const char* B; int pm, pn; };

struct StaticOrder {
    int nM, nN, nwg, G, c; const char* A; const char* Bt; size_t tstep;
    __device__ void init(const bf16_t* A_, const bf16_t* Bt_, int M, int N, int K, int G_, int c_) { nM = M / BM; nN = N / BM; nwg = nM * nN; G = G_; c = c_; A = (const char*)A_; Bt = (const char*)Bt_; tstep = (size_t)BM * K * 2; }
    __device__ bool next(int i, Unit& u) const {
        const long L = (long)i * G + c; if (L >= nwg) return false;
        int wgid = (int)L; { const int q = nwg / NXCD, r = nwg % NXCD, xcd = wgid % NXCD, off = wgid / NXCD; wgid = (xcd < r ? xcd * (q + 1) : r * (q + 1) + (xcd - r) * q) + off; }
        const int nig = WGM * nN, gid = wgid / nig, fm = gid * WGM, gsz = (nM - fm) < WGM ? (nM - fm) : WGM;
        u.pm = fm + ((wgid % nig) % gsz); u.pn = (wgid % nig) / gsz; u.A = A + (size_t)u.pm * tstep; u.B = Bt + (size_t)u.pn * tstep; return true;
    }
};

__device__ __forceinline__ unsigned cvt_pk_bf16(float lo, float hi) { unsigned r; asm volatile("v_cvt_pk_bf16_f32 %0, %1, %2" : "=v"(r) : "v"(lo), "v"(hi)); return r; }

struct EpiStoreBf16 {
    static constexpr bool PERM = true;
    bf16_t* O; int ldc;
    __device__ __forceinline__ void operator()(const f32x4 (&acc)[2][2][4][2], const Unit& u, int wr, int wc, int fr, int fq) const {
        const int row0 = u.pm * BM + wr * 64 + fr, col0 = u.pn * BM + wc * 32 + 8 * fq;
#pragma unroll
        for (int ai = 0; ai < 2; ++ai)
#pragma unroll
            for (int m = 0; m < 4; ++m) { bf16_t* rowp = O + (size_t)(row0 + ai * HALF + m * 16) * ldc + col0;
#pragma unroll
                for (int bj = 0; bj < 2; ++bj) { const f32x4 v0 = acc[ai][bj][m][0], v1 = acc[ai][bj][m][1];
                    u32x4 w; w.x = cvt_pk_bf16(v0[0], v0[1]); w.y = cvt_pk_bf16(v0[2], v0[3]); w.z = cvt_pk_bf16(v1[0], v1[1]); w.w = cvt_pk_bf16(v1[2], v1[3]);
                    *(u32x4*)(rowp + bj * HALF) = w; } }
    }
};

template <int LAYER> struct EpiProjNorm {
    static constexpr bool PERM = true;
    bf16_t* O; int ldc; const float *g0, *g1, *g2, *g3, *g4; PG8_LAS float* hn;
    __device__ __forceinline__ const float* gain_of(int H) const {
        if (LAYER == 0) return H < 8 ? g0 : (H < 10 ? g1 : nullptr);
        return H < 8 ? g0 : H < 16 ? g1 : (H >= 24 && H < 32) ? g2 : (H == 36 || H == 37) ? g3 : (H == 40 || H == 41) ? g4 : nullptr;
    }
    __device__ __forceinline__ void operator()(f32x4 (&acc)[2][2][4][2], const Unit& u, int wr, int wc, int fr, int fq) const {
        const bool any = (LAYER == 0) ? (u.pn < 3) : (u.pn < 4 || u.pn == 6 || u.pn == 7 || u.pn == 9 || u.pn == 10);
        if (any) {
#pragma unroll
            for (int ai = 0; ai < 2; ++ai)
#pragma unroll
                for (int m = 0; m < 4; ++m)
#pragma unroll
                    for (int bj = 0; bj < 2; ++bj) {
                        const f32x4 a = acc[ai][bj][m][0], b = acc[ai][bj][m][1];
                        float ss = (a[0] * a[0] + a[1] * a[1]) + (a[2] * a[2] + a[3] * a[3]) + (b[0] * b[0] + b[1] * b[1]) + (b[2] * b[2] + b[3] * b[3]);
                        ss += __shfl_xor(ss, 16); ss += __shfl_xor(ss, 32);
                        if (fq == 0) hn[(ai * HALF + wr * 64 + m * 16 + fr) * 8 + bj * 4 + wc] = ss;
                    }
        }
        asm volatile("s_waitcnt lgkmcnt(0)" ::: "memory"); __builtin_amdgcn_s_barrier(); asm volatile("" ::: "memory");
        const int row0 = u.pm * BM + wr * 64 + fr, col0 = u.pn * BM + wc * 32 + 8 * fq;
#pragma unroll
        for (int bj = 0; bj < 2; ++bj) {
            const float* g = gain_of(4 * u.pn + 2 * bj + (wc >> 1));
            f32x4 ga = (f32x4){1.f, 1.f, 1.f, 1.f}, gb = ga;
            if (g) { ga = *(const f32x4*)(g + (wc & 1) * 32 + 8 * fq); gb = *(const f32x4*)(g + (wc & 1) * 32 + 8 * fq + 4); }
#pragma unroll
            for (int ai = 0; ai < 2; ++ai)
#pragma unroll
                for (int m = 0; m < 4; ++m) {
                    f32x4 v0 = acc[ai][bj][m][0], v1 = acc[ai][bj][m][1];
                    if (g) { const int rl = (ai * HALF + wr * 64 + m * 16 + fr) * 8 + bj * 4;
                        const float r = 1.0f / sqrtf((hn[rl + wc] + hn[rl + (wc ^ 1)]) * (1.0f / 64) + 1e-6f);
                        v0 = v0 * ga * r; v1 = v1 * gb * r; }
                    u32x4 w; w.x = cvt_pk_bf16(v0[0], v0[1]); w.y = cvt_pk_bf16(v0[2], v0[3]); w.z = cvt_pk_bf16(v1[0], v1[1]); w.w = cvt_pk_bf16(v1[2], v1[3]);
                    *(u32x4*)(O + (size_t)(row0 + ai * HALF + m * 16) * ldc + col0 + bj * HALF) = w;
                }
        }
    }
};
struct EpiResidF32 {
    static constexpr bool PERM = true;
    const float* R; float* O; int ldc;
    __device__ __forceinline__ void operator()(const f32x4 (&acc)[2][2][4][2], const Unit& u, int wr, int wc, int fr, int fq) const {
        const int row0 = u.pm * BM + wr * 64 + fr, col0 = u.pn * BM + wc * 32 + 8 * fq;
#pragma unroll
        for (int ai = 0; ai < 2; ++ai)
#pragma unroll
            for (int m = 0; m < 4; ++m) { const size_t ro = (size_t)(row0 + ai * HALF + m * 16) * ldc + col0;
#pragma unroll
                for (int bj = 0; bj < 2; ++bj) {
                    const f32x4 r0 = *(const f32x4*)(R + ro + bj * HALF), r1 = *(const f32x4*)(R + ro + bj * HALF + 4);
                    *(f32x4*)(O + ro + bj * HALF) = r0 + acc[ai][bj][m][0]; *(f32x4*)(O + ro + bj * HALF + 4) = r1 + acc[ai][bj][m][1]; } }
    }
};
struct EpiSiluMul {
    static constexpr bool PERM = true;
    bf16_t* H; int ldh;
    __device__ __forceinline__ void operator()(const f32x4 (&acc)[2][2][4][2], const Unit& u, int wr, int wc, int fr, int fq) const {
        const int row0 = u.pm * BM + wr * 64 + fr, col0 = u.pn * HALF + wc * 32 + 8 * fq;
#pragma unroll
        for (int ai = 0; ai < 2; ++ai)
#pragma unroll
            for (int m = 0; m < 4; ++m) { bf16_t* rowp = H + (size_t)(row0 + ai * HALF + m * 16) * ldh + col0;
                float h[8];
#pragma unroll
                for (int n = 0; n < 2; ++n)
#pragma unroll
                    for (int j = 0; j < 4; ++j) { const float g = acc[ai][0][m][n][j], up = acc[ai][1][m][n][j]; h[n * 4 + j] = g * up / (1.0f + __expf(-g)); }
                u32x4 w; w.x = cvt_pk_bf16(h[0], h[1]); w.y = cvt_pk_bf16(h[2], h[3]); w.z = cvt_pk_bf16(h[4], h[5]); w.w = cvt_pk_bf16(h[6], h[7]);
                *(u32x4*)rowp = w; }
    }
};

template <class Epi, class Sched, bool GATHER = false>
__device__ __forceinline__ void gemm_phase(PG8_LAS unsigned char* lds, const int K, const Sched& S, const Epi& E, const int tid, unsigned g00 = 0, unsigned g01 = 0, unsigned g10 = 0, unsigned g11 = 0) {
    const int wid = __builtin_amdgcn_readfirstlane(tid >> 6), lane = tid & 63, wr = wid >> 2, wc = wid & 3, fr = lane & 15, fq = lane >> 4;
    const int nt = K / BK;
    unsigned voffA[2], voffB[2], voffA1[2];
#pragma unroll
    for (int i = 0; i < 2; ++i) { int R, C; stage_rc(tid * 16 + i * 8192, R, C); const int Rb = Epi::PERM ? ((R & ~31) + perm32(R & 31)) : R;
        voffA[i] = (unsigned)(R * K + C) * 2u; voffB[i] = (unsigned)(Rb * K + C) * 2u; voffA1[i] = voffA[i];
        if (GATHER) { voffA[i] = (i ? g01 : g00) + (unsigned)C * 2u; voffA1[i] = (i ? g11 : g10) + (unsigned)C * 2u; } }
    const size_t kstep = (size_t)(BK * 2);
    const size_t hstep = (size_t)HALF * K * 2;
    const size_t hstepA = GATHER ? (size_t)0 : hstep;
    const unsigned ldsw = (unsigned)wid * 1024u;
    const int aoff = lds_byte(wr * 64 + fr, fq * 8), boff = lds_byte(wc * 32 + fr, fq * 8);
#define PG8_SA(b, h) (((b) * 2 + (h)) * HTB)
#define PG8_SB(b, h) ((4 + (b) * 2 + (h)) * HTB)
#define PG8_STAGE(bufoff, gbase, voff) do { _Pragma("unroll") for (int _i = 0; _i < 2; ++_i) \
        __builtin_amdgcn_global_load_lds((const unsigned*)((const char*)(gbase) + (voff)[_i]), (PG8_LAS unsigned*)(lds + (bufoff) + ldsw + _i * 8192), 16, 0, 0); } while (0)
#define PG8_LDA(dst, b, h) do { _Pragma("unroll") for (int m = 0; m < 4; ++m) _Pragma("unroll") for (int k = 0; k < 2; ++k) dst[m][k] = *(const PG8_LAS bf16x8*)(lds + PG8_SA(b, h) + aoff + m * 2048 + k * 1024); } while (0)
#define PG8_LDB(dst, b, h) do { _Pragma("unroll") for (int n = 0; n < 2; ++n) _Pragma("unroll") for (int k = 0; k < 2; ++k) dst[n][k] = *(const PG8_LAS bf16x8*)(lds + PG8_SB(b, h) + boff + n * 2048 + k * 1024); } while (0)
#define PG8_MMA(ai, bj, At, Bt) do { __builtin_amdgcn_s_setprio(1); _Pragma("unroll") for (int m = 0; m < 4; ++m) _Pragma("unroll") for (int n = 0; n < 2; ++n) _Pragma("unroll") for (int k = 0; k < 2; ++k) \
        acc[ai][bj][m][n] = __builtin_amdgcn_mfma_f32_16x16x32_bf16(Bt[n][k], At[m][k], acc[ai][bj][m][n], 0, 0, 0); __builtin_amdgcn_s_setprio(0); } while (0)
#define PG8_WAIT_V(n) asm volatile("s_waitcnt vmcnt(" #n ")" ::: "memory")
#define PG8_WAIT_L(n) asm volatile("s_waitcnt lgkmcnt(" #n ")" ::: "memory")
#define PG8_BAR __builtin_amdgcn_s_barrier()
#define PG8_SCHED __builtin_amdgcn_sched_barrier(0)
    Unit cur, nxt; int ui = 0;
    if (!S.next(0, cur)) return;
    f32x4 acc[2][2][4][2];
#pragma unroll
    for (int a = 0; a < 2; ++a)
#pragma unroll
        for (int b = 0; b < 2; ++b)
#pragma unroll
            for (int m = 0; m < 4; ++m)
#pragma unroll
                for (int n = 0; n < 2; ++n) acc[a][b][m][n] = (f32x4){0.f, 0.f, 0.f, 0.f};
    bf16x8 At[4][2], B0[2][2], B1[2][2];
    const char* cA = cur.A; const char* cB = cur.B;
    PG8_STAGE(PG8_SB(0, 0), cB, voffB); PG8_STAGE(PG8_SB(0, 1), cB + hstep, voffB); PG8_STAGE(PG8_SA(0, 0), cA, voffA); PG8_STAGE(PG8_SA(0, 1), cA + hstepA, voffA1);
    if (wr == 1) PG8_BAR;
    PG8_WAIT_V(2); PG8_BAR;
    PG8_STAGE(PG8_SB(1, 0), cB + kstep, voffB); PG8_STAGE(PG8_SA(1, 0), cA + kstep, voffA); PG8_STAGE(PG8_SB(1, 1), cB + hstep + kstep, voffB);
    PG8_WAIT_V(6); PG8_BAR;
    for (;;) {
        const bool has_next = S.next(ui + 1, nxt);
        const char* nA = has_next ? nxt.A : cA; const char* nB = has_next ? nxt.B : cB;
        for (int t = 0; t < nt; t += 2) {
            const bool last = (t == nt - 2);
            const char* a1 = cA + (size_t)(t + 1) * kstep;
            const char* a2 = last ? nA : cA + (size_t)(t + 2) * kstep; const char* b2 = last ? nB : cB + (size_t)(t + 2) * kstep;
            const char* a3 = a2 + kstep; const char* b3 = b2 + kstep;
            PG8_LDB(B0, 0, 0); PG8_LDB(B1, 0, 1); PG8_SCHED; PG8_LDA(At, 0, 0); PG8_STAGE(PG8_SA(1, 1), a1 + hstepA, voffA1);
            PG8_WAIT_V(8); PG8_WAIT_L(0); PG8_BAR; PG8_MMA(0, 0, At, B0); PG8_MMA(0, 1, At, B1); PG8_BAR; PG8_SCHED;
            PG8_LDA(At, 0, 1); PG8_STAGE(PG8_SB(0, 0), b2, voffB); PG8_STAGE(PG8_SB(0, 1), b2 + hstep, voffB); PG8_STAGE(PG8_SA(0, 0), a2, voffA);
            PG8_WAIT_V(8); PG8_WAIT_L(0); PG8_BAR; PG8_MMA(1, 0, At, B0); PG8_MMA(1, 1, At, B1); PG8_BAR; PG8_SCHED;
            PG8_LDB(B0, 1, 0); PG8_LDB(B1, 1, 1); PG8_SCHED; PG8_LDA(At, 1, 0); PG8_STAGE(PG8_SA(0, 1), a2 + hstepA, voffA1);
            PG8_WAIT_V(8); PG8_WAIT_L(0); PG8_BAR; PG8_MMA(0, 0, At, B0); PG8_MMA(0, 1, At, B1); PG8_BAR; PG8_SCHED;
            PG8_LDA(At, 1, 1); PG8_STAGE(PG8_SB(1, 0), b3, voffB); PG8_STAGE(PG8_SB(1, 1), b3 + hstep, voffB); PG8_STAGE(PG8_SA(1, 0), a3, voffA);
            PG8_WAIT_V(8); PG8_WAIT_L(0); PG8_BAR; PG8_MMA(1, 0, At, B0); PG8_MMA(1, 1, At, B1); PG8_BAR; PG8_SCHED;
        }
        if (wr == 0) PG8_BAR;
        { int l2; asm volatile("v_mbcnt_lo_u32_b32 %0, -1, 0\n\tv_mbcnt_hi_u32_b32 %0, -1, %0" : "=v"(l2)); E(acc, cur, wr, wc, l2 & 15, l2 >> 4); }
        if (!has_next) break;
#pragma unroll
        for (int a = 0; a < 2; ++a)
#pragma unroll
            for (int b = 0; b < 2; ++b)
#pragma unroll
                for (int m = 0; m < 4; ++m)
#pragma unroll
                    for (int n = 0; n < 2; ++n) acc[a][b][m][n] = (f32x4){0.f, 0.f, 0.f, 0.f};
        cur = nxt; cA = nA; cB = nB; ++ui;
        if (wr == 1) PG8_BAR;
    }
    PG8_WAIT_V(0);
    PG8_BAR;
#undef PG8_SA
#undef PG8_SB
#undef PG8_STAGE
#undef PG8_LDA
#undef PG8_LDB
#undef PG8_MMA
#undef PG8_WAIT_V
#undef PG8_WAIT_L
#undef PG8_BAR
#undef PG8_SCHED
}
}

#define GAS __attribute__((address_space(1)))
#define LAS __attribute__((address_space(3)))
typedef unsigned v4u __attribute__((ext_vector_type(4)));
typedef float f32x4 __attribute__((ext_vector_type(4)));
typedef short bf16x8 __attribute__((ext_vector_type(8)));
constexpr int NWAVES = 8;
constexpr int RING_BYTES = 131072, LDSCTL_OFF = RING_BYTES, MISC_OFF = LDSCTL_OFF + 320, LDS_BYTES = 147456;
constexpr size_t MiB = 1u << 20;
constexpr size_t CTL_ZERO_BYTES = 1 * MiB;
constexpr int CW_BAR = 4096;
constexpr int CW_MOE = 65536;
#define LDS_WAIT() asm volatile("s_waitcnt lgkmcnt(0)" ::: "memory")
#define VM_WAIT() asm volatile("s_waitcnt vmcnt(0)" ::: "memory")
DEV unsigned pk2(float lo, float hi) { return (unsigned)f2bf(lo) | ((unsigned)f2bf(hi) << 16); }

#define XB_TMO      128
#define XB_XCNT(j)  (256  + 64 * (j))
#define XB_XSUB(j)  (1280 + 64 * (j))
#define XB_XGEN(j)  (2304 + 64 * (j))
#define XB_TOP      3328
#define XB_TOPGEN   3392
#define XCD_BAR_WORDS 3456
#define XB_SPIN_CAP (1u << 22)
DEV unsigned xb_ld(unsigned* p)              { return __hip_atomic_load(p, __ATOMIC_RELAXED, __HIP_MEMORY_SCOPE_AGENT); }
DEV unsigned xb_add(unsigned* p, unsigned v) { return __hip_atomic_fetch_add(p, v, __ATOMIC_RELAXED, __HIP_MEMORY_SCOPE_AGENT); }
DEV unsigned xb_xcc_id() { return (unsigned)__builtin_amdgcn_s_getreg((3 << 11) | 20) & 0xFu; }
#define XB_SPIN(cond, bar) do { unsigned _sp = 0; while (cond) { __builtin_amdgcn_s_sleep(1); \
    if ((++_sp & 255u) == 0u) { if (xb_ld(&(bar)[XB_TMO])) break; if (_sp > XB_SPIN_CAP) { atomicAdd(&(bar)[XB_TMO], 1u); break; } } } } while (0)
struct XcdBarrier { unsigned* bar; unsigned x; volatile LAS unsigned* st; };
DEV XcdBarrier xcd_barrier_post(unsigned* bar, volatile LAS unsigned* st) {
    XcdBarrier b; b.bar = bar; b.x = xb_xcc_id(); b.st = st;
    if (threadIdx.x == 0) (void)xb_add(&bar[XB_XCNT(b.x)], 1u);
    return b;
}
DEV void xcd_barrier_complete(unsigned* bar, unsigned x, unsigned& nloc, unsigned& nx) {
    const unsigned G = gridDim.x * gridDim.y * gridDim.z;
    unsigned sum, cnt, mine, sp = 0u;
    for (;;) {
        sum = 0u; cnt = 0u; mine = 0u;
#pragma unroll
        for (unsigned j = 0; j < 16; ++j) { const unsigned c = xb_ld(&bar[XB_XCNT(j)]); sum += c; cnt += (c > 0u) ? 1u : 0u; mine = (j == x) ? c : mine; }
        if (sum == G) break;
        __builtin_amdgcn_s_sleep(1);
        if ((++sp & 255u) == 0u) { if (xb_ld(&bar[XB_TMO])) break; if (sp > XB_SPIN_CAP) { atomicAdd(&bar[XB_TMO], 1u); break; } }
    }
    nloc = mine > 0u ? mine : 1u; nx = cnt > 0u ? cnt : 1u;
}
DEV void xcd_barrier(const XcdBarrier& b, const int tid_) {
    asm volatile("s_waitcnt vmcnt(0)" ::: "memory");
    __syncthreads();
    if (tid_ == 0) {
        unsigned* bar = b.bar;
        __builtin_amdgcn_s_waitcnt(0);
        unsigned nloc = b.st[0], nx = b.st[1];
        if (nloc == 0u) { xcd_barrier_complete(bar, b.x, nloc, nx); b.st[0] = nloc; b.st[1] = nx; }
        const unsigned old = xb_add(&bar[XB_XSUB(b.x)], 1u);
        const unsigned gen = old / nloc;
        if (old + 1u == (gen + 1u) * nloc) {
            __builtin_amdgcn_fence(__ATOMIC_RELEASE, "agent");
            asm volatile("s_waitcnt vmcnt(0)" ::: "memory");
            const unsigned og = xb_add(&bar[XB_TOP], 1u);
            const unsigned tg = og / nx;
            if (og + 1u == (tg + 1u) * nx) xb_add(&bar[XB_TOPGEN], 1u);
            else XB_SPIN(xb_ld(&bar[XB_TOPGEN]) == tg, bar);
            __builtin_amdgcn_fence(__ATOMIC_ACQUIRE, "agent");
            xb_add(&bar[XB_XGEN(b.x)], 1u);
            asm volatile("s_waitcnt vmcnt(0)" ::: "memory");
        } else {
            XB_SPIN(xb_ld(&bar[XB_XGEN(b.x)]) == gen, bar);
            __builtin_amdgcn_fence(__ATOMIC_ACQUIRE, "agent");
            asm volatile("s_waitcnt vmcnt(0)" ::: "memory");
        }
    }
    __syncthreads();
}

struct Frame {
    LAS unsigned char* lds;
    volatile LAS unsigned* MISC;
    int tid, lane, wave;
    int vcu, G;
};

DEV void refresh(Frame& F) { int l; asm volatile("v_mbcnt_lo_u32_b32 %0, -1, 0\n\tv_mbcnt_hi_u32_b32 %0, -1, %0" : "=v"(l)); F.lane = l; F.tid = F.wave * 64 + l; }
DEV float wave_sum(float v) {
#pragma unroll
    for (int o = 1; o < 64; o <<= 1) v += __shfl_xor(v, o);
    return v;
}
DEV void transpose_item(const float* W, int K, int N, bf16* WT, int k0, int n0, int dst_row0, LAS float* scr, int lane) {
    const int c4 = lane & 7, r0 = lane >> 3;
    const bool okc = (n0 + 4 * c4) < N;
    f32x4 v[8];
#pragma unroll
    for (int i = 0; i < 8; ++i) v[i] = okc ? *(const GAS f32x4*)(W + (size_t)(k0 + r0 + 8 * i) * N + n0 + 4 * c4) : (f32x4){0.f, 0.f, 0.f, 0.f};
#pragma unroll
    for (int i = 0; i < 8; ++i) { LAS float* d = scr + (r0 + 8 * i) * 33 + 4 * c4; d[0] = v[i].x; d[1] = v[i].y; d[2] = v[i].z; d[3] = v[i].w; }
    LDS_WAIT(); asm volatile("" ::: "memory");
    const int c = lane & 7;
#pragma unroll
    for (int j = 0; j < 4; ++j) { const int n = (lane >> 3) + 8 * j; const LAS float* s = scr + (8 * c) * 33 + n;
        v4u o; o.x = pk2(s[0 * 33], s[1 * 33]); o.y = pk2(s[2 * 33], s[3 * 33]); o.z = pk2(s[4 * 33], s[5 * 33]); o.w = pk2(s[6 * 33], s[7 * 33]);
        if (n0 + n < N) *(GAS v4u*)(WT + (size_t)(dst_row0 + n) * K + k0 + 8 * c) = o; }
    LDS_WAIT(); asm volatile("" ::: "memory");
}
DEV float rms_row_to_bf16(int lane, const float* xrow, const float* gain, bf16* orow) {
    const GAS f32x4* xr = (const GAS f32x4*)xrow + lane;
    const GAS f32x4* gr = (const GAS f32x4*)gain + lane;
    f32x4 v[4]; float s = 0.f;
#pragma unroll
    for (int j = 0; j < 4; ++j) { v[j] = xr[64 * j]; s += (v[j].x * v[j].x + v[j].y * v[j].y) + (v[j].z * v[j].z + v[j].w * v[j].w); }
    const float rstd = 1.0f / sqrtf(wave_sum(s) * (1.f / D) + EPS);
    GAS unsigned long long* o8 = (GAS unsigned long long*)orow + lane;
#pragma unroll
    for (int j = 0; j < 4; ++j) { const f32x4 g = gr[64 * j];
        o8[64 * j] = (unsigned long long)pk2(v[j].x * rstd * g.x, v[j].y * rstd * g.y) | ((unsigned long long)pk2(v[j].z * rstd * g.z, v[j].w * rstd * g.w) << 32); }
    return rstd;
}

DEV void fp_convert_weights(const Params& P, Frame& F, int which, int ci, int n) {
    LAS float* scr = (LAS float*)(F.lds + F.wave * 16384);
    const int gw = ci * NWAVES + F.wave, NGW = n * NWAVES;
    constexpr int I_IN0 = 16 * 72, I_OUT = 16 * 32, I_IN1 = 16 * 89;
    if (which == 0) {
        for (int it = gw; it < I_IN0 + I_OUT; it += NGW) {
            int r = it;
            if (r < I_IN0) { const int kb = r / 72, nb = r % 72; transpose_item(P.ev_w_in, D, EVEN_IN, P.win0t, 64 * kb, 32 * nb, 32 * nb, scr, F.lane); continue; } r -= I_IN0;
            { const int kb = r / 32, nb = r % 32; transpose_item(P.ev_w_out, D, D, P.wout0t, 64 * kb, 32 * nb, 32 * nb, scr, F.lane); }
        }
    } else {
        for (int it = gw; it < I_IN1 + I_OUT; it += NGW) {
            int r = it;
            if (r < I_IN1) { const int kb = r / 89, nb = r % 89; transpose_item(P.od_w_in, D, ODD_IN, P.win1t, 64 * kb, 32 * nb, 32 * nb, scr, F.lane); continue; } r -= I_IN1;
            { const int kb = r / 32, nb = r % 32; transpose_item(P.od_w_out, D, D, P.wout1t, 64 * kb, 32 * nb, 32 * nb, scr, F.lane); }
        }
    }
}
DEV void fp_norm_rows(Frame& F, const float* src, const float* gain, bf16* xn) {
    const int gw = F.vcu * NWAVES + F.wave, NGW = F.G * NWAVES;
    for (int m = gw; m < T; m += NGW) rms_row_to_bf16(F.lane, src + (size_t)m * D, gain, xn + (size_t)m * D);
}

constexpr int TAB_OFF = MISC_OFF + 128;
constexpr int RT_PART_OFF = 0;
constexpr int RT_SS_OFF = 98304;
constexpr int RT_HIST_OFF = 100352;
typedef float f32x4v __attribute__((ext_vector_type(4)));

DEV void fp_prep_router(const Params& P, Frame& F) {
    const int gtid = F.vcu * NWAVES * 64 + F.tid, gsz = F.G * NWAVES * 64;
    for (int i = gtid; i < 2 * 48 * D; i += gsz) {
        const int k = i & (D - 1), j = (i >> 10) % 48, l = i / (48 * D);
        float w = 0.f;
        if (j < 4) w = P.moe_w_grp[((size_t)l * D + k) * 4 + j]; else if (j < 36) w = P.moe_w_exp[((size_t)l * D + k) * 32 + (j - 4)];
        w *= P.moe_norm[l * D + k];
        const bf16 hi = f2bf(w); const bf16 lo = f2bf(w - bf2f(hi));
        P.wr[((size_t)(l * 2 + 0) * 48 + j) * D + k] = hi;
        P.wr[((size_t)(l * 2 + 1) * 48 + j) * D + k] = lo;
    }
}

DEV void fp_route(const Params& P, Frame& F, int layer) {
    const int lane = F.lane, w = F.wave;
    const bf16* wr_hi = P.wr + (size_t)(layer * 2 + 0) * 48 * D;
    const bf16* wr_lo = P.wr + (size_t)(layer * 2 + 1) * 48 * D;
    LAS float* part = (LAS float*)(F.lds + RT_PART_OFF);
    LAS float* ssp = (LAS float*)(F.lds + RT_SS_OFF);
    LAS unsigned* hist = (LAS unsigned*)(F.lds + RT_HIST_OFF);
    unsigned* cnt = P.ctl + CW_MOE + layer * 256;
    for (int tb = F.vcu; tb < T / 64; tb += F.G) {
        const int t0 = tb * 64;
        if (F.tid < 64) hist[F.tid] = 0u;
        const float* xrow = P.out + (size_t)(t0 + (lane & 15)) * D + 128 * w + 8 * (lane >> 4);
        const size_t boff = (size_t)(lane & 15) * D + 128 * w + 8 * (lane >> 4);
        pg8::f32x4 acc[4][3];
        float ss[4] = {0.f, 0.f, 0.f, 0.f};
#pragma unroll
        for (int g = 0; g < 4; ++g)
#pragma unroll
            for (int c = 0; c < 3; ++c) acc[g][c] = (pg8::f32x4){0.f, 0.f, 0.f, 0.f};
#pragma unroll 1
        for (int ks = 0; ks < 4; ++ks) {
            bf16x8 bh[3], bl[3];
#pragma unroll
            for (int c = 0; c < 3; ++c) { bh[c] = *(const bf16x8*)(wr_hi + boff + (size_t)16 * c * D + 32 * ks); bl[c] = *(const bf16x8*)(wr_lo + boff + (size_t)16 * c * D + 32 * ks); }
            f32x4v xa[4], xb[4];
#pragma unroll
            for (int g = 0; g < 4; ++g) { xa[g] = *(const f32x4v*)(xrow + (size_t)16 * g * D + 32 * ks); xb[g] = *(const f32x4v*)(xrow + (size_t)16 * g * D + 32 * ks + 4); }
#pragma unroll
            for (int g = 0; g < 4; ++g) {
                float xv[8] = {xa[g].x, xa[g].y, xa[g].z, xa[g].w, xb[g].x, xb[g].y, xb[g].z, xb[g].w};
                bf16x8 ah, al;
#pragma unroll
                for (int j = 0; j < 8; ++j) { ss[g] += xv[j] * xv[j]; const bf16 h = f2bf(xv[j]); ah[j] = (short)h; al[j] = (short)f2bf(xv[j] - bf2f(h)); }
#pragma unroll
                for (int c = 0; c < 3; ++c) {
                    acc[g][c] = __builtin_amdgcn_mfma_f32_16x16x32_bf16(ah, bh[c], acc[g][c], 0, 0, 0);
                    acc[g][c] = __builtin_amdgcn_mfma_f32_16x16x32_bf16(ah, bl[c], acc[g][c], 0, 0, 0);
                    acc[g][c] = __builtin_amdgcn_mfma_f32_16x16x32_bf16(al, bh[c], acc[g][c], 0, 0, 0);
                }
            }
        }
#pragma unroll
        for (int g = 0; g < 4; ++g) {
            float s = ss[g]; s += __shfl_xor(s, 16); s += __shfl_xor(s, 32);
            if (lane < 16) ssp[w * 64 + 16 * g + lane] = s;
#pragma unroll
            for (int c = 0; c < 3; ++c)
#pragma unroll
                for (int r = 0; r < 4; ++r) part[(w * 64 + 16 * g + 4 * (lane >> 4) + r) * 48 + 16 * c + (lane & 15)] = acc[g][c][r];
        }
        __syncthreads();
        for (int i = F.tid; i < 64 * 48; i += NWAVES * 64) { float a = part[i];
#pragma unroll
            for (int ww = 1; ww < 8; ++ww) a += part[ww * 64 * 48 + i];
            part[i] = a; }
        if (F.tid < 64) { float a = ssp[F.tid];
#pragma unroll
            for (int ww = 1; ww < 8; ++ww) a += ssp[ww * 64 + F.tid];
            ssp[F.tid] = a; }
        __syncthreads();
        int e1 = 0, e2 = 0; float w1 = 0.f, w2 = 0.f; unsigned r1 = 0, r2 = 0;
        if (F.tid < 64) {
            const int t = t0 + F.tid;
            const float rs = 1.0f / sqrtf(ssp[F.tid] * (1.f / D) + EPS);
            P.rstd[t] = rs;
            float lg[4], le[32];
#pragma unroll
            for (int j = 0; j < 4; ++j) lg[j] = part[F.tid * 48 + j] * rs + P.moe_b_grp[layer * 4 + j];
#pragma unroll
            for (int j = 0; j < 32; ++j) le[j] = part[F.tid * 48 + 4 + j] * rs + P.moe_b_exp[layer * 32 + j];
            int gs = 0; float gm = lg[0];
#pragma unroll
            for (int j = 1; j < 4; ++j) if (lg[j] > gm) { gm = lg[j]; gs = j; }
            float gz = 0.f;
#pragma unroll
            for (int j = 0; j < 4; ++j) gz += expf(lg[j] - gm);
            const float pg = 1.0f / gz;
            float wv[8];
#pragma unroll
            for (int j = 0; j < 8; ++j) wv[j] = gs == 0 ? le[j] : gs == 1 ? le[8 + j] : gs == 2 ? le[16 + j] : le[24 + j];
            int i1 = 0; float m1 = wv[0];
#pragma unroll
            for (int j = 1; j < 8; ++j) if (wv[j] > m1) { m1 = wv[j]; i1 = j; }
            int i2 = -1; float m2 = -3e38f;
#pragma unroll
            for (int j = 0; j < 8; ++j) if (j != i1 && wv[j] > m2) { m2 = wv[j]; i2 = j; }
            const float ex2 = expf(m2 - m1);
            w1 = pg / (1.0f + ex2); w2 = pg * ex2 / (1.0f + ex2);
            e1 = gs * 8 + i1; e2 = gs * 8 + i2;
            r1 = __hip_atomic_fetch_add(&hist[e1], 1u, __ATOMIC_RELAXED, __HIP_MEMORY_SCOPE_WORKGROUP); r2 = __hip_atomic_fetch_add(&hist[e2], 1u, __ATOMIC_RELAXED, __HIP_MEMORY_SCOPE_WORKGROUP);
        }
        __syncthreads();
        if (F.tid < 32) { const unsigned h = hist[F.tid]; hist[32 + F.tid] = h ? xb_add(&cnt[F.tid], h) : 0u; }
        __syncthreads();
        if (F.tid < 64) {
            const int t = t0 + F.tid;
            P.eid[t * 2 + 0] = e1; P.eid[t * 2 + 1] = e2; P.ew[t * 2 + 0] = w1; P.ew[t * 2 + 1] = w2;
            const int i1x = (int)(hist[32 + e1] + r1), i2x = (int)(hist[32 + e2] + r2);
            P.pos[t * 2 + 0] = i1x; P.pos[t * 2 + 1] = i2x;
            P.rowtok[e1 * T + i1x] = t; P.rowtok[e2 * T + i2x] = t;
        }
        for (int r = w; r < 64; r += NWAVES) rms_row_to_bf16(lane, P.out + (size_t)(t0 + r) * D, P.moe_norm + layer * D, P.xn + (size_t)(t0 + r) * D);
        __syncthreads();
    }
}

DEV void moe_table(const Params& P, Frame& F, int layer) {
    volatile LAS int* tab = (volatile LAS int*)(F.lds + TAB_OFF);
    if (F.tid == 0) {
        unsigned* cnt = P.ctl + CW_MOE + layer * 256;
        int acc = 0;
        for (int e = 0; e < 32; ++e) { tab[e] = acc; acc += (int)((xb_ld(&cnt[e]) + 255u) >> 8); }
        tab[32] = acc;
    }
    __syncthreads();
}

struct ListOrder {
    int code[4]; int n, npn; const char* A; const char* Bt; size_t tstep, bstep;
    __device__ __forceinline__ bool next(int i, pg8::Unit& o) const {
        if (i >= n) return false;
        const int c = (i == 0) ? code[0] : (i == 1) ? code[1] : (i == 2) ? code[2] : code[3];
        const int tt = c >> 8, e = (c >> 3) & 31, pn = c & 7;
        o.pm = tt; o.pn = pn; o.A = A + (size_t)tt * tstep; o.B = Bt + (size_t)(e * npn + pn) * bstep; return true;
    }
};
DEV void fp_moe_fused(const Params& P, Frame& F, int layer, int ci, int ncu) {
    moe_table(P, F, layer);
    volatile LAS int* tab = (volatile LAS int*)(F.lds + TAB_OFF);
    const int ntile = __builtin_amdgcn_readfirstlane(tab[32]);
#pragma unroll
    for (int rep = 0; rep < 2; ++rep) { const int tt = ci + rep * ncu; if (tt >= ntile) break;
        int e = 0;
        for (int q = 1; q < 32; ++q) e += (tt >= tab[q]) ? 1 : 0;
        e = __builtin_amdgcn_readfirstlane(e);
        const int cb = (tt << 8) | (e << 3);
        {
          const int rbase = e * T + (tt - tab[e]) * 256;
          unsigned g[2][2];
#pragma unroll
          for (int hh = 0; hh < 2; ++hh)
#pragma unroll
              for (int i = 0; i < 2; ++i) { int R, C; pg8::stage_rc(F.tid * 16 + i * 8192, R, C); int tk = P.rowtok[rbase + hh * 128 + R]; tk = ((unsigned)tk < (unsigned)T) ? tk : 0; g[hh][i] = (unsigned)tk * (unsigned)(D * 2); }
          ListOrder L; L.tstep = 0; L.A = (const char*)P.xn; L.Bt = (const char*)P.wgut[layer]; L.npn = 2; L.n = 2; L.bstep = (size_t)256 * D * 2;
          L.code[0] = cb; L.code[1] = cb | 1; L.code[2] = 0; L.code[3] = 0;
          pg8::EpiSiluMul E{P.hid, 256}; pg8::gemm_phase<pg8::EpiSiluMul, ListOrder, true>(F.lds, D, L, E, F.tid, g[0][0], g[0][1], g[1][0], g[1][1]); }
        refresh(F);
        if (F.tid == 0) { __builtin_amdgcn_fence(__ATOMIC_ACQUIRE, "agent"); asm volatile("s_waitcnt vmcnt(0)" ::: "memory"); }
        __syncthreads();
        { ListOrder L; L.tstep = (size_t)256 * 256 * 2; L.bstep = L.tstep; L.A = (const char*)P.hid; L.Bt = (const char*)P.wdt[layer]; L.npn = 4; L.n = 4;
          L.code[0] = cb; L.code[1] = cb | 1; L.code[2] = cb | 2; L.code[3] = cb | 3;
          pg8::EpiStoreBf16 E{P.ha, D}; pg8::gemm_phase(F.lds, 256, L, E, F.tid); }
        refresh(F);
    }
}
DEV void fp_combine(const Params& P, Frame& F, int layer, const float* gain2, bf16* xn) {
    moe_table(P, F, layer);
    volatile LAS int* tab = (volatile LAS int*)(F.lds + TAB_OFF);
    const int gw = F.vcu * NWAVES + F.wave, NGW = F.G * NWAVES, lane = F.lane;
    int p1v = 0, p2v = 0; float w1v = 0.f, w2v = 0.f;
    { const int tj = gw + lane * NGW;
      if (tj < T) { p1v = tab[P.eid[tj * 2]] * 256 + P.pos[tj * 2]; p2v = tab[P.eid[tj * 2 + 1]] * 256 + P.pos[tj * 2 + 1]; w1v = P.ew[tj * 2]; w2v = P.ew[tj * 2 + 1]; } }
    int jj = 0;
    for (int t = gw; t < T; t += NGW, ++jj) {
        const int p1 = __builtin_amdgcn_readlane(p1v, jj), p2 = __builtin_amdgcn_readlane(p2v, jj);
        const float w1 = u2f((unsigned)__builtin_amdgcn_readlane((int)f2u(w1v), jj)), w2 = u2f((unsigned)__builtin_amdgcn_readlane((int)f2u(w2v), jj));
        GAS f32x4* xr = (GAS f32x4*)(P.out + (size_t)t * D) + lane;
        const GAS unsigned long long* y1 = (const GAS unsigned long long*)(P.ha + (size_t)p1 * D) + lane;
        const GAS unsigned long long* y2 = (const GAS unsigned long long*)(P.ha + (size_t)p2 * D) + lane;
        f32x4 v[4]; float s = 0.f;
#pragma unroll
        for (int j = 0; j < 4; ++j) {
            v[j] = xr[64 * j];
            const unsigned long long a = y1[64 * j], b = y2[64 * j];
            v[j].x += w1 * u2f((unsigned)(a & 0xffffu) << 16) + w2 * u2f((unsigned)(b & 0xffffu) << 16);
            v[j].y += w1 * u2f((unsigned)((a >> 16) & 0xffffu) << 16) + w2 * u2f((unsigned)((b >> 16) & 0xffffu) << 16);
            v[j].z += w1 * u2f((unsigned)((a >> 32) & 0xffffu) << 16) + w2 * u2f((unsigned)((b >> 32) & 0xffffu) << 16);
            v[j].w += w1 * u2f((unsigned)((a >> 48) & 0xffffu) << 16) + w2 * u2f((unsigned)((b >> 48) & 0xffffu) << 16);
            xr[64 * j] = v[j];
            s += (v[j].x * v[j].x + v[j].y * v[j].y) + (v[j].z * v[j].z + v[j].w * v[j].w);
        }
        if (xn) {
            const float rstd = 1.0f / sqrtf(wave_sum(s) * (1.f / D) + EPS);
            const GAS f32x4* gr = (const GAS f32x4*)gain2 + lane;
            GAS unsigned long long* o8 = (GAS unsigned long long*)(xn + (size_t)t * D) + lane;
#pragma unroll
            for (int j = 0; j < 4; ++j) { const f32x4 g = gr[64 * j];
                o8[64 * j] = (unsigned long long)pk2(v[j].x * rstd * g.x, v[j].y * rstd * g.y) | ((unsigned long long)pk2(v[j].z * rstd * g.z, v[j].w * rstd * g.w) << 32); }
        }
    }
}


DEV void fp_convert_moe_part(const Params& P, Frame& F, int layer, int ci, int nconv) {
    LAS float* scr = (LAS float*)(F.lds + F.wave * 16384);
    constexpr int NIT = 32 * 384;
    for (int it = ci * NWAVES + F.wave; it < NIT; it += nconv * NWAVES) {
        const int e = it / 384; int r = it % 384;
        const size_t eo = (size_t)(layer * 32 + e);
        if (r < 256) { const bool up = r >= 128; r &= 127; const int kb = r / 8, nb = r % 8; const int f0 = 32 * nb;
            const float* W = (up ? P.moe_w_up : P.moe_w_gate) + eo * D * 256;
            transpose_item(W, D, 256, P.wgut[layer] + (size_t)e * 512 * D, 64 * kb, f0, (f0 >> 7) * 256 + (up ? 128 : 0) + (f0 & 127), scr, F.lane);
        } else { r -= 256; const int kb = r / 32, nb = r % 32;
            transpose_item(P.moe_w_down + eo * 256 * D, 256, D, P.wdt[layer] + (size_t)e * D * 256, 64 * kb, 32 * nb, 32 * nb, scr, F.lane); }
    }
}
namespace att {
typedef float f32x16 __attribute__((ext_vector_type(16)));
typedef short s16x4 __attribute__((ext_vector_type(4)));
typedef short v4i16_t __attribute__((ext_vector_type(4)));
typedef LAS const char* lptr;
constexpr float LOG2E = 1.4426950408889634f;
constexpr int KS0 = 0, VS0 = 32768, SLOT = 8192;
constexpr int SCR0 = 65536;
constexpr float MNEG = -1e30f;

struct TileRegs { v4u k, v; };
DEV void tile_load(TileRegs& R, const bf16* Kg, const bf16* Vg, int pitch, int k0, int tid) {
    const int w = tid >> 6, lane = tid & 63;
    R.k = *(const GAS v4u*)(Kg + (size_t)(k0 + lane) * pitch + w * 8);
    R.v = *(const GAS v4u*)(Vg + (size_t)(k0 + 16 * (w & 3) + (lane >> 2)) * pitch + (w >> 2) * 32 + (lane & 3) * 8);
}
DEV void tile_store(LAS unsigned char* lds, int slot, const TileRegs& R, int tid) {
    *(LAS v4u*)(lds + KS0 + slot * SLOT + tid * 16) = R.k;
    *(LAS v4u*)(lds + VS0 + slot * SLOT + tid * 16) = R.v;
}
DEV void qk_tile(f32x16& p0, f32x16& p1, lptr Kslot, const bf16x8 (&qr)[4], int r32, int hi) {
    lptr kb = Kslot + hi * 1024 + r32 * 16;
    p0 = f32x16{}; p1 = f32x16{};
#pragma unroll
    for (int dh = 0; dh < 2; ++dh) {
        bf16x8 kf[4];
#pragma unroll
        for (int d1 = 0; d1 < 2; ++d1) { kf[2 * d1] = *(const LAS bf16x8*)(kb + (2 * dh + d1) * 2048); kf[2 * d1 + 1] = *(const LAS bf16x8*)(kb + (2 * dh + d1) * 2048 + 512); }
#pragma unroll
        for (int d1 = 0; d1 < 2; ++d1) {
            p0 = __builtin_amdgcn_mfma_f32_32x32x16_bf16(kf[2 * d1], qr[2 * dh + d1], p0, 0, 0, 0);
            p1 = __builtin_amdgcn_mfma_f32_32x32x16_bf16(kf[2 * d1 + 1], qr[2 * dh + d1], p1, 0, 0, 0);
        }
    }
}
DEV s16x4 vtr(lptr p) { return __builtin_bit_cast(s16x4, __builtin_amdgcn_ds_read_tr16_b64_v4i16((LAS v4i16_t*)p)); }
DEV unsigned cvtpk(float lo, float hi) { unsigned r; asm volatile("v_cvt_pk_bf16_f32 %0, %1, %2" : "=v"(r) : "v"(lo), "v"(hi)); return r; }
DEV void pv_tile(f32x16 (&o)[2], lptr Vslot, const f32x16& p0, const f32x16& p1, int lane) {
    const int hi = lane >> 5;
    lptr vp = Vslot + ((lane >> 4) & 1) * 32 + (lane & 3) * 8 + (4 * hi + ((lane & 15) >> 2)) * 64;
    bf16x8 pf[4];
#pragma unroll
    for (int ks = 0; ks < 4; ++ks) {
        const f32x16& p = (ks < 2) ? p0 : p1; const int b = (ks & 1) * 8;
        v4u w; w.x = cvtpk(p[b + 0], p[b + 1]); w.y = cvtpk(p[b + 2], p[b + 3]); w.z = cvtpk(p[b + 4], p[b + 5]); w.w = cvtpk(p[b + 6], p[b + 7]);
        pf[ks] = __builtin_bit_cast(bf16x8, w);
    }
#pragma unroll
    for (int d0 = 0; d0 < 2; ++d0)
#pragma unroll
        for (int ks = 0; ks < 4; ++ks) {
            const s16x4 lo = vtr(vp + d0 * 4096 + ks * 1024), hh = vtr(vp + d0 * 4096 + ks * 1024 + 512);
            const bf16x8 vf = (bf16x8){lo[0], lo[1], lo[2], lo[3], hh[0], hh[1], hh[2], hh[3]};
            o[d0] = __builtin_amdgcn_mfma_f32_32x32x16_bf16(vf, pf[ks], o[d0], 0, 0, 0);
        }
}
DEV float lane_swap_max(float m) {
    auto rr = __builtin_amdgcn_permlane32_swap(__float_as_uint(m), __float_as_uint(m), false, false);
    return fmaxf(__uint_as_float(rr[0]), __uint_as_float(rr[1]));
}
DEV float lane_swap_sum(float m) {
    auto rr = __builtin_amdgcn_permlane32_swap(__float_as_uint(m), __float_as_uint(m), false, false);
    return __uint_as_float(rr[0]) + __uint_as_float(rr[1]);
}
DEV float lane_partner(float m, int hi) {
    auto rr = __builtin_amdgcn_permlane32_swap(__float_as_uint(m), __float_as_uint(m), false, false);
    return hi ? __uint_as_float(rr[0]) : __uint_as_float(rr[1]);
}

constexpr float M0 = 16.0f;
struct SoftState { float l; f32x16 o[2]; };
DEV void soft_reset(SoftState& s) { s.l = 0.f; s.o[0] = f32x16{}; s.o[1] = f32x16{}; }

DEV void soft_tile(SoftState& st, f32x16& p0, f32x16& p1, float s2, float k0rel_f, int klo, int klim, bool need_mask, lptr Vslot, int lane) {
    const int hi = lane >> 5;
    const float c1 = 0.125f * LOG2E;
    const float base = s2 * (k0rel_f + (float)(4 * hi)) - M0;
    float ls0 = 0.f, ls1 = 0.f;
    if (need_mask) {
#pragma unroll
        for (int r = 0; r < 16; ++r) {
            const int kr = (r & 3) + 8 * (r >> 2);
            const float x0 = __builtin_amdgcn_exp2f(fmaf(p0[r], c1, fmaf(s2, (float)kr, base)));
            const float x1 = __builtin_amdgcn_exp2f(fmaf(p1[r], c1, fmaf(s2, (float)(kr + 32), base)));
            p0[r] = (kr > klo && kr <= klim) ? x0 : 0.f; p1[r] = (kr + 32 > klo && kr + 32 <= klim) ? x1 : 0.f;
            ls0 += p0[r]; ls1 += p1[r];
        }
    } else {
#pragma unroll
        for (int r = 0; r < 16; ++r) {
            const int kr = (r & 3) + 8 * (r >> 2);
            p0[r] = __builtin_amdgcn_exp2f(fmaf(p0[r], c1, fmaf(s2, (float)kr, base)));
            p1[r] = __builtin_amdgcn_exp2f(fmaf(p1[r], c1, fmaf(s2, (float)(kr + 32), base)));
            ls0 += p0[r]; ls1 += p1[r];
        }
    }
    st.l += ls0 + ls1;
    pv_tile(st.o, Vslot, p0, p1, lane);
}

DEV void soft_pair_fast(SoftState& st, const bf16x8 (&qr)[4], lptr Ka, lptr Va, lptr Kb, lptr Vb, float s2, float baseA, float baseB, int lane) {
    const int r32 = lane & 31, hi = lane >> 5;
    const float c1 = 0.125f * LOG2E;
    f32x16 a0, a1, b0, b1;
    qk_tile(a0, a1, Ka, qr, r32, hi);
    qk_tile(b0, b1, Kb, qr, r32, hi);
    float ls0 = 0.f, ls1 = 0.f;
#pragma unroll
    for (int r = 0; r < 16; ++r) {
        const int kr = (r & 3) + 8 * (r >> 2);
        a0[r] = __builtin_amdgcn_exp2f(fmaf(a0[r], c1, fmaf(s2, (float)kr, baseA)));
        a1[r] = __builtin_amdgcn_exp2f(fmaf(a1[r], c1, fmaf(s2, (float)(kr + 32), baseA)));
        ls0 += a0[r]; ls1 += a1[r];
    }
    pv_tile(st.o, Va, a0, a1, lane);
#pragma unroll
    for (int r = 0; r < 16; ++r) {
        const int kr = (r & 3) + 8 * (r >> 2);
        b0[r] = __builtin_amdgcn_exp2f(fmaf(b0[r], c1, fmaf(s2, (float)kr, baseB)));
        b1[r] = __builtin_amdgcn_exp2f(fmaf(b1[r], c1, fmaf(s2, (float)(kr + 32), baseB)));
        ls0 += b0[r]; ls1 += b1[r];
    }
    st.l += ls0 + ls1;
    pv_tile(st.o, Vb, b0, b1, lane);
}

DEV void store_ot(const f32x16 (&o)[2], float f, bf16* orow, int hi) {
#pragma unroll
    for (int d0 = 0; d0 < 2; ++d0)
#pragma unroll
        for (int g = 0; g < 4; ++g) {
            const unsigned a = cvtpk(o[d0][4 * g] * f, o[d0][4 * g + 1] * f), b = cvtpk(o[d0][4 * g + 2] * f, o[d0][4 * g + 3] * f);
            *(GAS unsigned long long*)(orow + 32 * d0 + 8 * g + 4 * hi) = (unsigned long long)a | ((unsigned long long)b << 32);
        }
}
DEV void load_q(bf16x8 (&qr)[4], const bf16* qrow, int hi) {
#pragma unroll
    for (int d0 = 0; d0 < 4; ++d0) qr[d0] = *(const GAS bf16x8*)(qrow + 16 * d0 + 8 * hi);
}

template <bool FAST, class MaskF>
DEV void run_segment(Frame& F, SoftState& st, const bf16x8 (&qr)[4], const bf16* Kg, const bf16* Vg, int pitch, unsigned long long tmask, float s2, int qpos, const MaskF& mf) {
    const int tid = F.tid, lane = F.lane, r32 = lane & 31, hi = lane >> 5;
    if (tmask == 0ull) return;
#define NEXT_TILE(var) do { if (tmask) { var = __builtin_ctzll(tmask); tmask &= tmask - 1ull; } else var = -1; } while (0)
#define SEG_COMPUTE(t, slot) do { int klo, klim; mf((t), klo, klim); \
        if (__any(klim >= 0 && klo < 60 && klim > klo)) { const bool need_mask = __any(klo >= 0 || klim < 60); f32x16 p0, p1; \
            qk_tile(p0, p1, (lptr)(F.lds + KS0 + (slot) * SLOT), qr, r32, hi); \
            soft_tile(st, p0, p1, s2, (float)((t) * 64 - qpos), klo, klim, need_mask, (lptr)(F.lds + VS0 + (slot) * SLOT), lane); } } while (0)
    int ta, tb, tc, td, set = 0;
    NEXT_TILE(ta); NEXT_TILE(tb);
    TileRegs RA, RB; tile_load(RA, Kg, Vg, pitch, ta * 64, tid); if (tb >= 0) tile_load(RB, Kg, Vg, pitch, tb * 64, tid);
    for (;;) {
        tile_store(F.lds, 2 * set, RA, tid); if (tb >= 0) tile_store(F.lds, 2 * set + 1, RB, tid);
        NEXT_TILE(tc); NEXT_TILE(td);
        if (tc >= 0) tile_load(RA, Kg, Vg, pitch, tc * 64, tid);
        if (td >= 0) tile_load(RB, Kg, Vg, pitch, td * 64, tid);
        __syncthreads();
        bool fast = false;
        if (FAST && tb >= 0) {
            int kloA, klimA, kloB, klimB; mf(ta, kloA, klimA); mf(tb, kloB, klimB);
            const bool fullA = klimA >= 59 && kloA < 0, noneA = klimA < 0 || kloA >= 59 || klimA <= kloA;
            const bool fullB = klimB >= 59 && kloB < 0, noneB = klimB < 0 || kloB >= 59 || klimB <= kloB;
            fast = __all((fullA || noneA) && (fullB || noneB)) && __any(fullA) && __any(fullB);
            if (fast) {
                const float hb = (float)(4 * hi - qpos);
                const float baseA = fullA ? s2 * ((float)(ta * 64) + hb) - M0 : MNEG, baseB = fullB ? s2 * ((float)(tb * 64) + hb) - M0 : MNEG;
                soft_pair_fast(st, qr, (lptr)(F.lds + KS0 + (2 * set) * SLOT), (lptr)(F.lds + VS0 + (2 * set) * SLOT), (lptr)(F.lds + KS0 + (2 * set + 1) * SLOT), (lptr)(F.lds + VS0 + (2 * set + 1) * SLOT), s2, baseA, baseB, lane);
            }
        }
        if (!fast) {
            SEG_COMPUTE(ta, 2 * set);
            if (tb >= 0) SEG_COMPUTE(tb, 2 * set + 1);
        }
        if (tc < 0) break;
        ta = tc; tb = td; set ^= 1;
    }
    __syncthreads();
#undef NEXT_TILE
#undef SEG_COMPUTE
}
DEV unsigned long long tile_range(int t0, int t1) { return (t1 < t0) ? 0ull : ((~0ull >> (63 - (t1 - t0))) << t0); }
}

DEV void headnorm_group(bf16* row, int off, int nheads, const float* g, int lane) {
    const int hg = lane >> 3, ch = lane & 7;
    if (hg < nheads) {
        GAS v4u* p = (GAS v4u*)(row + off + hg * 64 + ch * 8);
        const v4u x = *p;
        float v[8] = {u2f(x.x << 16), u2f(x.x & 0xffff0000u), u2f(x.y << 16), u2f(x.y & 0xffff0000u), u2f(x.z << 16), u2f(x.z & 0xffff0000u), u2f(x.w << 16), u2f(x.w & 0xffff0000u)};
        float ss = 0.f;
#pragma unroll
        for (int j = 0; j < 8; ++j) ss += v[j] * v[j];
        ss += __shfl_xor(ss, 1); ss += __shfl_xor(ss, 2); ss += __shfl_xor(ss, 4);
        const float r = 1.0f / sqrtf(ss * (1.0f / 64) + EPS);
        const f32x4 g0 = *(const GAS f32x4*)(g + ch * 8), g1 = *(const GAS f32x4*)(g + ch * 8 + 4);
        v4u o; o.x = pk2(v[0] * r * g0.x, v[1] * r * g0.y); o.y = pk2(v[2] * r * g0.z, v[3] * r * g0.w); o.z = pk2(v[4] * r * g1.x, v[5] * r * g1.y); o.w = pk2(v[6] * r * g1.z, v[7] * r * g1.w);
        *p = o;
    }
}
DEV void fp_headnorm(const Params& P, Frame& F, int layer) {
    const int gw = F.vcu * NWAVES + F.wave, NGW = F.G * NWAVES, lane = F.lane;
    for (int t = gw; t < T; t += NGW) {
        bf16* row = P.proj + (size_t)t * LDP;
        if (layer == 0) {
            headnorm_group(row, 0, 8, P.ev_q_norm, lane);
            headnorm_group(row, 512, 2, P.ev_k_norm, lane);
        } else {
            headnorm_group(row, 0, 8, P.od_c_q_norm, lane);
            headnorm_group(row, 512, 8, P.od_c_k_norm, lane);
            headnorm_group(row, 1536, 8, P.od_d_q_norm, lane);
            headnorm_group(row, 2304, 2, P.od_d_k_norm + 64, lane);
            headnorm_group(row, 2560, 2, P.od_d_k_norm + 128, lane);
        }
    }
}

DEV void fp_prep_compress(const Params& P, Frame& F, int ci, int n) {
    const int gw = ci * NWAVES + F.wave, NGW = n * NWAVES, lane = F.lane;
    for (int i = gw; i < 128; i += NGW) {
        const int which = i >> 6, e = i & 63;
        const float* pos = P.od_cmp_pos + which * 2048; const float* w = P.od_cmp_w + (size_t)which * 2048 * 64 + e;
        float s = 0.f;
        for (int k = lane; k < 2048; k += 64) s += pos[k] * w[(size_t)k * 64];
        s = wave_sum(s);
        if (lane == 0) P.cbias[i] = s;
    }
    LAS float* scr = (LAS float*)(F.lds + F.wave * 16384);
    for (int i = gw; i < 128; i += NGW) {
        const int which = i >> 6, r = i & 63, kb = r >> 1, nb = r & 1;
        transpose_item(P.od_cmp_w + (size_t)which * 2048 * 64, 2048, 64, P.wcmpt + (size_t)which * 64 * 2048, 64 * kb, 32 * nb, 32 * nb, scr, lane);
    }
}

DEV void fp_prep1(const Params& P, Frame& F) {
    const int gw = F.vcu * NWAVES + F.wave, NGW = F.G * NWAVES, lane = F.lane, w = F.wave;
    for (int i = gw; i < NB * 64; i += NGW) {
        const int n = i & 7, h = (i >> 3) & 7, b = i >> 6;
        const bf16* kp = P.proj + ((size_t)b * S + n * 256) * LDP + 512 + h * 64 + lane;
        float s0 = 0.f, s1 = 0.f, s2 = 0.f, s3 = 0.f;
#pragma unroll 4
        for (int j = 0; j < 256; j += 4) { s0 += bf2f(kp[(size_t)j * LDP]); s1 += bf2f(kp[(size_t)(j + 1) * LDP]); s2 += bf2f(kp[(size_t)(j + 2) * LDP]); s3 += bf2f(kp[(size_t)(j + 3) * LDP]); }
        P.kmean[(size_t)i * 64 + lane] = ((s0 + s1) + (s2 + s3)) * (1.0f / 256);
    }
    LAS float* part = (LAS float*)F.lds;
    for (int it = F.vcu; it < 2 * NB * 2 * 8; it += F.G) {
        const int ng = it & 7, hkv = (it >> 3) & 1, b = (it >> 4) % NB, which = it / (16 * NB);
        const int n = 16 * ng + (lane & 15);
        const int ncl = n > 126 ? 126 : n;
        const bf16* arow = P.proj + ((size_t)b * S + ncl * 16) * LDP + (which ? 2176 : 2048) + hkv * 64 + 8 * (lane >> 4);
        const bf16* brow = P.wcmpt + (size_t)which * 64 * 2048 + (size_t)(lane & 15) * 2048 + 8 * (lane >> 4);
        pg8::f32x4 acc[4];
#pragma unroll
        for (int c = 0; c < 4; ++c) acc[c] = (pg8::f32x4){0.f, 0.f, 0.f, 0.f};
#pragma unroll
        for (int kk = 0; kk < 8; ++kk) {
            const int ks = 8 * w + kk, li = ks >> 1, dh = (ks & 1) * 32;
            const bf16x8 a = *(const GAS bf16x8*)(arow + (size_t)li * LDP + dh);
#pragma unroll
            for (int c = 0; c < 4; ++c) {
                const bf16x8 bb = *(const GAS bf16x8*)(brow + (size_t)(16 * c) * 2048 + 32 * ks);
                acc[c] = __builtin_amdgcn_mfma_f32_16x16x32_bf16(a, bb, acc[c], 0, 0, 0);
            }
        }
#pragma unroll
        for (int c = 0; c < 4; ++c)
#pragma unroll
            for (int r = 0; r < 4; ++r) part[(w * 16 + 4 * (lane >> 4) + r) * 64 + 16 * c + (lane & 15)] = acc[c][r];
        __syncthreads();
        {
            const int row = F.tid >> 5, c0 = 2 * (F.tid & 31);
            float v0 = P.cbias[which * 64 + c0], v1 = P.cbias[which * 64 + c0 + 1];
#pragma unroll
            for (int ww = 0; ww < 8; ++ww) { v0 += part[(ww * 16 + row) * 64 + c0]; v1 += part[(ww * 16 + row) * 64 + c0 + 1]; }
            if (which == 0) {
                float ss = v0 * v0 + v1 * v1;
                ss += __shfl_xor(ss, 1); ss += __shfl_xor(ss, 2); ss += __shfl_xor(ss, 4); ss += __shfl_xor(ss, 8); ss += __shfl_xor(ss, 16);
                const float rs = 1.0f / sqrtf(ss * (1.0f / 64) + EPS);
                v0 *= rs * P.od_d_k_norm[c0]; v1 *= rs * P.od_d_k_norm[c0 + 1];
            }
            const int nn = 16 * ng + row;
            if (nn < NCMP) *(GAS unsigned*)(P.kvcmp + (((size_t)(which * NB + b) * NCMP + nn) * 2 + hkv) * 64 + c0) = pk2(v0, v1);
        }
        __syncthreads();
    }
}

DEV void sb_tile(att::f32x16& p0, att::f32x16& p1, float& carry, int lim, int hi) {
    using namespace att;
    const float c1 = 0.125f * LOG2E;
    f32x16 k0, k1;
    float cs[2][4];
#pragma unroll
    for (int hf = 0; hf < 2; ++hf)
#pragma unroll
        for (int g = 0; g < 4; ++g) {
            float s = 0.f;
#pragma unroll
            for (int i = 0; i < 4; ++i) {
                const int r = 4 * g + i, kr = i + 8 * g + 32 * hf;
                const float z2 = (hf ? p1[r] : p0[r]) * c1;
                const float e = __builtin_amdgcn_exp2f(-fabsf(z2));
                const float ls2 = fminf(z2, 0.f) - __builtin_amdgcn_logf(1.0f + e);
                const bool ok = kr < lim;
                const float lk2 = ok ? (ls2 - z2) : 0.f;
                if (hf) { p1[r] = ok ? ls2 : MNEG; k1[r] = lk2; } else { p0[r] = ok ? ls2 : MNEG; k0[r] = lk2; }
                s += lk2;
            }
            cs[hf][g] = s;
        }
    float run = carry;
#pragma unroll
    for (int hf = 1; hf >= 0; --hf)
#pragma unroll
        for (int g = 3; g >= 0; --g) {
            const float mine = cs[hf][g], other = lane_partner(mine, hi);
            float suf = hi ? run : run + other;
            run += mine + other;
#pragma unroll
            for (int i = 3; i >= 0; --i) {
                const int r = 4 * g + i;
                if (hf) { p1[r] = __builtin_amdgcn_exp2f(p1[r] + suf); suf += k1[r]; } else { p0[r] = __builtin_amdgcn_exp2f(p0[r] + suf); suf += k0[r]; }
            }
        }
    carry = run;
}

DEV void fp_attn0(const Params& P, Frame& F) {
    using namespace att;
    const int tid = F.tid, lane = F.lane, r32 = lane & 31, hi = lane >> 5, w = F.wave;
    for (int u = F.vcu; u < 512; u += F.G) {
        {
            const int b = u >> 6, h = (u >> 3) & 7, blk = u & 7;
            const bf16* base = P.proj + (size_t)b * S * LDP;
            const int q = blk * 256 + w * 32 + r32;
            bf16x8 qr[4]; load_q(qr, base + (size_t)q * LDP + 768 + h * 64, hi);
            const bf16* Kg = base + 1280 + h * 64; const bf16* Vg = base + 1792 + h * 64;
            f32x16 o[2]; o[0] = f32x16{}; o[1] = f32x16{};
            float carry = 0.f;
            const int tmax = blk * 4 + 3;
            const int tw = (blk * 256 + w * 32 + 31) >> 6;
            volatile LAS int* flag = (volatile LAS int*)(F.lds + LDSCTL_OFF + 12288);
            if (tid < 3) flag[tid] = 0;
            TileRegs R; tile_load(R, Kg, Vg, LDP, tmax * 64, tid);
            int slot = 0; bool wave_done = false;
            for (int t = tmax; t >= 0; --t) {
                tile_store(F.lds, slot, R, tid);
                if (t > 0) tile_load(R, Kg, Vg, LDP, (t - 1) * 64, tid);
                __syncthreads();
                if (t < tmax && flag[(t + 1) % 3] == 0) break;
                if (tid == 0) flag[(t + 2) % 3] = 0;
                if (!wave_done && t <= tw) {
                    f32x16 p0, p1;
                    qk_tile(p0, p1, (lptr)(F.lds + KS0 + slot * SLOT), qr, r32, hi);
                    sb_tile(p0, p1, carry, q - t * 64 - 4 * hi, hi);
                    pv_tile(o, (lptr)(F.lds + VS0 + slot * SLOT), p0, p1, lane);
                    if (__all(carry < -150.f)) wave_done = true;
                }
                if (!wave_done && lane == 0) flag[t % 3] = 1;
                slot ^= 1;
            }
            __syncthreads();
            store_ot(o, 1.0f, P.o + (size_t)(b * S + q) * D + 512 + h * 64, hi);
        }
    }
    asm volatile("" ::: "memory");
    for (int u = 512 + F.vcu; u < 1024; u += F.G) {
        {
            const int v = u - 512, b = v >> 6, hkv = (v >> 5) & 1, c = v & 31;
            const bf16* base = P.proj + (size_t)b * S * LDP;
            const int hh = hkv * 4 + (w >> 1), q = c * 64 + (w & 1) * 32 + r32;
            bf16x8 qr[4]; load_q(qr, base + (size_t)q * LDP + hh * 64, hi);
            const float sl = exp2f(-(float)(hh + 1)), s2 = sl * LOG2E;
            SoftState st; soft_reset(st);
            const int t0 = c - 2 < 0 ? 0 : c - 2;
            run_segment<true>(F, st, qr, base + 512 + hkv * 64, base + 640 + hkv * 64, LDP, tile_range(t0, c), s2, q,
                        [&](int t, int& klo, int& klim) { klim = q - t * 64 - 4 * hi; klo = klim - 128; });
            const float den = lane_swap_sum(st.l) + __builtin_amdgcn_exp2f(P.ev_sink[hh] * LOG2E - M0);
            store_ot(st.o, 1.0f / den, P.o + (size_t)(b * S + q) * D + hh * 64, hi);
        }
    }
}

DEV void fp_attn1(const Params& P, Frame& F) {
    using namespace att;
    const int lane = F.lane, r32 = lane & 31, hi = lane >> 5, w = F.wave;
    for (int u = F.vcu; u < 512; u += F.G) {
        {
            const int v = u & 255, bh = v >> 2, blk = (u < 256) ? (v & 3) : 7 - (v & 3);
            const int b = bh >> 3, h = bh & 7;
            const bf16* base = P.proj + (size_t)b * S * LDP;
            const int q = blk * 256 + w * 32 + r32;
            bf16x8 qr[4]; load_q(qr, base + (size_t)q * LDP + h * 64, hi);
            const float sl = exp2f(-(float)(h + 1)), s2 = sl * LOG2E;
            float gt[8];
#pragma unroll
            for (int n = 0; n < 8; ++n) {
                float g = 0.f;
                if (n < blk) {
                    const float* km = P.kmean + ((size_t)(b * 8 + h) * 8 + n) * 64;
#pragma unroll
                    for (int d0 = 0; d0 < 4; ++d0)
#pragma unroll
                        for (int j = 0; j < 8; ++j) g += bf2f((bf16)qr[d0][j]) * km[16 * d0 + 8 * hi + j];
                }
                g = lane_swap_sum(g);
                gt[n] = n < blk ? g : NEG;
            }
            unsigned sel = 0;
#pragma unroll
            for (int n = 0; n < 8; ++n) {
                int rank = 0;
#pragma unroll
                for (int k = 0; k < 8; ++k) rank += (gt[k] > gt[n] || (gt[k] == gt[n] && k < n)) ? 1 : 0;
                if (rank < 3 && n < blk) sel |= 1u << n;
            }
            SoftState st; soft_reset(st);
            run_segment<true>(F, st, qr, base + 512 + h * 64, base + 1024 + h * 64, LDP, tile_range(0, blk * 4 + 3), s2, q,
                        [&](int t, int& klo, int& klim) { const int n = t >> 2; klo = -1;
                            if (n < blk) klim = ((sel >> n) & 1) ? 63 : -1; else klim = q - t * 64 - 4 * hi; });
            const float l = lane_swap_sum(st.l);
            store_ot(st.o, 1.0f / l, P.o + (size_t)(b * S + q) * D + h * 64, hi);
        }
    }
    asm volatile("" ::: "memory");
    for (int u = 512 + F.vcu; u < 1024; u += F.G) {
        {
            const int v = u & 255, bk = v >> 4, c = (u < 768) ? (v & 15) : 31 - (v & 15);
            const int b = bk >> 1, hkv = bk & 1;
            const bf16* base = P.proj + (size_t)b * S * LDP;
            const int h = hkv * 4 + (w >> 1), q = c * 64 + (w & 1) * 32 + r32, t = b * S + q;
            bf16x8 qr[4]; load_q(qr, base + (size_t)q * LDP + 1536 + h * 64, hi);
            const float sl = exp2f(-(float)(h + 1)), s2 = sl * LOG2E;
            const bf16* grow = base + (size_t)q * LDP + 2816 + h * 3;
            LAS float* part = (LAS float*)(F.lds + SCR0);
            volatile LAS unsigned long long* tot = (volatile LAS unsigned long long*)(F.lds + SCR0 + 33792);
            volatile LAS unsigned* selm = (volatile LAS unsigned*)(F.lds + SCR0 + 33792 + 16896);
            f32x16 fin[2];
            {
                const int ntile = c >= 16 ? 2 : 1;
                const bf16* Kc = P.kvcmp + ((size_t)(0 * NB + b) * NCMP) * 128 + hkv * 64;
                const bf16* Vc = P.kvcmp + ((size_t)(1 * NB + b) * NCMP) * 128 + hkv * 64;
                { TileRegs R0; tile_load(R0, Kc, Vc, 128, 0, F.tid); tile_store(F.lds, 0, R0, F.tid); }
                if (ntile == 2) { TileRegs R1; tile_load(R1, Kc, Vc, 128, 64, F.tid); tile_store(F.lds, 1, R1, F.tid); }
                __syncthreads();
                const int nlim = (q - 31) >> 4;
                const float c1 = 0.125f * LOG2E, s16 = 16.0f * s2;
                const float basec = s2 * (float)(31 - q) + s16 * (float)(4 * hi);
                float lsum = 0.f;
                for (int tl = 0; tl < ntile; ++tl) {
                    f32x16 x0, x1; qk_tile(x0, x1, (lptr)(F.lds + KS0 + tl * SLOT), qr, r32, hi);
                    const int klim = nlim - 64 * tl - 4 * hi; const float bt = basec + s16 * (float)(64 * tl) - M0;
#pragma unroll
                    for (int r = 0; r < 16; ++r) {
                        const int kr = (r & 3) + 8 * (r >> 2);
                        lsum += kr <= klim ? __builtin_amdgcn_exp2f(fmaf(x0[r], c1, fmaf(s16, (float)kr, bt))) : 0.f;
                        lsum += kr + 32 <= klim ? __builtin_amdgcn_exp2f(fmaf(x1[r], c1, fmaf(s16, (float)(kr + 32), bt))) : 0.f;
                    }
                }
                lsum = lane_swap_sum(lsum);
                const float inv = nlim >= 0 ? 1.0f / lsum : 0.f;
                fin[0] = f32x16{}; fin[1] = f32x16{};
                LAS float* prow = part + ((w >> 1) * 64 + (w & 1) * 32 + r32) * 33;
                float peprev = 0.f;
                for (int tl = 0; tl < ntile; ++tl) {
                    f32x16 x0, x1; qk_tile(x0, x1, (lptr)(F.lds + KS0 + tl * SLOT), qr, r32, hi);
                    const int klim = nlim - 64 * tl - 4 * hi; const float bt = basec + s16 * (float)(64 * tl) - M0;
#pragma unroll
                    for (int r = 0; r < 16; ++r) {
                        const int kr = (r & 3) + 8 * (r >> 2);
                        x0[r] = kr <= klim ? __builtin_amdgcn_exp2f(fmaf(x0[r], c1, fmaf(s16, (float)kr, bt))) * inv : 0.f;
                        x1[r] = kr + 32 <= klim ? __builtin_amdgcn_exp2f(fmaf(x1[r], c1, fmaf(s16, (float)(kr + 32), bt))) * inv : 0.f;
                    }
#pragma unroll
                    for (int ix = 0; ix < 8; ++ix) {
                        const int g = ix & 3;
                        const float C = (ix < 4) ? (x0[4 * g] + x0[4 * g + 1]) + (x0[4 * g + 2] + x0[4 * g + 3]) : (x1[4 * g] + x1[4 * g + 1]) + (x1[4 * g + 2] + x1[4 * g + 3]);
                        const float pe = lane_partner((ix < 4) ? x0[4 * g + 3] : x1[4 * g + 3], hi);
                        prow[2 * (8 * tl + ix) + hi] = C + (hi ? pe : peprev);
                        peprev = pe;
                    }
                    pv_tile(fin, (lptr)(F.lds + VS0 + tl * SLOT), x0, x1, lane);
                }
                { const float g0 = 1.0f / (1.0f + __expf(-bf2f(grow[0])));
#pragma unroll
                for (int r = 0; r < 16; ++r) { fin[0][r] *= g0; fin[1][r] *= g0; } }
            }
            __syncthreads();
            {
                const int ql = F.tid >> 3, jg = F.tid & 7;
#pragma unroll
                for (int jj = 0; jj < 4; ++jj) {
                    const int j = 4 * jg + jj;
                    float sc = ((part[(0 * 64 + ql) * 33 + j] + part[(1 * 64 + ql) * 33 + j]) + part[(2 * 64 + ql) * 33 + j]) + part[(3 * 64 + ql) * 33 + j];
                    const bool forced = (j == 0) || (j == c) || (j == c - 1);
                    sc = (j <= c) ? sc + (forced ? 1000.0f : 0.0f) : NEG;
                    const unsigned ub = f2u(sc), ord = ub ^ ((ub >> 31) ? 0xffffffffu : 0x80000000u);
                    tot[ql * 33 + j] = ((unsigned long long)ord << 32) | (unsigned)(31 - j);
                }
                __syncthreads();
                unsigned long long mine[4];
#pragma unroll
                for (int jj = 0; jj < 4; ++jj) mine[jj] = tot[ql * 33 + 4 * jg + jj];
                int rank[4] = {0, 0, 0, 0};
                for (int k = 0; k < 32; ++k) {
                    const unsigned long long sk = tot[ql * 33 + k];
#pragma unroll
                    for (int jj = 0; jj < 4; ++jj) rank[jj] += (sk > mine[jj]) ? 1 : 0;
                }
                unsigned bits = 0;
#pragma unroll
                for (int jj = 0; jj < 4; ++jj) if (rank[jj] < 16 && 4 * jg + jj <= c) bits |= 1u << (4 * jg + jj);
                bits |= __shfl_xor(bits, 1); bits |= __shfl_xor(bits, 2); bits |= __shfl_xor(bits, 4);
                if (jg == 0) selm[ql] = bits;
                unsigned ub = bits; ub |= __shfl_xor(ub, 8); ub |= __shfl_xor(ub, 16); ub |= __shfl_xor(ub, 32);
                if (lane == 0) selm[64 + w] = ub;
            }
            __syncthreads();
            const unsigned mask = selm[(w & 1) * 32 + r32];
            const unsigned umask = ((selm[64] | selm[65]) | (selm[66] | selm[67])) | ((selm[68] | selm[69]) | (selm[70] | selm[71]));
            __syncthreads();
            LAS float* stg = (LAS float*)(F.lds + SCR0) + w * 2048 + lane;
#pragma unroll
            for (int r = 0; r < 16; ++r) { stg[r * 64] = fin[0][r]; stg[(16 + r) * 64] = fin[1][r]; }
            SoftState st; soft_reset(st);
            run_segment<false>(F, st, qr, base + 2304 + hkv * 64, base + 2432 + hkv * 64, LDP, (unsigned long long)umask, s2, q,
                        [&](int tt, int& klo, int& klim) { klo = -1; klim = ((mask >> tt) & 1) ? (q - tt * 64 - 4 * hi) : -1; });
            { const float g1 = 1.0f / (1.0f + __expf(-bf2f(grow[1]))); const float f = g1 / lane_swap_sum(st.l);
#pragma unroll
              for (int r = 0; r < 16; ++r) { stg[r * 64] += f * st.o[0][r]; stg[(16 + r) * 64] += f * st.o[1][r]; } }
            soft_reset(st);
            run_segment<true>(F, st, qr, base + 2560 + hkv * 64, base + 2688 + hkv * 64, LDP, tile_range(c - 8 < 0 ? 0 : c - 8, c), s2, q,
                        [&](int tt, int& klo, int& klim) { klim = q - tt * 64 - 4 * hi; klo = klim - 512; });
            { const float g2 = 1.0f / (1.0f + __expf(-bf2f(grow[2]))); const float f = g2 / lane_swap_sum(st.l);
#pragma unroll
              for (int r = 0; r < 16; ++r) { st.o[0][r] = stg[r * 64] + f * st.o[0][r]; st.o[1][r] = stg[(16 + r) * 64] + f * st.o[1][r]; } }
            store_ot(st.o, 1.0f, P.o + (size_t)t * D + 512 + h * 64, hi);
            __syncthreads();
        }
    }
}
enum { PH_PRE = 0, PH_INPROJ0, PH_ATTN0, PH_OUTPROJ0, PH_ROUTE0, PH_FFN0, PH_COMBINE0, PH_INPROJ1, PH_PREP1, PH_ATTN1, PH_OUTPROJ1, PH_ROUTE1, PH_FFN1, PH_COMBINE1, PH_COUNT };
struct FArgs { Params p; };

#ifndef PROBE_PHASE
#define PROBE_PHASE -1
#endif
constexpr int STAMP_OFF = LDSCTL_OFF + 1024;
constexpr int HN_OFF = LDSCTL_OFF + 2048;
DEV void stampk(Frame& F, int k) {
    if (PROBE_PHASE >= 0 && F.tid == 0) ((volatile LAS unsigned*)(F.lds + STAMP_OFF))[k] = (unsigned)__builtin_amdgcn_s_memrealtime() | 1u;
}
__global__ void __launch_bounds__(NWAVES * 64, 2) k_fast(FArgs args) {
    extern __shared__ __attribute__((aligned(16))) unsigned char lds[];
    const Params& P = args.p;
    Frame F;
    F.lds = (LAS unsigned char*)lds;
    F.MISC = (volatile LAS unsigned*)(F.lds + MISC_OFF);
    F.tid = threadIdx.x; F.lane = F.tid & 63; F.wave = __builtin_amdgcn_readfirstlane(F.tid >> 6);
    F.G = gridDim.x; { const int bx = blockIdx.x; F.vcu = (F.G % 8 == 0) ? (bx % 8) * (F.G / 8) + bx / 8 : bx; }
    for (int u = F.tid; u < (LDS_BYTES - LDSCTL_OFF) / 4; u += NWAVES * 64) ((LAS unsigned*)(F.lds + LDSCTL_OFF))[u] = 0u;
    __syncthreads();
    XcdBarrier bar = xcd_barrier_post(P.ctl + CW_BAR, F.MISC + 8);
#define BEGIN(k) refresh(F); stampk(F, (k));
#define SEAM() do { refresh(F); xcd_barrier(bar, F.tid); } while (0)
    { BEGIN(PH_PRE) fp_convert_weights(P, F, 0, F.vcu, F.G); fp_prep_router(P, F); fp_norm_rows(F, P.x, P.ev_norm, P.xn); if (F.G != 256) { fp_convert_weights(P, F, 1, F.vcu, F.G); fp_prep_compress(P, F, F.vcu, F.G); } SEAM(); }
    { BEGIN(PH_INPROJ0) const int cq = F.vcu >> 2, cr = F.vcu & 3, gi = 3 * cq + cr;
      if (F.G == 256 && cr == 3) fp_convert_moe_part(P, F, 0, cq, 64);
      else { pg8::StaticOrder So; So.init(P.xn, P.win0t, T, EVEN_IN, D, F.G == 256 ? 192 : F.G, F.G == 256 ? gi : F.vcu);
        pg8::EpiProjNorm<0> E{P.proj, LDP, P.ev_q_norm, P.ev_k_norm, nullptr, nullptr, nullptr, (PG8_LAS float*)(F.lds + HN_OFF)};
        pg8::gemm_phase(F.lds, D, So, E, F.tid); if (F.G != 256) { refresh(F); fp_convert_moe_part(P, F, 0, F.vcu, F.G); } }
      SEAM(); }
    { BEGIN(PH_ATTN0) fp_attn0(P, F); SEAM(); }
    { BEGIN(PH_OUTPROJ0) pg8::StaticOrder So; So.init(P.o, P.wout0t, T, D, D, F.G, (int)blockIdx.x);
      pg8::EpiResidF32 E{P.x, P.out, D}; pg8::gemm_phase(F.lds, D, So, E, F.tid); SEAM(); }
    { BEGIN(PH_ROUTE0) fp_route(P, F, 0); SEAM(); }
    { BEGIN(PH_FFN0) const int cq = F.vcu >> 2, cr = F.vcu & 3, gi = 3 * cq + cr;
      if (F.G == 256 && cr == 3) { fp_convert_weights(P, F, 1, cq, 64); fp_prep_compress(P, F, cq, 64); fp_convert_moe_part(P, F, 1, cq, 64); }
      else if (F.G == 256) fp_moe_fused(P, F, 0, gi, 192);
      else { fp_moe_fused(P, F, 0, F.vcu, F.G); refresh(F); fp_convert_moe_part(P, F, 1, F.vcu, F.G); }
      SEAM(); }
    { BEGIN(PH_COMBINE0) fp_combine(P, F, 0, P.od_norm, P.xn); SEAM(); }
    { BEGIN(PH_INPROJ1) pg8::StaticOrder So; So.init(P.xn, P.win1t, T, LDP, D, F.G, (int)blockIdx.x);
      pg8::EpiProjNorm<1> E{P.proj, LDP, P.od_c_q_norm, P.od_c_k_norm, P.od_d_q_norm, P.od_d_k_norm + 64, P.od_d_k_norm + 128, (PG8_LAS float*)(F.lds + HN_OFF)};
      pg8::gemm_phase(F.lds, D, So, E, F.tid); SEAM(); }
    { BEGIN(PH_PREP1) fp_prep1(P, F); SEAM(); }
    { BEGIN(PH_ATTN1) fp_attn1(P, F); SEAM(); }
    { BEGIN(PH_OUTPROJ1) pg8::StaticOrder So; So.init(P.o, P.wout1t, T, D, D, F.G, (int)blockIdx.x);
      pg8::EpiResidF32 E{P.out, P.out, D}; pg8::gemm_phase(F.lds, D, So, E, F.tid); SEAM(); }
    { BEGIN(PH_ROUTE1) fp_route(P, F, 1); SEAM(); }
    { BEGIN(PH_FFN1) fp_moe_fused(P, F, 1, F.vcu, F.G); SEAM(); }
    { BEGIN(PH_COMBINE1) fp_combine(P, F, 1, nullptr, nullptr); }
    if (PROBE_PHASE >= 0) {
        refresh(F);
        if (F.vcu == 0 && F.tid == 0) {
            volatile LAS unsigned* st = (volatile LAS unsigned*)(F.lds + STAMP_OFF);
            const unsigned t1 = (PROBE_PHASE + 1 < PH_COUNT) ? st[(PROBE_PHASE + 1 < PH_COUNT) ? PROBE_PHASE + 1 : 0] : ((unsigned)__builtin_amdgcn_s_memrealtime() | 1u);
            const unsigned t0 = st[PROBE_PHASE < 0 ? 0 : PROBE_PHASE];
            asm volatile("s_waitcnt vmcnt(0)" ::: "memory");
#ifndef PROBE_SCALE
#define PROBE_SCALE 0.01f
#endif
            P.out[0] += (float)(t1 - t0) * PROBE_SCALE;
        }
    }
#undef BEGIN
#undef SEAM
}

static size_t carve(Params& p, void* d_ws) {
    char* w = (char*)d_ws;
    p.ctl = (unsigned*)w;
    p.win0t = (bf16*)(w + 1 * MiB);
    p.wout0t = (bf16*)(w + 6 * MiB);
    p.win1t = (bf16*)(w + 8 * MiB);
    p.wout1t = (bf16*)(w + 14 * MiB);
    p.wgut[0] = (bf16*)(w + 16 * MiB);
    p.wdt[0] = (bf16*)(w + 48 * MiB);
    p.proj = (bf16*)(w + 64 * MiB);
    p.ha = (bf16*)(w + 64 * MiB);
    p.xn = (bf16*)(w + 160 * MiB);
    p.o = (bf16*)(w + 192 * MiB);
    p.hid = (bf16*)(w + 192 * MiB);
    size_t off = 224 * MiB;
    auto take = [&](size_t bytes) { char* r = w + off; off = (off + bytes + 255) & ~(size_t)255; return r; };
    p.rstd = (float*)take((size_t)T * 4);
    p.eid = (int*)take((size_t)T * 2 * 4);
    p.ew = (float*)take((size_t)T * 2 * 4);
    p.kmean = (float*)take((size_t)NB * 8 * 8 * 64 * 4);
    p.kvcmp = (bf16*)take((size_t)2 * NB * 128 * 2 * 64 * 2);
    p.pos = (int*)take((size_t)T * 2 * 4);
    p.wr = (bf16*)take((size_t)2 * 2 * 48 * D * 2);
    p.wcmpt = (bf16*)take((size_t)2 * 64 * 2048 * 2);
    p.cbias = (float*)take((size_t)128 * 4);
    p.wgut[1] = (bf16*)(w + 228 * MiB);
    p.wdt[1] = (bf16*)(w + 260 * MiB);
    p.rowtok = (int*)(w + 276 * MiB);
    return off > 228 * MiB ? (size_t)1 << 40 : 278 * MiB;
}

extern "C" void kernel_launch(void* const* d_in, const int* in_sizes, int n_in, void* d_out, int out_size, void* d_ws, size_t ws_size,
                              hipStream_t stream) {
    Params p{};
    const float** f = (const float**)&p;
    for (int i = 0; i < 24; ++i) f[i] = (const float*)d_in[i];
    p.out = (float*)d_out;
    const size_t need = carve(p, d_ws);
    static int grid = 0;
    if (grid == 0) {
        int dev = 0, cus = 0, per_cu = 0;
        if (hipGetDevice(&dev) != hipSuccess || hipDeviceGetAttribute(&cus, hipDeviceAttributeMultiprocessorCount, dev) != hipSuccess) { grid = -1; return; }
        if (hipFuncSetAttribute((const void*)k_fast, hipFuncAttributeMaxDynamicSharedMemorySize, LDS_BYTES) != hipSuccess) { fprintf(stderr, "hipFuncSetAttribute failed\n"); grid = -1; return; }
        if (hipOccupancyMaxActiveBlocksPerMultiprocessor(&per_cu, (const void*)k_fast, NWAVES * 64, LDS_BYTES) != hipSuccess || per_cu < 1) { fprintf(stderr, "occupancy query: %d\n", per_cu); (void)hipGetLastError(); grid = -1; return; }
        grid = cus;
        if (need > ws_size) { fprintf(stderr, "workspace too small: need %zu have %zu\n", need, ws_size); grid = -1; return; }
    }
    if (grid < 0) return;
    (void)hipMemsetAsync(d_ws, 0, CTL_ZERO_BYTES, stream);
    FArgs a{}; a.p = p;
    hipLaunchKernelGGL(k_fast, dim3(grid), dim3(NWAVES * 64), LDS_BYTES, stream, a);
}
```

```cpp
#include <hip/hip_runtime.h>
#include <cstdio>
#include <cstdint>
#define DEV __device__ __forceinline__

#ifndef NB
#define NB 8
#endif
typedef unsigned short bf16;
constexpr int S = 2048, D = 1024, T = NB * S, HD = 64;
constexpr int EVEN_IN = 2304, ODD_IN = 2840, LDP = 3072;
constexpr int NCMP = 127, NSLC = 32;
constexpr float NEG = -1e30f;
constexpr float EPS = 1e-6f;
constexpr int RMAX = 2 * T + 32 * 256;

DEV float u2f(unsigned u) { return __builtin_bit_cast(float, u); }
DEV unsigned f2u(float f) { return __builtin_bit_cast(unsigned, f); }
DEV float bf2f(bf16 h) { return u2f(((unsigned)h) << 16); }
DEV bf16 f2bf(float f) { unsigned u = f2u(f); u += 0x7fffu + ((u >> 16) & 1u); return (bf16)(u >> 16); }

constexpr size_t MiB_ = (size_t)1 << 20;
__host__ __device__ constexpr size_t al256c(size_t x) { return (x + 255) & ~(size_t)255; }
constexpr size_t WS_CTL = 0, WS_WIN0T = 1 * MiB_, WS_WOUT0T = 6 * MiB_, WS_WIN1T = 8 * MiB_, WS_WOUT1T = 14 * MiB_, WS_WGUT0 = 16 * MiB_, WS_WDT0 = 48 * MiB_,
                 WS_PROJ = 64 * MiB_  , WS_XN = 160 * MiB_, WS_O = 192 * MiB_  ,
                 WS_RSTD = 224 * MiB_, WS_EID = al256c(WS_RSTD + (size_t)T * 4), WS_EW = al256c(WS_EID + (size_t)T * 8), WS_KMEAN = al256c(WS_EW + (size_t)T * 8),
                 WS_KVCMP = al256c(WS_KMEAN + (size_t)NB * 8 * 8 * 64 * 4), WS_POS = al256c(WS_KVCMP + (size_t)2 * NB * 128 * 2 * 64 * 2), WS_WR = al256c(WS_POS + (size_t)T * 8),
                 WS_WCMPT = al256c(WS_WR + (size_t)2 * 2 * 48 * D * 2), WS_CBIAS = al256c(WS_WCMPT + (size_t)2 * 64 * 2048 * 2), WS_MISC_END = al256c(WS_CBIAS + 512),
                 WS_WGUT1 = 228 * MiB_, WS_WDT1 = 260 * MiB_, WS_ROWTOK = 276 * MiB_, WS_END = 278 * MiB_;
static_assert(WS_MISC_END <= WS_WGUT1, "misc region overflows");
struct Params {
    const float *x, *ev_norm, *ev_w_in, *ev_q_norm, *ev_k_norm, *ev_sink, *ev_w_out;
    const float *od_norm, *od_w_in, *od_c_q_norm, *od_c_k_norm, *od_d_q_norm, *od_d_k_norm, *od_cmp_pos, *od_cmp_w, *od_w_out;
    const float *moe_norm, *moe_w_grp, *moe_b_grp, *moe_w_exp, *moe_b_exp, *moe_w_gate, *moe_w_up, *moe_w_down;
    float* out;
    char* ws;
    DEV unsigned* ctl() const { return (unsigned*)(ws + WS_CTL); }
    DEV bf16* win0t() const { return (bf16*)(ws + WS_WIN0T); }
    DEV bf16* wout0t() const { return (bf16*)(ws + WS_WOUT0T); }
    DEV bf16* win1t() const { return (bf16*)(ws + WS_WIN1T); }
    DEV bf16* wout1t() const { return (bf16*)(ws + WS_WOUT1T); }
    DEV bf16* wgut(int l) const { return (bf16*)(ws + (l ? WS_WGUT1 : WS_WGUT0)); }
    DEV bf16* wdt(int l) const { return (bf16*)(ws + (l ? WS_WDT1 : WS_WDT0)); }
    DEV bf16* proj() const { return (bf16*)(ws + WS_PROJ); }
    DEV bf16* ha() const { return (bf16*)(ws + WS_PROJ); }
    DEV bf16* xn() const { return (bf16*)(ws + WS_XN); }
    DEV bf16* o() const { return (bf16*)(ws + WS_O); }
    DEV bf16* hid() const { return (bf16*)(ws + WS_O); }
    DEV float* rstd() const { return (float*)(ws + WS_RSTD); }
    DEV int* eid() const { return (int*)(ws + WS_EID); }
    DEV float* ew() const { return (float*)(ws + WS_EW); }
    DEV float* kmean() const { return (float*)(ws + WS_KMEAN); }
    DEV bf16* kvcmp() const { return (bf16*)(ws + WS_KVCMP); }
    DEV int* pos() const { return (int*)(ws + WS_POS); }
    DEV bf16* wr() const { return (bf16*)(ws + WS_WR); }
    DEV bf16* wcmpt() const { return (bf16*)(ws + WS_WCMPT); }
    DEV float* cbias() const { return (float*)(ws + WS_CBIAS); }
    DEV int* rowtok() const { return (int*)(ws + WS_ROWTOK); }
};


namespace pg8 {
#define PG8_LAS __attribute__((address_space(3)))
typedef unsigned short bf16_t;
typedef short bf16x8 __attribute__((ext_vector_type(8)));
typedef float f32x4 __attribute__((ext_vector_type(4)));
typedef unsigned u32x4 __attribute__((ext_vector_type(4)));
constexpr int BM = 256, BK = 64, HALF = 128, HTB = HALF * BK * 2, STAGE_BYTES = 8 * HTB, NXCD = 8, WGM = 8;

__host__ __device__ __forceinline__ int lds_byte(int r, int c) { const int st = (r >> 4) * 2 + (c >> 5), rr = r & 15, cc = c & 31, ob = rr * 64 + cc * 2; return st * 1024 + (ob ^ (((ob >> 9) & 1) << 5)); }
__host__ __device__ __forceinline__ void stage_rc(int b, int& R, int& C) { const int st = b / 1024, sb = b % 1024, swz = sb ^ (((sb >> 9) & 1) << 5); R = (st >> 1) * 16 + swz / 64; C = (st & 1) * 32 + (swz % 64) / 2; }
__host__ __device__ __forceinline__ int perm32(int rho) { const int n = rho >> 4, i = rho & 15; return 8 * (i >> 2) + 4 * n + (i & 3); }

struct Unit { const char* A; const char* B; int pm, pn; };

struct StaticOrder {
    int nM, nN, nwg, G, c; const char* A; const char* Bt; size_t tstep;
    __device__ void init(const bf16_t* A_, const bf16_t* Bt_, int M, int N, int K, int G_, int c_) { nM = M / BM; nN = N / BM; nwg = nM * nN; G = G_; c = c_; A = (const char*)A_; Bt = (const char*)Bt_; tstep = (size_t)BM * K * 2; }
    __device__ bool next(int i, Unit& u) const {
        const long L = (long)i * G + c; if (L >= nwg) return false;
        int wgid = (int)L; { const int q = nwg / NXCD, r = nwg % NXCD, xcd = wgid % NXCD, off = wgid / NXCD; wgid = (xcd < r ? xcd * (q + 1) : r * (q + 1) + (xcd - r) * q) + off; }
        const int nig = WGM * nN, gid = wgid / nig, fm = gid * WGM, gsz = (nM - fm) < WGM ? (nM - fm) : WGM;
        u.pm = fm + ((wgid % nig) % gsz); u.pn = (wgid % nig) / gsz; u.A = A + (size_t)u.pm * tstep; u.B = Bt + (size_t)u.pn * tstep; return true;
    }
};

__device__ __forceinline__ unsigned cvt_pk_bf16(float lo, float hi) { unsigned r; asm volatile("v_cvt_pk_bf16_f32 %0, %1, %2" : "=v"(r) : "v"(lo), "v"(hi)); return r; }

struct EpiStoreBf16 {
    static constexpr bool PERM = true;
    bf16_t* O; int ldc;
    __device__ __forceinline__ void operator()(const f32x4 (&acc)[2][2][4][2], const Unit& u, int wr, int wc, int fr, int fq) const {
        const int row0 = u.pm * BM + wr * 64 + fr, col0 = u.pn * BM + wc * 32 + 8 * fq;
#pragma unroll
        for (int ai = 0; ai < 2; ++ai)
#pragma unroll
            for (int m = 0; m < 4; ++m) { bf16_t* rowp = O + (size_t)(row0 + ai * HALF + m * 16) * ldc + col0;
#pragma unroll
                for (int bj = 0; bj < 2; ++bj) { const f32x4 v0 = acc[ai][bj][m][0], v1 = acc[ai][bj][m][1];
                    u32x4 w; w.x = cvt_pk_bf16(v0[0], v0[1]); w.y = cvt_pk_bf16(v0[2], v0[3]); w.z = cvt_pk_bf16(v1[0], v1[1]); w.w = cvt_pk_bf16(v1[2], v1[3]);
                    *(u32x4*)(rowp + bj * HALF) = w; } }
    }
};

template <int LAYER> struct EpiProjNorm {
    static constexpr bool PERM = true;
    bf16_t* O; int ldc; const float *g0, *g1, *g2, *g3, *g4; PG8_LAS float* hn;
    __device__ __forceinline__ const float* gain_of(int H) const {
        if (LAYER == 0) return H < 8 ? g0 : (H < 10 ? g1 : nullptr);
        return H < 8 ? g0 : H < 16 ? g1 : (H >= 24 && H < 32) ? g2 : (H == 36 || H == 37) ? g3 : (H == 40 || H == 41) ? g4 : nullptr;
    }
    __device__ __forceinline__ void operator()(f32x4 (&acc)[2][2][4][2], const Unit& u, int wr, int wc, int fr, int fq) const {
        const bool any = (LAYER == 0) ? (u.pn < 3) : (u.pn < 4 || u.pn == 6 || u.pn == 7 || u.pn == 9 || u.pn == 10);
        if (any) {
#pragma unroll
            for (int ai = 0; ai < 2; ++ai)
#pragma unroll
                for (int m = 0; m < 4; ++m)
#pragma unroll
                    for (int bj = 0; bj < 2; ++bj) {
                        const f32x4 a = acc[ai][bj][m][0], b = acc[ai][bj][m][1];
                        float ss = (a[0] * a[0] + a[1] * a[1]) + (a[2] * a[2] + a[3] * a[3]) + (b[0] * b[0] + b[1] * b[1]) + (b[2] * b[2] + b[3] * b[3]);
                        ss += __shfl_xor(ss, 16); ss += __shfl_xor(ss, 32);
                        if (fq == 0) hn[(ai * HALF + wr * 64 + m * 16 + fr) * 8 + bj * 4 + wc] = ss;
                    }
        }
        asm volatile("s_waitcnt lgkmcnt(0)" ::: "memory"); __builtin_amdgcn_s_barrier(); asm volatile("" ::: "memory");
        const int row0 = u.pm * BM + wr * 64 + fr, col0 = u.pn * BM + wc * 32 + 8 * fq;
#pragma unroll
        for (int bj = 0; bj < 2; ++bj) {
            const float* g = gain_of(4 * u.pn + 2 * bj + (wc >> 1));
            f32x4 ga = (f32x4){1.f, 1.f, 1.f, 1.f}, gb = ga;
            if (g) { ga = *(const f32x4*)(g + (wc & 1) * 32 + 8 * fq); gb = *(const f32x4*)(g + (wc & 1) * 32 + 8 * fq + 4); }
#pragma unroll
            for (int ai = 0; ai < 2; ++ai)
#pragma unroll
                for (int m = 0; m < 4; ++m) {
                    f32x4 v0 = acc[ai][bj][m][0], v1 = acc[ai][bj][m][1];
                    if (g) { const int rl = (ai * HALF + wr * 64 + m * 16 + fr) * 8 + bj * 4;
                        const float r = 1.0f / sqrtf((hn[rl + wc] + hn[rl + (wc ^ 1)]) * (1.0f / 64) + 1e-6f);
                        v0 = v0 * ga * r; v1 = v1 * gb * r; }
                    u32x4 w; w.x = cvt_pk_bf16(v0[0], v0[1]); w.y = cvt_pk_bf16(v0[2], v0[3]); w.z = cvt_pk_bf16(v1[0], v1[1]); w.w = cvt_pk_bf16(v1[2], v1[3]);
                    *(u32x4*)(O + (size_t)(row0 + ai * HALF + m * 16) * ldc + col0 + bj * HALF) = w;
                }
        }
    }
};
struct EpiResidF32 {
    static constexpr bool PERM = true;
    const float* R; float* O; int ldc;
    __device__ __forceinline__ void operator()(const f32x4 (&acc)[2][2][4][2], const Unit& u, int wr, int wc, int fr, int fq) const {
        const int row0 = u.pm * BM + wr * 64 + fr, col0 = u.pn * BM + wc * 32 + 8 * fq;
#pragma unroll
        for (int ai = 0; ai < 2; ++ai)
#pragma unroll
            for (int m = 0; m < 4; ++m) { const size_t ro = (size_t)(row0 + ai * HALF + m * 16) * ldc + col0;
#pragma unroll
                for (int bj = 0; bj < 2; ++bj) {
                    const f32x4 r0 = *(const f32x4*)(R + ro + bj * HALF), r1 = *(const f32x4*)(R + ro + bj * HALF + 4);
                    *(f32x4*)(O + ro + bj * HALF) = r0 + acc[ai][bj][m][0]; *(f32x4*)(O + ro + bj * HALF + 4) = r1 + acc[ai][bj][m][1]; } }
    }
};
struct EpiSiluMul {
    static constexpr bool PERM = true;
    bf16_t* H; int ldh;
    __device__ __forceinline__ void operator()(const f32x4 (&acc)[2][2][4][2], const Unit& u, int wr, int wc, int fr, int fq) const {
        const int row0 = u.pm * BM + wr * 64 + fr, col0 = u.pn * HALF + wc * 32 + 8 * fq;
#pragma unroll
        for (int ai = 0; ai < 2; ++ai)
#pragma unroll
            for (int m = 0; m < 4; ++m) { bf16_t* rowp = H + (size_t)(row0 + ai * HALF + m * 16) * ldh + col0;
                float h[8];
#pragma unroll
                for (int n = 0; n < 2; ++n)
#pragma unroll
                    for (int j = 0; j < 4; ++j) { const float g = acc[ai][0][m][n][j], up = acc[ai][1][m][n][j]; h[n * 4 + j] = g * up * __builtin_amdgcn_rcpf(1.0f + __expf(-g)); }
                u32x4 w; w.x = cvt_pk_bf16(h[0], h[1]); w.y = cvt_pk_bf16(h[2], h[3]); w.z = cvt_pk_bf16(h[4], h[5]); w.w = cvt_pk_bf16(h[6], h[7]);
                *(u32x4*)rowp = w; }
    }
};

template <class Epi, class Sched, bool GATHER = false>
__device__ __forceinline__ void gemm_phase(PG8_LAS unsigned char* lds, const int K, const Sched& S, const Epi& E, const int wave_, unsigned g00 = 0, unsigned g01 = 0, unsigned g10 = 0, unsigned g11 = 0) {
    int lane; asm volatile("v_mbcnt_lo_u32_b32 %0, -1, 0\n\tv_mbcnt_hi_u32_b32 %0, -1, %0" : "=v"(lane));
    const int wid = __builtin_amdgcn_readfirstlane(wave_), tid = wid * 64 + lane, wr = wid >> 2, wc = wid & 3, fr = lane & 15, fq = lane >> 4;
    const int nt = K / BK;
    unsigned voffA[2], voffB[2], voffA1[2];
#pragma unroll
    for (int i = 0; i < 2; ++i) { int R, C; stage_rc(tid * 16 + i * 8192, R, C); const int Rb = Epi::PERM ? ((R & ~31) + perm32(R & 31)) : R;
        voffA[i] = (unsigned)(R * K + C) * 2u; voffB[i] = (unsigned)(Rb * K + C) * 2u; voffA1[i] = voffA[i];
        if (GATHER) { voffA[i] = (i ? g01 : g00) + (unsigned)C * 2u; voffA1[i] = (i ? g11 : g10) + (unsigned)C * 2u; } }
    const size_t kstep = (size_t)(BK * 2);
    const size_t hstep = (size_t)HALF * K * 2;
    const size_t hstepA = GATHER ? (size_t)0 : hstep;
    const unsigned ldsw = (unsigned)wid * 1024u;
    const int aoff = lds_byte(wr * 64 + fr, fq * 8), boff = lds_byte(wc * 32 + fr, fq * 8);
#define PG8_SA(b, h) (((b) * 2 + (h)) * HTB)
#define PG8_SB(b, h) ((4 + (b) * 2 + (h)) * HTB)
#define PG8_STAGE(bufoff, gbase, voff) do { _Pragma("unroll") for (int _i = 0; _i < 2; ++_i) \
        __builtin_amdgcn_global_load_lds((const unsigned*)((const char*)(gbase) + (voff)[_i]), (PG8_LAS unsigned*)(lds + (bufoff) + ldsw + _i * 8192), 16, 0, 0); } while (0)
#define PG8_LDA(dst, b, h) do { _Pragma("unroll") for (int m = 0; m < 4; ++m) _Pragma("unroll") for (int k = 0; k < 2; ++k) dst[m][k] = *(const PG8_LAS bf16x8*)(lds + PG8_SA(b, h) + aoff + m * 2048 + k * 1024); } while (0)
#define PG8_LDB(dst, b, h) do { _Pragma("unroll") for (int n = 0; n < 2; ++n) _Pragma("unroll") for (int k = 0; k < 2; ++k) dst[n][k] = *(const PG8_LAS bf16x8*)(lds + PG8_SB(b, h) + boff + n * 2048 + k * 1024); } while (0)
#define PG8_MMA(ai, bj, At, Bt) do { __builtin_amdgcn_s_setprio(1); _Pragma("unroll") for (int m = 0; m < 4; ++m) _Pragma("unroll") for (int n = 0; n < 2; ++n) _Pragma("unroll") for (int k = 0; k < 2; ++k) \
        acc[ai][bj][m][n] = __builtin_amdgcn_mfma_f32_16x16x32_bf16(Bt[n][k], At[m][k], acc[ai][bj][m][n], 0, 0, 0); __builtin_amdgcn_s_setprio(0); } while (0)
#define PG8_WAIT_V(n) asm volatile("s_waitcnt vmcnt(" #n ")" ::: "memory")
#define PG8_WAIT_L(n) asm volatile("s_waitcnt lgkmcnt(" #n ")" ::: "memory")
#define PG8_BAR __builtin_amdgcn_s_barrier()
#define PG8_SCHED __builtin_amdgcn_sched_barrier(0)
    Unit cur, nxt; int ui = 0;
    if (!S.next(0, cur)) return;
    f32x4 acc[2][2][4][2];
#pragma unroll
    for (int a = 0; a < 2; ++a)
#pragma unroll
        for (int b = 0; b < 2; ++b)
#pragma unroll
            for (int m = 0; m < 4; ++m)
#pragma unroll
                for (int n = 0; n < 2; ++n) acc[a][b][m][n] = (f32x4){0.f, 0.f, 0.f, 0.f};
    bf16x8 At[4][2], B0[2][2], B1[2][2];
    const char* cA = cur.A; const char* cB = cur.B;
    PG8_STAGE(PG8_SB(0, 0), cB, voffB); PG8_STAGE(PG8_SB(0, 1), cB + hstep, voffB); PG8_STAGE(PG8_SA(0, 0), cA, voffA); PG8_STAGE(PG8_SA(0, 1), cA + hstepA, voffA1);
    if (wr == 1) PG8_BAR;
    PG8_WAIT_V(2); PG8_BAR;
    PG8_STAGE(PG8_SB(1, 0), cB + kstep, voffB); PG8_STAGE(PG8_SA(1, 0), cA + kstep, voffA); PG8_STAGE(PG8_SB(1, 1), cB + hstep + kstep, voffB);
    PG8_WAIT_V(6); PG8_BAR;
    for (;;) {
        const bool has_next = S.next(ui + 1, nxt);
        const char* nA = has_next ? nxt.A : cA; const char* nB = has_next ? nxt.B : cB;
        for (int t = 0; t < nt; t += 2) {
            const bool last = (t == nt - 2);
            const char* a1 = cA + (size_t)(t + 1) * kstep;
            const char* a2 = last ? nA : cA + (size_t)(t + 2) * kstep; const char* b2 = last ? nB : cB + (size_t)(t + 2) * kstep;
            const char* a3 = a2 + kstep; const char* b3 = b2 + kstep;
            PG8_LDB(B0, 0, 0); PG8_LDB(B1, 0, 1); PG8_SCHED; PG8_LDA(At, 0, 0); PG8_STAGE(PG8_SA(1, 1), a1 + hstepA, voffA1);
            PG8_WAIT_V(8); PG8_WAIT_L(0); PG8_BAR; PG8_MMA(0, 0, At, B0); PG8_MMA(0, 1, At, B1); PG8_BAR; PG8_SCHED;
            PG8_LDA(At, 0, 1); PG8_STAGE(PG8_SB(0, 0), b2, voffB); PG8_STAGE(PG8_SB(0, 1), b2 + hstep, voffB); PG8_STAGE(PG8_SA(0, 0), a2, voffA);
            PG8_WAIT_V(8); PG8_WAIT_L(0); PG8_BAR; PG8_MMA(1, 0, At, B0); PG8_MMA(1, 1, At, B1); PG8_BAR; PG8_SCHED;
            PG8_LDB(B0, 1, 0); PG8_LDB(B1, 1, 1); PG8_SCHED; PG8_LDA(At, 1, 0); PG8_STAGE(PG8_SA(0, 1), a2 + hstepA, voffA1);
            PG8_WAIT_V(8); PG8_WAIT_L(0); PG8_BAR; PG8_MMA(0, 0, At, B0); PG8_MMA(0, 1, At, B1); PG8_BAR; PG8_SCHED;
            PG8_LDA(At, 1, 1); PG8_STAGE(PG8_SB(1, 0), b3, voffB); PG8_STAGE(PG8_SB(1, 1), b3 + hstep, voffB); PG8_STAGE(PG8_SA(1, 0), a3, voffA);
            PG8_WAIT_V(8); PG8_WAIT_L(0); PG8_BAR; PG8_MMA(1, 0, At, B0); PG8_MMA(1, 1, At, B1); PG8_BAR; PG8_SCHED;
        }
        if (wr == 0) PG8_BAR;
        { int l2; asm volatile("v_mbcnt_lo_u32_b32 %0, -1, 0\n\tv_mbcnt_hi_u32_b32 %0, -1, %0" : "=v"(l2)); E(acc, cur, wr, wc, l2 & 15, l2 >> 4); }
        if (!has_next) break;
#pragma unroll
        for (int a = 0; a < 2; ++a)
#pragma unroll
            for (int b = 0; b < 2; ++b)
#pragma unroll
                for (int m = 0; m < 4; ++m)
#pragma unroll
                    for (int n = 0; n < 2; ++n) acc[a][b][m][n] = (f32x4){0.f, 0.f, 0.f, 0.f};
        cur = nxt; cA = nA; cB = nB; ++ui;
        if (wr == 1) PG8_BAR;
    }
    PG8_WAIT_V(0);
    PG8_BAR;
#undef PG8_SA
#undef PG8_SB
#undef PG8_STAGE
#undef PG8_LDA
#undef PG8_LDB
#undef PG8_MMA
#undef PG8_WAIT_V
#undef PG8_WAIT_L
#undef PG8_BAR
#undef PG8_SCHED
}
}

#define GAS __attribute__((address_space(1)))
#define LAS __attribute__((address_space(3)))
typedef unsigned v4u __attribute__((ext_vector_type(4)));
typedef float f32x4 __attribute__((ext_vector_type(4)));
typedef short bf16x8 __attribute__((ext_vector_type(8)));
constexpr int NWAVES = 8;
constexpr int RING_BYTES = 131072, LDSCTL_OFF = RING_BYTES, MISC_OFF = LDSCTL_OFF + 320, LDS_BYTES = 147456;
constexpr size_t MiB = 1u << 20;
constexpr size_t CTL_ZERO_BYTES = 1 * MiB;
constexpr int CW_BAR = 4096;
constexpr int CW_MOE = 65536;
#define LDS_WAIT() asm volatile("s_waitcnt lgkmcnt(0)" ::: "memory")
#define VM_WAIT() asm volatile("s_waitcnt vmcnt(0)" ::: "memory")
DEV unsigned pk2(float lo, float hi) { return (unsigned)f2bf(lo) | ((unsigned)f2bf(hi) << 16); }

#define XB_TMO      128
#define XB_XCNT(j)  (256  + 64 * (j))
#define XB_XSUB(j)  (1280 + 64 * (j))
#define XB_XGEN(j)  (2304 + 64 * (j))
#define XB_TOP      3328
#define XB_TOPGEN   3392
#define XCD_BAR_WORDS 3456
#define XB_SPIN_CAP (1u << 22)
DEV unsigned xb_ld(unsigned* p)              { return __hip_atomic_load(p, __ATOMIC_RELAXED, __HIP_MEMORY_SCOPE_AGENT); }
DEV unsigned xb_add(unsigned* p, unsigned v) { return __hip_atomic_fetch_add(p, v, __ATOMIC_RELAXED, __HIP_MEMORY_SCOPE_AGENT); }
DEV unsigned xb_xcc_id() { return (unsigned)__builtin_amdgcn_s_getreg((3 << 11) | 20) & 0xFu; }
#define XB_SPIN(cond, bar) do { unsigned _sp = 0; while (cond) { __builtin_amdgcn_s_sleep(1); \
    if ((++_sp & 255u) == 0u) { if (xb_ld(&(bar)[XB_TMO])) break; if (_sp > XB_SPIN_CAP) { atomicAdd(&(bar)[XB_TMO], 1u); break; } } } } while (0)
struct XcdBarrier { unsigned* bar; unsigned x; volatile LAS unsigned* st; };
DEV XcdBarrier xcd_barrier_post(unsigned* bar, volatile LAS unsigned* st) {
    XcdBarrier b; b.bar = bar; b.x = xb_xcc_id(); b.st = st;
    if (threadIdx.x == 0) (void)xb_add(&bar[XB_XCNT(b.x)], 1u);
    return b;
}
DEV void xcd_barrier_complete(unsigned* bar, unsigned x, unsigned& nloc, unsigned& nx) {
    const unsigned G = gridDim.x * gridDim.y * gridDim.z;
    unsigned sum, cnt, mine, sp = 0u;
    for (;;) {
        sum = 0u; cnt = 0u; mine = 0u;
#pragma unroll
        for (unsigned j = 0; j < 16; ++j) { const unsigned c = xb_ld(&bar[XB_XCNT(j)]); sum += c; cnt += (c > 0u) ? 1u : 0u; mine = (j == x) ? c : mine; }
        if (sum == G) break;
        __builtin_amdgcn_s_sleep(1);
        if ((++sp & 255u) == 0u) { if (xb_ld(&bar[XB_TMO])) break; if (sp > XB_SPIN_CAP) { atomicAdd(&bar[XB_TMO], 1u); break; } }
    }
    nloc = mine > 0u ? mine : 1u; nx = cnt > 0u ? cnt : 1u;
}
DEV void xcd_barrier(const XcdBarrier& b, const int tid_) {
    asm volatile("s_waitcnt vmcnt(0)" ::: "memory");
    __syncthreads();
    if (tid_ == 0) {
        unsigned* bar = b.bar;
        __builtin_amdgcn_s_waitcnt(0);
        unsigned nloc = b.st[0], nx = b.st[1];
        if (nloc == 0u) { xcd_barrier_complete(bar, b.x, nloc, nx); b.st[0] = nloc; b.st[1] = nx; }
        const unsigned old = xb_add(&bar[XB_XSUB(b.x)], 1u);
        const unsigned gen = old / nloc;
        if (old + 1u == (gen + 1u) * nloc) {
            __builtin_amdgcn_fence(__ATOMIC_RELEASE, "agent");
            asm volatile("s_waitcnt vmcnt(0)" ::: "memory");
            const unsigned og = xb_add(&bar[XB_TOP], 1u);
            const unsigned tg = og / nx;
            if (og + 1u == (tg + 1u) * nx) xb_add(&bar[XB_TOPGEN], 1u);
            else XB_SPIN(xb_ld(&bar[XB_TOPGEN]) == tg, bar);
            __builtin_amdgcn_fence(__ATOMIC_ACQUIRE, "agent");
            xb_add(&bar[XB_XGEN(b.x)], 1u);
            asm volatile("s_waitcnt vmcnt(0)" ::: "memory");
        } else {
            XB_SPIN(xb_ld(&bar[XB_XGEN(b.x)]) == gen, bar);
            __builtin_amdgcn_fence(__ATOMIC_ACQUIRE, "agent");
            asm volatile("s_waitcnt vmcnt(0)" ::: "memory");
        }
    }
    __syncthreads();
}

struct Frame {
    LAS unsigned char* lds;
    volatile LAS unsigned* MISC;
    int tid, lane, wave;
    int vcu, G;
};

DEV void refresh(Frame& F) { int l; asm volatile("v_mbcnt_lo_u32_b32 %0, -1, 0\n\tv_mbcnt_hi_u32_b32 %0, -1, %0" : "=v"(l)); F.lane = l; F.tid = F.wave * 64 + l; }
DEV int fresh_lane() { int l; asm volatile("v_mbcnt_lo_u32_b32 %0, -1, 0\n\tv_mbcnt_hi_u32_b32 %0, -1, %0" : "=v"(l)); return l; }
DEV float wave_sum(float v) {
#pragma unroll
    for (int o = 1; o < 64; o <<= 1) v += __shfl_xor(v, o);
    return v;
}
DEV void transpose_item(const float* W, int K, int N, bf16* WT, int k0, int n0, int dst_row0, LAS float* scr, int lane) {
    const int c4 = lane & 7, r0 = lane >> 3;
    const bool okc = (n0 + 4 * c4) < N;
    f32x4 v[8];
#pragma unroll
    for (int i = 0; i < 8; ++i) v[i] = okc ? *(const GAS f32x4*)(W + (size_t)(k0 + r0 + 8 * i) * N + n0 + 4 * c4) : (f32x4){0.f, 0.f, 0.f, 0.f};
#pragma unroll
    for (int i = 0; i < 8; ++i) { LAS float* d = scr + (r0 + 8 * i) * 33 + 4 * c4; d[0] = v[i].x; d[1] = v[i].y; d[2] = v[i].z; d[3] = v[i].w; }
    LDS_WAIT(); asm volatile("" ::: "memory");
    const int c = lane & 7;
#pragma unroll
    for (int j = 0; j < 4; ++j) { const int n = (lane >> 3) + 8 * j; const LAS float* s = scr + (8 * c) * 33 + n;
        v4u o; o.x = pk2(s[0 * 33], s[1 * 33]); o.y = pk2(s[2 * 33], s[3 * 33]); o.z = pk2(s[4 * 33], s[5 * 33]); o.w = pk2(s[6 * 33], s[7 * 33]);
        if (n0 + n < N) *(GAS v4u*)(WT + (size_t)(dst_row0 + n) * K + k0 + 8 * c) = o; }
    LDS_WAIT(); asm volatile("" ::: "memory");
}
DEV float rms_row_to_bf16(int lane, const float* xrow, const float* gain, bf16* orow) {
    const GAS f32x4* xr = (const GAS f32x4*)xrow + lane;
    const GAS f32x4* gr = (const GAS f32x4*)gain + lane;
    f32x4 v[4]; float s = 0.f;
#pragma unroll
    for (int j = 0; j < 4; ++j) { v[j] = xr[64 * j]; s += (v[j].x * v[j].x + v[j].y * v[j].y) + (v[j].z * v[j].z + v[j].w * v[j].w); }
    const float rstd = 1.0f / sqrtf(wave_sum(s) * (1.f / D) + EPS);
    GAS unsigned long long* o8 = (GAS unsigned long long*)orow + lane;
#pragma unroll
    for (int j = 0; j < 4; ++j) { const f32x4 g = gr[64 * j];
        o8[64 * j] = (unsigned long long)pk2(v[j].x * rstd * g.x, v[j].y * rstd * g.y) | ((unsigned long long)pk2(v[j].z * rstd * g.z, v[j].w * rstd * g.w) << 32); }
    return rstd;
}

DEV void fp_convert_weights(const Params& P, Frame& F, int which, int ci, int n) {
    LAS float* scr = (LAS float*)(F.lds + F.wave * 16384);
    const int gw = ci * NWAVES + F.wave, NGW = n * NWAVES;
    constexpr int I_IN0 = 16 * 72, I_OUT = 16 * 32, I_IN1 = 16 * 89;
    if (which == 0) {
        for (int it = gw; it < I_IN0 + I_OUT; it += NGW) {
            int r = it;
            if (r < I_IN0) { const int kb = r / 72, nb = r % 72; transpose_item(P.ev_w_in, D, EVEN_IN, P.win0t(), 64 * kb, 32 * nb, 32 * nb, scr, F.lane); continue; } r -= I_IN0;
            { const int kb = r / 32, nb = r % 32; transpose_item(P.ev_w_out, D, D, P.wout0t(), 64 * kb, 32 * nb, 32 * nb, scr, F.lane); }
        }
    } else {
        for (int it = gw; it < I_IN1 + I_OUT; it += NGW) {
            int r = it;
            if (r < I_IN1) { const int kb = r / 89, nb = r % 89; transpose_item(P.od_w_in, D, ODD_IN, P.win1t(), 64 * kb, 32 * nb, 32 * nb, scr, F.lane); continue; } r -= I_IN1;
            { const int kb = r / 32, nb = r % 32; transpose_item(P.od_w_out, D, D, P.wout1t(), 64 * kb, 32 * nb, 32 * nb, scr, F.lane); }
        }
    }
}
DEV void fp_norm_rows(Frame& F, const float* src, const float* gain, bf16* xn) {
    const int gw = F.vcu * NWAVES + F.wave, NGW = F.G * NWAVES;
    for (int m = gw; m < T; m += NGW) rms_row_to_bf16(F.lane, src + (size_t)m * D, gain, xn + (size_t)m * D);
}

constexpr int TAB_OFF = MISC_OFF + 128;
constexpr int RT_PART_OFF = 0;
constexpr int RT_SS_OFF = 98304;
constexpr int RT_HIST_OFF = 100352;
typedef float f32x4v __attribute__((ext_vector_type(4)));

DEV void fp_prep_router(const Params& P, Frame& F) {
    const int gtid = F.vcu * NWAVES * 64 + F.tid, gsz = F.G * NWAVES * 64;
    for (int i = gtid; i < 2 * 48 * D; i += gsz) {
        const int k = i & (D - 1), j = (i >> 10) % 48, l = i / (48 * D);
        float w = 0.f;
        if (j < 4) w = P.moe_w_grp[((size_t)l * D + k) * 4 + j]; else if (j < 36) w = P.moe_w_exp[((size_t)l * D + k) * 32 + (j - 4)];
        w *= P.moe_norm[l * D + k];
        const bf16 hi = f2bf(w); const bf16 lo = f2bf(w - bf2f(hi));
        P.wr()[((size_t)(l * 2 + 0) * 48 + j) * D + k] = hi;
        P.wr()[((size_t)(l * 2 + 1) * 48 + j) * D + k] = lo;
    }
}

DEV void fp_route(const Params& P, Frame& F, int layer) {
    const int lane = F.lane, w = F.wave;
    const bf16* wr_hi = P.wr() + (size_t)(layer * 2 + 0) * 48 * D;
    const bf16* wr_lo = P.wr() + (size_t)(layer * 2 + 1) * 48 * D;
    LAS float* part = (LAS float*)(F.lds + RT_PART_OFF);
    LAS float* ssp = (LAS float*)(F.lds + RT_SS_OFF);
    LAS unsigned* hist = (LAS unsigned*)(F.lds + RT_HIST_OFF);
    unsigned* cnt = P.ctl() + CW_MOE + layer * 256;
    for (int tb = F.vcu; tb < T / 64; tb += F.G) {
        const int t0 = tb * 64;
        if (F.tid < 64) hist[F.tid] = 0u;
        const float* xrow = P.out + (size_t)(t0 + (lane & 15)) * D + 128 * w + 8 * (lane >> 4);
        const size_t boff = (size_t)(lane & 15) * D + 128 * w + 8 * (lane >> 4);
        pg8::f32x4 acc[4][3];
        float ss[4] = {0.f, 0.f, 0.f, 0.f};
#pragma unroll
        for (int g = 0; g < 4; ++g)
#pragma unroll
            for (int c = 0; c < 3; ++c) acc[g][c] = (pg8::f32x4){0.f, 0.f, 0.f, 0.f};
#pragma unroll 1
        for (int ks = 0; ks < 4; ++ks) {
            bf16x8 bh[3], bl[3];
#pragma unroll
            for (int c = 0; c < 3; ++c) { bh[c] = *(const bf16x8*)(wr_hi + boff + (size_t)16 * c * D + 32 * ks); bl[c] = *(const bf16x8*)(wr_lo + boff + (size_t)16 * c * D + 32 * ks); }
            f32x4v xa[4], xb[4];
#pragma unroll
            for (int g = 0; g < 4; ++g) { xa[g] = *(const f32x4v*)(xrow + (size_t)16 * g * D + 32 * ks); xb[g] = *(const f32x4v*)(xrow + (size_t)16 * g * D + 32 * ks + 4); }
#pragma unroll
            for (int g = 0; g < 4; ++g) {
                float xv[8] = {xa[g].x, xa[g].y, xa[g].z, xa[g].w, xb[g].x, xb[g].y, xb[g].z, xb[g].w};
                bf16x8 ah, al;
#pragma unroll
                for (int j = 0; j < 8; ++j) { ss[g] += xv[j] * xv[j]; const bf16 h = f2bf(xv[j]); ah[j] = (short)h; al[j] = (short)f2bf(xv[j] - bf2f(h)); }
#pragma unroll
                for (int c = 0; c < 3; ++c) {
                    acc[g][c] = __builtin_amdgcn_mfma_f32_16x16x32_bf16(ah, bh[c], acc[g][c], 0, 0, 0);
                    acc[g][c] = __builtin_amdgcn_mfma_f32_16x16x32_bf16(ah, bl[c], acc[g][c], 0, 0, 0);
                    acc[g][c] = __builtin_amdgcn_mfma_f32_16x16x32_bf16(al, bh[c], acc[g][c], 0, 0, 0);
                }
            }
        }
#pragma unroll
        for (int g = 0; g < 4; ++g) {
            float s = ss[g]; s += __shfl_xor(s, 16); s += __shfl_xor(s, 32);
            if (lane < 16) ssp[w * 64 + 16 * g + lane] = s;
#pragma unroll
            for (int c = 0; c < 3; ++c)
#pragma unroll
                for (int r = 0; r < 4; ++r) part[(w * 64 + 16 * g + 4 * (lane >> 4) + r) * 48 + 16 * c + (lane & 15)] = acc[g][c][r];
        }
        __syncthreads();
        for (int i = F.tid; i < 64 * 48; i += NWAVES * 64) { float a = part[i];
#pragma unroll
            for (int ww = 1; ww < 8; ++ww) a += part[ww * 64 * 48 + i];
            part[i] = a; }
        if (F.tid < 64) { float a = ssp[F.tid];
#pragma unroll
            for (int ww = 1; ww < 8; ++ww) a += ssp[ww * 64 + F.tid];
            ssp[F.tid] = a; }
        __syncthreads();
        int e1 = 0, e2 = 0; float w1 = 0.f, w2 = 0.f; unsigned r1 = 0, r2 = 0;
        if (F.tid < 64) {
            const int t = t0 + F.tid;
            const float rs = 1.0f / sqrtf(ssp[F.tid] * (1.f / D) + EPS);
            P.rstd()[t] = rs;
            float lg[4], le[32];
#pragma unroll
            for (int j = 0; j < 4; ++j) lg[j] = part[F.tid * 48 + j] * rs + P.moe_b_grp[layer * 4 + j];
#pragma unroll
            for (int j = 0; j < 32; ++j) le[j] = part[F.tid * 48 + 4 + j] * rs + P.moe_b_exp[layer * 32 + j];
            int gs = 0; float gm = lg[0];
#pragma unroll
            for (int j = 1; j < 4; ++j) if (lg[j] > gm) { gm = lg[j]; gs = j; }
            float gz = 0.f;
#pragma unroll
            for (int j = 0; j < 4; ++j) gz += expf(lg[j] - gm);
            const float pg = 1.0f / gz;
            float wv[8];
#pragma unroll
            for (int j = 0; j < 8; ++j) wv[j] = gs == 0 ? le[j] : gs == 1 ? le[8 + j] : gs == 2 ? le[16 + j] : le[24 + j];
            int i1 = 0; float m1 = wv[0];
#pragma unroll
            for (int j = 1; j < 8; ++j) if (wv[j] > m1) { m1 = wv[j]; i1 = j; }
            int i2 = -1; float m2 = -3e38f;
#pragma unroll
            for (int j = 0; j < 8; ++j) if (j != i1 && wv[j] > m2) { m2 = wv[j]; i2 = j; }
            const float ex2 = expf(m2 - m1);
            w1 = pg / (1.0f + ex2); w2 = pg * ex2 / (1.0f + ex2);
            e1 = gs * 8 + i1; e2 = gs * 8 + i2;
            r1 = __hip_atomic_fetch_add(&hist[e1], 1u, __ATOMIC_RELAXED, __HIP_MEMORY_SCOPE_WORKGROUP); r2 = __hip_atomic_fetch_add(&hist[e2], 1u, __ATOMIC_RELAXED, __HIP_MEMORY_SCOPE_WORKGROUP);
        }
        __syncthreads();
        if (F.tid < 32) { const unsigned h = hist[F.tid]; hist[32 + F.tid] = h ? xb_add(&cnt[F.tid], h) : 0u; }
        __syncthreads();
        if (F.tid < 64) {
            const int t = t0 + F.tid;
            P.eid()[t * 2 + 0] = e1; P.eid()[t * 2 + 1] = e2; P.ew()[t * 2 + 0] = w1; P.ew()[t * 2 + 1] = w2;
            const int i1x = (int)(hist[32 + e1] + r1), i2x = (int)(hist[32 + e2] + r2);
            P.pos()[t * 2 + 0] = i1x; P.pos()[t * 2 + 1] = i2x;
            P.rowtok()[e1 * T + i1x] = t; P.rowtok()[e2 * T + i2x] = t;
        }
        for (int r = w; r < 64; r += NWAVES) rms_row_to_bf16(lane, P.out + (size_t)(t0 + r) * D, P.moe_norm + layer * D, P.xn() + (size_t)(t0 + r) * D);
        __syncthreads();
    }
}

DEV void moe_table(const Params& P, Frame& F, int layer) {
    volatile LAS int* tab = (volatile LAS int*)(F.lds + TAB_OFF);
    if (F.tid == 0) {
        unsigned* cnt = P.ctl() + CW_MOE + layer * 256;
        int acc = 0;
        for (int e = 0; e < 32; ++e) { tab[e] = acc; acc += (int)((xb_ld(&cnt[e]) + 255u) >> 8); }
        tab[32] = acc;
    }
    __syncthreads();
}

struct ListOrder {
    int code[4]; int n, npn; const char* A; const char* Bt; size_t tstep, bstep;
    __device__ __forceinline__ bool next(int i, pg8::Unit& o) const {
        if (i >= n) return false;
        const int c = (i == 0) ? code[0] : (i == 1) ? code[1] : (i == 2) ? code[2] : code[3];
        const int tt = c >> 8, e = (c >> 3) & 31, pn = c & 7;
        o.pm = tt; o.pn = pn; o.A = A + (size_t)tt * tstep; o.B = Bt + (size_t)(e * npn + pn) * bstep; return true;
    }
};
DEV void fp_moe_fused(const Params& P, Frame& F, int layer, int ci, int ncu) {
    moe_table(P, F, layer);
    volatile LAS int* tab = (volatile LAS int*)(F.lds + TAB_OFF);
    const int ntile = __builtin_amdgcn_readfirstlane(tab[32]);
#pragma unroll
    for (int rep = 0; rep < 2; ++rep) { const int tt = ci + rep * ncu; if (tt >= ntile) break;
        int e = 0;
        for (int q = 1; q < 32; ++q) e += (tt >= tab[q]) ? 1 : 0;
        e = __builtin_amdgcn_readfirstlane(e);
        const int cb = (tt << 8) | (e << 3);
        {
          const int rbase = e * T + (tt - tab[e]) * 256;
          unsigned g[2][2]; const int tid_ = F.wave * 64 + fresh_lane();
#pragma unroll
          for (int hh = 0; hh < 2; ++hh)
#pragma unroll
              for (int i = 0; i < 2; ++i) { int R, C; pg8::stage_rc(tid_ * 16 + i * 8192, R, C); int tk = P.rowtok()[rbase + hh * 128 + R]; tk = ((unsigned)tk < (unsigned)T) ? tk : 0; g[hh][i] = (unsigned)tk * (unsigned)(D * 2); }
          ListOrder L; L.tstep = 0; L.A = (const char*)P.xn(); L.Bt = (const char*)P.wgut(layer); L.npn = 2; L.n = 2; L.bstep = (size_t)256 * D * 2;
          L.code[0] = cb; L.code[1] = cb | 1; L.code[2] = 0; L.code[3] = 0;
          pg8::EpiSiluMul E{P.hid(), 256}; pg8::gemm_phase<pg8::EpiSiluMul, ListOrder, true>(F.lds, D, L, E, F.wave, g[0][0], g[0][1], g[1][0], g[1][1]); }
        if (F.wave == 0 && fresh_lane() == 0) { __builtin_amdgcn_fence(__ATOMIC_ACQUIRE, "agent"); asm volatile("s_waitcnt vmcnt(0)" ::: "memory"); }
        __syncthreads();
        { ListOrder L; L.tstep = (size_t)256 * 256 * 2; L.bstep = L.tstep; L.A = (const char*)P.hid(); L.Bt = (const char*)P.wdt(layer); L.npn = 4; L.n = 4;
          L.code[0] = cb; L.code[1] = cb | 1; L.code[2] = cb | 2; L.code[3] = cb | 3;
          pg8::EpiStoreBf16 E{P.ha(), D}; pg8::gemm_phase(F.lds, 256, L, E, F.wave); }
    }
}
DEV void fp_combine(const Params& P, Frame& F, int layer, const float* gain2, bf16* xn) {
    moe_table(P, F, layer);
    volatile LAS int* tab = (volatile LAS int*)(F.lds + TAB_OFF);
    const int gw = F.vcu * NWAVES + F.wave, NGW = F.G * NWAVES, lane = F.lane;
    int p1v = 0, p2v = 0; float w1v = 0.f, w2v = 0.f;
    { const int tj = gw + lane * NGW;
      if (tj < T) { p1v = tab[P.eid()[tj * 2]] * 256 + P.pos()[tj * 2]; p2v = tab[P.eid()[tj * 2 + 1]] * 256 + P.pos()[tj * 2 + 1]; w1v = P.ew()[tj * 2]; w2v = P.ew()[tj * 2 + 1]; } }
    int jj = 0;
    for (int t = gw; t < T; t += NGW, ++jj) {
        const int p1 = __builtin_amdgcn_readlane(p1v, jj), p2 = __builtin_amdgcn_readlane(p2v, jj);
        const float w1 = u2f((unsigned)__builtin_amdgcn_readlane((int)f2u(w1v), jj)), w2 = u2f((unsigned)__builtin_amdgcn_readlane((int)f2u(w2v), jj));
        GAS f32x4* xr = (GAS f32x4*)(P.out + (size_t)t * D) + lane;
        const GAS unsigned long long* y1 = (const GAS unsigned long long*)(P.ha() + (size_t)p1 * D) + lane;
        const GAS unsigned long long* y2 = (const GAS unsigned long long*)(P.ha() + (size_t)p2 * D) + lane;
        f32x4 v[4]; float s = 0.f;
#pragma unroll
        for (int j = 0; j < 4; ++j) {
            v[j] = xr[64 * j];
            const unsigned long long a = y1[64 * j], b = y2[64 * j];
            v[j].x += w1 * u2f((unsigned)(a & 0xffffu) << 16) + w2 * u2f((unsigned)(b & 0xffffu) << 16);
            v[j].y += w1 * u2f((unsigned)((a >> 16) & 0xffffu) << 16) + w2 * u2f((unsigned)((b >> 16) & 0xffffu) << 16);
            v[j].z += w1 * u2f((unsigned)((a >> 32) & 0xffffu) << 16) + w2 * u2f((unsigned)((b >> 32) & 0xffffu) << 16);
            v[j].w += w1 * u2f((unsigned)((a >> 48) & 0xffffu) << 16) + w2 * u2f((unsigned)((b >> 48) & 0xffffu) << 16);
            xr[64 * j] = v[j];
            s += (v[j].x * v[j].x + v[j].y * v[j].y) + (v[j].z * v[j].z + v[j].w * v[j].w);
        }
        if (xn) {
            const float rstd = 1.0f / sqrtf(wave_sum(s) * (1.f / D) + EPS);
            const GAS f32x4* gr = (const GAS f32x4*)gain2 + lane;
            GAS unsigned long long* o8 = (GAS unsigned long long*)(xn + (size_t)t * D) + lane;
#pragma unroll
            for (int j = 0; j < 4; ++j) { const f32x4 g = gr[64 * j];
                o8[64 * j] = (unsigned long long)pk2(v[j].x * rstd * g.x, v[j].y * rstd * g.y) | ((unsigned long long)pk2(v[j].z * rstd * g.z, v[j].w * rstd * g.w) << 32); }
        }
    }
}


DEV void fp_convert_moe_part(const Params& P, Frame& F, int layer, int ci, int nconv) {
    LAS float* scr = (LAS float*)(F.lds + F.wave * 16384);
    constexpr int NIT = 32 * 384;
    for (int it = ci * NWAVES + F.wave; it < NIT; it += nconv * NWAVES) {
        const int e = it / 384; int r = it % 384;
        const size_t eo = (size_t)(layer * 32 + e);
        if (r < 256) { const bool up = r >= 128; r &= 127; const int kb = r / 8, nb = r % 8; const int f0 = 32 * nb;
            const float* W = (up ? P.moe_w_up : P.moe_w_gate) + eo * D * 256;
            transpose_item(W, D, 256, P.wgut(layer) + (size_t)e * 512 * D, 64 * kb, f0, (f0 >> 7) * 256 + (up ? 128 : 0) + (f0 & 127), scr, F.lane);
        } else { r -= 256; const int kb = r / 32, nb = r % 32;
            transpose_item(P.moe_w_down + eo * 256 * D, 256, D, P.wdt(layer) + (size_t)e * D * 256, 64 * kb, 32 * nb, 32 * nb, scr, F.lane); }
    }
}
namespace att {
typedef float f32x16 __attribute__((ext_vector_type(16)));
typedef short s16x4 __attribute__((ext_vector_type(4)));
typedef short v4i16_t __attribute__((ext_vector_type(4)));
typedef LAS const char* lptr;
constexpr float LOG2E = 1.4426950408889634f;
constexpr int KS0 = 0, VS0 = 32768, SLOT = 8192;
constexpr int SCR0 = 65536;
constexpr float MNEG = -1e30f;

struct TileRegs { v4u k, v; };
DEV void tile_load(TileRegs& R, const bf16* Kg, const bf16* Vg, int pitch, int k0, int tid) {
    const int w = tid >> 6, lane = tid & 63;
    R.k = *(const GAS v4u*)(Kg + (size_t)(k0 + lane) * pitch + w * 8);
    R.v = *(const GAS v4u*)(Vg + (size_t)(k0 + 16 * (w & 3) + (lane >> 2)) * pitch + (w >> 2) * 32 + (lane & 3) * 8);
}
DEV void tile_store(LAS unsigned char* lds, int slot, const TileRegs& R, int tid) {
    *(LAS v4u*)(lds + KS0 + slot * SLOT + tid * 16) = R.k;
    *(LAS v4u*)(lds + VS0 + slot * SLOT + tid * 16) = R.v;
}
DEV void qk_tile(f32x16& p0, f32x16& p1, lptr Kslot, const bf16x8 (&qr)[4], int r32, int hi) {
    lptr kb = Kslot + hi * 1024 + r32 * 16;
    __builtin_amdgcn_s_setprio(1);
#pragma unroll
    for (int dh = 0; dh < 2; ++dh) {
        bf16x8 kf[4];
#pragma unroll
        for (int d1 = 0; d1 < 2; ++d1) { kf[2 * d1] = *(const LAS bf16x8*)(kb + (2 * dh + d1) * 2048); kf[2 * d1 + 1] = *(const LAS bf16x8*)(kb + (2 * dh + d1) * 2048 + 512); }
#pragma unroll
        for (int d1 = 0; d1 < 2; ++d1) {
            p0 = __builtin_amdgcn_mfma_f32_32x32x16_bf16(kf[2 * d1], qr[2 * dh + d1], p0, 0, 0, 0);
            p1 = __builtin_amdgcn_mfma_f32_32x32x16_bf16(kf[2 * d1 + 1], qr[2 * dh + d1], p1, 0, 0, 0);
        }
    }
    __builtin_amdgcn_s_setprio(0);
}
DEV void bias_init(f32x16& p0, f32x16& p1, float s, float base) {
#pragma unroll
    for (int r = 0; r < 16; ++r) { const int kr = (r & 3) + 8 * (r >> 2); p0[r] = fmaf(s, (float)kr, base); p1[r] = fmaf(s, (float)(kr + 32), base); }
}
DEV s16x4 vtr(lptr p) { return __builtin_bit_cast(s16x4, __builtin_amdgcn_ds_read_tr16_b64_v4i16((LAS v4i16_t*)p)); }
DEV unsigned cvtpk(float lo, float hi) { unsigned r; asm volatile("v_cvt_pk_bf16_f32 %0, %1, %2" : "=v"(r) : "v"(lo), "v"(hi)); return r; }
DEV void pv_tile(f32x16 (&o)[2], lptr Vslot, const f32x16& p0, const f32x16& p1, int lane) {
    const int hi = lane >> 5;
    lptr vp = Vslot + ((lane >> 4) & 1) * 32 + (lane & 3) * 8 + (4 * hi + ((lane & 15) >> 2)) * 64;
    bf16x8 pf[4];
#pragma unroll
    for (int ks = 0; ks < 4; ++ks) {
        const f32x16& p = (ks < 2) ? p0 : p1; const int b = (ks & 1) * 8;
        v4u w; w.x = cvtpk(p[b + 0], p[b + 1]); w.y = cvtpk(p[b + 2], p[b + 3]); w.z = cvtpk(p[b + 4], p[b + 5]); w.w = cvtpk(p[b + 6], p[b + 7]);
        pf[ks] = __builtin_bit_cast(bf16x8, w);
    }
    __builtin_amdgcn_s_setprio(1);
#pragma unroll
    for (int ks = 0; ks < 4; ++ks)
#pragma unroll
        for (int d0 = 0; d0 < 2; ++d0) {
            const s16x4 lo = vtr(vp + d0 * 4096 + ks * 1024), hh = vtr(vp + d0 * 4096 + ks * 1024 + 512);
            const bf16x8 vf = (bf16x8){lo[0], lo[1], lo[2], lo[3], hh[0], hh[1], hh[2], hh[3]};
            o[d0] = __builtin_amdgcn_mfma_f32_32x32x16_bf16(vf, pf[ks], o[d0], 0, 0, 0);
        }
    __builtin_amdgcn_s_setprio(0);
}
DEV float lane_swap_max(float m) {
    auto rr = __builtin_amdgcn_permlane32_swap(__float_as_uint(m), __float_as_uint(m), false, false);
    return fmaxf(__uint_as_float(rr[0]), __uint_as_float(rr[1]));
}
DEV float lane_swap_sum(float m) {
    auto rr = __builtin_amdgcn_permlane32_swap(__float_as_uint(m), __float_as_uint(m), false, false);
    return __uint_as_float(rr[0]) + __uint_as_float(rr[1]);
}
DEV float lane_partner(float m, int hi) {
    auto rr = __builtin_amdgcn_permlane32_swap(__float_as_uint(m), __float_as_uint(m), false, false);
    return hi ? __uint_as_float(rr[0]) : __uint_as_float(rr[1]);
}

constexpr float M0 = 16.0f;
struct SoftState { float l; f32x16 o[2]; };
DEV void soft_reset(SoftState& s) { s.l = 0.f; s.o[0] = f32x16{}; s.o[1] = f32x16{}; }

DEV void soft_tile(SoftState& st, f32x16& p0, f32x16& p1, int klo, int klim, bool need_mask, lptr Vslot, int lane) {
    float ls0 = 0.f, ls1 = 0.f;
    if (need_mask) {
#pragma unroll
        for (int r = 0; r < 16; ++r) {
            const int kr = (r & 3) + 8 * (r >> 2);
            const float x0 = __builtin_amdgcn_exp2f(p0[r]), x1 = __builtin_amdgcn_exp2f(p1[r]);
            p0[r] = (kr > klo && kr <= klim) ? x0 : 0.f; p1[r] = (kr + 32 > klo && kr + 32 <= klim) ? x1 : 0.f;
            ls0 += p0[r]; ls1 += p1[r];
        }
    } else {
#pragma unroll
        for (int r = 0; r < 16; ++r) { p0[r] = __builtin_amdgcn_exp2f(p0[r]); p1[r] = __builtin_amdgcn_exp2f(p1[r]); ls0 += p0[r]; ls1 += p1[r]; }
    }
    st.l += ls0 + ls1;
    pv_tile(st.o, Vslot, p0, p1, lane);
}

DEV void soft_pair_fast(SoftState& st, const bf16x8 (&qr)[4], lptr Ka, lptr Va, lptr Kb, lptr Vb, float s2, float baseA, float baseB, int lane) {
    const int r32 = lane & 31, hi = lane >> 5;
    f32x16 a0, a1, b0, b1;
    bias_init(a0, a1, s2, baseA); bias_init(b0, b1, s2, baseB);
    qk_tile(a0, a1, Ka, qr, r32, hi);
    qk_tile(b0, b1, Kb, qr, r32, hi);
    float ls0 = 0.f, ls1 = 0.f;
#pragma unroll
    for (int r = 0; r < 16; ++r) { a0[r] = __builtin_amdgcn_exp2f(a0[r]); a1[r] = __builtin_amdgcn_exp2f(a1[r]); ls0 += a0[r]; ls1 += a1[r]; }
    pv_tile(st.o, Va, a0, a1, lane);
#pragma unroll
    for (int r = 0; r < 16; ++r) { b0[r] = __builtin_amdgcn_exp2f(b0[r]); b1[r] = __builtin_amdgcn_exp2f(b1[r]); ls0 += b0[r]; ls1 += b1[r]; }
    st.l += ls0 + ls1;
    pv_tile(st.o, Vb, b0, b1, lane);
}

DEV void store_ot(const f32x16 (&o)[2], float f, bf16* orow, int hi) {
#pragma unroll
    for (int d0 = 0; d0 < 2; ++d0)
#pragma unroll
        for (int g = 0; g < 4; ++g) {
            const unsigned a = cvtpk(o[d0][4 * g] * f, o[d0][4 * g + 1] * f), b = cvtpk(o[d0][4 * g + 2] * f, o[d0][4 * g + 3] * f);
            *(GAS unsigned long long*)(orow + 32 * d0 + 8 * g + 4 * hi) = (unsigned long long)a | ((unsigned long long)b << 32);
        }
}
DEV void load_q(bf16x8 (&qr)[4], const bf16* qrow, int hi) {
    const float c1 = 0.125f * LOG2E;
#pragma unroll
    for (int d0 = 0; d0 < 4; ++d0) {
        const v4u x = *(const GAS v4u*)(qrow + 16 * d0 + 8 * hi);
        v4u y;
        y.x = pk2(u2f(x.x << 16) * c1, u2f(x.x & 0xffff0000u) * c1); y.y = pk2(u2f(x.y << 16) * c1, u2f(x.y & 0xffff0000u) * c1);
        y.z = pk2(u2f(x.z << 16) * c1, u2f(x.z & 0xffff0000u) * c1); y.w = pk2(u2f(x.w << 16) * c1, u2f(x.w & 0xffff0000u) * c1);
        qr[d0] = __builtin_bit_cast(bf16x8, y);
    }
}

template <bool FAST, class MaskF>
DEV void run_segment(Frame& F, SoftState& st, const bf16x8 (&qr)[4], const bf16* Kg, const bf16* Vg, int pitch, unsigned long long tmask, float s2, int qpos, const MaskF& mf) {
    const int tid = F.tid, lane = F.lane, r32 = lane & 31, hi = lane >> 5;
    if (tmask == 0ull) return;
#define NEXT_TILE(var) do { if (tmask) { var = __builtin_ctzll(tmask); tmask &= tmask - 1ull; } else var = -1; } while (0)
#define SEG_COMPUTE(t, slot) do { int klo, klim; mf((t), klo, klim); \
        if (__any(klim >= 0 && klo < 60 && klim > klo)) { const bool need_mask = __any(klo >= 0 || klim < 60); f32x16 p0, p1; \
            bias_init(p0, p1, s2, s2 * (float)((t) * 64 - qpos + 4 * hi) - M0); \
            qk_tile(p0, p1, (lptr)(F.lds + KS0 + (slot) * SLOT), qr, r32, hi); \
            soft_tile(st, p0, p1, klo, klim, need_mask, (lptr)(F.lds + VS0 + (slot) * SLOT), lane); } } while (0)
    int ta, tb, tc, td, set = 0;
    NEXT_TILE(ta); NEXT_TILE(tb);
    TileRegs RA, RB; tile_load(RA, Kg, Vg, pitch, ta * 64, tid); if (tb >= 0) tile_load(RB, Kg, Vg, pitch, tb * 64, tid);
    for (;;) {
        tile_store(F.lds, 2 * set, RA, tid); if (tb >= 0) tile_store(F.lds, 2 * set + 1, RB, tid);
        NEXT_TILE(tc); NEXT_TILE(td);
        if (tc >= 0) tile_load(RA, Kg, Vg, pitch, tc * 64, tid);
        if (td >= 0) tile_load(RB, Kg, Vg, pitch, td * 64, tid);
        __syncthreads();
        bool fast = false;
        if (FAST && tb >= 0) {
            int kloA, klimA, kloB, klimB; mf(ta, kloA, klimA); mf(tb, kloB, klimB);
            const bool fullA = klimA >= 59 && kloA < 0, noneA = klimA < 0 || kloA >= 59 || klimA <= kloA;
            const bool fullB = klimB >= 59 && kloB < 0, noneB = klimB < 0 || kloB >= 59 || klimB <= kloB;
            fast = __all((fullA || noneA) && (fullB || noneB)) && __any(fullA) && __any(fullB);
            if (fast) {
                const float hb = (float)(4 * hi - qpos);
                const float baseA = fullA ? s2 * ((float)(ta * 64) + hb) - M0 : MNEG, baseB = fullB ? s2 * ((float)(tb * 64) + hb) - M0 : MNEG;
                soft_pair_fast(st, qr, (lptr)(F.lds + KS0 + (2 * set) * SLOT), (lptr)(F.lds + VS0 + (2 * set) * SLOT), (lptr)(F.lds + KS0 + (2 * set + 1) * SLOT), (lptr)(F.lds + VS0 + (2 * set + 1) * SLOT), s2, baseA, baseB, lane);
            }
        }
        if (!fast) {
            SEG_COMPUTE(ta, 2 * set);
            if (tb >= 0) SEG_COMPUTE(tb, 2 * set + 1);
        }
        if (tc < 0) break;
        ta = tc; tb = td; set ^= 1;
    }
    __syncthreads();
#undef NEXT_TILE
#undef SEG_COMPUTE
}
DEV unsigned long long tile_range(int t0, int t1) { return (t1 < t0) ? 0ull : ((~0ull >> (63 - (t1 - t0))) << t0); }
}

DEV void headnorm_group(bf16* row, int off, int nheads, const float* g, int lane) {
    const int hg = lane >> 3, ch = lane & 7;
    if (hg < nheads) {
        GAS v4u* p = (GAS v4u*)(row + off + hg * 64 + ch * 8);
        const v4u x = *p;
        float v[8] = {u2f(x.x << 16), u2f(x.x & 0xffff0000u), u2f(x.y << 16), u2f(x.y & 0xffff0000u), u2f(x.z << 16), u2f(x.z & 0xffff0000u), u2f(x.w << 16), u2f(x.w & 0xffff0000u)};
        float ss = 0.f;
#pragma unroll
        for (int j = 0; j < 8; ++j) ss += v[j] * v[j];
        ss += __shfl_xor(ss, 1); ss += __shfl_xor(ss, 2); ss += __shfl_xor(ss, 4);
        const float r = 1.0f / sqrtf(ss * (1.0f / 64) + EPS);
        const f32x4 g0 = *(const GAS f32x4*)(g + ch * 8), g1 = *(const GAS f32x4*)(g + ch * 8 + 4);
        v4u o; o.x = pk2(v[0] * r * g0.x, v[1] * r * g0.y); o.y = pk2(v[2] * r * g0.z, v[3] * r * g0.w); o.z = pk2(v[4] * r * g1.x, v[5] * r * g1.y); o.w = pk2(v[6] * r * g1.z, v[7] * r * g1.w);
        *p = o;
    }
}
DEV void fp_headnorm(const Params& P, Frame& F, int layer) {
    const int gw = F.vcu * NWAVES + F.wave, NGW = F.G * NWAVES, lane = F.lane;
    for (int t = gw; t < T; t += NGW) {
        bf16* row = P.proj() + (size_t)t * LDP;
        if (layer == 0) {
            headnorm_group(row, 0, 8, P.ev_q_norm, lane);
            headnorm_group(row, 512, 2, P.ev_k_norm, lane);
        } else {
            headnorm_group(row, 0, 8, P.od_c_q_norm, lane);
            headnorm_group(row, 512, 8, P.od_c_k_norm, lane);
            headnorm_group(row, 1536, 8, P.od_d_q_norm, lane);
            headnorm_group(row, 2304, 2, P.od_d_k_norm + 64, lane);
            headnorm_group(row, 2560, 2, P.od_d_k_norm + 128, lane);
        }
    }
}

DEV void fp_prep_compress(const Params& P, Frame& F, int ci, int n) {
    const int gw = ci * NWAVES + F.wave, NGW = n * NWAVES, lane = F.lane;
    for (int i = gw; i < 128; i += NGW) {
        const int which = i >> 6, e = i & 63;
        const float* pos = P.od_cmp_pos + which * 2048; const float* w = P.od_cmp_w + (size_t)which * 2048 * 64 + e;
        float s = 0.f;
        for (int k = lane; k < 2048; k += 64) s += pos[k] * w[(size_t)k * 64];
        s = wave_sum(s);
        if (lane == 0) P.cbias()[i] = s;
    }
    LAS float* scr = (LAS float*)(F.lds + F.wave * 16384);
    for (int i = gw; i < 128; i += NGW) {
        const int which = i >> 6, r = i & 63, kb = r >> 1, nb = r & 1;
        transpose_item(P.od_cmp_w + (size_t)which * 2048 * 64, 2048, 64, P.wcmpt() + (size_t)which * 64 * 2048, 64 * kb, 32 * nb, 32 * nb, scr, lane);
    }
}

DEV void fp_prep1(const Params& P, Frame& F) {
    const int gw = F.vcu * NWAVES + F.wave, NGW = F.G * NWAVES, lane = F.lane, w = F.wave;
    for (int i = gw; i < NB * 64; i += NGW) {
        const int n = i & 7, h = (i >> 3) & 7, b = i >> 6;
        const bf16* kp = P.proj() + ((size_t)b * S + n * 256) * LDP + 512 + h * 64 + lane;
        float s0 = 0.f, s1 = 0.f, s2 = 0.f, s3 = 0.f;
#pragma unroll 4
        for (int j = 0; j < 256; j += 4) { s0 += bf2f(kp[(size_t)j * LDP]); s1 += bf2f(kp[(size_t)(j + 1) * LDP]); s2 += bf2f(kp[(size_t)(j + 2) * LDP]); s3 += bf2f(kp[(size_t)(j + 3) * LDP]); }
        P.kmean()[(size_t)i * 64 + lane] = ((s0 + s1) + (s2 + s3)) * (1.0f / 256);
    }
    LAS float* part = (LAS float*)F.lds;
    for (int it = F.vcu; it < 2 * NB * 2 * 8; it += F.G) {
        const int ng = it & 7, hkv = (it >> 3) & 1, b = (it >> 4) % NB, which = it / (16 * NB);
        const int n = 16 * ng + (lane & 15);
        const int ncl = n > 126 ? 126 : n;
        const bf16* arow = P.proj() + ((size_t)b * S + ncl * 16) * LDP + (which ? 2176 : 2048) + hkv * 64 + 8 * (lane >> 4);
        const bf16* brow = P.wcmpt() + (size_t)which * 64 * 2048 + (size_t)(lane & 15) * 2048 + 8 * (lane >> 4);
        pg8::f32x4 acc[4];
#pragma unroll
        for (int c = 0; c < 4; ++c) acc[c] = (pg8::f32x4){0.f, 0.f, 0.f, 0.f};
#pragma unroll
        for (int kk = 0; kk < 8; ++kk) {
            const int ks = 8 * w + kk, li = ks >> 1, dh = (ks & 1) * 32;
            const bf16x8 a = *(const GAS bf16x8*)(arow + (size_t)li * LDP + dh);
#pragma unroll
            for (int c = 0; c < 4; ++c) {
                const bf16x8 bb = *(const GAS bf16x8*)(brow + (size_t)(16 * c) * 2048 + 32 * ks);
                acc[c] = __builtin_amdgcn_mfma_f32_16x16x32_bf16(a, bb, acc[c], 0, 0, 0);
            }
        }
#pragma unroll
        for (int c = 0; c < 4; ++c)
#pragma unroll
            for (int r = 0; r < 4; ++r) part[(w * 16 + 4 * (lane >> 4) + r) * 64 + 16 * c + (lane & 15)] = acc[c][r];
        __syncthreads();
        {
            const int row = F.tid >> 5, c0 = 2 * (F.tid & 31);
            float v0 = P.cbias()[which * 64 + c0], v1 = P.cbias()[which * 64 + c0 + 1];
#pragma unroll
            for (int ww = 0; ww < 8; ++ww) { v0 += part[(ww * 16 + row) * 64 + c0]; v1 += part[(ww * 16 + row) * 64 + c0 + 1]; }
            if (which == 0) {
                float ss = v0 * v0 + v1 * v1;
                ss += __shfl_xor(ss, 1); ss += __shfl_xor(ss, 2); ss += __shfl_xor(ss, 4); ss += __shfl_xor(ss, 8); ss += __shfl_xor(ss, 16);
                const float rs = 1.0f / sqrtf(ss * (1.0f / 64) + EPS);
                v0 *= rs * P.od_d_k_norm[c0]; v1 *= rs * P.od_d_k_norm[c0 + 1];
            }
            const int nn = 16 * ng + row;
            if (nn < NCMP) *(GAS unsigned*)(P.kvcmp() + (((size_t)(which * NB + b) * NCMP + nn) * 2 + hkv) * 64 + c0) = pk2(v0, v1);
        }
        __syncthreads();
    }
}

DEV void sb_tile(att::f32x16& p0, att::f32x16& p1, float& carry, int lim, int hi) {
    using namespace att;
    const float c1 = 0.125f * LOG2E;
    f32x16 k0, k1;
    float cp[2][4];
#pragma unroll
    for (int hf = 0; hf < 2; ++hf)
#pragma unroll
        for (int g = 0; g < 4; ++g) {
            float pr = 1.f;
#pragma unroll
            for (int i = 0; i < 4; ++i) {
                const int r = 4 * g + i, kr = i + 8 * g + 32 * hf;
                const float z2 = fminf(hf ? p1[r] : p0[r], 100.f);
                const float e1 = __builtin_amdgcn_exp2f(z2);
                const float keep = __builtin_amdgcn_rcpf(1.0f + e1);
                const bool ok = kr < lim;
                const float sg = ok ? e1 * keep : 0.f;
                const float kp = ok ? keep : 1.f;
                if (hf) { p1[r] = sg; k1[r] = kp; } else { p0[r] = sg; k0[r] = kp; }
                pr *= kp;
            }
            cp[hf][g] = pr;
        }
    float run = carry;
#pragma unroll
    for (int hf = 1; hf >= 0; --hf)
#pragma unroll
        for (int g = 3; g >= 0; --g) {
            const float mine = cp[hf][g], other = lane_partner(mine, hi);
            float suf = hi ? run : run * other;
            run *= mine * other;
#pragma unroll
            for (int i = 3; i >= 0; --i) {
                const int r = 4 * g + i;
                if (hf) { p1[r] *= suf; suf *= k1[r]; } else { p0[r] *= suf; suf *= k0[r]; }
            }
        }
    carry = run;
}

DEV void fp_attn0(const Params& P, Frame& F) {
    using namespace att;
    const int tid = F.tid, lane = F.lane, r32 = lane & 31, hi = lane >> 5, w = F.wave;
    for (int u = F.vcu; u < 512; u += F.G) {
        {
            const int b = u >> 6, h = (u >> 3) & 7, blk = u & 7;
            const bf16* base = P.proj() + (size_t)b * S * LDP;
            const int q = blk * 256 + w * 32 + r32;
            bf16x8 qr[4]; load_q(qr, base + (size_t)q * LDP + 768 + h * 64, hi);
            const bf16* Kg = base + 1280 + h * 64; const bf16* Vg = base + 1792 + h * 64;
            f32x16 o[2]; o[0] = f32x16{}; o[1] = f32x16{};
            float carry = 1.f;
            const int tmax = blk * 4 + 3;
            const int tw = (blk * 256 + w * 32 + 31) >> 6;
            volatile LAS int* flag = (volatile LAS int*)(F.lds + LDSCTL_OFF + 12288);
            if (tid < 3) flag[tid] = 0;
            TileRegs R; tile_load(R, Kg, Vg, LDP, tmax * 64, tid);
            int slot = 0; bool wave_done = false;
            for (int t = tmax; t >= 0; --t) {
                tile_store(F.lds, slot, R, tid);
                if (t > 0) tile_load(R, Kg, Vg, LDP, (t - 1) * 64, tid);
                __syncthreads();
                if (t < tmax && flag[(t + 1) % 3] == 0) break;
                if (tid == 0) flag[(t + 2) % 3] = 0;
                if (!wave_done && t <= tw) {
                    f32x16 p0 = f32x16{}, p1 = f32x16{};
                    qk_tile(p0, p1, (lptr)(F.lds + KS0 + slot * SLOT), qr, r32, hi);
                    sb_tile(p0, p1, carry, q - t * 64 - 4 * hi, hi);
                    pv_tile(o, (lptr)(F.lds + VS0 + slot * SLOT), p0, p1, lane);
                    if (__all(carry == 0.f)) wave_done = true;
                }
                if (!wave_done && lane == 0) flag[t % 3] = 1;
                slot ^= 1;
            }
            __syncthreads();
            store_ot(o, 1.0f, P.o() + (size_t)(b * S + q) * D + 512 + h * 64, hi);
        }
    }
    asm volatile("" ::: "memory");
    for (int u = 512 + F.vcu; u < 1024; u += F.G) {
        {
            const int v = u - 512, b = v >> 6, hkv = (v >> 5) & 1, c = v & 31;
            const bf16* base = P.proj() + (size_t)b * S * LDP;
            const int hh = hkv * 4 + (w >> 1), q = c * 64 + (w & 1) * 32 + r32;
            bf16x8 qr[4]; load_q(qr, base + (size_t)q * LDP + hh * 64, hi);
            const float sl = exp2f(-(float)(hh + 1)), s2 = sl * LOG2E;
            SoftState st; soft_reset(st);
            const int t0 = c - 2 < 0 ? 0 : c - 2;
            run_segment<true>(F, st, qr, base + 512 + hkv * 64, base + 640 + hkv * 64, LDP, tile_range(t0, c), s2, q,
                        [&](int t, int& klo, int& klim) { klim = q - t * 64 - 4 * hi; klo = klim - 128; });
            const float den = lane_swap_sum(st.l) + __builtin_amdgcn_exp2f(P.ev_sink[hh] * LOG2E - M0);
            store_ot(st.o, 1.0f / den, P.o() + (size_t)(b * S + q) * D + hh * 64, hi);
        }
    }
}

DEV void fp_attn1(const Params& P, Frame& F) {
    using namespace att;
    const int lane = F.lane, r32 = lane & 31, hi = lane >> 5, w = F.wave;
    for (int u = F.vcu; u < 512; u += F.G) {
        {
            const int v = u & 255, bh = v >> 2, blk = (u < 256) ? (v & 3) : 7 - (v & 3);
            const int b = bh >> 3, h = bh & 7;
            const bf16* base = P.proj() + (size_t)b * S * LDP;
            const int q = blk * 256 + w * 32 + r32;
            bf16x8 qr[4]; load_q(qr, base + (size_t)q * LDP + h * 64, hi);
            const float sl = exp2f(-(float)(h + 1)), s2 = sl * LOG2E;
            float gt[8];
#pragma unroll
            for (int n = 0; n < 8; ++n) {
                float g = 0.f;
                if (n < blk) {
                    const float* km = P.kmean() + ((size_t)(b * 8 + h) * 8 + n) * 64;
#pragma unroll
                    for (int d0 = 0; d0 < 4; ++d0)
#pragma unroll
                        for (int j = 0; j < 8; ++j) g += bf2f((bf16)qr[d0][j]) * km[16 * d0 + 8 * hi + j];
                }
                g = lane_swap_sum(g);
                gt[n] = n < blk ? g : NEG;
            }
            unsigned sel = 0;
#pragma unroll
            for (int n = 0; n < 8; ++n) {
                int rank = 0;
#pragma unroll
                for (int k = 0; k < 8; ++k) rank += (gt[k] > gt[n] || (gt[k] == gt[n] && k < n)) ? 1 : 0;
                if (rank < 3 && n < blk) sel |= 1u << n;
            }
            SoftState st; soft_reset(st);
            run_segment<true>(F, st, qr, base + 512 + h * 64, base + 1024 + h * 64, LDP, tile_range(0, blk * 4 + 3), s2, q,
                        [&](int t, int& klo, int& klim) { const int n = t >> 2; klo = -1;
                            if (n < blk) klim = ((sel >> n) & 1) ? 63 : -1; else klim = q - t * 64 - 4 * hi; });
            const float l = lane_swap_sum(st.l);
            store_ot(st.o, 1.0f / l, P.o() + (size_t)(b * S + q) * D + h * 64, hi);
        }
    }
    asm volatile("" ::: "memory");
    for (int u = 512 + F.vcu; u < 1024; u += F.G) {
        {
            const int v = u & 255, bk = v >> 4, c = (u < 768) ? (v & 15) : 31 - (v & 15);
            const int b = bk >> 1, hkv = bk & 1;
            const bf16* base = P.proj() + (size_t)b * S * LDP;
            const int h = hkv * 4 + (w >> 1), q = c * 64 + (w & 1) * 32 + r32, t = b * S + q;
            bf16x8 qr[4]; load_q(qr, base + (size_t)q * LDP + 1536 + h * 64, hi);
            const float sl = exp2f(-(float)(h + 1)), s2 = sl * LOG2E;
            const bf16* grow = base + (size_t)q * LDP + 2816 + h * 3;
            LAS float* part = (LAS float*)(F.lds + SCR0);
            volatile LAS unsigned long long* tot = (volatile LAS unsigned long long*)(F.lds + SCR0 + 33792);
            volatile LAS unsigned* selm = (volatile LAS unsigned*)(F.lds + SCR0 + 33792 + 16896);
            f32x16 fin[2];
            {
                const int ntile = c >= 16 ? 2 : 1;
                const bf16* Kc = P.kvcmp() + ((size_t)(0 * NB + b) * NCMP) * 128 + hkv * 64;
                const bf16* Vc = P.kvcmp() + ((size_t)(1 * NB + b) * NCMP) * 128 + hkv * 64;
                { TileRegs R0; tile_load(R0, Kc, Vc, 128, 0, F.tid); tile_store(F.lds, 0, R0, F.tid); }
                if (ntile == 2) { TileRegs R1; tile_load(R1, Kc, Vc, 128, 64, F.tid); tile_store(F.lds, 1, R1, F.tid); }
                __syncthreads();
                const int nlim = (q - 31) >> 4;
                const float s16 = 16.0f * s2;
                const float basec = s2 * (float)(31 - q) + s16 * (float)(4 * hi);
                float lsum = 0.f;
                for (int tl = 0; tl < ntile; ++tl) {
                    const int klim = nlim - 64 * tl - 4 * hi; const float bt = basec + s16 * (float)(64 * tl) - M0;
                    f32x16 x0, x1; bias_init(x0, x1, s16, bt); qk_tile(x0, x1, (lptr)(F.lds + KS0 + tl * SLOT), qr, r32, hi);
#pragma unroll
                    for (int r = 0; r < 16; ++r) {
                        const int kr = (r & 3) + 8 * (r >> 2);
                        lsum += kr <= klim ? __builtin_amdgcn_exp2f(x0[r]) : 0.f;
                        lsum += kr + 32 <= klim ? __builtin_amdgcn_exp2f(x1[r]) : 0.f;
                    }
                }
                lsum = lane_swap_sum(lsum);
                const float inv = nlim >= 0 ? 1.0f / lsum : 0.f;
                fin[0] = f32x16{}; fin[1] = f32x16{};
                LAS float* prow = part + ((w >> 1) * 64 + (w & 1) * 32 + r32) * 33;
                float peprev = 0.f;
                for (int tl = 0; tl < ntile; ++tl) {
                    const int klim = nlim - 64 * tl - 4 * hi; const float bt = basec + s16 * (float)(64 * tl) - M0;
                    f32x16 x0, x1; bias_init(x0, x1, s16, bt); qk_tile(x0, x1, (lptr)(F.lds + KS0 + tl * SLOT), qr, r32, hi);
#pragma unroll
                    for (int r = 0; r < 16; ++r) {
                        const int kr = (r & 3) + 8 * (r >> 2);
                        x0[r] = kr <= klim ? __builtin_amdgcn_exp2f(x0[r]) * inv : 0.f;
                        x1[r] = kr + 32 <= klim ? __builtin_amdgcn_exp2f(x1[r]) * inv : 0.f;
                    }
#pragma unroll
                    for (int ix = 0; ix < 8; ++ix) {
                        const int g = ix & 3;
                        const float C = (ix < 4) ? (x0[4 * g] + x0[4 * g + 1]) + (x0[4 * g + 2] + x0[4 * g + 3]) : (x1[4 * g] + x1[4 * g + 1]) + (x1[4 * g + 2] + x1[4 * g + 3]);
                        const float pe = lane_partner((ix < 4) ? x0[4 * g + 3] : x1[4 * g + 3], hi);
                        prow[2 * (8 * tl + ix) + hi] = C + (hi ? pe : peprev);
                        peprev = pe;
                    }
                    pv_tile(fin, (lptr)(F.lds + VS0 + tl * SLOT), x0, x1, lane);
                }
                { const float g0 = 1.0f / (1.0f + __expf(-bf2f(grow[0])));
#pragma unroll
                for (int r = 0; r < 16; ++r) { fin[0][r] *= g0; fin[1][r] *= g0; } }
            }
            __syncthreads();
            {
                const int ql = F.tid >> 3, jg = F.tid & 7;
#pragma unroll
                for (int jj = 0; jj < 4; ++jj) {
                    const int j = 4 * jg + jj;
                    float sc = ((part[(0 * 64 + ql) * 33 + j] + part[(1 * 64 + ql) * 33 + j]) + part[(2 * 64 + ql) * 33 + j]) + part[(3 * 64 + ql) * 33 + j];
                    const bool forced = (j == 0) || (j == c) || (j == c - 1);
                    sc = (j <= c) ? sc + (forced ? 1000.0f : 0.0f) : NEG;
                    const unsigned ub = f2u(sc), ord = ub ^ ((ub >> 31) ? 0xffffffffu : 0x80000000u);
                    tot[ql * 33 + j] = ((unsigned long long)ord << 32) | (unsigned)(31 - j);
                }
                __syncthreads();
                unsigned long long mine[4];
#pragma unroll
                for (int jj = 0; jj < 4; ++jj) mine[jj] = tot[ql * 33 + 4 * jg + jj];
                int rank[4] = {0, 0, 0, 0};
                for (int k = 0; k < 32; ++k) {
                    const unsigned long long sk = tot[ql * 33 + k];
#pragma unroll
                    for (int jj = 0; jj < 4; ++jj) rank[jj] += (sk > mine[jj]) ? 1 : 0;
                }
                unsigned bits = 0;
#pragma unroll
                for (int jj = 0; jj < 4; ++jj) if (rank[jj] < 16 && 4 * jg + jj <= c) bits |= 1u << (4 * jg + jj);
                bits |= __shfl_xor(bits, 1); bits |= __shfl_xor(bits, 2); bits |= __shfl_xor(bits, 4);
                if (jg == 0) selm[ql] = bits;
                unsigned ub = bits; ub |= __shfl_xor(ub, 8); ub |= __shfl_xor(ub, 16); ub |= __shfl_xor(ub, 32);
                if (lane == 0) selm[64 + w] = ub;
            }
            __syncthreads();
            const unsigned mask = selm[(w & 1) * 32 + r32];
            const unsigned umask = ((selm[64] | selm[65]) | (selm[66] | selm[67])) | ((selm[68] | selm[69]) | (selm[70] | selm[71]));
            __syncthreads();
            LAS float* stg = (LAS float*)(F.lds + SCR0) + w * 2048 + lane;
#pragma unroll
            for (int r = 0; r < 16; ++r) { stg[r * 64] = fin[0][r]; stg[(16 + r) * 64] = fin[1][r]; }
            SoftState st; soft_reset(st);
            run_segment<false>(F, st, qr, base + 2304 + hkv * 64, base + 2432 + hkv * 64, LDP, (unsigned long long)umask, s2, q,
                        [&](int tt, int& klo, int& klim) { klo = -1; klim = ((mask >> tt) & 1) ? (q - tt * 64 - 4 * hi) : -1; });
            { const float g1 = 1.0f / (1.0f + __expf(-bf2f(grow[1]))); const float f = g1 / lane_swap_sum(st.l);
#pragma unroll
              for (int r = 0; r < 16; ++r) { stg[r * 64] += f * st.o[0][r]; stg[(16 + r) * 64] += f * st.o[1][r]; } }
            soft_reset(st);
            run_segment<true>(F, st, qr, base + 2560 + hkv * 64, base + 2688 + hkv * 64, LDP, tile_range(c - 8 < 0 ? 0 : c - 8, c), s2, q,
                        [&](int tt, int& klo, int& klim) { klim = q - tt * 64 - 4 * hi; klo = klim - 512; });
            { const float g2 = 1.0f / (1.0f + __expf(-bf2f(grow[2]))); const float f = g2 / lane_swap_sum(st.l);
#pragma unroll
              for (int r = 0; r < 16; ++r) { st.o[0][r] = stg[r * 64] + f * st.o[0][r]; st.o[1][r] = stg[(16 + r) * 64] + f * st.o[1][r]; } }
            store_ot(st.o, 1.0f, P.o() + (size_t)t * D + 512 + h * 64, hi);
            __syncthreads();
        }
    }
}
enum { PH_PRE = 0, PH_INPROJ0, PH_ATTN0, PH_OUTPROJ0, PH_ROUTE0, PH_FFN0, PH_COMBINE0, PH_INPROJ1, PH_PREP1, PH_ATTN1, PH_OUTPROJ1, PH_ROUTE1, PH_FFN1, PH_COMBINE1, PH_COUNT };
struct FArgs { Params p; };

#ifndef PROBE_PHASE
#define PROBE_PHASE -1
#endif
constexpr int STAMP_OFF = LDSCTL_OFF + 1024;
constexpr int HN_OFF = LDSCTL_OFF + 2048;
DEV void stampk(Frame& F, int k) {
    if (PROBE_PHASE >= 0 && F.tid == 0) ((volatile LAS unsigned*)(F.lds + STAMP_OFF))[k] = (unsigned)__builtin_amdgcn_s_memrealtime() | 1u;
}
__global__ void __launch_bounds__(NWAVES * 64, 2) k_fast(FArgs args) {
    extern __shared__ __attribute__((aligned(16))) unsigned char lds[];
    const Params& P = args.p;
    Frame F;
    F.lds = (LAS unsigned char*)lds;
    F.MISC = (volatile LAS unsigned*)(F.lds + MISC_OFF);
    F.tid = threadIdx.x; F.lane = F.tid & 63; F.wave = __builtin_amdgcn_readfirstlane(F.tid >> 6);
    F.G = gridDim.x; { const int bx = blockIdx.x; F.vcu = (F.G % 8 == 0) ? (bx % 8) * (F.G / 8) + bx / 8 : bx; }
    for (int u = F.tid; u < (LDS_BYTES - LDSCTL_OFF) / 4; u += NWAVES * 64) ((LAS unsigned*)(F.lds + LDSCTL_OFF))[u] = 0u;
    __syncthreads();
    XcdBarrier bar = xcd_barrier_post(P.ctl() + CW_BAR, F.MISC + 8);
#define BEGIN(k) refresh(F); stampk(F, (k));
#define SEAM() do { refresh(F); xcd_barrier(bar, F.tid); } while (0)
    { BEGIN(PH_PRE) fp_convert_weights(P, F, 0, F.vcu, F.G); fp_prep_router(P, F); fp_norm_rows(F, P.x, P.ev_norm, P.xn()); if (F.G != 256) { fp_convert_weights(P, F, 1, F.vcu, F.G); fp_prep_compress(P, F, F.vcu, F.G); } SEAM(); }
    { BEGIN(PH_INPROJ0) const int cq = F.vcu >> 2, cr = F.vcu & 3, gi = 3 * cq + cr;
      if (F.G == 256 && cr == 3) fp_convert_moe_part(P, F, 0, cq, 64);
      else { pg8::StaticOrder So; So.init(P.xn(), P.win0t(), T, EVEN_IN, D, F.G == 256 ? 192 : F.G, F.G == 256 ? gi : F.vcu);
        pg8::EpiProjNorm<0> E{P.proj(), LDP, P.ev_q_norm, P.ev_k_norm, nullptr, nullptr, nullptr, (PG8_LAS float*)(F.lds + HN_OFF)};
        pg8::gemm_phase(F.lds, D, So, E, F.wave); if (F.G != 256) { refresh(F); fp_convert_moe_part(P, F, 0, F.vcu, F.G); } }
      SEAM(); }
    { BEGIN(PH_ATTN0) fp_attn0(P, F); SEAM(); }
    { BEGIN(PH_OUTPROJ0) pg8::StaticOrder So; So.init(P.o(), P.wout0t(), T, D, D, F.G, (int)blockIdx.x);
      pg8::EpiResidF32 E{P.x, P.out, D}; pg8::gemm_phase(F.lds, D, So, E, F.wave); SEAM(); }
    { BEGIN(PH_ROUTE0) fp_route(P, F, 0); SEAM(); }
    { BEGIN(PH_FFN0) const int cq = F.vcu >> 2, cr = F.vcu & 3, gi = 3 * cq + cr;
      if (F.G == 256 && cr == 3) { fp_convert_weights(P, F, 1, cq, 64); fp_prep_compress(P, F, cq, 64); fp_convert_moe_part(P, F, 1, cq, 64); }
      else if (F.G == 256) fp_moe_fused(P, F, 0, gi, 192);
      else { fp_moe_fused(P, F, 0, F.vcu, F.G); refresh(F); fp_convert_moe_part(P, F, 1, F.vcu, F.G); }
      SEAM(); }
    { BEGIN(PH_COMBINE0) fp_combine(P, F, 0, P.od_norm, P.xn()); SEAM(); }
    { BEGIN(PH_INPROJ1) pg8::StaticOrder So; So.init(P.xn(), P.win1t(), T, LDP, D, F.G, (int)blockIdx.x);
      pg8::EpiProjNorm<1> E{P.proj(), LDP, P.od_c_q_norm, P.od_c_k_norm, P.od_d_q_norm, P.od_d_k_norm + 64, P.od_d_k_norm + 128, (PG8_LAS float*)(F.lds + HN_OFF)};
      pg8::gemm_phase(F.lds, D, So, E, F.wave); SEAM(); }
    { BEGIN(PH_PREP1) fp_prep1(P, F); SEAM(); }
    { BEGIN(PH_ATTN1) fp_attn1(P, F); SEAM(); }
    { BEGIN(PH_OUTPROJ1) pg8::StaticOrder So; So.init(P.o(), P.wout1t(), T, D, D, F.G, (int)blockIdx.x);
      pg8::EpiResidF32 E{P.out, P.out, D}; pg8::gemm_phase(F.lds, D, So, E, F.wave); SEAM(); }
    { BEGIN(PH_ROUTE1) fp_route(P, F, 1); SEAM(); }
    { BEGIN(PH_FFN1) fp_moe_fused(P, F, 1, F.vcu, F.G); SEAM(); }
    { BEGIN(PH_COMBINE1) fp_combine(P, F, 1, nullptr, nullptr); }
    if (PROBE_PHASE >= 0) {
        refresh(F);
        if (F.vcu == 0 && F.tid == 0) {
            volatile LAS unsigned* st = (volatile LAS unsigned*)(F.lds + STAMP_OFF);
            const unsigned t1 = (PROBE_PHASE + 1 < PH_COUNT) ? st[(PROBE_PHASE + 1 < PH_COUNT) ? PROBE_PHASE + 1 : 0] : ((unsigned)__builtin_amdgcn_s_memrealtime() | 1u);
            const unsigned t0 = st[PROBE_PHASE < 0 ? 0 : PROBE_PHASE];
            asm volatile("s_waitcnt vmcnt(0)" ::: "memory");
#ifndef PROBE_SCALE
#define PROBE_SCALE 0.01f
#endif
            P.out[0] += (float)(t1 - t0) * PROBE_SCALE;
        }
    }
#undef BEGIN
#undef SEAM
}

static size_t carve(Params& p, void* d_ws) { p.ws = (char*)d_ws; return WS_END; }

extern "C" void kernel_launch(void* const* d_in, const int* in_sizes, int n_in, void* d_out, int out_size, void* d_ws, size_t ws_size,
                              hipStream_t stream) {
    Params p{};
    const float** f = (const float**)&p;
    for (int i = 0; i < 24; ++i) f[i] = (const float*)d_in[i];
    p.out = (float*)d_out;
    const size_t need = carve(p, d_ws);
    static int grid = 0;
    if (grid == 0) {
        int dev = 0, cus = 0, per_cu = 0;
        if (hipGetDevice(&dev) != hipSuccess || hipDeviceGetAttribute(&cus, hipDeviceAttributeMultiprocessorCount, dev) != hipSuccess) { grid = -1; return; }
        if (hipFuncSetAttribute((const void*)k_fast, hipFuncAttributeMaxDynamicSharedMemorySize, LDS_BYTES) != hipSuccess) { fprintf(stderr, "hipFuncSetAttribute failed\n"); grid = -1; return; }
        if (hipOccupancyMaxActiveBlocksPerMultiprocessor(&per_cu, (const void*)k_fast, NWAVES * 64, LDS_BYTES) != hipSuccess || per_cu < 1) { fprintf(stderr, "occupancy query: %d\n", per_cu); (void)hipGetLastError(); grid = -1; return; }
        grid = cus;
        if (need > ws_size) { fprintf(stderr, "workspace too small: need %zu have %zu\n", need, ws_size); grid = -1; return; }
    }
    if (grid < 0) return;
    (void)hipMemsetAsync(d_ws, 0, CTL_ZERO_BYTES, stream);
    FArgs a{}; a.p = p;
    hipLaunchKernelGGL(k_fast, dim3(grid), dim3(NWAVES * 64), LDS_BYTES, stream, a);
}
```

```cpp
#include <hip/hip_runtime.h>
#include <cstdio>
#include <cstdint>
#define DEV __device__ __forceinline__

#ifndef NB
#define NB 8
#endif
typedef unsigned short bf16;
constexpr int S = 2048, D = 1024, T = NB * S, HD = 64;
constexpr int EVEN_IN = 2304, ODD_IN = 2840, LDP = 3072;
constexpr int NCMP = 127, NSLC = 32;
constexpr float NEG = -1e30f;
constexpr float EPS = 1e-6f;
constexpr int RMAX = 2 * T + 32 * 256;

DEV float u2f(unsigned u) { return __builtin_bit_cast(float, u); }
DEV unsigned f2u(float f) { return __builtin_bit_cast(unsigned, f); }
DEV float bf2f(bf16 h) { return u2f(((unsigned)h) << 16); }
DEV bf16 f2bf(float f) { unsigned u = f2u(f); u += 0x7fffu + ((u >> 16) & 1u); return (bf16)(u >> 16); }

constexpr size_t MiB_ = (size_t)1 << 20;
__host__ __device__ constexpr size_t al256c(size_t x) { return (x + 255) & ~(size_t)255; }
constexpr size_t WS_CTL = 0, WS_WIN0T = 1 * MiB_, WS_WOUT0T = 6 * MiB_, WS_WIN1T = 8 * MiB_, WS_WOUT1T = 14 * MiB_, WS_WGUT0 = 16 * MiB_, WS_WDT0 = 48 * MiB_,
                 WS_PROJ = 64 * MiB_  , WS_XN = 160 * MiB_, WS_O = 192 * MiB_  ,
                 WS_RSTD = 224 * MiB_, WS_EID = al256c(WS_RSTD + (size_t)T * 4), WS_EW = al256c(WS_EID + (size_t)T * 8), WS_KMEAN = al256c(WS_EW + (size_t)T * 8),
                 WS_KVCMP = al256c(WS_KMEAN + (size_t)NB * 8 * 8 * 64 * 4), WS_POS = al256c(WS_KVCMP + (size_t)2 * NB * 128 * 2 * 64 * 2), WS_WR = al256c(WS_POS + (size_t)T * 8),
                 WS_WCMPT = al256c(WS_WR + (size_t)2 * 2 * 48 * D * 2), WS_CBIAS = al256c(WS_WCMPT + (size_t)2 * 64 * 2048 * 2), WS_MISC_END = al256c(WS_CBIAS + 512),
                 WS_WGUT1 = 228 * MiB_, WS_WDT1 = 260 * MiB_, WS_ROWTOK = 276 * MiB_, WS_END = 278 * MiB_;
static_assert(WS_MISC_END <= WS_WGUT1, "misc region overflows");
struct Params {
    const float *x, *ev_norm, *ev_w_in, *ev_q_norm, *ev_k_norm, *ev_sink, *ev_w_out;
    const float *od_norm, *od_w_in, *od_c_q_norm, *od_c_k_norm, *od_d_q_norm, *od_d_k_norm, *od_cmp_pos, *od_cmp_w, *od_w_out;
    const float *moe_norm, *moe_w_grp, *moe_b_grp, *moe_w_exp, *moe_b_exp, *moe_w_gate, *moe_w_up, *moe_w_down;
    float* out;
    char* ws;
    DEV unsigned* ctl() const { return (unsigned*)(ws + WS_CTL); }
    DEV bf16* win0t() const { return (bf16*)(ws + WS_WIN0T); }
    DEV bf16* wout0t() const { return (bf16*)(ws + WS_WOUT0T); }
    DEV bf16* win1t() const { return (bf16*)(ws + WS_WIN1T); }
    DEV bf16* wout1t() const { return (bf16*)(ws + WS_WOUT1T); }
    DEV bf16* wgut(int l) const { return (bf16*)(ws + (l ? WS_WGUT1 : WS_WGUT0)); }
    DEV bf16* wdt(int l) const { return (bf16*)(ws + (l ? WS_WDT1 : WS_WDT0)); }
    DEV bf16* proj() const { return (bf16*)(ws + WS_PROJ); }
    DEV bf16* ha() const { return (bf16*)(ws + WS_PROJ); }
    DEV bf16* xn() const { return (bf16*)(ws + WS_XN); }
    DEV bf16* o() const { return (bf16*)(ws + WS_O); }
    DEV bf16* hid() const { return (bf16*)(ws + WS_O); }
    DEV float* rstd() const { return (float*)(ws + WS_RSTD); }
    DEV int* eid() const { return (int*)(ws + WS_EID); }
    DEV float* ew() const { return (float*)(ws + WS_EW); }
    DEV float* kmean() const { return (float*)(ws + WS_KMEAN); }
    DEV bf16* kvcmp() const { return (bf16*)(ws + WS_KVCMP); }
    DEV int* pos() const { return (int*)(ws + WS_POS); }
    DEV bf16* wr() const { return (bf16*)(ws + WS_WR); }
    DEV bf16* wcmpt() const { return (bf16*)(ws + WS_WCMPT); }
    DEV float* cbias() const { return (float*)(ws + WS_CBIAS); }
    DEV int* rowtok() const { return (int*)(ws + WS_ROWTOK); }
};


namespace pg8 {
#define PG8_LAS __attribute__((address_space(3)))
typedef unsigned short bf16_t;
typedef short bf16x8 __attribute__((ext_vector_type(8)));
typedef float f32x4 __attribute__((ext_vector_type(4)));
typedef unsigned u32x4 __attribute__((ext_vector_type(4)));
constexpr int BM = 256, BK = 64, HALF = 128, HTB = HALF * BK * 2, STAGE_BYTES = 8 * HTB, NXCD = 8, WGM = 8;

__host__ __device__ __forceinline__ int lds_byte(int r, int c) { const int st = (r >> 4) * 2 + (c >> 5), rr = r & 15, cc = c & 31, ob = rr * 64 + cc * 2; return st * 1024 + (ob ^ (((ob >> 9) & 1) << 5)); }
__host__ __device__ __forceinline__ void stage_rc(int b, int& R, int& C) { const int st = b / 1024, sb = b % 1024, swz = sb ^ (((sb >> 9) & 1) << 5); R = (st >> 1) * 16 + swz / 64; C = (st & 1) * 32 + (swz % 64) / 2; }
__host__ __device__ __forceinline__ int perm32(int rho) { const int n = rho >> 4, i = rho & 15; return 8 * (i >> 2) + 4 * n + (i & 3); }

struct Unit { const char* A; const char* B; int pm, pn; };

struct StaticOrder {
    int nM, nN, nwg, G, c; const char* A; const char* Bt; size_t tstep;
    __device__ void init(const bf16_t* A_, const bf16_t* Bt_, int M, int N, int K, int G_, int c_) { nM = M / BM; nN = N / BM; nwg = nM * nN; G = G_; c = c_; A = (const char*)A_; Bt = (const char*)Bt_; tstep = (size_t)BM * K * 2; }
    __device__ bool next(int i, Unit& u) const {
        const long L = (long)i * G + c; if (L >= nwg) return false;
        int wgid = (int)L; { const int q = nwg / NXCD, r = nwg % NXCD, xcd = wgid % NXCD, off = wgid / NXCD; wgid = (xcd < r ? xcd * (q + 1) : r * (q + 1) + (xcd - r) * q) + off; }
        const int nig = WGM * nN, gid = wgid / nig, fm = gid * WGM, gsz = (nM - fm) < WGM ? (nM - fm) : WGM;
        u.pm = fm + ((wgid % nig) % gsz); u.pn = (wgid % nig) / gsz; u.A = A + (size_t)u.pm * tstep; u.B = Bt + (size_t)u.pn * tstep; return true;
    }
};

__device__ __forceinline__ unsigned cvt_pk_bf16(float lo, float hi) { unsigned r; asm volatile("v_cvt_pk_bf16_f32 %0, %1, %2" : "=v"(r) : "v"(lo), "v"(hi)); return r; }

struct EpiStoreBf16 {
    static constexpr bool PERM = true;
    bf16_t* O; int ldc;
    __device__ __forceinline__ void operator()(const f32x4 (&acc)[2][2][4][2], const Unit& u, int wr, int wc, int fr, int fq) const {
        const int row0 = u.pm * BM + wr * 64 + fr, col0 = u.pn * BM + wc * 32 + 8 * fq;
#pragma unroll
        for (int ai = 0; ai < 2; ++ai)
#pragma unroll
            for (int m = 0; m < 4; ++m) { bf16_t* rowp = O + (size_t)(row0 + ai * HALF + m * 16) * ldc + col0;
#pragma unroll
                for (int bj = 0; bj < 2; ++bj) { const f32x4 v0 = acc[ai][bj][m][0], v1 = acc[ai][bj][m][1];
                    u32x4 w; w.x = cvt_pk_bf16(v0[0], v0[1]); w.y = cvt_pk_bf16(v0[2], v0[3]); w.z = cvt_pk_bf16(v1[0], v1[1]); w.w = cvt_pk_bf16(v1[2], v1[3]);
                    *(u32x4*)(rowp + bj * HALF) = w; } }
    }
};

template <int LAYER> struct EpiProjNorm {
    static constexpr bool PERM = true;
    bf16_t* O; int ldc; const float *g0, *g1, *g2, *g3, *g4; PG8_LAS float* hn;
    __device__ __forceinline__ const float* gain_of(int H) const {
        if (LAYER == 0) return H < 8 ? g0 : (H < 10 ? g1 : nullptr);
        return H < 8 ? g0 : H < 16 ? g1 : (H >= 24 && H < 32) ? g2 : (H == 36 || H == 37) ? g3 : (H == 40 || H == 41) ? g4 : nullptr;
    }
    __device__ __forceinline__ void operator()(f32x4 (&acc)[2][2][4][2], const Unit& u, int wr, int wc, int fr, int fq) const {
        const bool any = (LAYER == 0) ? (u.pn < 3) : (u.pn < 4 || u.pn == 6 || u.pn == 7 || u.pn == 9 || u.pn == 10);
        if (any) {
#pragma unroll
            for (int ai = 0; ai < 2; ++ai)
#pragma unroll
                for (int m = 0; m < 4; ++m)
#pragma unroll
                    for (int bj = 0; bj < 2; ++bj) {
                        const f32x4 a = acc[ai][bj][m][0], b = acc[ai][bj][m][1];
                        float ss = (a[0] * a[0] + a[1] * a[1]) + (a[2] * a[2] + a[3] * a[3]) + (b[0] * b[0] + b[1] * b[1]) + (b[2] * b[2] + b[3] * b[3]);
                        ss += __shfl_xor(ss, 16); ss += __shfl_xor(ss, 32);
                        if (fq == 0) hn[(ai * HALF + wr * 64 + m * 16 + fr) * 8 + bj * 4 + wc] = ss;
                    }
        }
        asm volatile("s_waitcnt lgkmcnt(0)" ::: "memory"); __builtin_amdgcn_s_barrier(); asm volatile("" ::: "memory");
        const int row0 = u.pm * BM + wr * 64 + fr, col0 = u.pn * BM + wc * 32 + 8 * fq;
#pragma unroll
        for (int bj = 0; bj < 2; ++bj) {
            const float* g = gain_of(4 * u.pn + 2 * bj + (wc >> 1));
            f32x4 ga = (f32x4){1.f, 1.f, 1.f, 1.f}, gb = ga;
            if (g) { ga = *(const f32x4*)(g + (wc & 1) * 32 + 8 * fq); gb = *(const f32x4*)(g + (wc & 1) * 32 + 8 * fq + 4); }
#pragma unroll
            for (int ai = 0; ai < 2; ++ai)
#pragma unroll
                for (int m = 0; m < 4; ++m) {
                    f32x4 v0 = acc[ai][bj][m][0], v1 = acc[ai][bj][m][1];
                    if (g) { const int rl = (ai * HALF + wr * 64 + m * 16 + fr) * 8 + bj * 4;
                        const float r = 1.0f / sqrtf((hn[rl + wc] + hn[rl + (wc ^ 1)]) * (1.0f / 64) + 1e-6f);
                        v0 = v0 * ga * r; v1 = v1 * gb * r; }
                    u32x4 w; w.x = cvt_pk_bf16(v0[0], v0[1]); w.y = cvt_pk_bf16(v0[2], v0[3]); w.z = cvt_pk_bf16(v1[0], v1[1]); w.w = cvt_pk_bf16(v1[2], v1[3]);
                    *(u32x4*)(O + (size_t)(row0 + ai * HALF + m * 16) * ldc + col0 + bj * HALF) = w;
                }
        }
    }
};
struct EpiResidF32 {
    static constexpr bool PERM = true;
    const float* R; float* O; int ldc;
    __device__ __forceinline__ void operator()(const f32x4 (&acc)[2][2][4][2], const Unit& u, int wr, int wc, int fr, int fq) const {
        const int row0 = u.pm * BM + wr * 64 + fr, col0 = u.pn * BM + wc * 32 + 8 * fq;
#pragma unroll
        for (int ai = 0; ai < 2; ++ai)
#pragma unroll
            for (int m = 0; m < 4; ++m) { const size_t ro = (size_t)(row0 + ai * HALF + m * 16) * ldc + col0;
#pragma unroll
                for (int bj = 0; bj < 2; ++bj) {
                    const f32x4 r0 = *(const f32x4*)(R + ro + bj * HALF), r1 = *(const f32x4*)(R + ro + bj * HALF + 4);
                    *(f32x4*)(O + ro + bj * HALF) = r0 + acc[ai][bj][m][0]; *(f32x4*)(O + ro + bj * HALF + 4) = r1 + acc[ai][bj][m][1]; } }
    }
};
struct EpiSiluMul {
    static constexpr bool PERM = true;
    bf16_t* H; int ldh;
    __device__ __forceinline__ void operator()(const f32x4 (&acc)[2][2][4][2], const Unit& u, int wr, int wc, int fr, int fq) const {
        const int row0 = u.pm * BM + wr * 64 + fr, col0 = u.pn * HALF + wc * 32 + 8 * fq;
#pragma unroll
        for (int ai = 0; ai < 2; ++ai)
#pragma unroll
            for (int m = 0; m < 4; ++m) { bf16_t* rowp = H + (size_t)(row0 + ai * HALF + m * 16) * ldh + col0;
                float h[8];
#pragma unroll
                for (int n = 0; n < 2; ++n)
#pragma unroll
                    for (int j = 0; j < 4; ++j) { const float g = acc[ai][0][m][n][j], up = acc[ai][1][m][n][j]; h[n * 4 + j] = g * up * __builtin_amdgcn_rcpf(1.0f + __expf(-g)); }
                u32x4 w; w.x = cvt_pk_bf16(h[0], h[1]); w.y = cvt_pk_bf16(h[2], h[3]); w.z = cvt_pk_bf16(h[4], h[5]); w.w = cvt_pk_bf16(h[6], h[7]);
                *(u32x4*)rowp = w; }
    }
};

template <class Epi, class Sched, bool GATHER = false>
__device__ __forceinline__ void gemm_phase(PG8_LAS unsigned char* lds, const int K, const Sched& S, const Epi& E, const int wave_, unsigned g00 = 0, unsigned g01 = 0, unsigned g10 = 0, unsigned g11 = 0) {
    int lane; asm volatile("v_mbcnt_lo_u32_b32 %0, -1, 0\n\tv_mbcnt_hi_u32_b32 %0, -1, %0" : "=v"(lane));
    const int wid = __builtin_amdgcn_readfirstlane(wave_), tid = wid * 64 + lane, wr = wid >> 2, wc = wid & 3, fr = lane & 15, fq = lane >> 4;
    const int nt = K / BK;
    unsigned voffA[2], voffB[2], voffA1[2];
#pragma unroll
    for (int i = 0; i < 2; ++i) { int R, C; stage_rc(tid * 16 + i * 8192, R, C); const int Rb = Epi::PERM ? ((R & ~31) + perm32(R & 31)) : R;
        voffA[i] = (unsigned)(R * K + C) * 2u; voffB[i] = (unsigned)(Rb * K + C) * 2u; voffA1[i] = voffA[i];
        if (GATHER) { voffA[i] = (i ? g01 : g00) + (unsigned)C * 2u; voffA1[i] = (i ? g11 : g10) + (unsigned)C * 2u; } }
    const size_t kstep = (size_t)(BK * 2);
    const size_t hstep = (size_t)HALF * K * 2;
    const size_t hstepA = GATHER ? (size_t)0 : hstep;
    const unsigned ldsw = (unsigned)wid * 1024u;
    const int aoff = lds_byte(wr * 64 + fr, fq * 8), boff = lds_byte(wc * 32 + fr, fq * 8);
#define PG8_SA(b, h) (((b) * 2 + (h)) * HTB)
#define PG8_SB(b, h) ((4 + (b) * 2 + (h)) * HTB)
#define PG8_STAGE(bufoff, gbase, voff) do { _Pragma("unroll") for (int _i = 0; _i < 2; ++_i) \
        __builtin_amdgcn_global_load_lds((const unsigned*)((const char*)(gbase) + (voff)[_i]), (PG8_LAS unsigned*)(lds + (bufoff) + ldsw + _i * 8192), 16, 0, 0); } while (0)
#define PG8_LDA(dst, b, h) do { _Pragma("unroll") for (int m = 0; m < 4; ++m) _Pragma("unroll") for (int k = 0; k < 2; ++k) dst[m][k] = *(const PG8_LAS bf16x8*)(lds + PG8_SA(b, h) + aoff + m * 2048 + k * 1024); } while (0)
#define PG8_LDB(dst, b, h) do { _Pragma("unroll") for (int n = 0; n < 2; ++n) _Pragma("unroll") for (int k = 0; k < 2; ++k) dst[n][k] = *(const PG8_LAS bf16x8*)(lds + PG8_SB(b, h) + boff + n * 2048 + k * 1024); } while (0)
#define PG8_MMA(ai, bj, At, Bt) do { __builtin_amdgcn_s_setprio(1); _Pragma("unroll") for (int m = 0; m < 4; ++m) _Pragma("unroll") for (int n = 0; n < 2; ++n) _Pragma("unroll") for (int k = 0; k < 2; ++k) \
        acc[ai][bj][m][n] = __builtin_amdgcn_mfma_f32_16x16x32_bf16(Bt[n][k], At[m][k], acc[ai][bj][m][n], 0, 0, 0); __builtin_amdgcn_s_setprio(0); } while (0)
#define PG8_WAIT_V(n) asm volatile("s_waitcnt vmcnt(" #n ")" ::: "memory")
#define PG8_WAIT_L(n) asm volatile("s_waitcnt lgkmcnt(" #n ")" ::: "memory")
#define PG8_BAR __builtin_amdgcn_s_barrier()
#define PG8_SCHED __builtin_amdgcn_sched_barrier(0)
    Unit cur, nxt; int ui = 0;
    if (!S.next(0, cur)) return;
    f32x4 acc[2][2][4][2];
#pragma unroll
    for (int a = 0; a < 2; ++a)
#pragma unroll
        for (int b = 0; b < 2; ++b)
#pragma unroll
            for (int m = 0; m < 4; ++m)
#pragma unroll
                for (int n = 0; n < 2; ++n) acc[a][b][m][n] = (f32x4){0.f, 0.f, 0.f, 0.f};
    bf16x8 At[4][2], B0[2][2], B1[2][2];
    const char* cA = cur.A; const char* cB = cur.B;
    PG8_STAGE(PG8_SB(0, 0), cB, voffB); PG8_STAGE(PG8_SB(0, 1), cB + hstep, voffB); PG8_STAGE(PG8_SA(0, 0), cA, voffA); PG8_STAGE(PG8_SA(0, 1), cA + hstepA, voffA1);
    if (wr == 1) PG8_BAR;
    PG8_WAIT_V(2); PG8_BAR;
    PG8_STAGE(PG8_SB(1, 0), cB + kstep, voffB); PG8_STAGE(PG8_SA(1, 0), cA + kstep, voffA); PG8_STAGE(PG8_SB(1, 1), cB + hstep + kstep, voffB);
    PG8_WAIT_V(6); PG8_BAR;
    for (;;) {
        const bool has_next = S.next(ui + 1, nxt);
        const char* nA = has_next ? nxt.A : cA; const char* nB = has_next ? nxt.B : cB;
        for (int t = 0; t < nt; t += 2) {
            const bool last = (t == nt - 2);
            const char* a1 = cA + (size_t)(t + 1) * kstep;
            const char* a2 = last ? nA : cA + (size_t)(t + 2) * kstep; const char* b2 = last ? nB : cB + (size_t)(t + 2) * kstep;
            const char* a3 = a2 + kstep; const char* b3 = b2 + kstep;
            PG8_LDB(B0, 0, 0); PG8_LDB(B1, 0, 1); PG8_SCHED; PG8_LDA(At, 0, 0); PG8_STAGE(PG8_SA(1, 1), a1 + hstepA, voffA1);
            PG8_WAIT_V(8); PG8_WAIT_L(0); PG8_BAR; PG8_MMA(0, 0, At, B0); PG8_MMA(0, 1, At, B1); PG8_BAR; PG8_SCHED;
            PG8_LDA(At, 0, 1); PG8_STAGE(PG8_SB(0, 0), b2, voffB); PG8_STAGE(PG8_SB(0, 1), b2 + hstep, voffB); PG8_STAGE(PG8_SA(0, 0), a2, voffA);
            PG8_WAIT_V(8); PG8_WAIT_L(0); PG8_BAR; PG8_MMA(1, 0, At, B0); PG8_MMA(1, 1, At, B1); PG8_BAR; PG8_SCHED;
            PG8_LDB(B0, 1, 0); PG8_LDB(B1, 1, 1); PG8_SCHED; PG8_LDA(At, 1, 0); PG8_STAGE(PG8_SA(0, 1), a2 + hstepA, voffA1);
            PG8_WAIT_V(8); PG8_WAIT_L(0); PG8_BAR; PG8_MMA(0, 0, At, B0); PG8_MMA(0, 1, At, B1); PG8_BAR; PG8_SCHED;
            PG8_LDA(At, 1, 1); PG8_STAGE(PG8_SB(1, 0), b3, voffB); PG8_STAGE(PG8_SB(1, 1), b3 + hstep, voffB); PG8_STAGE(PG8_SA(1, 0), a3, voffA);
            PG8_WAIT_V(8); PG8_WAIT_L(0); PG8_BAR; PG8_MMA(1, 0, At, B0); PG8_MMA(1, 1, At, B1); PG8_BAR; PG8_SCHED;
        }
        if (wr == 0) PG8_BAR;
        { int l2; asm volatile("v_mbcnt_lo_u32_b32 %0, -1, 0\n\tv_mbcnt_hi_u32_b32 %0, -1, %0" : "=v"(l2)); E(acc, cur, wr, wc, l2 & 15, l2 >> 4); }
        if (!has_next) break;
#pragma unroll
        for (int a = 0; a < 2; ++a)
#pragma unroll
            for (int b = 0; b < 2; ++b)
#pragma unroll
                for (int m = 0; m < 4; ++m)
#pragma unroll
                    for (int n = 0; n < 2; ++n) acc[a][b][m][n] = (f32x4){0.f, 0.f, 0.f, 0.f};
        cur = nxt; cA = nA; cB = nB; ++ui;
        if (wr == 1) PG8_BAR;
    }
    PG8_WAIT_V(0);
    PG8_BAR;
#undef PG8_SA
#undef PG8_SB
#undef PG8_STAGE
#undef PG8_LDA
#undef PG8_LDB
#undef PG8_MMA
#undef PG8_WAIT_V
#undef PG8_WAIT_L
#undef PG8_BAR
#undef PG8_SCHED
}
}

#define GAS __attribute__((address_space(1)))
#define LAS __attribute__((address_space(3)))
typedef unsigned v4u __attribute__((ext_vector_type(4)));
typedef float f32x4 __attribute__((ext_vector_type(4)));
typedef short bf16x8 __attribute__((ext_vector_type(8)));
constexpr int NWAVES = 8;
constexpr int RING_BYTES = 131072, LDSCTL_OFF = RING_BYTES, MISC_OFF = LDSCTL_OFF + 320, LDS_BYTES = 147456;
constexpr size_t MiB = 1u << 20;
constexpr size_t CTL_ZERO_BYTES = 1 * MiB;
constexpr int CW_BAR = 4096;
constexpr int CW_MOE = 65536;
#define LDS_WAIT() asm volatile("s_waitcnt lgkmcnt(0)" ::: "memory")
#define VM_WAIT() asm volatile("s_waitcnt vmcnt(0)" ::: "memory")
DEV unsigned pk2(float lo, float hi) { return (unsigned)f2bf(lo) | ((unsigned)f2bf(hi) << 16); }

#define XB_TMO      128
#define XB_XCNT(j)  (256  + 64 * (j))
#define XB_XSUB(j)  (1280 + 64 * (j))
#define XB_XGEN(j)  (2304 + 64 * (j))
#define XB_TOP      3328
#define XB_TOPGEN   3392
#define XCD_BAR_WORDS 3456
#define XB_SPIN_CAP (1u << 22)
DEV unsigned xb_ld(unsigned* p)              { return __hip_atomic_load(p, __ATOMIC_RELAXED, __HIP_MEMORY_SCOPE_AGENT); }
DEV unsigned xb_add(unsigned* p, unsigned v) { return __hip_atomic_fetch_add(p, v, __ATOMIC_RELAXED, __HIP_MEMORY_SCOPE_AGENT); }
DEV unsigned xb_xcc_id() { return (unsigned)__builtin_amdgcn_s_getreg((3 << 11) | 20) & 0xFu; }
#define XB_SPIN(cond, bar) do { unsigned _sp = 0; while (cond) { __builtin_amdgcn_s_sleep(1); \
    if ((++_sp & 255u) == 0u) { if (xb_ld(&(bar)[XB_TMO])) break; if (_sp > XB_SPIN_CAP) { atomicAdd(&(bar)[XB_TMO], 1u); break; } } } } while (0)
struct XcdBarrier { unsigned* bar; unsigned x; volatile LAS unsigned* st; unsigned expect; };
DEV XcdBarrier xcd_barrier_post(unsigned* bar, volatile LAS unsigned* st) {
    XcdBarrier b; b.bar = bar; b.x = xb_xcc_id(); b.st = st; b.expect = 0u;
    if (threadIdx.x == 0) (void)xb_add(&bar[XB_XCNT(b.x)], 1u);
    return b;
}
DEV void xcd_barrier_complete(unsigned* bar, unsigned x, unsigned& nloc, unsigned& nx, unsigned expect) {
    const unsigned G = expect ? expect : gridDim.x * gridDim.y * gridDim.z;
    unsigned sum, cnt, mine, sp = 0u;
    for (;;) {
        sum = 0u; cnt = 0u; mine = 0u;
#pragma unroll
        for (unsigned j = 0; j < 16; ++j) { const unsigned c = xb_ld(&bar[XB_XCNT(j)]); sum += c; cnt += (c > 0u) ? 1u : 0u; mine = (j == x) ? c : mine; }
        if (sum == G) break;
        __builtin_amdgcn_s_sleep(1);
        if ((++sp & 255u) == 0u) { if (xb_ld(&bar[XB_TMO])) break; if (sp > XB_SPIN_CAP) { atomicAdd(&bar[XB_TMO], 1u); break; } }
    }
    nloc = mine > 0u ? mine : 1u; nx = cnt > 0u ? cnt : 1u;
}
DEV void xcd_barrier(const XcdBarrier& b, const int tid_) {
    asm volatile("s_waitcnt vmcnt(0)" ::: "memory");
    __syncthreads();
    if (tid_ == 0) {
        unsigned* bar = b.bar;
        __builtin_amdgcn_s_waitcnt(0);
        unsigned nloc = b.st[0], nx = b.st[1];
        if (nloc == 0u) { xcd_barrier_complete(bar, b.x, nloc, nx, b.expect); b.st[0] = nloc; b.st[1] = nx; }
        const unsigned old = xb_add(&bar[XB_XSUB(b.x)], 1u);
        const unsigned gen = old / nloc;
        if (old + 1u == (gen + 1u) * nloc) {
            __builtin_amdgcn_fence(__ATOMIC_RELEASE, "agent");
            asm volatile("s_waitcnt vmcnt(0)" ::: "memory");
            const unsigned og = xb_add(&bar[XB_TOP], 1u);
            const unsigned tg = og / nx;
            if (og + 1u == (tg + 1u) * nx) xb_add(&bar[XB_TOPGEN], 1u);
            else XB_SPIN(xb_ld(&bar[XB_TOPGEN]) == tg, bar);
            __builtin_amdgcn_fence(__ATOMIC_ACQUIRE, "agent");
            xb_add(&bar[XB_XGEN(b.x)], 1u);
            asm volatile("s_waitcnt vmcnt(0)" ::: "memory");
        } else {
            XB_SPIN(xb_ld(&bar[XB_XGEN(b.x)]) == gen, bar);
            __builtin_amdgcn_fence(__ATOMIC_ACQUIRE, "agent");
            asm volatile("s_waitcnt vmcnt(0)" ::: "memory");
        }
    }
    __syncthreads();
}

struct Frame {
    LAS unsigned char* lds;
    volatile LAS unsigned* MISC;
    int tid, lane, wave;
    int vcu, G;
};

DEV void refresh(Frame& F) { int l; asm volatile("v_mbcnt_lo_u32_b32 %0, -1, 0\n\tv_mbcnt_hi_u32_b32 %0, -1, %0" : "=v"(l)); F.lane = l; F.tid = F.wave * 64 + l; }
DEV int fresh_lane() { int l; asm volatile("v_mbcnt_lo_u32_b32 %0, -1, 0\n\tv_mbcnt_hi_u32_b32 %0, -1, %0" : "=v"(l)); return l; }
DEV float wave_sum(float v) {
#pragma unroll
    for (int o = 1; o < 64; o <<= 1) v += __shfl_xor(v, o);
    return v;
}
DEV void transpose_item(const float* W, int K, int N, bf16* WT, int k0, int n0, int dst_row0, LAS float* scr, int lane) {
    const int c4 = lane & 7, r0 = lane >> 3;
    const bool okc = (n0 + 4 * c4) < N;
    f32x4 v[8];
#pragma unroll
    for (int i = 0; i < 8; ++i) v[i] = okc ? *(const GAS f32x4*)(W + (size_t)(k0 + r0 + 8 * i) * N + n0 + 4 * c4) : (f32x4){0.f, 0.f, 0.f, 0.f};
#pragma unroll
    for (int i = 0; i < 8; ++i) { LAS float* d = scr + (r0 + 8 * i) * 33 + 4 * c4; d[0] = v[i].x; d[1] = v[i].y; d[2] = v[i].z; d[3] = v[i].w; }
    LDS_WAIT(); asm volatile("" ::: "memory");
    const int c = lane & 7;
#pragma unroll
    for (int j = 0; j < 4; ++j) { const int n = (lane >> 3) + 8 * j; const LAS float* s = scr + (8 * c) * 33 + n;
        v4u o; o.x = pk2(s[0 * 33], s[1 * 33]); o.y = pk2(s[2 * 33], s[3 * 33]); o.z = pk2(s[4 * 33], s[5 * 33]); o.w = pk2(s[6 * 33], s[7 * 33]);
        if (n0 + n < N) *(GAS v4u*)(WT + (size_t)(dst_row0 + n) * K + k0 + 8 * c) = o; }
    LDS_WAIT(); asm volatile("" ::: "memory");
}
DEV float rms_row_to_bf16(int lane, const float* xrow, const float* gain, bf16* orow) {
    const GAS f32x4* xr = (const GAS f32x4*)xrow + lane;
    const GAS f32x4* gr = (const GAS f32x4*)gain + lane;
    f32x4 v[4]; float s = 0.f;
#pragma unroll
    for (int j = 0; j < 4; ++j) { v[j] = xr[64 * j]; s += (v[j].x * v[j].x + v[j].y * v[j].y) + (v[j].z * v[j].z + v[j].w * v[j].w); }
    const float rstd = 1.0f / sqrtf(wave_sum(s) * (1.f / D) + EPS);
    GAS unsigned long long* o8 = (GAS unsigned long long*)orow + lane;
#pragma unroll
    for (int j = 0; j < 4; ++j) { const f32x4 g = gr[64 * j];
        o8[64 * j] = (unsigned long long)pk2(v[j].x * rstd * g.x, v[j].y * rstd * g.y) | ((unsigned long long)pk2(v[j].z * rstd * g.z, v[j].w * rstd * g.w) << 32); }
    return rstd;
}

DEV void fp_convert_weights(const Params& P, Frame& F, int which, int ci, int n) {
    LAS float* scr = (LAS float*)(F.lds + F.wave * 16384);
    const int gw = ci * NWAVES + F.wave, NGW = n * NWAVES;
    constexpr int I_IN0 = 16 * 72, I_OUT = 16 * 32, I_IN1 = 16 * 89;
    if (which == 0) {
        for (int it = gw; it < I_IN0 + I_OUT; it += NGW) {
            int r = it;
            if (r < I_IN0) { const int kb = r / 72, nb = r % 72; transpose_item(P.ev_w_in, D, EVEN_IN, P.win0t(), 64 * kb, 32 * nb, 32 * nb, scr, F.lane); continue; } r -= I_IN0;
            { const int kb = r / 32, nb = r % 32; transpose_item(P.ev_w_out, D, D, P.wout0t(), 64 * kb, 32 * nb, 32 * nb, scr, F.lane); }
        }
    } else {
        for (int it = gw; it < I_IN1 + I_OUT; it += NGW) {
            int r = it;
            if (r < I_IN1) { const int kb = r / 89, nb = r % 89; transpose_item(P.od_w_in, D, ODD_IN, P.win1t(), 64 * kb, 32 * nb, 32 * nb, scr, F.lane); continue; } r -= I_IN1;
            { const int kb = r / 32, nb = r % 32; transpose_item(P.od_w_out, D, D, P.wout1t(), 64 * kb, 32 * nb, 32 * nb, scr, F.lane); }
        }
    }
}
DEV void fp_norm_rows(Frame& F, const float* src, const float* gain, bf16* xn) {
    const int gw = F.vcu * NWAVES + F.wave, NGW = F.G * NWAVES, lane = F.lane;
    f32x4 gg[4];
    { const GAS f32x4* gr = (const GAS f32x4*)gain + lane;
#pragma unroll
      for (int j = 0; j < 4; ++j) gg[j] = gr[64 * j]; }
#pragma unroll 2
    for (int m = gw; m < T; m += NGW) {
        const GAS f32x4* xr = (const GAS f32x4*)(src + (size_t)m * D) + lane;
        f32x4 v[4]; float s = 0.f;
#pragma unroll
        for (int j = 0; j < 4; ++j) { v[j] = xr[64 * j]; s += (v[j].x * v[j].x + v[j].y * v[j].y) + (v[j].z * v[j].z + v[j].w * v[j].w); }
        const float rstd = 1.0f / sqrtf(wave_sum(s) * (1.f / D) + EPS);
        GAS unsigned long long* o8 = (GAS unsigned long long*)(xn + (size_t)m * D) + lane;
#pragma unroll
        for (int j = 0; j < 4; ++j)
            o8[64 * j] = (unsigned long long)pk2(v[j].x * rstd * gg[j].x, v[j].y * rstd * gg[j].y) | ((unsigned long long)pk2(v[j].z * rstd * gg[j].z, v[j].w * rstd * gg[j].w) << 32);
    }
}

constexpr int TAB_OFF = MISC_OFF + 128;
constexpr int RT_PART_OFF = 0;
constexpr int RT_SS_OFF = 98304;
constexpr int RT_HIST_OFF = 100352;
typedef float f32x4v __attribute__((ext_vector_type(4)));

DEV void fp_prep_router(const Params& P, Frame& F) {
    const int gtid = F.vcu * NWAVES * 64 + F.tid, gsz = F.G * NWAVES * 64;
    for (int i = gtid; i < 2 * 48 * D; i += gsz) {
        const int k = i & (D - 1), j = (i >> 10) % 48, l = i / (48 * D);
        float w = 0.f;
        if (j < 4) w = P.moe_w_grp[((size_t)l * D + k) * 4 + j]; else if (j < 36) w = P.moe_w_exp[((size_t)l * D + k) * 32 + (j - 4)];
        w *= P.moe_norm[l * D + k];
        const bf16 hi = f2bf(w); const bf16 lo = f2bf(w - bf2f(hi));
        P.wr()[((size_t)(l * 2 + 0) * 48 + j) * D + k] = hi;
        P.wr()[((size_t)(l * 2 + 1) * 48 + j) * D + k] = lo;
    }
}

DEV void fp_route(const Params& P, Frame& F, int layer) {
    const int lane = F.lane, w = F.wave;
    const bf16* wr_hi = P.wr() + (size_t)(layer * 2 + 0) * 48 * D;
    const bf16* wr_lo = P.wr() + (size_t)(layer * 2 + 1) * 48 * D;
    LAS float* part = (LAS float*)(F.lds + RT_PART_OFF);
    LAS float* ssp = (LAS float*)(F.lds + RT_SS_OFF);
    LAS unsigned* hist = (LAS unsigned*)(F.lds + RT_HIST_OFF);
    unsigned* cnt = P.ctl() + CW_MOE + layer * 256;
    for (int tb = F.vcu; tb < T / 64; tb += F.G) {
        const int t0 = tb * 64;
        if (F.tid < 64) hist[F.tid] = 0u;
        const float* xrow = P.out + (size_t)(t0 + (lane & 15)) * D + 128 * w + 8 * (lane >> 4);
        const size_t boff = (size_t)(lane & 15) * D + 128 * w + 8 * (lane >> 4);
        pg8::f32x4 acc[4][3];
        float ss[4] = {0.f, 0.f, 0.f, 0.f};
#pragma unroll
        for (int g = 0; g < 4; ++g)
#pragma unroll
            for (int c = 0; c < 3; ++c) acc[g][c] = (pg8::f32x4){0.f, 0.f, 0.f, 0.f};
#pragma unroll 1
        for (int ks = 0; ks < 4; ++ks) {
            bf16x8 bh[3], bl[3];
#pragma unroll
            for (int c = 0; c < 3; ++c) { bh[c] = *(const bf16x8*)(wr_hi + boff + (size_t)16 * c * D + 32 * ks); bl[c] = *(const bf16x8*)(wr_lo + boff + (size_t)16 * c * D + 32 * ks); }
            f32x4v xa[4], xb[4];
#pragma unroll
            for (int g = 0; g < 4; ++g) { xa[g] = *(const f32x4v*)(xrow + (size_t)16 * g * D + 32 * ks); xb[g] = *(const f32x4v*)(xrow + (size_t)16 * g * D + 32 * ks + 4); }
#pragma unroll
            for (int g = 0; g < 4; ++g) {
                float xv[8] = {xa[g].x, xa[g].y, xa[g].z, xa[g].w, xb[g].x, xb[g].y, xb[g].z, xb[g].w};
                bf16x8 ah, al;
#pragma unroll
                for (int j = 0; j < 8; ++j) { ss[g] += xv[j] * xv[j]; const bf16 h = f2bf(xv[j]); ah[j] = (short)h; al[j] = (short)f2bf(xv[j] - bf2f(h)); }
#pragma unroll
                for (int c = 0; c < 3; ++c) {
                    acc[g][c] = __builtin_amdgcn_mfma_f32_16x16x32_bf16(ah, bh[c], acc[g][c], 0, 0, 0);
                    acc[g][c] = __builtin_amdgcn_mfma_f32_16x16x32_bf16(ah, bl[c], acc[g][c], 0, 0, 0);
                    acc[g][c] = __builtin_amdgcn_mfma_f32_16x16x32_bf16(al, bh[c], acc[g][c], 0, 0, 0);
                }
            }
        }
#pragma unroll
        for (int g = 0; g < 4; ++g) {
            float s = ss[g]; s += __shfl_xor(s, 16); s += __shfl_xor(s, 32);
            if (lane < 16) ssp[w * 64 + 16 * g + lane] = s;
#pragma unroll
            for (int c = 0; c < 3; ++c)
#pragma unroll
                for (int r = 0; r < 4; ++r) part[(w * 64 + 16 * g + 4 * (lane >> 4) + r) * 48 + 16 * c + (lane & 15)] = acc[g][c][r];
        }
        __syncthreads();
        for (int i = F.tid; i < 64 * 48; i += NWAVES * 64) { float a = part[i];
#pragma unroll
            for (int ww = 1; ww < 8; ++ww) a += part[ww * 64 * 48 + i];
            part[i] = a; }
        if (F.tid < 64) { float a = ssp[F.tid];
#pragma unroll
            for (int ww = 1; ww < 8; ++ww) a += ssp[ww * 64 + F.tid];
            ssp[F.tid] = a; }
        __syncthreads();
        int e1 = 0, e2 = 0; float w1 = 0.f, w2 = 0.f; unsigned r1 = 0, r2 = 0;
        if (F.tid < 64) {
            const int t = t0 + F.tid;
            const float rs = 1.0f / sqrtf(ssp[F.tid] * (1.f / D) + EPS);
            P.rstd()[t] = rs;
            float lg[4], le[32];
#pragma unroll
            for (int j = 0; j < 4; ++j) lg[j] = part[F.tid * 48 + j] * rs + P.moe_b_grp[layer * 4 + j];
#pragma unroll
            for (int j = 0; j < 32; ++j) le[j] = part[F.tid * 48 + 4 + j] * rs + P.moe_b_exp[layer * 32 + j];
            int gs = 0; float gm = lg[0];
#pragma unroll
            for (int j = 1; j < 4; ++j) if (lg[j] > gm) { gm = lg[j]; gs = j; }
            float gz = 0.f;
#pragma unroll
            for (int j = 0; j < 4; ++j) gz += expf(lg[j] - gm);
            const float pg = 1.0f / gz;
            float wv[8];
#pragma unroll
            for (int j = 0; j < 8; ++j) wv[j] = gs == 0 ? le[j] : gs == 1 ? le[8 + j] : gs == 2 ? le[16 + j] : le[24 + j];
            int i1 = 0; float m1 = wv[0];
#pragma unroll
            for (int j = 1; j < 8; ++j) if (wv[j] > m1) { m1 = wv[j]; i1 = j; }
            int i2 = -1; float m2 = -3e38f;
#pragma unroll
            for (int j = 0; j < 8; ++j) if (j != i1 && wv[j] > m2) { m2 = wv[j]; i2 = j; }
            const float ex2 = expf(m2 - m1);
            w1 = pg / (1.0f + ex2); w2 = pg * ex2 / (1.0f + ex2);
            e1 = gs * 8 + i1; e2 = gs * 8 + i2;
            r1 = __hip_atomic_fetch_add(&hist[e1], 1u, __ATOMIC_RELAXED, __HIP_MEMORY_SCOPE_WORKGROUP); r2 = __hip_atomic_fetch_add(&hist[e2], 1u, __ATOMIC_RELAXED, __HIP_MEMORY_SCOPE_WORKGROUP);
        }
        __syncthreads();
        if (F.tid < 32) { const unsigned h = hist[F.tid]; hist[32 + F.tid] = h ? xb_add(&cnt[F.tid], h) : 0u; }
        __syncthreads();
        if (F.tid < 64) {
            const int t = t0 + F.tid;
            P.eid()[t * 2 + 0] = e1; P.eid()[t * 2 + 1] = e2; P.ew()[t * 2 + 0] = w1; P.ew()[t * 2 + 1] = w2;
            const int i1x = (int)(hist[32 + e1] + r1), i2x = (int)(hist[32 + e2] + r2);
            P.pos()[t * 2 + 0] = i1x; P.pos()[t * 2 + 1] = i2x;
            P.rowtok()[e1 * T + i1x] = t; P.rowtok()[e2 * T + i2x] = t;
        }
        { const GAS f32x4* gr = (const GAS f32x4*)(P.moe_norm + layer * D) + lane;
          f32x4 gg[4];
#pragma unroll
          for (int j = 0; j < 4; ++j) gg[j] = gr[64 * j];
#pragma unroll 2
          for (int ri = 0; ri < 8; ++ri) { const int r = w + NWAVES * ri;
              const float rs = 1.0f / sqrtf(ssp[r] * (1.f / D) + EPS);
              const GAS f32x4* xr = (const GAS f32x4*)(P.out + (size_t)(t0 + r) * D) + lane;
              GAS unsigned long long* o8 = (GAS unsigned long long*)(P.xn() + (size_t)(t0 + r) * D) + lane;
#pragma unroll
              for (int j = 0; j < 4; ++j) { const f32x4 v = xr[64 * j];
                  o8[64 * j] = (unsigned long long)pk2(v.x * rs * gg[j].x, v.y * rs * gg[j].y) | ((unsigned long long)pk2(v.z * rs * gg[j].z, v.w * rs * gg[j].w) << 32); }
          } }
        __syncthreads();
    }
}

DEV void moe_table(const Params& P, Frame& F, int layer) {
    volatile LAS int* tab = (volatile LAS int*)(F.lds + TAB_OFF);
    if (F.tid == 0) {
        unsigned* cnt = P.ctl() + CW_MOE + layer * 256;
        int acc = 0;
        for (int e = 0; e < 32; ++e) { tab[e] = acc; acc += (int)((xb_ld(&cnt[e]) + 255u) >> 8); }
        tab[32] = acc;
    }
    __syncthreads();
}

struct ListOrder {
    int code[8]; int n, npn; const char* A; const char* Bt; size_t tstep, bstep;
    __device__ __forceinline__ bool next(int i, pg8::Unit& o) const {
        if (i >= n) return false;
        const int c = (i == 0) ? code[0] : (i == 1) ? code[1] : (i == 2) ? code[2] : (i == 3) ? code[3] : (i == 4) ? code[4] : (i == 5) ? code[5] : (i == 6) ? code[6] : code[7];
        const int tt = c >> 8, e = (c >> 3) & 31, pn = c & 7;
        o.pm = tt; o.pn = pn; o.A = A + (size_t)tt * tstep; o.B = Bt + (size_t)(e * npn + pn) * bstep; return true;
    }
};
DEV int moe_expert_of(volatile LAS int* tab, int tt) { int e = 0; for (int q = 1; q < 32; ++q) e += (tt >= tab[q]) ? 1 : 0; return __builtin_amdgcn_readfirstlane(e); }
DEV void moe_run_gu(const Params& P, Frame& F, int layer, volatile LAS int* tab, int tt, int pn) {
    const int e = moe_expert_of(tab, tt);
    const int rbase = e * T + (tt - tab[e]) * 256;
    unsigned g[2][2]; const int tid_ = F.wave * 64 + fresh_lane();
#pragma unroll
    for (int hh = 0; hh < 2; ++hh)
#pragma unroll
        for (int i = 0; i < 2; ++i) { int R, C; pg8::stage_rc(tid_ * 16 + i * 8192, R, C); int tk = P.rowtok()[rbase + hh * 128 + R]; tk = ((unsigned)tk < (unsigned)T) ? tk : 0; g[hh][i] = (unsigned)tk * (unsigned)(D * 2); }
    ListOrder L; L.tstep = 0; L.A = (const char*)P.xn(); L.Bt = (const char*)P.wgut(layer); L.npn = 2; L.n = 1; L.bstep = (size_t)256 * D * 2;
#pragma unroll
    for (int i = 0; i < 8; ++i) L.code[i] = 0;
    L.code[0] = (tt << 8) | (e << 3) | pn;
    pg8::EpiSiluMul E{P.hid(), 256}; pg8::gemm_phase<pg8::EpiSiluMul, ListOrder, true>(F.lds, D, L, E, F.wave, g[0][0], g[0][1], g[1][0], g[1][1]);
}
DEV void moe_run_dn(const Params& P, Frame& F, int layer, volatile LAS int* tab, int tbase, int d0, int dstep, int dend) {
    ListOrder L; L.tstep = (size_t)256 * 256 * 2; L.bstep = L.tstep; L.A = (const char*)P.hid(); L.Bt = (const char*)P.wdt(layer); L.npn = 4;
    int n = 0;
#pragma unroll
    for (int i = 0; i < 8; ++i) { const int d = d0 + i * dstep; int code = 0;
        if (d < dend) { const int tt = tbase + (d >> 2); code = (tt << 8) | (moe_expert_of(tab, tt) << 3) | (d & 3); n = i + 1; }
        L.code[i] = code; }
    L.n = __builtin_amdgcn_readfirstlane(n);
    if (L.n == 0) return;
    pg8::EpiStoreBf16 E{P.ha(), D}; pg8::gemm_phase(F.lds, 256, L, E, F.wave);
}
DEV void fp_moe_rounds(const Params& P, Frame& F, int layer, int wi, int W, const XcdBarrier& wb) {
    moe_table(P, F, layer);
    volatile LAS int* tab = (volatile LAS int*)(F.lds + TAB_OFF);
    const int ntile = __builtin_amdgcn_readfirstlane(tab[32]);
    const int n1 = 2 * ntile < W ? 2 * ntile : W, T1 = n1 >> 1, g2 = 2 * ntile - n1;
    if (wi < n1) moe_run_gu(P, F, layer, tab, wi >> 1, wi & 1);
    refresh(F); xcd_barrier(wb, F.tid);
    if (wi < g2) { const int u = n1 + wi; moe_run_gu(P, F, layer, tab, u >> 1, u & 1); }
    else moe_run_dn(P, F, layer, tab, 0, wi - g2, W - g2, 4 * T1);
    refresh(F); xcd_barrier(wb, F.tid);
    moe_run_dn(P, F, layer, tab, T1, wi, W, 4 * (ntile - T1));
}
DEV void fp_combine(const Params& P, Frame& F, int layer, const float* gain2, bf16* xn) {
    moe_table(P, F, layer);
    volatile LAS int* tab = (volatile LAS int*)(F.lds + TAB_OFF);
    const int gw = F.vcu * NWAVES + F.wave, NGW = F.G * NWAVES, lane = F.lane;
    int p1v = 0, p2v = 0; float w1v = 0.f, w2v = 0.f;
    { const int tj = gw + lane * NGW;
      if (tj < T) { p1v = tab[P.eid()[tj * 2]] * 256 + P.pos()[tj * 2]; p2v = tab[P.eid()[tj * 2 + 1]] * 256 + P.pos()[tj * 2 + 1]; w1v = P.ew()[tj * 2]; w2v = P.ew()[tj * 2 + 1]; } }
    f32x4 gg[4];
    if (xn) { const GAS f32x4* gr = (const GAS f32x4*)gain2 + lane;
#pragma unroll
        for (int j = 0; j < 4; ++j) gg[j] = gr[64 * j]; }
    int jj = 0;
#pragma unroll 2
    for (int t = gw; t < T; t += NGW, ++jj) {
        const int p1 = __builtin_amdgcn_readlane(p1v, jj), p2 = __builtin_amdgcn_readlane(p2v, jj);
        const float w1 = u2f((unsigned)__builtin_amdgcn_readlane((int)f2u(w1v), jj)), w2 = u2f((unsigned)__builtin_amdgcn_readlane((int)f2u(w2v), jj));
        GAS f32x4* xr = (GAS f32x4*)(P.out + (size_t)t * D) + lane;
        const GAS unsigned long long* y1 = (const GAS unsigned long long*)(P.ha() + (size_t)p1 * D) + lane;
        const GAS unsigned long long* y2 = (const GAS unsigned long long*)(P.ha() + (size_t)p2 * D) + lane;
        f32x4 v[4]; float s = 0.f;
#pragma unroll
        for (int j = 0; j < 4; ++j) {
            v[j] = xr[64 * j];
            const unsigned long long a = y1[64 * j], b = y2[64 * j];
            v[j].x += w1 * u2f((unsigned)(a & 0xffffu) << 16) + w2 * u2f((unsigned)(b & 0xffffu) << 16);
            v[j].y += w1 * u2f((unsigned)((a >> 16) & 0xffffu) << 16) + w2 * u2f((unsigned)((b >> 16) & 0xffffu) << 16);
            v[j].z += w1 * u2f((unsigned)((a >> 32) & 0xffffu) << 16) + w2 * u2f((unsigned)((b >> 32) & 0xffffu) << 16);
            v[j].w += w1 * u2f((unsigned)((a >> 48) & 0xffffu) << 16) + w2 * u2f((unsigned)((b >> 48) & 0xffffu) << 16);
            xr[64 * j] = v[j];
            s += (v[j].x * v[j].x + v[j].y * v[j].y) + (v[j].z * v[j].z + v[j].w * v[j].w);
        }
        if (xn) {
            const float rstd = 1.0f / sqrtf(wave_sum(s) * (1.f / D) + EPS);
            GAS unsigned long long* o8 = (GAS unsigned long long*)(xn + (size_t)t * D) + lane;
#pragma unroll
            for (int j = 0; j < 4; ++j) { const f32x4 g = gg[j];
                o8[64 * j] = (unsigned long long)pk2(v[j].x * rstd * g.x, v[j].y * rstd * g.y) | ((unsigned long long)pk2(v[j].z * rstd * g.z, v[j].w * rstd * g.w) << 32); }
        }
    }
}


DEV void fp_convert_moe_part(const Params& P, Frame& F, int layer, int ci, int nconv) {
    LAS float* scr = (LAS float*)(F.lds + F.wave * 16384);
    constexpr int NIT = 32 * 384;
    for (int it = ci * NWAVES + F.wave; it < NIT; it += nconv * NWAVES) {
        const int e = it / 384; int r = it % 384;
        const size_t eo = (size_t)(layer * 32 + e);
        if (r < 256) { const bool up = r >= 128; r &= 127; const int kb = r / 8, nb = r % 8; const int f0 = 32 * nb;
            const float* W = (up ? P.moe_w_up : P.moe_w_gate) + eo * D * 256;
            transpose_item(W, D, 256, P.wgut(layer) + (size_t)e * 512 * D, 64 * kb, f0, (f0 >> 7) * 256 + (up ? 128 : 0) + (f0 & 127), scr, F.lane);
        } else { r -= 256; const int kb = r / 32, nb = r % 32;
            transpose_item(P.moe_w_down + eo * 256 * D, 256, D, P.wdt(layer) + (size_t)e * D * 256, 64 * kb, 32 * nb, 32 * nb, scr, F.lane); }
    }
}
namespace att {
typedef float f32x16 __attribute__((ext_vector_type(16)));
typedef short s16x4 __attribute__((ext_vector_type(4)));
typedef short v4i16_t __attribute__((ext_vector_type(4)));
typedef LAS const char* lptr;
constexpr float LOG2E = 1.4426950408889634f;
constexpr int KS0 = 0, VS0 = 32768, SLOT = 8192;
constexpr int SCR0 = 65536;
constexpr float MNEG = -1e30f;

struct TileRegs { v4u k, v; };
DEV void tile_load(TileRegs& R, const bf16* Kg, const bf16* Vg, int pitch, int k0, int tid) {
    const int w = tid >> 6, lane = tid & 63;
    R.k = *(const GAS v4u*)(Kg + (size_t)(k0 + lane) * pitch + w * 8);
    R.v = *(const GAS v4u*)(Vg + (size_t)(k0 + 16 * (w & 3) + (lane >> 2)) * pitch + (w >> 2) * 32 + (lane & 3) * 8);
}
DEV void tile_store(LAS unsigned char* lds, int slot, const TileRegs& R, int tid) {
    *(LAS v4u*)(lds + KS0 + slot * SLOT + tid * 16) = R.k;
    *(LAS v4u*)(lds + VS0 + slot * SLOT + tid * 16) = R.v;
}
DEV void qk_tile(f32x16& p0, f32x16& p1, lptr Kslot, const bf16x8 (&qr)[4], int r32, int hi) {
    lptr kb = Kslot + hi * 1024 + r32 * 16;
    __builtin_amdgcn_s_setprio(1);
#pragma unroll
    for (int dh = 0; dh < 2; ++dh) {
        bf16x8 kf[4];
#pragma unroll
        for (int d1 = 0; d1 < 2; ++d1) { kf[2 * d1] = *(const LAS bf16x8*)(kb + (2 * dh + d1) * 2048); kf[2 * d1 + 1] = *(const LAS bf16x8*)(kb + (2 * dh + d1) * 2048 + 512); }
#pragma unroll
        for (int d1 = 0; d1 < 2; ++d1) {
            p0 = __builtin_amdgcn_mfma_f32_32x32x16_bf16(kf[2 * d1], qr[2 * dh + d1], p0, 0, 0, 0);
            p1 = __builtin_amdgcn_mfma_f32_32x32x16_bf16(kf[2 * d1 + 1], qr[2 * dh + d1], p1, 0, 0, 0);
        }
    }
    __builtin_amdgcn_s_setprio(0);
}
DEV float fadd_s(float a, float b) { float r; asm("v_add_f32_e32 %0, %1, %2" : "=v"(r) : "v"(a), "v"(b)); return r; }
DEV float ffma_s(float a, float b, float c) { float r; asm("v_fma_f32 %0, %1, %2, %3" : "=v"(r) : "v"(a), "v"(b), "v"(c)); return r; }
DEV void bias_init(f32x16& p0, f32x16& p1, float s, float base) {
#pragma unroll
    for (int r = 0; r < 16; ++r) { const int kr = (r & 3) + 8 * (r >> 2); p0[r] = fmaf(s, (float)kr, base); p1[r] = fmaf(s, (float)(kr + 32), base); }
}
DEV s16x4 vtr(lptr p) { return __builtin_bit_cast(s16x4, __builtin_amdgcn_ds_read_tr16_b64_v4i16((LAS v4i16_t*)p)); }
DEV unsigned cvtpk(float lo, float hi) { unsigned r; asm volatile("v_cvt_pk_bf16_f32 %0, %1, %2" : "=v"(r) : "v"(lo), "v"(hi)); return r; }
DEV void pv_tile(f32x16 (&o)[2], lptr Vslot, const f32x16& p0, const f32x16& p1, int lane) {
    const int hi = lane >> 5;
    lptr vp = Vslot + ((lane >> 4) & 1) * 32 + (lane & 3) * 8 + (4 * hi + ((lane & 15) >> 2)) * 64;
    bf16x8 pf[4];
#pragma unroll
    for (int ks = 0; ks < 4; ++ks) {
        const f32x16& p = (ks < 2) ? p0 : p1; const int b = (ks & 1) * 8;
        v4u w; w.x = cvtpk(p[b + 0], p[b + 1]); w.y = cvtpk(p[b + 2], p[b + 3]); w.z = cvtpk(p[b + 4], p[b + 5]); w.w = cvtpk(p[b + 6], p[b + 7]);
        pf[ks] = __builtin_bit_cast(bf16x8, w);
    }
    __builtin_amdgcn_s_setprio(1);
#pragma unroll
    for (int ks = 0; ks < 4; ++ks)
#pragma unroll
        for (int d0 = 0; d0 < 2; ++d0) {
            const s16x4 lo = vtr(vp + d0 * 4096 + ks * 1024), hh = vtr(vp + d0 * 4096 + ks * 1024 + 512);
            const bf16x8 vf = (bf16x8){lo[0], lo[1], lo[2], lo[3], hh[0], hh[1], hh[2], hh[3]};
            o[d0] = __builtin_amdgcn_mfma_f32_32x32x16_bf16(vf, pf[ks], o[d0], 0, 0, 0);
        }
    __builtin_amdgcn_s_setprio(0);
}
DEV float lane_swap_max(float m) {
    auto rr = __builtin_amdgcn_permlane32_swap(__float_as_uint(m), __float_as_uint(m), false, false);
    return fmaxf(__uint_as_float(rr[0]), __uint_as_float(rr[1]));
}
DEV float lane_swap_sum(float m) {
    auto rr = __builtin_amdgcn_permlane32_swap(__float_as_uint(m), __float_as_uint(m), false, false);
    return __uint_as_float(rr[0]) + __uint_as_float(rr[1]);
}
DEV float lane_partner(float m, int hi) {
    auto rr = __builtin_amdgcn_permlane32_swap(__float_as_uint(m), __float_as_uint(m), false, false);
    return hi ? __uint_as_float(rr[0]) : __uint_as_float(rr[1]);
}

constexpr float M0 = 16.0f;
struct SoftState { float l; f32x16 o[2]; };
DEV void soft_reset(SoftState& s) { s.l = 0.f; s.o[0] = f32x16{}; s.o[1] = f32x16{}; }

DEV void soft_tile(SoftState& st, f32x16& p0, f32x16& p1, int klo, int klim, bool need_mask, lptr Vslot, int lane) {
    float ls0 = 0.f, ls1 = 0.f;
    if (need_mask) {
#pragma unroll
        for (int r = 0; r < 16; ++r) {
            const int kr = (r & 3) + 8 * (r >> 2);
            const float x0 = __builtin_amdgcn_exp2f(p0[r]), x1 = __builtin_amdgcn_exp2f(p1[r]);
            p0[r] = (kr > klo && kr <= klim) ? x0 : 0.f; p1[r] = (kr + 32 > klo && kr + 32 <= klim) ? x1 : 0.f;
            ls0 += p0[r]; ls0 += p1[r];
        }
    } else {
#pragma unroll
        for (int r = 0; r < 16; ++r) { p0[r] = __builtin_amdgcn_exp2f(p0[r]); p1[r] = __builtin_amdgcn_exp2f(p1[r]); ls0 += p0[r]; ls0 += p1[r]; }
    }
    st.l += ls0 + ls1;
    pv_tile(st.o, Vslot, p0, p1, lane);
}

DEV void soft_pair_fast(SoftState& st, const bf16x8 (&qr)[4], lptr Ka, lptr Va, lptr Kb, lptr Vb, float s2, float baseA, float baseB, int lane) {
    const int r32 = lane & 31, hi = lane >> 5;
    f32x16 a0, a1, b0, b1;
    bias_init(a0, a1, s2, baseA); bias_init(b0, b1, s2, baseB);
    qk_tile(a0, a1, Ka, qr, r32, hi);
    qk_tile(b0, b1, Kb, qr, r32, hi);
    float ls0 = 0.f, ls1 = 0.f;
#pragma unroll
    for (int r = 0; r < 16; ++r) { a0[r] = __builtin_amdgcn_exp2f(a0[r]); a1[r] = __builtin_amdgcn_exp2f(a1[r]); ls0 += a0[r]; ls0 += a1[r]; }
    pv_tile(st.o, Va, a0, a1, lane);
#pragma unroll
    for (int r = 0; r < 16; ++r) { b0[r] = __builtin_amdgcn_exp2f(b0[r]); b1[r] = __builtin_amdgcn_exp2f(b1[r]); ls0 += b0[r]; ls0 += b1[r]; }
    st.l += ls0 + ls1;
    pv_tile(st.o, Vb, b0, b1, lane);
}

DEV void store_ot(const f32x16 (&o)[2], float f, bf16* orow, int hi) {
#pragma unroll
    for (int d0 = 0; d0 < 2; ++d0)
#pragma unroll
        for (int g = 0; g < 4; ++g) {
            const unsigned a = cvtpk(o[d0][4 * g] * f, o[d0][4 * g + 1] * f), b = cvtpk(o[d0][4 * g + 2] * f, o[d0][4 * g + 3] * f);
            *(GAS unsigned long long*)(orow + 32 * d0 + 8 * g + 4 * hi) = (unsigned long long)a | ((unsigned long long)b << 32);
        }
}
DEV void load_q(bf16x8 (&qr)[4], const bf16* qrow, int hi) {
    const float c1 = 0.125f * LOG2E;
#pragma unroll
    for (int d0 = 0; d0 < 4; ++d0) {
        const v4u x = *(const GAS v4u*)(qrow + 16 * d0 + 8 * hi);
        v4u y;
        y.x = pk2(u2f(x.x << 16) * c1, u2f(x.x & 0xffff0000u) * c1); y.y = pk2(u2f(x.y << 16) * c1, u2f(x.y & 0xffff0000u) * c1);
        y.z = pk2(u2f(x.z << 16) * c1, u2f(x.z & 0xffff0000u) * c1); y.w = pk2(u2f(x.w << 16) * c1, u2f(x.w & 0xffff0000u) * c1);
        qr[d0] = __builtin_bit_cast(bf16x8, y);
    }
}

template <bool FAST, class MaskF>
DEV void run_segment(Frame& F, SoftState& st, const bf16x8 (&qr)[4], const bf16* Kg, const bf16* Vg, int pitch, unsigned long long tmask, float s2, int qpos, const MaskF& mf) {
    const int tid = F.tid, lane = F.lane, r32 = lane & 31, hi = lane >> 5;
    if (tmask == 0ull) return;
#define NEXT_TILE(var) do { if (tmask) { var = __builtin_ctzll(tmask); tmask &= tmask - 1ull; } else var = -1; } while (0)
#define SEG_COMPUTE(t, slot) do { int klo, klim; mf((t), klo, klim); \
        if (__any(klim >= 0 && klo < 60 && klim > klo)) { \
            const bool none_ = klim < 0 || klo >= 59 || klim <= klo, full_ = klim >= 59 && klo < 0;        \
            const bool need_mask = __any(!none_ && !full_); f32x16 p0, p1; \
            bias_init(p0, p1, s2, none_ ? MNEG : s2 * (float)((t) * 64 - qpos + 4 * hi) - M0); \
            qk_tile(p0, p1, (lptr)(F.lds + KS0 + (slot) * SLOT), qr, r32, hi); \
            soft_tile(st, p0, p1, klo, klim, need_mask, (lptr)(F.lds + VS0 + (slot) * SLOT), lane); } } while (0)
    int ta, tb, tc, td, set = 0;
    NEXT_TILE(ta); NEXT_TILE(tb);
    TileRegs RA, RB; tile_load(RA, Kg, Vg, pitch, ta * 64, tid); if (tb >= 0) tile_load(RB, Kg, Vg, pitch, tb * 64, tid);
    for (;;) {
        tile_store(F.lds, 2 * set, RA, tid); if (tb >= 0) tile_store(F.lds, 2 * set + 1, RB, tid);
        NEXT_TILE(tc); NEXT_TILE(td);
        if (tc >= 0) tile_load(RA, Kg, Vg, pitch, tc * 64, tid);
        if (td >= 0) tile_load(RB, Kg, Vg, pitch, td * 64, tid);
        __syncthreads();
        bool fast = false;
        if (FAST && tb >= 0) {
            int kloA, klimA, kloB, klimB; mf(ta, kloA, klimA); mf(tb, kloB, klimB);
            const bool fullA = klimA >= 59 && kloA < 0, noneA = klimA < 0 || kloA >= 59 || klimA <= kloA;
            const bool fullB = klimB >= 59 && kloB < 0, noneB = klimB < 0 || kloB >= 59 || klimB <= kloB;
            fast = __all((fullA || noneA) && (fullB || noneB)) && __any(fullA) && __any(fullB);
            if (fast) {
                const float hb = (float)(4 * hi - qpos);
                const float baseA = fullA ? s2 * ((float)(ta * 64) + hb) - M0 : MNEG, baseB = fullB ? s2 * ((float)(tb * 64) + hb) - M0 : MNEG;
                soft_pair_fast(st, qr, (lptr)(F.lds + KS0 + (2 * set) * SLOT), (lptr)(F.lds + VS0 + (2 * set) * SLOT), (lptr)(F.lds + KS0 + (2 * set + 1) * SLOT), (lptr)(F.lds + VS0 + (2 * set + 1) * SLOT), s2, baseA, baseB, lane);
            }
        }
        if (!fast) {
            SEG_COMPUTE(ta, 2 * set);
            if (tb >= 0) SEG_COMPUTE(tb, 2 * set + 1);
        }
        if (tc < 0) break;
        ta = tc; tb = td; set ^= 1;
    }
    __syncthreads();
#undef NEXT_TILE
#undef SEG_COMPUTE
}
DEV unsigned long long tile_range(int t0, int t1) { return (t1 < t0) ? 0ull : ((~0ull >> (63 - (t1 - t0))) << t0); }
}

DEV void headnorm_group(bf16* row, int off, int nheads, const float* g, int lane) {
    const int hg = lane >> 3, ch = lane & 7;
    if (hg < nheads) {
        GAS v4u* p = (GAS v4u*)(row + off + hg * 64 + ch * 8);
        const v4u x = *p;
        float v[8] = {u2f(x.x << 16), u2f(x.x & 0xffff0000u), u2f(x.y << 16), u2f(x.y & 0xffff0000u), u2f(x.z << 16), u2f(x.z & 0xffff0000u), u2f(x.w << 16), u2f(x.w & 0xffff0000u)};
        float ss = 0.f;
#pragma unroll
        for (int j = 0; j < 8; ++j) ss += v[j] * v[j];
        ss += __shfl_xor(ss, 1); ss += __shfl_xor(ss, 2); ss += __shfl_xor(ss, 4);
        const float r = 1.0f / sqrtf(ss * (1.0f / 64) + EPS);
        const f32x4 g0 = *(const GAS f32x4*)(g + ch * 8), g1 = *(const GAS f32x4*)(g + ch * 8 + 4);
        v4u o; o.x = pk2(v[0] * r * g0.x, v[1] * r * g0.y); o.y = pk2(v[2] * r * g0.z, v[3] * r * g0.w); o.z = pk2(v[4] * r * g1.x, v[5] * r * g1.y); o.w = pk2(v[6] * r * g1.z, v[7] * r * g1.w);
        *p = o;
    }
}
DEV void fp_headnorm(const Params& P, Frame& F, int layer) {
    const int gw = F.vcu * NWAVES + F.wave, NGW = F.G * NWAVES, lane = F.lane;
    for (int t = gw; t < T; t += NGW) {
        bf16* row = P.proj() + (size_t)t * LDP;
        if (layer == 0) {
            headnorm_group(row, 0, 8, P.ev_q_norm, lane);
            headnorm_group(row, 512, 2, P.ev_k_norm, lane);
        } else {
            headnorm_group(row, 0, 8, P.od_c_q_norm, lane);
            headnorm_group(row, 512, 8, P.od_c_k_norm, lane);
            headnorm_group(row, 1536, 8, P.od_d_q_norm, lane);
            headnorm_group(row, 2304, 2, P.od_d_k_norm + 64, lane);
            headnorm_group(row, 2560, 2, P.od_d_k_norm + 128, lane);
        }
    }
}

DEV void fp_prep_compress(const Params& P, Frame& F, int ci, int n) {
    const int gw = ci * NWAVES + F.wave, NGW = n * NWAVES, lane = F.lane;
    for (int i = gw; i < 128; i += NGW) {
        const int which = i >> 6, e = i & 63;
        const float* pos = P.od_cmp_pos + which * 2048; const float* w = P.od_cmp_w + (size_t)which * 2048 * 64 + e;
        float s = 0.f;
        for (int k = lane; k < 2048; k += 64) s += pos[k] * w[(size_t)k * 64];
        s = wave_sum(s);
        if (lane == 0) P.cbias()[i] = s;
    }
    LAS float* scr = (LAS float*)(F.lds + F.wave * 16384);
    for (int i = gw; i < 128; i += NGW) {
        const int which = i >> 6, r = i & 63, kb = r >> 1, nb = r & 1;
        transpose_item(P.od_cmp_w + (size_t)which * 2048 * 64, 2048, 64, P.wcmpt() + (size_t)which * 64 * 2048, 64 * kb, 32 * nb, 32 * nb, scr, lane);
    }
}

DEV void fp_prep1(const Params& P, Frame& F) {
    const int gw = F.vcu * NWAVES + F.wave, NGW = F.G * NWAVES, lane = F.lane, w = F.wave;
    for (int i = gw; i < NB * 64; i += NGW) {
        const int n = i & 7, h = (i >> 3) & 7, b = i >> 6;
        const bf16* kp = P.proj() + ((size_t)b * S + n * 256) * LDP + 512 + h * 64 + lane;
        float s0 = 0.f, s1 = 0.f, s2 = 0.f, s3 = 0.f;
#pragma unroll 4
        for (int j = 0; j < 256; j += 4) { s0 += bf2f(kp[(size_t)j * LDP]); s1 += bf2f(kp[(size_t)(j + 1) * LDP]); s2 += bf2f(kp[(size_t)(j + 2) * LDP]); s3 += bf2f(kp[(size_t)(j + 3) * LDP]); }
        P.kmean()[(size_t)i * 64 + lane] = ((s0 + s1) + (s2 + s3)) * (1.0f / 256);
    }
    LAS float* part = (LAS float*)F.lds;
    for (int it = F.vcu; it < 2 * NB * 2 * 8; it += F.G) {
        const int ng = it & 7, hkv = (it >> 3) & 1, b = (it >> 4) % NB, which = it / (16 * NB);
        const int n = 16 * ng + (lane & 15);
        const int ncl = n > 126 ? 126 : n;
        const bf16* arow = P.proj() + ((size_t)b * S + ncl * 16) * LDP + (which ? 2176 : 2048) + hkv * 64 + 8 * (lane >> 4);
        const bf16* brow = P.wcmpt() + (size_t)which * 64 * 2048 + (size_t)(lane & 15) * 2048 + 8 * (lane >> 4);
        pg8::f32x4 acc[4];
#pragma unroll
        for (int c = 0; c < 4; ++c) acc[c] = (pg8::f32x4){0.f, 0.f, 0.f, 0.f};
#pragma unroll
        for (int kk = 0; kk < 8; ++kk) {
            const int ks = 8 * w + kk, li = ks >> 1, dh = (ks & 1) * 32;
            const bf16x8 a = *(const GAS bf16x8*)(arow + (size_t)li * LDP + dh);
#pragma unroll
            for (int c = 0; c < 4; ++c) {
                const bf16x8 bb = *(const GAS bf16x8*)(brow + (size_t)(16 * c) * 2048 + 32 * ks);
                acc[c] = __builtin_amdgcn_mfma_f32_16x16x32_bf16(a, bb, acc[c], 0, 0, 0);
            }
        }
#pragma unroll
        for (int c = 0; c < 4; ++c)
#pragma unroll
            for (int r = 0; r < 4; ++r) part[(w * 16 + 4 * (lane >> 4) + r) * 64 + 16 * c + (lane & 15)] = acc[c][r];
        __syncthreads();
        {
            const int row = F.tid >> 5, c0 = 2 * (F.tid & 31);
            float v0 = P.cbias()[which * 64 + c0], v1 = P.cbias()[which * 64 + c0 + 1];
#pragma unroll
            for (int ww = 0; ww < 8; ++ww) { v0 += part[(ww * 16 + row) * 64 + c0]; v1 += part[(ww * 16 + row) * 64 + c0 + 1]; }
            if (which == 0) {
                float ss = v0 * v0 + v1 * v1;
                ss += __shfl_xor(ss, 1); ss += __shfl_xor(ss, 2); ss += __shfl_xor(ss, 4); ss += __shfl_xor(ss, 8); ss += __shfl_xor(ss, 16);
                const float rs = 1.0f / sqrtf(ss * (1.0f / 64) + EPS);
                v0 *= rs * P.od_d_k_norm[c0]; v1 *= rs * P.od_d_k_norm[c0 + 1];
            }
            const int nn = 16 * ng + row;
            if (nn < NCMP) *(GAS unsigned*)(P.kvcmp() + (((size_t)(which * NB + b) * NCMP + nn) * 2 + hkv) * 64 + c0) = pk2(v0, v1);
        }
        __syncthreads();
    }
}

template <bool MASK>
DEV void sb_tile(att::f32x16& p0, att::f32x16& p1, float& carry, int lim, int hi) {
    using namespace att;
    f32x16 k0, k1;
    float cp[2][4];
#pragma unroll
    for (int hf = 0; hf < 2; ++hf)
#pragma unroll
        for (int g = 0; g < 4; ++g) {
            float pr = 1.f;
#pragma unroll
            for (int i = 0; i < 4; ++i) {
                const int r = 4 * g + i, kr = i + 8 * g + 32 * hf;
                float e1 = __builtin_amdgcn_exp2f(hf ? p1[r] : p0[r]);
                float kp = __builtin_amdgcn_rcpf(1.0f + e1);
                if (MASK) { const bool ok = kr < lim; e1 = ok ? e1 : 0.f; kp = ok ? kp : 1.f; }
                if (hf) { p1[r] = e1; k1[r] = kp; } else { p0[r] = e1; k0[r] = kp; }
                pr *= kp;
            }
            cp[hf][g] = pr;
        }
    float run = carry;
#pragma unroll
    for (int hf = 1; hf >= 0; --hf)
#pragma unroll
        for (int g = 3; g >= 0; --g) {
            const float mine = cp[hf][g], other = lane_partner(mine, hi);
            float suf = hi ? run : run * other;
            run *= mine * other;
#pragma unroll
            for (int i = 3; i >= 0; --i) {
                const int r = 4 * g + i;
                if (hf) { suf *= k1[r]; p1[r] *= suf; } else { suf *= k0[r]; p0[r] *= suf; }
            }
        }
    carry = run;
}

DEV void fp_attn0(const Params& P, Frame& F) {
    using namespace att;
    const int tid = F.tid, lane = F.lane, r32 = lane & 31, hi = lane >> 5, w = F.wave;
    for (int u = F.vcu; u < 512; u += F.G) {
        {
            const int b = u >> 6, h = (u >> 3) & 7, blk = u & 7;
            const bf16* base = P.proj() + (size_t)b * S * LDP;
            const int q = blk * 256 + w * 32 + r32;
            bf16x8 qr[4]; load_q(qr, base + (size_t)q * LDP + 768 + h * 64, hi);
            const bf16* Kg = base + 1280 + h * 64; const bf16* Vg = base + 1792 + h * 64;
            f32x16 o[2]; o[0] = f32x16{}; o[1] = f32x16{};
            float carry = 1.f;
            const int tmax = blk * 4 + 3;
            const int tw = (blk * 256 + w * 32 + 31) >> 6;
            volatile LAS int* flag = (volatile LAS int*)(F.lds + LDSCTL_OFF + 12288);
            if (tid < 3) flag[tid] = 0;
            TileRegs RA, RB, RC;
            tile_load(RA, Kg, Vg, LDP, tmax * 64, tid); tile_load(RB, Kg, Vg, LDP, (tmax - 1) * 64, tid); tile_load(RC, Kg, Vg, LDP, (tmax - 2) * 64, tid);
            bool wave_done = false, stop = false;
#define SB_STEP(RX, t_) do { const int t = (t_); \
                tile_store(F.lds, t & 3, RX, tid); \
                if (t >= 3) tile_load(RX, Kg, Vg, LDP, (t - 3) * 64, tid); \
                __syncthreads(); \
                if (t < tmax && flag[(t + 1) % 3] == 0) { stop = true; break; } \
                if (tid == 0) flag[(t + 2) % 3] = 0; \
                if (!wave_done && t <= tw) { \
                    f32x16 p0 = f32x16{}, p1 = f32x16{}; \
                    qk_tile(p0, p1, (lptr)(F.lds + KS0 + (t & 3) * SLOT), qr, r32, hi); \
                    if (t * 64 + 63 < blk * 256 + w * 32) sb_tile<false>(p0, p1, carry, 64, hi); else sb_tile<true>(p0, p1, carry, q - t * 64 - 4 * hi, hi); \
                    pv_tile(o, (lptr)(F.lds + VS0 + (t & 3) * SLOT), p0, p1, lane); \
                    if (__all(carry == 0.f)) wave_done = true; \
                } \
                if (!wave_done && lane == 0) flag[t % 3] = 1; } while (0)
            for (int t3 = tmax; t3 >= 0 && !stop; t3 -= 3) {
                SB_STEP(RA, t3);
                if (stop || t3 - 1 < 0) break;
                SB_STEP(RB, t3 - 1);
                if (stop || t3 - 2 < 0) break;
                SB_STEP(RC, t3 - 2);
            }
#undef SB_STEP
            __syncthreads();
            store_ot(o, 1.0f, P.o() + (size_t)(b * S + q) * D + 512 + h * 64, hi);
        }
    }
    asm volatile("" ::: "memory");
    for (int u = 512 + F.vcu; u < 1024; u += F.G) {
        {
            const int v = u - 512, b = v >> 6, hkv = (v >> 5) & 1, c = v & 31;
            const bf16* base = P.proj() + (size_t)b * S * LDP;
            const int hh = hkv * 4 + (w >> 1), q = c * 64 + (w & 1) * 32 + r32;
            bf16x8 qr[4]; load_q(qr, base + (size_t)q * LDP + hh * 64, hi);
            const float sl = exp2f(-(float)(hh + 1)), s2 = sl * LOG2E;
            SoftState st; soft_reset(st);
            const int t0 = c - 2 < 0 ? 0 : c - 2;
            run_segment<true>(F, st, qr, base + 512 + hkv * 64, base + 640 + hkv * 64, LDP, tile_range(t0, c), s2, q,
                        [&](int t, int& klo, int& klim) { klim = q - t * 64 - 4 * hi; klo = klim - 128; });
            const float den = lane_swap_sum(st.l) + __builtin_amdgcn_exp2f(P.ev_sink[hh] * LOG2E - M0);
            store_ot(st.o, 1.0f / den, P.o() + (size_t)(b * S + q) * D + hh * 64, hi);
        }
    }
}

DEV void fp_attn1(const Params& P, Frame& F) {
    using namespace att;
    const int lane = F.lane, r32 = lane & 31, hi = lane >> 5, w = F.wave;
    for (int u = F.vcu; u < 512; u += F.G) {
        {
            const int v = u & 255, bh = v >> 2, blk = (u < 256) ? (v & 3) : 7 - (v & 3);
            const int b = bh >> 3, h = bh & 7;
            const bf16* base = P.proj() + (size_t)b * S * LDP;
            const int q = blk * 256 + w * 32 + r32;
            bf16x8 qr[4]; load_q(qr, base + (size_t)q * LDP + h * 64, hi);
            const float sl = exp2f(-(float)(h + 1)), s2 = sl * LOG2E;
            float gt[8];
#pragma unroll
            for (int n = 0; n < 8; ++n) {
                float g = 0.f;
                if (n < blk) {
                    const float* km = P.kmean() + ((size_t)(b * 8 + h) * 8 + n) * 64;
#pragma unroll
                    for (int d0 = 0; d0 < 4; ++d0)
#pragma unroll
                        for (int j = 0; j < 8; ++j) g += bf2f((bf16)qr[d0][j]) * km[16 * d0 + 8 * hi + j];
                }
                g = lane_swap_sum(g);
                gt[n] = n < blk ? g : NEG;
            }
            unsigned sel = 0;
#pragma unroll
            for (int n = 0; n < 8; ++n) {
                int rank = 0;
#pragma unroll
                for (int k = 0; k < 8; ++k) rank += (gt[k] > gt[n] || (gt[k] == gt[n] && k < n)) ? 1 : 0;
                if (rank < 3 && n < blk) sel |= 1u << n;
            }
            SoftState st; soft_reset(st);
            run_segment<true>(F, st, qr, base + 512 + h * 64, base + 1024 + h * 64, LDP, tile_range(0, blk * 4 + 3), s2, q,
                        [&](int t, int& klo, int& klim) { const int n = t >> 2; klo = -1;
                            if (n < blk) klim = ((sel >> n) & 1) ? 63 : -1; else klim = q - t * 64 - 4 * hi; });
            const float l = lane_swap_sum(st.l);
            store_ot(st.o, 1.0f / l, P.o() + (size_t)(b * S + q) * D + h * 64, hi);
        }
    }
    asm volatile("" ::: "memory");
    for (int u = 512 + F.vcu; u < 1024; u += F.G) {
        {
            const int v = u & 255, bk = v >> 4, c = (u < 768) ? (v & 15) : 31 - (v & 15);
            const int b = bk >> 1, hkv = bk & 1;
            const bf16* base = P.proj() + (size_t)b * S * LDP;
            const int h = hkv * 4 + (w >> 1), q = c * 64 + (w & 1) * 32 + r32, t = b * S + q;
            bf16x8 qr[4]; load_q(qr, base + (size_t)q * LDP + 1536 + h * 64, hi);
            const float sl = exp2f(-(float)(h + 1)), s2 = sl * LOG2E;
            const bf16* grow = base + (size_t)q * LDP + 2816 + h * 3;
            LAS float* part = (LAS float*)(F.lds + SCR0);
            volatile LAS unsigned long long* tot = (volatile LAS unsigned long long*)(F.lds + SCR0 + 33792);
            volatile LAS unsigned* selm = (volatile LAS unsigned*)(F.lds + SCR0 + 33792 + 16896);
            f32x16 fin[2];
            {
                const int ntile = c >= 16 ? 2 : 1;
                const bf16* Kc = P.kvcmp() + ((size_t)(0 * NB + b) * NCMP) * 128 + hkv * 64;
                const bf16* Vc = P.kvcmp() + ((size_t)(1 * NB + b) * NCMP) * 128 + hkv * 64;
                { TileRegs R0; tile_load(R0, Kc, Vc, 128, 0, F.tid); tile_store(F.lds, 0, R0, F.tid); }
                if (ntile == 2) { TileRegs R1; tile_load(R1, Kc, Vc, 128, 64, F.tid); tile_store(F.lds, 1, R1, F.tid); }
                __syncthreads();
                const int nlim = (q - 31) >> 4;
                const float s16 = 16.0f * s2;
                const float basec = s2 * (float)(31 - q) + s16 * (float)(4 * hi);
                float lsum = 0.f;
                for (int tl = 0; tl < ntile; ++tl) {
                    const int klim = nlim - 64 * tl - 4 * hi; const float bt = basec + s16 * (float)(64 * tl) - M0;
                    f32x16 x0, x1; bias_init(x0, x1, s16, bt); qk_tile(x0, x1, (lptr)(F.lds + KS0 + tl * SLOT), qr, r32, hi);
#pragma unroll
                    for (int r = 0; r < 16; ++r) {
                        const int kr = (r & 3) + 8 * (r >> 2);
                        lsum += kr <= klim ? __builtin_amdgcn_exp2f(x0[r]) : 0.f;
                        lsum += kr + 32 <= klim ? __builtin_amdgcn_exp2f(x1[r]) : 0.f;
                    }
                }
                lsum = lane_swap_sum(lsum);
                const float inv = nlim >= 0 ? 1.0f / lsum : 0.f;
                fin[0] = f32x16{}; fin[1] = f32x16{};
                LAS float* prow = part + ((w >> 1) * 64 + (w & 1) * 32 + r32) * 33;
                float peprev = 0.f;
                for (int tl = 0; tl < ntile; ++tl) {
                    const int klim = nlim - 64 * tl - 4 * hi; const float bt = basec + s16 * (float)(64 * tl) - M0;
                    f32x16 x0, x1; bias_init(x0, x1, s16, bt); qk_tile(x0, x1, (lptr)(F.lds + KS0 + tl * SLOT), qr, r32, hi);
#pragma unroll
                    for (int r = 0; r < 16; ++r) {
                        const int kr = (r & 3) + 8 * (r >> 2);
                        x0[r] = kr <= klim ? __builtin_amdgcn_exp2f(x0[r]) * inv : 0.f;
                        x1[r] = kr + 32 <= klim ? __builtin_amdgcn_exp2f(x1[r]) * inv : 0.f;
                    }
#pragma unroll
                    for (int ix = 0; ix < 8; ++ix) {
                        const int g = ix & 3;
                        const float C = (ix < 4) ? (x0[4 * g] + x0[4 * g + 1]) + (x0[4 * g + 2] + x0[4 * g + 3]) : (x1[4 * g] + x1[4 * g + 1]) + (x1[4 * g + 2] + x1[4 * g + 3]);
                        const float pe = lane_partner((ix < 4) ? x0[4 * g + 3] : x1[4 * g + 3], hi);
                        prow[2 * (8 * tl + ix) + hi] = C + (hi ? pe : peprev);
                        peprev = pe;
                    }
                    pv_tile(fin, (lptr)(F.lds + VS0 + tl * SLOT), x0, x1, lane);
                }
                { const float g0 = 1.0f / (1.0f + __expf(-bf2f(grow[0])));
#pragma unroll
                for (int r = 0; r < 16; ++r) { fin[0][r] *= g0; fin[1][r] *= g0; } }
            }
            __syncthreads();
            {
                const int ql = F.tid >> 3, jg = F.tid & 7;
#pragma unroll
                for (int jj = 0; jj < 4; ++jj) {
                    const int j = 4 * jg + jj;
                    float sc = ((part[(0 * 64 + ql) * 33 + j] + part[(1 * 64 + ql) * 33 + j]) + part[(2 * 64 + ql) * 33 + j]) + part[(3 * 64 + ql) * 33 + j];
                    const bool forced = (j == 0) || (j == c) || (j == c - 1);
                    sc = (j <= c) ? sc + (forced ? 1000.0f : 0.0f) : NEG;
                    const unsigned ub = f2u(sc), ord = ub ^ ((ub >> 31) ? 0xffffffffu : 0x80000000u);
                    tot[ql * 33 + j] = ((unsigned long long)ord << 32) | (unsigned)(31 - j);
                }
                __syncthreads();
                unsigned long long mine[4];
#pragma unroll
                for (int jj = 0; jj < 4; ++jj) mine[jj] = tot[ql * 33 + 4 * jg + jj];
                int rank[4] = {0, 0, 0, 0};
                for (int k = 0; k < 32; ++k) {
                    const unsigned long long sk = tot[ql * 33 + k];
#pragma unroll
                    for (int jj = 0; jj < 4; ++jj) rank[jj] += (sk > mine[jj]) ? 1 : 0;
                }
                unsigned bits = 0;
#pragma unroll
                for (int jj = 0; jj < 4; ++jj) if (rank[jj] < 16 && 4 * jg + jj <= c) bits |= 1u << (4 * jg + jj);
                bits |= __shfl_xor(bits, 1); bits |= __shfl_xor(bits, 2); bits |= __shfl_xor(bits, 4);
                if (jg == 0) selm[ql] = bits;
                unsigned ub = bits; ub |= __shfl_xor(ub, 8); ub |= __shfl_xor(ub, 16); ub |= __shfl_xor(ub, 32);
                if (lane == 0) selm[64 + w] = ub;
            }
            __syncthreads();
            const unsigned mask = selm[(w & 1) * 32 + r32];
            const unsigned umask = ((selm[64] | selm[65]) | (selm[66] | selm[67])) | ((selm[68] | selm[69]) | (selm[70] | selm[71]));
            __syncthreads();
            LAS float* stg = (LAS float*)(F.lds + SCR0) + w * 2048 + lane;
#pragma unroll
            for (int r = 0; r < 16; ++r) { stg[r * 64] = fin[0][r]; stg[(16 + r) * 64] = fin[1][r]; }
            SoftState st; soft_reset(st);
            run_segment<false>(F, st, qr, base + 2304 + hkv * 64, base + 2432 + hkv * 64, LDP, (unsigned long long)umask, s2, q,
                        [&](int tt, int& klo, int& klim) { klo = -1; klim = ((mask >> tt) & 1) ? (q - tt * 64 - 4 * hi) : -1; });
            { const float g1 = 1.0f / (1.0f + __expf(-bf2f(grow[1]))); const float f = g1 / lane_swap_sum(st.l);
#pragma unroll
              for (int r = 0; r < 16; ++r) { stg[r * 64] += f * st.o[0][r]; stg[(16 + r) * 64] += f * st.o[1][r]; } }
            soft_reset(st);
            run_segment<true>(F, st, qr, base + 2560 + hkv * 64, base + 2688 + hkv * 64, LDP, tile_range(c - 8 < 0 ? 0 : c - 8, c), s2, q,
                        [&](int tt, int& klo, int& klim) { klim = q - tt * 64 - 4 * hi; klo = klim - 512; });
            { const float g2 = 1.0f / (1.0f + __expf(-bf2f(grow[2]))); const float f = g2 / lane_swap_sum(st.l);
#pragma unroll
              for (int r = 0; r < 16; ++r) { st.o[0][r] = stg[r * 64] + f * st.o[0][r]; st.o[1][r] = stg[(16 + r) * 64] + f * st.o[1][r]; } }
            store_ot(st.o, 1.0f, P.o() + (size_t)t * D + 512 + h * 64, hi);
            __syncthreads();
        }
    }
}
enum { PH_PRE = 0, PH_INPROJ0, PH_ATTN0, PH_OUTPROJ0, PH_ROUTE0, PH_FFN0, PH_COMBINE0, PH_INPROJ1, PH_PREP1, PH_ATTN1, PH_OUTPROJ1, PH_ROUTE1, PH_FFN1, PH_COMBINE1, PH_COUNT };
struct FArgs { Params p; };

#ifndef PROBE_PHASE
#define PROBE_PHASE -1
#endif
constexpr int STAMP_OFF = LDSCTL_OFF + 1024;
constexpr int HN_OFF = LDSCTL_OFF + 2048;
DEV void stampk(Frame& F, int k) {
    if (PROBE_PHASE >= 0 && F.tid == 0) ((volatile LAS unsigned*)(F.lds + STAMP_OFF))[k] = (unsigned)__builtin_amdgcn_s_memrealtime() | 1u;
}
__global__ void __launch_bounds__(NWAVES * 64, 2) k_fast(FArgs args) {
    extern __shared__ __attribute__((aligned(16))) unsigned char lds[];
    const Params& P = args.p;
    Frame F;
    F.lds = (LAS unsigned char*)lds;
    F.MISC = (volatile LAS unsigned*)(F.lds + MISC_OFF);
    F.tid = threadIdx.x; F.lane = F.tid & 63; F.wave = __builtin_amdgcn_readfirstlane(F.tid >> 6);
    F.G = gridDim.x; { const int bx = blockIdx.x; F.vcu = (F.G % 8 == 0) ? (bx % 8) * (F.G / 8) + bx / 8 : bx; }
    for (int u = F.tid; u < (LDS_BYTES - LDSCTL_OFF) / 4; u += NWAVES * 64) ((LAS unsigned*)(F.lds + LDSCTL_OFF))[u] = 0u;
    __syncthreads();
    XcdBarrier bar = xcd_barrier_post(P.ctl() + CW_BAR, F.MISC + 8);
#define BEGIN(k) refresh(F); stampk(F, (k));
#define SEAM() do { refresh(F); xcd_barrier(bar, F.tid); } while (0)
    { BEGIN(PH_PRE) fp_convert_weights(P, F, 0, F.vcu, F.G); fp_prep_router(P, F); fp_norm_rows(F, P.x, P.ev_norm, P.xn()); if (F.G != 256) { fp_convert_weights(P, F, 1, F.vcu, F.G); fp_prep_compress(P, F, F.vcu, F.G); } SEAM(); }
    { BEGIN(PH_INPROJ0) const int cq = F.vcu >> 2, cr = F.vcu & 3, gi = 3 * cq + cr;
      if (F.G == 256 && cr == 3) fp_convert_moe_part(P, F, 0, cq, 64);
      else { pg8::StaticOrder So; So.init(P.xn(), P.win0t(), T, EVEN_IN, D, F.G == 256 ? 192 : F.G, F.G == 256 ? gi : F.vcu);
        pg8::EpiProjNorm<0> E{P.proj(), LDP, P.ev_q_norm, P.ev_k_norm, nullptr, nullptr, nullptr, (PG8_LAS float*)(F.lds + HN_OFF)};
        pg8::gemm_phase(F.lds, D, So, E, F.wave); if (F.G != 256) { refresh(F); fp_convert_moe_part(P, F, 0, F.vcu, F.G); } }
      SEAM(); }
    { BEGIN(PH_ATTN0) fp_attn0(P, F); SEAM(); }
    { BEGIN(PH_OUTPROJ0) pg8::StaticOrder So; So.init(P.o(), P.wout0t(), T, D, D, F.G, (int)blockIdx.x);
      pg8::EpiResidF32 E{P.x, P.out, D}; pg8::gemm_phase(F.lds, D, So, E, F.wave); SEAM(); }
    { BEGIN(PH_ROUTE0) fp_route(P, F, 0); SEAM(); }
    { BEGIN(PH_FFN0) const int cq = F.vcu >> 2, cr = F.vcu & 3, gi = 3 * cq + cr;
      if (F.G == 256 && cr == 3) { fp_convert_weights(P, F, 1, cq, 64); fp_prep_compress(P, F, cq, 64); fp_convert_moe_part(P, F, 1, cq, 64); }
      else if (F.G == 256) { XcdBarrier wb = xcd_barrier_post(P.ctl() + CW_BAR + XCD_BAR_WORDS, F.MISC + 10); wb.expect = 192u; fp_moe_rounds(P, F, 0, gi, 192, wb); }
      else { XcdBarrier wb = xcd_barrier_post(P.ctl() + CW_BAR + XCD_BAR_WORDS, F.MISC + 10); fp_moe_rounds(P, F, 0, F.vcu, F.G, wb); refresh(F); fp_convert_weights(P, F, 1, F.vcu, F.G); fp_prep_compress(P, F, F.vcu, F.G); fp_convert_moe_part(P, F, 1, F.vcu, F.G); }
      SEAM(); }
    { BEGIN(PH_COMBINE0) fp_combine(P, F, 0, P.od_norm, P.xn()); SEAM(); }
    { BEGIN(PH_INPROJ1) pg8::StaticOrder So; So.init(P.xn(), P.win1t(), T, LDP, D, F.G, (int)blockIdx.x);
      pg8::EpiProjNorm<1> E{P.proj(), LDP, P.od_c_q_norm, P.od_c_k_norm, P.od_d_q_norm, P.od_d_k_norm + 64, P.od_d_k_norm + 128, (PG8_LAS float*)(F.lds + HN_OFF)};
      pg8::gemm_phase(F.lds, D, So, E, F.wave); SEAM(); }
    { BEGIN(PH_PREP1) fp_prep1(P, F); SEAM(); }
    { BEGIN(PH_ATTN1) fp_attn1(P, F); SEAM(); }
    { BEGIN(PH_OUTPROJ1) pg8::StaticOrder So; So.init(P.o(), P.wout1t(), T, D, D, F.G, (int)blockIdx.x);
      pg8::EpiResidF32 E{P.out, P.out, D}; pg8::gemm_phase(F.lds, D, So, E, F.wave); SEAM(); }
    { BEGIN(PH_ROUTE1) fp_route(P, F, 1); SEAM(); }
    { BEGIN(PH_FFN1) XcdBarrier wb = xcd_barrier_post(P.ctl() + CW_BAR + 2 * XCD_BAR_WORDS, F.MISC + 12); fp_moe_rounds(P, F, 1, F.vcu, F.G, wb); SEAM(); }
    { BEGIN(PH_COMBINE1) fp_combine(P, F, 1, nullptr, nullptr); }
    if (PROBE_PHASE >= 0) {
        refresh(F);
        if (F.vcu == 0 && F.tid == 0) {
            volatile LAS unsigned* st = (volatile LAS unsigned*)(F.lds + STAMP_OFF);
            const unsigned t1 = (PROBE_PHASE + 1 < PH_COUNT) ? st[(PROBE_PHASE + 1 < PH_COUNT) ? PROBE_PHASE + 1 : 0] : ((unsigned)__builtin_amdgcn_s_memrealtime() | 1u);
            const unsigned t0 = st[PROBE_PHASE < 0 ? 0 : PROBE_PHASE];
            asm volatile("s_waitcnt vmcnt(0)" ::: "memory");
#ifndef PROBE_SCALE
#define PROBE_SCALE 0.01f
#endif
            P.out[0] += (float)(t1 - t0) * PROBE_SCALE;
        }
    }
#undef BEGIN
#undef SEAM
}

static size_t carve(Params& p, void* d_ws) { p.ws = (char*)d_ws; return WS_END; }

extern "C" void kernel_launch(void* const* d_in, const int* in_sizes, int n_in, void* d_out, int out_size, void* d_ws, size_t ws_size,
                              hipStream_t stream) {
    Params p{};
    const float** f = (const float**)&p;
    for (int i = 0; i < 24; ++i) f[i] = (const float*)d_in[i];
    p.out = (float*)d_out;
    const size_t need = carve(p, d_ws);
    static int grid = 0;
    if (grid == 0) {
        int dev = 0, cus = 0, per_cu = 0;
        if (hipGetDevice(&dev) != hipSuccess || hipDeviceGetAttribute(&cus, hipDeviceAttributeMultiprocessorCount, dev) != hipSuccess) { grid = -1; return; }
        if (hipFuncSetAttribute((const void*)k_fast, hipFuncAttributeMaxDynamicSharedMemorySize, LDS_BYTES) != hipSuccess) { fprintf(stderr, "hipFuncSetAttribute failed\n"); grid = -1; return; }
        if (hipOccupancyMaxActiveBlocksPerMultiprocessor(&per_cu, (const void*)k_fast, NWAVES * 64, LDS_BYTES) != hipSuccess || per_cu < 1) { fprintf(stderr, "occupancy query: %d\n", per_cu); (void)hipGetLastError(); grid = -1; return; }
        grid = cus;
        if (need > ws_size) { fprintf(stderr, "workspace too small: need %zu have %zu\n", need, ws_size); grid = -1; return; }
    }
    if (grid < 0) return;
    (void)hipMemsetAsync(d_ws, 0, CTL_ZERO_BYTES, stream);
    FArgs a{}; a.p = p;
    hipLaunchKernelGGL(k_fast, dim3(grid), dim3(NWAVES * 64), LDS_BYTES, stream, a);
}
```

```cpp
#include <hip/hip_runtime.h>
#include <cstdio>
#include <cstdint>
#define DEV __device__ __forceinline__

#ifndef NB
#define NB 8
#endif
typedef unsigned short bf16;
constexpr int S = 2048, D = 1024, T = NB * S, HD = 64;
constexpr int EVEN_IN = 2304, ODD_IN = 2840, LDP = 3072;
constexpr int NCMP = 127, NSLC = 32;
constexpr float NEG = -1e30f;
constexpr float EPS = 1e-6f;
constexpr int RMAX = 2 * T + 32 * 256;

DEV float u2f(unsigned u) { return __builtin_bit_cast(float, u); }
DEV unsigned f2u(float f) { return __builtin_bit_cast(unsigned, f); }
DEV float bf2f(bf16 h) { return u2f(((unsigned)h) << 16); }
DEV bf16 f2bf(float f) { unsigned u = f2u(f); u += 0x7fffu + ((u >> 16) & 1u); return (bf16)(u >> 16); }

constexpr size_t MiB_ = (size_t)1 << 20;
__host__ __device__ constexpr size_t al256c(size_t x) { return (x + 255) & ~(size_t)255; }
constexpr size_t WS_CTL = 0, WS_WIN0T = 1 * MiB_, WS_WOUT0T = 6 * MiB_, WS_WIN1T = 8 * MiB_, WS_WOUT1T = 14 * MiB_, WS_WGUT0 = 16 * MiB_, WS_WDT0 = 48 * MiB_,
                 WS_PROJ = 64 * MiB_  , WS_XN = 160 * MiB_, WS_O = 192 * MiB_  ,
                 WS_RSTD = 224 * MiB_, WS_EID = al256c(WS_RSTD + (size_t)T * 4), WS_EW = al256c(WS_EID + (size_t)T * 8), WS_KMEAN = al256c(WS_EW + (size_t)T * 8),
                 WS_KVCMP = al256c(WS_KMEAN + (size_t)NB * 8 * 8 * 64 * 4), WS_POS = al256c(WS_KVCMP + (size_t)2 * NB * 128 * 2 * 64 * 2), WS_WR = al256c(WS_POS + (size_t)T * 8),
                 WS_WCMPT = al256c(WS_WR + (size_t)2 * 2 * 48 * D * 2), WS_CBIAS = al256c(WS_WCMPT + (size_t)2 * 64 * 2048 * 2), WS_SSQ = al256c(WS_CBIAS + 512), WS_MISC_END = al256c(WS_SSQ + (size_t)T * 16 * 4),
                 WS_WGUT1 = 228 * MiB_, WS_WDT1 = 260 * MiB_, WS_ROWTOK = 276 * MiB_, WS_END = 278 * MiB_;
static_assert(WS_MISC_END <= WS_WGUT1, "misc region overflows");
struct Params {
    const float *x, *ev_norm, *ev_w_in, *ev_q_norm, *ev_k_norm, *ev_sink, *ev_w_out;
    const float *od_norm, *od_w_in, *od_c_q_norm, *od_c_k_norm, *od_d_q_norm, *od_d_k_norm, *od_cmp_pos, *od_cmp_w, *od_w_out;
    const float *moe_norm, *moe_w_grp, *moe_b_grp, *moe_w_exp, *moe_b_exp, *moe_w_gate, *moe_w_up, *moe_w_down;
    float* out;
    char* ws;
    DEV unsigned* ctl() const { return (unsigned*)(ws + WS_CTL); }
    DEV bf16* win0t() const { return (bf16*)(ws + WS_WIN0T); }
    DEV bf16* wout0t() const { return (bf16*)(ws + WS_WOUT0T); }
    DEV bf16* win1t() const { return (bf16*)(ws + WS_WIN1T); }
    DEV bf16* wout1t() const { return (bf16*)(ws + WS_WOUT1T); }
    DEV bf16* wgut(int l) const { return (bf16*)(ws + (l ? WS_WGUT1 : WS_WGUT0)); }
    DEV bf16* wdt(int l) const { return (bf16*)(ws + (l ? WS_WDT1 : WS_WDT0)); }
    DEV bf16* proj() const { return (bf16*)(ws + WS_PROJ); }
    DEV bf16* ha() const { return (bf16*)(ws + WS_PROJ); }
    DEV bf16* xn() const { return (bf16*)(ws + WS_XN); }
    DEV bf16* o() const { return (bf16*)(ws + WS_O); }
    DEV bf16* hid() const { return (bf16*)(ws + WS_O); }
    DEV float* rstd() const { return (float*)(ws + WS_RSTD); }
    DEV int* eid() const { return (int*)(ws + WS_EID); }
    DEV float* ew() const { return (float*)(ws + WS_EW); }
    DEV float* kmean() const { return (float*)(ws + WS_KMEAN); }
    DEV bf16* kvcmp() const { return (bf16*)(ws + WS_KVCMP); }
    DEV int* pos() const { return (int*)(ws + WS_POS); }
    DEV bf16* wr() const { return (bf16*)(ws + WS_WR); }
    DEV bf16* wcmpt() const { return (bf16*)(ws + WS_WCMPT); }
    DEV float* cbias() const { return (float*)(ws + WS_CBIAS); }
    DEV float* ssq() const { return (float*)(ws + WS_SSQ); }
    DEV int* rowtok() const { return (int*)(ws + WS_ROWTOK); }
};


namespace pg8 {
#define PG8_LAS __attribute__((address_space(3)))
typedef unsigned short bf16_t;
typedef short bf16x8 __attribute__((ext_vector_type(8)));
typedef float f32x4 __attribute__((ext_vector_type(4)));
typedef unsigned u32x4 __attribute__((ext_vector_type(4)));
constexpr int BM = 256, BK = 64, HALF = 128, HTB = HALF * BK * 2, STAGE_BYTES = 8 * HTB, NXCD = 8, WGM = 8;

__host__ __device__ __forceinline__ int lds_byte(int r, int c) { const int st = (r >> 4) * 2 + (c >> 5), rr = r & 15, cc = c & 31, ob = rr * 64 + cc * 2; return st * 1024 + (ob ^ (((ob >> 9) & 1) << 5)); }
__host__ __device__ __forceinline__ void stage_rc(int b, int& R, int& C) { const int st = b / 1024, sb = b % 1024, swz = sb ^ (((sb >> 9) & 1) << 5); R = (st >> 1) * 16 + swz / 64; C = (st & 1) * 32 + (swz % 64) / 2; }
__host__ __device__ __forceinline__ int perm32(int rho) { const int n = rho >> 4, i = rho & 15; return 8 * (i >> 2) + 4 * n + (i & 3); }

struct Unit { const char* A; const char* B; int pm, pn; };

struct StaticOrder {
    int nM, nN, nwg, G, c; const char* A; const char* Bt; size_t tstep;
    __device__ void init(const bf16_t* A_, const bf16_t* Bt_, int M, int N, int K, int G_, int c_) { nM = M / BM; nN = N / BM; nwg = nM * nN; G = G_; c = c_; A = (const char*)A_; Bt = (const char*)Bt_; tstep = (size_t)BM * K * 2; }
    __device__ bool next(int i, Unit& u) const {
        const long L = (long)i * G + c; if (L >= nwg) return false;
        int wgid = (int)L; { const int q = nwg / NXCD, r = nwg % NXCD, xcd = wgid % NXCD, off = wgid / NXCD; wgid = (xcd < r ? xcd * (q + 1) : r * (q + 1) + (xcd - r) * q) + off; }
        const int nig = WGM * nN, gid = wgid / nig, fm = gid * WGM, gsz = (nM - fm) < WGM ? (nM - fm) : WGM;
        u.pm = fm + ((wgid % nig) % gsz); u.pn = (wgid % nig) / gsz; u.A = A + (size_t)u.pm * tstep; u.B = Bt + (size_t)u.pn * tstep; return true;
    }
};

__device__ __forceinline__ unsigned cvt_pk_bf16(float lo, float hi) { unsigned r; asm volatile("v_cvt_pk_bf16_f32 %0, %1, %2" : "=v"(r) : "v"(lo), "v"(hi)); return r; }

struct EpiStoreBf16 {
    static constexpr bool PERM = true;
    bf16_t* O; int ldc;
    __device__ __forceinline__ void operator()(const f32x4 (&acc)[2][2][4][2], const Unit& u, int wr, int wc, int fr, int fq) const {
        const int row0 = u.pm * BM + wr * 64 + fr, col0 = u.pn * BM + wc * 32 + 8 * fq;
#pragma unroll
        for (int ai = 0; ai < 2; ++ai)
#pragma unroll
            for (int m = 0; m < 4; ++m) { bf16_t* rowp = O + (size_t)(row0 + ai * HALF + m * 16) * ldc + col0;
#pragma unroll
                for (int bj = 0; bj < 2; ++bj) { const f32x4 v0 = acc[ai][bj][m][0], v1 = acc[ai][bj][m][1];
                    u32x4 w; w.x = cvt_pk_bf16(v0[0], v0[1]); w.y = cvt_pk_bf16(v0[2], v0[3]); w.z = cvt_pk_bf16(v1[0], v1[1]); w.w = cvt_pk_bf16(v1[2], v1[3]);
                    *(u32x4*)(rowp + bj * HALF) = w; } }
    }
};

template <int LAYER> struct EpiProjNorm {
    static constexpr bool PERM = true;
    bf16_t* O; int ldc; const float *g0, *g1, *g2, *g3, *g4; PG8_LAS float* hn;
    __device__ __forceinline__ const float* gain_of(int H) const {
        if (LAYER == 0) return H < 8 ? g0 : (H < 10 ? g1 : nullptr);
        return H < 8 ? g0 : H < 16 ? g1 : (H >= 24 && H < 32) ? g2 : (H == 36 || H == 37) ? g3 : (H == 40 || H == 41) ? g4 : nullptr;
    }
    __device__ __forceinline__ void operator()(f32x4 (&acc)[2][2][4][2], const Unit& u, int wr, int wc, int fr, int fq) const {
        const bool any = (LAYER == 0) ? (u.pn < 3) : (u.pn < 4 || u.pn == 6 || u.pn == 7 || u.pn == 9 || u.pn == 10);
        if (any) {
#pragma unroll
            for (int ai = 0; ai < 2; ++ai)
#pragma unroll
                for (int m = 0; m < 4; ++m)
#pragma unroll
                    for (int bj = 0; bj < 2; ++bj) {
                        const f32x4 a = acc[ai][bj][m][0], b = acc[ai][bj][m][1];
                        float ss = (a[0] * a[0] + a[1] * a[1]) + (a[2] * a[2] + a[3] * a[3]) + (b[0] * b[0] + b[1] * b[1]) + (b[2] * b[2] + b[3] * b[3]);
                        ss += __shfl_xor(ss, 16); ss += __shfl_xor(ss, 32);
                        if (fq == 0) hn[(ai * HALF + wr * 64 + m * 16 + fr) * 8 + bj * 4 + wc] = ss;
                    }
        }
        asm volatile("s_waitcnt lgkmcnt(0)" ::: "memory"); __builtin_amdgcn_s_barrier(); asm volatile("" ::: "memory");
        const int row0 = u.pm * BM + wr * 64 + fr, col0 = u.pn * BM + wc * 32 + 8 * fq;
#pragma unroll
        for (int bj = 0; bj < 2; ++bj) {
            const float* g = gain_of(4 * u.pn + 2 * bj + (wc >> 1));
            f32x4 ga = (f32x4){1.f, 1.f, 1.f, 1.f}, gb = ga;
            if (g) { ga = *(const f32x4*)(g + (wc & 1) * 32 + 8 * fq); gb = *(const f32x4*)(g + (wc & 1) * 32 + 8 * fq + 4); }
#pragma unroll
            for (int ai = 0; ai < 2; ++ai)
#pragma unroll
                for (int m = 0; m < 4; ++m) {
                    f32x4 v0 = acc[ai][bj][m][0], v1 = acc[ai][bj][m][1];
                    if (g) { const int rl = (ai * HALF + wr * 64 + m * 16 + fr) * 8 + bj * 4;
                        const float r = 1.0f / sqrtf((hn[rl + wc] + hn[rl + (wc ^ 1)]) * (1.0f / 64) + 1e-6f);
                        v0 = v0 * ga * r; v1 = v1 * gb * r; }
                    u32x4 w; w.x = cvt_pk_bf16(v0[0], v0[1]); w.y = cvt_pk_bf16(v0[2], v0[3]); w.z = cvt_pk_bf16(v1[0], v1[1]); w.w = cvt_pk_bf16(v1[2], v1[3]);
                    *(u32x4*)(O + (size_t)(row0 + ai * HALF + m * 16) * ldc + col0 + bj * HALF) = w;
                }
        }
    }
};
struct EpiResidF32 {
    static constexpr bool PERM = true;
    const float* R; float* O; int ldc; float* SSQ;
    __device__ __forceinline__ void operator()(const f32x4 (&acc)[2][2][4][2], const Unit& u, int wr, int wc, int fr, int fq) const {
        const int row0 = u.pm * BM + wr * 64 + fr, col0 = u.pn * BM + wc * 32 + 8 * fq;
#pragma unroll
        for (int ai = 0; ai < 2; ++ai)
#pragma unroll
            for (int m = 0; m < 4; ++m) { const int row = row0 + ai * HALF + m * 16; const size_t ro = (size_t)row * ldc + col0;
                float ss = 0.f;
#pragma unroll
                for (int bj = 0; bj < 2; ++bj) {
                    const f32x4 r0 = *(const f32x4*)(R + ro + bj * HALF), r1 = *(const f32x4*)(R + ro + bj * HALF + 4);
                    const f32x4 v0 = r0 + acc[ai][bj][m][0], v1 = r1 + acc[ai][bj][m][1];
                    *(f32x4*)(O + ro + bj * HALF) = v0; *(f32x4*)(O + ro + bj * HALF + 4) = v1;
                    ss += (v0[0] * v0[0] + v0[1] * v0[1]) + (v0[2] * v0[2] + v0[3] * v0[3]) + (v1[0] * v1[0] + v1[1] * v1[1]) + (v1[2] * v1[2] + v1[3] * v1[3]); }
                ss += __shfl_xor(ss, 16); ss += __shfl_xor(ss, 32);
                if (fq == 0) SSQ[(size_t)row * 16 + u.pn * 4 + wc] = ss; }
    }
};
struct EpiSiluMul {
    static constexpr bool PERM = true;
    bf16_t* H; int ldh;
    __device__ __forceinline__ void operator()(const f32x4 (&acc)[2][2][4][2], const Unit& u, int wr, int wc, int fr, int fq) const {
        const int row0 = u.pm * BM + wr * 64 + fr, col0 = u.pn * HALF + wc * 32 + 8 * fq;
#pragma unroll
        for (int ai = 0; ai < 2; ++ai)
#pragma unroll
            for (int m = 0; m < 4; ++m) { bf16_t* rowp = H + (size_t)(row0 + ai * HALF + m * 16) * ldh + col0;
                float h[8];
#pragma unroll
                for (int n = 0; n < 2; ++n)
#pragma unroll
                    for (int j = 0; j < 4; ++j) { const float g = acc[ai][0][m][n][j], up = acc[ai][1][m][n][j]; h[n * 4 + j] = g * up * __builtin_amdgcn_rcpf(1.0f + __expf(-g)); }
                u32x4 w; w.x = cvt_pk_bf16(h[0], h[1]); w.y = cvt_pk_bf16(h[2], h[3]); w.z = cvt_pk_bf16(h[4], h[5]); w.w = cvt_pk_bf16(h[6], h[7]);
                *(u32x4*)rowp = w; }
    }
};

template <class Epi, class Sched, bool GATHER = false>
__device__ __forceinline__ void gemm_phase(PG8_LAS unsigned char* lds, const int K, const Sched& S, const Epi& E, const int wave_, unsigned g00 = 0, unsigned g01 = 0, unsigned g10 = 0, unsigned g11 = 0) {
    int lane; asm volatile("v_mbcnt_lo_u32_b32 %0, -1, 0\n\tv_mbcnt_hi_u32_b32 %0, -1, %0" : "=v"(lane));
    const int wid = __builtin_amdgcn_readfirstlane(wave_), tid = wid * 64 + lane, wr = wid >> 2, wc = wid & 3, fr = lane & 15, fq = lane >> 4;
    const int nt = K / BK;
    unsigned voffA[2], voffB[2], voffA1[2];
#pragma unroll
    for (int i = 0; i < 2; ++i) { int R, C; stage_rc(tid * 16 + i * 8192, R, C); const int Rb = Epi::PERM ? ((R & ~31) + perm32(R & 31)) : R;
        voffA[i] = (unsigned)(R * K + C) * 2u; voffB[i] = (unsigned)(Rb * K + C) * 2u; voffA1[i] = voffA[i];
        if (GATHER) { voffA[i] = (i ? g01 : g00) + (unsigned)C * 2u; voffA1[i] = (i ? g11 : g10) + (unsigned)C * 2u; } }
    const size_t kstep = (size_t)(BK * 2);
    const size_t hstep = (size_t)HALF * K * 2;
    const size_t hstepA = GATHER ? (size_t)0 : hstep;
    const unsigned ldsw = (unsigned)wid * 1024u;
    const int aoff = lds_byte(wr * 64 + fr, fq * 8), boff = lds_byte(wc * 32 + fr, fq * 8);
#define PG8_SA(b, h) (((b) * 2 + (h)) * HTB)
#define PG8_SB(b, h) ((4 + (b) * 2 + (h)) * HTB)
#define PG8_STAGE(bufoff, gbase, voff) do { _Pragma("unroll") for (int _i = 0; _i < 2; ++_i) \
        __builtin_amdgcn_global_load_lds((const unsigned*)((const char*)(gbase) + (voff)[_i]), (PG8_LAS unsigned*)(lds + (bufoff) + ldsw + _i * 8192), 16, 0, 0); } while (0)
#define PG8_LDA(dst, b, h) do { _Pragma("unroll") for (int m = 0; m < 4; ++m) _Pragma("unroll") for (int k = 0; k < 2; ++k) dst[m][k] = *(const PG8_LAS bf16x8*)(lds + PG8_SA(b, h) + aoff + m * 2048 + k * 1024); } while (0)
#define PG8_LDB(dst, b, h) do { _Pragma("unroll") for (int n = 0; n < 2; ++n) _Pragma("unroll") for (int k = 0; k < 2; ++k) dst[n][k] = *(const PG8_LAS bf16x8*)(lds + PG8_SB(b, h) + boff + n * 2048 + k * 1024); } while (0)
#define PG8_MMA(ai, bj, At, Bt) do { __builtin_amdgcn_s_setprio(1); _Pragma("unroll") for (int m = 0; m < 4; ++m) _Pragma("unroll") for (int n = 0; n < 2; ++n) _Pragma("unroll") for (int k = 0; k < 2; ++k) \
        acc[ai][bj][m][n] = __builtin_amdgcn_mfma_f32_16x16x32_bf16(Bt[n][k], At[m][k], acc[ai][bj][m][n], 0, 0, 0); __builtin_amdgcn_s_setprio(0); } while (0)
#define PG8_WAIT_V(n) asm volatile("s_waitcnt vmcnt(" #n ")" ::: "memory")
#define PG8_WAIT_L(n) asm volatile("s_waitcnt lgkmcnt(" #n ")" ::: "memory")
#define PG8_BAR __builtin_amdgcn_s_barrier()
#define PG8_SCHED __builtin_amdgcn_sched_barrier(0)
    Unit cur, nxt; int ui = 0;
    if (!S.next(0, cur)) return;
    f32x4 acc[2][2][4][2];
#pragma unroll
    for (int a = 0; a < 2; ++a)
#pragma unroll
        for (int b = 0; b < 2; ++b)
#pragma unroll
            for (int m = 0; m < 4; ++m)
#pragma unroll
                for (int n = 0; n < 2; ++n) acc[a][b][m][n] = (f32x4){0.f, 0.f, 0.f, 0.f};
    bf16x8 At[4][2], B0[2][2], B1[2][2];
    const char* cA = cur.A; const char* cB = cur.B;
    PG8_STAGE(PG8_SB(0, 0), cB, voffB); PG8_STAGE(PG8_SB(0, 1), cB + hstep, voffB); PG8_STAGE(PG8_SA(0, 0), cA, voffA); PG8_STAGE(PG8_SA(0, 1), cA + hstepA, voffA1);
    if (wr == 1) PG8_BAR;
    PG8_WAIT_V(2); PG8_BAR;
    PG8_STAGE(PG8_SB(1, 0), cB + kstep, voffB); PG8_STAGE(PG8_SA(1, 0), cA + kstep, voffA); PG8_STAGE(PG8_SB(1, 1), cB + hstep + kstep, voffB);
    PG8_WAIT_V(6); PG8_BAR;
    for (;;) {
        const bool has_next = S.next(ui + 1, nxt);
        const char* nA = has_next ? nxt.A : cA; const char* nB = has_next ? nxt.B : cB;
        for (int t = 0; t < nt; t += 2) {
            const bool last = (t == nt - 2);
            const char* a1 = cA + (size_t)(t + 1) * kstep;
            const char* a2 = last ? nA : cA + (size_t)(t + 2) * kstep; const char* b2 = last ? nB : cB + (size_t)(t + 2) * kstep;
            const char* a3 = a2 + kstep; const char* b3 = b2 + kstep;
            PG8_LDB(B0, 0, 0); PG8_LDB(B1, 0, 1); PG8_SCHED; PG8_LDA(At, 0, 0); PG8_STAGE(PG8_SA(1, 1), a1 + hstepA, voffA1);
            PG8_WAIT_V(8); PG8_WAIT_L(0); PG8_BAR; PG8_MMA(0, 0, At, B0); PG8_MMA(0, 1, At, B1); PG8_BAR; PG8_SCHED;
            PG8_LDA(At, 0, 1); PG8_STAGE(PG8_SB(0, 0), b2, voffB); PG8_STAGE(PG8_SB(0, 1), b2 + hstep, voffB); PG8_STAGE(PG8_SA(0, 0), a2, voffA);
            PG8_WAIT_V(8); PG8_WAIT_L(0); PG8_BAR; PG8_MMA(1, 0, At, B0); PG8_MMA(1, 1, At, B1); PG8_BAR; PG8_SCHED;
            PG8_LDB(B0, 1, 0); PG8_LDB(B1, 1, 1); PG8_SCHED; PG8_LDA(At, 1, 0); PG8_STAGE(PG8_SA(0, 1), a2 + hstepA, voffA1);
            PG8_WAIT_V(8); PG8_WAIT_L(0); PG8_BAR; PG8_MMA(0, 0, At, B0); PG8_MMA(0, 1, At, B1); PG8_BAR; PG8_SCHED;
            PG8_LDA(At, 1, 1); PG8_STAGE(PG8_SB(1, 0), b3, voffB); PG8_STAGE(PG8_SB(1, 1), b3 + hstep, voffB); PG8_STAGE(PG8_SA(1, 0), a3, voffA);
            PG8_WAIT_V(8); PG8_WAIT_L(0); PG8_BAR; PG8_MMA(1, 0, At, B0); PG8_MMA(1, 1, At, B1); PG8_BAR; PG8_SCHED;
        }
        if (wr == 0) PG8_BAR;
        { int l2; asm volatile("v_mbcnt_lo_u32_b32 %0, -1, 0\n\tv_mbcnt_hi_u32_b32 %0, -1, %0" : "=v"(l2)); E(acc, cur, wr, wc, l2 & 15, l2 >> 4); }
        if (!has_next) break;
#pragma unroll
        for (int a = 0; a < 2; ++a)
#pragma unroll
            for (int b = 0; b < 2; ++b)
#pragma unroll
                for (int m = 0; m < 4; ++m)
#pragma unroll
                    for (int n = 0; n < 2; ++n) acc[a][b][m][n] = (f32x4){0.f, 0.f, 0.f, 0.f};
        cur = nxt; cA = nA; cB = nB; ++ui;
        if (wr == 1) PG8_BAR;
    }
    PG8_WAIT_V(0);
    PG8_BAR;
#undef PG8_SA
#undef PG8_SB
#undef PG8_STAGE
#undef PG8_LDA
#undef PG8_LDB
#undef PG8_MMA
#undef PG8_WAIT_V
#undef PG8_WAIT_L
#undef PG8_BAR
#undef PG8_SCHED
}
}

#define GAS __attribute__((address_space(1)))
#define LAS __attribute__((address_space(3)))
typedef unsigned v4u __attribute__((ext_vector_type(4)));
typedef float f32x4 __attribute__((ext_vector_type(4)));
typedef short bf16x8 __attribute__((ext_vector_type(8)));
constexpr int NWAVES = 8;
constexpr int RING_BYTES = 131072, LDSCTL_OFF = RING_BYTES, MISC_OFF = LDSCTL_OFF + 320, LDS_BYTES = 147456;
constexpr size_t MiB = 1u << 20;
constexpr size_t CTL_ZERO_BYTES = 1 * MiB;
constexpr int CW_BAR = 4096;
constexpr int CW_MOE = 65536;
#define LDS_WAIT() asm volatile("s_waitcnt lgkmcnt(0)" ::: "memory")
#define VM_WAIT() asm volatile("s_waitcnt vmcnt(0)" ::: "memory")
DEV unsigned pk2(float lo, float hi) { return (unsigned)f2bf(lo) | ((unsigned)f2bf(hi) << 16); }

#define XB_TMO      128
#define XB_XCNT(j)  (256  + 64 * (j))
#define XB_XSUB(j)  (1280 + 64 * (j))
#define XB_XGEN(j)  (2304 + 64 * (j))
#define XB_TOP      3328
#define XB_TOPGEN   3392
#define XCD_BAR_WORDS 3456
#define XB_SPIN_CAP (1u << 22)
DEV unsigned xb_ld(unsigned* p)              { return __hip_atomic_load(p, __ATOMIC_RELAXED, __HIP_MEMORY_SCOPE_AGENT); }
DEV unsigned xb_add(unsigned* p, unsigned v) { return __hip_atomic_fetch_add(p, v, __ATOMIC_RELAXED, __HIP_MEMORY_SCOPE_AGENT); }
DEV unsigned xb_xcc_id() { return (unsigned)__builtin_amdgcn_s_getreg((3 << 11) | 20) & 0xFu; }
#define XB_SPIN(cond, bar) do { unsigned _sp = 0; while (cond) { __builtin_amdgcn_s_sleep(1); \
    if ((++_sp & 255u) == 0u) { if (xb_ld(&(bar)[XB_TMO])) break; if (_sp > XB_SPIN_CAP) { atomicAdd(&(bar)[XB_TMO], 1u); break; } } } } while (0)
struct XcdBarrier { unsigned* bar; unsigned x; volatile LAS unsigned* st; unsigned expect; };
DEV XcdBarrier xcd_barrier_post(unsigned* bar, volatile LAS unsigned* st) {
    XcdBarrier b; b.bar = bar; b.x = xb_xcc_id(); b.st = st; b.expect = 0u;
    if (threadIdx.x == 0) (void)xb_add(&bar[XB_XCNT(b.x)], 1u);
    return b;
}
DEV void xcd_barrier_complete(unsigned* bar, unsigned x, unsigned& nloc, unsigned& nx, unsigned expect) {
    const unsigned G = expect ? expect : gridDim.x * gridDim.y * gridDim.z;
    unsigned sum, cnt, mine, sp = 0u;
    for (;;) {
        sum = 0u; cnt = 0u; mine = 0u;
#pragma unroll
        for (unsigned j = 0; j < 16; ++j) { const unsigned c = xb_ld(&bar[XB_XCNT(j)]); sum += c; cnt += (c > 0u) ? 1u : 0u; mine = (j == x) ? c : mine; }
        if (sum == G) break;
        __builtin_amdgcn_s_sleep(1);
        if ((++sp & 255u) == 0u) { if (xb_ld(&bar[XB_TMO])) break; if (sp > XB_SPIN_CAP) { atomicAdd(&bar[XB_TMO], 1u); break; } }
    }
    nloc = mine > 0u ? mine : 1u; nx = cnt > 0u ? cnt : 1u;
}
DEV void xcd_barrier(const XcdBarrier& b, const int tid_) {
    asm volatile("s_waitcnt vmcnt(0)" ::: "memory");
    __syncthreads();
    if (tid_ == 0) {
        unsigned* bar = b.bar;
        __builtin_amdgcn_s_waitcnt(0);
        unsigned nloc = b.st[0], nx = b.st[1];
        if (nloc == 0u) { xcd_barrier_complete(bar, b.x, nloc, nx, b.expect); b.st[0] = nloc; b.st[1] = nx; }
        const unsigned old = xb_add(&bar[XB_XSUB(b.x)], 1u);
        const unsigned gen = old / nloc;
        if (old + 1u == (gen + 1u) * nloc) {
            __builtin_amdgcn_fence(__ATOMIC_RELEASE, "agent");
            asm volatile("s_waitcnt vmcnt(0)" ::: "memory");
            const unsigned og = xb_add(&bar[XB_TOP], 1u);
            const unsigned tg = og / nx;
            if (og + 1u == (tg + 1u) * nx) xb_add(&bar[XB_TOPGEN], 1u);
            else XB_SPIN(xb_ld(&bar[XB_TOPGEN]) == tg, bar);
            __builtin_amdgcn_fence(__ATOMIC_ACQUIRE, "agent");
            xb_add(&bar[XB_XGEN(b.x)], 1u);
            asm volatile("s_waitcnt vmcnt(0)" ::: "memory");
        } else {
            XB_SPIN(xb_ld(&bar[XB_XGEN(b.x)]) == gen, bar);
            __builtin_amdgcn_fence(__ATOMIC_ACQUIRE, "agent");
            asm volatile("s_waitcnt vmcnt(0)" ::: "memory");
        }
    }
    __syncthreads();
}

struct Frame {
    LAS unsigned char* lds;
    volatile LAS unsigned* MISC;
    int tid, lane, wave;
    int vcu, G;
};

DEV void refresh(Frame& F) { int l; asm volatile("v_mbcnt_lo_u32_b32 %0, -1, 0\n\tv_mbcnt_hi_u32_b32 %0, -1, %0" : "=v"(l)); F.lane = l; F.tid = F.wave * 64 + l; }
DEV int fresh_lane() { int l; asm volatile("v_mbcnt_lo_u32_b32 %0, -1, 0\n\tv_mbcnt_hi_u32_b32 %0, -1, %0" : "=v"(l)); return l; }
DEV float wave_sum(float v) {
#pragma unroll
    for (int o = 1; o < 64; o <<= 1) v += __shfl_xor(v, o);
    return v;
}
DEV void transpose_item(const float* W, int K, int N, bf16* WT, int k0, int n0, int dst_row0, LAS float* scr, int lane) {
    const int c4 = lane & 7, r0 = lane >> 3;
    const bool okc = (n0 + 4 * c4) < N;
    f32x4 v[8];
#pragma unroll
    for (int i = 0; i < 8; ++i) v[i] = okc ? *(const GAS f32x4*)(W + (size_t)(k0 + r0 + 8 * i) * N + n0 + 4 * c4) : (f32x4){0.f, 0.f, 0.f, 0.f};
#pragma unroll
    for (int i = 0; i < 8; ++i) { LAS float* d = scr + (r0 + 8 * i) * 33 + 4 * c4; d[0] = v[i].x; d[1] = v[i].y; d[2] = v[i].z; d[3] = v[i].w; }
    LDS_WAIT(); asm volatile("" ::: "memory");
    const int c = lane & 7;
#pragma unroll
    for (int j = 0; j < 4; ++j) { const int n = (lane >> 3) + 8 * j; const LAS float* s = scr + (8 * c) * 33 + n;
        v4u o; o.x = pk2(s[0 * 33], s[1 * 33]); o.y = pk2(s[2 * 33], s[3 * 33]); o.z = pk2(s[4 * 33], s[5 * 33]); o.w = pk2(s[6 * 33], s[7 * 33]);
        if (n0 + n < N) *(GAS v4u*)(WT + (size_t)(dst_row0 + n) * K + k0 + 8 * c) = o; }
    LDS_WAIT(); asm volatile("" ::: "memory");
}
DEV float rms_row_to_bf16(int lane, const float* xrow, const float* gain, bf16* orow) {
    const GAS f32x4* xr = (const GAS f32x4*)xrow + lane;
    const GAS f32x4* gr = (const GAS f32x4*)gain + lane;
    f32x4 v[4]; float s = 0.f;
#pragma unroll
    for (int j = 0; j < 4; ++j) { v[j] = xr[64 * j]; s += (v[j].x * v[j].x + v[j].y * v[j].y) + (v[j].z * v[j].z + v[j].w * v[j].w); }
    const float rstd = 1.0f / sqrtf(wave_sum(s) * (1.f / D) + EPS);
    GAS unsigned long long* o8 = (GAS unsigned long long*)orow + lane;
#pragma unroll
    for (int j = 0; j < 4; ++j) { const f32x4 g = gr[64 * j];
        o8[64 * j] = (unsigned long long)pk2(v[j].x * rstd * g.x, v[j].y * rstd * g.y) | ((unsigned long long)pk2(v[j].z * rstd * g.z, v[j].w * rstd * g.w) << 32); }
    return rstd;
}

DEV void fp_convert_weights(const Params& P, Frame& F, int which, int ci, int n) {
    LAS float* scr = (LAS float*)(F.lds + F.wave * 16384);
    const int gw = ci * NWAVES + F.wave, NGW = n * NWAVES;
    constexpr int I_IN0 = 16 * 72, I_OUT = 16 * 32, I_IN1 = 16 * 89;
    if (which == 0) {
        for (int it = gw; it < I_IN0 + I_OUT; it += NGW) {
            int r = it;
            if (r < I_IN0) { const int kb = r / 72, nb = r % 72; transpose_item(P.ev_w_in, D, EVEN_IN, P.win0t(), 64 * kb, 32 * nb, 32 * nb, scr, F.lane); continue; } r -= I_IN0;
            { const int kb = r / 32, nb = r % 32; transpose_item(P.ev_w_out, D, D, P.wout0t(), 64 * kb, 32 * nb, 32 * nb, scr, F.lane); }
        }
    } else {
        for (int it = gw; it < I_IN1 + I_OUT; it += NGW) {
            int r = it;
            if (r < I_IN1) { const int kb = r / 89, nb = r % 89; transpose_item(P.od_w_in, D, ODD_IN, P.win1t(), 64 * kb, 32 * nb, 32 * nb, scr, F.lane); continue; } r -= I_IN1;
            { const int kb = r / 32, nb = r % 32; transpose_item(P.od_w_out, D, D, P.wout1t(), 64 * kb, 32 * nb, 32 * nb, scr, F.lane); }
        }
    }
}
DEV void fp_norm_rows(Frame& F, const float* src, const float* gain, bf16* xn) {
    const int gw = F.vcu * NWAVES + F.wave, NGW = F.G * NWAVES, lane = F.lane;
    f32x4 gg[4];
    { const GAS f32x4* gr = (const GAS f32x4*)gain + lane;
#pragma unroll
      for (int j = 0; j < 4; ++j) gg[j] = gr[64 * j]; }
#pragma unroll 2
    for (int m = gw; m < T; m += NGW) {
        const GAS f32x4* xr = (const GAS f32x4*)(src + (size_t)m * D) + lane;
        f32x4 v[4]; float s = 0.f;
#pragma unroll
        for (int j = 0; j < 4; ++j) { v[j] = xr[64 * j]; s += (v[j].x * v[j].x + v[j].y * v[j].y) + (v[j].z * v[j].z + v[j].w * v[j].w); }
        const float rstd = 1.0f / sqrtf(wave_sum(s) * (1.f / D) + EPS);
        GAS unsigned long long* o8 = (GAS unsigned long long*)(xn + (size_t)m * D) + lane;
#pragma unroll
        for (int j = 0; j < 4; ++j)
            o8[64 * j] = (unsigned long long)pk2(v[j].x * rstd * gg[j].x, v[j].y * rstd * gg[j].y) | ((unsigned long long)pk2(v[j].z * rstd * gg[j].z, v[j].w * rstd * gg[j].w) << 32);
    }
}

constexpr int TAB_OFF = MISC_OFF + 128;
constexpr int RT_PART_OFF = 0;
constexpr int RT_SS_OFF = 98304;
constexpr int RT_HIST_OFF = 100352;
typedef float f32x4v __attribute__((ext_vector_type(4)));

DEV void fp_prep_router(const Params& P, Frame& F) {
    const int gtid = F.vcu * NWAVES * 64 + F.tid, gsz = F.G * NWAVES * 64;
    for (int i = gtid; i < 2 * 48 * D; i += gsz) {
        const int k = i & (D - 1), j = (i >> 10) % 48, l = i / (48 * D);
        float w = 0.f;
        if (j < 4) w = P.moe_w_grp[((size_t)l * D + k) * 4 + j]; else if (j < 36) w = P.moe_w_exp[((size_t)l * D + k) * 32 + (j - 4)];
        w *= P.moe_norm[l * D + k];
        const bf16 hi = f2bf(w); const bf16 lo = f2bf(w - bf2f(hi));
        P.wr()[((size_t)(l * 2 + 0) * 48 + j) * D + k] = hi;
        P.wr()[((size_t)(l * 2 + 1) * 48 + j) * D + k] = lo;
    }
}

DEV void fp_route(const Params& P, Frame& F, int layer) {
    const int lane = F.lane, w = F.wave;
    const bf16* wr_hi = P.wr() + (size_t)(layer * 2 + 0) * 48 * D;
    const bf16* wr_lo = P.wr() + (size_t)(layer * 2 + 1) * 48 * D;
    LAS float* part = (LAS float*)(F.lds + RT_PART_OFF);
    LAS float* ssp = (LAS float*)(F.lds + RT_SS_OFF);
    LAS unsigned* hist = (LAS unsigned*)(F.lds + RT_HIST_OFF);
    unsigned* cnt = P.ctl() + CW_MOE + layer * 256;
    for (int tb = F.vcu; tb < T / 64; tb += F.G) {
        const int t0 = tb * 64;
        if (F.tid < 64) hist[F.tid] = 0u;
        if (F.tid < 64) { const float* sq = P.ssq() + (size_t)(t0 + F.tid) * 16; float a = 0.f;
#pragma unroll
            for (int j = 0; j < 16; ++j) a += sq[j];
            ssp[F.tid] = 1.0f / sqrtf(a * (1.f / D) + EPS); }
        __syncthreads();
        const float* xrow = P.out + (size_t)(t0 + (lane & 15)) * D + 128 * w + 8 * (lane >> 4);
        const float* grow_ = P.moe_norm + layer * D + 128 * w + 8 * (lane >> 4);
        bf16* xnrow = P.xn() + (size_t)(t0 + (lane & 15)) * D + 128 * w + 8 * (lane >> 4);
        const size_t boff = (size_t)(lane & 15) * D + 128 * w + 8 * (lane >> 4);
        float rsg[4];
#pragma unroll
        for (int g = 0; g < 4; ++g) rsg[g] = ssp[16 * g + (lane & 15)];
        pg8::f32x4 acc[4][3];
#pragma unroll
        for (int g = 0; g < 4; ++g)
#pragma unroll
            for (int c = 0; c < 3; ++c) acc[g][c] = (pg8::f32x4){0.f, 0.f, 0.f, 0.f};
        f32x4v xaA[4], xbA[4], xaB[4], xbB[4];
#define RT_LOAD(XA, XB, ks_) do { _Pragma("unroll") for (int g = 0; g < 4; ++g) { XA[g] = *(const f32x4v*)(xrow + (size_t)16 * g * D + 32 * (ks_)); XB[g] = *(const f32x4v*)(xrow + (size_t)16 * g * D + 32 * (ks_) + 4); } } while (0)
#define RT_STEP(XA, XB, ks_) do { bf16x8 BH[3], BL[3]; \
            _Pragma("unroll") for (int c = 0; c < 3; ++c) { BH[c] = *(const bf16x8*)(wr_hi + boff + (size_t)16 * c * D + 32 * (ks_)); BL[c] = *(const bf16x8*)(wr_lo + boff + (size_t)16 * c * D + 32 * (ks_)); } \
            const f32x4v GA = *(const f32x4v*)(grow_ + 32 * (ks_)), GB = *(const f32x4v*)(grow_ + 32 * (ks_) + 4); \
            const float gv[8] = {GA.x, GA.y, GA.z, GA.w, GB.x, GB.y, GB.z, GB.w}; \
            _Pragma("unroll") for (int g = 0; g < 4; ++g) { \
                const float xv[8] = {XA[g].x, XA[g].y, XA[g].z, XA[g].w, XB[g].x, XB[g].y, XB[g].z, XB[g].w}; \
                bf16x8 ah, al; v4u xo; unsigned xw[4]; \
                _Pragma("unroll") for (int j = 0; j < 8; ++j) { const bf16 h = f2bf(xv[j]); ah[j] = (short)h; al[j] = (short)f2bf(xv[j] - bf2f(h)); } \
                _Pragma("unroll") for (int j = 0; j < 4; ++j) xw[j] = pk2(xv[2 * j] * rsg[g] * gv[2 * j], xv[2 * j + 1] * rsg[g] * gv[2 * j + 1]); \
                xo.x = xw[0]; xo.y = xw[1]; xo.z = xw[2]; xo.w = xw[3]; \
                *(GAS v4u*)(xnrow + (size_t)16 * g * D + 32 * (ks_)) = xo; \
                _Pragma("unroll") for (int c = 0; c < 3; ++c) { \
                    acc[g][c] = __builtin_amdgcn_mfma_f32_16x16x32_bf16(ah, BH[c], acc[g][c], 0, 0, 0); \
                    acc[g][c] = __builtin_amdgcn_mfma_f32_16x16x32_bf16(ah, BL[c], acc[g][c], 0, 0, 0); \
                    acc[g][c] = __builtin_amdgcn_mfma_f32_16x16x32_bf16(al, BH[c], acc[g][c], 0, 0, 0); } } } while (0)
        RT_LOAD(xaA, xbA, 0);
        RT_LOAD(xaB, xbB, 1);
        RT_STEP(xaA, xbA, 0);
        RT_LOAD(xaA, xbA, 2);
        RT_STEP(xaB, xbB, 1);
        RT_LOAD(xaB, xbB, 3);
        RT_STEP(xaA, xbA, 2);
        RT_STEP(xaB, xbB, 3);
#undef RT_LOAD
#undef RT_STEP
        __syncthreads();
#pragma unroll
        for (int g = 0; g < 4; ++g)
#pragma unroll
            for (int c = 0; c < 3; ++c)
#pragma unroll
                for (int r = 0; r < 4; ++r) part[(w * 64 + 16 * g + 4 * (lane >> 4) + r) * 48 + 16 * c + (lane & 15)] = acc[g][c][r];
        __syncthreads();
        for (int i = F.tid; i < 64 * 48; i += NWAVES * 64) { float a = part[i];
#pragma unroll
            for (int ww = 1; ww < 8; ++ww) a += part[ww * 64 * 48 + i];
            part[i] = a; }
        __syncthreads();
        int e1 = 0, e2 = 0; float w1 = 0.f, w2 = 0.f; unsigned r1 = 0, r2 = 0;
        if (F.tid < 64) {
            const int t = t0 + F.tid;
            const float rs = ssp[F.tid];
            P.rstd()[t] = rs;
            float lg[4], le[32];
#pragma unroll
            for (int j = 0; j < 4; ++j) lg[j] = part[F.tid * 48 + j] * rs + P.moe_b_grp[layer * 4 + j];
#pragma unroll
            for (int j = 0; j < 32; ++j) le[j] = part[F.tid * 48 + 4 + j] * rs + P.moe_b_exp[layer * 32 + j];
            int gs = 0; float gm = lg[0];
#pragma unroll
            for (int j = 1; j < 4; ++j) if (lg[j] > gm) { gm = lg[j]; gs = j; }
            float gz = 0.f;
#pragma unroll
            for (int j = 0; j < 4; ++j) gz += expf(lg[j] - gm);
            const float pg = 1.0f / gz;
            float wv[8];
#pragma unroll
            for (int j = 0; j < 8; ++j) wv[j] = gs == 0 ? le[j] : gs == 1 ? le[8 + j] : gs == 2 ? le[16 + j] : le[24 + j];
            int i1 = 0; float m1 = wv[0];
#pragma unroll
            for (int j = 1; j < 8; ++j) if (wv[j] > m1) { m1 = wv[j]; i1 = j; }
            int i2 = -1; float m2 = -3e38f;
#pragma unroll
            for (int j = 0; j < 8; ++j) if (j != i1 && wv[j] > m2) { m2 = wv[j]; i2 = j; }
            const float ex2 = expf(m2 - m1);
            w1 = pg / (1.0f + ex2); w2 = pg * ex2 / (1.0f + ex2);
            e1 = gs * 8 + i1; e2 = gs * 8 + i2;
            r1 = __hip_atomic_fetch_add(&hist[e1], 1u, __ATOMIC_RELAXED, __HIP_MEMORY_SCOPE_WORKGROUP); r2 = __hip_atomic_fetch_add(&hist[e2], 1u, __ATOMIC_RELAXED, __HIP_MEMORY_SCOPE_WORKGROUP);
        }
        __syncthreads();
        if (F.tid < 32) { const unsigned h = hist[F.tid]; hist[32 + F.tid] = h ? xb_add(&cnt[F.tid], h) : 0u; }
        __syncthreads();
        if (F.tid < 64) {
            const int t = t0 + F.tid;
            P.eid()[t * 2 + 0] = e1; P.eid()[t * 2 + 1] = e2; P.ew()[t * 2 + 0] = w1; P.ew()[t * 2 + 1] = w2;
            const int i1x = (int)(hist[32 + e1] + r1), i2x = (int)(hist[32 + e2] + r2);
            P.pos()[t * 2 + 0] = i1x; P.pos()[t * 2 + 1] = i2x;
            P.rowtok()[e1 * T + i1x] = t; P.rowtok()[e2 * T + i2x] = t;
        }
        __syncthreads();
    }
}

DEV void moe_table(const Params& P, Frame& F, int layer) {
    volatile LAS int* tab = (volatile LAS int*)(F.lds + TAB_OFF);
    if (F.tid == 0) {
        unsigned* cnt = P.ctl() + CW_MOE + layer * 256;
        int acc = 0;
        for (int e = 0; e < 32; ++e) { tab[e] = acc; acc += (int)((xb_ld(&cnt[e]) + 255u) >> 8); }
        tab[32] = acc;
    }
    __syncthreads();
}

struct ListOrder {
    int code[8]; int n, npn; const char* A; const char* Bt; size_t tstep, bstep;
    __device__ __forceinline__ bool next(int i, pg8::Unit& o) const {
        if (i >= n) return false;
        const int c = (i == 0) ? code[0] : (i == 1) ? code[1] : (i == 2) ? code[2] : (i == 3) ? code[3] : (i == 4) ? code[4] : (i == 5) ? code[5] : (i == 6) ? code[6] : code[7];
        const int tt = c >> 8, e = (c >> 3) & 31, pn = c & 7;
        o.pm = tt; o.pn = pn; o.A = A + (size_t)tt * tstep; o.B = Bt + (size_t)(e * npn + pn) * bstep; return true;
    }
};
DEV int moe_expert_of(volatile LAS int* tab, int tt) { int e = 0; for (int q = 1; q < 32; ++q) e += (tt >= tab[q]) ? 1 : 0; return __builtin_amdgcn_readfirstlane(e); }
DEV void moe_run_gu(const Params& P, Frame& F, int layer, volatile LAS int* tab, int tt, int pn) {
    const int e = moe_expert_of(tab, tt);
    const int rbase = e * T + (tt - tab[e]) * 256;
    unsigned g[2][2]; const int tid_ = F.wave * 64 + fresh_lane();
#pragma unroll
    for (int hh = 0; hh < 2; ++hh)
#pragma unroll
        for (int i = 0; i < 2; ++i) { int R, C; pg8::stage_rc(tid_ * 16 + i * 8192, R, C); int tk = P.rowtok()[rbase + hh * 128 + R]; tk = ((unsigned)tk < (unsigned)T) ? tk : 0; g[hh][i] = (unsigned)tk * (unsigned)(D * 2); }
    ListOrder L; L.tstep = 0; L.A = (const char*)P.xn(); L.Bt = (const char*)P.wgut(layer); L.npn = 2; L.n = 1; L.bstep = (size_t)256 * D * 2;
#pragma unroll
    for (int i = 0; i < 8; ++i) L.code[i] = 0;
    L.code[0] = (tt << 8) | (e << 3) | pn;
    pg8::EpiSiluMul E{P.hid(), 256}; pg8::gemm_phase<pg8::EpiSiluMul, ListOrder, true>(F.lds, D, L, E, F.wave, g[0][0], g[0][1], g[1][0], g[1][1]);
}
DEV void moe_run_dn(const Params& P, Frame& F, int layer, volatile LAS int* tab, int tbase, int d0, int dstep, int dend) {
    ListOrder L; L.tstep = (size_t)256 * 256 * 2; L.bstep = L.tstep; L.A = (const char*)P.hid(); L.Bt = (const char*)P.wdt(layer); L.npn = 4;
    int n = 0;
#pragma unroll
    for (int i = 0; i < 8; ++i) { const int d = d0 + i * dstep; int code = 0;
        if (d < dend) { const int tt = tbase + (d >> 2); code = (tt << 8) | (moe_expert_of(tab, tt) << 3) | (d & 3); n = i + 1; }
        L.code[i] = code; }
    L.n = __builtin_amdgcn_readfirstlane(n);
    if (L.n == 0) return;
    pg8::EpiStoreBf16 E{P.ha(), D}; pg8::gemm_phase(F.lds, 256, L, E, F.wave);
}
DEV void fp_moe_rounds(const Params& P, Frame& F, int layer, int wi, int W, const XcdBarrier& wb) {
    moe_table(P, F, layer);
    volatile LAS int* tab = (volatile LAS int*)(F.lds + TAB_OFF);
    const int ntile = __builtin_amdgcn_readfirstlane(tab[32]);
    const int n1 = 2 * ntile < W ? 2 * ntile : W, T1 = n1 >> 1, g2 = 2 * ntile - n1;
    if (wi < n1) moe_run_gu(P, F, layer, tab, wi >> 1, wi & 1);
    refresh(F); xcd_barrier(wb, F.tid);
    if (wi < g2) { const int u = n1 + wi; moe_run_gu(P, F, layer, tab, u >> 1, u & 1); }
    else moe_run_dn(P, F, layer, tab, 0, wi - g2, W - g2, 4 * T1);
    refresh(F); xcd_barrier(wb, F.tid);
    moe_run_dn(P, F, layer, tab, T1, wi, W, 4 * (ntile - T1));
}
DEV void fp_combine(const Params& P, Frame& F, int layer, const float* gain2, bf16* xn) {
    moe_table(P, F, layer);
    volatile LAS int* tab = (volatile LAS int*)(F.lds + TAB_OFF);
    const int gw = F.vcu * NWAVES + F.wave, NGW = F.G * NWAVES, lane = F.lane;
    int p1v = 0, p2v = 0; float w1v = 0.f, w2v = 0.f;
    { const int tj = gw + lane * NGW;
      if (tj < T) { p1v = tab[P.eid()[tj * 2]] * 256 + P.pos()[tj * 2]; p2v = tab[P.eid()[tj * 2 + 1]] * 256 + P.pos()[tj * 2 + 1]; w1v = P.ew()[tj * 2]; w2v = P.ew()[tj * 2 + 1]; } }
    f32x4 gg[4];
    if (xn) { const GAS f32x4* gr = (const GAS f32x4*)gain2 + lane;
#pragma unroll
        for (int j = 0; j < 4; ++j) gg[j] = gr[64 * j]; }
    int jj = 0;
#pragma unroll 2
    for (int t = gw; t < T; t += NGW, ++jj) {
        const int p1 = __builtin_amdgcn_readlane(p1v, jj), p2 = __builtin_amdgcn_readlane(p2v, jj);
        const float w1 = u2f((unsigned)__builtin_amdgcn_readlane((int)f2u(w1v), jj)), w2 = u2f((unsigned)__builtin_amdgcn_readlane((int)f2u(w2v), jj));
        GAS f32x4* xr = (GAS f32x4*)(P.out + (size_t)t * D) + lane;
        const GAS unsigned long long* y1 = (const GAS unsigned long long*)(P.ha() + (size_t)p1 * D) + lane;
        const GAS unsigned long long* y2 = (const GAS unsigned long long*)(P.ha() + (size_t)p2 * D) + lane;
        f32x4 v[4]; float s = 0.f;
#pragma unroll
        for (int j = 0; j < 4; ++j) {
            v[j] = xr[64 * j];
            const unsigned long long a = y1[64 * j], b = y2[64 * j];
            v[j].x += w1 * u2f((unsigned)(a & 0xffffu) << 16) + w2 * u2f((unsigned)(b & 0xffffu) << 16);
            v[j].y += w1 * u2f((unsigned)((a >> 16) & 0xffffu) << 16) + w2 * u2f((unsigned)((b >> 16) & 0xffffu) << 16);
            v[j].z += w1 * u2f((unsigned)((a >> 32) & 0xffffu) << 16) + w2 * u2f((unsigned)((b >> 32) & 0xffffu) << 16);
            v[j].w += w1 * u2f((unsigned)((a >> 48) & 0xffffu) << 16) + w2 * u2f((unsigned)((b >> 48) & 0xffffu) << 16);
            xr[64 * j] = v[j];
            s += (v[j].x * v[j].x + v[j].y * v[j].y) + (v[j].z * v[j].z + v[j].w * v[j].w);
        }
        if (xn) {
            const float rstd = 1.0f / sqrtf(wave_sum(s) * (1.f / D) + EPS);
            GAS unsigned long long* o8 = (GAS unsigned long long*)(xn + (size_t)t * D) + lane;
#pragma unroll
            for (int j = 0; j < 4; ++j) { const f32x4 g = gg[j];
                o8[64 * j] = (unsigned long long)pk2(v[j].x * rstd * g.x, v[j].y * rstd * g.y) | ((unsigned long long)pk2(v[j].z * rstd * g.z, v[j].w * rstd * g.w) << 32); }
        }
    }
}


DEV void fp_convert_moe_part(const Params& P, Frame& F, int layer, int ci, int nconv) {
    LAS float* scr = (LAS float*)(F.lds + F.wave * 16384);
    constexpr int NIT = 32 * 384;
    for (int it = ci * NWAVES + F.wave; it < NIT; it += nconv * NWAVES) {
        const int e = it / 384; int r = it % 384;
        const size_t eo = (size_t)(layer * 32 + e);
        if (r < 256) { const bool up = r >= 128; r &= 127; const int kb = r / 8, nb = r % 8; const int f0 = 32 * nb;
            const float* W = (up ? P.moe_w_up : P.moe_w_gate) + eo * D * 256;
            transpose_item(W, D, 256, P.wgut(layer) + (size_t)e * 512 * D, 64 * kb, f0, (f0 >> 7) * 256 + (up ? 128 : 0) + (f0 & 127), scr, F.lane);
        } else { r -= 256; const int kb = r / 32, nb = r % 32;
            transpose_item(P.moe_w_down + eo * 256 * D, 256, D, P.wdt(layer) + (size_t)e * D * 256, 64 * kb, 32 * nb, 32 * nb, scr, F.lane); }
    }
}
namespace att {
typedef float f32x16 __attribute__((ext_vector_type(16)));
typedef short s16x4 __attribute__((ext_vector_type(4)));
typedef short v4i16_t __attribute__((ext_vector_type(4)));
typedef LAS const char* lptr;
constexpr float LOG2E = 1.4426950408889634f;
constexpr int KS0 = 0, VS0 = 32768, SLOT = 8192;
constexpr int SCR0 = 65536;
constexpr float MNEG = -1e30f;

struct TileRegs { v4u k, v; };
DEV void tile_load(TileRegs& R, const bf16* Kg, const bf16* Vg, int pitch, int k0, int tid) {
    const int w = tid >> 6, lane = tid & 63;
    R.k = *(const GAS v4u*)(Kg + (size_t)(k0 + lane) * pitch + w * 8);
    R.v = *(const GAS v4u*)(Vg + (size_t)(k0 + 16 * (w & 3) + (lane >> 2)) * pitch + (w >> 2) * 32 + (lane & 3) * 8);
}
DEV void tile_store(LAS unsigned char* lds, int slot, const TileRegs& R, int tid) {
    *(LAS v4u*)(lds + KS0 + slot * SLOT + tid * 16) = R.k;
    *(LAS v4u*)(lds + VS0 + slot * SLOT + tid * 16) = R.v;
}
DEV void qk_tile(f32x16& p0, f32x16& p1, lptr Kslot, const bf16x8 (&qr)[4], int r32, int hi) {
    lptr kb = Kslot + hi * 1024 + r32 * 16;
    __builtin_amdgcn_s_setprio(1);
#pragma unroll
    for (int dh = 0; dh < 2; ++dh) {
        bf16x8 kf[4];
#pragma unroll
        for (int d1 = 0; d1 < 2; ++d1) { kf[2 * d1] = *(const LAS bf16x8*)(kb + (2 * dh + d1) * 2048); kf[2 * d1 + 1] = *(const LAS bf16x8*)(kb + (2 * dh + d1) * 2048 + 512); }
#pragma unroll
        for (int d1 = 0; d1 < 2; ++d1) {
            p0 = __builtin_amdgcn_mfma_f32_32x32x16_bf16(kf[2 * d1], qr[2 * dh + d1], p0, 0, 0, 0);
            p1 = __builtin_amdgcn_mfma_f32_32x32x16_bf16(kf[2 * d1 + 1], qr[2 * dh + d1], p1, 0, 0, 0);
        }
    }
    __builtin_amdgcn_s_setprio(0);
}
DEV float fadd_s(float a, float b) { float r; asm("v_add_f32_e32 %0, %1, %2" : "=v"(r) : "v"(a), "v"(b)); return r; }
DEV float ffma_s(float a, float b, float c) { float r; asm("v_fma_f32 %0, %1, %2, %3" : "=v"(r) : "v"(a), "v"(b), "v"(c)); return r; }
DEV void bias_init(f32x16& p0, f32x16& p1, float s, float base) {
#pragma unroll
    for (int r = 0; r < 16; ++r) { const int kr = (r & 3) + 8 * (r >> 2); p0[r] = fmaf(s, (float)kr, base); p1[r] = fmaf(s, (float)(kr + 32), base); }
}
DEV s16x4 vtr(lptr p) { return __builtin_bit_cast(s16x4, __builtin_amdgcn_ds_read_tr16_b64_v4i16((LAS v4i16_t*)p)); }
DEV unsigned cvtpk(float lo, float hi) { unsigned r; asm volatile("v_cvt_pk_bf16_f32 %0, %1, %2" : "=v"(r) : "v"(lo), "v"(hi)); return r; }
DEV void pv_tile(f32x16 (&o)[2], lptr Vslot, const f32x16& p0, const f32x16& p1, int lane) {
    const int hi = lane >> 5;
    lptr vp = Vslot + ((lane >> 4) & 1) * 32 + (lane & 3) * 8 + (4 * hi + ((lane & 15) >> 2)) * 64;
    bf16x8 pf[4];
#pragma unroll
    for (int ks = 0; ks < 4; ++ks) {
        const f32x16& p = (ks < 2) ? p0 : p1; const int b = (ks & 1) * 8;
        v4u w; w.x = cvtpk(p[b + 0], p[b + 1]); w.y = cvtpk(p[b + 2], p[b + 3]); w.z = cvtpk(p[b + 4], p[b + 5]); w.w = cvtpk(p[b + 6], p[b + 7]);
        pf[ks] = __builtin_bit_cast(bf16x8, w);
    }
    __builtin_amdgcn_s_setprio(1);
#pragma unroll
    for (int ks = 0; ks < 4; ++ks)
#pragma unroll
        for (int d0 = 0; d0 < 2; ++d0) {
            const s16x4 lo = vtr(vp + d0 * 4096 + ks * 1024), hh = vtr(vp + d0 * 4096 + ks * 1024 + 512);
            const bf16x8 vf = (bf16x8){lo[0], lo[1], lo[2], lo[3], hh[0], hh[1], hh[2], hh[3]};
            o[d0] = __builtin_amdgcn_mfma_f32_32x32x16_bf16(vf, pf[ks], o[d0], 0, 0, 0);
        }
    __builtin_amdgcn_s_setprio(0);
}
DEV float lane_swap_max(float m) {
    auto rr = __builtin_amdgcn_permlane32_swap(__float_as_uint(m), __float_as_uint(m), false, false);
    return fmaxf(__uint_as_float(rr[0]), __uint_as_float(rr[1]));
}
DEV float lane_swap_sum(float m) {
    auto rr = __builtin_amdgcn_permlane32_swap(__float_as_uint(m), __float_as_uint(m), false, false);
    return __uint_as_float(rr[0]) + __uint_as_float(rr[1]);
}
DEV float lane_partner(float m, int hi) {
    auto rr = __builtin_amdgcn_permlane32_swap(__float_as_uint(m), __float_as_uint(m), false, false);
    return hi ? __uint_as_float(rr[0]) : __uint_as_float(rr[1]);
}

constexpr float M0 = 16.0f;
struct SoftState { float l; f32x16 o[2]; };
DEV void soft_reset(SoftState& s) { s.l = 0.f; s.o[0] = f32x16{}; s.o[1] = f32x16{}; }

DEV void soft_tile(SoftState& st, f32x16& p0, f32x16& p1, int klo, int klim, bool need_mask, lptr Vslot, int lane) {
    float ls0 = 0.f, ls1 = 0.f;
    if (need_mask) {
#pragma unroll
        for (int r = 0; r < 16; ++r) {
            const int kr = (r & 3) + 8 * (r >> 2);
            const float x0 = __builtin_amdgcn_exp2f(p0[r]), x1 = __builtin_amdgcn_exp2f(p1[r]);
            p0[r] = (kr > klo && kr <= klim) ? x0 : 0.f; p1[r] = (kr + 32 > klo && kr + 32 <= klim) ? x1 : 0.f;
            ls0 += p0[r]; ls0 += p1[r];
        }
    } else {
#pragma unroll
        for (int r = 0; r < 16; ++r) { p0[r] = __builtin_amdgcn_exp2f(p0[r]); p1[r] = __builtin_amdgcn_exp2f(p1[r]); ls0 += p0[r]; ls0 += p1[r]; }
    }
    st.l += ls0 + ls1;
    pv_tile(st.o, Vslot, p0, p1, lane);
}

DEV void soft_pair_fast(SoftState& st, const bf16x8 (&qr)[4], lptr Ka, lptr Va, lptr Kb, lptr Vb, float s2, float baseA, float baseB, int lane) {
    const int r32 = lane & 31, hi = lane >> 5;
    f32x16 a0, a1, b0, b1;
    bias_init(a0, a1, s2, baseA); bias_init(b0, b1, s2, baseB);
    qk_tile(a0, a1, Ka, qr, r32, hi);
    qk_tile(b0, b1, Kb, qr, r32, hi);
    float ls0 = 0.f, ls1 = 0.f;
#pragma unroll
    for (int r = 0; r < 16; ++r) { a0[r] = __builtin_amdgcn_exp2f(a0[r]); a1[r] = __builtin_amdgcn_exp2f(a1[r]); ls0 += a0[r]; ls0 += a1[r]; }
    pv_tile(st.o, Va, a0, a1, lane);
#pragma unroll
    for (int r = 0; r < 16; ++r) { b0[r] = __builtin_amdgcn_exp2f(b0[r]); b1[r] = __builtin_amdgcn_exp2f(b1[r]); ls0 += b0[r]; ls0 += b1[r]; }
    st.l += ls0 + ls1;
    pv_tile(st.o, Vb, b0, b1, lane);
}

DEV void store_ot(const f32x16 (&o)[2], float f, bf16* orow, int hi) {
#pragma unroll
    for (int d0 = 0; d0 < 2; ++d0)
#pragma unroll
        for (int g = 0; g < 4; ++g) {
            const unsigned a = cvtpk(o[d0][4 * g] * f, o[d0][4 * g + 1] * f), b = cvtpk(o[d0][4 * g + 2] * f, o[d0][4 * g + 3] * f);
            *(GAS unsigned long long*)(orow + 32 * d0 + 8 * g + 4 * hi) = (unsigned long long)a | ((unsigned long long)b << 32);
        }
}
DEV void load_q(bf16x8 (&qr)[4], const bf16* qrow, int hi) {
    const float c1 = 0.125f * LOG2E;
#pragma unroll
    for (int d0 = 0; d0 < 4; ++d0) {
        const v4u x = *(const GAS v4u*)(qrow + 16 * d0 + 8 * hi);
        v4u y;
        y.x = pk2(u2f(x.x << 16) * c1, u2f(x.x & 0xffff0000u) * c1); y.y = pk2(u2f(x.y << 16) * c1, u2f(x.y & 0xffff0000u) * c1);
        y.z = pk2(u2f(x.z << 16) * c1, u2f(x.z & 0xffff0000u) * c1); y.w = pk2(u2f(x.w << 16) * c1, u2f(x.w & 0xffff0000u) * c1);
        qr[d0] = __builtin_bit_cast(bf16x8, y);
    }
}

template <bool FAST, class MaskF>
DEV void run_segment(Frame& F, SoftState& st, const bf16x8 (&qr)[4], const bf16* Kg, const bf16* Vg, int pitch, unsigned long long tmask, float s2, int qpos, const MaskF& mf) {
    const int tid = F.tid, lane = F.lane, r32 = lane & 31, hi = lane >> 5;
    if (tmask == 0ull) return;
#define NEXT_TILE(var) do { if (tmask) { var = __builtin_ctzll(tmask); tmask &= tmask - 1ull; } else var = -1; } while (0)
#define SEG_COMPUTE(t, slot) do { int klo, klim; mf((t), klo, klim); \
        if (__any(klim >= 0 && klo < 60 && klim > klo)) { \
            const bool none_ = klim < 0 || klo >= 59 || klim <= klo, full_ = klim >= 59 && klo < 0;        \
            const bool need_mask = __any(!none_ && !full_); f32x16 p0, p1; \
            bias_init(p0, p1, s2, none_ ? MNEG : s2 * (float)((t) * 64 - qpos + 4 * hi) - M0); \
            qk_tile(p0, p1, (lptr)(F.lds + KS0 + (slot) * SLOT), qr, r32, hi); \
            soft_tile(st, p0, p1, klo, klim, need_mask, (lptr)(F.lds + VS0 + (slot) * SLOT), lane); } } while (0)
    int ta, tb, tc, td, set = 0;
    NEXT_TILE(ta); NEXT_TILE(tb);
    TileRegs RA, RB; tile_load(RA, Kg, Vg, pitch, ta * 64, tid); if (tb >= 0) tile_load(RB, Kg, Vg, pitch, tb * 64, tid);
    for (;;) {
        tile_store(F.lds, 2 * set, RA, tid); if (tb >= 0) tile_store(F.lds, 2 * set + 1, RB, tid);
        NEXT_TILE(tc); NEXT_TILE(td);
        if (tc >= 0) tile_load(RA, Kg, Vg, pitch, tc * 64, tid);
        if (td >= 0) tile_load(RB, Kg, Vg, pitch, td * 64, tid);
        __syncthreads();
        bool fast = false;
        if (FAST && tb >= 0) {
            int kloA, klimA, kloB, klimB; mf(ta, kloA, klimA); mf(tb, kloB, klimB);
            const bool fullA = klimA >= 59 && kloA < 0, noneA = klimA < 0 || kloA >= 59 || klimA <= kloA;
            const bool fullB = klimB >= 59 && kloB < 0, noneB = klimB < 0 || kloB >= 59 || klimB <= kloB;
            fast = __all((fullA || noneA) && (fullB || noneB)) && __any(fullA) && __any(fullB);
            if (fast) {
                const float hb = (float)(4 * hi - qpos);
                const float baseA = fullA ? s2 * ((float)(ta * 64) + hb) - M0 : MNEG, baseB = fullB ? s2 * ((float)(tb * 64) + hb) - M0 : MNEG;
                soft_pair_fast(st, qr, (lptr)(F.lds + KS0 + (2 * set) * SLOT), (lptr)(F.lds + VS0 + (2 * set) * SLOT), (lptr)(F.lds + KS0 + (2 * set + 1) * SLOT), (lptr)(F.lds + VS0 + (2 * set + 1) * SLOT), s2, baseA, baseB, lane);
            }
        }
        if (!fast) {
            SEG_COMPUTE(ta, 2 * set);
            if (tb >= 0) SEG_COMPUTE(tb, 2 * set + 1);
        }
        if (tc < 0) break;
        ta = tc; tb = td; set ^= 1;
    }
    __syncthreads();
#undef NEXT_TILE
#undef SEG_COMPUTE
}
DEV unsigned long long tile_range(int t0, int t1) { return (t1 < t0) ? 0ull : ((~0ull >> (63 - (t1 - t0))) << t0); }
}

DEV void headnorm_group(bf16* row, int off, int nheads, const float* g, int lane) {
    const int hg = lane >> 3, ch = lane & 7;
    if (hg < nheads) {
        GAS v4u* p = (GAS v4u*)(row + off + hg * 64 + ch * 8);
        const v4u x = *p;
        float v[8] = {u2f(x.x << 16), u2f(x.x & 0xffff0000u), u2f(x.y << 16), u2f(x.y & 0xffff0000u), u2f(x.z << 16), u2f(x.z & 0xffff0000u), u2f(x.w << 16), u2f(x.w & 0xffff0000u)};
        float ss = 0.f;
#pragma unroll
        for (int j = 0; j < 8; ++j) ss += v[j] * v[j];
        ss += __shfl_xor(ss, 1); ss += __shfl_xor(ss, 2); ss += __shfl_xor(ss, 4);
        const float r = 1.0f / sqrtf(ss * (1.0f / 64) + EPS);
        const f32x4 g0 = *(const GAS f32x4*)(g + ch * 8), g1 = *(const GAS f32x4*)(g + ch * 8 + 4);
        v4u o; o.x = pk2(v[0] * r * g0.x, v[1] * r * g0.y); o.y = pk2(v[2] * r * g0.z, v[3] * r * g0.w); o.z = pk2(v[4] * r * g1.x, v[5] * r * g1.y); o.w = pk2(v[6] * r * g1.z, v[7] * r * g1.w);
        *p = o;
    }
}
DEV void fp_headnorm(const Params& P, Frame& F, int layer) {
    const int gw = F.vcu * NWAVES + F.wave, NGW = F.G * NWAVES, lane = F.lane;
    for (int t = gw; t < T; t += NGW) {
        bf16* row = P.proj() + (size_t)t * LDP;
        if (layer == 0) {
            headnorm_group(row, 0, 8, P.ev_q_norm, lane);
            headnorm_group(row, 512, 2, P.ev_k_norm, lane);
        } else {
            headnorm_group(row, 0, 8, P.od_c_q_norm, lane);
            headnorm_group(row, 512, 8, P.od_c_k_norm, lane);
            headnorm_group(row, 1536, 8, P.od_d_q_norm, lane);
            headnorm_group(row, 2304, 2, P.od_d_k_norm + 64, lane);
            headnorm_group(row, 2560, 2, P.od_d_k_norm + 128, lane);
        }
    }
}

DEV void fp_prep_compress(const Params& P, Frame& F, int ci, int n) {
    const int gw = ci * NWAVES + F.wave, NGW = n * NWAVES, lane = F.lane;
    for (int i = gw; i < 128; i += NGW) {
        const int which = i >> 6, e = i & 63;
        const float* pos = P.od_cmp_pos + which * 2048; const float* w = P.od_cmp_w + (size_t)which * 2048 * 64 + e;
        float s = 0.f;
        for (int k = lane; k < 2048; k += 64) s += pos[k] * w[(size_t)k * 64];
        s = wave_sum(s);
        if (lane == 0) P.cbias()[i] = s;
    }
    LAS float* scr = (LAS float*)(F.lds + F.wave * 16384);
    for (int i = gw; i < 128; i += NGW) {
        const int which = i >> 6, r = i & 63, kb = r >> 1, nb = r & 1;
        transpose_item(P.od_cmp_w + (size_t)which * 2048 * 64, 2048, 64, P.wcmpt() + (size_t)which * 64 * 2048, 64 * kb, 32 * nb, 32 * nb, scr, lane);
    }
}

DEV void fp_prep1(const Params& P, Frame& F) {
    const int gw = F.vcu * NWAVES + F.wave, NGW = F.G * NWAVES, lane = F.lane, w = F.wave;
    for (int i = gw; i < NB * 64; i += NGW) {
        const int n = i & 7, h = (i >> 3) & 7, b = i >> 6;
        const bf16* kp = P.proj() + ((size_t)b * S + n * 256) * LDP + 512 + h * 64 + lane;
        float s0 = 0.f, s1 = 0.f, s2 = 0.f, s3 = 0.f;
#pragma unroll 4
        for (int j = 0; j < 256; j += 4) { s0 += bf2f(kp[(size_t)j * LDP]); s1 += bf2f(kp[(size_t)(j + 1) * LDP]); s2 += bf2f(kp[(size_t)(j + 2) * LDP]); s3 += bf2f(kp[(size_t)(j + 3) * LDP]); }
        P.kmean()[(size_t)i * 64 + lane] = ((s0 + s1) + (s2 + s3)) * (1.0f / 256);
    }
    LAS float* part = (LAS float*)F.lds;
    for (int it = F.vcu; it < 2 * NB * 2 * 8; it += F.G) {
        const int ng = it & 7, hkv = (it >> 3) & 1, b = (it >> 4) % NB, which = it / (16 * NB);
        const int n = 16 * ng + (lane & 15);
        const int ncl = n > 126 ? 126 : n;
        const bf16* arow = P.proj() + ((size_t)b * S + ncl * 16) * LDP + (which ? 2176 : 2048) + hkv * 64 + 8 * (lane >> 4);
        const bf16* brow = P.wcmpt() + (size_t)which * 64 * 2048 + (size_t)(lane & 15) * 2048 + 8 * (lane >> 4);
        pg8::f32x4 acc[4];
#pragma unroll
        for (int c = 0; c < 4; ++c) acc[c] = (pg8::f32x4){0.f, 0.f, 0.f, 0.f};
#pragma unroll
        for (int kk = 0; kk < 8; ++kk) {
            const int ks = 8 * w + kk, li = ks >> 1, dh = (ks & 1) * 32;
            const bf16x8 a = *(const GAS bf16x8*)(arow + (size_t)li * LDP + dh);
#pragma unroll
            for (int c = 0; c < 4; ++c) {
                const bf16x8 bb = *(const GAS bf16x8*)(brow + (size_t)(16 * c) * 2048 + 32 * ks);
                acc[c] = __builtin_amdgcn_mfma_f32_16x16x32_bf16(a, bb, acc[c], 0, 0, 0);
            }
        }
#pragma unroll
        for (int c = 0; c < 4; ++c)
#pragma unroll
            for (int r = 0; r < 4; ++r) part[(w * 16 + 4 * (lane >> 4) + r) * 64 + 16 * c + (lane & 15)] = acc[c][r];
        __syncthreads();
        {
            const int row = F.tid >> 5, c0 = 2 * (F.tid & 31);
            float v0 = P.cbias()[which * 64 + c0], v1 = P.cbias()[which * 64 + c0 + 1];
#pragma unroll
            for (int ww = 0; ww < 8; ++ww) { v0 += part[(ww * 16 + row) * 64 + c0]; v1 += part[(ww * 16 + row) * 64 + c0 + 1]; }
            if (which == 0) {
                float ss = v0 * v0 + v1 * v1;
                ss += __shfl_xor(ss, 1); ss += __shfl_xor(ss, 2); ss += __shfl_xor(ss, 4); ss += __shfl_xor(ss, 8); ss += __shfl_xor(ss, 16);
                const float rs = 1.0f / sqrtf(ss * (1.0f / 64) + EPS);
                v0 *= rs * P.od_d_k_norm[c0]; v1 *= rs * P.od_d_k_norm[c0 + 1];
            }
            const int nn = 16 * ng + row;
            if (nn < NCMP) *(GAS unsigned*)(P.kvcmp() + (((size_t)(which * NB + b) * NCMP + nn) * 2 + hkv) * 64 + c0) = pk2(v0, v1);
        }
        __syncthreads();
    }
}

DEV void sb_tile(att::f32x16& p0, att::f32x16& p1, float& carry, int lim, int hi) {
    using namespace att;
    const float c1 = 0.125f * LOG2E;
    f32x16 k0, k1;
    float cp[2][4];
#pragma unroll
    for (int hf = 0; hf < 2; ++hf)
#pragma unroll
        for (int g = 0; g < 4; ++g) {
            float pr = 1.f;
#pragma unroll
            for (int i = 0; i < 4; ++i) {
                const int r = 4 * g + i, kr = i + 8 * g + 32 * hf;
                const float z2 = fminf(hf ? p1[r] : p0[r], 100.f);
                const float e1 = __builtin_amdgcn_exp2f(z2);
                const float keep = __builtin_amdgcn_rcpf(1.0f + e1);
                const bool ok = kr < lim;
                const float sg = ok ? e1 * keep : 0.f;
                const float kp = ok ? keep : 1.f;
                if (hf) { p1[r] = sg; k1[r] = kp; } else { p0[r] = sg; k0[r] = kp; }
                pr *= kp;
            }
            cp[hf][g] = pr;
        }
    float run = carry;
#pragma unroll
    for (int hf = 1; hf >= 0; --hf)
#pragma unroll
        for (int g = 3; g >= 0; --g) {
            const float mine = cp[hf][g], other = lane_partner(mine, hi);
            float suf = hi ? run : run * other;
            run *= mine * other;
#pragma unroll
            for (int i = 3; i >= 0; --i) {
                const int r = 4 * g + i;
                if (hf) { p1[r] *= suf; suf *= k1[r]; } else { p0[r] *= suf; suf *= k0[r]; }
            }
        }
    carry = run;
}

DEV void fp_attn0(const Params& P, Frame& F) {
    using namespace att;
    const int tid = F.tid, lane = F.lane, r32 = lane & 31, hi = lane >> 5, w = F.wave;
    for (int u = F.vcu; u < 512; u += F.G) {
        {
            const int b = u >> 6, h = (u >> 3) & 7, blk = u & 7;
            const bf16* base = P.proj() + (size_t)b * S * LDP;
            const int q = blk * 256 + w * 32 + r32;
            bf16x8 qr[4]; load_q(qr, base + (size_t)q * LDP + 768 + h * 64, hi);
            const bf16* Kg = base + 1280 + h * 64; const bf16* Vg = base + 1792 + h * 64;
            f32x16 o[2]; o[0] = f32x16{}; o[1] = f32x16{};
            float carry = 1.f;
            const int tmax = blk * 4 + 3;
            const int tw = (blk * 256 + w * 32 + 31) >> 6;
            volatile LAS int* flag = (volatile LAS int*)(F.lds + LDSCTL_OFF + 12288);
            if (tid < 3) flag[tid] = 0;
            TileRegs R; tile_load(R, Kg, Vg, LDP, tmax * 64, tid);
            int slot = 0; bool wave_done = false;
            for (int t = tmax; t >= 0; --t) {
                tile_store(F.lds, slot, R, tid);
                if (t > 0) tile_load(R, Kg, Vg, LDP, (t - 1) * 64, tid);
                __syncthreads();
                if (t < tmax && flag[(t + 1) % 3] == 0) break;
                if (tid == 0) flag[(t + 2) % 3] = 0;
                if (!wave_done && t <= tw) {
                    f32x16 p0 = f32x16{}, p1 = f32x16{};
                    qk_tile(p0, p1, (lptr)(F.lds + KS0 + slot * SLOT), qr, r32, hi);
                    sb_tile(p0, p1, carry, q - t * 64 - 4 * hi, hi);
                    pv_tile(o, (lptr)(F.lds + VS0 + slot * SLOT), p0, p1, lane);
                    if (__all(carry == 0.f)) wave_done = true;
                }
                if (!wave_done && lane == 0) flag[t % 3] = 1;
                slot ^= 1;
            }
            __syncthreads();
            store_ot(o, 1.0f, P.o() + (size_t)(b * S + q) * D + 512 + h * 64, hi);
        }
    }
    asm volatile("" ::: "memory");
    for (int u = 512 + F.vcu; u < 1024; u += F.G) {
        {
            const int v = u - 512, b = v >> 6, hkv = (v >> 5) & 1, c = v & 31;
            const bf16* base = P.proj() + (size_t)b * S * LDP;
            const int hh = hkv * 4 + (w >> 1), q = c * 64 + (w & 1) * 32 + r32;
            bf16x8 qr[4]; load_q(qr, base + (size_t)q * LDP + hh * 64, hi);
            const float sl = exp2f(-(float)(hh + 1)), s2 = sl * LOG2E;
            SoftState st; soft_reset(st);
            const int t0 = c - 2 < 0 ? 0 : c - 2;
            run_segment<true>(F, st, qr, base + 512 + hkv * 64, base + 640 + hkv * 64, LDP, tile_range(t0, c), s2, q,
                        [&](int t, int& klo, int& klim) { klim = q - t * 64 - 4 * hi; klo = klim - 128; });
            const float den = lane_swap_sum(st.l) + __builtin_amdgcn_exp2f(P.ev_sink[hh] * LOG2E - M0);
            store_ot(st.o, 1.0f / den, P.o() + (size_t)(b * S + q) * D + hh * 64, hi);
        }
    }
}

DEV void fp_attn1(const Params& P, Frame& F) {
    using namespace att;
    const int lane = F.lane, r32 = lane & 31, hi = lane >> 5, w = F.wave;
    for (int u = F.vcu; u < 512; u += F.G) {
        {
            const int v = u & 255, bh = v >> 2, blk = (u < 256) ? (v & 3) : 7 - (v & 3);
            const int b = bh >> 3, h = bh & 7;
            const bf16* base = P.proj() + (size_t)b * S * LDP;
            const int q = blk * 256 + w * 32 + r32;
            bf16x8 qr[4]; load_q(qr, base + (size_t)q * LDP + h * 64, hi);
            const float sl = exp2f(-(float)(h + 1)), s2 = sl * LOG2E;
            float gt[8];
#pragma unroll
            for (int n = 0; n < 8; ++n) {
                float g = 0.f;
                if (n < blk) {
                    const float* km = P.kmean() + ((size_t)(b * 8 + h) * 8 + n) * 64;
#pragma unroll
                    for (int d0 = 0; d0 < 4; ++d0)
#pragma unroll
                        for (int j = 0; j < 8; ++j) g += bf2f((bf16)qr[d0][j]) * km[16 * d0 + 8 * hi + j];
                }
                g = lane_swap_sum(g);
                gt[n] = n < blk ? g : NEG;
            }
            unsigned sel = 0;
#pragma unroll
            for (int n = 0; n < 8; ++n) {
                int rank = 0;
#pragma unroll
                for (int k = 0; k < 8; ++k) rank += (gt[k] > gt[n] || (gt[k] == gt[n] && k < n)) ? 1 : 0;
                if (rank < 3 && n < blk) sel |= 1u << n;
            }
            SoftState st; soft_reset(st);
            run_segment<true>(F, st, qr, base + 512 + h * 64, base + 1024 + h * 64, LDP, tile_range(0, blk * 4 + 3), s2, q,
                        [&](int t, int& klo, int& klim) { const int n = t >> 2; klo = -1;
                            if (n < blk) klim = ((sel >> n) & 1) ? 63 : -1; else klim = q - t * 64 - 4 * hi; });
            const float l = lane_swap_sum(st.l);
            store_ot(st.o, 1.0f / l, P.o() + (size_t)(b * S + q) * D + h * 64, hi);
        }
    }
    asm volatile("" ::: "memory");
    for (int u = 512 + F.vcu; u < 1024; u += F.G) {
        {
            const int v = u & 255, bk = v >> 4, c = (u < 768) ? (v & 15) : 31 - (v & 15);
            const int b = bk >> 1, hkv = bk & 1;
            const bf16* base = P.proj() + (size_t)b * S * LDP;
            const int h = hkv * 4 + (w >> 1), q = c * 64 + (w & 1) * 32 + r32, t = b * S + q;
            bf16x8 qr[4]; load_q(qr, base + (size_t)q * LDP + 1536 + h * 64, hi);
            const float sl = exp2f(-(float)(h + 1)), s2 = sl * LOG2E;
            const bf16* grow = base + (size_t)q * LDP + 2816 + h * 3;
            LAS float* part = (LAS float*)(F.lds + SCR0);
            volatile LAS unsigned long long* tot = (volatile LAS unsigned long long*)(F.lds + SCR0 + 33792);
            volatile LAS unsigned* selm = (volatile LAS unsigned*)(F.lds + SCR0 + 33792 + 16896);
            f32x16 fin[2];
            {
                const int ntile = c >= 16 ? 2 : 1;
                const bf16* Kc = P.kvcmp() + ((size_t)(0 * NB + b) * NCMP) * 128 + hkv * 64;
                const bf16* Vc = P.kvcmp() + ((size_t)(1 * NB + b) * NCMP) * 128 + hkv * 64;
                { TileRegs R0; tile_load(R0, Kc, Vc, 128, 0, F.tid); tile_store(F.lds, 0, R0, F.tid); }
                if (ntile == 2) { TileRegs R1; tile_load(R1, Kc, Vc, 128, 64, F.tid); tile_store(F.lds, 1, R1, F.tid); }
                __syncthreads();
                const int nlim = (q - 31) >> 4;
                const float s16 = 16.0f * s2;
                const float basec = s2 * (float)(31 - q) + s16 * (float)(4 * hi);
                float lsum = 0.f;
                for (int tl = 0; tl < ntile; ++tl) {
                    const int klim = nlim - 64 * tl - 4 * hi; const float bt = basec + s16 * (float)(64 * tl) - M0;
                    f32x16 x0, x1; bias_init(x0, x1, s16, bt); qk_tile(x0, x1, (lptr)(F.lds + KS0 + tl * SLOT), qr, r32, hi);
#pragma unroll
                    for (int r = 0; r < 16; ++r) {
                        const int kr = (r & 3) + 8 * (r >> 2);
                        lsum += kr <= klim ? __builtin_amdgcn_exp2f(x0[r]) : 0.f;
                        lsum += kr + 32 <= klim ? __builtin_amdgcn_exp2f(x1[r]) : 0.f;
                    }
                }
                lsum = lane_swap_sum(lsum);
                const float inv = nlim >= 0 ? 1.0f / lsum : 0.f;
                fin[0] = f32x16{}; fin[1] = f32x16{};
                LAS float* prow = part + ((w >> 1) * 64 + (w & 1) * 32 + r32) * 33;
                float peprev = 0.f;
                for (int tl = 0; tl < ntile; ++tl) {
                    const int klim = nlim - 64 * tl - 4 * hi; const float bt = basec + s16 * (float)(64 * tl) - M0;
                    f32x16 x0, x1; bias_init(x0, x1, s16, bt); qk_tile(x0, x1, (lptr)(F.lds + KS0 + tl * SLOT), qr, r32, hi);
#pragma unroll
                    for (int r = 0; r < 16; ++r) {
                        const int kr = (r & 3) + 8 * (r >> 2);
                        x0[r] = kr <= klim ? __builtin_amdgcn_exp2f(x0[r]) * inv : 0.f;
                        x1[r] = kr + 32 <= klim ? __builtin_amdgcn_exp2f(x1[r]) * inv : 0.f;
                    }
#pragma unroll
                    for (int ix = 0; ix < 8; ++ix) {
                        const int g = ix & 3;
                        const float C = (ix < 4) ? (x0[4 * g] + x0[4 * g + 1]) + (x0[4 * g + 2] + x0[4 * g + 3]) : (x1[4 * g] + x1[4 * g + 1]) + (x1[4 * g + 2] + x1[4 * g + 3]);
                        const float pe = lane_partner((ix < 4) ? x0[4 * g + 3] : x1[4 * g + 3], hi);
                        prow[2 * (8 * tl + ix) + hi] = C + (hi ? pe : peprev);
                        peprev = pe;
                    }
                    pv_tile(fin, (lptr)(F.lds + VS0 + tl * SLOT), x0, x1, lane);
                }
                { const float g0 = 1.0f / (1.0f + __expf(-bf2f(grow[0])));
#pragma unroll
                for (int r = 0; r < 16; ++r) { fin[0][r] *= g0; fin[1][r] *= g0; } }
            }
            __syncthreads();
            {
                const int ql = F.tid >> 3, jg = F.tid & 7;
#pragma unroll
                for (int jj = 0; jj < 4; ++jj) {
                    const int j = 4 * jg + jj;
                    float sc = ((part[(0 * 64 + ql) * 33 + j] + part[(1 * 64 + ql) * 33 + j]) + part[(2 * 64 + ql) * 33 + j]) + part[(3 * 64 + ql) * 33 + j];
                    const bool forced = (j == 0) || (j == c) || (j == c - 1);
                    sc = (j <= c) ? sc + (forced ? 1000.0f : 0.0f) : NEG;
                    const unsigned ub = f2u(sc), ord = ub ^ ((ub >> 31) ? 0xffffffffu : 0x80000000u);
                    tot[ql * 33 + j] = ((unsigned long long)ord << 32) | (unsigned)(31 - j);
                }
                __syncthreads();
                unsigned long long mine[4];
#pragma unroll
                for (int jj = 0; jj < 4; ++jj) mine[jj] = tot[ql * 33 + 4 * jg + jj];
                int rank[4] = {0, 0, 0, 0};
                for (int k = 0; k < 32; ++k) {
                    const unsigned long long sk = tot[ql * 33 + k];
#pragma unroll
                    for (int jj = 0; jj < 4; ++jj) rank[jj] += (sk > mine[jj]) ? 1 : 0;
                }
                unsigned bits = 0;
#pragma unroll
                for (int jj = 0; jj < 4; ++jj) if (rank[jj] < 16 && 4 * jg + jj <= c) bits |= 1u << (4 * jg + jj);
                bits |= __shfl_xor(bits, 1); bits |= __shfl_xor(bits, 2); bits |= __shfl_xor(bits, 4);
                if (jg == 0) selm[ql] = bits;
                unsigned ub = bits; ub |= __shfl_xor(ub, 8); ub |= __shfl_xor(ub, 16); ub |= __shfl_xor(ub, 32);
                if (lane == 0) selm[64 + w] = ub;
            }
            __syncthreads();
            const unsigned mask = selm[(w & 1) * 32 + r32];
            const unsigned umask = ((selm[64] | selm[65]) | (selm[66] | selm[67])) | ((selm[68] | selm[69]) | (selm[70] | selm[71]));
            __syncthreads();
            LAS float* stg = (LAS float*)(F.lds + SCR0) + w * 2048 + lane;
#pragma unroll
            for (int r = 0; r < 16; ++r) { stg[r * 64] = fin[0][r]; stg[(16 + r) * 64] = fin[1][r]; }
            SoftState st; soft_reset(st);
            run_segment<false>(F, st, qr, base + 2304 + hkv * 64, base + 2432 + hkv * 64, LDP, (unsigned long long)umask, s2, q,
                        [&](int tt, int& klo, int& klim) { klo = -1; klim = ((mask >> tt) & 1) ? (q - tt * 64 - 4 * hi) : -1; });
            { const float g1 = 1.0f / (1.0f + __expf(-bf2f(grow[1]))); const float f = g1 / lane_swap_sum(st.l);
#pragma unroll
              for (int r = 0; r < 16; ++r) { stg[r * 64] += f * st.o[0][r]; stg[(16 + r) * 64] += f * st.o[1][r]; } }
            soft_reset(st);
            run_segment<true>(F, st, qr, base + 2560 + hkv * 64, base + 2688 + hkv * 64, LDP, tile_range(c - 8 < 0 ? 0 : c - 8, c), s2, q,
                        [&](int tt, int& klo, int& klim) { klim = q - tt * 64 - 4 * hi; klo = klim - 512; });
            { const float g2 = 1.0f / (1.0f + __expf(-bf2f(grow[2]))); const float f = g2 / lane_swap_sum(st.l);
#pragma unroll
              for (int r = 0; r < 16; ++r) { st.o[0][r] = stg[r * 64] + f * st.o[0][r]; st.o[1][r] = stg[(16 + r) * 64] + f * st.o[1][r]; } }
            store_ot(st.o, 1.0f, P.o() + (size_t)t * D + 512 + h * 64, hi);
            __syncthreads();
        }
    }
}
enum { PH_PRE = 0, PH_INPROJ0, PH_ATTN0, PH_OUTPROJ0, PH_ROUTE0, PH_FFN0, PH_COMBINE0, PH_INPROJ1, PH_PREP1, PH_ATTN1, PH_OUTPROJ1, PH_ROUTE1, PH_FFN1, PH_COMBINE1, PH_COUNT };
struct FArgs { Params p; };

#ifndef PROBE_PHASE
#define PROBE_PHASE -1
#endif
constexpr int STAMP_OFF = LDSCTL_OFF + 1024;
constexpr int HN_OFF = LDSCTL_OFF + 2048;
DEV void stampk(Frame& F, int k) {
    if (PROBE_PHASE >= 0 && F.tid == 0) ((volatile LAS unsigned*)(F.lds + STAMP_OFF))[k] = (unsigned)__builtin_amdgcn_s_memrealtime() | 1u;
}
__global__ void __launch_bounds__(NWAVES * 64, 2) k_fast(FArgs args) {
    extern __shared__ __attribute__((aligned(16))) unsigned char lds[];
    const Params& P = args.p;
    Frame F;
    F.lds = (LAS unsigned char*)lds;
    F.MISC = (volatile LAS unsigned*)(F.lds + MISC_OFF);
    F.tid = threadIdx.x; F.lane = F.tid & 63; F.wave = __builtin_amdgcn_readfirstlane(F.tid >> 6);
    F.G = gridDim.x; { const int bx = blockIdx.x; F.vcu = (F.G % 8 == 0) ? (bx % 8) * (F.G / 8) + bx / 8 : bx; }
    for (int u = F.tid; u < (LDS_BYTES - LDSCTL_OFF) / 4; u += NWAVES * 64) ((LAS unsigned*)(F.lds + LDSCTL_OFF))[u] = 0u;
    __syncthreads();
    XcdBarrier bar = xcd_barrier_post(P.ctl() + CW_BAR, F.MISC + 8);
#define BEGIN(k) refresh(F); stampk(F, (k));
#define SEAM() do { refresh(F); xcd_barrier(bar, F.tid); } while (0)
    { BEGIN(PH_PRE) fp_convert_weights(P, F, 0, F.vcu, F.G); fp_prep_router(P, F); fp_norm_rows(F, P.x, P.ev_norm, P.xn()); if (F.G != 256) { fp_convert_weights(P, F, 1, F.vcu, F.G); fp_prep_compress(P, F, F.vcu, F.G); } SEAM(); }
    { BEGIN(PH_INPROJ0) const int cq = F.vcu >> 2, cr = F.vcu & 3, gi = 3 * cq + cr;
      if (F.G == 256 && cr == 3) fp_convert_moe_part(P, F, 0, cq, 64);
      else { pg8::StaticOrder So; So.init(P.xn(), P.win0t(), T, EVEN_IN, D, F.G == 256 ? 192 : F.G, F.G == 256 ? gi : F.vcu);
        pg8::EpiProjNorm<0> E{P.proj(), LDP, P.ev_q_norm, P.ev_k_norm, nullptr, nullptr, nullptr, (PG8_LAS float*)(F.lds + HN_OFF)};
        pg8::gemm_phase(F.lds, D, So, E, F.wave); if (F.G != 256) { refresh(F); fp_convert_moe_part(P, F, 0, F.vcu, F.G); } }
      SEAM(); }
    { BEGIN(PH_ATTN0) fp_attn0(P, F); SEAM(); }
    { BEGIN(PH_OUTPROJ0) pg8::StaticOrder So; So.init(P.o(), P.wout0t(), T, D, D, F.G, (int)blockIdx.x);
      pg8::EpiResidF32 E{P.x, P.out, D, P.ssq()}; pg8::gemm_phase(F.lds, D, So, E, F.wave); SEAM(); }
    { BEGIN(PH_ROUTE0) fp_route(P, F, 0); SEAM(); }
    { BEGIN(PH_FFN0) const int cq = F.vcu >> 2, cr = F.vcu & 3, gi = 3 * cq + cr;
      if (F.G == 256 && cr == 3) { fp_convert_weights(P, F, 1, cq, 64); fp_prep_compress(P, F, cq, 64); fp_convert_moe_part(P, F, 1, cq, 64); }
      else if (F.G == 256) { XcdBarrier wb = xcd_barrier_post(P.ctl() + CW_BAR + XCD_BAR_WORDS, F.MISC + 10); wb.expect = 192u; fp_moe_rounds(P, F, 0, gi, 192, wb); }
      else { XcdBarrier wb = xcd_barrier_post(P.ctl() + CW_BAR + XCD_BAR_WORDS, F.MISC + 10); fp_moe_rounds(P, F, 0, F.vcu, F.G, wb); refresh(F); fp_convert_weights(P, F, 1, F.vcu, F.G); fp_prep_compress(P, F, F.vcu, F.G); fp_convert_moe_part(P, F, 1, F.vcu, F.G); }
      SEAM(); }
    { BEGIN(PH_COMBINE0) fp_combine(P, F, 0, P.od_norm, P.xn()); SEAM(); }
    { BEGIN(PH_INPROJ1) pg8::StaticOrder So; So.init(P.xn(), P.win1t(), T, LDP, D, F.G, (int)blockIdx.x);
      pg8::EpiProjNorm<1> E{P.proj(), LDP, P.od_c_q_norm, P.od_c_k_norm, P.od_d_q_norm, P.od_d_k_norm + 64, P.od_d_k_norm + 128, (PG8_LAS float*)(F.lds + HN_OFF)};
      pg8::gemm_phase(F.lds, D, So, E, F.wave); SEAM(); }
    { BEGIN(PH_PREP1) fp_prep1(P, F); SEAM(); }
    { BEGIN(PH_ATTN1) fp_attn1(P, F); SEAM(); }
    { BEGIN(PH_OUTPROJ1) pg8::StaticOrder So; So.init(P.o(), P.wout1t(), T, D, D, F.G, (int)blockIdx.x);
      pg8::EpiResidF32 E{P.out, P.out, D, P.ssq()}; pg8::gemm_phase(F.lds, D, So, E, F.wave); SEAM(); }
    { BEGIN(PH_ROUTE1) fp_route(P, F, 1); SEAM(); }
    { BEGIN(PH_FFN1) XcdBarrier wb = xcd_barrier_post(P.ctl() + CW_BAR + 2 * XCD_BAR_WORDS, F.MISC + 12); fp_moe_rounds(P, F, 1, F.vcu, F.G, wb); SEAM(); }
    { BEGIN(PH_COMBINE1) fp_combine(P, F, 1, nullptr, nullptr); }
    if (PROBE_PHASE >= 0) {
        refresh(F);
        if (F.vcu == 0 && F.tid == 0) {
            volatile LAS unsigned* st = (volatile LAS unsigned*)(F.lds + STAMP_OFF);
            const unsigned t1 = (PROBE_PHASE + 1 < PH_COUNT) ? st[(PROBE_PHASE + 1 < PH_COUNT) ? PROBE_PHASE + 1 : 0] : ((unsigned)__builtin_amdgcn_s_memrealtime() | 1u);
            const unsigned t0 = st[PROBE_PHASE < 0 ? 0 : PROBE_PHASE];
            asm volatile("s_waitcnt vmcnt(0)" ::: "memory");
#ifndef PROBE_SCALE
#define PROBE_SCALE 0.01f
#endif
            P.out[0] += (float)(t1 - t0) * PROBE_SCALE;
        }
    }
#undef BEGIN
#undef SEAM
}

static size_t carve(Params& p, void* d_ws) { p.ws = (char*)d_ws; return WS_END; }

extern "C" void kernel_launch(void* const* d_in, const int* in_sizes, int n_in, void* d_out, int out_size, void* d_ws, size_t ws_size,
                              hipStream_t stream) {
    Params p{};
    const float** f = (const float**)&p;
    for (int i = 0; i < 24; ++i) f[i] = (const float*)d_in[i];
    p.out = (float*)d_out;
    const size_t need = carve(p, d_ws);
    static int grid = 0;
    if (grid == 0) {
        int dev = 0, cus = 0, per_cu = 0;
        if (hipGetDevice(&dev) != hipSuccess || hipDeviceGetAttribute(&cus, hipDeviceAttributeMultiprocessorCount, dev) != hipSuccess) { grid = -1; return; }
        if (hipFuncSetAttribute((const void*)k_fast, hipFuncAttributeMaxDynamicSharedMemorySize, LDS_BYTES) != hipSuccess) { fprintf(stderr, "hipFuncSetAttribute failed\n"); grid = -1; return; }
        if (hipOccupancyMaxActiveBlocksPerMultiprocessor(&per_cu, (const void*)k_fast, NWAVES * 64, LDS_BYTES) != hipSuccess || per_cu < 1) { fprintf(stderr, "occupancy query: %d\n", per_cu); (void)hipGetLastError(); grid = -1; return; }
        grid = cus;
        if (need > ws_size) { fprintf(stderr, "workspace too small: need %zu have %zu\n", need, ws_size); grid = -1; return; }
    }
    if (grid < 0) return;
    (void)hipMemsetAsync(d_ws, 0, CTL_ZERO_BYTES, stream);
    FArgs a{}; a.p = p;
    hipLaunchKernelGGL(k_fast, dim3(grid), dim3(NWAVES * 64), LDS_BYTES, stream, a);
}
```
